# Optimizing an MI355X kernel written in HIP

```python
import jax, jax.numpy as jnp
from jax import lax
import numpy as np

D_MODEL = 1024
BATCH = 8
SEQ = 4096
DEPTH = 4

GRID_W = 64
CTX_LEN = 256
N_MIXERS = 2
NA_HEADS = 16
NA_HEAD_DIM = D_MODEL // NA_HEADS
NA_KH_MAX = 8
NA_KW = 16
NA_KB = 2 * NA_KW
NA_NCB = GRID_W // NA_KW
SG_CHUNK = 128
SG_HALF = 3 * D_MODEL
SG_GROUP_CH = 128
SG_GROUPS = SG_HALF // SG_GROUP_CH
MLP_HIDDEN = 4 * D_MODEL
N_ATTN_LAYERS = (DEPTH + N_MIXERS - 1) // N_MIXERS
N_SG_LAYERS = DEPTH // N_MIXERS
EPS = 1e-6
NEG_INF = -1e30

kernel_name = "hybrid_natten_gmlp_dit_prefix"


def rms_norm(t, g):
    t32 = t.astype(jnp.float32)
    t32 = t32 * lax.rsqrt(jnp.mean(t32 * t32, axis=-1, keepdims=True) + EPS)
    return (t32 * g.astype(jnp.float32)).astype(t.dtype)


def layer_norm(t, g, b):
    t32 = t.astype(jnp.float32)
    mu = jnp.mean(t32, axis=-1, keepdims=True)
    var = jnp.mean(jnp.square(t32 - mu), axis=-1, keepdims=True)
    out = (t32 - mu) * lax.rsqrt(var + EPS) * g.astype(jnp.float32) + b.astype(jnp.float32)
    return out.astype(t.dtype)


def modulate(h, shift, scale):
    return h * (1.0 + scale) + shift


def squared_relu_mlp(h, w1, w2):
    return jnp.square(jax.nn.relu(h @ w1)) @ w2


def _na_column_tables():
    j = np.arange(NA_NCB)[:, None, None]
    qi = np.arange(NA_KW)[None, :, None]
    m = np.arange(NA_KB)[None, None, :]
    qcol = j * NA_KW + qi
    kstart = np.clip(j * NA_KW - NA_KW // 2, 0, GRID_W - NA_KB)
    kcol = kstart + m
    wstart = np.clip(qcol - NA_KW // 2, 0, GRID_W - NA_KW)
    valid = (kcol >= wstart) & (kcol < wstart + NA_KW)
    col_rel = np.clip(kcol - qcol + NA_KW - 1, 0, 2 * NA_KW - 2)
    key_cols = np.clip(np.arange(NA_NCB) * NA_KW - NA_KW // 2, 0, GRID_W - NA_KB)[:, None] + np.arange(NA_KB)[None, :]
    return key_cols, valid, col_rel


def neighbourhood_attention(h, hc, w_qkv, q_g, k_g, rpb, w_o, ctx_out):
    bsz, n_tok, _ = h.shape
    rows = n_tok // GRID_W
    kh = min(NA_KH_MAX, rows)
    scale = NA_HEAD_DIM ** -0.5

    def heads(t):
        return t.reshape(t.shape[0], t.shape[1], NA_HEADS, NA_HEAD_DIM)

    q, k, v = jnp.split(h @ w_qkv, 3, axis=-1)
    q = rms_norm(heads(q), q_g)
    k = rms_norm(heads(k), k_g)
    v = heads(v)
    if ctx_out:
        qc, kc, vc = jnp.split(hc @ w_qkv, 3, axis=-1)
        qc = rms_norm(heads(qc), q_g)
    else:
        kc, vc = jnp.split(hc @ w_qkv[:, D_MODEL:], 2, axis=-1)
    kc = rms_norm(heads(kc), k_g)
    vc = heads(vc)

    qg = q.reshape(bsz, rows, NA_NCB, NA_KW, NA_HEADS, NA_HEAD_DIM)
    kg = k.reshape(bsz, rows, GRID_W, NA_HEADS, NA_HEAD_DIM)
    vg = v.reshape(bsz, rows, GRID_W, NA_HEADS, NA_HEAD_DIM)
    key_cols, valid, col_rel = _na_column_tables()
    n_lat_keys = kh * NA_KB

    def row_step(r):
        rs = jnp.clip(r - kh // 2, 0, rows - kh)
        q_r = lax.dynamic_index_in_dim(qg, r, axis=1, keepdims=False)
        k_r = lax.dynamic_slice_in_dim(kg, rs, kh, axis=1)[:, :, key_cols]
        v_r = lax.dynamic_slice_in_dim(vg, rs, kh, axis=1)[:, :, key_cols]
        row_rel = rs + jnp.arange(kh) - r + NA_KH_MAX - 1
        bias = rpb[:, row_rel][:, :, col_rel]
        bias = jnp.where(valid[None, None], bias, NEG_INF).transpose(0, 2, 3, 1, 4)
        s_lat = jnp.einsum('bjqhd,bkjmhd->bhjqkm', q_r, k_r,
                           preferred_element_type=jnp.float32) * scale + bias[None].astype(jnp.float32)
        s_ctx = jnp.einsum('bjqhd,blhd->bhjql', q_r, kc,
                           preferred_element_type=jnp.float32) * scale
        s = jnp.concatenate([s_lat.reshape(s_lat.shape[:4] + (n_lat_keys,)), s_ctx], axis=-1)
        p = jax.nn.softmax(s, axis=-1).astype(v.dtype)
        p_lat = p[..., :n_lat_keys].reshape(s_lat.shape)
        p_ctx = p[..., n_lat_keys:]
        o = (jnp.einsum('bhjqkm,bkjmhd->bjqhd', p_lat, v_r)
             + jnp.einsum('bhjql,blhd->bjqhd', p_ctx, vc))
        return o.reshape(bsz, GRID_W, D_MODEL)

    y = lax.map(row_step, jnp.arange(rows))
    y = y.transpose(1, 0, 2, 3).reshape(bsz, n_tok, D_MODEL) @ w_o
    yc = None
    if ctx_out:
        sc = jnp.einsum('blhd,bmhd->bhlm', qc, kc, preferred_element_type=jnp.float32) * scale
        pc = jax.nn.softmax(sc, axis=-1).astype(vc.dtype)
        yc = jnp.einsum('bhlm,bmhd->blhd', pc, vc).reshape(bsz, -1, D_MODEL) @ w_o
    return y, yc


def spatial_gating(h, w_in, b_in, ln_g, ln_b, w_s, b_s, w_o):
    bsz, n, _ = h.shape
    z = jax.nn.gelu(h @ w_in + b_in, approximate=False)
    u, v = jnp.split(z, 2, axis=-1)
    v = layer_norm(v, ln_g, ln_b)
    v = v.reshape(bsz, n // SG_CHUNK, SG_CHUNK, SG_GROUPS, SG_GROUP_CH)
    s = jnp.einsum('gpq,bnqgc->bnpgc', w_s, v) + b_s.T[None, None, :, :, None]
    return (u * s.reshape(bsz, n, SG_HALF)) @ w_o


def setup_inputs(seed: int = 0) -> dict:
    key = jax.random.key(seed)
    ks = jax.random.split(key, 24)
    f32 = jnp.float32
    nrm = lambda k, shape, s: jax.random.normal(k, shape, f32) * s
    D = D_MODEL
    return {
        "x": nrm(ks[0], (BATCH, SEQ, D), 1.0),
        "c": nrm(ks[1], (BATCH, D), 1.0),
        "ctx": nrm(ks[2], (BATCH, CTX_LEN, D), 1.0),
        "c_ctx": nrm(ks[3], (D,), 1.0),
        "ada_w": nrm(ks[4], (DEPTH, D, 6 * D), 0.5 * D ** -0.5),
        "ada_b": nrm(ks[5], (DEPTH, 6 * D), 0.02),
        "norm1_g": 1.0 + nrm(ks[6], (DEPTH, D), 0.02),
        "norm2_g": 1.0 + nrm(ks[7], (DEPTH, D), 0.02),
        "mlp_w1": nrm(ks[8], (DEPTH, D, MLP_HIDDEN), D ** -0.5),
        "mlp_w2": nrm(ks[9], (DEPTH, MLP_HIDDEN, D), MLP_HIDDEN ** -0.5),
        "na_w_qkv": nrm(ks[10], (N_ATTN_LAYERS, D, 3 * D), D ** -0.5),
        "na_q_norm": 1.0 + nrm(ks[11], (N_ATTN_LAYERS, NA_HEAD_DIM), 0.02),
        "na_k_norm": 1.0 + nrm(ks[12], (N_ATTN_LAYERS, NA_HEAD_DIM), 0.02),
        "na_rpb": nrm(ks[13], (N_ATTN_LAYERS, NA_HEADS, 2 * NA_KH_MAX - 1, 2 * NA_KW - 1), 0.02),
        "na_w_o": nrm(ks[14], (N_ATTN_LAYERS, D, D), D ** -0.5),
        "sg_w_in": nrm(ks[15], (N_SG_LAYERS, D, 2 * SG_HALF), D ** -0.5),
        "sg_b_in": nrm(ks[16], (N_SG_LAYERS, 2 * SG_HALF), 0.02),
        "sg_ln_g": 1.0 + nrm(ks[17], (N_SG_LAYERS, SG_HALF), 0.02),
        "sg_ln_b": nrm(ks[18], (N_SG_LAYERS, SG_HALF), 0.02),
        "sg_w_s": nrm(ks[19], (N_SG_LAYERS, SG_GROUPS, SG_CHUNK, SG_CHUNK), SG_CHUNK ** -0.5),
        "sg_b_s": 1.0 + nrm(ks[20], (N_SG_LAYERS, SG_GROUPS, SG_CHUNK), 0.02),
        "sg_w_o": nrm(ks[21], (N_SG_LAYERS, SG_HALF, D), SG_HALF ** -0.5),
    }


def reference(x, c, ctx, c_ctx, ada_w, ada_b, norm1_g, norm2_g, mlp_w1, mlp_w2,
              na_w_qkv, na_q_norm, na_k_norm, na_rpb, na_w_o,
              sg_w_in, sg_b_in, sg_ln_g, sg_ln_b, sg_w_s, sg_b_s, sg_w_o):
    last_ctx_layer = ((DEPTH - 1) // N_MIXERS) * N_MIXERS
    silu_c = jax.nn.silu(c)
    silu_cc = jax.nn.silu(c_ctx)
    for i in range(DEPTH):
        ctx_kv = i <= last_ctx_layer
        ctx_full = i < last_ctx_layer
        sh1, sc1, g1, sh2, sc2, g2 = [t[:, None, :] for t in
                                      jnp.split(silu_c @ ada_w[i] + ada_b[i], 6, axis=-1)]
        h = modulate(rms_norm(x, norm1_g[i]), sh1, sc1)
        hc = None
        if ctx_kv:
            csh1, csc1, cg1, csh2, csc2, cg2 = jnp.split(silu_cc @ ada_w[i] + ada_b[i], 6, axis=-1)
            hc = modulate(rms_norm(ctx, norm1_g[i]), csh1, csc1)
        if i % N_MIXERS == 0:
            a = i // N_MIXERS
            y, yc = neighbourhood_attention(h, hc, na_w_qkv[a], na_q_norm[a], na_k_norm[a],
                                            na_rpb[a], na_w_o[a], ctx_full)
        else:
            s = i // N_MIXERS
            y = spatial_gating(h, sg_w_in[s], sg_b_in[s], sg_ln_g[s], sg_ln_b[s],
                               sg_w_s[s], sg_b_s[s], sg_w_o[s])
            yc = None
            if ctx_full:
                yc = spatial_gating(hc, sg_w_in[s], sg_b_in[s], sg_ln_g[s], sg_ln_b[s],
                                    sg_w_s[s], sg_b_s[s], sg_w_o[s])
        x = x + g1 * y
        x = x + g2 * squared_relu_mlp(modulate(rms_norm(x, norm2_g[i]), sh2, sc2), mlp_w1[i], mlp_w2[i])
        if ctx_full:
            ctx = ctx + cg1 * yc
            ctx = ctx + cg2 * squared_relu_mlp(modulate(rms_norm(ctx, norm2_g[i]), csh2, csc2),
                                               mlp_w1[i], mlp_w2[i])
    return x
```

```cpp
#include <hip/hip_runtime.h>
#include <hip/hip_cooperative_groups.h>
#include <cstdio>
#include <cstdint>
namespace cg = cooperative_groups;
namespace pg8 {
#define PG8_LAS __attribute__((address_space(3)))
typedef unsigned short bf16_t;
typedef short bf16x8 __attribute__((ext_vector_type(8)));
typedef float f32x4 __attribute__((ext_vector_type(4)));
typedef unsigned u32x4 __attribute__((ext_vector_type(4)));
constexpr int BM = 256, BK = 64, HALF = 128, HTB = HALF * BK * 2  , STAGE_BYTES = 8 * HTB, NXCD = 8, WGM = 8;

__host__ __device__ __forceinline__ int lds_byte(int r, int c) { const int st = (r >> 4) * 2 + (c >> 5), rr = r & 15, cc = c & 31, ob = rr * 64 + cc * 2; return st * 1024 + (ob ^ (((ob >> 9) & 1) << 5)); }
__host__ __device__ __forceinline__ void stage_rc(int b, int& R, int& C) { const int st = b / 1024, sb = b % 1024, swz = sb ^ (((sb >> 9) & 1) << 5); R = (st >> 1) * 16 + swz / 64; C = (st & 1) * 32 + (swz % 64) / 2; }
__host__ __device__ __forceinline__ int perm32(int rho) { const int n = rho >> 4, i = rho & 15; return 8 * (i >> 2) + 4 * n + (i & 3); }

struct Unit { int pm, pn; };
struct Gemm { const bf16_t* A; const bf16_t* Bt; int M, N, K; };

struct StaticOrder {
    int nM, nN, nwg, G, c;
    __host__ __device__ void init(int M, int N, int G_, int c_) { nM = M / BM; nN = N / BM; nwg = nM * nN; G = G_; c = c_; }
    __host__ __device__ bool next(int i, Unit& u) const {
        const long L = (long)i * G + c; if (L >= nwg) return false;
        int wgid = (int)L; { const int q = nwg / NXCD, r = nwg % NXCD, xcd = wgid % NXCD, off = wgid / NXCD; wgid = (xcd < r ? xcd * (q + 1) : r * (q + 1) + (xcd - r) * q) + off; }
        const int nig = WGM * nN, gid = wgid / nig, fm = gid * WGM, gsz = (nM - fm) < WGM ? (nM - fm) : WGM;
        u.pm = fm + ((wgid % nig) % gsz); u.pn = (wgid % nig) / gsz; return true;
    }
    __device__ __forceinline__ void a_ready(const Unit&) const {}
    __device__ __forceinline__ void done(const Unit&) const {}
};

__device__ __forceinline__ unsigned cvt_pk_bf16(float lo, float hi) { unsigned r; asm volatile("v_cvt_pk_bf16_f32 %0, %1, %2" : "=v"(r) : "v"(lo), "v"(hi)); return r; }
template <class Epi, class Sched, bool ALIGN_EPI = false, bool SP2 = false>
__device__ __forceinline__ void gemm_phase(PG8_LAS unsigned char* lds, const Gemm g, const Sched& S, const Epi& E) {
    const int tid = threadIdx.x, wid = __builtin_amdgcn_readfirstlane(tid >> 6), lane = tid & 63, wr = wid >> 2, wc = wid & 3, fr = lane & 15, fq = lane >> 4;
    const int K = g.K, nt = K / BK;
    unsigned voffA[2], voffB[2];
#pragma unroll
    for (int i = 0; i < 2; ++i) { int R, C; stage_rc(tid * 16 + i * 8192, R, C); const int Rb = Epi::PERM ? ((R & ~31) + perm32(R & 31)) : R;
        voffA[i] = (unsigned)(R * K + C) * 2u; voffB[i] = (unsigned)(Rb * K + C) * 2u; }
    const size_t kstep = (size_t)(BK * 2);
    const size_t hstep = (size_t)HALF * K * 2;
    const size_t tstep = 2 * hstep;
    const unsigned ldsw = (unsigned)wid * 1024u;
    const int aoff = lds_byte(wr * 64 + fr, fq * 8), boff = lds_byte(wc * 32 + fr, fq * 8);
#define PG8_SA(b, h) (((b) * 2 + (h)) * HTB)
#define PG8_SB(b, h) ((4 + (b) * 2 + (h)) * HTB)
#define PG8_STAGE(bufoff, gbase, voff) do { _Pragma("unroll") for (int _i = 0; _i < 2; ++_i) \
        __builtin_amdgcn_global_load_lds((const unsigned*)((const char*)(gbase) + (voff)[_i]), (PG8_LAS unsigned*)(lds + (bufoff) + ldsw + _i * 8192), 16, 0, 0); } while (0)
#define PG8_LDA(dst, b, h) do { _Pragma("unroll") for (int m = 0; m < 4; ++m) _Pragma("unroll") for (int k = 0; k < 2; ++k) dst[m][k] = *(const PG8_LAS bf16x8*)(lds + PG8_SA(b, h) + aoff + m * 2048 + k * 1024); } while (0)
#define PG8_LDB(dst, b, h) do { _Pragma("unroll") for (int n = 0; n < 2; ++n) _Pragma("unroll") for (int k = 0; k < 2; ++k) dst[n][k] = *(const PG8_LAS bf16x8*)(lds + PG8_SB(b, h) + boff + n * 2048 + k * 1024); } while (0)
#define PG8_MMA(ai, bj, At, Bt) do { __builtin_amdgcn_s_setprio(1); _Pragma("unroll") for (int m = 0; m < 4; ++m) _Pragma("unroll") for (int n = 0; n < 2; ++n) _Pragma("unroll") for (int k = 0; k < 2; ++k) \
        acc[ai][bj][m][n] = __builtin_amdgcn_mfma_f32_16x16x32_bf16(Bt[n][k], At[m][k], acc[ai][bj][m][n], 0, 0, 0); __builtin_amdgcn_s_setprio(0); } while (0)
#define PG8_WAIT_V(n) asm volatile("s_waitcnt vmcnt(" #n ")" ::: "memory")
#define PG8_WAIT_L(n) asm volatile("s_waitcnt lgkmcnt(" #n ")" ::: "memory")
#define PG8_BAR __builtin_amdgcn_s_barrier()
#define PG8_SCHED __builtin_amdgcn_sched_barrier(0)
    Unit cur, nxt; int ui = 0;
    if (!S.next(0, cur)) return;
    f32x4 acc[2][2][4][2];
#pragma unroll
    for (int a = 0; a < 2; ++a)
#pragma unroll
        for (int b = 0; b < 2; ++b)
#pragma unroll
            for (int m = 0; m < 4; ++m)
#pragma unroll
                for (int n = 0; n < 2; ++n) acc[a][b][m][n] = (f32x4){0.f, 0.f, 0.f, 0.f};
    bf16x8 At[4][2], B0[2][2], B1[2][2];
    const char* cA = (const char*)g.A + (size_t)cur.pm * tstep; const char* cB = (const char*)g.Bt + (size_t)cur.pn * tstep;
    S.a_ready(cur);
    if constexpr (SP2) {
        PG8_STAGE(PG8_SB(0, 0), cB, voffB); PG8_STAGE(PG8_SB(0, 1), cB + hstep, voffB); PG8_STAGE(PG8_SA(0, 0), cA, voffA); PG8_STAGE(PG8_SA(0, 1), cA + hstep, voffA);
        if (wr == 1) PG8_BAR;
        PG8_WAIT_V(2); PG8_BAR;
        PG8_STAGE(PG8_SB(1, 0), cB + kstep, voffB); PG8_STAGE(PG8_SA(1, 0), cA + kstep, voffA); PG8_STAGE(PG8_SB(1, 1), cB + hstep + kstep, voffB);
        PG8_WAIT_V(6); PG8_BAR;
    } else {
        PG8_STAGE(PG8_SB(0, 0), cB, voffB); PG8_STAGE(PG8_SA(0, 0), cA, voffA); PG8_STAGE(PG8_SB(0, 1), cB + hstep, voffB); PG8_STAGE(PG8_SA(0, 1), cA + hstep, voffA);
        if (wr == 1) PG8_BAR;
        PG8_WAIT_V(4); PG8_BAR;
        PG8_STAGE(PG8_SB(1, 0), cB + kstep, voffB); PG8_STAGE(PG8_SA(1, 0), cA + kstep, voffA); PG8_STAGE(PG8_SB(1, 1), cB + hstep + kstep, voffB);
        PG8_WAIT_V(6); PG8_BAR;
    }
    for (;;) {
        const bool has_next = S.next(ui + 1, nxt);
        const char* nA = has_next ? (const char*)g.A + (size_t)nxt.pm * tstep : cA; const char* nB = has_next ? (const char*)g.Bt + (size_t)nxt.pn * tstep : cB;
        for (int t = 0; t < nt; t += 2) {
            const bool last = (t == nt - 2);
            const char* a1 = cA + (size_t)(t + 1) * kstep;
            const char* a2 = last ? nA : cA + (size_t)(t + 2) * kstep; const char* b2 = last ? nB : cB + (size_t)(t + 2) * kstep;
            const char* a3 = a2 + kstep; const char* b3 = b2 + kstep;
            if (last && has_next) S.a_ready(nxt);
            if constexpr (SP2) {
            PG8_LDB(B0, 0, 0); PG8_LDB(B1, 0, 1); PG8_SCHED; PG8_LDA(At, 0, 0); PG8_STAGE(PG8_SA(1, 1), a1 + hstep, voffA);
            PG8_WAIT_V(8); PG8_WAIT_L(0); PG8_BAR; PG8_MMA(0, 0, At, B0); PG8_MMA(0, 1, At, B1); PG8_BAR; PG8_SCHED;
            PG8_LDA(At, 0, 1); PG8_STAGE(PG8_SB(0, 0), b2, voffB); PG8_STAGE(PG8_SB(0, 1), b2 + hstep, voffB); PG8_STAGE(PG8_SA(0, 0), a2, voffA);
            PG8_WAIT_V(8); PG8_WAIT_L(0); PG8_BAR; PG8_MMA(1, 0, At, B0); PG8_MMA(1, 1, At, B1); PG8_BAR; PG8_SCHED;
            PG8_LDB(B0, 1, 0); PG8_LDB(B1, 1, 1); PG8_SCHED; PG8_LDA(At, 1, 0); PG8_STAGE(PG8_SA(0, 1), a2 + hstep, voffA);
            PG8_WAIT_V(8); PG8_WAIT_L(0); PG8_BAR; PG8_MMA(0, 0, At, B0); PG8_MMA(0, 1, At, B1); PG8_BAR; PG8_SCHED;
            PG8_LDA(At, 1, 1); PG8_STAGE(PG8_SB(1, 0), b3, voffB); PG8_STAGE(PG8_SB(1, 1), b3 + hstep, voffB); PG8_STAGE(PG8_SA(1, 0), a3, voffA);
            PG8_WAIT_V(8); PG8_WAIT_L(0); PG8_BAR; PG8_MMA(1, 0, At, B0); PG8_MMA(1, 1, At, B1); PG8_BAR; PG8_SCHED;
            } else {
            PG8_LDB(B0, 0, 0); PG8_SCHED; PG8_LDA(At, 0, 0); PG8_STAGE(PG8_SA(1, 1), a1 + hstep, voffA);
            PG8_WAIT_L(8); PG8_BAR; PG8_WAIT_L(0); PG8_MMA(0, 0, At, B0); PG8_BAR; PG8_SCHED;
            PG8_LDB(B1, 0, 1); PG8_STAGE(PG8_SB(0, 0), b2, voffB);
            PG8_BAR; PG8_WAIT_L(0); PG8_MMA(0, 1, At, B1); PG8_BAR;
            PG8_LDA(At, 0, 1); PG8_STAGE(PG8_SA(0, 0), a2, voffA);
            PG8_BAR; PG8_WAIT_L(0); PG8_MMA(1, 0, At, B0); PG8_BAR; PG8_SCHED;
            PG8_STAGE(PG8_SB(0, 1), b2 + hstep, voffB);
            PG8_WAIT_V(6); PG8_BAR; PG8_MMA(1, 1, At, B1); PG8_BAR;
            PG8_LDB(B0, 1, 0); PG8_SCHED; PG8_LDA(At, 1, 0); PG8_STAGE(PG8_SA(0, 1), a2 + hstep, voffA);
            PG8_WAIT_L(8); PG8_BAR; PG8_WAIT_L(0); PG8_MMA(0, 0, At, B0); PG8_BAR; PG8_SCHED;
            PG8_LDB(B1, 1, 1); PG8_STAGE(PG8_SB(1, 0), b3, voffB);
            PG8_BAR; PG8_WAIT_L(0); PG8_MMA(0, 1, At, B1); PG8_BAR;
            PG8_LDA(At, 1, 1); PG8_STAGE(PG8_SA(1, 0), a3, voffA);
            PG8_BAR; PG8_WAIT_L(0); PG8_MMA(1, 0, At, B0); PG8_BAR; PG8_SCHED;
            PG8_STAGE(PG8_SB(1, 1), b3 + hstep, voffB);
            PG8_WAIT_V(6); PG8_BAR; PG8_MMA(1, 1, At, B1); PG8_BAR;
            }
        }
        if constexpr (ALIGN_EPI) { if (wr == 0) PG8_BAR; }
        if constexpr (!Epi::AFTER_DRAIN) { E(acc, cur, wr, wc, fr, fq); S.done(cur); }
        if (!has_next) break;
#pragma unroll
        for (int a = 0; a < 2; ++a)
#pragma unroll
            for (int b = 0; b < 2; ++b)
#pragma unroll
                for (int m = 0; m < 4; ++m)
#pragma unroll
                    for (int n = 0; n < 2; ++n) acc[a][b][m][n] = (f32x4){0.f, 0.f, 0.f, 0.f};
        cur = nxt; cA = nA; cB = nB; ++ui;
        if constexpr (ALIGN_EPI) { if (wr == 1) PG8_BAR; }
    }
    PG8_WAIT_V(0);
    if constexpr (!ALIGN_EPI) { if (wr == 0) PG8_BAR; }
    PG8_BAR;
    if constexpr (Epi::AFTER_DRAIN) { E.fused(acc, cur, wr, wc, fr, fq, lds, wid, lane); S.done(cur); }
#undef PG8_SA
#undef PG8_SB
#undef PG8_STAGE
#undef PG8_LDA
#undef PG8_LDB
#undef PG8_MMA
#undef PG8_WAIT_V
#undef PG8_WAIT_L
#undef PG8_BAR
#undef PG8_SCHED
}
}

#define LAS __attribute__((address_space(3)))
using pg8::bf16_t; using pg8::f32x4; using pg8::Unit; using pg8::u32x4;
typedef unsigned u32x2 __attribute__((ext_vector_type(2)));

constexpr int NLAT = 32768, NCTX = 2048, MTOT = 34816;
constexpr int NTHREADS = 512;
constexpr int LDS_BYTES = 131072;
constexpr int NPH = 35;

constexpr size_t OFF_W1T = 0;
constexpr size_t OFF_W2T = OFF_W1T + 4ull * 4096 * 1024 * 2;
constexpr size_t OFF_QKVT = OFF_W2T + 4ull * 4096 * 1024 * 2;
constexpr size_t OFF_WOT = OFF_QKVT + 2ull * 3072 * 1024 * 2;
constexpr size_t OFF_WINT = OFF_WOT + 2ull * 1024 * 1024 * 2;
constexpr size_t OFF_SGOT = OFF_WINT + 2ull * 6144 * 1024 * 2;
constexpr size_t OFF_MODS = OFF_SGOT + 2ull * 1024 * 3072 * 2;
constexpr size_t OFF_CTXR = OFF_MODS + 4ull * 9 * 6144 * 4;
constexpr size_t OFF_HB = OFF_CTXR + 2048ull * 1024 * 4;
constexpr size_t OFF_BIG = OFF_HB + 34816ull * 1024 * 2;
constexpr size_t OFF_STATS = OFF_BIG + 34816ull * 4096 * 2;
constexpr size_t WS_END = OFF_STATS + 34816ull * 2 * 4;

struct Params {
    const float *x, *c, *ctx, *c_ctx, *ada_w, *ada_b, *norm1_g, *norm2_g, *mlp_w1, *mlp_w2, *na_w_qkv, *na_q_norm, *na_k_norm, *na_rpb, *na_w_o,
        *sg_w_in, *sg_b_in, *sg_ln_g, *sg_ln_b, *sg_w_s, *sg_b_s, *sg_w_o;
    float* out; unsigned char* ws; int ph_lo, ph_hi;
};

__device__ __forceinline__ float bf2f(unsigned h) { return __uint_as_float(h << 16); }
__device__ __forceinline__ unsigned f2bf(float f) { unsigned u = __float_as_uint(f); u += 0x7FFFu + ((u >> 16) & 1u); return u >> 16; }
__device__ __forceinline__ unsigned pk2(float lo, float hi) { return pg8::cvt_pk_bf16(lo, hi); }
__device__ __forceinline__ float wave_sum(float v) {
#pragma unroll
    for (int o = 1; o < 64; o <<= 1) v += __shfl_xor(v, o);
    return v;
}
__device__ __forceinline__ float wave_max(float v) {
#pragma unroll
    for (int o = 1; o < 64; o <<= 1) v = fmaxf(v, __shfl_xor(v, o));
    return v;
}
#define LDS_WAIT() asm volatile("s_waitcnt lgkmcnt(0)" ::: "memory")
__device__ __forceinline__ float silu_f(float v) { return v / (1.f + expf(-v)); }
__device__ __forceinline__ float gelu_f(float v) { return 0.5f * v * (1.f + erff(v * 0.70710678118654752f)); }

__device__ __forceinline__ int sigma_inv(int L) { return 128 * ((L >> 5) & 1) + 32 * (L >> 6) + 16 * ((L >> 2) & 1) + 4 * ((L >> 3) & 3) + (L & 3); }

__device__ __forceinline__ void phase_mods(const Params& p, LAS unsigned char* lds) {
    LAS float* sc = (LAS float*)lds;
    LAS float* red = (LAS float*)(lds + 36864);
    float* mods = (float*)(p.ws + OFF_MODS);
    const int tid = threadIdx.x;
    for (int i = tid; i < 9 * 1024; i += NTHREADS) { const int b = i >> 10, k = i & 1023; const float v = b < 8 ? p.c[b * 1024 + k] : p.c_ctx[k]; sc[i] = silu_f(v); }
    __syncthreads();
    const int c4 = (tid & 15) * 4, kk = tid >> 4;
    for (int item = blockIdx.x; item < 384; item += gridDim.x) {
        const int l = item / 96, n0 = (item % 96) * 64;
        const float* W = p.ada_w + (size_t)l * 1024 * 6144 + n0 + c4;
        f32x4 acc[9];
#pragma unroll
        for (int b = 0; b < 9; ++b) acc[b] = (f32x4){0.f, 0.f, 0.f, 0.f};
#pragma unroll 4
        for (int i = 0; i < 32; ++i) { const int k = kk + 32 * i; const f32x4 w = *(const f32x4*)(W + (size_t)k * 6144);
#pragma unroll
            for (int b = 0; b < 9; ++b) acc[b] += sc[b * 1024 + k] * w; }
#pragma unroll
        for (int b = 0; b < 9; ++b) *(LAS f32x4*)(red + (kk * 9 + b) * 64 + c4) = acc[b];
        __syncthreads();
        for (int o = tid; o < 576; o += NTHREADS) { const int b = o >> 6, cc = o & 63; float s = 0.f;
            for (int j = 0; j < 32; ++j) s += red[(j * 9 + b) * 64 + cc];
            mods[(size_t)(l * 9 + b) * 6144 + n0 + cc] = s + p.ada_b[l * 6144 + n0 + cc]; }
        __syncthreads();
    }
}

struct MatDesc { const float* src; bf16_t* dst; int K, N; };
__device__ __forceinline__ MatDesc get_mat(const Params& p, int mi) {
    MatDesc m;
    if (mi < 4) { m.src = p.mlp_w1 + (size_t)mi * 1024 * 4096; m.dst = (bf16_t*)(p.ws + OFF_W1T) + (size_t)mi * 4096 * 1024; m.K = 1024; m.N = 4096; }
    else if (mi < 8) { const int l = mi - 4; m.src = p.mlp_w2 + (size_t)l * 4096 * 1024; m.dst = (bf16_t*)(p.ws + OFF_W2T) + (size_t)l * 1024 * 4096; m.K = 4096; m.N = 1024; }
    else if (mi < 10) { const int a = mi - 8; m.src = p.na_w_qkv + (size_t)a * 1024 * 3072; m.dst = (bf16_t*)(p.ws + OFF_QKVT) + (size_t)a * 3072 * 1024; m.K = 1024; m.N = 3072; }
    else if (mi < 12) { const int a = mi - 10; m.src = p.na_w_o + (size_t)a * 1024 * 1024; m.dst = (bf16_t*)(p.ws + OFF_WOT) + (size_t)a * 1024 * 1024; m.K = 1024; m.N = 1024; }
    else if (mi < 14) { const int s = mi - 12; m.src = p.sg_w_in + (size_t)s * 1024 * 6144; m.dst = (bf16_t*)(p.ws + OFF_WINT) + (size_t)s * 6144 * 1024; m.K = 1024; m.N = 6144; }
    else { const int s = mi - 14; m.src = p.sg_w_o + (size_t)s * 3072 * 1024; m.dst = (bf16_t*)(p.ws + OFF_SGOT) + (size_t)s * 1024 * 3072; m.K = 3072; m.N = 1024; }
    return m;
}
__device__ __forceinline__ void transpose_item(const float* W, int K, int N, bf16_t* WT, LAS float* scr, int item, int lane) {
    const int nblk = N / 32, kb = item / nblk, nb = item % nblk, k0 = 64 * kb, n0 = 32 * nb;
#pragma unroll 8
    for (int i = 0; i < 32; ++i) { const int kk = 2 * i + (lane >> 5); scr[kk * 33 + (lane & 31)] = W[(size_t)(k0 + kk) * N + n0 + (lane & 31)]; }
    LDS_WAIT();
    const int c = lane & 7;
#pragma unroll
    for (int j = 0; j < 4; ++j) { const int n = (lane >> 3) + 8 * j; const LAS float* s = scr + (8 * c) * 33 + n;
        u32x4 o; o.x = pk2(s[0 * 33], s[1 * 33]); o.y = pk2(s[2 * 33], s[3 * 33]); o.z = pk2(s[4 * 33], s[5 * 33]); o.w = pk2(s[6 * 33], s[7 * 33]);
        const int nl = n0 + n, drow = (nl & ~255) + sigma_inv(nl & 255);
        *(u32x4*)(WT + (size_t)drow * K + k0 + 8 * c) = o; }
    LDS_WAIT();
}
__device__ __forceinline__ void phase_convert(const Params& p, LAS unsigned char* lds) {
    const int lane = threadIdx.x & 63, wave = threadIdx.x >> 6, gw = blockIdx.x * 8 + wave, NGW = gridDim.x * 8;
    LAS float* scr = (LAS float*)(lds + wave * 8704);
    for (int mi = 0; mi < 16; ++mi) {
        const MatDesc m = get_mat(p, mi);
        const int nitems = (m.K / 64) * (m.N / 32);
        for (int it = gw; it < nitems; it += NGW) transpose_item(m.src, m.K, m.N, m.dst, scr, it, lane);
    }
}

__device__ __forceinline__ void phase_normmod(const float* xl, const float* xc, bf16_t* hb, const float* g, const float* modsl, int sh_off, int sc_off, int M) {
    const int lane = threadIdx.x & 63, gw = blockIdx.x * 8 + (threadIdx.x >> 6), NGW = gridDim.x * 8;
    for (int row = gw; row < M; row += NGW) {
        const float* xr = row < NLAT ? xl + (size_t)row * 1024 : xc + (size_t)(row - NLAT) * 1024;
        const int b = row < NLAT ? (row >> 12) : 8;
        f32x4 v[4]; float s = 0.f;
#pragma unroll
        for (int j = 0; j < 4; ++j) { v[j] = *(const f32x4*)(xr + 4 * lane + 256 * j); s += (v[j].x * v[j].x + v[j].y * v[j].y) + (v[j].z * v[j].z + v[j].w * v[j].w); }
        s = wave_sum(s);
        const float rstd = 1.0f / sqrtf(s * (1.0f / 1024.0f) + 1e-6f);
#pragma unroll
        for (int j = 0; j < 4; ++j) { const int col = 4 * lane + 256 * j;
            const f32x4 gv = *(const f32x4*)(g + col), scv = *(const f32x4*)(modsl + (size_t)b * 6144 + sc_off + col), shv = *(const f32x4*)(modsl + (size_t)b * 6144 + sh_off + col);
            const f32x4 o = v[j] * rstd * gv * (1.0f + scv) + shv;
            u32x2 w; w.x = pk2(o.x, o.y); w.y = pk2(o.z, o.w);
            *(u32x2*)(hb + (size_t)row * 1024 + col) = w; }
    }
}
__device__ __forceinline__ void phase_headnorm(bf16_t* qkv, const float* qg, const float* kg, int M) {
    const int lane = threadIdx.x & 63, gw = blockIdx.x * 8 + (threadIdx.x >> 6), NGW = gridDim.x * 8;
    const bool isq = lane < 32; const int d0 = (lane & 1) * 32;
    const float* gn = isq ? qg : kg; const float mul = isq ? 0.125f : 1.0f;
    for (int row = gw; row < M; row += NGW) {
        bf16_t* ptr = qkv + (size_t)row * 3072 + lane * 32;
        u32x4 raw[4]; float v[32]; float s = 0.f;
#pragma unroll
        for (int j = 0; j < 4; ++j) raw[j] = *(const u32x4*)(ptr + 8 * j);
#pragma unroll
        for (int j = 0; j < 4; ++j) {
#pragma unroll
            for (int e = 0; e < 4; ++e) { const unsigned w = raw[j][e]; v[8 * j + 2 * e] = bf2f(w & 0xffffu); v[8 * j + 2 * e + 1] = bf2f(w >> 16); } }
#pragma unroll
        for (int i = 0; i < 32; ++i) s += v[i] * v[i];
        s += __shfl_xor(s, 1);
        const float rstd = mul / sqrtf(s * (1.0f / 64.0f) + 1e-6f);
#pragma unroll
        for (int j = 0; j < 4; ++j) { u32x4 o;
#pragma unroll
            for (int e = 0; e < 4; ++e) { const int i = 8 * j + 2 * e; o[e] = pk2(v[i] * rstd * gn[d0 + i], v[i + 1] * rstd * gn[d0 + i + 1]); }
            *(u32x4*)(ptr + 8 * j) = o; }
    }
}
__device__ __forceinline__ float dot64(const float (&q)[64], const bf16_t* kp) {
    float s = 0.f;
#pragma unroll
    for (int j = 0; j < 8; ++j) { const u32x4 w = *(const u32x4*)(kp + 8 * j);
#pragma unroll
        for (int e = 0; e < 4; ++e) { s += q[8 * j + 2 * e] * bf2f(w[e] & 0xffffu); s += q[8 * j + 2 * e + 1] * bf2f(w[e] >> 16); } }
    return s;
}
__device__ __forceinline__ void phase_attn_naive(const Params& p, int a, bool ctx_q) {
    const bf16_t* qkv = (const bf16_t*)(p.ws + OFF_BIG); bf16_t* ao = (bf16_t*)(p.ws + OFF_BIG) + (size_t)MTOT * 3072;
    const float* rpb = p.na_rpb + (size_t)a * 16 * 15 * 31;
    const int lane = threadIdx.x & 63, gw = blockIdx.x * 8 + (threadIdx.x >> 6), NGW = gridDim.x * 8;
    const int nq = ctx_q ? MTOT : NLAT;
    for (int item = gw; item < nq * 16; item += NGW) {
        const int row = item >> 4, h = item & 15;
        const bool lat = row < NLAT;
        int b, r = 0, qc = 0, rs = 0, wst = 0;
        if (lat) { b = row >> 12; const int t = row & 4095; r = t >> 6; qc = t & 63; rs = min(max(r - 4, 0), 56); wst = min(max(qc - 8, 0), 48); } else b = (row - NLAT) >> 8;
        float q[64];
        { const bf16_t* qp = qkv + (size_t)row * 3072 + h * 64;
#pragma unroll
          for (int j = 0; j < 8; ++j) { const u32x4 w = *(const u32x4*)(qp + 8 * j);
#pragma unroll
              for (int e = 0; e < 4; ++e) { q[8 * j + 2 * e] = bf2f(w[e] & 0xffffu); q[8 * j + 2 * e + 1] = bf2f(w[e] >> 16); } } }
        float sc[6];
#pragma unroll
        for (int i = 0; i < 2; ++i) {
            if (lat) { const int kk = lane + 64 * i, kr = rs + (kk >> 4), kc = wst + (kk & 15);
                sc[i] = dot64(q, qkv + (size_t)(b * 4096 + kr * 64 + kc) * 3072 + 1024 + h * 64) + rpb[(h * 15 + (kr - r + 7)) * 31 + (kc - qc + 15)]; }
            else sc[i] = -1e30f; }
#pragma unroll
        for (int i = 0; i < 4; ++i) { const int j = lane + 64 * i; sc[2 + i] = dot64(q, qkv + (size_t)(NLAT + b * 256 + j) * 3072 + 1024 + h * 64); }
        float mx = sc[0];
#pragma unroll
        for (int i = 1; i < 6; ++i) mx = fmaxf(mx, sc[i]);
        mx = wave_max(mx);
        float sum = 0.f;
#pragma unroll
        for (int i = 0; i < 6; ++i) { sc[i] = expf(sc[i] - mx); sum += sc[i]; }
        sum = wave_sum(sum);
        float o = 0.f;
        if (lat) {
#pragma unroll
            for (int i = 0; i < 2; ++i)
                for (int l = 0; l < 64; ++l) { const float pk = __shfl(sc[i], l); const int kk = l + 64 * i, kr = rs + (kk >> 4), kc = wst + (kk & 15);
                    o += pk * bf2f(qkv[(size_t)(b * 4096 + kr * 64 + kc) * 3072 + 2048 + h * 64 + lane]); } }
#pragma unroll
        for (int i = 0; i < 4; ++i)
            for (int l = 0; l < 64; ++l) { const float pk = __shfl(sc[2 + i], l); const int j = l + 64 * i;
                o += pk * bf2f(qkv[(size_t)(NLAT + b * 256 + j) * 3072 + 2048 + h * 64 + lane]); }
        ao[(size_t)row * 1024 + h * 64 + lane] = (bf16_t)f2bf(o / sum);
    }
}
__device__ __forceinline__ void phase_lnstats(const bf16_t* vb, float* stats, int M) {
    const int lane = threadIdx.x & 63, gw = blockIdx.x * 8 + (threadIdx.x >> 6), NGW = gridDim.x * 8;
    for (int row = gw; row < M; row += NGW) {
        const bf16_t* vp = vb + (size_t)row * 3072 + lane * 8;
        float v[48]; float s = 0.f;
#pragma unroll
        for (int j = 0; j < 6; ++j) { const u32x4 w = *(const u32x4*)(vp + 512 * j);
#pragma unroll
            for (int e = 0; e < 4; ++e) { v[8 * j + 2 * e] = bf2f(w[e] & 0xffffu); v[8 * j + 2 * e + 1] = bf2f(w[e] >> 16); } }
#pragma unroll
        for (int i = 0; i < 48; ++i) s += v[i];
        const float mean = wave_sum(s) * (1.0f / 3072.0f);
        float q = 0.f;
#pragma unroll
        for (int i = 0; i < 48; ++i) { const float d = v[i] - mean; q += d * d; }
        q = wave_sum(q) * (1.0f / 3072.0f);
        if (lane == 0) { stats[2 * row] = mean; stats[2 * row + 1] = 1.0f / sqrtf(q + 1e-6f); }
    }
}
__device__ __forceinline__ void phase_spatial_naive(const Params& p, int sl, int M, LAS unsigned char* lds) {
    bf16_t* vb = (bf16_t*)(p.ws + OFF_BIG); const float* stats = (const float*)(p.ws + OFF_STATS);
    LAS float* V = (LAS float*)lds;
    LAS float* Wl = (LAS float*)(lds + 65536);
    const float* lng = p.sg_ln_g + sl * 3072; const float* lnb = p.sg_ln_b + sl * 3072;
    const int tid = threadIdx.x;
    const int nunits = (M / 128) * 24;
    for (int u = blockIdx.x; u < nunits; u += gridDim.x) {
        const int nc = u / 24, g = u % 24, r0 = nc * 128;
        const float* Wg = p.sg_w_s + ((size_t)sl * 24 + g) * 16384;
        for (int i = 0; i < 32; ++i) { const int idx = tid + 512 * i, q = idx >> 7, c = idx & 127;
            const float val = bf2f(vb[(size_t)(r0 + q) * 3072 + g * 128 + c]);
            V[idx] = (val - stats[2 * (r0 + q)]) * stats[2 * (r0 + q) + 1] * lng[g * 128 + c] + lnb[g * 128 + c];
            Wl[idx] = Wg[idx]; }
        __syncthreads();
        const int c = tid & 127, pg = tid >> 7;
        float acc[32];
#pragma unroll
        for (int i = 0; i < 32; ++i) acc[i] = 0.f;
        for (int q = 0; q < 128; ++q) { const float vv = V[q * 128 + c];
#pragma unroll
            for (int i = 0; i < 32; ++i) acc[i] += Wl[(pg * 32 + i) * 128 + q] * vv; }
        __syncthreads();
#pragma unroll
        for (int i = 0; i < 32; ++i) { const int pp = pg * 32 + i; vb[(size_t)(r0 + pp) * 3072 + g * 128 + c] = (bf16_t)f2bf(acc[i] + p.sg_b_s[((size_t)sl * 24 + g) * 128 + pp]); }
    }
}

template <class F> struct EpiG {
    static constexpr bool PERM = false, AFTER_DRAIN = false;
    F f;
    __device__ __forceinline__ void operator()(const f32x4 (&acc)[2][2][4][2], const Unit& u, int wr, int wc, int fr, int fq) const {
#pragma unroll
        for (int ai = 0; ai < 2; ++ai)
#pragma unroll
            for (int m = 0; m < 4; ++m) { const int row = u.pm * 256 + ai * 128 + wr * 64 + m * 16 + fr;
#pragma unroll
                for (int bj = 0; bj < 2; ++bj) { const int col = u.pn * 256 + 64 * wc + 32 * bj + 8 * fq; f(row, col, acc[ai][bj][m][0], acc[ai][bj][m][1]); }
                asm volatile("" ::: "memory"); }
    }
};
__device__ __forceinline__ void store8_bf16(bf16_t* o, const f32x4 a, const f32x4 b) { u32x4 w; w.x = pk2(a.x, a.y); w.y = pk2(a.z, a.w); w.z = pk2(b.x, b.y); w.w = pk2(b.z, b.w); *(u32x4*)o = w; }
struct EStore { bf16_t* O; int ldo;
    __device__ __forceinline__ void operator()(int row, int col, f32x4 a, f32x4 b) const { store8_bf16(O + (size_t)row * ldo + col, a, b); } };
struct ESqrelu { bf16_t* O; int ldo;
    __device__ __forceinline__ void operator()(int row, int col, f32x4 a, f32x4 b) const {
#pragma unroll
        for (int i = 0; i < 4; ++i) { const float x = fmaxf(a[i], 0.f), y = fmaxf(b[i], 0.f); a[i] = x * x; b[i] = y * y; }
        store8_bf16(O + (size_t)row * ldo + col, a, b); } };
struct EGeluBias { bf16_t* O; int ldo; const float* bias;
    __device__ __forceinline__ void operator()(int row, int col, f32x4 a, f32x4 b) const {
        const f32x4 b0 = *(const f32x4*)(bias + col), b1 = *(const f32x4*)(bias + col + 4);
#pragma unroll
        for (int i = 0; i < 4; ++i) { a[i] = gelu_f(a[i] + b0[i]); b[i] = gelu_f(b[i] + b1[i]); }
        store8_bf16(O + (size_t)row * ldo + col, a, b); } };
struct EGeluGate { bf16_t* O; int ldo; const float* bias;
    __device__ __forceinline__ void operator()(int row, int col, f32x4 a, f32x4 b) const {
        const f32x4 b0 = *(const f32x4*)(bias + col), b1 = *(const f32x4*)(bias + col + 4);
        bf16_t* op = O + (size_t)row * ldo + col; const u32x4 sv = *(const u32x4*)op;
#pragma unroll
        for (int i = 0; i < 4; ++i) { a[i] = gelu_f(a[i] + b0[i]); b[i] = gelu_f(b[i] + b1[i]); }
        a.x *= bf2f(sv.x & 0xffffu); a.y *= bf2f(sv.x >> 16); a.z *= bf2f(sv.y & 0xffffu); a.w *= bf2f(sv.y >> 16);
        b.x *= bf2f(sv.z & 0xffffu); b.y *= bf2f(sv.z >> 16); b.z *= bf2f(sv.w & 0xffffu); b.w *= bf2f(sv.w >> 16);
        store8_bf16(op, a, b); } };
struct EResid { const float* inl; const float* inc; float* outl; float* outc; const float* gate;
    __device__ __forceinline__ void operator()(int row, int col, f32x4 a, f32x4 b) const {
        const bool lat = row < NLAT; const int bb = lat ? (row >> 12) : 8;
        const float* ip = lat ? inl + (size_t)row * 1024 + col : inc + (size_t)(row - NLAT) * 1024 + col;
        float* op = lat ? outl + (size_t)row * 1024 + col : outc + (size_t)(row - NLAT) * 1024 + col;
        const f32x4 g0 = *(const f32x4*)(gate + (size_t)bb * 6144 + col), g1 = *(const f32x4*)(gate + (size_t)bb * 6144 + col + 4);
        const f32x4 x0 = *(const f32x4*)ip, x1 = *(const f32x4*)(ip + 4);
        *(f32x4*)op = x0 + g0 * a; *(f32x4*)(op + 4) = x1 + g1 * b; } };

template <class F> __device__ __forceinline__ void run_gemm(LAS unsigned char* lds, const bf16_t* A, const bf16_t* Bt, int M, int N, int K, const F& f) {
    pg8::StaticOrder S; S.init(M, N, (int)gridDim.x, (int)blockIdx.x);
    pg8::Gemm g; g.A = A; g.Bt = Bt; g.M = M; g.N = N; g.K = K;
    EpiG<F> E; E.f = f;
    pg8::gemm_phase<EpiG<F>, pg8::StaticOrder, true, true>(lds, g, S, E);
}

enum { OP_NORM1, OP_NORM2, OP_QKV, OP_HEADNORM, OP_ATTN, OP_MIXOUT, OP_MLP1, OP_MLP2, OP_VGEMM, OP_LNSTATS, OP_SPATIAL, OP_UGEMM, OP_PROLOGUE };

__device__ __forceinline__ void run_phase(const Params& p, int ph, LAS unsigned char* lds) {
    int L = 0, op = OP_PROLOGUE;
    if (ph > 0) {
        int q = ph - 1;
        if (q < 8) { L = 0; } else if (q < 17) { L = 1; q -= 8; } else if (q < 25) { L = 2; q -= 17; } else { L = 3; q -= 25; }
        if ((L & 1) == 0) op = q == 0 ? OP_NORM1 : q == 1 ? OP_QKV : q == 2 ? OP_HEADNORM : q == 3 ? OP_ATTN : q == 4 ? OP_MIXOUT : q == 5 ? OP_NORM2 : q == 6 ? OP_MLP1 : OP_MLP2;
        else op = q == 0 ? OP_NORM1 : q == 1 ? OP_VGEMM : q == 2 ? OP_LNSTATS : q == 3 ? OP_SPATIAL : q == 4 ? OP_UGEMM : q == 5 ? OP_MIXOUT : q == 6 ? OP_NORM2 : q == 7 ? OP_MLP1 : OP_MLP2;
    }
#ifdef ONLY_OP
    op = ONLY_OP;
#endif
    const int mi = L >> 1;
    const bool attnL = (L & 1) == 0;
    const int Mfull = L < 2 ? MTOT : NLAT;
    float* mods = (float*)(p.ws + OFF_MODS); const float* modsl = mods + (size_t)L * 9 * 6144;
    float* ctxr = (float*)(p.ws + OFF_CTXR);
    bf16_t* hb = (bf16_t*)(p.ws + OFF_HB); bf16_t* big = (bf16_t*)(p.ws + OFF_BIG);
    const bool first = (L == 0);
    switch (op) {
    case OP_PROLOGUE: phase_mods(p, lds); __syncthreads(); phase_convert(p, lds); break;
    case OP_NORM1: phase_normmod(first ? p.x : p.out, first ? p.ctx : ctxr, hb, p.norm1_g + L * 1024, modsl, 0, 1024, L <= 2 ? MTOT : NLAT); break;
    case OP_NORM2: phase_normmod(p.out, ctxr, hb, p.norm2_g + L * 1024, modsl, 3072, 4096, Mfull); break;
    case OP_QKV: { EStore f; f.O = big; f.ldo = 3072; run_gemm(lds, hb, (const bf16_t*)(p.ws + OFF_QKVT) + (size_t)mi * 3072 * 1024, MTOT, 3072, 1024, f); } break;
    case OP_HEADNORM: phase_headnorm(big, p.na_q_norm + mi * 64, p.na_k_norm + mi * 64, MTOT); break;
    case OP_ATTN: phase_attn_naive(p, mi, L == 0); break;
    case OP_MIXOUT: case OP_MLP2: {
        EResid f; const bool mo = (op == OP_MIXOUT);
        f.inl = (first && mo) ? p.x : p.out; f.inc = (first && mo) ? p.ctx : ctxr; f.outl = p.out; f.outc = ctxr; f.gate = modsl + (mo ? 2048 : 5120);
        const bf16_t* A; const bf16_t* Bt; int K;
        if (!mo) { A = big; Bt = (const bf16_t*)(p.ws + OFF_W2T) + (size_t)L * 1024 * 4096; K = 4096; }
        else if (attnL) { A = big + (size_t)MTOT * 3072; Bt = (const bf16_t*)(p.ws + OFF_WOT) + (size_t)mi * 1024 * 1024; K = 1024; }
        else { A = big; Bt = (const bf16_t*)(p.ws + OFF_SGOT) + (size_t)mi * 1024 * 3072; K = 3072; }
        run_gemm(lds, A, Bt, Mfull, 1024, K, f); } break;
    case OP_MLP1: { ESqrelu f; f.O = big; f.ldo = 4096; run_gemm(lds, hb, (const bf16_t*)(p.ws + OFF_W1T) + (size_t)L * 4096 * 1024, Mfull, 4096, 1024, f); } break;
    case OP_VGEMM: { EGeluBias f; f.O = big; f.ldo = 3072; f.bias = p.sg_b_in + mi * 6144 + 3072;
        run_gemm(lds, hb, (const bf16_t*)(p.ws + OFF_WINT) + (size_t)mi * 6144 * 1024 + (size_t)3072 * 1024, Mfull, 3072, 1024, f); } break;
    case OP_LNSTATS: phase_lnstats(big, (float*)(p.ws + OFF_STATS), Mfull); break;
    case OP_SPATIAL: phase_spatial_naive(p, mi, Mfull, lds); break;
    case OP_UGEMM: { EGeluGate f; f.O = big; f.ldo = 3072; f.bias = p.sg_b_in + mi * 6144;
        run_gemm(lds, hb, (const bf16_t*)(p.ws + OFF_WINT) + (size_t)mi * 6144 * 1024, Mfull, 3072, 1024, f); } break;
    default: break;
    }
}

#ifndef ONE_LAUNCH
#define ONE_LAUNCH 0
#endif
__global__ void __launch_bounds__(NTHREADS) mk(Params p) {
    extern __shared__ __attribute__((aligned(16))) unsigned char lds_raw[];
    LAS unsigned char* lds = (LAS unsigned char*)lds_raw;
#if ONE_LAUNCH
    cg::grid_group grid = cg::this_grid();
    for (int ph = p.ph_lo; ph < p.ph_hi; ++ph) {
        if (ph > p.ph_lo) grid.sync();
        run_phase(p, ph, lds);
        __syncthreads();
    }
#else
    run_phase(p, p.ph_lo, lds);
#endif
}

#ifndef ONE_LAUNCH
#define ONE_LAUNCH 0
#endif
extern "C" void kernel_launch(void* const* d_in, const int* in_sizes, int n_in, void* d_out, int out_size, void* d_ws, size_t ws_size, hipStream_t stream) {
    static int grid = 0;
    if (grid == 0) {
        if (n_in != 22 || ws_size < WS_END) { fprintf(stderr, "kernel_launch: unexpected n_in %d or ws_size %zu (< %zu)\n", n_in, ws_size, (size_t)WS_END); grid = -1; return; }
        int dev = 0, cus = 0, per_cu = 0;
        hipGetDevice(&dev); hipDeviceGetAttribute(&cus, hipDeviceAttributeMultiprocessorCount, dev);
        if (hipFuncSetAttribute((const void*)mk, hipFuncAttributeMaxDynamicSharedMemorySize, LDS_BYTES) != hipSuccess) { fprintf(stderr, "kernel_launch: hipFuncSetAttribute failed\n"); grid = -1; return; }
        if (hipOccupancyMaxActiveBlocksPerMultiprocessor(&per_cu, (const void*)mk, NTHREADS, LDS_BYTES) != hipSuccess || per_cu < 1) { fprintf(stderr, "kernel_launch: occupancy query says %d\n", per_cu); per_cu = 1; }
        (void)hipGetLastError();
        grid = cus;
    }
    if (grid < 0) return;
    Params p{};
    const float** pp = (const float**)&p;
    for (int i = 0; i < 22; ++i) pp[i] = (const float*)d_in[i];
    p.out = (float*)d_out; p.ws = (unsigned char*)d_ws;
#if ONE_LAUNCH
    p.ph_lo = 0; p.ph_hi = NPH;
    void* args[] = {&p};
    hipError_t e = hipLaunchCooperativeKernel((void*)mk, dim3(grid), dim3(NTHREADS), args, LDS_BYTES, stream);
    if (e != hipSuccess) fprintf(stderr, "cooperative launch failed: %s (grid %d)\n", hipGetErrorString(e), grid);
#else
    for (int ph = 0; ph < NPH; ++ph) { p.ph_lo = ph; p.ph_hi = ph + 1; hipLaunchKernelGGL(mk, dim3(grid), dim3(NTHREADS), LDS_BYTES, stream, p); }
#endif
}
```

```cpp
#include <hip/hip_runtime.h>
#include <hip/hip_cooperative_groups.h>
#include <cstdio>
#include <cstdint>
namespace cg = cooperative_groups;
namespace pg8 {
#define PG8_LAS __attribute__((address_space(3)))
typedef unsigned short bf16_t;
typedef short bf16x8 __attribute__((ext_vector_type(8)));
typedef float f32x4 __attribute__((ext_vector_type(4)));
typedef unsigned u32x4 __attribute__((ext_vector_type(4)));
constexpr int BM = 256, BK = 64, HALF = 128, HTB = HALF * BK * 2  , STAGE_BYTES = 8 * HTB, NXCD = 8, WGM = 8;

__host__ __device__ __forceinline__ int lds_byte(int r, int c) { const int st = (r >> 4) * 2 + (c >> 5), rr = r & 15, cc = c & 31, ob = rr * 64 + cc * 2; return st * 1024 + (ob ^ (((ob >> 9) & 1) << 5)); }
__host__ __device__ __forceinline__ void stage_rc(int b, int& R, int& C) { const int st = b / 1024, sb = b % 1024, swz = sb ^ (((sb >> 9) & 1) << 5); R = (st >> 1) * 16 + swz / 64; C = (st & 1) * 32 + (swz % 64) / 2; }
__host__ __device__ __forceinline__ int perm32(int rho) { const int n = rho >> 4, i = rho & 15; return 8 * (i >> 2) + 4 * n + (i & 3); }

struct Unit { int pm, pn; };
struct Gemm { const bf16_t* A; const bf16_t* Bt; int M, N, K; };

struct StaticOrder {
    int nM, nN, nwg, G, c;
    __host__ __device__ void init(int M, int N, int G_, int c_) { nM = M / BM; nN = N / BM; nwg = nM * nN; G = G_; c = c_; }
    __host__ __device__ bool next(int i, Unit& u) const {
        const long L = (long)i * G + c; if (L >= nwg) return false;
        int wgid = (int)L; { const int q = nwg / NXCD, r = nwg % NXCD, xcd = wgid % NXCD, off = wgid / NXCD; wgid = (xcd < r ? xcd * (q + 1) : r * (q + 1) + (xcd - r) * q) + off; }
        const int nig = WGM * nN, gid = wgid / nig, fm = gid * WGM, gsz = (nM - fm) < WGM ? (nM - fm) : WGM;
        u.pm = fm + ((wgid % nig) % gsz); u.pn = (wgid % nig) / gsz; return true;
    }
    __device__ __forceinline__ void a_ready(const Unit&) const {}
    __device__ __forceinline__ void done(const Unit&) const {}
};

__device__ __forceinline__ unsigned cvt_pk_bf16(float lo, float hi) { unsigned r; asm volatile("v_cvt_pk_bf16_f32 %0, %1, %2" : "=v"(r) : "v"(lo), "v"(hi)); return r; }
template <class Epi, class Sched, bool ALIGN_EPI = false, bool SP2 = false>
__device__ __forceinline__ void gemm_phase(PG8_LAS unsigned char* lds, const Gemm g, const Sched& S, const Epi& E, const int tid_in) {
    const int tid = tid_in, wid = __builtin_amdgcn_readfirstlane(tid >> 6), lane = tid & 63, wr = wid >> 2, wc = wid & 3, fr = lane & 15, fq = lane >> 4;
    const int K = g.K, nt = K / BK;
    unsigned voffA[2], voffB[2];
#pragma unroll
    for (int i = 0; i < 2; ++i) { int R, C; stage_rc(tid * 16 + i * 8192, R, C); const int Rb = Epi::PERM ? ((R & ~31) + perm32(R & 31)) : R;
        voffA[i] = (unsigned)(R * K + C) * 2u; voffB[i] = (unsigned)(Rb * K + C) * 2u; }
    const size_t kstep = (size_t)(BK * 2);
    const size_t hstep = (size_t)HALF * K * 2;
    const size_t tstep = 2 * hstep;
    const unsigned ldsw = (unsigned)wid * 1024u;
    const int aoff = lds_byte(wr * 64 + fr, fq * 8), boff = lds_byte(wc * 32 + fr, fq * 8);
#define PG8_SA(b, h) (((b) * 2 + (h)) * HTB)
#define PG8_SB(b, h) ((4 + (b) * 2 + (h)) * HTB)
#define PG8_STAGE(bufoff, gbase, voff) do { _Pragma("unroll") for (int _i = 0; _i < 2; ++_i) \
        __builtin_amdgcn_global_load_lds((const unsigned*)((const char*)(gbase) + (voff)[_i]), (PG8_LAS unsigned*)(lds + (bufoff) + ldsw + _i * 8192), 16, 0, 0); } while (0)
#define PG8_LDA(dst, b, h) do { _Pragma("unroll") for (int m = 0; m < 4; ++m) _Pragma("unroll") for (int k = 0; k < 2; ++k) dst[m][k] = *(const PG8_LAS bf16x8*)(lds + PG8_SA(b, h) + aoff + m * 2048 + k * 1024); } while (0)
#define PG8_LDB(dst, b, h) do { _Pragma("unroll") for (int n = 0; n < 2; ++n) _Pragma("unroll") for (int k = 0; k < 2; ++k) dst[n][k] = *(const PG8_LAS bf16x8*)(lds + PG8_SB(b, h) + boff + n * 2048 + k * 1024); } while (0)
#define PG8_MMA(ai, bj, At, Bt) do { __builtin_amdgcn_s_setprio(1); _Pragma("unroll") for (int m = 0; m < 4; ++m) _Pragma("unroll") for (int n = 0; n < 2; ++n) _Pragma("unroll") for (int k = 0; k < 2; ++k) \
        acc[ai][bj][m][n] = __builtin_amdgcn_mfma_f32_16x16x32_bf16(Bt[n][k], At[m][k], acc[ai][bj][m][n], 0, 0, 0); __builtin_amdgcn_s_setprio(0); } while (0)
#define PG8_WAIT_V(n) asm volatile("s_waitcnt vmcnt(" #n ")" ::: "memory")
#define PG8_WAIT_L(n) asm volatile("s_waitcnt lgkmcnt(" #n ")" ::: "memory")
#define PG8_BAR __builtin_amdgcn_s_barrier()
#define PG8_SCHED __builtin_amdgcn_sched_barrier(0)
    Unit cur, nxt; int ui = 0;
    if (!S.next(0, cur)) return;
    f32x4 acc[2][2][4][2];
#pragma unroll
    for (int a = 0; a < 2; ++a)
#pragma unroll
        for (int b = 0; b < 2; ++b)
#pragma unroll
            for (int m = 0; m < 4; ++m)
#pragma unroll
                for (int n = 0; n < 2; ++n) acc[a][b][m][n] = (f32x4){0.f, 0.f, 0.f, 0.f};
    bf16x8 At[4][2], B0[2][2], B1[2][2];
    const char* cA = (const char*)g.A + (size_t)cur.pm * tstep; const char* cB = (const char*)g.Bt + (size_t)cur.pn * tstep;
    S.a_ready(cur);
    if constexpr (SP2) {
        PG8_STAGE(PG8_SB(0, 0), cB, voffB); PG8_STAGE(PG8_SB(0, 1), cB + hstep, voffB); PG8_STAGE(PG8_SA(0, 0), cA, voffA); PG8_STAGE(PG8_SA(0, 1), cA + hstep, voffA);
        if (wr == 1) PG8_BAR;
        PG8_WAIT_V(2); PG8_BAR;
        PG8_STAGE(PG8_SB(1, 0), cB + kstep, voffB); PG8_STAGE(PG8_SA(1, 0), cA + kstep, voffA); PG8_STAGE(PG8_SB(1, 1), cB + hstep + kstep, voffB);
        PG8_WAIT_V(6); PG8_BAR;
    } else {
        PG8_STAGE(PG8_SB(0, 0), cB, voffB); PG8_STAGE(PG8_SA(0, 0), cA, voffA); PG8_STAGE(PG8_SB(0, 1), cB + hstep, voffB); PG8_STAGE(PG8_SA(0, 1), cA + hstep, voffA);
        if (wr == 1) PG8_BAR;
        PG8_WAIT_V(4); PG8_BAR;
        PG8_STAGE(PG8_SB(1, 0), cB + kstep, voffB); PG8_STAGE(PG8_SA(1, 0), cA + kstep, voffA); PG8_STAGE(PG8_SB(1, 1), cB + hstep + kstep, voffB);
        PG8_WAIT_V(6); PG8_BAR;
    }
    for (;;) {
        const bool has_next = S.next(ui + 1, nxt);
        const char* nA = has_next ? (const char*)g.A + (size_t)nxt.pm * tstep : cA; const char* nB = has_next ? (const char*)g.Bt + (size_t)nxt.pn * tstep : cB;
        for (int t = 0; t < nt; t += 2) {
            const bool last = (t == nt - 2);
            const char* a1 = cA + (size_t)(t + 1) * kstep;
            const char* a2 = last ? nA : cA + (size_t)(t + 2) * kstep; const char* b2 = last ? nB : cB + (size_t)(t + 2) * kstep;
            const char* a3 = a2 + kstep; const char* b3 = b2 + kstep;
            if (last && has_next) S.a_ready(nxt);
            if constexpr (SP2) {
            PG8_LDB(B0, 0, 0); PG8_LDB(B1, 0, 1); PG8_SCHED; PG8_LDA(At, 0, 0); PG8_STAGE(PG8_SA(1, 1), a1 + hstep, voffA);
            PG8_WAIT_V(8); PG8_WAIT_L(0); PG8_BAR; PG8_MMA(0, 0, At, B0); PG8_MMA(0, 1, At, B1); PG8_BAR; PG8_SCHED;
            PG8_LDA(At, 0, 1); PG8_STAGE(PG8_SB(0, 0), b2, voffB); PG8_STAGE(PG8_SB(0, 1), b2 + hstep, voffB); PG8_STAGE(PG8_SA(0, 0), a2, voffA);
            PG8_WAIT_V(8); PG8_WAIT_L(0); PG8_BAR; PG8_MMA(1, 0, At, B0); PG8_MMA(1, 1, At, B1); PG8_BAR; PG8_SCHED;
            PG8_LDB(B0, 1, 0); PG8_LDB(B1, 1, 1); PG8_SCHED; PG8_LDA(At, 1, 0); PG8_STAGE(PG8_SA(0, 1), a2 + hstep, voffA);
            PG8_WAIT_V(8); PG8_WAIT_L(0); PG8_BAR; PG8_MMA(0, 0, At, B0); PG8_MMA(0, 1, At, B1); PG8_BAR; PG8_SCHED;
            PG8_LDA(At, 1, 1); PG8_STAGE(PG8_SB(1, 0), b3, voffB); PG8_STAGE(PG8_SB(1, 1), b3 + hstep, voffB); PG8_STAGE(PG8_SA(1, 0), a3, voffA);
            PG8_WAIT_V(8); PG8_WAIT_L(0); PG8_BAR; PG8_MMA(1, 0, At, B0); PG8_MMA(1, 1, At, B1); PG8_BAR; PG8_SCHED;
            } else {
            PG8_LDB(B0, 0, 0); PG8_SCHED; PG8_LDA(At, 0, 0); PG8_STAGE(PG8_SA(1, 1), a1 + hstep, voffA);
            PG8_WAIT_L(8); PG8_BAR; PG8_WAIT_L(0); PG8_MMA(0, 0, At, B0); PG8_BAR; PG8_SCHED;
            PG8_LDB(B1, 0, 1); PG8_STAGE(PG8_SB(0, 0), b2, voffB);
            PG8_BAR; PG8_WAIT_L(0); PG8_MMA(0, 1, At, B1); PG8_BAR;
            PG8_LDA(At, 0, 1); PG8_STAGE(PG8_SA(0, 0), a2, voffA);
            PG8_BAR; PG8_WAIT_L(0); PG8_MMA(1, 0, At, B0); PG8_BAR; PG8_SCHED;
            PG8_STAGE(PG8_SB(0, 1), b2 + hstep, voffB);
            PG8_WAIT_V(6); PG8_BAR; PG8_MMA(1, 1, At, B1); PG8_BAR;
            PG8_LDB(B0, 1, 0); PG8_SCHED; PG8_LDA(At, 1, 0); PG8_STAGE(PG8_SA(0, 1), a2 + hstep, voffA);
            PG8_WAIT_L(8); PG8_BAR; PG8_WAIT_L(0); PG8_MMA(0, 0, At, B0); PG8_BAR; PG8_SCHED;
            PG8_LDB(B1, 1, 1); PG8_STAGE(PG8_SB(1, 0), b3, voffB);
            PG8_BAR; PG8_WAIT_L(0); PG8_MMA(0, 1, At, B1); PG8_BAR;
            PG8_LDA(At, 1, 1); PG8_STAGE(PG8_SA(1, 0), a3, voffA);
            PG8_BAR; PG8_WAIT_L(0); PG8_MMA(1, 0, At, B0); PG8_BAR; PG8_SCHED;
            PG8_STAGE(PG8_SB(1, 1), b3 + hstep, voffB);
            PG8_WAIT_V(6); PG8_BAR; PG8_MMA(1, 1, At, B1); PG8_BAR;
            }
        }
        if constexpr (ALIGN_EPI) { if (wr == 0) PG8_BAR; }
        if constexpr (!Epi::AFTER_DRAIN) { E(acc, cur, wr, wc, fr, fq); S.done(cur); }
        if (!has_next) break;
#pragma unroll
        for (int a = 0; a < 2; ++a)
#pragma unroll
            for (int b = 0; b < 2; ++b)
#pragma unroll
                for (int m = 0; m < 4; ++m)
#pragma unroll
                    for (int n = 0; n < 2; ++n) acc[a][b][m][n] = (f32x4){0.f, 0.f, 0.f, 0.f};
        cur = nxt; cA = nA; cB = nB; ++ui;
        if constexpr (ALIGN_EPI) { if (wr == 1) PG8_BAR; }
    }
    PG8_WAIT_V(0);
    if constexpr (!ALIGN_EPI) { if (wr == 0) PG8_BAR; }
    PG8_BAR;
    if constexpr (Epi::AFTER_DRAIN) { E.fused(acc, cur, wr, wc, fr, fq, lds, wid, lane); S.done(cur); }
#undef PG8_SA
#undef PG8_SB
#undef PG8_STAGE
#undef PG8_LDA
#undef PG8_LDB
#undef PG8_MMA
#undef PG8_WAIT_V
#undef PG8_WAIT_L
#undef PG8_BAR
#undef PG8_SCHED
}
}

#define LAS __attribute__((address_space(3)))
using pg8::bf16_t; using pg8::f32x4; using pg8::Unit; using pg8::u32x4;
typedef unsigned u32x2 __attribute__((ext_vector_type(2)));

constexpr int NLAT = 32768, NCTX = 2048, MTOT = 34816;
constexpr int NTHREADS = 512;
constexpr int LDS_BYTES = 131072;
constexpr int NPH = 35;

constexpr size_t OFF_W1T = 0;
constexpr size_t OFF_W2T = OFF_W1T + 4ull * 4096 * 1024 * 2;
constexpr size_t OFF_QKVT = OFF_W2T + 4ull * 4096 * 1024 * 2;
constexpr size_t OFF_WOT = OFF_QKVT + 2ull * 3072 * 1024 * 2;
constexpr size_t OFF_WINT = OFF_WOT + 2ull * 1024 * 1024 * 2;
constexpr size_t OFF_SGOT = OFF_WINT + 2ull * 6144 * 1024 * 2;
constexpr size_t OFF_MODS = OFF_SGOT + 2ull * 1024 * 3072 * 2;
constexpr size_t OFF_CTXR = OFF_MODS + 4ull * 9 * 6144 * 4;
constexpr size_t OFF_HB = OFF_CTXR + 2048ull * 1024 * 4;
constexpr size_t OFF_BIG = OFF_HB + 34816ull * 1024 * 2;
constexpr size_t OFF_STATS = OFF_BIG + 34816ull * 4096 * 2;
constexpr size_t WS_END = OFF_STATS + 34816ull * 2 * 4;

struct Params {
    const float *x, *c, *ctx, *c_ctx, *ada_w, *ada_b, *norm1_g, *norm2_g, *mlp_w1, *mlp_w2, *na_w_qkv, *na_q_norm, *na_k_norm, *na_rpb, *na_w_o,
        *sg_w_in, *sg_b_in, *sg_ln_g, *sg_ln_b, *sg_w_s, *sg_b_s, *sg_w_o;
    float* out; unsigned char* ws; int ph_lo, ph_hi;
};

struct Tix { int tid, bid, gsz; };
__device__ __forceinline__ float bf2f(unsigned h) { return __uint_as_float(h << 16); }
__device__ __forceinline__ unsigned f2bf(float f) { unsigned u = __float_as_uint(f); u += 0x7FFFu + ((u >> 16) & 1u); return u >> 16; }
__device__ __forceinline__ unsigned pk2(float lo, float hi) { return pg8::cvt_pk_bf16(lo, hi); }
__device__ __forceinline__ float wave_sum(float v) {
#pragma unroll
    for (int o = 1; o < 64; o <<= 1) v += __shfl_xor(v, o);
    return v;
}
__device__ __forceinline__ float wave_max(float v) {
#pragma unroll
    for (int o = 1; o < 64; o <<= 1) v = fmaxf(v, __shfl_xor(v, o));
    return v;
}
#define LDS_WAIT() asm volatile("s_waitcnt lgkmcnt(0)" ::: "memory")
__device__ __forceinline__ float silu_f(float v) { return v / (1.f + expf(-v)); }
__device__ __forceinline__ float gelu_f(float v) { return 0.5f * v * (1.f + erff(v * 0.70710678118654752f)); }

__device__ __forceinline__ int sigma_inv(int L) { return 128 * ((L >> 5) & 1) + 32 * (L >> 6) + 16 * ((L >> 2) & 1) + 4 * ((L >> 3) & 3) + (L & 3); }

__device__ __forceinline__ void phase_mods(const Params& p, LAS unsigned char* lds, const Tix T_) {
    LAS float* sc = (LAS float*)lds;
    LAS float* red = (LAS float*)(lds + 36864);
    float* mods = (float*)(p.ws + OFF_MODS);
    const int tid = T_.tid;
    for (int i = tid; i < 9 * 1024; i += NTHREADS) { const int b = i >> 10, k = i & 1023; const float v = b < 8 ? p.c[b * 1024 + k] : p.c_ctx[k]; sc[i] = silu_f(v); }
    __syncthreads();
    const int c4 = (tid & 15) * 4, kk = tid >> 4;
    for (int item = T_.bid; item < 384; item += T_.gsz) {
        const int l = item / 96, n0 = (item % 96) * 64;
        const float* W = p.ada_w + (size_t)l * 1024 * 6144 + n0 + c4;
        f32x4 acc[9];
#pragma unroll
        for (int b = 0; b < 9; ++b) acc[b] = (f32x4){0.f, 0.f, 0.f, 0.f};
#pragma unroll 4
        for (int i = 0; i < 32; ++i) { const int k = kk + 32 * i; const f32x4 w = *(const f32x4*)(W + (size_t)k * 6144);
#pragma unroll
            for (int b = 0; b < 9; ++b) acc[b] += sc[b * 1024 + k] * w; }
#pragma unroll
        for (int b = 0; b < 9; ++b) *(LAS f32x4*)(red + (kk * 9 + b) * 64 + c4) = acc[b];
        __syncthreads();
        for (int o = tid; o < 576; o += NTHREADS) { const int b = o >> 6, cc = o & 63; float s = 0.f;
            for (int j = 0; j < 32; ++j) s += red[(j * 9 + b) * 64 + cc];
            mods[(size_t)(l * 9 + b) * 6144 + n0 + cc] = s + p.ada_b[l * 6144 + n0 + cc]; }
        __syncthreads();
    }
}

struct MatDesc { const float* src; bf16_t* dst; int K, N; };
__device__ __forceinline__ MatDesc get_mat(const Params& p, int mi) {
    MatDesc m;
    if (mi < 4) { m.src = p.mlp_w1 + (size_t)mi * 1024 * 4096; m.dst = (bf16_t*)(p.ws + OFF_W1T) + (size_t)mi * 4096 * 1024; m.K = 1024; m.N = 4096; }
    else if (mi < 8) { const int l = mi - 4; m.src = p.mlp_w2 + (size_t)l * 4096 * 1024; m.dst = (bf16_t*)(p.ws + OFF_W2T) + (size_t)l * 1024 * 4096; m.K = 4096; m.N = 1024; }
    else if (mi < 10) { const int a = mi - 8; m.src = p.na_w_qkv + (size_t)a * 1024 * 3072; m.dst = (bf16_t*)(p.ws + OFF_QKVT) + (size_t)a * 3072 * 1024; m.K = 1024; m.N = 3072; }
    else if (mi < 12) { const int a = mi - 10; m.src = p.na_w_o + (size_t)a * 1024 * 1024; m.dst = (bf16_t*)(p.ws + OFF_WOT) + (size_t)a * 1024 * 1024; m.K = 1024; m.N = 1024; }
    else if (mi < 14) { const int s = mi - 12; m.src = p.sg_w_in + (size_t)s * 1024 * 6144; m.dst = (bf16_t*)(p.ws + OFF_WINT) + (size_t)s * 6144 * 1024; m.K = 1024; m.N = 6144; }
    else { const int s = mi - 14; m.src = p.sg_w_o + (size_t)s * 3072 * 1024; m.dst = (bf16_t*)(p.ws + OFF_SGOT) + (size_t)s * 1024 * 3072; m.K = 3072; m.N = 1024; }
    return m;
}
__device__ __forceinline__ void transpose_item(const float* W, int K, int N, bf16_t* WT, LAS float* scr, int item, int lane) {
    const int nblk = N / 32, kb = item / nblk, nb = item % nblk, k0 = 64 * kb, n0 = 32 * nb;
#pragma unroll 8
    for (int i = 0; i < 32; ++i) { const int kk = 2 * i + (lane >> 5); scr[kk * 33 + (lane & 31)] = W[(size_t)(k0 + kk) * N + n0 + (lane & 31)]; }
    LDS_WAIT();
    const int c = lane & 7;
#pragma unroll
    for (int j = 0; j < 4; ++j) { const int n = (lane >> 3) + 8 * j; const LAS float* s = scr + (8 * c) * 33 + n;
        u32x4 o; o.x = pk2(s[0 * 33], s[1 * 33]); o.y = pk2(s[2 * 33], s[3 * 33]); o.z = pk2(s[4 * 33], s[5 * 33]); o.w = pk2(s[6 * 33], s[7 * 33]);
        const int nl = n0 + n, drow = (nl & ~255) + sigma_inv(nl & 255);
        *(u32x4*)(WT + (size_t)drow * K + k0 + 8 * c) = o; }
    LDS_WAIT();
}
__device__ __forceinline__ void phase_convert(const Params& p, LAS unsigned char* lds, const Tix T_) {
    const int lane = T_.tid & 63, wave = T_.tid >> 6, gw = T_.bid * 8 + wave, NGW = T_.gsz * 8;
    LAS float* scr = (LAS float*)(lds + wave * 8704);
    for (int mi = 0; mi < 16; ++mi) {
        const MatDesc m = get_mat(p, mi);
        const int nitems = (m.K / 64) * (m.N / 32);
        for (int it = gw; it < nitems; it += NGW) transpose_item(m.src, m.K, m.N, m.dst, scr, it, lane);
    }
}

__device__ __forceinline__ void phase_normmod(const float* xl, const float* xc, bf16_t* hb, const float* g, const float* modsl, int sh_off, int sc_off, int M, const Tix T_) {
    const int lane = T_.tid & 63, gw = T_.bid * 8 + (T_.tid >> 6), NGW = T_.gsz * 8;
    for (int row = gw; row < M; row += NGW) {
        const float* xr = row < NLAT ? xl + (size_t)row * 1024 : xc + (size_t)(row - NLAT) * 1024;
        const int b = row < NLAT ? (row >> 12) : 8;
        f32x4 v[4]; float s = 0.f;
#pragma unroll
        for (int j = 0; j < 4; ++j) { v[j] = *(const f32x4*)(xr + 4 * lane + 256 * j); s += (v[j].x * v[j].x + v[j].y * v[j].y) + (v[j].z * v[j].z + v[j].w * v[j].w); }
        s = wave_sum(s);
        const float rstd = 1.0f / sqrtf(s * (1.0f / 1024.0f) + 1e-6f);
#pragma unroll
        for (int j = 0; j < 4; ++j) { const int col = 4 * lane + 256 * j;
            const f32x4 gv = *(const f32x4*)(g + col), scv = *(const f32x4*)(modsl + (size_t)b * 6144 + sc_off + col), shv = *(const f32x4*)(modsl + (size_t)b * 6144 + sh_off + col);
            const f32x4 o = v[j] * rstd * gv * (1.0f + scv) + shv;
            u32x2 w; w.x = pk2(o.x, o.y); w.y = pk2(o.z, o.w);
            *(u32x2*)(hb + (size_t)row * 1024 + col) = w; }
    }
}
__device__ __forceinline__ void phase_headnorm(bf16_t* qkv, const float* qg, const float* kg, int M, const Tix T_) {
    const int lane = T_.tid & 63, gw = T_.bid * 8 + (T_.tid >> 6), NGW = T_.gsz * 8;
    const bool isq = lane < 32; const int d0 = (lane & 1) * 32;
    const float* gn = isq ? qg : kg; const float mul = isq ? 0.125f : 1.0f;
    for (int row = gw; row < M; row += NGW) {
        bf16_t* ptr = qkv + (size_t)row * 3072 + lane * 32;
        u32x4 raw[4]; float v[32]; float s = 0.f;
#pragma unroll
        for (int j = 0; j < 4; ++j) raw[j] = *(const u32x4*)(ptr + 8 * j);
#pragma unroll
        for (int j = 0; j < 4; ++j) {
#pragma unroll
            for (int e = 0; e < 4; ++e) { const unsigned w = raw[j][e]; v[8 * j + 2 * e] = bf2f(w & 0xffffu); v[8 * j + 2 * e + 1] = bf2f(w >> 16); } }
#pragma unroll
        for (int i = 0; i < 32; ++i) s += v[i] * v[i];
        s += __shfl_xor(s, 1);
        const float rstd = mul / sqrtf(s * (1.0f / 64.0f) + 1e-6f);
#pragma unroll
        for (int j = 0; j < 4; ++j) { u32x4 o;
#pragma unroll
            for (int e = 0; e < 4; ++e) { const int i = 8 * j + 2 * e; o[e] = pk2(v[i] * rstd * gn[d0 + i], v[i + 1] * rstd * gn[d0 + i + 1]); }
            *(u32x4*)(ptr + 8 * j) = o; }
    }
}
__device__ __forceinline__ float dot64(const float (&q)[64], const bf16_t* kp) {
    float s = 0.f;
#pragma unroll
    for (int j = 0; j < 8; ++j) { const u32x4 w = *(const u32x4*)(kp + 8 * j);
#pragma unroll
        for (int e = 0; e < 4; ++e) { s += q[8 * j + 2 * e] * bf2f(w[e] & 0xffffu); s += q[8 * j + 2 * e + 1] * bf2f(w[e] >> 16); } }
    return s;
}
__device__ __forceinline__ void phase_attn_naive(const Params& p, int a, bool ctx_q, const Tix T_) {
    const bf16_t* qkv = (const bf16_t*)(p.ws + OFF_BIG); bf16_t* ao = (bf16_t*)(p.ws + OFF_BIG) + (size_t)MTOT * 3072;
    const float* rpb = p.na_rpb + (size_t)a * 16 * 15 * 31;
    const int lane = T_.tid & 63, gw = T_.bid * 8 + (T_.tid >> 6), NGW = T_.gsz * 8;
    const int nq = ctx_q ? MTOT : NLAT;
    for (int item = gw; item < nq * 16; item += NGW) {
        const int row = item >> 4, h = item & 15;
        const bool lat = row < NLAT;
        int b, r = 0, qc = 0, rs = 0, wst = 0;
        if (lat) { b = row >> 12; const int t = row & 4095; r = t >> 6; qc = t & 63; rs = min(max(r - 4, 0), 56); wst = min(max(qc - 8, 0), 48); } else b = (row - NLAT) >> 8;
        float q[64];
        { const bf16_t* qp = qkv + (size_t)row * 3072 + h * 64;
#pragma unroll
          for (int j = 0; j < 8; ++j) { const u32x4 w = *(const u32x4*)(qp + 8 * j);
#pragma unroll
              for (int e = 0; e < 4; ++e) { q[8 * j + 2 * e] = bf2f(w[e] & 0xffffu); q[8 * j + 2 * e + 1] = bf2f(w[e] >> 16); } } }
        float sc[6];
#pragma unroll
        for (int i = 0; i < 2; ++i) {
            if (lat) { const int kk = lane + 64 * i, kr = rs + (kk >> 4), kc = wst + (kk & 15);
                sc[i] = dot64(q, qkv + (size_t)(b * 4096 + kr * 64 + kc) * 3072 + 1024 + h * 64) + rpb[(h * 15 + (kr - r + 7)) * 31 + (kc - qc + 15)]; }
            else sc[i] = -1e30f; }
#pragma unroll
        for (int i = 0; i < 4; ++i) { const int j = lane + 64 * i; sc[2 + i] = dot64(q, qkv + (size_t)(NLAT + b * 256 + j) * 3072 + 1024 + h * 64); }
        float mx = sc[0];
#pragma unroll
        for (int i = 1; i < 6; ++i) mx = fmaxf(mx, sc[i]);
        mx = wave_max(mx);
        float sum = 0.f;
#pragma unroll
        for (int i = 0; i < 6; ++i) { sc[i] = expf(sc[i] - mx); sum += sc[i]; }
        sum = wave_sum(sum);
        float o = 0.f;
        if (lat) {
#pragma unroll
            for (int i = 0; i < 2; ++i)
                for (int l = 0; l < 64; ++l) { const float pk = __shfl(sc[i], l); const int kk = l + 64 * i, kr = rs + (kk >> 4), kc = wst + (kk & 15);
                    o += pk * bf2f(qkv[(size_t)(b * 4096 + kr * 64 + kc) * 3072 + 2048 + h * 64 + lane]); } }
#pragma unroll
        for (int i = 0; i < 4; ++i)
            for (int l = 0; l < 64; ++l) { const float pk = __shfl(sc[2 + i], l); const int j = l + 64 * i;
                o += pk * bf2f(qkv[(size_t)(NLAT + b * 256 + j) * 3072 + 2048 + h * 64 + lane]); }
        ao[(size_t)row * 1024 + h * 64 + lane] = (bf16_t)f2bf(o / sum);
    }
}
__device__ __forceinline__ void phase_lnstats(const bf16_t* vb, float* stats, int M, const Tix T_) {
    const int lane = T_.tid & 63, gw = T_.bid * 8 + (T_.tid >> 6), NGW = T_.gsz * 8;
    for (int row = gw; row < M; row += NGW) {
        const bf16_t* vp = vb + (size_t)row * 3072 + lane * 8;
        float v[48]; float s = 0.f;
#pragma unroll
        for (int j = 0; j < 6; ++j) { const u32x4 w = *(const u32x4*)(vp + 512 * j);
#pragma unroll
            for (int e = 0; e < 4; ++e) { v[8 * j + 2 * e] = bf2f(w[e] & 0xffffu); v[8 * j + 2 * e + 1] = bf2f(w[e] >> 16); } }
#pragma unroll
        for (int i = 0; i < 48; ++i) s += v[i];
        const float mean = wave_sum(s) * (1.0f / 3072.0f);
        float q = 0.f;
#pragma unroll
        for (int i = 0; i < 48; ++i) { const float d = v[i] - mean; q += d * d; }
        q = wave_sum(q) * (1.0f / 3072.0f);
        if (lane == 0) { stats[2 * row] = mean; stats[2 * row + 1] = 1.0f / sqrtf(q + 1e-6f); }
    }
}
__device__ __forceinline__ void phase_spatial_naive(const Params& p, int sl, int M, LAS unsigned char* lds, const Tix T_) {
    bf16_t* vb = (bf16_t*)(p.ws + OFF_BIG); const float* stats = (const float*)(p.ws + OFF_STATS);
    LAS float* V = (LAS float*)lds;
    LAS float* Wl = (LAS float*)(lds + 65536);
    const float* lng = p.sg_ln_g + sl * 3072; const float* lnb = p.sg_ln_b + sl * 3072;
    const int tid = T_.tid;
    const int nunits = (M / 128) * 24;
    for (int u = T_.bid; u < nunits; u += T_.gsz) {
        const int nc = u / 24, g = u % 24, r0 = nc * 128;
        const float* Wg = p.sg_w_s + ((size_t)sl * 24 + g) * 16384;
        for (int i = 0; i < 32; ++i) { const int idx = tid + 512 * i, q = idx >> 7, c = idx & 127;
            const float val = bf2f(vb[(size_t)(r0 + q) * 3072 + g * 128 + c]);
            V[idx] = (val - stats[2 * (r0 + q)]) * stats[2 * (r0 + q) + 1] * lng[g * 128 + c] + lnb[g * 128 + c];
            Wl[idx] = Wg[idx]; }
        __syncthreads();
        const int c = tid & 127, pg = tid >> 7;
        float acc[32];
#pragma unroll
        for (int i = 0; i < 32; ++i) acc[i] = 0.f;
        for (int q = 0; q < 128; ++q) { const float vv = V[q * 128 + c];
#pragma unroll
            for (int i = 0; i < 32; ++i) acc[i] += Wl[(pg * 32 + i) * 128 + q] * vv; }
        __syncthreads();
#pragma unroll
        for (int i = 0; i < 32; ++i) { const int pp = pg * 32 + i; vb[(size_t)(r0 + pp) * 3072 + g * 128 + c] = (bf16_t)f2bf(acc[i] + p.sg_b_s[((size_t)sl * 24 + g) * 128 + pp]); }
    }
}

template <class F> struct EpiG {
    static constexpr bool PERM = false, AFTER_DRAIN = false;
    F f;
    __device__ __forceinline__ void operator()(const f32x4 (&acc)[2][2][4][2], const Unit& u, int wr, int wc, int fr, int fq) const {
#pragma unroll
        for (int ai = 0; ai < 2; ++ai)
#pragma unroll
            for (int m = 0; m < 4; ++m) { const int row = u.pm * 256 + ai * 128 + wr * 64 + m * 16 + fr;
#pragma unroll
                for (int bj = 0; bj < 2; ++bj) { const int col = u.pn * 256 + 64 * wc + 32 * bj + 8 * fq; f(row, col, acc[ai][bj][m][0], acc[ai][bj][m][1]); }
                asm volatile("" ::: "memory"); }
    }
};
__device__ __forceinline__ void store8_bf16(bf16_t* o, const f32x4 a, const f32x4 b) { u32x4 w; w.x = pk2(a.x, a.y); w.y = pk2(a.z, a.w); w.z = pk2(b.x, b.y); w.w = pk2(b.z, b.w); *(u32x4*)o = w; }
struct EStore { bf16_t* O; int ldo;
    __device__ __forceinline__ void operator()(int row, int col, f32x4 a, f32x4 b) const { store8_bf16(O + (size_t)row * ldo + col, a, b); } };
struct ESqrelu { bf16_t* O; int ldo;
    __device__ __forceinline__ void operator()(int row, int col, f32x4 a, f32x4 b) const {
#pragma unroll
        for (int i = 0; i < 4; ++i) { const float x = fmaxf(a[i], 0.f), y = fmaxf(b[i], 0.f); a[i] = x * x; b[i] = y * y; }
        store8_bf16(O + (size_t)row * ldo + col, a, b); } };
struct EGeluBias { bf16_t* O; int ldo; const float* bias;
    __device__ __forceinline__ void operator()(int row, int col, f32x4 a, f32x4 b) const {
        const f32x4 b0 = *(const f32x4*)(bias + col), b1 = *(const f32x4*)(bias + col + 4);
#pragma unroll
        for (int i = 0; i < 4; ++i) { a[i] = gelu_f(a[i] + b0[i]); b[i] = gelu_f(b[i] + b1[i]); }
        store8_bf16(O + (size_t)row * ldo + col, a, b); } };
struct EGeluGate { bf16_t* O; int ldo; const float* bias;
    __device__ __forceinline__ void operator()(int row, int col, f32x4 a, f32x4 b) const {
        const f32x4 b0 = *(const f32x4*)(bias + col), b1 = *(const f32x4*)(bias + col + 4);
        bf16_t* op = O + (size_t)row * ldo + col; const u32x4 sv = *(const u32x4*)op;
#pragma unroll
        for (int i = 0; i < 4; ++i) { a[i] = gelu_f(a[i] + b0[i]); b[i] = gelu_f(b[i] + b1[i]); }
        a.x *= bf2f(sv.x & 0xffffu); a.y *= bf2f(sv.x >> 16); a.z *= bf2f(sv.y & 0xffffu); a.w *= bf2f(sv.y >> 16);
        b.x *= bf2f(sv.z & 0xffffu); b.y *= bf2f(sv.z >> 16); b.z *= bf2f(sv.w & 0xffffu); b.w *= bf2f(sv.w >> 16);
        store8_bf16(op, a, b); } };
struct EResid { const float* inl; const float* inc; float* outl; float* outc; const float* gate;
    __device__ __forceinline__ void operator()(int row, int col, f32x4 a, f32x4 b) const {
        const bool lat = row < NLAT; const int bb = lat ? (row >> 12) : 8;
        const float* ip = lat ? inl + (size_t)row * 1024 + col : inc + (size_t)(row - NLAT) * 1024 + col;
        float* op = lat ? outl + (size_t)row * 1024 + col : outc + (size_t)(row - NLAT) * 1024 + col;
        const f32x4 g0 = *(const f32x4*)(gate + (size_t)bb * 6144 + col), g1 = *(const f32x4*)(gate + (size_t)bb * 6144 + col + 4);
        const f32x4 x0 = *(const f32x4*)ip, x1 = *(const f32x4*)(ip + 4);
        *(f32x4*)op = x0 + g0 * a; *(f32x4*)(op + 4) = x1 + g1 * b; } };

template <class F> __device__ __forceinline__ void run_gemm(LAS unsigned char* lds, const bf16_t* A, const bf16_t* Bt, int M, int N, int K, const F& f, const Tix T_) {
    pg8::StaticOrder S; S.init(M, N, T_.gsz, T_.bid);
    pg8::Gemm g; g.A = A; g.Bt = Bt; g.M = M; g.N = N; g.K = K;
    EpiG<F> E; E.f = f;
    pg8::gemm_phase<EpiG<F>, pg8::StaticOrder, true, true>(lds, g, S, E, T_.tid);
}

enum { OP_NORM1, OP_NORM2, OP_QKV, OP_HEADNORM, OP_ATTN, OP_MIXOUT, OP_MLP1, OP_MLP2, OP_VGEMM, OP_LNSTATS, OP_SPATIAL, OP_UGEMM, OP_PROLOGUE };

__device__ __forceinline__ void run_phase(const Params& p, int ph, LAS unsigned char* lds, const Tix T_) {
    int L = 0, op = OP_PROLOGUE;
    if (ph > 0) {
        int q = ph - 1;
        if (q < 8) { L = 0; } else if (q < 17) { L = 1; q -= 8; } else if (q < 25) { L = 2; q -= 17; } else { L = 3; q -= 25; }
        if ((L & 1) == 0) op = q == 0 ? OP_NORM1 : q == 1 ? OP_QKV : q == 2 ? OP_HEADNORM : q == 3 ? OP_ATTN : q == 4 ? OP_MIXOUT : q == 5 ? OP_NORM2 : q == 6 ? OP_MLP1 : OP_MLP2;
        else op = q == 0 ? OP_NORM1 : q == 1 ? OP_VGEMM : q == 2 ? OP_LNSTATS : q == 3 ? OP_SPATIAL : q == 4 ? OP_UGEMM : q == 5 ? OP_MIXOUT : q == 6 ? OP_NORM2 : q == 7 ? OP_MLP1 : OP_MLP2;
    }
#ifdef ONLY_OP
    op = ONLY_OP;
#endif
    const int mi = L >> 1;
    const bool attnL = (L & 1) == 0;
    const int Mfull = L < 2 ? MTOT : NLAT;
    float* mods = (float*)(p.ws + OFF_MODS); const float* modsl = mods + (size_t)L * 9 * 6144;
    float* ctxr = (float*)(p.ws + OFF_CTXR);
    bf16_t* hb = (bf16_t*)(p.ws + OFF_HB); bf16_t* big = (bf16_t*)(p.ws + OFF_BIG);
    const bool first = (L == 0);
    switch (op) {
    case OP_PROLOGUE: phase_mods(p, lds, T_); __syncthreads(); phase_convert(p, lds, T_); break;
    case OP_NORM1: phase_normmod(first ? p.x : p.out, first ? p.ctx : ctxr, hb, p.norm1_g + L * 1024, modsl, 0, 1024, L <= 2 ? MTOT : NLAT, T_); break;
    case OP_NORM2: phase_normmod(p.out, ctxr, hb, p.norm2_g + L * 1024, modsl, 3072, 4096, Mfull, T_); break;
    case OP_QKV: { EStore f; f.O = big; f.ldo = 3072; run_gemm(lds, hb, (const bf16_t*)(p.ws + OFF_QKVT) + (size_t)mi * 3072 * 1024, MTOT, 3072, 1024, f, T_); } break;
    case OP_HEADNORM: phase_headnorm(big, p.na_q_norm + mi * 64, p.na_k_norm + mi * 64, MTOT, T_); break;
    case OP_ATTN: phase_attn_naive(p, mi, L == 0, T_); break;
    case OP_MIXOUT: case OP_MLP2: {
        EResid f; const bool mo = (op == OP_MIXOUT);
        f.inl = (first && mo) ? p.x : p.out; f.inc = (first && mo) ? p.ctx : ctxr; f.outl = p.out; f.outc = ctxr; f.gate = modsl + (mo ? 2048 : 5120);
        const bf16_t* A; const bf16_t* Bt; int K;
        if (!mo) { A = big; Bt = (const bf16_t*)(p.ws + OFF_W2T) + (size_t)L * 1024 * 4096; K = 4096; }
        else if (attnL) { A = big + (size_t)MTOT * 3072; Bt = (const bf16_t*)(p.ws + OFF_WOT) + (size_t)mi * 1024 * 1024; K = 1024; }
        else { A = big; Bt = (const bf16_t*)(p.ws + OFF_SGOT) + (size_t)mi * 1024 * 3072; K = 3072; }
        run_gemm(lds, A, Bt, Mfull, 1024, K, f, T_); } break;
    case OP_MLP1: { ESqrelu f; f.O = big; f.ldo = 4096; run_gemm(lds, hb, (const bf16_t*)(p.ws + OFF_W1T) + (size_t)L * 4096 * 1024, Mfull, 4096, 1024, f, T_); } break;
    case OP_VGEMM: { EGeluBias f; f.O = big; f.ldo = 3072; f.bias = p.sg_b_in + mi * 6144 + 3072;
        run_gemm(lds, hb, (const bf16_t*)(p.ws + OFF_WINT) + (size_t)mi * 6144 * 1024 + (size_t)3072 * 1024, Mfull, 3072, 1024, f, T_); } break;
    case OP_LNSTATS: phase_lnstats(big, (float*)(p.ws + OFF_STATS), Mfull, T_); break;
    case OP_SPATIAL: phase_spatial_naive(p, mi, Mfull, lds, T_); break;
    case OP_UGEMM: { EGeluGate f; f.O = big; f.ldo = 3072; f.bias = p.sg_b_in + mi * 6144;
        run_gemm(lds, hb, (const bf16_t*)(p.ws + OFF_WINT) + (size_t)mi * 6144 * 1024, Mfull, 3072, 1024, f, T_); } break;
    default: break;
    }
}

#ifndef ONE_LAUNCH
#define ONE_LAUNCH 1
#endif
__global__ void __launch_bounds__(NTHREADS) mk(Params p0) {
    extern __shared__ __attribute__((aligned(16))) unsigned char lds_raw[];
    LAS unsigned char* lds = (LAS unsigned char*)lds_raw;
#if ONE_LAUNCH
    cg::grid_group grid = cg::this_grid();
    for (int ph = p0.ph_lo; ph < p0.ph_hi; ++ph) {
        if (ph > p0.ph_lo) grid.sync();
        Tix T_; T_.tid = threadIdx.x; T_.bid = blockIdx.x; T_.gsz = gridDim.x;
        size_t z = 0;
        asm volatile("" : "+v"(T_.tid)); asm volatile("" : "+s"(T_.bid), "+s"(T_.gsz), "+s"(z));
        Params p = p0;
        { const float** pp = (const float**)&p;
#pragma unroll
          for (int i = 0; i < 22; ++i) pp[i] += z; }
        p.out += z; p.ws += z;
        run_phase(p, ph, lds, T_);
        __syncthreads();
    }
#else
    Tix T_; T_.tid = threadIdx.x; T_.bid = blockIdx.x; T_.gsz = gridDim.x;
    run_phase(p0, p0.ph_lo, lds, T_);
#endif
}

extern "C" void kernel_launch(void* const* d_in, const int* in_sizes, int n_in, void* d_out, int out_size, void* d_ws, size_t ws_size, hipStream_t stream) {
    static int grid = 0;
    if (grid == 0) {
        if (n_in != 22 || ws_size < WS_END) { fprintf(stderr, "kernel_launch: unexpected n_in %d or ws_size %zu (< %zu)\n", n_in, ws_size, (size_t)WS_END); grid = -1; return; }
        int dev = 0, cus = 0, per_cu = 0;
        hipGetDevice(&dev); hipDeviceGetAttribute(&cus, hipDeviceAttributeMultiprocessorCount, dev);
        if (hipFuncSetAttribute((const void*)mk, hipFuncAttributeMaxDynamicSharedMemorySize, LDS_BYTES) != hipSuccess) { fprintf(stderr, "kernel_launch: hipFuncSetAttribute failed\n"); grid = -1; return; }
        if (hipOccupancyMaxActiveBlocksPerMultiprocessor(&per_cu, (const void*)mk, NTHREADS, LDS_BYTES) != hipSuccess || per_cu < 1) { fprintf(stderr, "kernel_launch: occupancy query says %d\n", per_cu); per_cu = 1; }
        (void)hipGetLastError();
        grid = cus;
    }
    if (grid < 0) return;
    Params p{};
    const float** pp = (const float**)&p;
    for (int i = 0; i < 22; ++i) pp[i] = (const float*)d_in[i];
    p.out = (float*)d_out; p.ws = (unsigned char*)d_ws;
#if ONE_LAUNCH
    p.ph_lo = 0; p.ph_hi = NPH;
    void* args[] = {&p};
    hipError_t e = hipLaunchCooperativeKernel((void*)mk, dim3(grid), dim3(NTHREADS), args, LDS_BYTES, stream);
    if (e != hipSuccess) fprintf(stderr, "cooperative launch failed: %s (grid %d)\n", hipGetErrorString(e), grid);
#else
    for (int ph = 0; ph < NPH; ++ph) { p.ph_lo = ph; p.ph_hi = ph + 1; hipLaunchKernelGGL(mk, dim3(grid), dim3(NTHREADS), LDS_BYTES, stream, p); }
#endif
}
```

```cpp
#include <hip/hip_runtime.h>
#include <hip/hip_cooperative_groups.h>
#include <cstdio>
#include <cstdint>
namespace cg = cooperative_groups;
namespace pg8 {
#define PG8_LAS __attribute__((address_space(3)))
typedef unsigned short bf16_t;
typedef short bf16x8 __attribute__((ext_vector_type(8)));
typedef float f32x4 __attribute__((ext_vector_type(4)));
typedef unsigned u32x4 __attribute__((ext_vector_type(4)));
constexpr int BM = 256, BK = 64, HALF = 128, HTB = HALF * BK * 2  , STAGE_BYTES = 8 * HTB, NXCD = 8, WGM = 8;

__host__ __device__ __forceinline__ int lds_byte(int r, int c) { const int st = (r >> 4) * 2 + (c >> 5), rr = r & 15, cc = c & 31, ob = rr * 64 + cc * 2; return st * 1024 + (ob ^ (((ob >> 9) & 1) << 5)); }
__host__ __device__ __forceinline__ void stage_rc(int b, int& R, int& C) { const int st = b / 1024, sb = b % 1024, swz = sb ^ (((sb >> 9) & 1) << 5); R = (st >> 1) * 16 + swz / 64; C = (st & 1) * 32 + (swz % 64) / 2; }
__host__ __device__ __forceinline__ int perm32(int rho) { const int n = rho >> 4, i = rho & 15; return 8 * (i >> 2) + 4 * n + (i & 3); }

struct Unit { int pm, pn; };
struct Gemm { const bf16_t* A; const bf16_t* Bt; int M, N, K; };

struct StaticOrder {
    int nM, nN, nwg, G, c;
    __host__ __device__ void init(int M, int N, int G_, int c_) { nM = M / BM; nN = N / BM; nwg = nM * nN; G = G_; c = c_; }
    __host__ __device__ bool next(int i, Unit& u) const {
        const long L = (long)i * G + c; if (L >= nwg) return false;
        int wgid = (int)L; { const int q = nwg / NXCD, r = nwg % NXCD, xcd = wgid % NXCD, off = wgid / NXCD; wgid = (xcd < r ? xcd * (q + 1) : r * (q + 1) + (xcd - r) * q) + off; }
        const int nig = WGM * nN, gid = wgid / nig, fm = gid * WGM, gsz = (nM - fm) < WGM ? (nM - fm) : WGM;
        u.pm = fm + ((wgid % nig) % gsz); u.pn = (wgid % nig) / gsz; return true;
    }
    __device__ __forceinline__ void a_ready(const Unit&) const {}
    __device__ __forceinline__ void done(const Unit&) const {}
};

__device__ __forceinline__ unsigned cvt_pk_bf16(float lo, float hi) { unsigned r; asm volatile("v_cvt_pk_bf16_f32 %0, %1, %2" : "=v"(r) : "v"(lo), "v"(hi)); return r; }
template <class Epi, class Sched, bool ALIGN_EPI = false, bool SP2 = false>
__device__ __forceinline__ void gemm_phase(PG8_LAS unsigned char* lds, const Gemm g, const Sched& S, const Epi& E, const int tid_in) {
    const int tid = tid_in, wid = __builtin_amdgcn_readfirstlane(tid >> 6), lane = tid & 63, wr = wid >> 2, wc = wid & 3, fr = lane & 15, fq = lane >> 4;
    const int K = g.K, nt = K / BK;
    unsigned voffA[2], voffB[2];
#pragma unroll
    for (int i = 0; i < 2; ++i) { int R, C; stage_rc(tid * 16 + i * 8192, R, C); const int Rb = Epi::PERM ? ((R & ~31) + perm32(R & 31)) : R;
        voffA[i] = (unsigned)(R * K + C) * 2u; voffB[i] = (unsigned)(Rb * K + C) * 2u; }
    const size_t kstep = (size_t)(BK * 2);
    const size_t hstep = (size_t)HALF * K * 2;
    const size_t tstep = 2 * hstep;
    const unsigned ldsw = (unsigned)wid * 1024u;
    const int aoff = lds_byte(wr * 64 + fr, fq * 8), boff = lds_byte(wc * 32 + fr, fq * 8);
#define PG8_SA(b, h) (((b) * 2 + (h)) * HTB)
#define PG8_SB(b, h) ((4 + (b) * 2 + (h)) * HTB)
#define PG8_STAGE(bufoff, gbase, voff) do { _Pragma("unroll") for (int _i = 0; _i < 2; ++_i) \
        __builtin_amdgcn_global_load_lds((const unsigned*)((const char*)(gbase) + (voff)[_i]), (PG8_LAS unsigned*)(lds + (bufoff) + ldsw + _i * 8192), 16, 0, 0); } while (0)
#define PG8_LDA(dst, b, h) do { _Pragma("unroll") for (int m = 0; m < 4; ++m) _Pragma("unroll") for (int k = 0; k < 2; ++k) dst[m][k] = *(const PG8_LAS bf16x8*)(lds + PG8_SA(b, h) + aoff + m * 2048 + k * 1024); } while (0)
#define PG8_LDB(dst, b, h) do { _Pragma("unroll") for (int n = 0; n < 2; ++n) _Pragma("unroll") for (int k = 0; k < 2; ++k) dst[n][k] = *(const PG8_LAS bf16x8*)(lds + PG8_SB(b, h) + boff + n * 2048 + k * 1024); } while (0)
#define PG8_MMA(ai, bj, At, Bt) do { __builtin_amdgcn_s_setprio(1); _Pragma("unroll") for (int m = 0; m < 4; ++m) _Pragma("unroll") for (int n = 0; n < 2; ++n) _Pragma("unroll") for (int k = 0; k < 2; ++k) \
        acc[ai][bj][m][n] = __builtin_amdgcn_mfma_f32_16x16x32_bf16(Bt[n][k], At[m][k], acc[ai][bj][m][n], 0, 0, 0); __builtin_amdgcn_s_setprio(0); } while (0)
#define PG8_WAIT_V(n) asm volatile("s_waitcnt vmcnt(" #n ")" ::: "memory")
#define PG8_WAIT_L(n) asm volatile("s_waitcnt lgkmcnt(" #n ")" ::: "memory")
#define PG8_BAR __builtin_amdgcn_s_barrier()
#define PG8_SCHED __builtin_amdgcn_sched_barrier(0)
    Unit cur, nxt; int ui = 0;
    if (!S.next(0, cur)) return;
    f32x4 acc[2][2][4][2];
#pragma unroll
    for (int a = 0; a < 2; ++a)
#pragma unroll
        for (int b = 0; b < 2; ++b)
#pragma unroll
            for (int m = 0; m < 4; ++m)
#pragma unroll
                for (int n = 0; n < 2; ++n) acc[a][b][m][n] = (f32x4){0.f, 0.f, 0.f, 0.f};
    bf16x8 At[4][2], B0[2][2], B1[2][2];
    const char* cA = (const char*)g.A + (size_t)cur.pm * tstep; const char* cB = (const char*)g.Bt + (size_t)cur.pn * tstep;
    S.a_ready(cur);
    if constexpr (SP2) {
        PG8_STAGE(PG8_SB(0, 0), cB, voffB); PG8_STAGE(PG8_SB(0, 1), cB + hstep, voffB); PG8_STAGE(PG8_SA(0, 0), cA, voffA); PG8_STAGE(PG8_SA(0, 1), cA + hstep, voffA);
        if (wr == 1) PG8_BAR;
        PG8_WAIT_V(2); PG8_BAR;
        PG8_STAGE(PG8_SB(1, 0), cB + kstep, voffB); PG8_STAGE(PG8_SA(1, 0), cA + kstep, voffA); PG8_STAGE(PG8_SB(1, 1), cB + hstep + kstep, voffB);
        PG8_WAIT_V(6); PG8_BAR;
    } else {
        PG8_STAGE(PG8_SB(0, 0), cB, voffB); PG8_STAGE(PG8_SA(0, 0), cA, voffA); PG8_STAGE(PG8_SB(0, 1), cB + hstep, voffB); PG8_STAGE(PG8_SA(0, 1), cA + hstep, voffA);
        if (wr == 1) PG8_BAR;
        PG8_WAIT_V(4); PG8_BAR;
        PG8_STAGE(PG8_SB(1, 0), cB + kstep, voffB); PG8_STAGE(PG8_SA(1, 0), cA + kstep, voffA); PG8_STAGE(PG8_SB(1, 1), cB + hstep + kstep, voffB);
        PG8_WAIT_V(6); PG8_BAR;
    }
    for (;;) {
        const bool has_next = S.next(ui + 1, nxt);
        const char* nA = has_next ? (const char*)g.A + (size_t)nxt.pm * tstep : cA; const char* nB = has_next ? (const char*)g.Bt + (size_t)nxt.pn * tstep : cB;
        for (int t = 0; t < nt; t += 2) {
            const bool last = (t == nt - 2);
            const char* a1 = cA + (size_t)(t + 1) * kstep;
            const char* a2 = last ? nA : cA + (size_t)(t + 2) * kstep; const char* b2 = last ? nB : cB + (size_t)(t + 2) * kstep;
            const char* a3 = a2 + kstep; const char* b3 = b2 + kstep;
            if (last && has_next) S.a_ready(nxt);
            if constexpr (SP2) {
            PG8_LDB(B0, 0, 0); PG8_LDB(B1, 0, 1); PG8_SCHED; PG8_LDA(At, 0, 0); PG8_STAGE(PG8_SA(1, 1), a1 + hstep, voffA);
            PG8_WAIT_V(8); PG8_WAIT_L(0); PG8_BAR; PG8_MMA(0, 0, At, B0); PG8_MMA(0, 1, At, B1); PG8_BAR; PG8_SCHED;
            PG8_LDA(At, 0, 1); PG8_STAGE(PG8_SB(0, 0), b2, voffB); PG8_STAGE(PG8_SB(0, 1), b2 + hstep, voffB); PG8_STAGE(PG8_SA(0, 0), a2, voffA);
            PG8_WAIT_V(8); PG8_WAIT_L(0); PG8_BAR; PG8_MMA(1, 0, At, B0); PG8_MMA(1, 1, At, B1); PG8_BAR; PG8_SCHED;
            PG8_LDB(B0, 1, 0); PG8_LDB(B1, 1, 1); PG8_SCHED; PG8_LDA(At, 1, 0); PG8_STAGE(PG8_SA(0, 1), a2 + hstep, voffA);
            PG8_WAIT_V(8); PG8_WAIT_L(0); PG8_BAR; PG8_MMA(0, 0, At, B0); PG8_MMA(0, 1, At, B1); PG8_BAR; PG8_SCHED;
            PG8_LDA(At, 1, 1); PG8_STAGE(PG8_SB(1, 0), b3, voffB); PG8_STAGE(PG8_SB(1, 1), b3 + hstep, voffB); PG8_STAGE(PG8_SA(1, 0), a3, voffA);
            PG8_WAIT_V(8); PG8_WAIT_L(0); PG8_BAR; PG8_MMA(1, 0, At, B0); PG8_MMA(1, 1, At, B1); PG8_BAR; PG8_SCHED;
            } else {
            PG8_LDB(B0, 0, 0); PG8_SCHED; PG8_LDA(At, 0, 0); PG8_STAGE(PG8_SA(1, 1), a1 + hstep, voffA);
            PG8_WAIT_L(8); PG8_BAR; PG8_WAIT_L(0); PG8_MMA(0, 0, At, B0); PG8_BAR; PG8_SCHED;
            PG8_LDB(B1, 0, 1); PG8_STAGE(PG8_SB(0, 0), b2, voffB);
            PG8_BAR; PG8_WAIT_L(0); PG8_MMA(0, 1, At, B1); PG8_BAR;
            PG8_LDA(At, 0, 1); PG8_STAGE(PG8_SA(0, 0), a2, voffA);
            PG8_BAR; PG8_WAIT_L(0); PG8_MMA(1, 0, At, B0); PG8_BAR; PG8_SCHED;
            PG8_STAGE(PG8_SB(0, 1), b2 + hstep, voffB);
            PG8_WAIT_V(6); PG8_BAR; PG8_MMA(1, 1, At, B1); PG8_BAR;
            PG8_LDB(B0, 1, 0); PG8_SCHED; PG8_LDA(At, 1, 0); PG8_STAGE(PG8_SA(0, 1), a2 + hstep, voffA);
            PG8_WAIT_L(8); PG8_BAR; PG8_WAIT_L(0); PG8_MMA(0, 0, At, B0); PG8_BAR; PG8_SCHED;
            PG8_LDB(B1, 1, 1); PG8_STAGE(PG8_SB(1, 0), b3, voffB);
            PG8_BAR; PG8_WAIT_L(0); PG8_MMA(0, 1, At, B1); PG8_BAR;
            PG8_LDA(At, 1, 1); PG8_STAGE(PG8_SA(1, 0), a3, voffA);
            PG8_BAR; PG8_WAIT_L(0); PG8_MMA(1, 0, At, B0); PG8_BAR; PG8_SCHED;
            PG8_STAGE(PG8_SB(1, 1), b3 + hstep, voffB);
            PG8_WAIT_V(6); PG8_BAR; PG8_MMA(1, 1, At, B1); PG8_BAR;
            }
        }
        if constexpr (ALIGN_EPI) { if (wr == 0) PG8_BAR; }
        if constexpr (!Epi::AFTER_DRAIN) { E(acc, cur, wr, wc, fr, fq); S.done(cur); }
        if (!has_next) break;
#pragma unroll
        for (int a = 0; a < 2; ++a)
#pragma unroll
            for (int b = 0; b < 2; ++b)
#pragma unroll
                for (int m = 0; m < 4; ++m)
#pragma unroll
                    for (int n = 0; n < 2; ++n) acc[a][b][m][n] = (f32x4){0.f, 0.f, 0.f, 0.f};
        cur = nxt; cA = nA; cB = nB; ++ui;
        if constexpr (ALIGN_EPI) { if (wr == 1) PG8_BAR; }
    }
    PG8_WAIT_V(0);
    if constexpr (!ALIGN_EPI) { if (wr == 0) PG8_BAR; }
    PG8_BAR;
    if constexpr (Epi::AFTER_DRAIN) { E.fused(acc, cur, wr, wc, fr, fq, lds, wid, lane); S.done(cur); }
#undef PG8_SA
#undef PG8_SB
#undef PG8_STAGE
#undef PG8_LDA
#undef PG8_LDB
#undef PG8_MMA
#undef PG8_WAIT_V
#undef PG8_WAIT_L
#undef PG8_BAR
#undef PG8_SCHED
}
}

#ifndef NAIVE_ATTN
#define NAIVE_ATTN 0
#endif
#ifndef NAIVE_SPATIAL
#define NAIVE_SPATIAL 0
#endif
#define LAS __attribute__((address_space(3)))
using pg8::bf16_t; using pg8::f32x4; using pg8::Unit; using pg8::u32x4;
typedef unsigned u32x2 __attribute__((ext_vector_type(2)));

constexpr int NLAT = 32768, NCTX = 2048, MTOT = 34816;
constexpr int NTHREADS = 512;
constexpr int LDS_BYTES = 131072;
constexpr int NPH = 35;

constexpr size_t OFF_W1T = 0;
constexpr size_t OFF_W2T = OFF_W1T + 4ull * 4096 * 1024 * 2;
constexpr size_t OFF_QKVT = OFF_W2T + 4ull * 4096 * 1024 * 2;
constexpr size_t OFF_WOT = OFF_QKVT + 2ull * 3072 * 1024 * 2;
constexpr size_t OFF_WINT = OFF_WOT + 2ull * 1024 * 1024 * 2;
constexpr size_t OFF_SGOT = OFF_WINT + 2ull * 6144 * 1024 * 2;
constexpr size_t OFF_MODS = OFF_SGOT + 2ull * 1024 * 3072 * 2;
constexpr size_t OFF_CTXR = OFF_MODS + 4ull * 9 * 6144 * 4;
constexpr size_t OFF_HB = OFF_CTXR + 2048ull * 1024 * 4;
constexpr size_t OFF_BIG = OFF_HB + 34816ull * 1024 * 2;
constexpr size_t OFF_STATS = OFF_BIG + 34816ull * 4096 * 2;
constexpr size_t WS_END = OFF_STATS + 34816ull * 2 * 4;

struct Params {
    const float *x, *c, *ctx, *c_ctx, *ada_w, *ada_b, *norm1_g, *norm2_g, *mlp_w1, *mlp_w2, *na_w_qkv, *na_q_norm, *na_k_norm, *na_rpb, *na_w_o,
        *sg_w_in, *sg_b_in, *sg_ln_g, *sg_ln_b, *sg_w_s, *sg_b_s, *sg_w_o;
    float* out; unsigned char* ws; int ph_lo, ph_hi;
};

struct Tix { int tid, bid, gsz; };
__device__ __forceinline__ float bf2f(unsigned h) { return __uint_as_float(h << 16); }
__device__ __forceinline__ unsigned f2bf(float f) { unsigned u = __float_as_uint(f); u += 0x7FFFu + ((u >> 16) & 1u); return u >> 16; }
__device__ __forceinline__ unsigned pk2(float lo, float hi) { return pg8::cvt_pk_bf16(lo, hi); }
__device__ __forceinline__ float wave_sum(float v) {
#pragma unroll
    for (int o = 1; o < 64; o <<= 1) v += __shfl_xor(v, o);
    return v;
}
__device__ __forceinline__ float wave_max(float v) {
#pragma unroll
    for (int o = 1; o < 64; o <<= 1) v = fmaxf(v, __shfl_xor(v, o));
    return v;
}
#define LDS_WAIT() asm volatile("s_waitcnt lgkmcnt(0)" ::: "memory")
__device__ __forceinline__ float silu_f(float v) { return v / (1.f + expf(-v)); }
__device__ __forceinline__ float gelu_f(float v) { return 0.5f * v * (1.f + erff(v * 0.70710678118654752f)); }

__device__ __forceinline__ int sigma_inv(int L) { return 128 * ((L >> 5) & 1) + 32 * (L >> 6) + 16 * ((L >> 2) & 1) + 4 * ((L >> 3) & 3) + (L & 3); }

__device__ __forceinline__ void phase_mods(const Params& p, LAS unsigned char* lds, const Tix T_) {
    LAS float* sc = (LAS float*)lds;
    LAS float* red = (LAS float*)(lds + 36864);
    float* mods = (float*)(p.ws + OFF_MODS);
    const int tid = T_.tid;
    for (int i = tid; i < 9 * 1024; i += NTHREADS) { const int b = i >> 10, k = i & 1023; const float v = b < 8 ? p.c[b * 1024 + k] : p.c_ctx[k]; sc[i] = silu_f(v); }
    __syncthreads();
    const int c4 = (tid & 15) * 4, kk = tid >> 4;
    for (int item = T_.bid; item < 384; item += T_.gsz) {
        const int l = item / 96, n0 = (item % 96) * 64;
        const float* W = p.ada_w + (size_t)l * 1024 * 6144 + n0 + c4;
        f32x4 acc[9];
#pragma unroll
        for (int b = 0; b < 9; ++b) acc[b] = (f32x4){0.f, 0.f, 0.f, 0.f};
#pragma unroll 4
        for (int i = 0; i < 32; ++i) { const int k = kk + 32 * i; const f32x4 w = *(const f32x4*)(W + (size_t)k * 6144);
#pragma unroll
            for (int b = 0; b < 9; ++b) acc[b] += sc[b * 1024 + k] * w; }
#pragma unroll
        for (int b = 0; b < 9; ++b) *(LAS f32x4*)(red + (kk * 9 + b) * 64 + c4) = acc[b];
        __syncthreads();
        for (int o = tid; o < 576; o += NTHREADS) { const int b = o >> 6, cc = o & 63; float s = 0.f;
            for (int j = 0; j < 32; ++j) s += red[(j * 9 + b) * 64 + cc];
            mods[(size_t)(l * 9 + b) * 6144 + n0 + cc] = s + p.ada_b[l * 6144 + n0 + cc]; }
        __syncthreads();
    }
}

struct MatDesc { const float* src; bf16_t* dst; int K, N; };
__device__ __forceinline__ MatDesc get_mat(const Params& p, int mi) {
    MatDesc m;
    if (mi < 4) { m.src = p.mlp_w1 + (size_t)mi * 1024 * 4096; m.dst = (bf16_t*)(p.ws + OFF_W1T) + (size_t)mi * 4096 * 1024; m.K = 1024; m.N = 4096; }
    else if (mi < 8) { const int l = mi - 4; m.src = p.mlp_w2 + (size_t)l * 4096 * 1024; m.dst = (bf16_t*)(p.ws + OFF_W2T) + (size_t)l * 1024 * 4096; m.K = 4096; m.N = 1024; }
    else if (mi < 10) { const int a = mi - 8; m.src = p.na_w_qkv + (size_t)a * 1024 * 3072; m.dst = (bf16_t*)(p.ws + OFF_QKVT) + (size_t)a * 3072 * 1024; m.K = 1024; m.N = 3072; }
    else if (mi < 12) { const int a = mi - 10; m.src = p.na_w_o + (size_t)a * 1024 * 1024; m.dst = (bf16_t*)(p.ws + OFF_WOT) + (size_t)a * 1024 * 1024; m.K = 1024; m.N = 1024; }
    else if (mi < 14) { const int s = mi - 12; m.src = p.sg_w_in + (size_t)s * 1024 * 6144; m.dst = (bf16_t*)(p.ws + OFF_WINT) + (size_t)s * 6144 * 1024; m.K = 1024; m.N = 6144; }
    else { const int s = mi - 14; m.src = p.sg_w_o + (size_t)s * 3072 * 1024; m.dst = (bf16_t*)(p.ws + OFF_SGOT) + (size_t)s * 1024 * 3072; m.K = 3072; m.N = 1024; }
    return m;
}
__device__ __forceinline__ void transpose_item(const float* W, int K, int N, bf16_t* WT, LAS float* scr, int item, int lane) {
    const int nblk = N / 32, kb = item / nblk, nb = item % nblk, k0 = 64 * kb, n0 = 32 * nb;
#pragma unroll 8
    for (int i = 0; i < 32; ++i) { const int kk = 2 * i + (lane >> 5); scr[kk * 33 + (lane & 31)] = W[(size_t)(k0 + kk) * N + n0 + (lane & 31)]; }
    LDS_WAIT();
    const int c = lane & 7;
#pragma unroll
    for (int j = 0; j < 4; ++j) { const int n = (lane >> 3) + 8 * j; const LAS float* s = scr + (8 * c) * 33 + n;
        u32x4 o; o.x = pk2(s[0 * 33], s[1 * 33]); o.y = pk2(s[2 * 33], s[3 * 33]); o.z = pk2(s[4 * 33], s[5 * 33]); o.w = pk2(s[6 * 33], s[7 * 33]);
        const int nl = n0 + n, drow = (nl & ~255) + sigma_inv(nl & 255);
        *(u32x4*)(WT + (size_t)drow * K + k0 + 8 * c) = o; }
    LDS_WAIT();
}
__device__ __forceinline__ void phase_convert(const Params& p, LAS unsigned char* lds, const Tix T_) {
    const int lane = T_.tid & 63, wave = T_.tid >> 6, gw = T_.bid * 8 + wave, NGW = T_.gsz * 8;
    LAS float* scr = (LAS float*)(lds + wave * 8704);
    for (int mi = 0; mi < 16; ++mi) {
        const MatDesc m = get_mat(p, mi);
        const int nitems = (m.K / 64) * (m.N / 32);
        for (int it = gw; it < nitems; it += NGW) transpose_item(m.src, m.K, m.N, m.dst, scr, it, lane);
    }
}

__device__ __forceinline__ void phase_normmod(const float* xl, const float* xc, bf16_t* hb, const float* g, const float* modsl, int sh_off, int sc_off, int M, const Tix T_) {
    const int lane = T_.tid & 63, gw = T_.bid * 8 + (T_.tid >> 6), NGW = T_.gsz * 8;
    for (int row = gw; row < M; row += NGW) {
        const float* xr = row < NLAT ? xl + (size_t)row * 1024 : xc + (size_t)(row - NLAT) * 1024;
        const int b = row < NLAT ? (row >> 12) : 8;
        f32x4 v[4]; float s = 0.f;
#pragma unroll
        for (int j = 0; j < 4; ++j) { v[j] = *(const f32x4*)(xr + 4 * lane + 256 * j); s += (v[j].x * v[j].x + v[j].y * v[j].y) + (v[j].z * v[j].z + v[j].w * v[j].w); }
        s = wave_sum(s);
        const float rstd = 1.0f / sqrtf(s * (1.0f / 1024.0f) + 1e-6f);
#pragma unroll
        for (int j = 0; j < 4; ++j) { const int col = 4 * lane + 256 * j;
            const f32x4 gv = *(const f32x4*)(g + col), scv = *(const f32x4*)(modsl + (size_t)b * 6144 + sc_off + col), shv = *(const f32x4*)(modsl + (size_t)b * 6144 + sh_off + col);
            const f32x4 o = v[j] * rstd * gv * (1.0f + scv) + shv;
            u32x2 w; w.x = pk2(o.x, o.y); w.y = pk2(o.z, o.w);
            *(u32x2*)(hb + (size_t)row * 1024 + col) = w; }
    }
}
__device__ __forceinline__ void phase_headnorm(bf16_t* qkv, const float* qg, const float* kg, int M, const Tix T_) {
    const int lane = T_.tid & 63, gw = T_.bid * 8 + (T_.tid >> 6), NGW = T_.gsz * 8;
    const bool isq = lane < 32; const int d0 = (lane & 1) * 32;
    const float* gn = isq ? qg : kg; const float mul = isq ? 0.125f : 1.0f;
    for (int row = gw; row < M; row += NGW) {
        bf16_t* ptr = qkv + (size_t)row * 3072 + lane * 32;
        u32x4 raw[4]; float v[32]; float s = 0.f;
#pragma unroll
        for (int j = 0; j < 4; ++j) raw[j] = *(const u32x4*)(ptr + 8 * j);
#pragma unroll
        for (int j = 0; j < 4; ++j) {
#pragma unroll
            for (int e = 0; e < 4; ++e) { const unsigned w = raw[j][e]; v[8 * j + 2 * e] = bf2f(w & 0xffffu); v[8 * j + 2 * e + 1] = bf2f(w >> 16); } }
#pragma unroll
        for (int i = 0; i < 32; ++i) s += v[i] * v[i];
        s += __shfl_xor(s, 1);
        const float rstd = mul / sqrtf(s * (1.0f / 64.0f) + 1e-6f);
#pragma unroll
        for (int j = 0; j < 4; ++j) { u32x4 o;
#pragma unroll
            for (int e = 0; e < 4; ++e) { const int i = 8 * j + 2 * e; o[e] = pk2(v[i] * rstd * gn[d0 + i], v[i + 1] * rstd * gn[d0 + i + 1]); }
            *(u32x4*)(ptr + 8 * j) = o; }
    }
}
__device__ __forceinline__ float dot64(const float (&q)[64], const bf16_t* kp) {
    float s = 0.f;
#pragma unroll
    for (int j = 0; j < 8; ++j) { const u32x4 w = *(const u32x4*)(kp + 8 * j);
#pragma unroll
        for (int e = 0; e < 4; ++e) { s += q[8 * j + 2 * e] * bf2f(w[e] & 0xffffu); s += q[8 * j + 2 * e + 1] * bf2f(w[e] >> 16); } }
    return s;
}
__device__ __forceinline__ void phase_attn_naive(const Params& p, int a, bool ctx_q, const Tix T_) {
    const bf16_t* qkv = (const bf16_t*)(p.ws + OFF_BIG); bf16_t* ao = (bf16_t*)(p.ws + OFF_BIG) + (size_t)MTOT * 3072;
    const float* rpb = p.na_rpb + (size_t)a * 16 * 15 * 31;
    const int lane = T_.tid & 63, gw = T_.bid * 8 + (T_.tid >> 6), NGW = T_.gsz * 8;
    const int nq = ctx_q ? MTOT : NLAT;
    for (int item = gw; item < nq * 16; item += NGW) {
        const int row = item >> 4, h = item & 15;
        const bool lat = row < NLAT;
        int b, r = 0, qc = 0, rs = 0, wst = 0;
        if (lat) { b = row >> 12; const int t = row & 4095; r = t >> 6; qc = t & 63; rs = min(max(r - 4, 0), 56); wst = min(max(qc - 8, 0), 48); } else b = (row - NLAT) >> 8;
        float q[64];
        { const bf16_t* qp = qkv + (size_t)row * 3072 + h * 64;
#pragma unroll
          for (int j = 0; j < 8; ++j) { const u32x4 w = *(const u32x4*)(qp + 8 * j);
#pragma unroll
              for (int e = 0; e < 4; ++e) { q[8 * j + 2 * e] = bf2f(w[e] & 0xffffu); q[8 * j + 2 * e + 1] = bf2f(w[e] >> 16); } } }
        float sc[6];
#pragma unroll
        for (int i = 0; i < 2; ++i) {
            if (lat) { const int kk = lane + 64 * i, kr = rs + (kk >> 4), kc = wst + (kk & 15);
                sc[i] = dot64(q, qkv + (size_t)(b * 4096 + kr * 64 + kc) * 3072 + 1024 + h * 64) + rpb[(h * 15 + (kr - r + 7)) * 31 + (kc - qc + 15)]; }
            else sc[i] = -1e30f; }
#pragma unroll
        for (int i = 0; i < 4; ++i) { const int j = lane + 64 * i; sc[2 + i] = dot64(q, qkv + (size_t)(NLAT + b * 256 + j) * 3072 + 1024 + h * 64); }
        float mx = sc[0];
#pragma unroll
        for (int i = 1; i < 6; ++i) mx = fmaxf(mx, sc[i]);
        mx = wave_max(mx);
        float sum = 0.f;
#pragma unroll
        for (int i = 0; i < 6; ++i) { sc[i] = expf(sc[i] - mx); sum += sc[i]; }
        sum = wave_sum(sum);
        float o = 0.f;
        if (lat) {
#pragma unroll
            for (int i = 0; i < 2; ++i)
                for (int l = 0; l < 64; ++l) { const float pk = __shfl(sc[i], l); const int kk = l + 64 * i, kr = rs + (kk >> 4), kc = wst + (kk & 15);
                    o += pk * bf2f(qkv[(size_t)(b * 4096 + kr * 64 + kc) * 3072 + 2048 + h * 64 + lane]); } }
#pragma unroll
        for (int i = 0; i < 4; ++i)
            for (int l = 0; l < 64; ++l) { const float pk = __shfl(sc[2 + i], l); const int j = l + 64 * i;
                o += pk * bf2f(qkv[(size_t)(NLAT + b * 256 + j) * 3072 + 2048 + h * 64 + lane]); }
        ao[(size_t)row * 1024 + h * 64 + lane] = (bf16_t)f2bf(o / sum);
    }
}
__device__ __forceinline__ void phase_lnstats(const bf16_t* vb, float* stats, int M, const Tix T_) {
    const int lane = T_.tid & 63, gw = T_.bid * 8 + (T_.tid >> 6), NGW = T_.gsz * 8;
    for (int row = gw; row < M; row += NGW) {
        const bf16_t* vp = vb + (size_t)row * 3072 + lane * 8;
        float v[48]; float s = 0.f;
#pragma unroll
        for (int j = 0; j < 6; ++j) { const u32x4 w = *(const u32x4*)(vp + 512 * j);
#pragma unroll
            for (int e = 0; e < 4; ++e) { v[8 * j + 2 * e] = bf2f(w[e] & 0xffffu); v[8 * j + 2 * e + 1] = bf2f(w[e] >> 16); } }
#pragma unroll
        for (int i = 0; i < 48; ++i) s += v[i];
        const float mean = wave_sum(s) * (1.0f / 3072.0f);
        float q = 0.f;
#pragma unroll
        for (int i = 0; i < 48; ++i) { const float d = v[i] - mean; q += d * d; }
        q = wave_sum(q) * (1.0f / 3072.0f);
        if (lane == 0) { stats[2 * row] = mean; stats[2 * row + 1] = 1.0f / sqrtf(q + 1e-6f); }
    }
}
__device__ __forceinline__ void phase_spatial_naive(const Params& p, int sl, int M, LAS unsigned char* lds, const Tix T_) {
    bf16_t* vb = (bf16_t*)(p.ws + OFF_BIG); const float* stats = (const float*)(p.ws + OFF_STATS);
    LAS float* V = (LAS float*)lds;
    LAS float* Wl = (LAS float*)(lds + 65536);
    const float* lng = p.sg_ln_g + sl * 3072; const float* lnb = p.sg_ln_b + sl * 3072;
    const int tid = T_.tid;
    const int nunits = (M / 128) * 24;
    for (int u = T_.bid; u < nunits; u += T_.gsz) {
        const int nc = u / 24, g = u % 24, r0 = nc * 128;
        const float* Wg = p.sg_w_s + ((size_t)sl * 24 + g) * 16384;
        for (int i = 0; i < 32; ++i) { const int idx = tid + 512 * i, q = idx >> 7, c = idx & 127;
            const float val = bf2f(vb[(size_t)(r0 + q) * 3072 + g * 128 + c]);
            V[idx] = (val - stats[2 * (r0 + q)]) * stats[2 * (r0 + q) + 1] * lng[g * 128 + c] + lnb[g * 128 + c];
            Wl[idx] = Wg[idx]; }
        __syncthreads();
        const int c = tid & 127, pg = tid >> 7;
        float acc[32];
#pragma unroll
        for (int i = 0; i < 32; ++i) acc[i] = 0.f;
        for (int q = 0; q < 128; ++q) { const float vv = V[q * 128 + c];
#pragma unroll
            for (int i = 0; i < 32; ++i) acc[i] += Wl[(pg * 32 + i) * 128 + q] * vv; }
        __syncthreads();
#pragma unroll
        for (int i = 0; i < 32; ++i) { const int pp = pg * 32 + i; vb[(size_t)(r0 + pp) * 3072 + g * 128 + c] = (bf16_t)f2bf(acc[i] + p.sg_b_s[((size_t)sl * 24 + g) * 128 + pp]); }
    }
}


typedef short s16x4 __attribute__((ext_vector_type(4)));
typedef short s16x8 __attribute__((ext_vector_type(8)));
typedef float f32x16 __attribute__((ext_vector_type(16)));
typedef float f32x2 __attribute__((ext_vector_type(2)));
typedef __bf16 bf16x2_t __attribute__((ext_vector_type(2)));
__device__ __forceinline__ unsigned pkb(float a, float b) { const f32x2 v = {a, b}; const bf16x2_t r = __builtin_convertvector(v, bf16x2_t); return __builtin_bit_cast(unsigned, r); }
__device__ __forceinline__ s16x8 pack8(float a0, float a1, float a2, float a3, float a4, float a5, float a6, float a7) {
    u32x4 w; w.x = pkb(a0, a1); w.y = pkb(a2, a3); w.z = pkb(a4, a5); w.w = pkb(a6, a7); return __builtin_bit_cast(s16x8, w); }
__device__ __forceinline__ s16x8 tr_pair(const LAS unsigned char* a0, int second_off) {
    const s16x4 a = __builtin_amdgcn_ds_read_tr16_b64_v4i16((LAS s16x4*)a0);
    const s16x4 b = __builtin_amdgcn_ds_read_tr16_b64_v4i16((LAS s16x4*)(a0 + second_off));
    s16x8 r; r[0] = a[0]; r[1] = a[1]; r[2] = a[2]; r[3] = a[3]; r[4] = b[0]; r[5] = b[1]; r[6] = b[2]; r[7] = b[3]; return r; }
#define MFMA32(a, b, c) __builtin_amdgcn_mfma_f32_32x32x16_bf16((a), (b), (c), 0, 0, 0)

constexpr int AV_STR = 144;
__device__ __forceinline__ void phase_attn_mfma(const Params& p, int a, bool ctx_q, LAS unsigned char* lds, const Tix T_) {
    const bf16_t* qkv = (const bf16_t*)(p.ws + OFF_BIG); bf16_t* ao = (bf16_t*)(p.ws + OFF_BIG) + (size_t)MTOT * 3072;
    const float* rpb = p.na_rpb + (size_t)a * 16 * 15 * 31;
    const int tid = T_.tid, lane = tid & 63, wave = __builtin_amdgcn_readfirstlane(tid >> 6), qt = wave & 1, kq = wave >> 1, l31 = lane & 31, hi = lane >> 5;
    LAS unsigned char* Vl = lds;
    LAS float* Ored = (LAS float*)lds;
    LAS float* lred = (LAS float*)(lds + 69632);
    LAS float* tab = (LAS float*)(lds + 110592);
    LAS float* misc = (LAS float*)(lds + 110592 + 2048);
    float mb;
    { float m = 0.f; for (int i = tid; i < 7440; i += NTHREADS) m = fmaxf(m, rpb[i]);
      float qg = 0.f, kg = 0.f; if (tid < 64) { qg = fabsf(p.na_q_norm[a * 64 + tid]); kg = fabsf(p.na_k_norm[a * 64 + tid]); }
      m = wave_max(m); qg = wave_max(qg); kg = wave_max(kg);
      if (lane == 0) { misc[wave] = m; if (wave == 0) { misc[8] = qg; misc[9] = kg; } }
      __syncthreads();
      float rm = misc[0];
#pragma unroll
      for (int w = 1; w < 8; ++w) rm = fmaxf(rm, misc[w]);
      mb = 8.0f * misc[8] * misc[9] + rm; }
    const int nlatu = 8 * 64 * 16, nctxu = ctx_q ? 8 * 4 * 16 : 0;
    const int tr_q = (lane & 15) >> 2, tr_p = lane & 3, dgrp = (lane >> 4) & 1;
    for (int u = T_.bid; u < nlatu + nctxu; u += T_.gsz) {
        int b, h, qrow0, r = 0, rs = 0, ntl, ntiles;
        if (u < nlatu) { h = u & 15; const int br = u >> 4; r = br & 63; b = br >> 6; qrow0 = b * 4096 + r * 64; rs = min(max(r - 4, 0), 56); ntl = 16; ntiles = 24; }
        else { const int v = u - nlatu; h = v & 15; const int bq = v >> 4; b = bq >> 2; qrow0 = NLAT + b * 256 + (bq & 3) * 64; ntl = 0; ntiles = 8; }
        for (int idx = tid; idx < ntiles * 256; idx += NTHREADS) { const int key = idx >> 3, ch = idx & 7, kt = key >> 5, kk = key & 31;
            const size_t grow = kt < ntl ? (size_t)(b * 4096 + (rs + (kt >> 1)) * 64 + 32 * (kt & 1) + kk) : (size_t)(NLAT + b * 256 + 32 * (kt - ntl) + kk);
            const u32x4 w = *(const u32x4*)(qkv + grow * 3072 + 2048 + h * 64 + ch * 8);
            *(LAS u32x4*)(Vl + key * AV_STR + ch * 16) = w; }
        if (tid < 465) tab[tid] = rpb[h * 465 + tid];
        s16x8 Qf[4];
        { const bf16_t* qp = qkv + (size_t)(qrow0 + 32 * qt + l31) * 3072 + h * 64 + 8 * hi;
#pragma unroll
          for (int ks = 0; ks < 4; ++ks) Qf[ks] = *(const s16x8*)(qp + 16 * ks); }
        __syncthreads();
        f32x16 O0, O1;
#pragma unroll
        for (int i = 0; i < 16; ++i) { O0[i] = 0.f; O1[i] = 0.f; }
        float lsum = 0.f;
        const int qcol = 32 * qt + l31, wst = min(max(qcol - 8, 0), 48);
        const int t0 = kq * (ntiles >> 2), t1 = t0 + (ntiles >> 2);
        for (int kt = t0; kt < t1; ++kt) {
            const bool islat = kt < ntl;
            const size_t grow = islat ? (size_t)(b * 4096 + (rs + (kt >> 1)) * 64 + 32 * (kt & 1) + l31) : (size_t)(NLAT + b * 256 + 32 * (kt - ntl) + l31);
            const bf16_t* kp = qkv + grow * 3072 + 1024 + h * 64 + 8 * hi;
            s16x8 Kf[4];
#pragma unroll
            for (int ks = 0; ks < 4; ++ks) Kf[ks] = *(const s16x8*)(kp + 16 * ks);
            f32x16 S;
#pragma unroll
            for (int i = 0; i < 16; ++i) S[i] = 0.f;
#pragma unroll
            for (int ks = 0; ks < 4; ++ks) S = MFMA32(Kf[ks], Qf[ks], S);
            float pv[16];
            if (islat) {
                const int kr = rs + (kt >> 1), rb = (kr - r + 7) * 31, cbase = 32 * (kt & 1) + 4 * hi;
#pragma unroll
                for (int j = 0; j < 4; ++j)
#pragma unroll
                    for (int i = 0; i < 4; ++i) { const int kcol = cbase + 8 * j + i; const bool valid = (unsigned)(kcol - wst) < 16u;
                        const int delta = min(max(kcol - qcol + 15, 0), 30);
                        const float e = __expf(S[4 * j + i] + tab[rb + delta] - mb); pv[4 * j + i] = valid ? e : 0.f; }
            } else {
#pragma unroll
                for (int i = 0; i < 16; ++i) pv[i] = __expf(S[i] - mb);
            }
#pragma unroll
            for (int i = 0; i < 16; ++i) lsum += pv[i];
            const s16x8 P0 = pack8(pv[0], pv[1], pv[2], pv[3], pv[4], pv[5], pv[6], pv[7]);
            const s16x8 P1 = pack8(pv[8], pv[9], pv[10], pv[11], pv[12], pv[13], pv[14], pv[15]);
            const LAS unsigned char* vb = Vl + (kt * 32 + 4 * hi + tr_q) * AV_STR + (16 * dgrp + 4 * tr_p) * 2;
            { const s16x8 V00 = tr_pair(vb, 8 * AV_STR), V01 = tr_pair(vb + 64, 8 * AV_STR);
              const s16x8 V10 = tr_pair(vb + 16 * AV_STR, 8 * AV_STR), V11 = tr_pair(vb + 16 * AV_STR + 64, 8 * AV_STR);
              O0 = MFMA32(V00, P0, O0); O1 = MFMA32(V01, P0, O1); O0 = MFMA32(V10, P1, O0); O1 = MFMA32(V11, P1, O1); }
        }
        __syncthreads();
#pragma unroll
        for (int j = 0; j < 4; ++j) {
            *(LAS f32x4*)(Ored + (size_t)((kq * 64 + 32 * qt + l31) * 68 + 8 * j + 4 * hi)) = (f32x4){O0[4 * j], O0[4 * j + 1], O0[4 * j + 2], O0[4 * j + 3]};
            *(LAS f32x4*)(Ored + (size_t)((kq * 64 + 32 * qt + l31) * 68 + 32 + 8 * j + 4 * hi)) = (f32x4){O1[4 * j], O1[4 * j + 1], O1[4 * j + 2], O1[4 * j + 3]}; }
        lred[(kq * 2 + hi) * 64 + 32 * qt + l31] = lsum;
        __syncthreads();
        { const int q = tid >> 3, d8 = (tid & 7) * 8;
          f32x4 s0 = (f32x4){0.f, 0.f, 0.f, 0.f}, s1 = s0; float l = 0.f;
#pragma unroll
          for (int k = 0; k < 4; ++k) { s0 += *(const LAS f32x4*)(Ored + (k * 64 + q) * 68 + d8); s1 += *(const LAS f32x4*)(Ored + (k * 64 + q) * 68 + d8 + 4); l += lred[(k * 2) * 64 + q] + lred[(k * 2 + 1) * 64 + q]; }
          const float inv = 1.0f / l;
          u32x4 o; o.x = pkb(s0.x * inv, s0.y * inv); o.y = pkb(s0.z * inv, s0.w * inv); o.z = pkb(s1.x * inv, s1.y * inv); o.w = pkb(s1.z * inv, s1.w * inv);
          *(u32x4*)(ao + (size_t)(qrow0 + q) * 1024 + h * 64 + d8) = o; }
        __syncthreads();
    }
}

constexpr int SP_RS = 320;
__device__ __forceinline__ void phase_spatial_mfma(const Params& p, int sl, int M, LAS unsigned char* lds, const Tix T_) {
    bf16_t* vb = (bf16_t*)(p.ws + OFF_BIG); const float* stats = (const float*)(p.ws + OFF_STATS);
    const float* lng = p.sg_ln_g + sl * 3072; const float* lnb = p.sg_ln_b + sl * 3072;
    const int tid = T_.tid, lane = tid & 63, wave = __builtin_amdgcn_readfirstlane(tid >> 6), pt = wave & 3, cth = wave >> 2, l31 = lane & 31, hi = lane >> 5;
    const int tr_q = (lane & 15) >> 2, tr_p = lane & 3, dgrp = (lane >> 4) & 1;
    const int nunits = (M / 128) * 24;
    for (int u = T_.bid; u < nunits; u += T_.gsz) {
        const int nc = u / 24, g = u % 24, r0 = nc * 128;
#pragma unroll
        for (int i = 0; i < 4; ++i) { const int idx = tid + NTHREADS * i, q = idx >> 4, c8 = (idx & 15) * 8;
            const u32x4 w = *(const u32x4*)(vb + (size_t)(r0 + q) * 3072 + g * 128 + c8);
            const float mean = stats[2 * (r0 + q)], rstd = stats[2 * (r0 + q) + 1];
            const f32x4 g0 = *(const f32x4*)(lng + g * 128 + c8), g1 = *(const f32x4*)(lng + g * 128 + c8 + 4), b0 = *(const f32x4*)(lnb + g * 128 + c8), b1 = *(const f32x4*)(lnb + g * 128 + c8 + 4);
            u32x4 o;
            o.x = pkb((bf2f(w.x & 0xffffu) - mean) * rstd * g0.x + b0.x, (bf2f(w.x >> 16) - mean) * rstd * g0.y + b0.y);
            o.y = pkb((bf2f(w.y & 0xffffu) - mean) * rstd * g0.z + b0.z, (bf2f(w.y >> 16) - mean) * rstd * g0.w + b0.w);
            o.z = pkb((bf2f(w.z & 0xffffu) - mean) * rstd * g1.x + b1.x, (bf2f(w.z >> 16) - mean) * rstd * g1.y + b1.y);
            o.w = pkb((bf2f(w.w & 0xffffu) - mean) * rstd * g1.z + b1.z, (bf2f(w.w >> 16) - mean) * rstd * g1.w + b1.w);
            *(LAS u32x4*)(lds + q * SP_RS + c8 * 2) = o; }
        const float* wp = p.sg_w_s + ((size_t)sl * 24 + g) * 16384 + (32 * pt + l31) * 128 + 8 * hi;
        s16x8 Wf[8];
#pragma unroll
        for (int ks = 0; ks < 8; ++ks) { const f32x4 x = *(const f32x4*)(wp + 16 * ks), y = *(const f32x4*)(wp + 16 * ks + 4); Wf[ks] = pack8(x.x, x.y, x.z, x.w, y.x, y.y, y.z, y.w); }
        const float bs = p.sg_b_s[((size_t)sl * 24 + g) * 128 + 32 * pt + l31];
        __syncthreads();
#pragma unroll
        for (int cc = 0; cc < 2; ++cc) { const int ct = 2 * cth + cc;
            f32x16 acc;
#pragma unroll
            for (int i = 0; i < 16; ++i) acc[i] = 0.f;
            const LAS unsigned char* ab = lds + (8 * hi + tr_q) * SP_RS + (32 * ct + 16 * dgrp + 4 * tr_p) * 2;
#pragma unroll
            for (int ks = 0; ks < 8; ++ks) { const s16x8 Af = tr_pair(ab + 16 * ks * SP_RS, 4 * SP_RS); acc = MFMA32(Af, Wf[ks], acc); }
            bf16_t* orow = vb + (size_t)(r0 + 32 * pt + l31) * 3072 + g * 128 + 32 * ct + 4 * hi;
#pragma unroll
            for (int j = 0; j < 4; ++j) { u32x2 o; o.x = pkb(acc[4 * j] + bs, acc[4 * j + 1] + bs); o.y = pkb(acc[4 * j + 2] + bs, acc[4 * j + 3] + bs); *(u32x2*)(orow + 8 * j) = o; }
        }
        __syncthreads();
    }
}

template <class F> struct EpiG {
    static constexpr bool PERM = false, AFTER_DRAIN = false;
    F f;
    __device__ __forceinline__ void operator()(const f32x4 (&acc)[2][2][4][2], const Unit& u, int wr, int wc, int fr, int fq) const {
#pragma unroll
        for (int ai = 0; ai < 2; ++ai)
#pragma unroll
            for (int m = 0; m < 4; ++m) { const int row = u.pm * 256 + ai * 128 + wr * 64 + m * 16 + fr;
#pragma unroll
                for (int bj = 0; bj < 2; ++bj) { const int col = u.pn * 256 + 64 * wc + 32 * bj + 8 * fq; f(row, col, acc[ai][bj][m][0], acc[ai][bj][m][1]); }
                asm volatile("" ::: "memory"); }
    }
};
__device__ __forceinline__ void store8_bf16(bf16_t* o, const f32x4 a, const f32x4 b) { u32x4 w; w.x = pk2(a.x, a.y); w.y = pk2(a.z, a.w); w.z = pk2(b.x, b.y); w.w = pk2(b.z, b.w); *(u32x4*)o = w; }
struct EStore { bf16_t* O; int ldo;
    __device__ __forceinline__ void operator()(int row, int col, f32x4 a, f32x4 b) const { store8_bf16(O + (size_t)row * ldo + col, a, b); } };
struct ESqrelu { bf16_t* O; int ldo;
    __device__ __forceinline__ void operator()(int row, int col, f32x4 a, f32x4 b) const {
#pragma unroll
        for (int i = 0; i < 4; ++i) { const float x = fmaxf(a[i], 0.f), y = fmaxf(b[i], 0.f); a[i] = x * x; b[i] = y * y; }
        store8_bf16(O + (size_t)row * ldo + col, a, b); } };
struct EGeluBias { bf16_t* O; int ldo; const float* bias;
    __device__ __forceinline__ void operator()(int row, int col, f32x4 a, f32x4 b) const {
        const f32x4 b0 = *(const f32x4*)(bias + col), b1 = *(const f32x4*)(bias + col + 4);
#pragma unroll
        for (int i = 0; i < 4; ++i) { a[i] = gelu_f(a[i] + b0[i]); b[i] = gelu_f(b[i] + b1[i]); }
        store8_bf16(O + (size_t)row * ldo + col, a, b); } };
struct EGeluGate { bf16_t* O; int ldo; const float* bias;
    __device__ __forceinline__ void operator()(int row, int col, f32x4 a, f32x4 b) const {
        const f32x4 b0 = *(const f32x4*)(bias + col), b1 = *(const f32x4*)(bias + col + 4);
        bf16_t* op = O + (size_t)row * ldo + col; const u32x4 sv = *(const u32x4*)op;
#pragma unroll
        for (int i = 0; i < 4; ++i) { a[i] = gelu_f(a[i] + b0[i]); b[i] = gelu_f(b[i] + b1[i]); }
        a.x *= bf2f(sv.x & 0xffffu); a.y *= bf2f(sv.x >> 16); a.z *= bf2f(sv.y & 0xffffu); a.w *= bf2f(sv.y >> 16);
        b.x *= bf2f(sv.z & 0xffffu); b.y *= bf2f(sv.z >> 16); b.z *= bf2f(sv.w & 0xffffu); b.w *= bf2f(sv.w >> 16);
        store8_bf16(op, a, b); } };
struct EResid { const float* inl; const float* inc; float* outl; float* outc; const float* gate;
    __device__ __forceinline__ void operator()(int row, int col, f32x4 a, f32x4 b) const {
        const bool lat = row < NLAT; const int bb = lat ? (row >> 12) : 8;
        const float* ip = lat ? inl + (size_t)row * 1024 + col : inc + (size_t)(row - NLAT) * 1024 + col;
        float* op = lat ? outl + (size_t)row * 1024 + col : outc + (size_t)(row - NLAT) * 1024 + col;
        const f32x4 g0 = *(const f32x4*)(gate + (size_t)bb * 6144 + col), g1 = *(const f32x4*)(gate + (size_t)bb * 6144 + col + 4);
        const f32x4 x0 = *(const f32x4*)ip, x1 = *(const f32x4*)(ip + 4);
        *(f32x4*)op = x0 + g0 * a; *(f32x4*)(op + 4) = x1 + g1 * b; } };

template <class F> __device__ __forceinline__ void run_gemm(LAS unsigned char* lds, const bf16_t* A, const bf16_t* Bt, int M, int N, int K, const F& f, const Tix T_) {
    pg8::StaticOrder S; S.init(M, N, T_.gsz, T_.bid);
    pg8::Gemm g; g.A = A; g.Bt = Bt; g.M = M; g.N = N; g.K = K;
    EpiG<F> E; E.f = f;
    pg8::gemm_phase<EpiG<F>, pg8::StaticOrder, true, true>(lds, g, S, E, T_.tid);
}

enum { OP_NORM1, OP_NORM2, OP_QKV, OP_HEADNORM, OP_ATTN, OP_MIXOUT, OP_MLP1, OP_MLP2, OP_VGEMM, OP_LNSTATS, OP_SPATIAL, OP_UGEMM, OP_PROLOGUE };

__device__ __forceinline__ void run_phase(const Params& p, int ph, LAS unsigned char* lds, const Tix T_) {
    int L = 0, op = OP_PROLOGUE;
    if (ph > 0) {
        int q = ph - 1;
        if (q < 8) { L = 0; } else if (q < 17) { L = 1; q -= 8; } else if (q < 25) { L = 2; q -= 17; } else { L = 3; q -= 25; }
        if ((L & 1) == 0) op = q == 0 ? OP_NORM1 : q == 1 ? OP_QKV : q == 2 ? OP_HEADNORM : q == 3 ? OP_ATTN : q == 4 ? OP_MIXOUT : q == 5 ? OP_NORM2 : q == 6 ? OP_MLP1 : OP_MLP2;
        else op = q == 0 ? OP_NORM1 : q == 1 ? OP_VGEMM : q == 2 ? OP_LNSTATS : q == 3 ? OP_SPATIAL : q == 4 ? OP_UGEMM : q == 5 ? OP_MIXOUT : q == 6 ? OP_NORM2 : q == 7 ? OP_MLP1 : OP_MLP2;
    }
#ifdef ONLY_OP
    op = ONLY_OP;
#endif
    const int mi = L >> 1;
    const bool attnL = (L & 1) == 0;
    const int Mfull = L < 2 ? MTOT : NLAT;
    float* mods = (float*)(p.ws + OFF_MODS); const float* modsl = mods + (size_t)L * 9 * 6144;
    float* ctxr = (float*)(p.ws + OFF_CTXR);
    bf16_t* hb = (bf16_t*)(p.ws + OFF_HB); bf16_t* big = (bf16_t*)(p.ws + OFF_BIG);
    const bool first = (L == 0);
    switch (op) {
    case OP_PROLOGUE: phase_mods(p, lds, T_); __syncthreads(); phase_convert(p, lds, T_); break;
    case OP_NORM1: phase_normmod(first ? p.x : p.out, first ? p.ctx : ctxr, hb, p.norm1_g + L * 1024, modsl, 0, 1024, L <= 2 ? MTOT : NLAT, T_); break;
    case OP_NORM2: phase_normmod(p.out, ctxr, hb, p.norm2_g + L * 1024, modsl, 3072, 4096, Mfull, T_); break;
    case OP_QKV: { EStore f; f.O = big; f.ldo = 3072; run_gemm(lds, hb, (const bf16_t*)(p.ws + OFF_QKVT) + (size_t)mi * 3072 * 1024, MTOT, 3072, 1024, f, T_); } break;
    case OP_HEADNORM: phase_headnorm(big, p.na_q_norm + mi * 64, p.na_k_norm + mi * 64, MTOT, T_); break;
    #if NAIVE_ATTN
    case OP_ATTN: phase_attn_naive(p, mi, L == 0, T_); break;
#else
    case OP_ATTN: phase_attn_mfma(p, mi, L == 0, lds, T_); break;
#endif
    case OP_MIXOUT: case OP_MLP2: {
        EResid f; const bool mo = (op == OP_MIXOUT);
        f.inl = (first && mo) ? p.x : p.out; f.inc = (first && mo) ? p.ctx : ctxr; f.outl = p.out; f.outc = ctxr; f.gate = modsl + (mo ? 2048 : 5120);
        const bf16_t* A; const bf16_t* Bt; int K;
        if (!mo) { A = big; Bt = (const bf16_t*)(p.ws + OFF_W2T) + (size_t)L * 1024 * 4096; K = 4096; }
        else if (attnL) { A = big + (size_t)MTOT * 3072; Bt = (const bf16_t*)(p.ws + OFF_WOT) + (size_t)mi * 1024 * 1024; K = 1024; }
        else { A = big; Bt = (const bf16_t*)(p.ws + OFF_SGOT) + (size_t)mi * 1024 * 3072; K = 3072; }
        run_gemm(lds, A, Bt, Mfull, 1024, K, f, T_); } break;
    case OP_MLP1: { ESqrelu f; f.O = big; f.ldo = 4096; run_gemm(lds, hb, (const bf16_t*)(p.ws + OFF_W1T) + (size_t)L * 4096 * 1024, Mfull, 4096, 1024, f, T_); } break;
    case OP_VGEMM: { EGeluBias f; f.O = big; f.ldo = 3072; f.bias = p.sg_b_in + mi * 6144 + 3072;
        run_gemm(lds, hb, (const bf16_t*)(p.ws + OFF_WINT) + (size_t)mi * 6144 * 1024 + (size_t)3072 * 1024, Mfull, 3072, 1024, f, T_); } break;
    case OP_LNSTATS: phase_lnstats(big, (float*)(p.ws + OFF_STATS), Mfull, T_); break;
    #if NAIVE_SPATIAL
    case OP_SPATIAL: phase_spatial_naive(p, mi, Mfull, lds, T_); break;
#else
    case OP_SPATIAL: phase_spatial_mfma(p, mi, Mfull, lds, T_); break;
#endif
    case OP_UGEMM: { EGeluGate f; f.O = big; f.ldo = 3072; f.bias = p.sg_b_in + mi * 6144;
        run_gemm(lds, hb, (const bf16_t*)(p.ws + OFF_WINT) + (size_t)mi * 6144 * 1024, Mfull, 3072, 1024, f, T_); } break;
    default: break;
    }
}

#ifndef NAIVE_ATTN
#define NAIVE_ATTN 0
#endif
#ifndef NAIVE_SPATIAL
#define NAIVE_SPATIAL 0
#endif
#ifndef ONE_LAUNCH
#define ONE_LAUNCH 1
#endif
__global__ void __launch_bounds__(NTHREADS) mk(Params p0) {
    extern __shared__ __attribute__((aligned(16))) unsigned char lds_raw[];
    LAS unsigned char* lds = (LAS unsigned char*)lds_raw;
#if ONE_LAUNCH
    cg::grid_group grid = cg::this_grid();
    for (int ph = p0.ph_lo; ph < p0.ph_hi; ++ph) {
        if (ph > p0.ph_lo) grid.sync();
        Tix T_; T_.tid = threadIdx.x; T_.bid = blockIdx.x; T_.gsz = gridDim.x;
        size_t z = 0;
        asm volatile("" : "+v"(T_.tid)); asm volatile("" : "+s"(T_.bid), "+s"(T_.gsz), "+s"(z));
        Params p = p0;
        { const float** pp = (const float**)&p;
#pragma unroll
          for (int i = 0; i < 22; ++i) pp[i] += z; }
        p.out += z; p.ws += z;
        run_phase(p, ph, lds, T_);
        __syncthreads();
    }
#else
    Tix T_; T_.tid = threadIdx.x; T_.bid = blockIdx.x; T_.gsz = gridDim.x;
    run_phase(p0, p0.ph_lo, lds, T_);
#endif
}

extern "C" void kernel_launch(void* const* d_in, const int* in_sizes, int n_in, void* d_out, int out_size, void* d_ws, size_t ws_size, hipStream_t stream) {
    static int grid = 0;
    if (grid == 0) {
        if (n_in != 22 || ws_size < WS_END) { fprintf(stderr, "kernel_launch: unexpected n_in %d or ws_size %zu (< %zu)\n", n_in, ws_size, (size_t)WS_END); grid = -1; return; }
        int dev = 0, cus = 0, per_cu = 0;
        hipGetDevice(&dev); hipDeviceGetAttribute(&cus, hipDeviceAttributeMultiprocessorCount, dev);
        if (hipFuncSetAttribute((const void*)mk, hipFuncAttributeMaxDynamicSharedMemorySize, LDS_BYTES) != hipSuccess) { fprintf(stderr, "kernel_launch: hipFuncSetAttribute failed\n"); grid = -1; return; }
        if (hipOccupancyMaxActiveBlocksPerMultiprocessor(&per_cu, (const void*)mk, NTHREADS, LDS_BYTES) != hipSuccess || per_cu < 1) { fprintf(stderr, "kernel_launch: occupancy query says %d\n", per_cu); per_cu = 1; }
        (void)hipGetLastError();
        grid = cus;
    }
    if (grid < 0) return;
    Params p{};
    const float** pp = (const float**)&p;
    for (int i = 0; i < 22; ++i) pp[i] = (const float*)d_in[i];
    p.out = (float*)d_out; p.ws = (unsigned char*)d_ws;
#if ONE_LAUNCH
    p.ph_lo = 0; p.ph_hi = NPH;
    void* args[] = {&p};
    hipError_t e = hipLaunchCooperativeKernel((void*)mk, dim3(grid), dim3(NTHREADS), args, LDS_BYTES, stream);
    if (e != hipSuccess) fprintf(stderr, "cooperative launch failed: %s (grid %d)\n", hipGetErrorString(e), grid);
#else
    for (int ph = 0; ph < NPH; ++ph) { p.ph_lo = ph; p.ph_hi = ph + 1; hipLaunchKernelGGL(mk, dim3(grid), dim3(NTHREADS), LDS_BYTES, stream, p); }
#endif
}
```

```cpp
#include <hip/hip_runtime.h>
#include <hip/hip_cooperative_groups.h>
#include <cstdio>
#include <cstdint>
namespace cg = cooperative_groups;
namespace pg8 {
#define PG8_LAS __attribute__((address_space(3)))
typedef unsigned short bf16_t;
typedef short bf16x8 __attribute__((ext_vector_type(8)));
typedef float f32x4 __attribute__((ext_vector_type(4)));
typedef unsigned u32x4 __attribute__((ext_vector_type(4)));
constexpr int BM = 256, BK = 64, HALF = 128, HTB = HALF * BK * 2  , STAGE_BYTES = 8 * HTB, NXCD = 8, WGM = 8;

__host__ __device__ __forceinline__ int lds_byte(int r, int c) { const int st = (r >> 4) * 2 + (c >> 5), rr = r & 15, cc = c & 31, ob = rr * 64 + cc * 2; return st * 1024 + (ob ^ (((ob >> 9) & 1) << 5)); }
__host__ __device__ __forceinline__ void stage_rc(int b, int& R, int& C) { const int st = b / 1024, sb = b % 1024, swz = sb ^ (((sb >> 9) & 1) << 5); R = (st >> 1) * 16 + swz / 64; C = (st & 1) * 32 + (swz % 64) / 2; }
__host__ __device__ __forceinline__ int perm32(int rho) { const int n = rho >> 4, i = rho & 15; return 8 * (i >> 2) + 4 * n + (i & 3); }

struct Unit { int pm, pn; };
struct Gemm { const bf16_t* A; const bf16_t* Bt; int M, N, K; };

struct StaticOrder {
    int nM, nN, nwg, G, c;
    __host__ __device__ void init(int M, int N, int G_, int c_) { nM = M / BM; nN = N / BM; nwg = nM * nN; G = G_; c = c_; }
    __host__ __device__ bool next(int i, Unit& u) const {
        const long L = (long)i * G + c; if (L >= nwg) return false;
        int wgid = (int)L; { const int q = nwg / NXCD, r = nwg % NXCD, xcd = wgid % NXCD, off = wgid / NXCD; wgid = (xcd < r ? xcd * (q + 1) : r * (q + 1) + (xcd - r) * q) + off; }
        const int nig = WGM * nN, gid = wgid / nig, fm = gid * WGM, gsz = (nM - fm) < WGM ? (nM - fm) : WGM;
        u.pm = fm + ((wgid % nig) % gsz); u.pn = (wgid % nig) / gsz; return true;
    }
    __device__ __forceinline__ void a_ready(const Unit&) const {}
    __device__ __forceinline__ void done(const Unit&) const {}
};

__device__ __forceinline__ unsigned cvt_pk_bf16(float lo, float hi) { unsigned r; asm volatile("v_cvt_pk_bf16_f32 %0, %1, %2" : "=v"(r) : "v"(lo), "v"(hi)); return r; }
template <class Epi, class Sched, bool ALIGN_EPI = false, bool SP2 = false>
__device__ __forceinline__ void gemm_phase(PG8_LAS unsigned char* lds, const Gemm g, const Sched& S, const Epi& E, const int tid_in) {
    const int tid = tid_in, wid = __builtin_amdgcn_readfirstlane(tid >> 6), lane = tid & 63, wr = wid >> 2, wc = wid & 3, fr = lane & 15, fq = lane >> 4;
    const int K = g.K, nt = K / BK;
    unsigned voffA[2], voffB[2];
#pragma unroll
    for (int i = 0; i < 2; ++i) { int R, C; stage_rc(tid * 16 + i * 8192, R, C); const int Rb = Epi::PERM ? ((R & ~31) + perm32(R & 31)) : R;
        voffA[i] = (unsigned)(R * K + C) * 2u; voffB[i] = (unsigned)(Rb * K + C) * 2u; }
    const size_t kstep = (size_t)(BK * 2);
    const size_t hstep = (size_t)HALF * K * 2;
    const size_t tstep = 2 * hstep;
    const unsigned ldsw = (unsigned)wid * 1024u;
    const int aoff = lds_byte(wr * 64 + fr, fq * 8), boff = lds_byte(wc * 32 + fr, fq * 8);
#define PG8_SA(b, h) (((b) * 2 + (h)) * HTB)
#define PG8_SB(b, h) ((4 + (b) * 2 + (h)) * HTB)
#define PG8_STAGE(bufoff, gbase, voff) do { _Pragma("unroll") for (int _i = 0; _i < 2; ++_i) \
        __builtin_amdgcn_global_load_lds((const unsigned*)((const char*)(gbase) + (voff)[_i]), (PG8_LAS unsigned*)(lds + (bufoff) + ldsw + _i * 8192), 16, 0, 0); } while (0)
#define PG8_LDA(dst, b, h) do { _Pragma("unroll") for (int m = 0; m < 4; ++m) _Pragma("unroll") for (int k = 0; k < 2; ++k) dst[m][k] = *(const PG8_LAS bf16x8*)(lds + PG8_SA(b, h) + aoff + m * 2048 + k * 1024); } while (0)
#define PG8_LDB(dst, b, h) do { _Pragma("unroll") for (int n = 0; n < 2; ++n) _Pragma("unroll") for (int k = 0; k < 2; ++k) dst[n][k] = *(const PG8_LAS bf16x8*)(lds + PG8_SB(b, h) + boff + n * 2048 + k * 1024); } while (0)
#define PG8_MMA(ai, bj, At, Bt) do { __builtin_amdgcn_s_setprio(1); _Pragma("unroll") for (int m = 0; m < 4; ++m) _Pragma("unroll") for (int n = 0; n < 2; ++n) _Pragma("unroll") for (int k = 0; k < 2; ++k) \
        acc[ai][bj][m][n] = __builtin_amdgcn_mfma_f32_16x16x32_bf16(Bt[n][k], At[m][k], acc[ai][bj][m][n], 0, 0, 0); __builtin_amdgcn_s_setprio(0); } while (0)
#define PG8_WAIT_V(n) asm volatile("s_waitcnt vmcnt(" #n ")" ::: "memory")
#define PG8_WAIT_L(n) asm volatile("s_waitcnt lgkmcnt(" #n ")" ::: "memory")
#define PG8_BAR __builtin_amdgcn_s_barrier()
#define PG8_SCHED __builtin_amdgcn_sched_barrier(0)
    Unit cur, nxt; int ui = 0;
    if (!S.next(0, cur)) return;
    f32x4 acc[2][2][4][2];
#pragma unroll
    for (int a = 0; a < 2; ++a)
#pragma unroll
        for (int b = 0; b < 2; ++b)
#pragma unroll
            for (int m = 0; m < 4; ++m)
#pragma unroll
                for (int n = 0; n < 2; ++n) acc[a][b][m][n] = (f32x4){0.f, 0.f, 0.f, 0.f};
    bf16x8 At[4][2], B0[2][2], B1[2][2];
    const char* cA = (const char*)g.A + (size_t)cur.pm * tstep; const char* cB = (const char*)g.Bt + (size_t)cur.pn * tstep;
    S.a_ready(cur);
    if constexpr (SP2) {
        PG8_STAGE(PG8_SB(0, 0), cB, voffB); PG8_STAGE(PG8_SB(0, 1), cB + hstep, voffB); PG8_STAGE(PG8_SA(0, 0), cA, voffA); PG8_STAGE(PG8_SA(0, 1), cA + hstep, voffA);
        if (wr == 1) PG8_BAR;
        PG8_WAIT_V(2); PG8_BAR;
        PG8_STAGE(PG8_SB(1, 0), cB + kstep, voffB); PG8_STAGE(PG8_SA(1, 0), cA + kstep, voffA); PG8_STAGE(PG8_SB(1, 1), cB + hstep + kstep, voffB);
        PG8_WAIT_V(6); PG8_BAR;
    } else {
        PG8_STAGE(PG8_SB(0, 0), cB, voffB); PG8_STAGE(PG8_SA(0, 0), cA, voffA); PG8_STAGE(PG8_SB(0, 1), cB + hstep, voffB); PG8_STAGE(PG8_SA(0, 1), cA + hstep, voffA);
        if (wr == 1) PG8_BAR;
        PG8_WAIT_V(4); PG8_BAR;
        PG8_STAGE(PG8_SB(1, 0), cB + kstep, voffB); PG8_STAGE(PG8_SA(1, 0), cA + kstep, voffA); PG8_STAGE(PG8_SB(1, 1), cB + hstep + kstep, voffB);
        PG8_WAIT_V(6); PG8_BAR;
    }
    for (;;) {
        const bool has_next = S.next(ui + 1, nxt);
        const char* nA = has_next ? (const char*)g.A + (size_t)nxt.pm * tstep : cA; const char* nB = has_next ? (const char*)g.Bt + (size_t)nxt.pn * tstep : cB;
        for (int t = 0; t < nt; t += 2) {
            const bool last = (t == nt - 2);
            const char* a1 = cA + (size_t)(t + 1) * kstep;
            const char* a2 = last ? nA : cA + (size_t)(t + 2) * kstep; const char* b2 = last ? nB : cB + (size_t)(t + 2) * kstep;
            const char* a3 = a2 + kstep; const char* b3 = b2 + kstep;
            if (last && has_next) S.a_ready(nxt);
            if constexpr (SP2) {
            PG8_LDB(B0, 0, 0); PG8_LDB(B1, 0, 1); PG8_SCHED; PG8_LDA(At, 0, 0); PG8_STAGE(PG8_SA(1, 1), a1 + hstep, voffA);
            PG8_WAIT_V(8); PG8_WAIT_L(0); PG8_BAR; PG8_MMA(0, 0, At, B0); PG8_MMA(0, 1, At, B1); PG8_BAR; PG8_SCHED;
            PG8_LDA(At, 0, 1); PG8_STAGE(PG8_SB(0, 0), b2, voffB); PG8_STAGE(PG8_SB(0, 1), b2 + hstep, voffB); PG8_STAGE(PG8_SA(0, 0), a2, voffA);
            PG8_WAIT_V(8); PG8_WAIT_L(0); PG8_BAR; PG8_MMA(1, 0, At, B0); PG8_MMA(1, 1, At, B1); PG8_BAR; PG8_SCHED;
            PG8_LDB(B0, 1, 0); PG8_LDB(B1, 1, 1); PG8_SCHED; PG8_LDA(At, 1, 0); PG8_STAGE(PG8_SA(0, 1), a2 + hstep, voffA);
            PG8_WAIT_V(8); PG8_WAIT_L(0); PG8_BAR; PG8_MMA(0, 0, At, B0); PG8_MMA(0, 1, At, B1); PG8_BAR; PG8_SCHED;
            PG8_LDA(At, 1, 1); PG8_STAGE(PG8_SB(1, 0), b3, voffB); PG8_STAGE(PG8_SB(1, 1), b3 + hstep, voffB); PG8_STAGE(PG8_SA(1, 0), a3, voffA);
            PG8_WAIT_V(8); PG8_WAIT_L(0); PG8_BAR; PG8_MMA(1, 0, At, B0); PG8_MMA(1, 1, At, B1); PG8_BAR; PG8_SCHED;
            } else {
            PG8_LDB(B0, 0, 0); PG8_SCHED; PG8_LDA(At, 0, 0); PG8_STAGE(PG8_SA(1, 1), a1 + hstep, voffA);
            PG8_WAIT_L(8); PG8_BAR; PG8_WAIT_L(0); PG8_MMA(0, 0, At, B0); PG8_BAR; PG8_SCHED;
            PG8_LDB(B1, 0, 1); PG8_STAGE(PG8_SB(0, 0), b2, voffB);
            PG8_BAR; PG8_WAIT_L(0); PG8_MMA(0, 1, At, B1); PG8_BAR;
            PG8_LDA(At, 0, 1); PG8_STAGE(PG8_SA(0, 0), a2, voffA);
            PG8_BAR; PG8_WAIT_L(0); PG8_MMA(1, 0, At, B0); PG8_BAR; PG8_SCHED;
            PG8_STAGE(PG8_SB(0, 1), b2 + hstep, voffB);
            PG8_WAIT_V(6); PG8_BAR; PG8_MMA(1, 1, At, B1); PG8_BAR;
            PG8_LDB(B0, 1, 0); PG8_SCHED; PG8_LDA(At, 1, 0); PG8_STAGE(PG8_SA(0, 1), a2 + hstep, voffA);
            PG8_WAIT_L(8); PG8_BAR; PG8_WAIT_L(0); PG8_MMA(0, 0, At, B0); PG8_BAR; PG8_SCHED;
            PG8_LDB(B1, 1, 1); PG8_STAGE(PG8_SB(1, 0), b3, voffB);
            PG8_BAR; PG8_WAIT_L(0); PG8_MMA(0, 1, At, B1); PG8_BAR;
            PG8_LDA(At, 1, 1); PG8_STAGE(PG8_SA(1, 0), a3, voffA);
            PG8_BAR; PG8_WAIT_L(0); PG8_MMA(1, 0, At, B0); PG8_BAR; PG8_SCHED;
            PG8_STAGE(PG8_SB(1, 1), b3 + hstep, voffB);
            PG8_WAIT_V(6); PG8_BAR; PG8_MMA(1, 1, At, B1); PG8_BAR;
            }
        }
        if constexpr (ALIGN_EPI) { if (wr == 0) PG8_BAR; }
        if constexpr (!Epi::AFTER_DRAIN) { E(acc, cur, wr, wc, fr, fq); S.done(cur); }
        if (!has_next) break;
#pragma unroll
        for (int a = 0; a < 2; ++a)
#pragma unroll
            for (int b = 0; b < 2; ++b)
#pragma unroll
                for (int m = 0; m < 4; ++m)
#pragma unroll
                    for (int n = 0; n < 2; ++n) acc[a][b][m][n] = (f32x4){0.f, 0.f, 0.f, 0.f};
        cur = nxt; cA = nA; cB = nB; ++ui;
        if constexpr (ALIGN_EPI) { if (wr == 1) PG8_BAR; }
    }
    PG8_WAIT_V(0);
    if constexpr (!ALIGN_EPI) { if (wr == 0) PG8_BAR; }
    PG8_BAR;
    if constexpr (Epi::AFTER_DRAIN) { E.fused(acc, cur, wr, wc, fr, fq, lds, wid, lane); S.done(cur); }
#undef PG8_SA
#undef PG8_SB
#undef PG8_STAGE
#undef PG8_LDA
#undef PG8_LDB
#undef PG8_MMA
#undef PG8_WAIT_V
#undef PG8_WAIT_L
#undef PG8_BAR
#undef PG8_SCHED
}
}

#ifndef REP_MASK
#define REP_MASK 0
#endif
#ifndef NAIVE_ATTN
#define NAIVE_ATTN 0
#endif
#ifndef NAIVE_SPATIAL
#define NAIVE_SPATIAL 0
#endif
#define LAS __attribute__((address_space(3)))
using pg8::bf16_t; using pg8::f32x4; using pg8::Unit; using pg8::u32x4;
typedef unsigned u32x2 __attribute__((ext_vector_type(2)));

constexpr int NLAT = 32768, NCTX = 2048, MTOT = 34816;
constexpr int NTHREADS = 512;
constexpr int LDS_BYTES = 131072;
constexpr int NPH = 33;

constexpr size_t OFF_W1T = 0;
constexpr size_t OFF_W2T = OFF_W1T + 4ull * 4096 * 1024 * 2;
constexpr size_t OFF_QKVT = OFF_W2T + 4ull * 4096 * 1024 * 2;
constexpr size_t OFF_WOT = OFF_QKVT + 2ull * 3072 * 1024 * 2;
constexpr size_t OFF_WINT = OFF_WOT + 2ull * 1024 * 1024 * 2;
constexpr size_t OFF_SGOT = OFF_WINT + 2ull * 6144 * 1024 * 2;
constexpr size_t OFF_MODS = OFF_SGOT + 2ull * 1024 * 3072 * 2;
constexpr size_t OFF_CTXR = OFF_MODS + 4ull * 9 * 6144 * 4;
constexpr size_t OFF_HB = OFF_CTXR + 2048ull * 1024 * 4;
constexpr size_t OFF_BIG = OFF_HB + 34816ull * 1024 * 2;
constexpr size_t OFF_STATS = OFF_BIG + 34816ull * 4096 * 2;
constexpr size_t WS_END = OFF_STATS + 34816ull * 2 * 4;

struct Params {
    const float *x, *c, *ctx, *c_ctx, *ada_w, *ada_b, *norm1_g, *norm2_g, *mlp_w1, *mlp_w2, *na_w_qkv, *na_q_norm, *na_k_norm, *na_rpb, *na_w_o,
        *sg_w_in, *sg_b_in, *sg_ln_g, *sg_ln_b, *sg_w_s, *sg_b_s, *sg_w_o;
    float* out; unsigned char* ws; int ph_lo, ph_hi;
};

struct Tix { int tid, bid, gsz; };
__device__ __forceinline__ float bf2f(unsigned h) { return __uint_as_float(h << 16); }
__device__ __forceinline__ unsigned f2bf(float f) { unsigned u = __float_as_uint(f); u += 0x7FFFu + ((u >> 16) & 1u); return u >> 16; }
__device__ __forceinline__ unsigned pk2(float lo, float hi) { return pg8::cvt_pk_bf16(lo, hi); }
__device__ __forceinline__ float wave_sum(float v) {
#pragma unroll
    for (int o = 1; o < 64; o <<= 1) v += __shfl_xor(v, o);
    return v;
}
__device__ __forceinline__ float wave_max(float v) {
#pragma unroll
    for (int o = 1; o < 64; o <<= 1) v = fmaxf(v, __shfl_xor(v, o));
    return v;
}
#define LDS_WAIT() asm volatile("s_waitcnt lgkmcnt(0)" ::: "memory")
__device__ __forceinline__ float silu_f(float v) { return v / (1.f + expf(-v)); }
__device__ __forceinline__ float gelu_f(float v) { return 0.5f * v * (1.f + erff(v * 0.70710678118654752f)); }

typedef float f32x2 __attribute__((ext_vector_type(2)));
__device__ __forceinline__ f32x2 gelu_pk(f32x2 v) {
    const f32x2 av = __builtin_elementwise_abs(v), d = av * 0.2316418882f + 1.0f;
    f32x2 t; t.x = __builtin_amdgcn_rcpf(d.x); t.y = __builtin_amdgcn_rcpf(d.y);
    f32x2 q = t * 0.5307027145f + (-0.7265760135f); q = q * t + 0.7107068705f; q = q * t + (-0.142248368f); q = q * t + 0.127414796f; q = q * t;
    const f32x2 s = (v * v) * (-0.72134752044f);
    f32x2 e; e.x = __builtin_amdgcn_exp2f(s.x); e.y = __builtin_amdgcn_exp2f(s.y);
    const f32x2 m = v * (q * e), r = v - m;
    f32x2 o; o.x = v.x < 0.f ? m.x : r.x; o.y = v.y < 0.f ? m.y : r.y; return o;
}
__device__ __forceinline__ f32x4 gelu4(f32x4 v) { const f32x2 a = gelu_pk((f32x2){v.x, v.y}), b = gelu_pk((f32x2){v.z, v.w}); return (f32x4){a.x, a.y, b.x, b.y}; }

__device__ __forceinline__ int sigma_inv(int L) { return 128 * ((L >> 5) & 1) + 32 * (L >> 6) + 16 * ((L >> 2) & 1) + 4 * ((L >> 3) & 3) + (L & 3); }

__device__ __forceinline__ void phase_mods(const Params& p, LAS unsigned char* lds, const Tix T_) {
    LAS float* sc = (LAS float*)lds;
    LAS float* red = (LAS float*)(lds + 36864);
    float* mods = (float*)(p.ws + OFF_MODS);
    const int tid = T_.tid;
    for (int i = tid; i < 9 * 1024; i += NTHREADS) { const int b = i >> 10, k = i & 1023; const float v = b < 8 ? p.c[b * 1024 + k] : p.c_ctx[k]; sc[i] = silu_f(v); }
    __syncthreads();
    const int c4 = (tid & 15) * 4, kk = tid >> 4;
    for (int item = T_.bid; item < 384; item += T_.gsz) {
        const int l = item / 96, n0 = (item % 96) * 64;
        const float* W = p.ada_w + (size_t)l * 1024 * 6144 + n0 + c4;
        f32x4 acc[9];
#pragma unroll
        for (int b = 0; b < 9; ++b) acc[b] = (f32x4){0.f, 0.f, 0.f, 0.f};
#pragma unroll 4
        for (int i = 0; i < 32; ++i) { const int k = kk + 32 * i; const f32x4 w = *(const f32x4*)(W + (size_t)k * 6144);
#pragma unroll
            for (int b = 0; b < 9; ++b) acc[b] += sc[b * 1024 + k] * w; }
#pragma unroll
        for (int b = 0; b < 9; ++b) *(LAS f32x4*)(red + (kk * 9 + b) * 64 + c4) = acc[b];
        __syncthreads();
        for (int o = tid; o < 576; o += NTHREADS) { const int b = o >> 6, cc = o & 63; float s = 0.f;
            for (int j = 0; j < 32; ++j) s += red[(j * 9 + b) * 64 + cc];
            mods[(size_t)(l * 9 + b) * 6144 + n0 + cc] = s + p.ada_b[l * 6144 + n0 + cc]; }
        __syncthreads();
    }
}

struct MatDesc { const float* src; bf16_t* dst; int K, N; };
__device__ __forceinline__ MatDesc get_mat(const Params& p, int mi) {
    MatDesc m;
    if (mi < 4) { m.src = p.mlp_w1 + (size_t)mi * 1024 * 4096; m.dst = (bf16_t*)(p.ws + OFF_W1T) + (size_t)mi * 4096 * 1024; m.K = 1024; m.N = 4096; }
    else if (mi < 8) { const int l = mi - 4; m.src = p.mlp_w2 + (size_t)l * 4096 * 1024; m.dst = (bf16_t*)(p.ws + OFF_W2T) + (size_t)l * 1024 * 4096; m.K = 4096; m.N = 1024; }
    else if (mi < 10) { const int a = mi - 8; m.src = p.na_w_qkv + (size_t)a * 1024 * 3072; m.dst = (bf16_t*)(p.ws + OFF_QKVT) + (size_t)a * 3072 * 1024; m.K = 1024; m.N = 3072; }
    else if (mi < 12) { const int a = mi - 10; m.src = p.na_w_o + (size_t)a * 1024 * 1024; m.dst = (bf16_t*)(p.ws + OFF_WOT) + (size_t)a * 1024 * 1024; m.K = 1024; m.N = 1024; }
    else if (mi < 14) { const int s = mi - 12; m.src = p.sg_w_in + (size_t)s * 1024 * 6144; m.dst = (bf16_t*)(p.ws + OFF_WINT) + (size_t)s * 6144 * 1024; m.K = 1024; m.N = 6144; }
    else { const int s = mi - 14; m.src = p.sg_w_o + (size_t)s * 3072 * 1024; m.dst = (bf16_t*)(p.ws + OFF_SGOT) + (size_t)s * 1024 * 3072; m.K = 3072; m.N = 1024; }
    return m;
}
__device__ __forceinline__ void transpose_item(const float* W, int K, int N, bf16_t* WT, LAS float* scr, int item, int lane) {
    const int nblk = N / 32, kb = item / nblk, nb = item % nblk, k0 = 64 * kb, n0 = 32 * nb;
#pragma unroll 8
    for (int i = 0; i < 32; ++i) { const int kk = 2 * i + (lane >> 5); scr[kk * 33 + (lane & 31)] = W[(size_t)(k0 + kk) * N + n0 + (lane & 31)]; }
    LDS_WAIT();
    const int c = lane & 7;
#pragma unroll
    for (int j = 0; j < 4; ++j) { const int n = (lane >> 3) + 8 * j; const LAS float* s = scr + (8 * c) * 33 + n;
        u32x4 o; o.x = pk2(s[0 * 33], s[1 * 33]); o.y = pk2(s[2 * 33], s[3 * 33]); o.z = pk2(s[4 * 33], s[5 * 33]); o.w = pk2(s[6 * 33], s[7 * 33]);
        const int nl = n0 + n, drow = (nl & ~255) + sigma_inv(nl & 255);
        *(u32x4*)(WT + (size_t)drow * K + k0 + 8 * c) = o; }
    LDS_WAIT();
}
__device__ __forceinline__ void phase_convert(const Params& p, LAS unsigned char* lds, const Tix T_) {
    const int lane = T_.tid & 63, wave = T_.tid >> 6, gw = T_.bid * 8 + wave, NGW = T_.gsz * 8;
    LAS float* scr = (LAS float*)(lds + wave * 8704);
    for (int mi = 0; mi < 16; ++mi) {
        const MatDesc m = get_mat(p, mi);
        const int nitems = (m.K / 64) * (m.N / 32);
        for (int it = gw; it < nitems; it += NGW) transpose_item(m.src, m.K, m.N, m.dst, scr, it, lane);
    }
}

__device__ __forceinline__ void phase_normmod(const float* xl, const float* xc, bf16_t* hb, const float* g, const float* modsl, int sh_off, int sc_off, int M, const Tix T_) {
    const int lane = T_.tid & 63, gw = T_.bid * 8 + (T_.tid >> 6), NGW = T_.gsz * 8;
    for (int row = gw; row < M; row += NGW) {
        const float* xr = row < NLAT ? xl + (size_t)row * 1024 : xc + (size_t)(row - NLAT) * 1024;
        const int b = row < NLAT ? (row >> 12) : 8;
        f32x4 v[4]; float s = 0.f;
#pragma unroll
        for (int j = 0; j < 4; ++j) { v[j] = *(const f32x4*)(xr + 4 * lane + 256 * j); s += (v[j].x * v[j].x + v[j].y * v[j].y) + (v[j].z * v[j].z + v[j].w * v[j].w); }
        s = wave_sum(s);
        const float rstd = 1.0f / sqrtf(s * (1.0f / 1024.0f) + 1e-6f);
#pragma unroll
        for (int j = 0; j < 4; ++j) { const int col = 4 * lane + 256 * j;
            const f32x4 gv = *(const f32x4*)(g + col), scv = *(const f32x4*)(modsl + (size_t)b * 6144 + sc_off + col), shv = *(const f32x4*)(modsl + (size_t)b * 6144 + sh_off + col);
            const f32x4 o = v[j] * rstd * gv * (1.0f + scv) + shv;
            u32x2 w; w.x = pk2(o.x, o.y); w.y = pk2(o.z, o.w);
            *(u32x2*)(hb + (size_t)row * 1024 + col) = w; }
    }
}
__device__ __forceinline__ void phase_headnorm(bf16_t* qkv, const float* qg, const float* kg, int M, const Tix T_) {
    const int lane = T_.tid & 63, gw = T_.bid * 8 + (T_.tid >> 6), NGW = T_.gsz * 8;
    const bool isq = lane < 32; const int d0 = (lane & 1) * 32;
    const float* gn = isq ? qg : kg; const float mul = isq ? 0.125f : 1.0f;
    for (int row = gw; row < M; row += NGW) {
        bf16_t* ptr = qkv + (size_t)row * 3072 + lane * 32;
        u32x4 raw[4]; float v[32]; float s = 0.f;
#pragma unroll
        for (int j = 0; j < 4; ++j) raw[j] = *(const u32x4*)(ptr + 8 * j);
#pragma unroll
        for (int j = 0; j < 4; ++j) {
#pragma unroll
            for (int e = 0; e < 4; ++e) { const unsigned w = raw[j][e]; v[8 * j + 2 * e] = bf2f(w & 0xffffu); v[8 * j + 2 * e + 1] = bf2f(w >> 16); } }
#pragma unroll
        for (int i = 0; i < 32; ++i) s += v[i] * v[i];
        s += __shfl_xor(s, 1);
        const float rstd = mul / sqrtf(s * (1.0f / 64.0f) + 1e-6f);
#pragma unroll
        for (int j = 0; j < 4; ++j) { u32x4 o;
#pragma unroll
            for (int e = 0; e < 4; ++e) { const int i = 8 * j + 2 * e; o[e] = pk2(v[i] * rstd * gn[d0 + i], v[i + 1] * rstd * gn[d0 + i + 1]); }
            *(u32x4*)(ptr + 8 * j) = o; }
    }
}
__device__ __forceinline__ float dot64(const float (&q)[64], const bf16_t* kp) {
    float s = 0.f;
#pragma unroll
    for (int j = 0; j < 8; ++j) { const u32x4 w = *(const u32x4*)(kp + 8 * j);
#pragma unroll
        for (int e = 0; e < 4; ++e) { s += q[8 * j + 2 * e] * bf2f(w[e] & 0xffffu); s += q[8 * j + 2 * e + 1] * bf2f(w[e] >> 16); } }
    return s;
}
__device__ __forceinline__ void phase_attn_naive(const Params& p, int a, bool ctx_q, const Tix T_) {
    const bf16_t* qkv = (const bf16_t*)(p.ws + OFF_BIG); bf16_t* ao = (bf16_t*)(p.ws + OFF_BIG) + (size_t)MTOT * 3072;
    const float* rpb = p.na_rpb + (size_t)a * 16 * 15 * 31;
    const int lane = T_.tid & 63, gw = T_.bid * 8 + (T_.tid >> 6), NGW = T_.gsz * 8;
    const int nq = ctx_q ? MTOT : NLAT;
    for (int item = gw; item < nq * 16; item += NGW) {
        const int row = item >> 4, h = item & 15;
        const bool lat = row < NLAT;
        int b, r = 0, qc = 0, rs = 0, wst = 0;
        if (lat) { b = row >> 12; const int t = row & 4095; r = t >> 6; qc = t & 63; rs = min(max(r - 4, 0), 56); wst = min(max(qc - 8, 0), 48); } else b = (row - NLAT) >> 8;
        float q[64];
        { const bf16_t* qp = qkv + (size_t)row * 3072 + h * 64;
#pragma unroll
          for (int j = 0; j < 8; ++j) { const u32x4 w = *(const u32x4*)(qp + 8 * j);
#pragma unroll
              for (int e = 0; e < 4; ++e) { q[8 * j + 2 * e] = bf2f(w[e] & 0xffffu); q[8 * j + 2 * e + 1] = bf2f(w[e] >> 16); } } }
        float sc[6];
#pragma unroll
        for (int i = 0; i < 2; ++i) {
            if (lat) { const int kk = lane + 64 * i, kr = rs + (kk >> 4), kc = wst + (kk & 15);
                sc[i] = dot64(q, qkv + (size_t)(b * 4096 + kr * 64 + kc) * 3072 + 1024 + h * 64) + rpb[(h * 15 + (kr - r + 7)) * 31 + (kc - qc + 15)]; }
            else sc[i] = -1e30f; }
#pragma unroll
        for (int i = 0; i < 4; ++i) { const int j = lane + 64 * i; sc[2 + i] = dot64(q, qkv + (size_t)(NLAT + b * 256 + j) * 3072 + 1024 + h * 64); }
        float mx = sc[0];
#pragma unroll
        for (int i = 1; i < 6; ++i) mx = fmaxf(mx, sc[i]);
        mx = wave_max(mx);
        float sum = 0.f;
#pragma unroll
        for (int i = 0; i < 6; ++i) { sc[i] = expf(sc[i] - mx); sum += sc[i]; }
        sum = wave_sum(sum);
        float o = 0.f;
        if (lat) {
#pragma unroll
            for (int i = 0; i < 2; ++i)
                for (int l = 0; l < 64; ++l) { const float pk = __shfl(sc[i], l); const int kk = l + 64 * i, kr = rs + (kk >> 4), kc = wst + (kk & 15);
                    o += pk * bf2f(qkv[(size_t)(b * 4096 + kr * 64 + kc) * 3072 + 2048 + h * 64 + lane]); } }
#pragma unroll
        for (int i = 0; i < 4; ++i)
            for (int l = 0; l < 64; ++l) { const float pk = __shfl(sc[2 + i], l); const int j = l + 64 * i;
                o += pk * bf2f(qkv[(size_t)(NLAT + b * 256 + j) * 3072 + 2048 + h * 64 + lane]); }
        ao[(size_t)row * 1024 + h * 64 + lane] = (bf16_t)f2bf(o / sum);
    }
}
__device__ __forceinline__ void phase_lnstats(const bf16_t* vb, float* stats, int M, const Tix T_) {
    const int lane = T_.tid & 63, gw = T_.bid * 8 + (T_.tid >> 6), NGW = T_.gsz * 8;
    for (int row = gw; row < M; row += NGW) {
        const bf16_t* vp = vb + (size_t)row * 3072 + lane * 8;
        float v[48]; float s = 0.f;
#pragma unroll
        for (int j = 0; j < 6; ++j) { const u32x4 w = *(const u32x4*)(vp + 512 * j);
#pragma unroll
            for (int e = 0; e < 4; ++e) { v[8 * j + 2 * e] = bf2f(w[e] & 0xffffu); v[8 * j + 2 * e + 1] = bf2f(w[e] >> 16); } }
#pragma unroll
        for (int i = 0; i < 48; ++i) s += v[i];
        const float mean = wave_sum(s) * (1.0f / 3072.0f);
        float q = 0.f;
#pragma unroll
        for (int i = 0; i < 48; ++i) { const float d = v[i] - mean; q += d * d; }
        q = wave_sum(q) * (1.0f / 3072.0f);
        if (lane == 0) { stats[2 * row] = mean; stats[2 * row + 1] = 1.0f / sqrtf(q + 1e-6f); }
    }
}
__device__ __forceinline__ void phase_spatial_naive(const Params& p, int sl, int M, LAS unsigned char* lds, const Tix T_) {
    bf16_t* vb = (bf16_t*)(p.ws + OFF_BIG); const float* stats = (const float*)(p.ws + OFF_STATS);
    LAS float* V = (LAS float*)lds;
    LAS float* Wl = (LAS float*)(lds + 65536);
    const float* lng = p.sg_ln_g + sl * 3072; const float* lnb = p.sg_ln_b + sl * 3072;
    const int tid = T_.tid;
    const int nunits = (M / 128) * 24;
    for (int u = T_.bid; u < nunits; u += T_.gsz) {
        const int nc = u / 24, g = u % 24, r0 = nc * 128;
        const float* Wg = p.sg_w_s + ((size_t)sl * 24 + g) * 16384;
        for (int i = 0; i < 32; ++i) { const int idx = tid + 512 * i, q = idx >> 7, c = idx & 127;
            const float val = bf2f(vb[(size_t)(r0 + q) * 3072 + g * 128 + c]);
            V[idx] = (val - stats[2 * (r0 + q)]) * stats[2 * (r0 + q) + 1] * lng[g * 128 + c] + lnb[g * 128 + c];
            Wl[idx] = Wg[idx]; }
        __syncthreads();
        const int c = tid & 127, pg = tid >> 7;
        float acc[32];
#pragma unroll
        for (int i = 0; i < 32; ++i) acc[i] = 0.f;
        for (int q = 0; q < 128; ++q) { const float vv = V[q * 128 + c];
#pragma unroll
            for (int i = 0; i < 32; ++i) acc[i] += Wl[(pg * 32 + i) * 128 + q] * vv; }
        __syncthreads();
#pragma unroll
        for (int i = 0; i < 32; ++i) { const int pp = pg * 32 + i; vb[(size_t)(r0 + pp) * 3072 + g * 128 + c] = (bf16_t)f2bf(acc[i] + p.sg_b_s[((size_t)sl * 24 + g) * 128 + pp]); }
    }
}


typedef short s16x4 __attribute__((ext_vector_type(4)));
typedef short s16x8 __attribute__((ext_vector_type(8)));
typedef float f32x16 __attribute__((ext_vector_type(16)));
typedef __bf16 bf16x2_t __attribute__((ext_vector_type(2)));
__device__ __forceinline__ unsigned pkb(float a, float b) { const f32x2 v = {a, b}; const bf16x2_t r = __builtin_convertvector(v, bf16x2_t); return __builtin_bit_cast(unsigned, r); }
__device__ __forceinline__ s16x8 pack8(float a0, float a1, float a2, float a3, float a4, float a5, float a6, float a7) {
    u32x4 w; w.x = pkb(a0, a1); w.y = pkb(a2, a3); w.z = pkb(a4, a5); w.w = pkb(a6, a7); return __builtin_bit_cast(s16x8, w); }
__device__ __forceinline__ s16x8 tr_pair(const LAS unsigned char* a0, int second_off) {
    const s16x4 a = __builtin_amdgcn_ds_read_tr16_b64_v4i16((LAS s16x4*)a0);
    const s16x4 b = __builtin_amdgcn_ds_read_tr16_b64_v4i16((LAS s16x4*)(a0 + second_off));
    s16x8 r; r[0] = a[0]; r[1] = a[1]; r[2] = a[2]; r[3] = a[3]; r[4] = b[0]; r[5] = b[1]; r[6] = b[2]; r[7] = b[3]; return r; }
#define MFMA32(a, b, c) __builtin_amdgcn_mfma_f32_32x32x16_bf16((a), (b), (c), 0, 0, 0)

constexpr int AV_STR = 144;
__device__ __forceinline__ void attn_one_tile(const s16x8 (&Kf)[4], const s16x8 (&Qf)[4], const LAS unsigned char* Vl, const LAS float* tab, f32x16& O0, f32x16& O1, float& lsum,
                                              int kt, int ntl, int r, int rs, int qcol, int wst, float mb, int hi, int tr_q, int tr_p, int dgrp) {
    f32x16 S;
#pragma unroll
    for (int i = 0; i < 16; ++i) S[i] = 0.f;
#pragma unroll
    for (int ks = 0; ks < 4; ++ks) S = MFMA32(Kf[ks], Qf[ks], S);
    float pv[16];
    if (kt < ntl) {
        const int kr = rs + (kt >> 1), rb = (kr - r + 7) * 31, cbase = 32 * (kt & 1) + 4 * hi;
#pragma unroll
        for (int j = 0; j < 4; ++j)
#pragma unroll
            for (int i = 0; i < 4; ++i) { const int kcol = cbase + 8 * j + i; const bool valid = (unsigned)(kcol - wst) < 16u;
                const int delta = min(max(kcol - qcol + 15, 0), 30);
                const float e = __expf(S[4 * j + i] + tab[rb + delta] - mb); pv[4 * j + i] = valid ? e : 0.f; }
    } else {
#pragma unroll
        for (int i = 0; i < 16; ++i) pv[i] = __expf(S[i] - mb);
    }
#pragma unroll
    for (int i = 0; i < 16; ++i) lsum += pv[i];
    const s16x8 P0 = pack8(pv[0], pv[1], pv[2], pv[3], pv[4], pv[5], pv[6], pv[7]);
    const s16x8 P1 = pack8(pv[8], pv[9], pv[10], pv[11], pv[12], pv[13], pv[14], pv[15]);
    const LAS unsigned char* vb = Vl + (kt * 32 + 4 * hi + tr_q) * AV_STR + (16 * dgrp + 4 * tr_p) * 2;
    const s16x8 V00 = tr_pair(vb, 8 * AV_STR), V01 = tr_pair(vb + 64, 8 * AV_STR);
    const s16x8 V10 = tr_pair(vb + 16 * AV_STR, 8 * AV_STR), V11 = tr_pair(vb + 16 * AV_STR + 64, 8 * AV_STR);
    O0 = MFMA32(V00, P0, O0); O1 = MFMA32(V01, P0, O1); O0 = MFMA32(V10, P1, O0); O1 = MFMA32(V11, P1, O1);
}
__device__ __forceinline__ void attn_load_k(s16x8 (&Kf)[4], const bf16_t* kbase, int klat0, int kctx0, int kt, int ntl, int rs) {
    const size_t grow = kt < ntl ? (size_t)(klat0 + (rs + (kt >> 1)) * 64 + 32 * (kt & 1)) : (size_t)(kctx0 + 32 * (kt - ntl));
#pragma unroll
    for (int ks = 0; ks < 4; ++ks) Kf[ks] = *(const s16x8*)(kbase + grow * 3072 + 16 * ks);
}

__device__ __forceinline__ void phase_attn_mfma(const Params& p, int a, bool ctx_q, LAS unsigned char* lds, const Tix T_) {
    const bf16_t* qkv = (const bf16_t*)(p.ws + OFF_BIG); bf16_t* ao = (bf16_t*)(p.ws + OFF_BIG) + (size_t)MTOT * 3072;
    const float* rpb = p.na_rpb + (size_t)a * 16 * 15 * 31;
    const int tid = T_.tid, lane = tid & 63, wave = __builtin_amdgcn_readfirstlane(tid >> 6), qt = wave & 1, kq = wave >> 1, l31 = lane & 31, hi = lane >> 5;
    LAS unsigned char* Vl = lds;
    LAS float* Ored = (LAS float*)lds;
    LAS float* lred = (LAS float*)(lds + 69632);
    LAS float* tab = (LAS float*)(lds + 110592);
    LAS float* misc = (LAS float*)(lds + 110592 + 2048);
    float mb;
    { float m = 0.f; for (int i = tid; i < 7440; i += NTHREADS) m = fmaxf(m, rpb[i]);
      float qg = 0.f, kg = 0.f; if (tid < 64) { qg = fabsf(p.na_q_norm[a * 64 + tid]); kg = fabsf(p.na_k_norm[a * 64 + tid]); }
      m = wave_max(m); qg = wave_max(qg); kg = wave_max(kg);
      if (lane == 0) { misc[wave] = m; if (wave == 0) { misc[8] = qg; misc[9] = kg; } }
      __syncthreads();
      float rm = misc[0];
#pragma unroll
      for (int w = 1; w < 8; ++w) rm = fmaxf(rm, misc[w]);
      mb = 8.0f * misc[8] * misc[9] + rm; }
    const int nlatu = 8 * 64 * 16, nctxu = ctx_q ? 8 * 4 * 16 : 0;
    const int tr_q = (lane & 15) >> 2, tr_p = lane & 3, dgrp = (lane >> 4) & 1;
    for (int u = T_.bid; u < nlatu + nctxu; u += T_.gsz) {
        int b, h, qrow0, r = 0, rs = 0, ntl, ntiles;
        if (u < nlatu) { h = u & 15; const int br = u >> 4; r = br & 63; b = br >> 6; qrow0 = b * 4096 + r * 64; rs = min(max(r - 4, 0), 56); ntl = 16; ntiles = 24; }
        else { const int v = u - nlatu; h = v & 15; const int bq = v >> 4; b = bq >> 2; qrow0 = NLAT + b * 256 + (bq & 3) * 64; ntl = 0; ntiles = 8; }
        for (int idx = tid; idx < ntiles * 256; idx += NTHREADS) { const int key = idx >> 3, ch = idx & 7, kt = key >> 5, kk = key & 31;
            const size_t grow = kt < ntl ? (size_t)(b * 4096 + (rs + (kt >> 1)) * 64 + 32 * (kt & 1) + kk) : (size_t)(NLAT + b * 256 + 32 * (kt - ntl) + kk);
            const u32x4 w = *(const u32x4*)(qkv + grow * 3072 + 2048 + h * 64 + ch * 8);
            *(LAS u32x4*)(Vl + key * AV_STR + ch * 16) = w; }
        if (tid < 465) tab[tid] = rpb[h * 465 + tid];
        s16x8 Qf[4];
        { const bf16_t* qp = qkv + (size_t)(qrow0 + 32 * qt + l31) * 3072 + h * 64 + 8 * hi;
#pragma unroll
          for (int ks = 0; ks < 4; ++ks) Qf[ks] = *(const s16x8*)(qp + 16 * ks); }
        const bf16_t* kbase = qkv + 1024 + h * 64 + 8 * hi;
        const int klat0 = b * 4096 + l31, kctx0 = NLAT + b * 256 + l31;
        const int ntw = ntiles >> 2, t0 = kq * ntw;
        s16x8 KA[4], KB[4];
        attn_load_k(KA, kbase, klat0, kctx0, t0, ntl, rs); attn_load_k(KB, kbase, klat0, kctx0, t0 + 1, ntl, rs);
        __syncthreads();
        f32x16 O0, O1;
#pragma unroll
        for (int i = 0; i < 16; ++i) { O0[i] = 0.f; O1[i] = 0.f; }
        float lsum = 0.f;
        const int qcol = 32 * qt + l31, wst = min(max(qcol - 8, 0), 48);
#pragma unroll 1
        for (int t = 0; t < ntw; t += 2) {
            s16x8 KN[4];
            const int kn = t0 + min(t + 2, ntw - 2);
            attn_load_k(KN, kbase, klat0, kctx0, kn, ntl, rs);
            attn_one_tile(KA, Qf, Vl, tab, O0, O1, lsum, t0 + t, ntl, r, rs, qcol, wst, mb, hi, tr_q, tr_p, dgrp);
#pragma unroll
            for (int ks = 0; ks < 4; ++ks) KA[ks] = KN[ks];
            attn_load_k(KN, kbase, klat0, kctx0, kn + 1, ntl, rs);
            attn_one_tile(KB, Qf, Vl, tab, O0, O1, lsum, t0 + t + 1, ntl, r, rs, qcol, wst, mb, hi, tr_q, tr_p, dgrp);
#pragma unroll
            for (int ks = 0; ks < 4; ++ks) KB[ks] = KN[ks];
        }
        __syncthreads();
#pragma unroll
        for (int j = 0; j < 4; ++j) {
            *(LAS f32x4*)(Ored + (size_t)((kq * 64 + 32 * qt + l31) * 68 + 8 * j + 4 * hi)) = (f32x4){O0[4 * j], O0[4 * j + 1], O0[4 * j + 2], O0[4 * j + 3]};
            *(LAS f32x4*)(Ored + (size_t)((kq * 64 + 32 * qt + l31) * 68 + 32 + 8 * j + 4 * hi)) = (f32x4){O1[4 * j], O1[4 * j + 1], O1[4 * j + 2], O1[4 * j + 3]}; }
        lred[(kq * 2 + hi) * 64 + 32 * qt + l31] = lsum;
        __syncthreads();
        { const int q = tid >> 3, d8 = (tid & 7) * 8;
          f32x4 s0 = (f32x4){0.f, 0.f, 0.f, 0.f}, s1 = s0; float l = 0.f;
#pragma unroll
          for (int k = 0; k < 4; ++k) { s0 += *(const LAS f32x4*)(Ored + (k * 64 + q) * 68 + d8); s1 += *(const LAS f32x4*)(Ored + (k * 64 + q) * 68 + d8 + 4); l += lred[(k * 2) * 64 + q] + lred[(k * 2 + 1) * 64 + q]; }
          const float inv = 1.0f / l;
          u32x4 o; o.x = pkb(s0.x * inv, s0.y * inv); o.y = pkb(s0.z * inv, s0.w * inv); o.z = pkb(s1.x * inv, s1.y * inv); o.w = pkb(s1.z * inv, s1.w * inv);
          *(u32x4*)(ao + (size_t)(qrow0 + q) * 1024 + h * 64 + d8) = o; }
        __syncthreads();
    }
}

constexpr int SP_RS = 320;
__device__ __forceinline__ void phase_spatial_mfma(const Params& p, int sl, int M, LAS unsigned char* lds, const Tix T_) {
    bf16_t* vb = (bf16_t*)(p.ws + OFF_BIG); const float* stats = (const float*)(p.ws + OFF_STATS);
    const float* lng = p.sg_ln_g + sl * 3072; const float* lnb = p.sg_ln_b + sl * 3072;
    const int tid = T_.tid, lane = tid & 63, wave = __builtin_amdgcn_readfirstlane(tid >> 6), pt = wave & 3, cth = wave >> 2, l31 = lane & 31, hi = lane >> 5;
    const int tr_q = (lane & 15) >> 2, tr_p = lane & 3, dgrp = (lane >> 4) & 1;
    const int nunits = (M / 128) * 24;
    for (int u = T_.bid; u < nunits; u += T_.gsz) {
        const int nc = u / 24, g = u % 24, r0 = nc * 128;
#pragma unroll
        for (int i = 0; i < 4; ++i) { const int idx = tid + NTHREADS * i, q = idx >> 4, c8 = (idx & 15) * 8;
            const u32x4 w = *(const u32x4*)(vb + (size_t)(r0 + q) * 3072 + g * 128 + c8);
            const float mean = stats[2 * (r0 + q)], rstd = stats[2 * (r0 + q) + 1];
            const f32x4 g0 = *(const f32x4*)(lng + g * 128 + c8), g1 = *(const f32x4*)(lng + g * 128 + c8 + 4), b0 = *(const f32x4*)(lnb + g * 128 + c8), b1 = *(const f32x4*)(lnb + g * 128 + c8 + 4);
            u32x4 o;
            o.x = pkb((bf2f(w.x & 0xffffu) - mean) * rstd * g0.x + b0.x, (bf2f(w.x >> 16) - mean) * rstd * g0.y + b0.y);
            o.y = pkb((bf2f(w.y & 0xffffu) - mean) * rstd * g0.z + b0.z, (bf2f(w.y >> 16) - mean) * rstd * g0.w + b0.w);
            o.z = pkb((bf2f(w.z & 0xffffu) - mean) * rstd * g1.x + b1.x, (bf2f(w.z >> 16) - mean) * rstd * g1.y + b1.y);
            o.w = pkb((bf2f(w.w & 0xffffu) - mean) * rstd * g1.z + b1.z, (bf2f(w.w >> 16) - mean) * rstd * g1.w + b1.w);
            *(LAS u32x4*)(lds + q * SP_RS + c8 * 2) = o; }
        const float* wp = p.sg_w_s + ((size_t)sl * 24 + g) * 16384 + (32 * pt + l31) * 128 + 8 * hi;
        s16x8 Wf[8];
#pragma unroll
        for (int ks = 0; ks < 8; ++ks) { const f32x4 x = *(const f32x4*)(wp + 16 * ks), y = *(const f32x4*)(wp + 16 * ks + 4); Wf[ks] = pack8(x.x, x.y, x.z, x.w, y.x, y.y, y.z, y.w); }
        const float bs = p.sg_b_s[((size_t)sl * 24 + g) * 128 + 32 * pt + l31];
        __syncthreads();
#pragma unroll
        for (int cc = 0; cc < 2; ++cc) { const int ct = 2 * cth + cc;
            f32x16 acc;
#pragma unroll
            for (int i = 0; i < 16; ++i) acc[i] = 0.f;
            const LAS unsigned char* ab = lds + (8 * hi + tr_q) * SP_RS + (32 * ct + 16 * dgrp + 4 * tr_p) * 2;
#pragma unroll
            for (int ks = 0; ks < 8; ++ks) { const s16x8 Af = tr_pair(ab + 16 * ks * SP_RS, 4 * SP_RS); acc = MFMA32(Af, Wf[ks], acc); }
            bf16_t* orow = vb + (size_t)(r0 + 32 * pt + l31) * 3072 + g * 128 + 32 * ct + 4 * hi;
#pragma unroll
            for (int j = 0; j < 4; ++j) { u32x2 o; o.x = pkb(acc[4 * j] + bs, acc[4 * j + 1] + bs); o.y = pkb(acc[4 * j + 2] + bs, acc[4 * j + 3] + bs); *(u32x2*)(orow + 8 * j) = o; }
        }
        __syncthreads();
    }
}

template <class F> struct EpiG {
    static constexpr bool PERM = false, AFTER_DRAIN = false;
    F f;
    __device__ __forceinline__ void operator()(const f32x4 (&acc)[2][2][4][2], const Unit& u, int wr, int wc, int fr, int fq) const {
#pragma unroll
        for (int ai = 0; ai < 2; ++ai)
#pragma unroll
            for (int m = 0; m < 4; ++m) { const int row = u.pm * 256 + ai * 128 + wr * 64 + m * 16 + fr;
#pragma unroll
                for (int bj = 0; bj < 2; ++bj) { const int col = u.pn * 256 + 64 * wc + 32 * bj + 8 * fq; f(row, col, acc[ai][bj][m][0], acc[ai][bj][m][1]); }
                asm volatile("" ::: "memory"); }
    }
};
__device__ __forceinline__ void store8_bf16(bf16_t* o, const f32x4 a, const f32x4 b) { u32x4 w; w.x = pk2(a.x, a.y); w.y = pk2(a.z, a.w); w.z = pk2(b.x, b.y); w.w = pk2(b.z, b.w); *(u32x4*)o = w; }
struct EStore { bf16_t* O; int ldo;
    __device__ __forceinline__ void operator()(int row, int col, f32x4 a, f32x4 b) const { store8_bf16(O + (size_t)row * ldo + col, a, b); } };
struct ESqrelu { bf16_t* O; int ldo;
    __device__ __forceinline__ void operator()(int row, int col, f32x4 a, f32x4 b) const {
#pragma unroll
        for (int i = 0; i < 4; ++i) { const float x = fmaxf(a[i], 0.f), y = fmaxf(b[i], 0.f); a[i] = x * x; b[i] = y * y; }
        store8_bf16(O + (size_t)row * ldo + col, a, b); } };
struct EGeluBias { bf16_t* O; int ldo; const float* bias;
    __device__ __forceinline__ void operator()(int row, int col, f32x4 a, f32x4 b) const {
        const f32x4 b0 = *(const f32x4*)(bias + col), b1 = *(const f32x4*)(bias + col + 4);
        a = gelu4(a + b0); b = gelu4(b + b1);
        store8_bf16(O + (size_t)row * ldo + col, a, b); } };
struct EGeluGate { bf16_t* O; int ldo; const float* bias;
    __device__ __forceinline__ void operator()(int row, int col, f32x4 a, f32x4 b) const {
        const f32x4 b0 = *(const f32x4*)(bias + col), b1 = *(const f32x4*)(bias + col + 4);
        bf16_t* op = O + (size_t)row * ldo + col; const u32x4 sv = *(const u32x4*)op;
        a = gelu4(a + b0); b = gelu4(b + b1);
        a.x *= bf2f(sv.x & 0xffffu); a.y *= bf2f(sv.x >> 16); a.z *= bf2f(sv.y & 0xffffu); a.w *= bf2f(sv.y >> 16);
        b.x *= bf2f(sv.z & 0xffffu); b.y *= bf2f(sv.z >> 16); b.z *= bf2f(sv.w & 0xffffu); b.w *= bf2f(sv.w >> 16);
        store8_bf16(op, a, b); } };
struct EResid { const float* inl; const float* inc; float* outl; float* outc; const float* gate;
    __device__ __forceinline__ void operator()(int row, int col, f32x4 a, f32x4 b) const {
        const bool lat = row < NLAT; const int bb = lat ? (row >> 12) : 8;
        const float* ip = lat ? inl + (size_t)row * 1024 + col : inc + (size_t)(row - NLAT) * 1024 + col;
        float* op = lat ? outl + (size_t)row * 1024 + col : outc + (size_t)(row - NLAT) * 1024 + col;
        const f32x4 g0 = *(const f32x4*)(gate + (size_t)bb * 6144 + col), g1 = *(const f32x4*)(gate + (size_t)bb * 6144 + col + 4);
        const f32x4 x0 = *(const f32x4*)ip, x1 = *(const f32x4*)(ip + 4);
        *(f32x4*)op = x0 + g0 * a; *(f32x4*)(op + 4) = x1 + g1 * b; } };

struct EpiQKV {
    static constexpr bool PERM = false, AFTER_DRAIN = false;
    bf16_t* O; const float* qg; const float* kg;
    __device__ __forceinline__ void operator()(const f32x4 (&acc)[2][2][4][2], const Unit& u, int wr, int wc, int fr, int fq) const {
        const int sect = u.pn >> 2;
        const int colb = u.pn * 256 + 64 * wc + 8 * fq;
        f32x4 g[2][2];
        if (sect < 2) { const float* gp = (sect == 0 ? qg : kg) + 8 * fq; const float mul = sect == 0 ? 0.125f : 1.0f;
#pragma unroll
            for (int bj = 0; bj < 2; ++bj) { g[bj][0] = *(const f32x4*)(gp + 32 * bj) * mul; g[bj][1] = *(const f32x4*)(gp + 32 * bj + 4) * mul; } }
#pragma unroll
        for (int ai = 0; ai < 2; ++ai)
#pragma unroll
            for (int m = 0; m < 4; ++m) { const int row = u.pm * 256 + ai * 128 + wr * 64 + m * 16 + fr;
                f32x4 v[2][2];
#pragma unroll
                for (int bj = 0; bj < 2; ++bj) { v[bj][0] = acc[ai][bj][m][0]; v[bj][1] = acc[ai][bj][m][1]; }
                if (sect < 2) { float ss = 0.f;
#pragma unroll
                    for (int bj = 0; bj < 2; ++bj)
#pragma unroll
                        for (int n = 0; n < 2; ++n) { const f32x4 x = v[bj][n]; ss += (x.x * x.x + x.y * x.y) + (x.z * x.z + x.w * x.w); }
                    ss += __shfl_xor(ss, 16); ss += __shfl_xor(ss, 32);
                    const float rstd = 1.0f / sqrtf(ss * (1.0f / 64.0f) + 1e-6f);
#pragma unroll
                    for (int bj = 0; bj < 2; ++bj)
#pragma unroll
                        for (int n = 0; n < 2; ++n) v[bj][n] = v[bj][n] * rstd * g[bj][n]; }
#pragma unroll
                for (int bj = 0; bj < 2; ++bj) store8_bf16(O + (size_t)row * 3072 + colb + 32 * bj, v[bj][0], v[bj][1]);
                asm volatile("" ::: "memory"); }
    }
};

template <class F> __device__ __forceinline__ void run_gemm(LAS unsigned char* lds, const bf16_t* A, const bf16_t* Bt, int M, int N, int K, const F& f, const Tix T_) {
    pg8::StaticOrder S; S.init(M, N, T_.gsz, T_.bid);
    pg8::Gemm g; g.A = A; g.Bt = Bt; g.M = M; g.N = N; g.K = K;
    EpiG<F> E; E.f = f;
    pg8::gemm_phase<EpiG<F>, pg8::StaticOrder, true, true>(lds, g, S, E, T_.tid);
}

enum { OP_NORM1, OP_NORM2, OP_QKV, OP_HEADNORM, OP_ATTN, OP_MIXOUT, OP_MLP1, OP_MLP2, OP_VGEMM, OP_LNSTATS, OP_SPATIAL, OP_UGEMM, OP_PROLOGUE };

__device__ __forceinline__ void decode_phase(int ph, int& L, int& op) {
    L = 0; op = OP_PROLOGUE;
    if (ph > 0) {
        int q = ph - 1;
        if (q < 7) { L = 0; } else if (q < 16) { L = 1; q -= 7; } else if (q < 23) { L = 2; q -= 16; } else { L = 3; q -= 23; }
        if ((L & 1) == 0) op = q == 0 ? OP_NORM1 : q == 1 ? OP_QKV : q == 2 ? OP_ATTN : q == 3 ? OP_MIXOUT : q == 4 ? OP_NORM2 : q == 5 ? OP_MLP1 : OP_MLP2;
        else op = q == 0 ? OP_NORM1 : q == 1 ? OP_VGEMM : q == 2 ? OP_LNSTATS : q == 3 ? OP_SPATIAL : q == 4 ? OP_UGEMM : q == 5 ? OP_MIXOUT : q == 6 ? OP_NORM2 : q == 7 ? OP_MLP1 : OP_MLP2;
    }
}

__device__ __forceinline__ void run_phase(const Params& p, int ph, LAS unsigned char* lds, const Tix T_) {
    int L, op; decode_phase(ph, L, op);
#ifdef ONLY_OP
    op = ONLY_OP;
#endif
    const int mi = L >> 1;
    const bool attnL = (L & 1) == 0;
    const int Mfull = L < 2 ? MTOT : NLAT;
    float* mods = (float*)(p.ws + OFF_MODS); const float* modsl = mods + (size_t)L * 9 * 6144;
    float* ctxr = (float*)(p.ws + OFF_CTXR);
    bf16_t* hb = (bf16_t*)(p.ws + OFF_HB); bf16_t* big = (bf16_t*)(p.ws + OFF_BIG);
    const bool first = (L == 0);
    switch (op) {
    case OP_PROLOGUE: phase_mods(p, lds, T_); __syncthreads(); phase_convert(p, lds, T_); break;
    case OP_NORM1: phase_normmod(first ? p.x : p.out, first ? p.ctx : ctxr, hb, p.norm1_g + L * 1024, modsl, 0, 1024, L <= 2 ? MTOT : NLAT, T_); break;
    case OP_NORM2: phase_normmod(p.out, ctxr, hb, p.norm2_g + L * 1024, modsl, 3072, 4096, Mfull, T_); break;
    case OP_QKV: { pg8::StaticOrder S; S.init(MTOT, 3072, T_.gsz, T_.bid);
        pg8::Gemm g; g.A = hb; g.Bt = (const bf16_t*)(p.ws + OFF_QKVT) + (size_t)mi * 3072 * 1024; g.M = MTOT; g.N = 3072; g.K = 1024;
        EpiQKV E; E.O = big; E.qg = p.na_q_norm + mi * 64; E.kg = p.na_k_norm + mi * 64;
        pg8::gemm_phase<EpiQKV, pg8::StaticOrder, true, true>(lds, g, S, E, T_.tid); } break;
    #if NAIVE_ATTN
    case OP_ATTN: phase_attn_naive(p, mi, L == 0, T_); break;
#else
    case OP_ATTN: phase_attn_mfma(p, mi, L == 0, lds, T_); break;
#endif
    case OP_MIXOUT: case OP_MLP2: {
        EResid f; const bool mo = (op == OP_MIXOUT);
        f.inl = (first && mo) ? p.x : p.out; f.inc = (first && mo) ? p.ctx : ctxr; f.outl = p.out; f.outc = ctxr; f.gate = modsl + (mo ? 2048 : 5120);
        const bf16_t* A; const bf16_t* Bt; int K;
        if (!mo) { A = big; Bt = (const bf16_t*)(p.ws + OFF_W2T) + (size_t)L * 1024 * 4096; K = 4096; }
        else if (attnL) { A = big + (size_t)MTOT * 3072; Bt = (const bf16_t*)(p.ws + OFF_WOT) + (size_t)mi * 1024 * 1024; K = 1024; }
        else { A = big; Bt = (const bf16_t*)(p.ws + OFF_SGOT) + (size_t)mi * 1024 * 3072; K = 3072; }
        run_gemm(lds, A, Bt, Mfull, 1024, K, f, T_); } break;
    case OP_MLP1: { ESqrelu f; f.O = big; f.ldo = 4096; run_gemm(lds, hb, (const bf16_t*)(p.ws + OFF_W1T) + (size_t)L * 4096 * 1024, Mfull, 4096, 1024, f, T_); } break;
    case OP_VGEMM: { EGeluBias f; f.O = big; f.ldo = 3072; f.bias = p.sg_b_in + mi * 6144 + 3072;
        run_gemm(lds, hb, (const bf16_t*)(p.ws + OFF_WINT) + (size_t)mi * 6144 * 1024 + (size_t)3072 * 1024, Mfull, 3072, 1024, f, T_); } break;
    case OP_LNSTATS: phase_lnstats(big, (float*)(p.ws + OFF_STATS), Mfull, T_); break;
    #if NAIVE_SPATIAL
    case OP_SPATIAL: phase_spatial_naive(p, mi, Mfull, lds, T_); break;
#else
    case OP_SPATIAL: phase_spatial_mfma(p, mi, Mfull, lds, T_); break;
#endif
    case OP_UGEMM: { EGeluGate f; f.O = big; f.ldo = 3072; f.bias = p.sg_b_in + mi * 6144;
        run_gemm(lds, hb, (const bf16_t*)(p.ws + OFF_WINT) + (size_t)mi * 6144 * 1024, Mfull, 3072, 1024, f, T_); } break;
    default: break;
    }
}

#ifndef NAIVE_ATTN
#define NAIVE_ATTN 0
#endif
#ifndef NAIVE_SPATIAL
#define NAIVE_SPATIAL 0
#endif
#ifndef ONE_LAUNCH
#define ONE_LAUNCH 1
#endif
__global__ void __launch_bounds__(NTHREADS) mk(Params p0) {
    extern __shared__ __attribute__((aligned(16))) unsigned char lds_raw[];
    LAS unsigned char* lds = (LAS unsigned char*)lds_raw;
#if ONE_LAUNCH
    cg::grid_group grid = cg::this_grid();
    bool first_it = true, repeated = false;
    for (int ph = p0.ph_lo; ph < p0.ph_hi; ) {
        if (!first_it) grid.sync();
        first_it = false;
        Tix T_; T_.tid = threadIdx.x; T_.bid = blockIdx.x; T_.gsz = gridDim.x;
        size_t z = 0;
        asm volatile("" : "+v"(T_.tid)); asm volatile("" : "+s"(T_.bid), "+s"(T_.gsz), "+s"(z));
        Params p = p0;
        { const float** pp = (const float**)&p;
#pragma unroll
          for (int i = 0; i < 22; ++i) pp[i] += z; }
        p.out += z; p.ws += z;
        run_phase(p, ph, lds, T_);
        __syncthreads();
        if (REP_MASK != 0) { int L_, op_; decode_phase(ph, L_, op_); if (((REP_MASK >> op_) & 1) && !repeated) { repeated = true; continue; } }
        repeated = false; ++ph;
    }
#else
    Tix T_; T_.tid = threadIdx.x; T_.bid = blockIdx.x; T_.gsz = gridDim.x;
    run_phase(p0, p0.ph_lo, lds, T_);
#endif
}

extern "C" void kernel_launch(void* const* d_in, const int* in_sizes, int n_in, void* d_out, int out_size, void* d_ws, size_t ws_size, hipStream_t stream) {
    static int grid = 0;
    if (grid == 0) {
        if (n_in != 22 || ws_size < WS_END) { fprintf(stderr, "kernel_launch: unexpected n_in %d or ws_size %zu (< %zu)\n", n_in, ws_size, (size_t)WS_END); grid = -1; return; }
        int dev = 0, cus = 0, per_cu = 0;
        hipGetDevice(&dev); hipDeviceGetAttribute(&cus, hipDeviceAttributeMultiprocessorCount, dev);
        if (hipFuncSetAttribute((const void*)mk, hipFuncAttributeMaxDynamicSharedMemorySize, LDS_BYTES) != hipSuccess) { fprintf(stderr, "kernel_launch: hipFuncSetAttribute failed\n"); grid = -1; return; }
        if (hipOccupancyMaxActiveBlocksPerMultiprocessor(&per_cu, (const void*)mk, NTHREADS, LDS_BYTES) != hipSuccess || per_cu < 1) { fprintf(stderr, "kernel_launch: occupancy query says %d\n", per_cu); per_cu = 1; }
        (void)hipGetLastError();
        grid = cus;
    }
    if (grid < 0) return;
    Params p{};
    const float** pp = (const float**)&p;
    for (int i = 0; i < 22; ++i) pp[i] = (const float*)d_in[i];
    p.out = (float*)d_out; p.ws = (unsigned char*)d_ws;
#if ONE_LAUNCH
    p.ph_lo = 0; p.ph_hi = NPH;
    void* args[] = {&p};
    hipError_t e = hipLaunchCooperativeKernel((void*)mk, dim3(grid), dim3(NTHREADS), args, LDS_BYTES, stream);
    if (e != hipSuccess) fprintf(stderr, "cooperative launch failed: %s (grid %d)\n", hipGetErrorString(e), grid);
#else
    for (int ph = 0; ph < NPH; ++ph) { p.ph_lo = ph; p.ph_hi = ph + 1; hipLaunchKernelGGL(mk, dim3(grid), dim3(NTHREADS), LDS_BYTES, stream, p); }
#endif
}
```

```cpp
#include <hip/hip_runtime.h>
#include <hip/hip_cooperative_groups.h>
#include <cstdio>
#include <cstdint>
namespace cg = cooperative_groups;
namespace pg8 {
#define PG8_LAS __attribute__((address_space(3)))
typedef unsigned short bf16_t;
typedef short bf16x8 __attribute__((ext_vector_type(8)));
typedef float f32x4 __attribute__((ext_vector_type(4)));
typedef unsigned u32x4 __attribute__((ext_vector_type(4)));
constexpr int BM = 256, BK = 64, HALF = 128, HTB = HALF * BK * 2  , STAGE_BYTES = 8 * HTB, NXCD = 8, WGM = 8;

__host__ __device__ __forceinline__ int lds_byte(int r, int c) { const int st = (r >> 4) * 2 + (c >> 5), rr = r & 15, cc = c & 31, ob = rr * 64 + cc * 2; return st * 1024 + (ob ^ (((ob >> 9) & 1) << 5)); }
__host__ __device__ __forceinline__ void stage_rc(int b, int& R, int& C) { const int st = b / 1024, sb = b % 1024, swz = sb ^ (((sb >> 9) & 1) << 5); R = (st >> 1) * 16 + swz / 64; C = (st & 1) * 32 + (swz % 64) / 2; }
__host__ __device__ __forceinline__ int perm32(int rho) { const int n = rho >> 4, i = rho & 15; return 8 * (i >> 2) + 4 * n + (i & 3); }

struct Unit { int pm, pn; };
struct Gemm { const bf16_t* A; const bf16_t* Bt; int M, N, K; };

struct StaticOrder {
    int nM, nN, nwg, G, c;
    __host__ __device__ void init(int M, int N, int G_, int c_) { nM = M / BM; nN = N / BM; nwg = nM * nN; G = G_; c = c_; }
    __host__ __device__ bool next(int i, Unit& u) const {
        const long L = (long)i * G + c; if (L >= nwg) return false;
        int wgid = (int)L; { const int q = nwg / NXCD, r = nwg % NXCD, xcd = wgid % NXCD, off = wgid / NXCD; wgid = (xcd < r ? xcd * (q + 1) : r * (q + 1) + (xcd - r) * q) + off; }
        const int nig = WGM * nN, gid = wgid / nig, fm = gid * WGM, gsz = (nM - fm) < WGM ? (nM - fm) : WGM;
        u.pm = fm + ((wgid % nig) % gsz); u.pn = (wgid % nig) / gsz; return true;
    }
    __device__ __forceinline__ void a_ready(const Unit&) const {}
    __device__ __forceinline__ void done(const Unit&) const {}
};

__device__ __forceinline__ unsigned cvt_pk_bf16(float lo, float hi) { unsigned r; asm volatile("v_cvt_pk_bf16_f32 %0, %1, %2" : "=v"(r) : "v"(lo), "v"(hi)); return r; }
template <class Epi, class Sched, bool ALIGN_EPI = false, bool SP2 = false>
__device__ __forceinline__ void gemm_phase(PG8_LAS unsigned char* lds, const Gemm g, const Sched& S, const Epi& E, const int tid_in) {
    const int tid = tid_in, wid = __builtin_amdgcn_readfirstlane(tid >> 6), lane = tid & 63, wr = wid >> 2, wc = wid & 3, fr = lane & 15, fq = lane >> 4;
    const int K = g.K, nt = K / BK;
    unsigned voffA[2], voffB[2];
#pragma unroll
    for (int i = 0; i < 2; ++i) { int R, C; stage_rc(tid * 16 + i * 8192, R, C); const int Rb = Epi::PERM ? ((R & ~31) + perm32(R & 31)) : R;
        voffA[i] = (unsigned)(R * K + C) * 2u; voffB[i] = (unsigned)(Rb * K + C) * 2u; }
    const size_t kstep = (size_t)(BK * 2);
    const size_t hstep = (size_t)HALF * K * 2;
    const size_t tstep = 2 * hstep;
    const unsigned ldsw = (unsigned)wid * 1024u;
    const int aoff = lds_byte(wr * 64 + fr, fq * 8), boff = lds_byte(wc * 32 + fr, fq * 8);
#define PG8_SA(b, h) (((b) * 2 + (h)) * HTB)
#define PG8_SB(b, h) ((4 + (b) * 2 + (h)) * HTB)
#define PG8_STAGE(bufoff, gbase, voff) do { _Pragma("unroll") for (int _i = 0; _i < 2; ++_i) \
        __builtin_amdgcn_global_load_lds((const unsigned*)((const char*)(gbase) + (voff)[_i]), (PG8_LAS unsigned*)(lds + (bufoff) + ldsw + _i * 8192), 16, 0, 0); } while (0)
#define PG8_LDA(dst, b, h) do { _Pragma("unroll") for (int m = 0; m < 4; ++m) _Pragma("unroll") for (int k = 0; k < 2; ++k) dst[m][k] = *(const PG8_LAS bf16x8*)(lds + PG8_SA(b, h) + aoff + m * 2048 + k * 1024); } while (0)
#define PG8_LDB(dst, b, h) do { _Pragma("unroll") for (int n = 0; n < 2; ++n) _Pragma("unroll") for (int k = 0; k < 2; ++k) dst[n][k] = *(const PG8_LAS bf16x8*)(lds + PG8_SB(b, h) + boff + n * 2048 + k * 1024); } while (0)
#define PG8_MMA(ai, bj, At, Bt) do { __builtin_amdgcn_s_setprio(1); _Pragma("unroll") for (int m = 0; m < 4; ++m) _Pragma("unroll") for (int n = 0; n < 2; ++n) _Pragma("unroll") for (int k = 0; k < 2; ++k) \
        acc[ai][bj][m][n] = __builtin_amdgcn_mfma_f32_16x16x32_bf16(Bt[n][k], At[m][k], acc[ai][bj][m][n], 0, 0, 0); __builtin_amdgcn_s_setprio(0); } while (0)
#define PG8_WAIT_V(n) asm volatile("s_waitcnt vmcnt(" #n ")" ::: "memory")
#define PG8_WAIT_L(n) asm volatile("s_waitcnt lgkmcnt(" #n ")" ::: "memory")
#define PG8_BAR __builtin_amdgcn_s_barrier()
#define PG8_SCHED __builtin_amdgcn_sched_barrier(0)
    Unit cur, nxt; int ui = 0;
    if (!S.next(0, cur)) return;
    f32x4 acc[2][2][4][2];
#pragma unroll
    for (int a = 0; a < 2; ++a)
#pragma unroll
        for (int b = 0; b < 2; ++b)
#pragma unroll
            for (int m = 0; m < 4; ++m)
#pragma unroll
                for (int n = 0; n < 2; ++n) acc[a][b][m][n] = (f32x4){0.f, 0.f, 0.f, 0.f};
    bf16x8 At[4][2], B0[2][2], B1[2][2];
    const char* cA = (const char*)g.A + (size_t)cur.pm * tstep; const char* cB = (const char*)g.Bt + (size_t)cur.pn * tstep;
    S.a_ready(cur);
    if constexpr (SP2) {
        PG8_STAGE(PG8_SB(0, 0), cB, voffB); PG8_STAGE(PG8_SB(0, 1), cB + hstep, voffB); PG8_STAGE(PG8_SA(0, 0), cA, voffA); PG8_STAGE(PG8_SA(0, 1), cA + hstep, voffA);
        if (wr == 1) PG8_BAR;
        PG8_WAIT_V(2); PG8_BAR;
        PG8_STAGE(PG8_SB(1, 0), cB + kstep, voffB); PG8_STAGE(PG8_SA(1, 0), cA + kstep, voffA); PG8_STAGE(PG8_SB(1, 1), cB + hstep + kstep, voffB);
        PG8_WAIT_V(6); PG8_BAR;
    } else {
        PG8_STAGE(PG8_SB(0, 0), cB, voffB); PG8_STAGE(PG8_SA(0, 0), cA, voffA); PG8_STAGE(PG8_SB(0, 1), cB + hstep, voffB); PG8_STAGE(PG8_SA(0, 1), cA + hstep, voffA);
        if (wr == 1) PG8_BAR;
        PG8_WAIT_V(4); PG8_BAR;
        PG8_STAGE(PG8_SB(1, 0), cB + kstep, voffB); PG8_STAGE(PG8_SA(1, 0), cA + kstep, voffA); PG8_STAGE(PG8_SB(1, 1), cB + hstep + kstep, voffB);
        PG8_WAIT_V(6); PG8_BAR;
    }
    for (;;) {
        const bool has_next = S.next(ui + 1, nxt);
        const char* nA = has_next ? (const char*)g.A + (size_t)nxt.pm * tstep : cA; const char* nB = has_next ? (const char*)g.Bt + (size_t)nxt.pn * tstep : cB;
        for (int t = 0; t < nt; t += 2) {
            const bool last = (t == nt - 2);
            const char* a1 = cA + (size_t)(t + 1) * kstep;
            const char* a2 = last ? nA : cA + (size_t)(t + 2) * kstep; const char* b2 = last ? nB : cB + (size_t)(t + 2) * kstep;
            const char* a3 = a2 + kstep; const char* b3 = b2 + kstep;
            if (last && has_next) S.a_ready(nxt);
            if constexpr (SP2) {
            PG8_LDB(B0, 0, 0); PG8_LDB(B1, 0, 1); PG8_SCHED; PG8_LDA(At, 0, 0); PG8_STAGE(PG8_SA(1, 1), a1 + hstep, voffA);
            PG8_WAIT_V(8); PG8_WAIT_L(0); PG8_BAR; PG8_MMA(0, 0, At, B0); PG8_MMA(0, 1, At, B1); PG8_BAR; PG8_SCHED;
            PG8_LDA(At, 0, 1); PG8_STAGE(PG8_SB(0, 0), b2, voffB); PG8_STAGE(PG8_SB(0, 1), b2 + hstep, voffB); PG8_STAGE(PG8_SA(0, 0), a2, voffA);
            PG8_WAIT_V(8); PG8_WAIT_L(0); PG8_BAR; PG8_MMA(1, 0, At, B0); PG8_MMA(1, 1, At, B1); PG8_BAR; PG8_SCHED;
            PG8_LDB(B0, 1, 0); PG8_LDB(B1, 1, 1); PG8_SCHED; PG8_LDA(At, 1, 0); PG8_STAGE(PG8_SA(0, 1), a2 + hstep, voffA);
            PG8_WAIT_V(8); PG8_WAIT_L(0); PG8_BAR; PG8_MMA(0, 0, At, B0); PG8_MMA(0, 1, At, B1); PG8_BAR; PG8_SCHED;
            PG8_LDA(At, 1, 1); PG8_STAGE(PG8_SB(1, 0), b3, voffB); PG8_STAGE(PG8_SB(1, 1), b3 + hstep, voffB); PG8_STAGE(PG8_SA(1, 0), a3, voffA);
            PG8_WAIT_V(8); PG8_WAIT_L(0); PG8_BAR; PG8_MMA(1, 0, At, B0); PG8_MMA(1, 1, At, B1); PG8_BAR; PG8_SCHED;
            } else {
            PG8_LDB(B0, 0, 0); PG8_SCHED; PG8_LDA(At, 0, 0); PG8_STAGE(PG8_SA(1, 1), a1 + hstep, voffA);
            PG8_WAIT_L(8); PG8_BAR; PG8_WAIT_L(0); PG8_MMA(0, 0, At, B0); PG8_BAR; PG8_SCHED;
            PG8_LDB(B1, 0, 1); PG8_STAGE(PG8_SB(0, 0), b2, voffB);
            PG8_BAR; PG8_WAIT_L(0); PG8_MMA(0, 1, At, B1); PG8_BAR;
            PG8_LDA(At, 0, 1); PG8_STAGE(PG8_SA(0, 0), a2, voffA);
            PG8_BAR; PG8_WAIT_L(0); PG8_MMA(1, 0, At, B0); PG8_BAR; PG8_SCHED;
            PG8_STAGE(PG8_SB(0, 1), b2 + hstep, voffB);
            PG8_WAIT_V(6); PG8_BAR; PG8_MMA(1, 1, At, B1); PG8_BAR;
            PG8_LDB(B0, 1, 0); PG8_SCHED; PG8_LDA(At, 1, 0); PG8_STAGE(PG8_SA(0, 1), a2 + hstep, voffA);
            PG8_WAIT_L(8); PG8_BAR; PG8_WAIT_L(0); PG8_MMA(0, 0, At, B0); PG8_BAR; PG8_SCHED;
            PG8_LDB(B1, 1, 1); PG8_STAGE(PG8_SB(1, 0), b3, voffB);
            PG8_BAR; PG8_WAIT_L(0); PG8_MMA(0, 1, At, B1); PG8_BAR;
            PG8_LDA(At, 1, 1); PG8_STAGE(PG8_SA(1, 0), a3, voffA);
            PG8_BAR; PG8_WAIT_L(0); PG8_MMA(1, 0, At, B0); PG8_BAR; PG8_SCHED;
            PG8_STAGE(PG8_SB(1, 1), b3 + hstep, voffB);
            PG8_WAIT_V(6); PG8_BAR; PG8_MMA(1, 1, At, B1); PG8_BAR;
            }
        }
        if constexpr (ALIGN_EPI) { if (wr == 0) PG8_BAR; }
        if constexpr (!Epi::AFTER_DRAIN) { E(acc, cur, wr, wc, fr, fq); S.done(cur); }
        if (!has_next) break;
#pragma unroll
        for (int a = 0; a < 2; ++a)
#pragma unroll
            for (int b = 0; b < 2; ++b)
#pragma unroll
                for (int m = 0; m < 4; ++m)
#pragma unroll
                    for (int n = 0; n < 2; ++n) acc[a][b][m][n] = (f32x4){0.f, 0.f, 0.f, 0.f};
        cur = nxt; cA = nA; cB = nB; ++ui;
        if constexpr (ALIGN_EPI) { if (wr == 1) PG8_BAR; }
    }
    PG8_WAIT_V(0);
    if constexpr (!ALIGN_EPI) { if (wr == 0) PG8_BAR; }
    PG8_BAR;
    if constexpr (Epi::AFTER_DRAIN) { E.fused(acc, cur, wr, wc, fr, fq, lds, wid, lane); S.done(cur); }
#undef PG8_SA
#undef PG8_SB
#undef PG8_STAGE
#undef PG8_LDA
#undef PG8_LDB
#undef PG8_MMA
#undef PG8_WAIT_V
#undef PG8_WAIT_L
#undef PG8_BAR
#undef PG8_SCHED
}
}

#ifndef REP_MASK
#define REP_MASK 0
#endif
#ifndef NAIVE_ATTN
#define NAIVE_ATTN 0
#endif
#ifndef NAIVE_SPATIAL
#define NAIVE_SPATIAL 0
#endif
#define LAS __attribute__((address_space(3)))
using pg8::bf16_t; using pg8::f32x4; using pg8::Unit; using pg8::u32x4;
typedef unsigned u32x2 __attribute__((ext_vector_type(2)));

constexpr int NLAT = 32768, NCTX = 2048, MTOT = 34816;
constexpr int NTHREADS = 512;
constexpr int LDS_BYTES = 131072;
constexpr int NPH = 24;

constexpr size_t OFF_W1T = 0;
constexpr size_t OFF_W2T = OFF_W1T + 4ull * 4096 * 1024 * 2;
constexpr size_t OFF_QKVT = OFF_W2T + 4ull * 4096 * 1024 * 2;
constexpr size_t OFF_WOT = OFF_QKVT + 2ull * 3072 * 1024 * 2;
constexpr size_t OFF_WINT = OFF_WOT + 2ull * 1024 * 1024 * 2;
constexpr size_t OFF_SGOT = OFF_WINT + 2ull * 6144 * 1024 * 2;
constexpr size_t OFF_MODS = OFF_SGOT + 2ull * 1024 * 3072 * 2;
constexpr size_t OFF_CTXR = OFF_MODS + 4ull * 9 * 6144 * 4;
constexpr size_t OFF_HB = OFF_CTXR + 2048ull * 1024 * 4;
constexpr size_t OFF_BIG = OFF_HB + 34816ull * 1024 * 2;
constexpr size_t OFF_SSQ = OFF_BIG + 34816ull * 4096 * 2;
constexpr size_t OFF_LNACC = OFF_SSQ + 8ull * 34816 * 4;
constexpr size_t OFF_GS = OFF_LNACC + 2ull * 34816 * 2 * 4;
constexpr size_t OFF_BQKV = OFF_GS + 8ull * 9 * 1024 * 4;
constexpr size_t OFF_BMLP = OFF_BQKV + 2ull * 9 * 3072 * 4;
constexpr size_t OFF_BWIN = OFF_BMLP + 4ull * 9 * 4096 * 4;
constexpr size_t WS_END = OFF_BWIN + 2ull * 9 * 6144 * 4;

struct Params {
    const float *x, *c, *ctx, *c_ctx, *ada_w, *ada_b, *norm1_g, *norm2_g, *mlp_w1, *mlp_w2, *na_w_qkv, *na_q_norm, *na_k_norm, *na_rpb, *na_w_o,
        *sg_w_in, *sg_b_in, *sg_ln_g, *sg_ln_b, *sg_w_s, *sg_b_s, *sg_w_o;
    float* out; unsigned char* ws; int ph_lo, ph_hi;
};

struct Tix { int tid, bid, gsz; };
__device__ __forceinline__ float bf2f(unsigned h) { return __uint_as_float(h << 16); }
__device__ __forceinline__ unsigned f2bf(float f) { unsigned u = __float_as_uint(f); u += 0x7FFFu + ((u >> 16) & 1u); return u >> 16; }
__device__ __forceinline__ unsigned pk2(float lo, float hi) { return pg8::cvt_pk_bf16(lo, hi); }
__device__ __forceinline__ float wave_sum(float v) {
#pragma unroll
    for (int o = 1; o < 64; o <<= 1) v += __shfl_xor(v, o);
    return v;
}
__device__ __forceinline__ float wave_max(float v) {
#pragma unroll
    for (int o = 1; o < 64; o <<= 1) v = fmaxf(v, __shfl_xor(v, o));
    return v;
}
#define LDS_WAIT() asm volatile("s_waitcnt lgkmcnt(0)" ::: "memory")
__device__ __forceinline__ float silu_f(float v) { return v / (1.f + expf(-v)); }
__device__ __forceinline__ float gelu_f(float v) { return 0.5f * v * (1.f + erff(v * 0.70710678118654752f)); }

typedef float f32x2 __attribute__((ext_vector_type(2)));
__device__ __forceinline__ f32x2 gelu_pk(f32x2 v) {
    const f32x2 av = __builtin_elementwise_abs(v), d = av * 0.2316418882f + 1.0f;
    f32x2 t; t.x = __builtin_amdgcn_rcpf(d.x); t.y = __builtin_amdgcn_rcpf(d.y);
    f32x2 q = t * 0.5307027145f + (-0.7265760135f); q = q * t + 0.7107068705f; q = q * t + (-0.142248368f); q = q * t + 0.127414796f; q = q * t;
    const f32x2 s = (v * v) * (-0.72134752044f);
    f32x2 e; e.x = __builtin_amdgcn_exp2f(s.x); e.y = __builtin_amdgcn_exp2f(s.y);
    const f32x2 m = v * (q * e), r = v - m;
    f32x2 o; o.x = v.x < 0.f ? m.x : r.x; o.y = v.y < 0.f ? m.y : r.y; return o;
}
__device__ __forceinline__ f32x4 gelu4(f32x4 v) { const f32x2 a = gelu_pk((f32x2){v.x, v.y}), b = gelu_pk((f32x2){v.z, v.w}); return (f32x4){a.x, a.y, b.x, b.y}; }

__device__ __forceinline__ int sigma_inv(int L) { return 128 * ((L >> 5) & 1) + 32 * (L >> 6) + 16 * ((L >> 2) & 1) + 4 * ((L >> 3) & 3) + (L & 3); }

__device__ __forceinline__ void phase_mods(const Params& p, LAS unsigned char* lds, const Tix T_) {
    LAS float* sc = (LAS float*)lds;
    LAS float* red = (LAS float*)(lds + 36864);
    float* mods = (float*)(p.ws + OFF_MODS);
    const int tid = T_.tid;
    for (int i = tid; i < 9 * 1024; i += NTHREADS) { const int b = i >> 10, k = i & 1023; const float v = b < 8 ? p.c[b * 1024 + k] : p.c_ctx[k]; sc[i] = silu_f(v); }
    __syncthreads();
    const int c4 = (tid & 15) * 4, kk = tid >> 4;
    for (int item = T_.bid; item < 384; item += T_.gsz) {
        const int l = item / 96, n0 = (item % 96) * 64;
        const float* W = p.ada_w + (size_t)l * 1024 * 6144 + n0 + c4;
        f32x4 acc[9];
#pragma unroll
        for (int b = 0; b < 9; ++b) acc[b] = (f32x4){0.f, 0.f, 0.f, 0.f};
#pragma unroll 4
        for (int i = 0; i < 32; ++i) { const int k = kk + 32 * i; const f32x4 w = *(const f32x4*)(W + (size_t)k * 6144);
#pragma unroll
            for (int b = 0; b < 9; ++b) acc[b] += sc[b * 1024 + k] * w; }
#pragma unroll
        for (int b = 0; b < 9; ++b) *(LAS f32x4*)(red + (kk * 9 + b) * 64 + c4) = acc[b];
        __syncthreads();
        for (int o = tid; o < 576; o += NTHREADS) { const int b = o >> 6, cc = o & 63; float s = 0.f;
            for (int j = 0; j < 32; ++j) s += red[(j * 9 + b) * 64 + cc];
            mods[(size_t)(l * 9 + b) * 6144 + n0 + cc] = s + p.ada_b[l * 6144 + n0 + cc]; }
        __syncthreads();
    }
}

struct MatDesc { const float* src; bf16_t* dst; int K, N; };
__device__ __forceinline__ MatDesc get_mat(const Params& p, int mi) {
    MatDesc m;
    if (mi < 4) { m.src = p.mlp_w1 + (size_t)mi * 1024 * 4096; m.dst = (bf16_t*)(p.ws + OFF_W1T) + (size_t)mi * 4096 * 1024; m.K = 1024; m.N = 4096; }
    else if (mi < 8) { const int l = mi - 4; m.src = p.mlp_w2 + (size_t)l * 4096 * 1024; m.dst = (bf16_t*)(p.ws + OFF_W2T) + (size_t)l * 1024 * 4096; m.K = 4096; m.N = 1024; }
    else if (mi < 10) { const int a = mi - 8; m.src = p.na_w_qkv + (size_t)a * 1024 * 3072; m.dst = (bf16_t*)(p.ws + OFF_QKVT) + (size_t)a * 3072 * 1024; m.K = 1024; m.N = 3072; }
    else if (mi < 12) { const int a = mi - 10; m.src = p.na_w_o + (size_t)a * 1024 * 1024; m.dst = (bf16_t*)(p.ws + OFF_WOT) + (size_t)a * 1024 * 1024; m.K = 1024; m.N = 1024; }
    else if (mi < 14) { const int s = mi - 12; m.src = p.sg_w_in + (size_t)s * 1024 * 6144; m.dst = (bf16_t*)(p.ws + OFF_WINT) + (size_t)s * 6144 * 1024; m.K = 1024; m.N = 6144; }
    else { const int s = mi - 14; m.src = p.sg_w_o + (size_t)s * 3072 * 1024; m.dst = (bf16_t*)(p.ws + OFF_SGOT) + (size_t)s * 1024 * 3072; m.K = 3072; m.N = 1024; }
    return m;
}
__device__ __forceinline__ void transpose_item(const float* W, int K, int N, bf16_t* WT, LAS float* scr, int item, int lane) {
    const int nblk = N / 32, kb = item / nblk, nb = item % nblk, k0 = 64 * kb, n0 = 32 * nb;
#pragma unroll 8
    for (int i = 0; i < 32; ++i) { const int kk = 2 * i + (lane >> 5); scr[kk * 33 + (lane & 31)] = W[(size_t)(k0 + kk) * N + n0 + (lane & 31)]; }
    LDS_WAIT();
    const int c = lane & 7;
#pragma unroll
    for (int j = 0; j < 4; ++j) { const int n = (lane >> 3) + 8 * j; const LAS float* s = scr + (8 * c) * 33 + n;
        u32x4 o; o.x = pk2(s[0 * 33], s[1 * 33]); o.y = pk2(s[2 * 33], s[3 * 33]); o.z = pk2(s[4 * 33], s[5 * 33]); o.w = pk2(s[6 * 33], s[7 * 33]);
        const int nl = n0 + n, drow = (nl & ~255) + sigma_inv(nl & 255);
        *(u32x4*)(WT + (size_t)drow * K + k0 + 8 * c) = o; }
    LDS_WAIT();
}
__device__ __forceinline__ void phase_convert(const Params& p, LAS unsigned char* lds, const Tix T_) {
    const int lane = T_.tid & 63, wave = T_.tid >> 6, gw = T_.bid * 8 + wave, NGW = T_.gsz * 8;
    LAS float* scr = (LAS float*)(lds + wave * 8704);
    for (int mi = 0; mi < 16; ++mi) {
        const MatDesc m = get_mat(p, mi);
        const int nitems = (m.K / 64) * (m.N / 32);
        for (int it = gw; it < nitems; it += NGW) transpose_item(m.src, m.K, m.N, m.dst, scr, it, lane);
    }
}


__device__ __forceinline__ void phase_zero(const Params& p, const Tix T_) {
    float* z0 = (float*)(p.ws + OFF_SSQ) + MTOT; const int n0 = 7 * MTOT + 2 * MTOT * 2;
    for (int i = T_.bid * NTHREADS + T_.tid; i < n0; i += T_.gsz * NTHREADS) z0[i] = 0.f;
}
__device__ __forceinline__ void phase_0b(const Params& p, LAS unsigned char* lds, const Tix T_) {
    const float* mods = (const float*)(p.ws + OFF_MODS);
    const int tid = T_.tid, lane = tid & 63, wave = tid >> 6, gw = T_.bid * 8 + wave, NGW = T_.gsz * 8;
    { float* gs = (float*)(p.ws + OFF_GS);
      for (int i = T_.bid * NTHREADS + tid; i < 8 * 9 * 1024; i += T_.gsz * NTHREADS) { const int n = i / 9216, rem = i % 9216, b = rem >> 10, c = rem & 1023, L = n >> 1;
          const float g = (n & 1) ? p.norm2_g[L * 1024 + c] : p.norm1_g[L * 1024 + c];
          gs[i] = g * (1.0f + mods[(size_t)(L * 9 + b) * 6144 + ((n & 1) ? 4096 : 1024) + c]); } }
    { bf16_t* hb = (bf16_t*)(p.ws + OFF_HB); float* ssq0 = (float*)(p.ws + OFF_SSQ);
      for (int row = gw; row < MTOT; row += NGW) {
          const float* xr = row < NLAT ? p.x + (size_t)row * 1024 : p.ctx + (size_t)(row - NLAT) * 1024;
          const int b = row < NLAT ? (row >> 12) : 8;
          f32x4 v[4]; float ss = 0.f;
#pragma unroll
          for (int j = 0; j < 4; ++j) { v[j] = *(const f32x4*)(xr + 4 * lane + 256 * j); ss += (v[j].x * v[j].x + v[j].y * v[j].y) + (v[j].z * v[j].z + v[j].w * v[j].w); }
          ss = wave_sum(ss);
          if (lane == 0) ssq0[row] = ss;
#pragma unroll
          for (int j = 0; j < 4; ++j) { const int col = 4 * lane + 256 * j;
              const f32x4 gv = *(const f32x4*)(p.norm1_g + col), scv = *(const f32x4*)(mods + (size_t)b * 6144 + 1024 + col);
              const f32x4 o = v[j] * gv * (1.0f + scv);
              u32x2 w; w.x = pk2(o.x, o.y); w.y = pk2(o.z, o.w);
              *(u32x2*)(hb + (size_t)row * 1024 + col) = w; } } }
    LAS float* sh = (LAS float*)lds;
    for (int cmb = 0; cmb < 8; ++cmb) {
        int L, shoff, N; const bf16_t* Bt; float* dst; const float* addb = nullptr;
        if (cmb < 2) { L = 2 * cmb; shoff = 0; N = 3072; Bt = (const bf16_t*)(p.ws + OFF_QKVT) + (size_t)cmb * 3072 * 1024; dst = (float*)(p.ws + OFF_BQKV) + (size_t)cmb * 9 * 3072; }
        else if (cmb < 6) { L = cmb - 2; shoff = 3072; N = 4096; Bt = (const bf16_t*)(p.ws + OFF_W1T) + (size_t)L * 4096 * 1024; dst = (float*)(p.ws + OFF_BMLP) + (size_t)L * 9 * 4096; }
        else { const int sl = cmb - 6; L = 2 * sl + 1; shoff = 0; N = 6144; Bt = (const bf16_t*)(p.ws + OFF_WINT) + (size_t)sl * 6144 * 1024; dst = (float*)(p.ws + OFF_BWIN) + (size_t)sl * 9 * 6144; addb = p.sg_b_in + sl * 6144; }
        __syncthreads();
        for (int i = tid; i < 9 * 1024; i += NTHREADS) sh[i] = mods[(size_t)(L * 9 + (i >> 10)) * 6144 + shoff + (i & 1023)];
        __syncthreads();
        for (int n = gw; n < N; n += NGW) {
            const bf16_t* wr_ = Bt + (size_t)((n & ~255) + sigma_inv(n & 255)) * 1024 + lane * 8;
            const u32x4 w0 = *(const u32x4*)wr_, w1 = *(const u32x4*)(wr_ + 512);
            float wv[16];
#pragma unroll
            for (int e = 0; e < 4; ++e) { wv[2 * e] = bf2f(w0[e] & 0xffffu); wv[2 * e + 1] = bf2f(w0[e] >> 16); wv[8 + 2 * e] = bf2f(w1[e] & 0xffffu); wv[8 + 2 * e + 1] = bf2f(w1[e] >> 16); }
            const float ab = addb ? addb[n] : 0.f;
#pragma unroll
            for (int b = 0; b < 9; ++b) {
                const f32x4 s0 = *(const LAS f32x4*)(sh + b * 1024 + lane * 8), s1 = *(const LAS f32x4*)(sh + b * 1024 + lane * 8 + 4);
                const f32x4 s2 = *(const LAS f32x4*)(sh + b * 1024 + 512 + lane * 8), s3 = *(const LAS f32x4*)(sh + b * 1024 + 512 + lane * 8 + 4);
                float a = (wv[0] * s0.x + wv[1] * s0.y) + (wv[2] * s0.z + wv[3] * s0.w) + (wv[4] * s1.x + wv[5] * s1.y) + (wv[6] * s1.z + wv[7] * s1.w)
                        + (wv[8] * s2.x + wv[9] * s2.y) + (wv[10] * s2.z + wv[11] * s2.w) + (wv[12] * s3.x + wv[13] * s3.y) + (wv[14] * s3.z + wv[15] * s3.w);
                a = wave_sum(a);
                if (lane == 0) dst[(size_t)b * N + n] = a + ab; }
        }
    }
}

typedef short s16x4 __attribute__((ext_vector_type(4)));
typedef short s16x8 __attribute__((ext_vector_type(8)));
typedef float f32x16 __attribute__((ext_vector_type(16)));
typedef __bf16 bf16x2_t __attribute__((ext_vector_type(2)));
__device__ __forceinline__ unsigned pkb(float a, float b) { const f32x2 v = {a, b}; const bf16x2_t r = __builtin_convertvector(v, bf16x2_t); return __builtin_bit_cast(unsigned, r); }
__device__ __forceinline__ s16x8 pack8(float a0, float a1, float a2, float a3, float a4, float a5, float a6, float a7) {
    u32x4 w; w.x = pkb(a0, a1); w.y = pkb(a2, a3); w.z = pkb(a4, a5); w.w = pkb(a6, a7); return __builtin_bit_cast(s16x8, w); }
__device__ __forceinline__ s16x8 tr_pair(const LAS unsigned char* a0, int second_off) {
    const s16x4 a = __builtin_amdgcn_ds_read_tr16_b64_v4i16((LAS s16x4*)a0);
    const s16x4 b = __builtin_amdgcn_ds_read_tr16_b64_v4i16((LAS s16x4*)(a0 + second_off));
    s16x8 r; r[0] = a[0]; r[1] = a[1]; r[2] = a[2]; r[3] = a[3]; r[4] = b[0]; r[5] = b[1]; r[6] = b[2]; r[7] = b[3]; return r; }
#define MFMA32(a, b, c) __builtin_amdgcn_mfma_f32_32x32x16_bf16((a), (b), (c), 0, 0, 0)

constexpr int AV_STR = 144;
__device__ __forceinline__ void attn_one_tile(const s16x8 (&Kf)[4], const s16x8 (&Qf)[4], const LAS unsigned char* Vl, const LAS float* tab, f32x16& O0, f32x16& O1, float& lsum,
                                              int kt, int ntl, int r, int rs, int qcol, int wst, float mb, int hi, int tr_q, int tr_p, int dgrp) {
    f32x16 S;
#pragma unroll
    for (int i = 0; i < 16; ++i) S[i] = 0.f;
#pragma unroll
    for (int ks = 0; ks < 4; ++ks) S = MFMA32(Kf[ks], Qf[ks], S);
    float pv[16];
    if (kt < ntl) {
        const int kr = rs + (kt >> 1), rb = (kr - r + 7) * 31, cbase = 32 * (kt & 1) + 4 * hi;
#pragma unroll
        for (int j = 0; j < 4; ++j)
#pragma unroll
            for (int i = 0; i < 4; ++i) { const int kcol = cbase + 8 * j + i; const bool valid = (unsigned)(kcol - wst) < 16u;
                const int delta = min(max(kcol - qcol + 15, 0), 30);
                const float e = __expf(S[4 * j + i] + tab[rb + delta] - mb); pv[4 * j + i] = valid ? e : 0.f; }
    } else {
#pragma unroll
        for (int i = 0; i < 16; ++i) pv[i] = __expf(S[i] - mb);
    }
#pragma unroll
    for (int i = 0; i < 16; ++i) lsum += pv[i];
    const s16x8 P0 = pack8(pv[0], pv[1], pv[2], pv[3], pv[4], pv[5], pv[6], pv[7]);
    const s16x8 P1 = pack8(pv[8], pv[9], pv[10], pv[11], pv[12], pv[13], pv[14], pv[15]);
    const LAS unsigned char* vb = Vl + (kt * 32 + 4 * hi + tr_q) * AV_STR + (16 * dgrp + 4 * tr_p) * 2;
    const s16x8 V00 = tr_pair(vb, 8 * AV_STR), V01 = tr_pair(vb + 64, 8 * AV_STR);
    const s16x8 V10 = tr_pair(vb + 16 * AV_STR, 8 * AV_STR), V11 = tr_pair(vb + 16 * AV_STR + 64, 8 * AV_STR);
    O0 = MFMA32(V00, P0, O0); O1 = MFMA32(V01, P0, O1); O0 = MFMA32(V10, P1, O0); O1 = MFMA32(V11, P1, O1);
}
__device__ __forceinline__ void attn_load_k(s16x8 (&Kf)[4], const bf16_t* kbase, int klat0, int kctx0, int kt, int ntl, int rs) {
    const size_t grow = kt < ntl ? (size_t)(klat0 + (rs + (kt >> 1)) * 64 + 32 * (kt & 1)) : (size_t)(kctx0 + 32 * (kt - ntl));
#pragma unroll
    for (int ks = 0; ks < 4; ++ks) Kf[ks] = *(const s16x8*)(kbase + grow * 3072 + 16 * ks);
}

__device__ __forceinline__ void phase_attn_mfma(const Params& p, int a, bool ctx_q, LAS unsigned char* lds, const Tix T_) {
    const bf16_t* qkv = (const bf16_t*)(p.ws + OFF_BIG); bf16_t* ao = (bf16_t*)(p.ws + OFF_BIG) + (size_t)MTOT * 3072;
    const float* rpb = p.na_rpb + (size_t)a * 16 * 15 * 31;
    const int tid = T_.tid, lane = tid & 63, wave = __builtin_amdgcn_readfirstlane(tid >> 6), qt = wave & 1, kq = wave >> 1, l31 = lane & 31, hi = lane >> 5;
    LAS unsigned char* Vl = lds;
    LAS float* Ored = (LAS float*)lds;
    LAS float* lred = (LAS float*)(lds + 69632);
    LAS float* tab = (LAS float*)(lds + 110592);
    LAS float* misc = (LAS float*)(lds + 110592 + 2048);
    float mb;
    { float m = 0.f; for (int i = tid; i < 7440; i += NTHREADS) m = fmaxf(m, rpb[i]);
      float qg = 0.f, kg = 0.f; if (tid < 64) { qg = fabsf(p.na_q_norm[a * 64 + tid]); kg = fabsf(p.na_k_norm[a * 64 + tid]); }
      m = wave_max(m); qg = wave_max(qg); kg = wave_max(kg);
      if (lane == 0) { misc[wave] = m; if (wave == 0) { misc[8] = qg; misc[9] = kg; } }
      __syncthreads();
      float rm = misc[0];
#pragma unroll
      for (int w = 1; w < 8; ++w) rm = fmaxf(rm, misc[w]);
      mb = 8.0f * misc[8] * misc[9] + rm; }
    const int nlatu = 8 * 64 * 16, nctxu = ctx_q ? 8 * 4 * 16 : 0;
    const int tr_q = (lane & 15) >> 2, tr_p = lane & 3, dgrp = (lane >> 4) & 1;
    for (int u = T_.bid; u < nlatu + nctxu; u += T_.gsz) {
        int b, h, qrow0, r = 0, rs = 0, ntl, ntiles;
        if (u < nlatu) { h = u & 15; const int br = u >> 4; r = br & 63; b = br >> 6; qrow0 = b * 4096 + r * 64; rs = min(max(r - 4, 0), 56); ntl = 16; ntiles = 24; }
        else { const int v = u - nlatu; h = v & 15; const int bq = v >> 4; b = bq >> 2; qrow0 = NLAT + b * 256 + (bq & 3) * 64; ntl = 0; ntiles = 8; }
        for (int idx = tid; idx < ntiles * 256; idx += NTHREADS) { const int key = idx >> 3, ch = idx & 7, kt = key >> 5, kk = key & 31;
            const size_t grow = kt < ntl ? (size_t)(b * 4096 + (rs + (kt >> 1)) * 64 + 32 * (kt & 1) + kk) : (size_t)(NLAT + b * 256 + 32 * (kt - ntl) + kk);
            const u32x4 w = *(const u32x4*)(qkv + grow * 3072 + 2048 + h * 64 + ch * 8);
            *(LAS u32x4*)(Vl + key * AV_STR + ch * 16) = w; }
        if (tid < 465) tab[tid] = rpb[h * 465 + tid];
        s16x8 Qf[4];
        { const bf16_t* qp = qkv + (size_t)(qrow0 + 32 * qt + l31) * 3072 + h * 64 + 8 * hi;
#pragma unroll
          for (int ks = 0; ks < 4; ++ks) Qf[ks] = *(const s16x8*)(qp + 16 * ks); }
        const bf16_t* kbase = qkv + 1024 + h * 64 + 8 * hi;
        const int klat0 = b * 4096 + l31, kctx0 = NLAT + b * 256 + l31;
        const int ntw = ntiles >> 2, t0 = kq * ntw;
        s16x8 KA[4], KB[4];
        attn_load_k(KA, kbase, klat0, kctx0, t0, ntl, rs); attn_load_k(KB, kbase, klat0, kctx0, t0 + 1, ntl, rs);
        __syncthreads();
        f32x16 O0, O1;
#pragma unroll
        for (int i = 0; i < 16; ++i) { O0[i] = 0.f; O1[i] = 0.f; }
        float lsum = 0.f;
        const int qcol = 32 * qt + l31, wst = min(max(qcol - 8, 0), 48);
#pragma unroll 1
        for (int t = 0; t < ntw; t += 2) {
            s16x8 KN[4];
            const int kn = t0 + min(t + 2, ntw - 2);
            attn_load_k(KN, kbase, klat0, kctx0, kn, ntl, rs);
            attn_one_tile(KA, Qf, Vl, tab, O0, O1, lsum, t0 + t, ntl, r, rs, qcol, wst, mb, hi, tr_q, tr_p, dgrp);
#pragma unroll
            for (int ks = 0; ks < 4; ++ks) KA[ks] = KN[ks];
            attn_load_k(KN, kbase, klat0, kctx0, kn + 1, ntl, rs);
            attn_one_tile(KB, Qf, Vl, tab, O0, O1, lsum, t0 + t + 1, ntl, r, rs, qcol, wst, mb, hi, tr_q, tr_p, dgrp);
#pragma unroll
            for (int ks = 0; ks < 4; ++ks) KB[ks] = KN[ks];
        }
        __syncthreads();
#pragma unroll
        for (int j = 0; j < 4; ++j) {
            *(LAS f32x4*)(Ored + (size_t)((kq * 64 + 32 * qt + l31) * 68 + 8 * j + 4 * hi)) = (f32x4){O0[4 * j], O0[4 * j + 1], O0[4 * j + 2], O0[4 * j + 3]};
            *(LAS f32x4*)(Ored + (size_t)((kq * 64 + 32 * qt + l31) * 68 + 32 + 8 * j + 4 * hi)) = (f32x4){O1[4 * j], O1[4 * j + 1], O1[4 * j + 2], O1[4 * j + 3]}; }
        lred[(kq * 2 + hi) * 64 + 32 * qt + l31] = lsum;
        __syncthreads();
        { const int q = tid >> 3, d8 = (tid & 7) * 8;
          f32x4 s0 = (f32x4){0.f, 0.f, 0.f, 0.f}, s1 = s0; float l = 0.f;
#pragma unroll
          for (int k = 0; k < 4; ++k) { s0 += *(const LAS f32x4*)(Ored + (k * 64 + q) * 68 + d8); s1 += *(const LAS f32x4*)(Ored + (k * 64 + q) * 68 + d8 + 4); l += lred[(k * 2) * 64 + q] + lred[(k * 2 + 1) * 64 + q]; }
          const float inv = 1.0f / l;
          u32x4 o; o.x = pkb(s0.x * inv, s0.y * inv); o.y = pkb(s0.z * inv, s0.w * inv); o.z = pkb(s1.x * inv, s1.y * inv); o.w = pkb(s1.z * inv, s1.w * inv);
          *(u32x4*)(ao + (size_t)(qrow0 + q) * 1024 + h * 64 + d8) = o; }
        __syncthreads();
    }
}

constexpr int SP_RS = 320;
__device__ __forceinline__ void phase_spatial_mfma(const Params& p, int sl, int M, LAS unsigned char* lds, const Tix T_) {
    bf16_t* vb = (bf16_t*)(p.ws + OFF_BIG); const float* lnacc = (const float*)(p.ws + OFF_LNACC) + (size_t)sl * MTOT * 2;
    const float* lng = p.sg_ln_g + sl * 3072; const float* lnb = p.sg_ln_b + sl * 3072;
    const int tid = T_.tid, lane = tid & 63, wave = __builtin_amdgcn_readfirstlane(tid >> 6), pt = wave & 3, cth = wave >> 2, l31 = lane & 31, hi = lane >> 5;
    const int tr_q = (lane & 15) >> 2, tr_p = lane & 3, dgrp = (lane >> 4) & 1;
    const int nunits = (M / 128) * 24;
    for (int u = T_.bid; u < nunits; u += T_.gsz) {
        const int nc = u / 24, g = u % 24, r0 = nc * 128;
#pragma unroll
        for (int i = 0; i < 4; ++i) { const int idx = tid + NTHREADS * i, q = idx >> 4, c8 = (idx & 15) * 8;
            const u32x4 w = *(const u32x4*)(vb + (size_t)(r0 + q) * 3072 + g * 128 + c8);
            const float mean = lnacc[2 * (r0 + q)] * (1.0f / 3072.0f), rstd = 1.0f / sqrtf(fmaxf(lnacc[2 * (r0 + q) + 1] * (1.0f / 3072.0f) - mean * mean, 0.f) + 1e-6f);
            const f32x4 g0 = *(const f32x4*)(lng + g * 128 + c8), g1 = *(const f32x4*)(lng + g * 128 + c8 + 4), b0 = *(const f32x4*)(lnb + g * 128 + c8), b1 = *(const f32x4*)(lnb + g * 128 + c8 + 4);
            u32x4 o;
            o.x = pkb((bf2f(w.x & 0xffffu) - mean) * rstd * g0.x + b0.x, (bf2f(w.x >> 16) - mean) * rstd * g0.y + b0.y);
            o.y = pkb((bf2f(w.y & 0xffffu) - mean) * rstd * g0.z + b0.z, (bf2f(w.y >> 16) - mean) * rstd * g0.w + b0.w);
            o.z = pkb((bf2f(w.z & 0xffffu) - mean) * rstd * g1.x + b1.x, (bf2f(w.z >> 16) - mean) * rstd * g1.y + b1.y);
            o.w = pkb((bf2f(w.w & 0xffffu) - mean) * rstd * g1.z + b1.z, (bf2f(w.w >> 16) - mean) * rstd * g1.w + b1.w);
            *(LAS u32x4*)(lds + q * SP_RS + c8 * 2) = o; }
        const float* wp = p.sg_w_s + ((size_t)sl * 24 + g) * 16384 + (32 * pt + l31) * 128 + 8 * hi;
        s16x8 Wf[8];
#pragma unroll
        for (int ks = 0; ks < 8; ++ks) { const f32x4 x = *(const f32x4*)(wp + 16 * ks), y = *(const f32x4*)(wp + 16 * ks + 4); Wf[ks] = pack8(x.x, x.y, x.z, x.w, y.x, y.y, y.z, y.w); }
        const float bs = p.sg_b_s[((size_t)sl * 24 + g) * 128 + 32 * pt + l31];
        __syncthreads();
#pragma unroll
        for (int cc = 0; cc < 2; ++cc) { const int ct = 2 * cth + cc;
            f32x16 acc;
#pragma unroll
            for (int i = 0; i < 16; ++i) acc[i] = 0.f;
            const LAS unsigned char* ab = lds + (8 * hi + tr_q) * SP_RS + (32 * ct + 16 * dgrp + 4 * tr_p) * 2;
#pragma unroll
            for (int ks = 0; ks < 8; ++ks) { const s16x8 Af = tr_pair(ab + 16 * ks * SP_RS, 4 * SP_RS); acc = MFMA32(Af, Wf[ks], acc); }
            bf16_t* orow = vb + (size_t)(r0 + 32 * pt + l31) * 3072 + g * 128 + 32 * ct + 4 * hi;
#pragma unroll
            for (int j = 0; j < 4; ++j) { u32x2 o; o.x = pkb(acc[4 * j] + bs, acc[4 * j + 1] + bs); o.y = pkb(acc[4 * j + 2] + bs, acc[4 * j + 3] + bs); *(u32x2*)(orow + 8 * j) = o; }
        }
        __syncthreads();
    }
}

template <class F> struct EpiG {
    static constexpr bool PERM = false, AFTER_DRAIN = false;
    F f;
    __device__ __forceinline__ void operator()(const f32x4 (&acc)[2][2][4][2], const Unit& u, int wr, int wc, int fr, int fq) const {
        F g = f; const int colb = u.pn * 256 + 64 * wc + 8 * fq;
        g.begin(u, colb, fq);
#pragma unroll
        for (int ai = 0; ai < 2; ++ai)
#pragma unroll
            for (int m = 0; m < 4; ++m) { const int row = u.pm * 256 + ai * 128 + wr * 64 + m * 16 + fr;
                g.row(row, colb, acc[ai][0][m][0], acc[ai][0][m][1], acc[ai][1][m][0], acc[ai][1][m][1]);
                asm volatile("" ::: "memory"); }
    }
};
__device__ __forceinline__ void store8_bf16(bf16_t* o, const f32x4 a, const f32x4 b) { u32x4 w; w.x = pk2(a.x, a.y); w.y = pk2(a.z, a.w); w.z = pk2(b.x, b.y); w.w = pk2(b.z, b.w); *(u32x4*)o = w; }
__device__ __forceinline__ float sumsq4(const f32x4 x) { return (x.x * x.x + x.y * x.y) + (x.z * x.z + x.w * x.w); }
__device__ __forceinline__ float sum4(const f32x4 x) { return (x.x + x.y) + (x.z + x.w); }
__device__ __forceinline__ float rstd_of(const float* ssq, int row) { return 1.0f / sqrtf(ssq[row] * (1.0f / 1024.0f) + 1e-6f); }
__device__ __forceinline__ void atomic_addf(float* p, float v) { __hip_atomic_fetch_add(p, v, __ATOMIC_RELAXED, __HIP_MEMORY_SCOPE_AGENT); }

struct FQKV { bf16_t* O; const float* qg; const float* kg; const float* ssq; const float* bias;
    f32x4 gn[4], bz[4]; int sect;
    __device__ __forceinline__ void begin(const Unit& u, int colb, int fq) {
        sect = u.pn >> 2; const int b = min(u.pm >> 4, 8); const float* bp = bias + (size_t)b * 3072 + colb;
        bz[0] = *(const f32x4*)bp; bz[1] = *(const f32x4*)(bp + 4); bz[2] = *(const f32x4*)(bp + 32); bz[3] = *(const f32x4*)(bp + 36);
        if (sect < 2) { const float* gp = (sect == 0 ? qg : kg) + 8 * fq; const float mul = sect == 0 ? 0.125f : 1.0f;
            gn[0] = *(const f32x4*)gp * mul; gn[1] = *(const f32x4*)(gp + 4) * mul; gn[2] = *(const f32x4*)(gp + 32) * mul; gn[3] = *(const f32x4*)(gp + 36) * mul; } }
    __device__ __forceinline__ void row(int row, int colb, f32x4 a0, f32x4 b0, f32x4 a1, f32x4 b1) {
        const float rs = rstd_of(ssq, row);
        a0 = a0 * rs + bz[0]; b0 = b0 * rs + bz[1]; a1 = a1 * rs + bz[2]; b1 = b1 * rs + bz[3];
        if (sect < 2) { float ss = (sumsq4(a0) + sumsq4(b0)) + (sumsq4(a1) + sumsq4(b1));
            ss += __shfl_xor(ss, 16); ss += __shfl_xor(ss, 32);
            const float r2 = 1.0f / sqrtf(ss * (1.0f / 64.0f) + 1e-6f);
            a0 = a0 * r2 * gn[0]; b0 = b0 * r2 * gn[1]; a1 = a1 * r2 * gn[2]; b1 = b1 * r2 * gn[3]; }
        bf16_t* op = O + (size_t)row * 3072 + colb; store8_bf16(op, a0, b0); store8_bf16(op + 32, a1, b1); } };
struct FSqrelu { bf16_t* O; const float* ssq; const float* bias;
    f32x4 bz[4];
    __device__ __forceinline__ void begin(const Unit& u, int colb, int fq) { const int b = min(u.pm >> 4, 8); const float* bp = bias + (size_t)b * 4096 + colb;
        bz[0] = *(const f32x4*)bp; bz[1] = *(const f32x4*)(bp + 4); bz[2] = *(const f32x4*)(bp + 32); bz[3] = *(const f32x4*)(bp + 36); }
    __device__ __forceinline__ void row(int row, int colb, f32x4 a0, f32x4 b0, f32x4 a1, f32x4 b1) {
        const float rs = rstd_of(ssq, row); const f32x4 z = (f32x4){0.f, 0.f, 0.f, 0.f};
        a0 = __builtin_elementwise_max(a0 * rs + bz[0], z); b0 = __builtin_elementwise_max(b0 * rs + bz[1], z); a1 = __builtin_elementwise_max(a1 * rs + bz[2], z); b1 = __builtin_elementwise_max(b1 * rs + bz[3], z);
        bf16_t* op = O + (size_t)row * 4096 + colb; store8_bf16(op, a0 * a0, b0 * b0); store8_bf16(op + 32, a1 * a1, b1 * b1); } };
struct FGeluV { bf16_t* O; const float* ssq; const float* bias; float* lnacc;
    f32x4 bz[4]; int fq_;
    __device__ __forceinline__ void begin(const Unit& u, int colb, int fq) { const int b = min(u.pm >> 4, 8); const float* bp = bias + (size_t)b * 6144 + colb; fq_ = fq;
        bz[0] = *(const f32x4*)bp; bz[1] = *(const f32x4*)(bp + 4); bz[2] = *(const f32x4*)(bp + 32); bz[3] = *(const f32x4*)(bp + 36); }
    __device__ __forceinline__ void row(int row, int colb, f32x4 a0, f32x4 b0, f32x4 a1, f32x4 b1) {
        const float rs = rstd_of(ssq, row);
        a0 = gelu4(a0 * rs + bz[0]); b0 = gelu4(b0 * rs + bz[1]); a1 = gelu4(a1 * rs + bz[2]); b1 = gelu4(b1 * rs + bz[3]);
        bf16_t* op = O + (size_t)row * 3072 + colb; store8_bf16(op, a0, b0); store8_bf16(op + 32, a1, b1);
        float s1 = (sum4(a0) + sum4(b0)) + (sum4(a1) + sum4(b1)), s2 = (sumsq4(a0) + sumsq4(b0)) + (sumsq4(a1) + sumsq4(b1));
        s1 += __shfl_xor(s1, 16); s1 += __shfl_xor(s1, 32); s2 += __shfl_xor(s2, 16); s2 += __shfl_xor(s2, 32);
        if (fq_ == 0) { atomic_addf(lnacc + 2 * (size_t)row, s1); atomic_addf(lnacc + 2 * (size_t)row + 1, s2); } } };
struct FGeluU { bf16_t* O; const float* ssq; const float* bias;
    f32x4 bz[4];
    __device__ __forceinline__ void begin(const Unit& u, int colb, int fq) { const int b = min(u.pm >> 4, 8); const float* bp = bias + (size_t)b * 6144 + colb;
        bz[0] = *(const f32x4*)bp; bz[1] = *(const f32x4*)(bp + 4); bz[2] = *(const f32x4*)(bp + 32); bz[3] = *(const f32x4*)(bp + 36); }
    __device__ __forceinline__ static f32x4 lo4(const u32x4 s) { return (f32x4){bf2f(s.x & 0xffffu), bf2f(s.x >> 16), bf2f(s.y & 0xffffu), bf2f(s.y >> 16)}; }
    __device__ __forceinline__ static f32x4 hi4(const u32x4 s) { return (f32x4){bf2f(s.z & 0xffffu), bf2f(s.z >> 16), bf2f(s.w & 0xffffu), bf2f(s.w >> 16)}; }
    __device__ __forceinline__ void row(int row, int colb, f32x4 a0, f32x4 b0, f32x4 a1, f32x4 b1) {
        const float rs = rstd_of(ssq, row);
        bf16_t* op = O + (size_t)row * 3072 + colb; const u32x4 sv0 = *(const u32x4*)op, sv1 = *(const u32x4*)(op + 32);
        a0 = gelu4(a0 * rs + bz[0]) * lo4(sv0); b0 = gelu4(b0 * rs + bz[1]) * hi4(sv0); a1 = gelu4(a1 * rs + bz[2]) * lo4(sv1); b1 = gelu4(b1 * rs + bz[3]) * hi4(sv1);
        store8_bf16(op, a0, b0); store8_bf16(op + 32, a1, b1); } };
struct FResid { const float* inl; const float* inc; float* outl; float* outc; const float* gate;
    const float* gsn; bf16_t* xb; float* ssqn;
    f32x4 gz[4], gsz[4]; int fq_;
    __device__ __forceinline__ void begin(const Unit& u, int colb, int fq) { const int b = min(u.pm >> 4, 8); fq_ = fq; const float* gp = gate + (size_t)b * 6144 + colb;
        gz[0] = *(const f32x4*)gp; gz[1] = *(const f32x4*)(gp + 4); gz[2] = *(const f32x4*)(gp + 32); gz[3] = *(const f32x4*)(gp + 36);
        if (gsn) { const float* sp = gsn + (size_t)b * 1024 + colb; gsz[0] = *(const f32x4*)sp; gsz[1] = *(const f32x4*)(sp + 4); gsz[2] = *(const f32x4*)(sp + 32); gsz[3] = *(const f32x4*)(sp + 36); } }
    __device__ __forceinline__ void row(int row, int colb, f32x4 a0, f32x4 b0, f32x4 a1, f32x4 b1) {
        const bool lat = row < NLAT;
        const float* ip = lat ? inl + (size_t)row * 1024 + colb : inc + (size_t)(row - NLAT) * 1024 + colb;
        float* op = lat ? outl + (size_t)row * 1024 + colb : outc + (size_t)(row - NLAT) * 1024 + colb;
        a0 = *(const f32x4*)ip + gz[0] * a0; b0 = *(const f32x4*)(ip + 4) + gz[1] * b0; a1 = *(const f32x4*)(ip + 32) + gz[2] * a1; b1 = *(const f32x4*)(ip + 36) + gz[3] * b1;
        *(f32x4*)op = a0; *(f32x4*)(op + 4) = b0; *(f32x4*)(op + 32) = a1; *(f32x4*)(op + 36) = b1;
        if (gsn) { float ss = (sumsq4(a0) + sumsq4(b0)) + (sumsq4(a1) + sumsq4(b1));
            ss += __shfl_xor(ss, 16); ss += __shfl_xor(ss, 32);
            if (fq_ == 0) atomic_addf(ssqn + row, ss);
            bf16_t* xp = xb + (size_t)row * 1024 + colb; store8_bf16(xp, a0 * gsz[0], b0 * gsz[1]); store8_bf16(xp + 32, a1 * gsz[2], b1 * gsz[3]); } } };

template <class F> __device__ __forceinline__ void run_gemm(LAS unsigned char* lds, const bf16_t* A, const bf16_t* Bt, int M, int N, int K, const F& f, const Tix T_) {
    pg8::StaticOrder S; S.init(M, N, T_.gsz, T_.bid);
    pg8::Gemm g; g.A = A; g.Bt = Bt; g.M = M; g.N = N; g.K = K;
    EpiG<F> E; E.f = f;
    pg8::gemm_phase<EpiG<F>, pg8::StaticOrder, true, true>(lds, g, S, E, T_.tid);
}

enum { OP_QKV, OP_ATTN, OP_MIXOUT, OP_MLP1, OP_MLP2, OP_VGEMM, OP_SPATIAL, OP_UGEMM, OP_PROLOGUE, OP_PHASE0B };

__device__ __forceinline__ void decode_phase(int ph, int& L, int& op) {
    L = 0; op = ph == 0 ? OP_PROLOGUE : OP_PHASE0B;
    if (ph > 1) {
        int q = ph - 2;
        if (q < 5) { L = 0; } else if (q < 11) { L = 1; q -= 5; } else if (q < 16) { L = 2; q -= 11; } else { L = 3; q -= 16; }
        if ((L & 1) == 0) op = q == 0 ? OP_QKV : q == 1 ? OP_ATTN : q == 2 ? OP_MIXOUT : q == 3 ? OP_MLP1 : OP_MLP2;
        else op = q == 0 ? OP_VGEMM : q == 1 ? OP_SPATIAL : q == 2 ? OP_UGEMM : q == 3 ? OP_MIXOUT : q == 4 ? OP_MLP1 : OP_MLP2;
    }
}

__device__ __forceinline__ void run_phase(const Params& p, int ph, LAS unsigned char* lds, const Tix T_) {
    int L, op; decode_phase(ph, L, op);
#ifdef ONLY_OP
    op = ONLY_OP;
#endif
    const int mi = L >> 1;
    const bool attnL = (L & 1) == 0;
    const int Mfull = L < 2 ? MTOT : NLAT;
    const float* modsl = (const float*)(p.ws + OFF_MODS) + (size_t)L * 9 * 6144;
    float* ctxr = (float*)(p.ws + OFF_CTXR);
    bf16_t* hb = (bf16_t*)(p.ws + OFF_HB); bf16_t* big = (bf16_t*)(p.ws + OFF_BIG);
    float* ssq = (float*)(p.ws + OFF_SSQ); const float* gs = (const float*)(p.ws + OFF_GS);
    const bool first = (L == 0);
    switch (op) {
    case OP_PROLOGUE: phase_zero(p, T_); phase_mods(p, lds, T_); __syncthreads(); phase_convert(p, lds, T_); break;
    case OP_PHASE0B: phase_0b(p, lds, T_); break;
    case OP_QKV: { FQKV f; f.O = big; f.qg = p.na_q_norm + mi * 64; f.kg = p.na_k_norm + mi * 64; f.ssq = ssq + (size_t)(2 * L) * MTOT; f.bias = (const float*)(p.ws + OFF_BQKV) + (size_t)mi * 9 * 3072;
        run_gemm(lds, hb, (const bf16_t*)(p.ws + OFF_QKVT) + (size_t)mi * 3072 * 1024, MTOT, 3072, 1024, f, T_); } break;
    case OP_ATTN: phase_attn_mfma(p, mi, L == 0, lds, T_); break;
    case OP_MIXOUT: case OP_MLP2: {
        FResid f; const bool mo = (op == OP_MIXOUT);
        f.inl = (first && mo) ? p.x : p.out; f.inc = (first && mo) ? p.ctx : ctxr; f.outl = p.out; f.outc = ctxr; f.gate = modsl + (mo ? 2048 : 5120);
        const int nn = mo ? 2 * L + 1 : 2 * L + 2;
        const bool has_next = nn < 8 && !(nn == 6 + 0 && false);
        f.gsn = has_next ? gs + (size_t)nn * 9 * 1024 : nullptr; f.xb = hb; f.ssqn = ssq + (size_t)(has_next ? nn : 0) * MTOT;
        const bf16_t* A; const bf16_t* Bt; int K;
        if (!mo) { A = big; Bt = (const bf16_t*)(p.ws + OFF_W2T) + (size_t)L * 1024 * 4096; K = 4096; }
        else if (attnL) { A = big + (size_t)MTOT * 3072; Bt = (const bf16_t*)(p.ws + OFF_WOT) + (size_t)mi * 1024 * 1024; K = 1024; }
        else { A = big; Bt = (const bf16_t*)(p.ws + OFF_SGOT) + (size_t)mi * 1024 * 3072; K = 3072; }
        run_gemm(lds, A, Bt, Mfull, 1024, K, f, T_); } break;
    case OP_MLP1: { FSqrelu f; f.O = big; f.ssq = ssq + (size_t)(2 * L + 1) * MTOT; f.bias = (const float*)(p.ws + OFF_BMLP) + (size_t)L * 9 * 4096;
        run_gemm(lds, hb, (const bf16_t*)(p.ws + OFF_W1T) + (size_t)L * 4096 * 1024, Mfull, 4096, 1024, f, T_); } break;
    case OP_VGEMM: { FGeluV f; f.O = big; f.ssq = ssq + (size_t)(2 * L) * MTOT; f.bias = (const float*)(p.ws + OFF_BWIN) + (size_t)mi * 9 * 6144 + 3072; f.lnacc = (float*)(p.ws + OFF_LNACC) + (size_t)mi * MTOT * 2;
        run_gemm(lds, hb, (const bf16_t*)(p.ws + OFF_WINT) + (size_t)mi * 6144 * 1024 + (size_t)3072 * 1024, Mfull, 3072, 1024, f, T_); } break;
    case OP_SPATIAL: phase_spatial_mfma(p, mi, Mfull, lds, T_); break;
    case OP_UGEMM: { FGeluU f; f.O = big; f.ssq = ssq + (size_t)(2 * L) * MTOT; f.bias = (const float*)(p.ws + OFF_BWIN) + (size_t)mi * 9 * 6144;
        run_gemm(lds, hb, (const bf16_t*)(p.ws + OFF_WINT) + (size_t)mi * 6144 * 1024, Mfull, 3072, 1024, f, T_); } break;
    default: break;
    }
}

#ifndef ONE_LAUNCH
#define ONE_LAUNCH 1
#endif
__global__ void __launch_bounds__(NTHREADS) mk(Params p0) {
    extern __shared__ __attribute__((aligned(16))) unsigned char lds_raw[];
    LAS unsigned char* lds = (LAS unsigned char*)lds_raw;
#if ONE_LAUNCH
    cg::grid_group grid = cg::this_grid();
    bool first_it = true, repeated = false;
    for (int ph = p0.ph_lo; ph < p0.ph_hi; ) {
        if (!first_it) grid.sync();
        first_it = false;
        Tix T_; T_.tid = threadIdx.x; T_.bid = blockIdx.x; T_.gsz = gridDim.x;
        size_t z = 0;
        asm volatile("" : "+v"(T_.tid)); asm volatile("" : "+s"(T_.bid), "+s"(T_.gsz), "+s"(z));
        Params p = p0;
        { const float** pp = (const float**)&p;
#pragma unroll
          for (int i = 0; i < 22; ++i) pp[i] += z; }
        p.out += z; p.ws += z;
        run_phase(p, ph, lds, T_);
        __syncthreads();
        if (REP_MASK != 0) { int L_, op_; decode_phase(ph, L_, op_); if (((REP_MASK >> op_) & 1) && !repeated) { repeated = true; continue; } }
        repeated = false; ++ph;
    }
#else
    Tix T_; T_.tid = threadIdx.x; T_.bid = blockIdx.x; T_.gsz = gridDim.x;
    run_phase(p0, p0.ph_lo, lds, T_);
#endif
}

extern "C" void kernel_launch(void* const* d_in, const int* in_sizes, int n_in, void* d_out, int out_size, void* d_ws, size_t ws_size, hipStream_t stream) {
    static int grid = 0;
    if (grid == 0) {
        if (n_in != 22 || ws_size < WS_END) { fprintf(stderr, "kernel_launch: unexpected n_in %d or ws_size %zu (< %zu)\n", n_in, ws_size, (size_t)WS_END); grid = -1; return; }
        int dev = 0, cus = 0, per_cu = 0;
        hipGetDevice(&dev); hipDeviceGetAttribute(&cus, hipDeviceAttributeMultiprocessorCount, dev);
        if (hipFuncSetAttribute((const void*)mk, hipFuncAttributeMaxDynamicSharedMemorySize, LDS_BYTES) != hipSuccess) { fprintf(stderr, "kernel_launch: hipFuncSetAttribute failed\n"); grid = -1; return; }
        if (hipOccupancyMaxActiveBlocksPerMultiprocessor(&per_cu, (const void*)mk, NTHREADS, LDS_BYTES) != hipSuccess || per_cu < 1) { fprintf(stderr, "kernel_launch: occupancy query says %d\n", per_cu); per_cu = 1; }
        (void)hipGetLastError();
        grid = cus;
    }
    if (grid < 0) return;
    Params p{};
    const float** pp = (const float**)&p;
    for (int i = 0; i < 22; ++i) pp[i] = (const float*)d_in[i];
    p.out = (float*)d_out; p.ws = (unsigned char*)d_ws;
#if ONE_LAUNCH
    p.ph_lo = 0; p.ph_hi = NPH;
    void* args[] = {&p};
    hipError_t e = hipLaunchCooperativeKernel((void*)mk, dim3(grid), dim3(NTHREADS), args, LDS_BYTES, stream);
    if (e != hipSuccess) fprintf(stderr, "cooperative launch failed: %s (grid %d)\n", hipGetErrorString(e), grid);
#else
    for (int ph = 0; ph < NPH; ++ph) { p.ph_lo = ph; p.ph_hi = ph + 1; hipLaunchKernelGGL(mk, dim3(grid), dim3(NTHREADS), LDS_BYTES, stream, p); }
#endif
}
```

```cpp
#include <hip/hip_runtime.h>
#include <hip/hip_cooperative_groups.h>
#include <cstdio>
#include <cstdint>
namespace cg = cooperative_groups;
namespace pg8 {
#define PG8_LAS __attribute__((address_space(3)))
typedef unsigned short bf16_t;
typedef short bf16x8 __attribute__((ext_vector_type(8)));
typedef float f32x4 __attribute__((ext_vector_type(4)));
typedef unsigned u32x4 __attribute__((ext_vector_type(4)));
constexpr int BM = 256, BK = 64, HALF = 128, HTB = HALF * BK * 2  , STAGE_BYTES = 8 * HTB, NXCD = 8, WGM = 8;

__host__ __device__ __forceinline__ int lds_byte(int r, int c) { const int st = (r >> 4) * 2 + (c >> 5), rr = r & 15, cc = c & 31, ob = rr * 64 + cc * 2; return st * 1024 + (ob ^ (((ob >> 9) & 1) << 5)); }
__host__ __device__ __forceinline__ void stage_rc(int b, int& R, int& C) { const int st = b / 1024, sb = b % 1024, swz = sb ^ (((sb >> 9) & 1) << 5); R = (st >> 1) * 16 + swz / 64; C = (st & 1) * 32 + (swz % 64) / 2; }
__host__ __device__ __forceinline__ int perm32(int rho) { const int n = rho >> 4, i = rho & 15; return 8 * (i >> 2) + 4 * n + (i & 3); }

struct Unit { int pm, pn; };
struct Gemm { const bf16_t* A; const bf16_t* Bt; int M, N, K; };

struct StaticOrder {
    int nM, nN, nwg, G, c;
    __host__ __device__ void init(int M, int N, int G_, int c_) { nM = M / BM; nN = N / BM; nwg = nM * nN; G = G_; c = c_; }
    __host__ __device__ bool next(int i, Unit& u) const {
        const long L = (long)i * G + c; if (L >= nwg) return false;
        int wgid = (int)L; { const int q = nwg / NXCD, r = nwg % NXCD, xcd = wgid % NXCD, off = wgid / NXCD; wgid = (xcd < r ? xcd * (q + 1) : r * (q + 1) + (xcd - r) * q) + off; }
        const int nig = WGM * nN, gid = wgid / nig, fm = gid * WGM, gsz = (nM - fm) < WGM ? (nM - fm) : WGM;
        u.pm = fm + ((wgid % nig) % gsz); u.pn = (wgid % nig) / gsz; return true;
    }
    __device__ __forceinline__ void a_ready(const Unit&) const {}
    __device__ __forceinline__ void done(const Unit&) const {}
};

__device__ __forceinline__ unsigned cvt_pk_bf16(float lo, float hi) { unsigned r; asm volatile("v_cvt_pk_bf16_f32 %0, %1, %2" : "=v"(r) : "v"(lo), "v"(hi)); return r; }
template <class Epi, class Sched, bool ALIGN_EPI = false, bool SP2 = false>
__device__ __forceinline__ void gemm_phase(PG8_LAS unsigned char* lds, const Gemm g, const Sched& S, const Epi& E, const int tid_in) {
    const int tid = tid_in, wid = __builtin_amdgcn_readfirstlane(tid >> 6), lane = tid & 63, wr = wid >> 2, wc = wid & 3, fr = lane & 15, fq = lane >> 4;
    const int K = g.K, nt = K / BK;
    unsigned voffA[2], voffB[2];
#pragma unroll
    for (int i = 0; i < 2; ++i) { int R, C; stage_rc(tid * 16 + i * 8192, R, C); const int Rb = Epi::PERM ? ((R & ~31) + perm32(R & 31)) : R;
        voffA[i] = (unsigned)(R * K + C) * 2u; voffB[i] = (unsigned)(Rb * K + C) * 2u; }
    const size_t kstep = (size_t)(BK * 2);
    const size_t hstep = (size_t)HALF * K * 2;
    const size_t tstep = 2 * hstep;
    const unsigned ldsw = (unsigned)wid * 1024u;
    const int aoff = lds_byte(wr * 64 + fr, fq * 8), boff = lds_byte(wc * 32 + fr, fq * 8);
#define PG8_SA(b, h) (((b) * 2 + (h)) * HTB)
#define PG8_SB(b, h) ((4 + (b) * 2 + (h)) * HTB)
#define PG8_STAGE(bufoff, gbase, voff) do { _Pragma("unroll") for (int _i = 0; _i < 2; ++_i) \
        __builtin_amdgcn_global_load_lds((const unsigned*)((const char*)(gbase) + (voff)[_i]), (PG8_LAS unsigned*)(lds + (bufoff) + ldsw + _i * 8192), 16, 0, 0); } while (0)
#define PG8_LDA(dst, b, h) do { _Pragma("unroll") for (int m = 0; m < 4; ++m) _Pragma("unroll") for (int k = 0; k < 2; ++k) dst[m][k] = *(const PG8_LAS bf16x8*)(lds + PG8_SA(b, h) + aoff + m * 2048 + k * 1024); } while (0)
#define PG8_LDB(dst, b, h) do { _Pragma("unroll") for (int n = 0; n < 2; ++n) _Pragma("unroll") for (int k = 0; k < 2; ++k) dst[n][k] = *(const PG8_LAS bf16x8*)(lds + PG8_SB(b, h) + boff + n * 2048 + k * 1024); } while (0)
#define PG8_MMA(ai, bj, At, Bt) do { __builtin_amdgcn_s_setprio(1); _Pragma("unroll") for (int m = 0; m < 4; ++m) _Pragma("unroll") for (int n = 0; n < 2; ++n) _Pragma("unroll") for (int k = 0; k < 2; ++k) \
        acc[ai][bj][m][n] = __builtin_amdgcn_mfma_f32_16x16x32_bf16(Bt[n][k], At[m][k], acc[ai][bj][m][n], 0, 0, 0); __builtin_amdgcn_s_setprio(0); } while (0)
#define PG8_WAIT_V(n) asm volatile("s_waitcnt vmcnt(" #n ")" ::: "memory")
#define PG8_WAIT_L(n) asm volatile("s_waitcnt lgkmcnt(" #n ")" ::: "memory")
#define PG8_BAR __builtin_amdgcn_s_barrier()
#define PG8_SCHED __builtin_amdgcn_sched_barrier(0)
    Unit cur, nxt; int ui = 0;
    if (!S.next(0, cur)) return;
    f32x4 acc[2][2][4][2];
#pragma unroll
    for (int a = 0; a < 2; ++a)
#pragma unroll
        for (int b = 0; b < 2; ++b)
#pragma unroll
            for (int m = 0; m < 4; ++m)
#pragma unroll
                for (int n = 0; n < 2; ++n) acc[a][b][m][n] = (f32x4){0.f, 0.f, 0.f, 0.f};
    bf16x8 At[4][2], B0[2][2], B1[2][2];
    const char* cA = (const char*)g.A + (size_t)cur.pm * tstep; const char* cB = (const char*)g.Bt + (size_t)cur.pn * tstep;
    S.a_ready(cur);
    if constexpr (SP2) {
        PG8_STAGE(PG8_SB(0, 0), cB, voffB); PG8_STAGE(PG8_SB(0, 1), cB + hstep, voffB); PG8_STAGE(PG8_SA(0, 0), cA, voffA); PG8_STAGE(PG8_SA(0, 1), cA + hstep, voffA);
        if (wr == 1) PG8_BAR;
        PG8_WAIT_V(2); PG8_BAR;
        PG8_STAGE(PG8_SB(1, 0), cB + kstep, voffB); PG8_STAGE(PG8_SA(1, 0), cA + kstep, voffA); PG8_STAGE(PG8_SB(1, 1), cB + hstep + kstep, voffB);
        PG8_WAIT_V(6); PG8_BAR;
    } else {
        PG8_STAGE(PG8_SB(0, 0), cB, voffB); PG8_STAGE(PG8_SA(0, 0), cA, voffA); PG8_STAGE(PG8_SB(0, 1), cB + hstep, voffB); PG8_STAGE(PG8_SA(0, 1), cA + hstep, voffA);
        if (wr == 1) PG8_BAR;
        PG8_WAIT_V(4); PG8_BAR;
        PG8_STAGE(PG8_SB(1, 0), cB + kstep, voffB); PG8_STAGE(PG8_SA(1, 0), cA + kstep, voffA); PG8_STAGE(PG8_SB(1, 1), cB + hstep + kstep, voffB);
        PG8_WAIT_V(6); PG8_BAR;
    }
    for (;;) {
        const bool has_next = S.next(ui + 1, nxt);
        const char* nA = has_next ? (const char*)g.A + (size_t)nxt.pm * tstep : cA; const char* nB = has_next ? (const char*)g.Bt + (size_t)nxt.pn * tstep : cB;
        for (int t = 0; t < nt; t += 2) {
            const bool last = (t == nt - 2);
            const char* a1 = cA + (size_t)(t + 1) * kstep;
            const char* a2 = last ? nA : cA + (size_t)(t + 2) * kstep; const char* b2 = last ? nB : cB + (size_t)(t + 2) * kstep;
            const char* a3 = a2 + kstep; const char* b3 = b2 + kstep;
            if (last && has_next) S.a_ready(nxt);
            if constexpr (SP2) {
            PG8_LDB(B0, 0, 0); PG8_LDB(B1, 0, 1); PG8_SCHED; PG8_LDA(At, 0, 0); PG8_STAGE(PG8_SA(1, 1), a1 + hstep, voffA);
            PG8_WAIT_V(8); PG8_WAIT_L(0); PG8_BAR; PG8_MMA(0, 0, At, B0); PG8_MMA(0, 1, At, B1); PG8_BAR; PG8_SCHED;
            PG8_LDA(At, 0, 1); PG8_STAGE(PG8_SB(0, 0), b2, voffB); PG8_STAGE(PG8_SB(0, 1), b2 + hstep, voffB); PG8_STAGE(PG8_SA(0, 0), a2, voffA);
            PG8_WAIT_V(8); PG8_WAIT_L(0); PG8_BAR; PG8_MMA(1, 0, At, B0); PG8_MMA(1, 1, At, B1); PG8_BAR; PG8_SCHED;
            PG8_LDB(B0, 1, 0); PG8_LDB(B1, 1, 1); PG8_SCHED; PG8_LDA(At, 1, 0); PG8_STAGE(PG8_SA(0, 1), a2 + hstep, voffA);
            PG8_WAIT_V(8); PG8_WAIT_L(0); PG8_BAR; PG8_MMA(0, 0, At, B0); PG8_MMA(0, 1, At, B1); PG8_BAR; PG8_SCHED;
            PG8_LDA(At, 1, 1); PG8_STAGE(PG8_SB(1, 0), b3, voffB); PG8_STAGE(PG8_SB(1, 1), b3 + hstep, voffB); PG8_STAGE(PG8_SA(1, 0), a3, voffA);
            PG8_WAIT_V(8); PG8_WAIT_L(0); PG8_BAR; PG8_MMA(1, 0, At, B0); PG8_MMA(1, 1, At, B1); PG8_BAR; PG8_SCHED;
            } else {
            PG8_LDB(B0, 0, 0); PG8_SCHED; PG8_LDA(At, 0, 0); PG8_STAGE(PG8_SA(1, 1), a1 + hstep, voffA);
            PG8_WAIT_L(8); PG8_BAR; PG8_WAIT_L(0); PG8_MMA(0, 0, At, B0); PG8_BAR; PG8_SCHED;
            PG8_LDB(B1, 0, 1); PG8_STAGE(PG8_SB(0, 0), b2, voffB);
            PG8_BAR; PG8_WAIT_L(0); PG8_MMA(0, 1, At, B1); PG8_BAR;
            PG8_LDA(At, 0, 1); PG8_STAGE(PG8_SA(0, 0), a2, voffA);
            PG8_BAR; PG8_WAIT_L(0); PG8_MMA(1, 0, At, B0); PG8_BAR; PG8_SCHED;
            PG8_STAGE(PG8_SB(0, 1), b2 + hstep, voffB);
            PG8_WAIT_V(6); PG8_BAR; PG8_MMA(1, 1, At, B1); PG8_BAR;
            PG8_LDB(B0, 1, 0); PG8_SCHED; PG8_LDA(At, 1, 0); PG8_STAGE(PG8_SA(0, 1), a2 + hstep, voffA);
            PG8_WAIT_L(8); PG8_BAR; PG8_WAIT_L(0); PG8_MMA(0, 0, At, B0); PG8_BAR; PG8_SCHED;
            PG8_LDB(B1, 1, 1); PG8_STAGE(PG8_SB(1, 0), b3, voffB);
            PG8_BAR; PG8_WAIT_L(0); PG8_MMA(0, 1, At, B1); PG8_BAR;
            PG8_LDA(At, 1, 1); PG8_STAGE(PG8_SA(1, 0), a3, voffA);
            PG8_BAR; PG8_WAIT_L(0); PG8_MMA(1, 0, At, B0); PG8_BAR; PG8_SCHED;
            PG8_STAGE(PG8_SB(1, 1), b3 + hstep, voffB);
            PG8_WAIT_V(6); PG8_BAR; PG8_MMA(1, 1, At, B1); PG8_BAR;
            }
        }
        if constexpr (ALIGN_EPI) { if (wr == 0) PG8_BAR; }
        if constexpr (!Epi::AFTER_DRAIN) { E(acc, cur, wr, wc, fr, fq); S.done(cur); }
        if (!has_next) break;
#pragma unroll
        for (int a = 0; a < 2; ++a)
#pragma unroll
            for (int b = 0; b < 2; ++b)
#pragma unroll
                for (int m = 0; m < 4; ++m)
#pragma unroll
                    for (int n = 0; n < 2; ++n) acc[a][b][m][n] = (f32x4){0.f, 0.f, 0.f, 0.f};
        cur = nxt; cA = nA; cB = nB; ++ui;
        if constexpr (ALIGN_EPI) { if (wr == 1) PG8_BAR; }
    }
    PG8_WAIT_V(0);
    if constexpr (!ALIGN_EPI) { if (wr == 0) PG8_BAR; }
    PG8_BAR;
    if constexpr (Epi::AFTER_DRAIN) { E.fused(acc, cur, wr, wc, fr, fq, lds, wid, lane); S.done(cur); }
#undef PG8_SA
#undef PG8_SB
#undef PG8_STAGE
#undef PG8_LDA
#undef PG8_LDB
#undef PG8_MMA
#undef PG8_WAIT_V
#undef PG8_WAIT_L
#undef PG8_BAR
#undef PG8_SCHED
}
}

#ifndef REP_MASK
#define REP_MASK 0
#endif
#ifndef NAIVE_ATTN
#define NAIVE_ATTN 0
#endif
#ifndef NAIVE_SPATIAL
#define NAIVE_SPATIAL 0
#endif
#define LAS __attribute__((address_space(3)))
using pg8::bf16_t; using pg8::f32x4; using pg8::Unit; using pg8::u32x4;
typedef unsigned u32x2 __attribute__((ext_vector_type(2)));

constexpr int NLAT = 32768, NCTX = 2048, MTOT = 34816;
constexpr int NTHREADS = 512;
constexpr int LDS_BYTES = 131072;
constexpr int NPH = 24;

constexpr size_t OFF_W1T = 0;
constexpr size_t OFF_W2T = OFF_W1T + 4ull * 4096 * 1024 * 2;
constexpr size_t OFF_QKVT = OFF_W2T + 4ull * 4096 * 1024 * 2;
constexpr size_t OFF_WOT = OFF_QKVT + 2ull * 3072 * 1024 * 2;
constexpr size_t OFF_WINT = OFF_WOT + 2ull * 1024 * 1024 * 2;
constexpr size_t OFF_SGOT = OFF_WINT + 2ull * 6144 * 1024 * 2;
constexpr size_t OFF_MODS = OFF_SGOT + 2ull * 1024 * 3072 * 2;
constexpr size_t OFF_CTXR = OFF_MODS + 4ull * 9 * 6144 * 4;
constexpr size_t OFF_HB = OFF_CTXR + 2048ull * 1024 * 4;
constexpr size_t OFF_BIG = OFF_HB + 34816ull * 1024 * 2;
constexpr size_t OFF_SSQ = OFF_BIG + 34816ull * 4096 * 2;
constexpr size_t OFF_LNACC = OFF_SSQ + 8ull * 34816 * 4;
constexpr size_t OFF_GS = OFF_LNACC + 2ull * 34816 * 2 * 4;
constexpr size_t OFF_BQKV = OFF_GS + 8ull * 9 * 1024 * 4;
constexpr size_t OFF_BMLP = OFF_BQKV + 2ull * 9 * 3072 * 4;
constexpr size_t OFF_BWIN = OFF_BMLP + 4ull * 9 * 4096 * 4;
constexpr size_t WS_END = OFF_BWIN + 2ull * 9 * 6144 * 4;

struct Params {
    const float *x, *c, *ctx, *c_ctx, *ada_w, *ada_b, *norm1_g, *norm2_g, *mlp_w1, *mlp_w2, *na_w_qkv, *na_q_norm, *na_k_norm, *na_rpb, *na_w_o,
        *sg_w_in, *sg_b_in, *sg_ln_g, *sg_ln_b, *sg_w_s, *sg_b_s, *sg_w_o;
    float* out; unsigned char* ws; int ph_lo, ph_hi;
};

struct Tix { int tid, bid, gsz; };
__device__ __forceinline__ float bf2f(unsigned h) { return __uint_as_float(h << 16); }
__device__ __forceinline__ unsigned f2bf(float f) { unsigned u = __float_as_uint(f); u += 0x7FFFu + ((u >> 16) & 1u); return u >> 16; }
__device__ __forceinline__ unsigned pk2(float lo, float hi) { return pg8::cvt_pk_bf16(lo, hi); }
__device__ __forceinline__ float wave_sum(float v) {
#pragma unroll
    for (int o = 1; o < 64; o <<= 1) v += __shfl_xor(v, o);
    return v;
}
__device__ __forceinline__ float wave_max(float v) {
#pragma unroll
    for (int o = 1; o < 64; o <<= 1) v = fmaxf(v, __shfl_xor(v, o));
    return v;
}
#define LDS_WAIT() asm volatile("s_waitcnt lgkmcnt(0)" ::: "memory")
__device__ __forceinline__ float silu_f(float v) { return v / (1.f + expf(-v)); }
__device__ __forceinline__ float gelu_f(float v) { return 0.5f * v * (1.f + erff(v * 0.70710678118654752f)); }

typedef float f32x2 __attribute__((ext_vector_type(2)));
__device__ __forceinline__ f32x2 gelu_pk(f32x2 v) {
    const f32x2 av = __builtin_elementwise_abs(v), d = av * 0.2316418882f + 1.0f;
    f32x2 t; t.x = __builtin_amdgcn_rcpf(d.x); t.y = __builtin_amdgcn_rcpf(d.y);
    f32x2 q = t * 0.5307027145f + (-0.7265760135f); q = q * t + 0.7107068705f; q = q * t + (-0.142248368f); q = q * t + 0.127414796f; q = q * t;
    const f32x2 s = (v * v) * (-0.72134752044f);
    f32x2 e; e.x = __builtin_amdgcn_exp2f(s.x); e.y = __builtin_amdgcn_exp2f(s.y);
    const f32x2 m = v * (q * e), r = v - m;
    f32x2 o; o.x = v.x < 0.f ? m.x : r.x; o.y = v.y < 0.f ? m.y : r.y; return o;
}
__device__ __forceinline__ f32x4 gelu4(f32x4 v) { const f32x2 a = gelu_pk((f32x2){v.x, v.y}), b = gelu_pk((f32x2){v.z, v.w}); return (f32x4){a.x, a.y, b.x, b.y}; }

__device__ __forceinline__ int sigma_inv(int L) { return 128 * ((L >> 5) & 1) + 32 * (L >> 6) + 16 * ((L >> 2) & 1) + 4 * ((L >> 3) & 3) + (L & 3); }

__device__ __forceinline__ void phase_mods(const Params& p, LAS unsigned char* lds, const Tix T_) {
    LAS float* sc = (LAS float*)lds;
    LAS float* red = (LAS float*)(lds + 36864);
    float* mods = (float*)(p.ws + OFF_MODS);
    const int tid = T_.tid;
    for (int i = tid; i < 9 * 1024; i += NTHREADS) { const int b = i >> 10, k = i & 1023; const float v = b < 8 ? p.c[b * 1024 + k] : p.c_ctx[k]; sc[i] = silu_f(v); }
    __syncthreads();
    const int c4 = (tid & 15) * 4, kk = tid >> 4;
    for (int item = T_.bid; item < 384; item += T_.gsz) {
        const int l = item / 96, n0 = (item % 96) * 64;
        const float* W = p.ada_w + (size_t)l * 1024 * 6144 + n0 + c4;
        f32x4 acc[9];
#pragma unroll
        for (int b = 0; b < 9; ++b) acc[b] = (f32x4){0.f, 0.f, 0.f, 0.f};
#pragma unroll 4
        for (int i = 0; i < 32; ++i) { const int k = kk + 32 * i; const f32x4 w = *(const f32x4*)(W + (size_t)k * 6144);
#pragma unroll
            for (int b = 0; b < 9; ++b) acc[b] += sc[b * 1024 + k] * w; }
#pragma unroll
        for (int b = 0; b < 9; ++b) *(LAS f32x4*)(red + (kk * 9 + b) * 64 + c4) = acc[b];
        __syncthreads();
        for (int o = tid; o < 576; o += NTHREADS) { const int b = o >> 6, cc = o & 63; float s = 0.f;
            for (int j = 0; j < 32; ++j) s += red[(j * 9 + b) * 64 + cc];
            mods[(size_t)(l * 9 + b) * 6144 + n0 + cc] = s + p.ada_b[l * 6144 + n0 + cc]; }
        __syncthreads();
    }
}

struct MatDesc { const float* src; bf16_t* dst; int K, N; };
__device__ __forceinline__ MatDesc get_mat(const Params& p, int mi) {
    MatDesc m;
    if (mi < 4) { m.src = p.mlp_w1 + (size_t)mi * 1024 * 4096; m.dst = (bf16_t*)(p.ws + OFF_W1T) + (size_t)mi * 4096 * 1024; m.K = 1024; m.N = 4096; }
    else if (mi < 8) { const int l = mi - 4; m.src = p.mlp_w2 + (size_t)l * 4096 * 1024; m.dst = (bf16_t*)(p.ws + OFF_W2T) + (size_t)l * 1024 * 4096; m.K = 4096; m.N = 1024; }
    else if (mi < 10) { const int a = mi - 8; m.src = p.na_w_qkv + (size_t)a * 1024 * 3072; m.dst = (bf16_t*)(p.ws + OFF_QKVT) + (size_t)a * 3072 * 1024; m.K = 1024; m.N = 3072; }
    else if (mi < 12) { const int a = mi - 10; m.src = p.na_w_o + (size_t)a * 1024 * 1024; m.dst = (bf16_t*)(p.ws + OFF_WOT) + (size_t)a * 1024 * 1024; m.K = 1024; m.N = 1024; }
    else if (mi < 14) { const int s = mi - 12; m.src = p.sg_w_in + (size_t)s * 1024 * 6144; m.dst = (bf16_t*)(p.ws + OFF_WINT) + (size_t)s * 6144 * 1024; m.K = 1024; m.N = 6144; }
    else { const int s = mi - 14; m.src = p.sg_w_o + (size_t)s * 3072 * 1024; m.dst = (bf16_t*)(p.ws + OFF_SGOT) + (size_t)s * 1024 * 3072; m.K = 3072; m.N = 1024; }
    return m;
}
__device__ __forceinline__ void transpose_item(const float* W, int K, int N, bf16_t* WT, LAS float* scr, int item, int lane) {
    const int nblk = N / 32, kb = item / nblk, nb = item % nblk, k0 = 64 * kb, n0 = 32 * nb;
#pragma unroll 8
    for (int i = 0; i < 32; ++i) { const int kk = 2 * i + (lane >> 5); scr[kk * 33 + (lane & 31)] = W[(size_t)(k0 + kk) * N + n0 + (lane & 31)]; }
    LDS_WAIT();
    const int c = lane & 7;
#pragma unroll
    for (int j = 0; j < 4; ++j) { const int n = (lane >> 3) + 8 * j; const LAS float* s = scr + (8 * c) * 33 + n;
        u32x4 o; o.x = pk2(s[0 * 33], s[1 * 33]); o.y = pk2(s[2 * 33], s[3 * 33]); o.z = pk2(s[4 * 33], s[5 * 33]); o.w = pk2(s[6 * 33], s[7 * 33]);
        const int nl = n0 + n, drow = (nl & ~255) + sigma_inv(nl & 255);
        *(u32x4*)(WT + (size_t)drow * K + k0 + 8 * c) = o; }
    LDS_WAIT();
}
__device__ __forceinline__ void phase_convert(const Params& p, LAS unsigned char* lds, const Tix T_) {
    const int lane = T_.tid & 63, wave = T_.tid >> 6, gw = T_.bid * 8 + wave, NGW = T_.gsz * 8;
    LAS float* scr = (LAS float*)(lds + wave * 8704);
    for (int mi = 0; mi < 16; ++mi) {
        const MatDesc m = get_mat(p, mi);
        const int nitems = (m.K / 64) * (m.N / 32);
        for (int it = gw; it < nitems; it += NGW) transpose_item(m.src, m.K, m.N, m.dst, scr, it, lane);
    }
}


__device__ __forceinline__ void phase_zero(const Params& p, const Tix T_) {
    float* z0 = (float*)(p.ws + OFF_SSQ) + MTOT; const int n0 = 7 * MTOT + 2 * MTOT * 2;
    for (int i = T_.bid * NTHREADS + T_.tid; i < n0; i += T_.gsz * NTHREADS) z0[i] = 0.f;
}
__device__ __forceinline__ void phase_0b(const Params& p, LAS unsigned char* lds, const Tix T_) {
    const float* mods = (const float*)(p.ws + OFF_MODS);
    const int tid = T_.tid, lane = tid & 63, wave = tid >> 6, gw = T_.bid * 8 + wave, NGW = T_.gsz * 8;
    { float* gs = (float*)(p.ws + OFF_GS);
      for (int i = T_.bid * NTHREADS + tid; i < 8 * 9 * 1024; i += T_.gsz * NTHREADS) { const int n = i / 9216, rem = i % 9216, b = rem >> 10, c = rem & 1023, L = n >> 1;
          const float g = (n & 1) ? p.norm2_g[L * 1024 + c] : p.norm1_g[L * 1024 + c];
          gs[i] = g * (1.0f + mods[(size_t)(L * 9 + b) * 6144 + ((n & 1) ? 4096 : 1024) + c]); } }
    { bf16_t* hb = (bf16_t*)(p.ws + OFF_HB); float* ssq0 = (float*)(p.ws + OFF_SSQ);
      for (int row = gw; row < MTOT; row += NGW) {
          const float* xr = row < NLAT ? p.x + (size_t)row * 1024 : p.ctx + (size_t)(row - NLAT) * 1024;
          const int b = row < NLAT ? (row >> 12) : 8;
          f32x4 v[4]; float ss = 0.f;
#pragma unroll
          for (int j = 0; j < 4; ++j) { v[j] = *(const f32x4*)(xr + 4 * lane + 256 * j); ss += (v[j].x * v[j].x + v[j].y * v[j].y) + (v[j].z * v[j].z + v[j].w * v[j].w); }
          ss = wave_sum(ss);
          if (lane == 0) ssq0[row] = ss;
#pragma unroll
          for (int j = 0; j < 4; ++j) { const int col = 4 * lane + 256 * j;
              const f32x4 gv = *(const f32x4*)(p.norm1_g + col), scv = *(const f32x4*)(mods + (size_t)b * 6144 + 1024 + col);
              const f32x4 o = v[j] * gv * (1.0f + scv);
              u32x2 w; w.x = pk2(o.x, o.y); w.y = pk2(o.z, o.w);
              *(u32x2*)(hb + (size_t)row * 1024 + col) = w; } } }
    LAS float* sh = (LAS float*)lds;
    for (int cmb = 0; cmb < 8; ++cmb) {
        int L, shoff, N; const bf16_t* Bt; float* dst; const float* addb = nullptr;
        if (cmb < 2) { L = 2 * cmb; shoff = 0; N = 3072; Bt = (const bf16_t*)(p.ws + OFF_QKVT) + (size_t)cmb * 3072 * 1024; dst = (float*)(p.ws + OFF_BQKV) + (size_t)cmb * 9 * 3072; }
        else if (cmb < 6) { L = cmb - 2; shoff = 3072; N = 4096; Bt = (const bf16_t*)(p.ws + OFF_W1T) + (size_t)L * 4096 * 1024; dst = (float*)(p.ws + OFF_BMLP) + (size_t)L * 9 * 4096; }
        else { const int sl = cmb - 6; L = 2 * sl + 1; shoff = 0; N = 6144; Bt = (const bf16_t*)(p.ws + OFF_WINT) + (size_t)sl * 6144 * 1024; dst = (float*)(p.ws + OFF_BWIN) + (size_t)sl * 9 * 6144; addb = p.sg_b_in + sl * 6144; }
        __syncthreads();
        for (int i = tid; i < 9 * 1024; i += NTHREADS) sh[i] = mods[(size_t)(L * 9 + (i >> 10)) * 6144 + shoff + (i & 1023)];
        __syncthreads();
        for (int n = gw; n < N; n += NGW) {
            const bf16_t* wr_ = Bt + (size_t)((n & ~255) + sigma_inv(n & 255)) * 1024 + lane * 8;
            const u32x4 w0 = *(const u32x4*)wr_, w1 = *(const u32x4*)(wr_ + 512);
            float wv[16];
#pragma unroll
            for (int e = 0; e < 4; ++e) { wv[2 * e] = bf2f(w0[e] & 0xffffu); wv[2 * e + 1] = bf2f(w0[e] >> 16); wv[8 + 2 * e] = bf2f(w1[e] & 0xffffu); wv[8 + 2 * e + 1] = bf2f(w1[e] >> 16); }
            const float ab = addb ? addb[n] : 0.f;
#pragma unroll
            for (int b = 0; b < 9; ++b) {
                const f32x4 s0 = *(const LAS f32x4*)(sh + b * 1024 + lane * 8), s1 = *(const LAS f32x4*)(sh + b * 1024 + lane * 8 + 4);
                const f32x4 s2 = *(const LAS f32x4*)(sh + b * 1024 + 512 + lane * 8), s3 = *(const LAS f32x4*)(sh + b * 1024 + 512 + lane * 8 + 4);
                float a = (wv[0] * s0.x + wv[1] * s0.y) + (wv[2] * s0.z + wv[3] * s0.w) + (wv[4] * s1.x + wv[5] * s1.y) + (wv[6] * s1.z + wv[7] * s1.w)
                        + (wv[8] * s2.x + wv[9] * s2.y) + (wv[10] * s2.z + wv[11] * s2.w) + (wv[12] * s3.x + wv[13] * s3.y) + (wv[14] * s3.z + wv[15] * s3.w);
                a = wave_sum(a);
                if (lane == 0) dst[(size_t)b * N + n] = a + ab; }
        }
    }
}

typedef short s16x4 __attribute__((ext_vector_type(4)));
typedef short s16x8 __attribute__((ext_vector_type(8)));
typedef float f32x16 __attribute__((ext_vector_type(16)));
typedef __bf16 bf16x2_t __attribute__((ext_vector_type(2)));
__device__ __forceinline__ unsigned pkb(float a, float b) { const f32x2 v = {a, b}; const bf16x2_t r = __builtin_convertvector(v, bf16x2_t); return __builtin_bit_cast(unsigned, r); }
__device__ __forceinline__ s16x8 pack8(float a0, float a1, float a2, float a3, float a4, float a5, float a6, float a7) {
    u32x4 w; w.x = pkb(a0, a1); w.y = pkb(a2, a3); w.z = pkb(a4, a5); w.w = pkb(a6, a7); return __builtin_bit_cast(s16x8, w); }
__device__ __forceinline__ s16x8 tr_pair(const LAS unsigned char* a0, int second_off) {
    const s16x4 a = __builtin_amdgcn_ds_read_tr16_b64_v4i16((LAS s16x4*)a0);
    const s16x4 b = __builtin_amdgcn_ds_read_tr16_b64_v4i16((LAS s16x4*)(a0 + second_off));
    s16x8 r; r[0] = a[0]; r[1] = a[1]; r[2] = a[2]; r[3] = a[3]; r[4] = b[0]; r[5] = b[1]; r[6] = b[2]; r[7] = b[3]; return r; }
#define MFMA32(a, b, c) __builtin_amdgcn_mfma_f32_32x32x16_bf16((a), (b), (c), 0, 0, 0)

constexpr int AV_STR = 144;
__device__ __forceinline__ f32x16 attn_qk(const s16x8 (&Kf)[4], const s16x8 (&Qf)[4]) {
    f32x16 S;
#pragma unroll
    for (int i = 0; i < 16; ++i) S[i] = 0.f;
#pragma unroll
    for (int ks = 0; ks < 4; ++ks) S = MFMA32(Kf[ks], Qf[ks], S);
    return S;
}
__device__ __forceinline__ float tabv(const LAS unsigned char* tabrow, int off) { return *(const LAS float*)(tabrow + off); }
__device__ __forceinline__ void attn_one_tile(const s16x8 (&Kf)[4], const s16x8 (&Qf)[4], const LAS unsigned char* vb, const LAS unsigned char* tabrow, const unsigned (&offo)[4], const unsigned offx,
                                              f32x16& O0, f32x16& O1, float& lsum, int mode, float mbl) {
    const f32x16 S = attn_qk(Kf, Qf);
    float pv[16];
    if (mode == 0) {
#pragma unroll
        for (int i = 0; i < 16; ++i) pv[i] = __builtin_amdgcn_exp2f(S[i] - mbl);
    } else if (mode == 1) {
#pragma unroll
        for (int i = 0; i < 16; ++i) pv[i] = __builtin_amdgcn_exp2f(S[i] + tabv(tabrow, (int)((offo[i >> 2] >> (8 * (i & 3))) & 0xffu)));
    } else {
#pragma unroll
        for (int i = 0; i < 16; ++i) pv[i] = 0.f;
        if (mode == 2) {
#pragma unroll
            for (int i = 0; i < 4; ++i) pv[i] = __builtin_amdgcn_exp2f(S[i] + tabv(tabrow, (int)((offx >> (8 * i)) & 0xffu)));
        } else {
#pragma unroll
            for (int i = 0; i < 4; ++i) pv[12 + i] = __builtin_amdgcn_exp2f(S[12 + i] + tabv(tabrow, (int)((offx >> (8 * i)) & 0xffu)));
        }
    }
#pragma unroll
    for (int i = 0; i < 16; ++i) lsum += pv[i];
    const s16x8 P0 = pack8(pv[0], pv[1], pv[2], pv[3], pv[4], pv[5], pv[6], pv[7]), P1 = pack8(pv[8], pv[9], pv[10], pv[11], pv[12], pv[13], pv[14], pv[15]);
    { const s16x8 V00 = tr_pair(vb, 8 * AV_STR), V01 = tr_pair(vb + 64, 8 * AV_STR);
      O0 = MFMA32(V00, P0, O0); O1 = MFMA32(V01, P0, O1); }
    { const s16x8 V10 = tr_pair(vb + 16 * AV_STR, 8 * AV_STR), V11 = tr_pair(vb + 16 * AV_STR + 64, 8 * AV_STR);
      O0 = MFMA32(V10, P1, O0); O1 = MFMA32(V11, P1, O1); }
}
__device__ __forceinline__ void attn_load_k(s16x8 (&Kf)[4], const bf16_t* kbase, int klat0, int kctx0, int kt, int ntl, int rs) {
    const size_t grow = kt < ntl ? (size_t)(klat0 + (rs + (kt >> 1)) * 64 + 32 * (kt & 1)) : (size_t)(kctx0 + 32 * (kt - ntl));
#pragma unroll
    for (int ks = 0; ks < 4; ++ks) Kf[ks] = *(const s16x8*)(kbase + grow * 3072 + 16 * ks);
}
struct AUnit { int b, h, qrow0, r, rs, ntl, ntiles; };
__device__ __forceinline__ AUnit attn_decode(int u, int nlatu) {
    AUnit a;
    if (u < nlatu) { a.h = u & 15; const int br = u >> 4; a.r = br & 63; a.b = br >> 6; a.qrow0 = a.b * 4096 + a.r * 64; a.rs = min(max(a.r - 4, 0), 56); a.ntl = 16; a.ntiles = 24; }
    else { const int v = u - nlatu; a.h = v & 15; const int bq = v >> 4; a.b = bq >> 2; a.qrow0 = NLAT + a.b * 256 + (bq & 3) * 64; a.r = 0; a.rs = 0; a.ntl = 0; a.ntiles = 8; }
    return a;
}
__device__ __forceinline__ u32x4 attn_load_v1(const bf16_t* vbase, const AUnit& a, int idx) {
    const int key = idx >> 3, ch = idx & 7, kt = key >> 5, kk = key & 31;
    const int grow = kt < a.ntl ? (a.b * 4096 + (a.rs + (kt >> 1)) * 64 + 32 * (kt & 1) + kk) : (NLAT + a.b * 256 + 32 * (kt - a.ntl) + kk);
    return *(const u32x4*)(vbase + (size_t)grow * 3072 + ch * 8);
}
__device__ __forceinline__ void attn_load_v(u32x4 (&vpre)[12], const bf16_t* qkv, const AUnit& a, int tid) {
    const bf16_t* vbase = qkv + 2048 + a.h * 64;
#pragma unroll
    for (int i = 0; i < 4; ++i) vpre[i] = attn_load_v1(vbase, a, tid + NTHREADS * i);
    if (a.ntiles == 24) {
#pragma unroll
        for (int i = 4; i < 12; ++i) vpre[i] = attn_load_v1(vbase, a, tid + NTHREADS * i);
    }
}

__device__ __forceinline__ void phase_attn_mfma(const Params& p, int a_, bool ctx_q, LAS unsigned char* lds, const Tix T_) {
    const bf16_t* qkv = (const bf16_t*)(p.ws + OFF_BIG); bf16_t* ao = (bf16_t*)(p.ws + OFF_BIG) + (size_t)MTOT * 3072;
    const float* rpb = p.na_rpb + (size_t)a_ * 16 * 15 * 31;
    const int tid = T_.tid, lane = tid & 63, wave = __builtin_amdgcn_readfirstlane(tid >> 6), qt = wave & 1, kq = wave >> 1, l31 = lane & 31, hi = lane >> 5;
    LAS unsigned char* Vl = lds;
    LAS float* Ored = (LAS float*)lds;
    LAS float* lred = (LAS float*)(lds + 69632);
    LAS float* tab = (LAS float*)(lds + 110592);
    LAS float* misc = (LAS float*)(lds + 110592 + 2048);
    constexpr float LOG2E = 1.4426950408889634f;
    float mb;
    { float m = 0.f; for (int i = tid; i < 7440; i += NTHREADS) m = fmaxf(m, rpb[i]);
      float qg = 0.f, kg = 0.f; if (tid < 64) { qg = fabsf(p.na_q_norm[a_ * 64 + tid]); kg = fabsf(p.na_k_norm[a_ * 64 + tid]); }
      m = wave_max(m); qg = wave_max(qg); kg = wave_max(kg);
      if (lane == 0) { misc[wave] = m; if (wave == 0) { misc[8] = qg; misc[9] = kg; } }
      __syncthreads();
      float rm = misc[0];
#pragma unroll
      for (int w = 1; w < 8; ++w) rm = fmaxf(rm, misc[w]);
      mb = 8.0f * misc[8] * misc[9] + rm; }
    const float mbl = mb * LOG2E;
    const int nlatu = 8 * 64 * 16, total = nlatu + (ctx_q ? 8 * 4 * 16 : 0);
    const int tr_q = (lane & 15) >> 2, tr_p = lane & 3, dgrp = (lane >> 4) & 1;
    const int qcol = 32 * qt + l31, wst = min(max(qcol - 8, 0), 48);
    unsigned offo[4], offx = 0u;
#pragma unroll
    for (int j = 0; j < 4; ++j) { offo[j] = 0u;
#pragma unroll
        for (int i = 0; i < 4; ++i) { const int kcol = 32 * qt + 8 * j + 4 * hi + i; offo[j] |= (unsigned)(((unsigned)(kcol - wst) < 16u ? kcol - qcol + 15 : 31) * 4) << (8 * i); } }
#pragma unroll
    for (int i = 0; i < 4; ++i) { const int kcol = (qt == 0 ? 32 : 24) + 4 * hi + i; offx |= (unsigned)(((unsigned)(kcol - wst) < 16u ? kcol - qcol + 15 : 31) * 4) << (8 * i); }
    int u = T_.bid;
    AUnit cur = attn_decode(min(u, total - 1), nlatu);
    u32x4 vpre[12];
    s16x8 Qf[4], KA[4], KB[4];
    if (u < total) {
        attn_load_v(vpre, qkv, cur, tid);
        const bf16_t* qp = qkv + (size_t)(cur.qrow0 + 32 * qt + l31) * 3072 + cur.h * 64 + 8 * hi;
#pragma unroll
        for (int ks = 0; ks < 4; ++ks) Qf[ks] = *(const s16x8*)(qp + 16 * ks);
        const int t0 = kq * (cur.ntiles >> 2);
        attn_load_k(KA, qkv + 1024 + cur.h * 64 + 8 * hi, cur.b * 4096 + l31, NLAT + cur.b * 256 + l31, t0, cur.ntl, cur.rs);
        attn_load_k(KB, qkv + 1024 + cur.h * 64 + 8 * hi, cur.b * 4096 + l31, NLAT + cur.b * 256 + l31, t0 + 1, cur.ntl, cur.rs);
    }
    while (u < total) {
        const int b = cur.b, h = cur.h, qrow0 = cur.qrow0, r = cur.r, rs = cur.rs, ntl = cur.ntl, ntiles = cur.ntiles;
        int tidl = tid; asm volatile("" : "+v"(tidl));
#pragma unroll
        for (int i = 0; i < 4; ++i) { const int idx = tidl + NTHREADS * i; *(LAS u32x4*)(Vl + (idx >> 3) * AV_STR + (idx & 7) * 16) = vpre[i]; }
        if (ntiles == 24) {
#pragma unroll
            for (int i = 4; i < 12; ++i) { const int idx = tidl + NTHREADS * i; *(LAS u32x4*)(Vl + (idx >> 3) * AV_STR + (idx & 7) * 16) = vpre[i]; } }
        if (tid < 480) { const int rr = tid >> 5, dd = tid & 31; tab[tid] = dd < 31 ? (rpb[h * 465 + rr * 31 + dd] - mb) * LOG2E : -1e30f; }
        const bf16_t* kbase = qkv + 1024 + h * 64 + 8 * hi;
        const int klat0 = b * 4096 + l31, kctx0 = NLAT + b * 256 + l31;
        const int ntw = ntiles >> 2, t0 = kq * ntw;
        __syncthreads();
        f32x16 O0, O1;
#pragma unroll
        for (int i = 0; i < 16; ++i) { O0[i] = 0.f; O1[i] = 0.f; }
        float lsum = 0.f;
#pragma unroll 1
        for (int t = 0; t < ntw; t += 2) {
            { const int kt = t0 + t; const int mode = kt >= ntl ? 0 : ((kt & 1) == qt ? 1 : 2 + qt);
              attn_one_tile(KA, Qf, Vl + (kt * 32 + 4 * hi + tr_q) * AV_STR + (16 * dgrp + 4 * tr_p) * 2, (const LAS unsigned char*)tab + (rs + (kt >> 1) - r + 7) * 128, offo, offx, O0, O1, lsum, mode, mbl); }
            __builtin_amdgcn_sched_barrier(0);
            attn_load_k(KA, kbase, klat0, kctx0, t0 + min(t + 2, ntw - 2), ntl, rs);
            { const int kt = t0 + t + 1; const int mode = kt >= ntl ? 0 : ((kt & 1) == qt ? 1 : 2 + qt);
              attn_one_tile(KB, Qf, Vl + (kt * 32 + 4 * hi + tr_q) * AV_STR + (16 * dgrp + 4 * tr_p) * 2, (const LAS unsigned char*)tab + (rs + (kt >> 1) - r + 7) * 128, offo, offx, O0, O1, lsum, mode, mbl); }
            __builtin_amdgcn_sched_barrier(0);
            attn_load_k(KB, kbase, klat0, kctx0, t0 + min(t + 2, ntw - 2) + 1, ntl, rs);
        }
        const int un = u + T_.gsz;
        const AUnit nxt = attn_decode(min(un, total - 1), nlatu);
        int tidm = tid; asm volatile("" : "+v"(tidm));
        if (un < total) attn_load_v(vpre, qkv, nxt, tidm);
        __syncthreads();
#pragma unroll
        for (int j = 0; j < 4; ++j) {
            *(LAS f32x4*)(Ored + (size_t)((kq * 64 + 32 * qt + l31) * 68 + 8 * j + 4 * hi)) = (f32x4){O0[4 * j], O0[4 * j + 1], O0[4 * j + 2], O0[4 * j + 3]};
            *(LAS f32x4*)(Ored + (size_t)((kq * 64 + 32 * qt + l31) * 68 + 32 + 8 * j + 4 * hi)) = (f32x4){O1[4 * j], O1[4 * j + 1], O1[4 * j + 2], O1[4 * j + 3]}; }
        lred[(kq * 2 + hi) * 64 + 32 * qt + l31] = lsum;
        if (un < total) {
            const bf16_t* qp = qkv + (size_t)(nxt.qrow0 + 32 * qt + l31) * 3072 + nxt.h * 64 + 8 * hi;
#pragma unroll
            for (int ks = 0; ks < 4; ++ks) Qf[ks] = *(const s16x8*)(qp + 16 * ks);
            const int t0n = kq * (nxt.ntiles >> 2);
            attn_load_k(KA, qkv + 1024 + nxt.h * 64 + 8 * hi, nxt.b * 4096 + l31, NLAT + nxt.b * 256 + l31, t0n, nxt.ntl, nxt.rs);
            attn_load_k(KB, qkv + 1024 + nxt.h * 64 + 8 * hi, nxt.b * 4096 + l31, NLAT + nxt.b * 256 + l31, t0n + 1, nxt.ntl, nxt.rs);
        }
        __syncthreads();
        { const int q = tid >> 3, d8 = (tid & 7) * 8;
          f32x4 s0 = (f32x4){0.f, 0.f, 0.f, 0.f}, s1 = s0; float l = 0.f;
#pragma unroll
          for (int k = 0; k < 4; ++k) { s0 += *(const LAS f32x4*)(Ored + (k * 64 + q) * 68 + d8); s1 += *(const LAS f32x4*)(Ored + (k * 64 + q) * 68 + d8 + 4); l += lred[(k * 2) * 64 + q] + lred[(k * 2 + 1) * 64 + q]; }
          const float inv = 1.0f / l;
          u32x4 o; o.x = pkb(s0.x * inv, s0.y * inv); o.y = pkb(s0.z * inv, s0.w * inv); o.z = pkb(s1.x * inv, s1.y * inv); o.w = pkb(s1.z * inv, s1.w * inv);
          *(u32x4*)(ao + (size_t)(qrow0 + q) * 1024 + h * 64 + d8) = o; }
        __syncthreads();
        u = un; cur = nxt;
    }
}

constexpr int SP_RS = 320;
__device__ __forceinline__ void phase_spatial_mfma(const Params& p, int sl, int M, LAS unsigned char* lds, const Tix T_) {
    bf16_t* vb = (bf16_t*)(p.ws + OFF_BIG); const float* lnacc = (const float*)(p.ws + OFF_LNACC) + (size_t)sl * MTOT * 2;
    const float* lng = p.sg_ln_g + sl * 3072; const float* lnb = p.sg_ln_b + sl * 3072;
    const int tid = T_.tid, lane = tid & 63, wave = __builtin_amdgcn_readfirstlane(tid >> 6), pt = wave & 3, cth = wave >> 2, l31 = lane & 31, hi = lane >> 5;
    const int tr_q = (lane & 15) >> 2, tr_p = lane & 3, dgrp = (lane >> 4) & 1;
    const int nunits = (M / 128) * 24;
    for (int u = T_.bid; u < nunits; u += T_.gsz) {
        const int nc = u / 24, g = u % 24, r0 = nc * 128;
#pragma unroll
        for (int i = 0; i < 4; ++i) { const int idx = tid + NTHREADS * i, q = idx >> 4, c8 = (idx & 15) * 8;
            const u32x4 w = *(const u32x4*)(vb + (size_t)(r0 + q) * 3072 + g * 128 + c8);
            const float mean = lnacc[2 * (r0 + q)] * (1.0f / 3072.0f), rstd = 1.0f / sqrtf(fmaxf(lnacc[2 * (r0 + q) + 1] * (1.0f / 3072.0f) - mean * mean, 0.f) + 1e-6f);
            const f32x4 g0 = *(const f32x4*)(lng + g * 128 + c8), g1 = *(const f32x4*)(lng + g * 128 + c8 + 4), b0 = *(const f32x4*)(lnb + g * 128 + c8), b1 = *(const f32x4*)(lnb + g * 128 + c8 + 4);
            u32x4 o;
            o.x = pkb((bf2f(w.x & 0xffffu) - mean) * rstd * g0.x + b0.x, (bf2f(w.x >> 16) - mean) * rstd * g0.y + b0.y);
            o.y = pkb((bf2f(w.y & 0xffffu) - mean) * rstd * g0.z + b0.z, (bf2f(w.y >> 16) - mean) * rstd * g0.w + b0.w);
            o.z = pkb((bf2f(w.z & 0xffffu) - mean) * rstd * g1.x + b1.x, (bf2f(w.z >> 16) - mean) * rstd * g1.y + b1.y);
            o.w = pkb((bf2f(w.w & 0xffffu) - mean) * rstd * g1.z + b1.z, (bf2f(w.w >> 16) - mean) * rstd * g1.w + b1.w);
            *(LAS u32x4*)(lds + q * SP_RS + c8 * 2) = o; }
        const float* wp = p.sg_w_s + ((size_t)sl * 24 + g) * 16384 + (32 * pt + l31) * 128 + 8 * hi;
        s16x8 Wf[8];
#pragma unroll
        for (int ks = 0; ks < 8; ++ks) { const f32x4 x = *(const f32x4*)(wp + 16 * ks), y = *(const f32x4*)(wp + 16 * ks + 4); Wf[ks] = pack8(x.x, x.y, x.z, x.w, y.x, y.y, y.z, y.w); }
        const float bs = p.sg_b_s[((size_t)sl * 24 + g) * 128 + 32 * pt + l31];
        __syncthreads();
#pragma unroll
        for (int cc = 0; cc < 2; ++cc) { const int ct = 2 * cth + cc;
            f32x16 acc;
#pragma unroll
            for (int i = 0; i < 16; ++i) acc[i] = 0.f;
            const LAS unsigned char* ab = lds + (8 * hi + tr_q) * SP_RS + (32 * ct + 16 * dgrp + 4 * tr_p) * 2;
#pragma unroll
            for (int ks = 0; ks < 8; ++ks) { const s16x8 Af = tr_pair(ab + 16 * ks * SP_RS, 4 * SP_RS); acc = MFMA32(Af, Wf[ks], acc); }
            bf16_t* orow = vb + (size_t)(r0 + 32 * pt + l31) * 3072 + g * 128 + 32 * ct + 4 * hi;
#pragma unroll
            for (int j = 0; j < 4; ++j) { u32x2 o; o.x = pkb(acc[4 * j] + bs, acc[4 * j + 1] + bs); o.y = pkb(acc[4 * j + 2] + bs, acc[4 * j + 3] + bs); *(u32x2*)(orow + 8 * j) = o; }
        }
        __syncthreads();
    }
}

template <class F> struct EpiG {
    static constexpr bool PERM = false, AFTER_DRAIN = false;
    F f;
    __device__ __forceinline__ void operator()(const f32x4 (&acc)[2][2][4][2], const Unit& u, int wr, int wc, int fr, int fq) const {
        F g = f; const int colb = u.pn * 256 + 64 * wc + 8 * fq;
        g.begin(u, colb, fq);
#pragma unroll
        for (int ai = 0; ai < 2; ++ai)
#pragma unroll
            for (int m = 0; m < 4; ++m) { const int row = u.pm * 256 + ai * 128 + wr * 64 + m * 16 + fr;
                g.row(row, colb, acc[ai][0][m][0], acc[ai][0][m][1], acc[ai][1][m][0], acc[ai][1][m][1]);
                asm volatile("" ::: "memory"); }
    }
};
__device__ __forceinline__ void store8_bf16(bf16_t* o, const f32x4 a, const f32x4 b) { u32x4 w; w.x = pk2(a.x, a.y); w.y = pk2(a.z, a.w); w.z = pk2(b.x, b.y); w.w = pk2(b.z, b.w); *(u32x4*)o = w; }
__device__ __forceinline__ float sumsq4(const f32x4 x) { return (x.x * x.x + x.y * x.y) + (x.z * x.z + x.w * x.w); }
__device__ __forceinline__ float sum4(const f32x4 x) { return (x.x + x.y) + (x.z + x.w); }
__device__ __forceinline__ float rstd_of(const float* ssq, int row) { return 1.0f / sqrtf(ssq[row] * (1.0f / 1024.0f) + 1e-6f); }
__device__ __forceinline__ void atomic_addf(float* p, float v) { __hip_atomic_fetch_add(p, v, __ATOMIC_RELAXED, __HIP_MEMORY_SCOPE_AGENT); }

struct FQKV { bf16_t* O; const float* qg; const float* kg; const float* ssq; const float* bias;
    f32x4 gn[4], bz[4]; int sect;
    __device__ __forceinline__ void begin(const Unit& u, int colb, int fq) {
        sect = u.pn >> 2; const int b = min(u.pm >> 4, 8); const float* bp = bias + (size_t)b * 3072 + colb;
        bz[0] = *(const f32x4*)bp; bz[1] = *(const f32x4*)(bp + 4); bz[2] = *(const f32x4*)(bp + 32); bz[3] = *(const f32x4*)(bp + 36);
        if (sect < 2) { const float* gp = (sect == 0 ? qg : kg) + 8 * fq; const float mul = sect == 0 ? 0.125f * 1.4426950408889634f : 1.0f;
            gn[0] = *(const f32x4*)gp * mul; gn[1] = *(const f32x4*)(gp + 4) * mul; gn[2] = *(const f32x4*)(gp + 32) * mul; gn[3] = *(const f32x4*)(gp + 36) * mul; } }
    __device__ __forceinline__ void row(int row, int colb, f32x4 a0, f32x4 b0, f32x4 a1, f32x4 b1) {
        const float rs = rstd_of(ssq, row);
        a0 = a0 * rs + bz[0]; b0 = b0 * rs + bz[1]; a1 = a1 * rs + bz[2]; b1 = b1 * rs + bz[3];
        if (sect < 2) { float ss = (sumsq4(a0) + sumsq4(b0)) + (sumsq4(a1) + sumsq4(b1));
            ss += __shfl_xor(ss, 16); ss += __shfl_xor(ss, 32);
            const float r2 = 1.0f / sqrtf(ss * (1.0f / 64.0f) + 1e-6f);
            a0 = a0 * r2 * gn[0]; b0 = b0 * r2 * gn[1]; a1 = a1 * r2 * gn[2]; b1 = b1 * r2 * gn[3]; }
        bf16_t* op = O + (size_t)row * 3072 + colb; store8_bf16(op, a0, b0); store8_bf16(op + 32, a1, b1); } };
struct FSqrelu { bf16_t* O; const float* ssq; const float* bias;
    f32x4 bz[4];
    __device__ __forceinline__ void begin(const Unit& u, int colb, int fq) { const int b = min(u.pm >> 4, 8); const float* bp = bias + (size_t)b * 4096 + colb;
        bz[0] = *(const f32x4*)bp; bz[1] = *(const f32x4*)(bp + 4); bz[2] = *(const f32x4*)(bp + 32); bz[3] = *(const f32x4*)(bp + 36); }
    __device__ __forceinline__ void row(int row, int colb, f32x4 a0, f32x4 b0, f32x4 a1, f32x4 b1) {
        const float rs = rstd_of(ssq, row); const f32x4 z = (f32x4){0.f, 0.f, 0.f, 0.f};
        a0 = __builtin_elementwise_max(a0 * rs + bz[0], z); b0 = __builtin_elementwise_max(b0 * rs + bz[1], z); a1 = __builtin_elementwise_max(a1 * rs + bz[2], z); b1 = __builtin_elementwise_max(b1 * rs + bz[3], z);
        bf16_t* op = O + (size_t)row * 4096 + colb; store8_bf16(op, a0 * a0, b0 * b0); store8_bf16(op + 32, a1 * a1, b1 * b1); } };
struct FGeluV { bf16_t* O; const float* ssq; const float* bias; float* lnacc;
    f32x4 bz[4]; int fq_;
    __device__ __forceinline__ void begin(const Unit& u, int colb, int fq) { const int b = min(u.pm >> 4, 8); const float* bp = bias + (size_t)b * 6144 + colb; fq_ = fq;
        bz[0] = *(const f32x4*)bp; bz[1] = *(const f32x4*)(bp + 4); bz[2] = *(const f32x4*)(bp + 32); bz[3] = *(const f32x4*)(bp + 36); }
    __device__ __forceinline__ void row(int row, int colb, f32x4 a0, f32x4 b0, f32x4 a1, f32x4 b1) {
        const float rs = rstd_of(ssq, row);
        a0 = gelu4(a0 * rs + bz[0]); b0 = gelu4(b0 * rs + bz[1]); a1 = gelu4(a1 * rs + bz[2]); b1 = gelu4(b1 * rs + bz[3]);
        bf16_t* op = O + (size_t)row * 3072 + colb; store8_bf16(op, a0, b0); store8_bf16(op + 32, a1, b1);
        float s1 = (sum4(a0) + sum4(b0)) + (sum4(a1) + sum4(b1)), s2 = (sumsq4(a0) + sumsq4(b0)) + (sumsq4(a1) + sumsq4(b1));
        s1 += __shfl_xor(s1, 16); s1 += __shfl_xor(s1, 32); s2 += __shfl_xor(s2, 16); s2 += __shfl_xor(s2, 32);
        if (fq_ == 0) { atomic_addf(lnacc + 2 * (size_t)row, s1); atomic_addf(lnacc + 2 * (size_t)row + 1, s2); } } };
struct FGeluU { bf16_t* O; const float* ssq; const float* bias;
    f32x4 bz[4];
    __device__ __forceinline__ void begin(const Unit& u, int colb, int fq) { const int b = min(u.pm >> 4, 8); const float* bp = bias + (size_t)b * 6144 + colb;
        bz[0] = *(const f32x4*)bp; bz[1] = *(const f32x4*)(bp + 4); bz[2] = *(const f32x4*)(bp + 32); bz[3] = *(const f32x4*)(bp + 36); }
    __device__ __forceinline__ static f32x4 lo4(const u32x4 s) { return (f32x4){bf2f(s.x & 0xffffu), bf2f(s.x >> 16), bf2f(s.y & 0xffffu), bf2f(s.y >> 16)}; }
    __device__ __forceinline__ static f32x4 hi4(const u32x4 s) { return (f32x4){bf2f(s.z & 0xffffu), bf2f(s.z >> 16), bf2f(s.w & 0xffffu), bf2f(s.w >> 16)}; }
    __device__ __forceinline__ void row(int row, int colb, f32x4 a0, f32x4 b0, f32x4 a1, f32x4 b1) {
        const float rs = rstd_of(ssq, row);
        bf16_t* op = O + (size_t)row * 3072 + colb; const u32x4 sv0 = *(const u32x4*)op, sv1 = *(const u32x4*)(op + 32);
        a0 = gelu4(a0 * rs + bz[0]) * lo4(sv0); b0 = gelu4(b0 * rs + bz[1]) * hi4(sv0); a1 = gelu4(a1 * rs + bz[2]) * lo4(sv1); b1 = gelu4(b1 * rs + bz[3]) * hi4(sv1);
        store8_bf16(op, a0, b0); store8_bf16(op + 32, a1, b1); } };
struct FResid { const float* inl; const float* inc; float* outl; float* outc; const float* gate;
    const float* gsn; bf16_t* xb; float* ssqn;
    f32x4 gz[4], gsz[4]; int fq_;
    __device__ __forceinline__ void begin(const Unit& u, int colb, int fq) { const int b = min(u.pm >> 4, 8); fq_ = fq; const float* gp = gate + (size_t)b * 6144 + colb;
        gz[0] = *(const f32x4*)gp; gz[1] = *(const f32x4*)(gp + 4); gz[2] = *(const f32x4*)(gp + 32); gz[3] = *(const f32x4*)(gp + 36);
        if (gsn) { const float* sp = gsn + (size_t)b * 1024 + colb; gsz[0] = *(const f32x4*)sp; gsz[1] = *(const f32x4*)(sp + 4); gsz[2] = *(const f32x4*)(sp + 32); gsz[3] = *(const f32x4*)(sp + 36); } }
    __device__ __forceinline__ void row(int row, int colb, f32x4 a0, f32x4 b0, f32x4 a1, f32x4 b1) {
        const bool lat = row < NLAT;
        const float* ip = lat ? inl + (size_t)row * 1024 + colb : inc + (size_t)(row - NLAT) * 1024 + colb;
        float* op = lat ? outl + (size_t)row * 1024 + colb : outc + (size_t)(row - NLAT) * 1024 + colb;
        a0 = *(const f32x4*)ip + gz[0] * a0; b0 = *(const f32x4*)(ip + 4) + gz[1] * b0; a1 = *(const f32x4*)(ip + 32) + gz[2] * a1; b1 = *(const f32x4*)(ip + 36) + gz[3] * b1;
        *(f32x4*)op = a0; *(f32x4*)(op + 4) = b0; *(f32x4*)(op + 32) = a1; *(f32x4*)(op + 36) = b1;
        if (gsn) { float ss = (sumsq4(a0) + sumsq4(b0)) + (sumsq4(a1) + sumsq4(b1));
            ss += __shfl_xor(ss, 16); ss += __shfl_xor(ss, 32);
            if (fq_ == 0) atomic_addf(ssqn + row, ss);
            bf16_t* xp = xb + (size_t)row * 1024 + colb; store8_bf16(xp, a0 * gsz[0], b0 * gsz[1]); store8_bf16(xp + 32, a1 * gsz[2], b1 * gsz[3]); } } };

template <class F> __device__ __forceinline__ void run_gemm(LAS unsigned char* lds, const bf16_t* A, const bf16_t* Bt, int M, int N, int K, const F& f, const Tix T_) {
    pg8::StaticOrder S; S.init(M, N, T_.gsz, T_.bid);
    pg8::Gemm g; g.A = A; g.Bt = Bt; g.M = M; g.N = N; g.K = K;
    EpiG<F> E; E.f = f;
    pg8::gemm_phase<EpiG<F>, pg8::StaticOrder, true, true>(lds, g, S, E, T_.tid);
}

enum { OP_QKV, OP_ATTN, OP_MIXOUT, OP_MLP1, OP_MLP2, OP_VGEMM, OP_SPATIAL, OP_UGEMM, OP_PROLOGUE, OP_PHASE0B };

__device__ __forceinline__ void decode_phase(int ph, int& L, int& op) {
    L = 0; op = ph == 0 ? OP_PROLOGUE : OP_PHASE0B;
    if (ph > 1) {
        int q = ph - 2;
        if (q < 5) { L = 0; } else if (q < 11) { L = 1; q -= 5; } else if (q < 16) { L = 2; q -= 11; } else { L = 3; q -= 16; }
        if ((L & 1) == 0) op = q == 0 ? OP_QKV : q == 1 ? OP_ATTN : q == 2 ? OP_MIXOUT : q == 3 ? OP_MLP1 : OP_MLP2;
        else op = q == 0 ? OP_VGEMM : q == 1 ? OP_SPATIAL : q == 2 ? OP_UGEMM : q == 3 ? OP_MIXOUT : q == 4 ? OP_MLP1 : OP_MLP2;
    }
}

__device__ __forceinline__ void run_phase(const Params& p, int ph, LAS unsigned char* lds, const Tix T_) {
    int L, op; decode_phase(ph, L, op);
#ifdef ONLY_OP
    op = ONLY_OP;
#endif
    const int mi = L >> 1;
    const bool attnL = (L & 1) == 0;
    const int Mfull = L < 2 ? MTOT : NLAT;
    const float* modsl = (const float*)(p.ws + OFF_MODS) + (size_t)L * 9 * 6144;
    float* ctxr = (float*)(p.ws + OFF_CTXR);
    bf16_t* hb = (bf16_t*)(p.ws + OFF_HB); bf16_t* big = (bf16_t*)(p.ws + OFF_BIG);
    float* ssq = (float*)(p.ws + OFF_SSQ); const float* gs = (const float*)(p.ws + OFF_GS);
    const bool first = (L == 0);
    switch (op) {
    case OP_PROLOGUE: phase_zero(p, T_); phase_mods(p, lds, T_); __syncthreads(); phase_convert(p, lds, T_); break;
    case OP_PHASE0B: phase_0b(p, lds, T_); break;
    case OP_QKV: { FQKV f; f.O = big; f.qg = p.na_q_norm + mi * 64; f.kg = p.na_k_norm + mi * 64; f.ssq = ssq + (size_t)(2 * L) * MTOT; f.bias = (const float*)(p.ws + OFF_BQKV) + (size_t)mi * 9 * 3072;
        run_gemm(lds, hb, (const bf16_t*)(p.ws + OFF_QKVT) + (size_t)mi * 3072 * 1024, MTOT, 3072, 1024, f, T_); } break;
    case OP_ATTN: phase_attn_mfma(p, mi, L == 0, lds, T_); break;
    case OP_MIXOUT: case OP_MLP2: {
        FResid f; const bool mo = (op == OP_MIXOUT);
        f.inl = (first && mo) ? p.x : p.out; f.inc = (first && mo) ? p.ctx : ctxr; f.outl = p.out; f.outc = ctxr; f.gate = modsl + (mo ? 2048 : 5120);
        const int nn = mo ? 2 * L + 1 : 2 * L + 2;
        const bool has_next = nn < 8 && !(nn == 6 + 0 && false);
        f.gsn = has_next ? gs + (size_t)nn * 9 * 1024 : nullptr; f.xb = hb; f.ssqn = ssq + (size_t)(has_next ? nn : 0) * MTOT;
        const bf16_t* A; const bf16_t* Bt; int K;
        if (!mo) { A = big; Bt = (const bf16_t*)(p.ws + OFF_W2T) + (size_t)L * 1024 * 4096; K = 4096; }
        else if (attnL) { A = big + (size_t)MTOT * 3072; Bt = (const bf16_t*)(p.ws + OFF_WOT) + (size_t)mi * 1024 * 1024; K = 1024; }
        else { A = big; Bt = (const bf16_t*)(p.ws + OFF_SGOT) + (size_t)mi * 1024 * 3072; K = 3072; }
        run_gemm(lds, A, Bt, Mfull, 1024, K, f, T_); } break;
    case OP_MLP1: { FSqrelu f; f.O = big; f.ssq = ssq + (size_t)(2 * L + 1) * MTOT; f.bias = (const float*)(p.ws + OFF_BMLP) + (size_t)L * 9 * 4096;
        run_gemm(lds, hb, (const bf16_t*)(p.ws + OFF_W1T) + (size_t)L * 4096 * 1024, Mfull, 4096, 1024, f, T_); } break;
    case OP_VGEMM: { FGeluV f; f.O = big; f.ssq = ssq + (size_t)(2 * L) * MTOT; f.bias = (const float*)(p.ws + OFF_BWIN) + (size_t)mi * 9 * 6144 + 3072; f.lnacc = (float*)(p.ws + OFF_LNACC) + (size_t)mi * MTOT * 2;
        run_gemm(lds, hb, (const bf16_t*)(p.ws + OFF_WINT) + (size_t)mi * 6144 * 1024 + (size_t)3072 * 1024, Mfull, 3072, 1024, f, T_); } break;
    case OP_SPATIAL: phase_spatial_mfma(p, mi, Mfull, lds, T_); break;
    case OP_UGEMM: { FGeluU f; f.O = big; f.ssq = ssq + (size_t)(2 * L) * MTOT; f.bias = (const float*)(p.ws + OFF_BWIN) + (size_t)mi * 9 * 6144;
        run_gemm(lds, hb, (const bf16_t*)(p.ws + OFF_WINT) + (size_t)mi * 6144 * 1024, Mfull, 3072, 1024, f, T_); } break;
    default: break;
    }
}

#ifndef ONE_LAUNCH
#define ONE_LAUNCH 1
#endif
__global__ void __launch_bounds__(NTHREADS) mk(Params p0) {
    extern __shared__ __attribute__((aligned(16))) unsigned char lds_raw[];
    LAS unsigned char* lds = (LAS unsigned char*)lds_raw;
#if ONE_LAUNCH
    cg::grid_group grid = cg::this_grid();
    bool first_it = true, repeated = false;
    for (int ph = p0.ph_lo; ph < p0.ph_hi; ) {
        if (!first_it) grid.sync();
        first_it = false;
        Tix T_; T_.tid = threadIdx.x; T_.bid = blockIdx.x; T_.gsz = gridDim.x;
        size_t z = 0;
        asm volatile("" : "+v"(T_.tid)); asm volatile("" : "+s"(T_.bid), "+s"(T_.gsz), "+s"(z));
        Params p = p0;
        { const float** pp = (const float**)&p;
#pragma unroll
          for (int i = 0; i < 22; ++i) pp[i] += z; }
        p.out += z; p.ws += z;
        run_phase(p, ph, lds, T_);
        __syncthreads();
        if (REP_MASK != 0) { int L_, op_; decode_phase(ph, L_, op_); if (((REP_MASK >> op_) & 1) && !repeated) { repeated = true; continue; } }
        repeated = false; ++ph;
    }
#else
    Tix T_; T_.tid = threadIdx.x; T_.bid = blockIdx.x; T_.gsz = gridDim.x;
    run_phase(p0, p0.ph_lo, lds, T_);
#endif
}

extern "C" void kernel_launch(void* const* d_in, const int* in_sizes, int n_in, void* d_out, int out_size, void* d_ws, size_t ws_size, hipStream_t stream) {
    static int grid = 0;
    if (grid == 0) {
        if (n_in != 22 || ws_size < WS_END) { fprintf(stderr, "kernel_launch: unexpected n_in %d or ws_size %zu (< %zu)\n", n_in, ws_size, (size_t)WS_END); grid = -1; return; }
        int dev = 0, cus = 0, per_cu = 0;
        hipGetDevice(&dev); hipDeviceGetAttribute(&cus, hipDeviceAttributeMultiprocessorCount, dev);
        if (hipFuncSetAttribute((const void*)mk, hipFuncAttributeMaxDynamicSharedMemorySize, LDS_BYTES) != hipSuccess) { fprintf(stderr, "kernel_launch: hipFuncSetAttribute failed\n"); grid = -1; return; }
        if (hipOccupancyMaxActiveBlocksPerMultiprocessor(&per_cu, (const void*)mk, NTHREADS, LDS_BYTES) != hipSuccess || per_cu < 1) { fprintf(stderr, "kernel_launch: occupancy query says %d\n", per_cu); per_cu = 1; }
        (void)hipGetLastError();
        grid = cus;
    }
    if (grid < 0) return;
    Params p{};
    const float** pp = (const float**)&p;
    for (int i = 0; i < 22; ++i) pp[i] = (const float*)d_in[i];
    p.out = (float*)d_out; p.ws = (unsigned char*)d_ws;
#if ONE_LAUNCH
    p.ph_lo = 0; p.ph_hi = NPH;
    void* args[] = {&p};
    hipError_t e = hipLaunchCooperativeKernel((void*)mk, dim3(grid), dim3(NTHREADS), args, LDS_BYTES, stream);
    if (e != hipSuccess) fprintf(stderr, "cooperative launch failed: %s (grid %d)\n", hipGetErrorString(e), grid);
#else
    for (int ph = 0; ph < NPH; ++ph) { p.ph_lo = ph; p.ph_hi = ph + 1; hipLaunchKernelGGL(mk, dim3(grid), dim3(NTHREADS), LDS_BYTES, stream, p); }
#endif
}
```

```cpp
#include <hip/hip_runtime.h>
#include <hip/hip_cooperative_groups.h>
#include <cstdio>
#include <cstdint>
namespace cg = cooperative_groups;
namespace pg8 {
#define PG8_LAS __attribute__((address_space(3)))
typedef unsigned short bf16_t;
typedef short bf16x8 __attribute__((ext_vector_type(8)));
typedef float f32x4 __attribute__((ext_vector_type(4)));
typedef unsigned u32x4 __attribute__((ext_vector_type(4)));
constexpr int BM = 256, BK = 64, HALF = 128, HTB = HALF * BK * 2  , STAGE_BYTES = 8 * HTB, NXCD = 8, WGM = 8;

__host__ __device__ __forceinline__ int lds_byte(int r, int c) { const int st = (r >> 4) * 2 + (c >> 5), rr = r & 15, cc = c & 31, ob = rr * 64 + cc * 2; return st * 1024 + (ob ^ (((ob >> 9) & 1) << 5)); }
__host__ __device__ __forceinline__ void stage_rc(int b, int& R, int& C) { const int st = b / 1024, sb = b % 1024, swz = sb ^ (((sb >> 9) & 1) << 5); R = (st >> 1) * 16 + swz / 64; C = (st & 1) * 32 + (swz % 64) / 2; }
__host__ __device__ __forceinline__ int perm32(int rho) { const int n = rho >> 4, i = rho & 15; return 8 * (i >> 2) + 4 * n + (i & 3); }

struct Unit { int pm, pn; };
struct Gemm { const bf16_t* A; const bf16_t* Bt; int M, N, K; };

struct StaticOrder {
    int nM, nN, nwg, G, c;
    __host__ __device__ void init(int M, int N, int G_, int c_) { nM = M / BM; nN = N / BM; nwg = nM * nN; G = G_; c = c_; }
    __host__ __device__ bool next(int i, Unit& u) const {
        const long L = (long)i * G + c; if (L >= nwg) return false;
        int wgid = (int)L; { const int q = nwg / NXCD, r = nwg % NXCD, xcd = wgid % NXCD, off = wgid / NXCD; wgid = (xcd < r ? xcd * (q + 1) : r * (q + 1) + (xcd - r) * q) + off; }
        const int nig = WGM * nN, gid = wgid / nig, fm = gid * WGM, gsz = (nM - fm) < WGM ? (nM - fm) : WGM;
        u.pm = fm + ((wgid % nig) % gsz); u.pn = (wgid % nig) / gsz; return true;
    }
    __device__ __forceinline__ void a_ready(const Unit&) const {}
    __device__ __forceinline__ void done(const Unit&) const {}
};

__device__ __forceinline__ unsigned cvt_pk_bf16(float lo, float hi) { unsigned r; asm volatile("v_cvt_pk_bf16_f32 %0, %1, %2" : "=v"(r) : "v"(lo), "v"(hi)); return r; }
template <class Epi, class Sched, bool ALIGN_EPI = false, bool SP2 = false>
__device__ __forceinline__ void gemm_phase(PG8_LAS unsigned char* lds, const Gemm g, const Sched& S, const Epi& E, const int tid_in) {
    const int tid = tid_in, wid = __builtin_amdgcn_readfirstlane(tid >> 6), lane = tid & 63, wr = wid >> 2, wc = wid & 3, fr = lane & 15, fq = lane >> 4;
    const int K = g.K, nt = K / BK;
    unsigned voffA[2], voffB[2];
#pragma unroll
    for (int i = 0; i < 2; ++i) { int R, C; stage_rc(tid * 16 + i * 8192, R, C); const int Rb = Epi::PERM ? ((R & ~31) + perm32(R & 31)) : R;
        voffA[i] = (unsigned)(R * K + C) * 2u; voffB[i] = (unsigned)(Rb * K + C) * 2u; }
    const size_t kstep = (size_t)(BK * 2);
    const size_t hstep = (size_t)HALF * K * 2;
    const size_t tstep = 2 * hstep;
    const unsigned ldsw = (unsigned)wid * 1024u;
    const int aoff = lds_byte(wr * 64 + fr, fq * 8), boff = lds_byte(wc * 32 + fr, fq * 8);
#define PG8_SA(b, h) (((b) * 2 + (h)) * HTB)
#define PG8_SB(b, h) ((4 + (b) * 2 + (h)) * HTB)
#define PG8_STAGE(bufoff, gbase, voff) do { _Pragma("unroll") for (int _i = 0; _i < 2; ++_i) \
        __builtin_amdgcn_global_load_lds((const unsigned*)((const char*)(gbase) + (voff)[_i]), (PG8_LAS unsigned*)(lds + (bufoff) + ldsw + _i * 8192), 16, 0, 0); } while (0)
#define PG8_LDA(dst, b, h) do { _Pragma("unroll") for (int m = 0; m < 4; ++m) _Pragma("unroll") for (int k = 0; k < 2; ++k) dst[m][k] = *(const PG8_LAS bf16x8*)(lds + PG8_SA(b, h) + aoff + m * 2048 + k * 1024); } while (0)
#define PG8_LDB(dst, b, h) do { _Pragma("unroll") for (int n = 0; n < 2; ++n) _Pragma("unroll") for (int k = 0; k < 2; ++k) dst[n][k] = *(const PG8_LAS bf16x8*)(lds + PG8_SB(b, h) + boff + n * 2048 + k * 1024); } while (0)
#define PG8_MMA(ai, bj, At, Bt) do { __builtin_amdgcn_s_setprio(1); _Pragma("unroll") for (int m = 0; m < 4; ++m) _Pragma("unroll") for (int n = 0; n < 2; ++n) _Pragma("unroll") for (int k = 0; k < 2; ++k) \
        acc[ai][bj][m][n] = __builtin_amdgcn_mfma_f32_16x16x32_bf16(Bt[n][k], At[m][k], acc[ai][bj][m][n], 0, 0, 0); __builtin_amdgcn_s_setprio(0); } while (0)
#define PG8_WAIT_V(n) asm volatile("s_waitcnt vmcnt(" #n ")" ::: "memory")
#define PG8_WAIT_L(n) asm volatile("s_waitcnt lgkmcnt(" #n ")" ::: "memory")
#define PG8_BAR __builtin_amdgcn_s_barrier()
#define PG8_SCHED __builtin_amdgcn_sched_barrier(0)
    Unit cur, nxt; int ui = 0;
    if (!S.next(0, cur)) return;
    f32x4 acc[2][2][4][2];
#pragma unroll
    for (int a = 0; a < 2; ++a)
#pragma unroll
        for (int b = 0; b < 2; ++b)
#pragma unroll
            for (int m = 0; m < 4; ++m)
#pragma unroll
                for (int n = 0; n < 2; ++n) acc[a][b][m][n] = (f32x4){0.f, 0.f, 0.f, 0.f};
    bf16x8 At[4][2], B0[2][2], B1[2][2];
    const char* cA = (const char*)g.A + (size_t)cur.pm * tstep; const char* cB = (const char*)g.Bt + (size_t)cur.pn * tstep;
    S.a_ready(cur);
    if constexpr (SP2) {
        PG8_STAGE(PG8_SB(0, 0), cB, voffB); PG8_STAGE(PG8_SB(0, 1), cB + hstep, voffB); PG8_STAGE(PG8_SA(0, 0), cA, voffA); PG8_STAGE(PG8_SA(0, 1), cA + hstep, voffA);
        if (wr == 1) PG8_BAR;
        PG8_WAIT_V(2); PG8_BAR;
        PG8_STAGE(PG8_SB(1, 0), cB + kstep, voffB); PG8_STAGE(PG8_SA(1, 0), cA + kstep, voffA); PG8_STAGE(PG8_SB(1, 1), cB + hstep + kstep, voffB);
        PG8_WAIT_V(6); PG8_BAR;
    } else {
        PG8_STAGE(PG8_SB(0, 0), cB, voffB); PG8_STAGE(PG8_SA(0, 0), cA, voffA); PG8_STAGE(PG8_SB(0, 1), cB + hstep, voffB); PG8_STAGE(PG8_SA(0, 1), cA + hstep, voffA);
        if (wr == 1) PG8_BAR;
        PG8_WAIT_V(4); PG8_BAR;
        PG8_STAGE(PG8_SB(1, 0), cB + kstep, voffB); PG8_STAGE(PG8_SA(1, 0), cA + kstep, voffA); PG8_STAGE(PG8_SB(1, 1), cB + hstep + kstep, voffB);
        PG8_WAIT_V(6); PG8_BAR;
    }
    for (;;) {
        const bool has_next = S.next(ui + 1, nxt);
        const char* nA = has_next ? (const char*)g.A + (size_t)nxt.pm * tstep : cA; const char* nB = has_next ? (const char*)g.Bt + (size_t)nxt.pn * tstep : cB;
        for (int t = 0; t < nt; t += 2) {
            const bool last = (t == nt - 2);
            const char* a1 = cA + (size_t)(t + 1) * kstep;
            const char* a2 = last ? nA : cA + (size_t)(t + 2) * kstep; const char* b2 = last ? nB : cB + (size_t)(t + 2) * kstep;
            const char* a3 = a2 + kstep; const char* b3 = b2 + kstep;
            if (last && has_next) S.a_ready(nxt);
            if constexpr (SP2) {
            PG8_LDB(B0, 0, 0); PG8_LDB(B1, 0, 1); PG8_SCHED; PG8_LDA(At, 0, 0); PG8_STAGE(PG8_SA(1, 1), a1 + hstep, voffA);
            PG8_WAIT_V(8); PG8_WAIT_L(0); PG8_BAR; PG8_MMA(0, 0, At, B0); PG8_MMA(0, 1, At, B1); PG8_BAR; PG8_SCHED;
            PG8_LDA(At, 0, 1); PG8_STAGE(PG8_SB(0, 0), b2, voffB); PG8_STAGE(PG8_SB(0, 1), b2 + hstep, voffB); PG8_STAGE(PG8_SA(0, 0), a2, voffA);
            PG8_WAIT_V(8); PG8_WAIT_L(0); PG8_BAR; PG8_MMA(1, 0, At, B0); PG8_MMA(1, 1, At, B1); PG8_BAR; PG8_SCHED;
            PG8_LDB(B0, 1, 0); PG8_LDB(B1, 1, 1); PG8_SCHED; PG8_LDA(At, 1, 0); PG8_STAGE(PG8_SA(0, 1), a2 + hstep, voffA);
            PG8_WAIT_V(8); PG8_WAIT_L(0); PG8_BAR; PG8_MMA(0, 0, At, B0); PG8_MMA(0, 1, At, B1); PG8_BAR; PG8_SCHED;
            PG8_LDA(At, 1, 1); PG8_STAGE(PG8_SB(1, 0), b3, voffB); PG8_STAGE(PG8_SB(1, 1), b3 + hstep, voffB); PG8_STAGE(PG8_SA(1, 0), a3, voffA);
            PG8_WAIT_V(8); PG8_WAIT_L(0); PG8_BAR; PG8_MMA(1, 0, At, B0); PG8_MMA(1, 1, At, B1); PG8_BAR; PG8_SCHED;
            } else {
            PG8_LDB(B0, 0, 0); PG8_SCHED; PG8_LDA(At, 0, 0); PG8_STAGE(PG8_SA(1, 1), a1 + hstep, voffA);
            PG8_WAIT_L(8); PG8_BAR; PG8_WAIT_L(0); PG8_MMA(0, 0, At, B0); PG8_BAR; PG8_SCHED;
            PG8_LDB(B1, 0, 1); PG8_STAGE(PG8_SB(0, 0), b2, voffB);
            PG8_BAR; PG8_WAIT_L(0); PG8_MMA(0, 1, At, B1); PG8_BAR;
            PG8_LDA(At, 0, 1); PG8_STAGE(PG8_SA(0, 0), a2, voffA);
            PG8_BAR; PG8_WAIT_L(0); PG8_MMA(1, 0, At, B0); PG8_BAR; PG8_SCHED;
            PG8_STAGE(PG8_SB(0, 1), b2 + hstep, voffB);
            PG8_WAIT_V(6); PG8_BAR; PG8_MMA(1, 1, At, B1); PG8_BAR;
            PG8_LDB(B0, 1, 0); PG8_SCHED; PG8_LDA(At, 1, 0); PG8_STAGE(PG8_SA(0, 1), a2 + hstep, voffA);
            PG8_WAIT_L(8); PG8_BAR; PG8_WAIT_L(0); PG8_MMA(0, 0, At, B0); PG8_BAR; PG8_SCHED;
            PG8_LDB(B1, 1, 1); PG8_STAGE(PG8_SB(1, 0), b3, voffB);
            PG8_BAR; PG8_WAIT_L(0); PG8_MMA(0, 1, At, B1); PG8_BAR;
            PG8_LDA(At, 1, 1); PG8_STAGE(PG8_SA(1, 0), a3, voffA);
            PG8_BAR; PG8_WAIT_L(0); PG8_MMA(1, 0, At, B0); PG8_BAR; PG8_SCHED;
            PG8_STAGE(PG8_SB(1, 1), b3 + hstep, voffB);
            PG8_WAIT_V(6); PG8_BAR; PG8_MMA(1, 1, At, B1); PG8_BAR;
            }
        }
        if constexpr (ALIGN_EPI) { if (wr == 0) PG8_BAR; }
        if constexpr (!Epi::AFTER_DRAIN) { E(acc, cur, wr, wc, fr, fq); S.done(cur); }
        if (!has_next) break;
#pragma unroll
        for (int a = 0; a < 2; ++a)
#pragma unroll
            for (int b = 0; b < 2; ++b)
#pragma unroll
                for (int m = 0; m < 4; ++m)
#pragma unroll
                    for (int n = 0; n < 2; ++n) acc[a][b][m][n] = (f32x4){0.f, 0.f, 0.f, 0.f};
        cur = nxt; cA = nA; cB = nB; ++ui;
        if constexpr (ALIGN_EPI) { if (wr == 1) PG8_BAR; }
    }
    PG8_WAIT_V(0);
    if constexpr (!ALIGN_EPI) { if (wr == 0) PG8_BAR; }
    PG8_BAR;
    if constexpr (Epi::AFTER_DRAIN) { E.fused(acc, cur, wr, wc, fr, fq, lds, wid, lane); S.done(cur); }
#undef PG8_SA
#undef PG8_SB
#undef PG8_STAGE
#undef PG8_LDA
#undef PG8_LDB
#undef PG8_MMA
#undef PG8_WAIT_V
#undef PG8_WAIT_L
#undef PG8_BAR
#undef PG8_SCHED
}
}
#define LAS __attribute__((address_space(3)))

#define XB_TMO      128
#define XB_XCNT(j)  (256  + 64 * (j))
#define XB_XSUB(j)  (1280 + 64 * (j))
#define XB_XGEN(j)  (2304 + 64 * (j))
#define XB_TOP      3328
#define XB_TOPGEN   3392
#define XCD_BAR_WORDS 3456
#define XB_SPIN_CAP (1u << 18)

__device__ __forceinline__ unsigned xb_ld(unsigned* p)              { return __hip_atomic_load(p, __ATOMIC_RELAXED, __HIP_MEMORY_SCOPE_AGENT); }
__device__ __forceinline__ unsigned xb_add(unsigned* p, unsigned v) { return __hip_atomic_fetch_add(p, v, __ATOMIC_RELAXED, __HIP_MEMORY_SCOPE_AGENT); }
__device__ __forceinline__ unsigned xb_xcc_id() { return (unsigned)__builtin_amdgcn_s_getreg((3 << 11) | 20) & 0xFu; }
#define XB_SPIN(cond, bar) do { unsigned _sp = 0; while (cond) { __builtin_amdgcn_s_sleep(1); \
    if ((++_sp & 255u) == 0u) { if (xb_ld(&(bar)[XB_TMO])) break; if (_sp > XB_SPIN_CAP) { atomicAdd(&(bar)[XB_TMO], 1u); break; } } } } while (0)

struct XcdBarrier {
    unsigned* bar; unsigned x;
    volatile LAS unsigned* st;
};

__device__ __forceinline__ XcdBarrier xcd_barrier_post(unsigned* bar, volatile LAS unsigned* st) {
    XcdBarrier b; b.bar = bar; b.x = xb_xcc_id(); b.st = st;
    if (threadIdx.x == 0) (void)xb_add(&bar[XB_XCNT(b.x)], 1u);
    return b;
}
__device__ __forceinline__ void xcd_barrier_complete(unsigned* bar, unsigned x, unsigned& nloc, unsigned& nx) {
    const unsigned G = gridDim.x * gridDim.y * gridDim.z;
    unsigned sum, cnt, mine, sp = 0u;
    for (;;) {
        sum = 0u; cnt = 0u; mine = 0u;
#pragma unroll
        for (unsigned j = 0; j < 16; ++j) { const unsigned c = xb_ld(&bar[XB_XCNT(j)]); sum += c; cnt += (c > 0u) ? 1u : 0u; mine = (j == x) ? c : mine; }
        if (sum == G) break;
        __builtin_amdgcn_s_sleep(1);
        if ((++sp & 255u) == 0u) { if (xb_ld(&bar[XB_TMO])) break; if (sp > XB_SPIN_CAP) { atomicAdd(&bar[XB_TMO], 1u); break; } }
    }
    nloc = mine > 0u ? mine : 1u; nx = cnt > 0u ? cnt : 1u;
}

__device__ __forceinline__ void xcd_barrier(const XcdBarrier& b) {
    asm volatile("s_waitcnt vmcnt(0)" ::: "memory");
    __syncthreads();
    if (threadIdx.x == 0) {
        unsigned* bar = b.bar;
        __builtin_amdgcn_s_waitcnt(0);
        unsigned nloc = b.st[0], nx = b.st[1];
        if (nloc == 0u) { xcd_barrier_complete(bar, b.x, nloc, nx); b.st[0] = nloc; b.st[1] = nx; }
        const unsigned old = xb_add(&bar[XB_XSUB(b.x)], 1u);
        const unsigned gen = old / nloc;
        if (old + 1u == (gen + 1u) * nloc) {
            __builtin_amdgcn_fence(__ATOMIC_RELEASE, "agent");
            asm volatile("s_waitcnt vmcnt(0)" ::: "memory");
            const unsigned og = xb_add(&bar[XB_TOP], 1u);
            const unsigned tg = og / nx;
            if (og + 1u == (tg + 1u) * nx) xb_add(&bar[XB_TOPGEN], 1u);
            else XB_SPIN(xb_ld(&bar[XB_TOPGEN]) == tg, bar);
            __builtin_amdgcn_fence(__ATOMIC_ACQUIRE, "agent");
            xb_add(&bar[XB_XGEN(b.x)], 1u);
            asm volatile("s_waitcnt vmcnt(0)" ::: "memory");
        } else {
            XB_SPIN(xb_ld(&bar[XB_XGEN(b.x)]) == gen, bar);
            __builtin_amdgcn_fence(__ATOMIC_ACQUIRE, "agent");
            asm volatile("s_waitcnt vmcnt(0)" ::: "memory");
        }
    }
    __syncthreads();
}


#ifndef REP_MASK
#define REP_MASK 0
#endif
#ifndef NAIVE_ATTN
#define NAIVE_ATTN 0
#endif
#ifndef NAIVE_SPATIAL
#define NAIVE_SPATIAL 0
#endif

using pg8::bf16_t; using pg8::f32x4; using pg8::Unit; using pg8::u32x4;
typedef unsigned u32x2 __attribute__((ext_vector_type(2)));

constexpr int NLAT = 32768, NCTX = 2048, MTOT = 34816;
constexpr int NTHREADS = 512;
constexpr int LDS_BYTES = 131072 + 16;
constexpr int NPH = 24;

constexpr size_t OFF_W1T = 0;
constexpr size_t OFF_W2T = OFF_W1T + 4ull * 4096 * 1024 * 2;
constexpr size_t OFF_QKVT = OFF_W2T + 4ull * 4096 * 1024 * 2;
constexpr size_t OFF_WOT = OFF_QKVT + 2ull * 3072 * 1024 * 2;
constexpr size_t OFF_WINT = OFF_WOT + 2ull * 1024 * 1024 * 2;
constexpr size_t OFF_SGOT = OFF_WINT + 2ull * 6144 * 1024 * 2;
constexpr size_t OFF_MODS = OFF_SGOT + 2ull * 1024 * 3072 * 2;
constexpr size_t OFF_CTXR = OFF_MODS + 4ull * 9 * 6144 * 4;
constexpr size_t OFF_HB = OFF_CTXR + 2048ull * 1024 * 4;
constexpr size_t OFF_BIG = OFF_HB + 34816ull * 1024 * 2;
constexpr size_t OFF_SSQ = OFF_BIG + 34816ull * 4096 * 2;
constexpr size_t OFF_LNACC = OFF_SSQ + 8ull * 34816 * 4;
constexpr size_t OFF_GS = OFF_LNACC + 2ull * 34816 * 2 * 4;
constexpr size_t OFF_BQKV = OFF_GS + 8ull * 9 * 1024 * 4;
constexpr size_t OFF_BMLP = OFF_BQKV + 2ull * 9 * 3072 * 4;
constexpr size_t OFF_BWIN = OFF_BMLP + 4ull * 9 * 4096 * 4;
constexpr size_t OFF_BAR = OFF_BWIN + 2ull * 9 * 6144 * 4;
constexpr size_t WS_END = OFF_BAR + 16384;

struct Params {
    const float *x, *c, *ctx, *c_ctx, *ada_w, *ada_b, *norm1_g, *norm2_g, *mlp_w1, *mlp_w2, *na_w_qkv, *na_q_norm, *na_k_norm, *na_rpb, *na_w_o,
        *sg_w_in, *sg_b_in, *sg_ln_g, *sg_ln_b, *sg_w_s, *sg_b_s, *sg_w_o;
    float* out; unsigned char* ws; int ph_lo, ph_hi;
};

struct Tix { int tid, bid, gsz; };
__device__ __forceinline__ float bf2f(unsigned h) { return __uint_as_float(h << 16); }
__device__ __forceinline__ unsigned f2bf(float f) { unsigned u = __float_as_uint(f); u += 0x7FFFu + ((u >> 16) & 1u); return u >> 16; }
__device__ __forceinline__ unsigned pk2(float lo, float hi) { return pg8::cvt_pk_bf16(lo, hi); }
__device__ __forceinline__ float wave_sum(float v) {
#pragma unroll
    for (int o = 1; o < 64; o <<= 1) v += __shfl_xor(v, o);
    return v;
}
__device__ __forceinline__ float wave_max(float v) {
#pragma unroll
    for (int o = 1; o < 64; o <<= 1) v = fmaxf(v, __shfl_xor(v, o));
    return v;
}
#define LDS_WAIT() asm volatile("s_waitcnt lgkmcnt(0)" ::: "memory")
__device__ __forceinline__ float silu_f(float v) { return v / (1.f + expf(-v)); }
__device__ __forceinline__ float gelu_f(float v) { return 0.5f * v * (1.f + erff(v * 0.70710678118654752f)); }

typedef float f32x2 __attribute__((ext_vector_type(2)));
__device__ __forceinline__ f32x2 gelu_pk(f32x2 v) {
    const f32x2 av = __builtin_elementwise_abs(v), d = av * 0.2316418882f + 1.0f;
    f32x2 t; t.x = __builtin_amdgcn_rcpf(d.x); t.y = __builtin_amdgcn_rcpf(d.y);
    f32x2 q = t * 0.5307027145f + (-0.7265760135f); q = q * t + 0.7107068705f; q = q * t + (-0.142248368f); q = q * t + 0.127414796f; q = q * t;
    const f32x2 s = (v * v) * (-0.72134752044f);
    f32x2 e; e.x = __builtin_amdgcn_exp2f(s.x); e.y = __builtin_amdgcn_exp2f(s.y);
    const f32x2 m = v * (q * e), r = v - m;
    f32x2 o; o.x = v.x < 0.f ? m.x : r.x; o.y = v.y < 0.f ? m.y : r.y; return o;
}
__device__ __forceinline__ f32x4 gelu4(f32x4 v) { const f32x2 a = gelu_pk((f32x2){v.x, v.y}), b = gelu_pk((f32x2){v.z, v.w}); return (f32x4){a.x, a.y, b.x, b.y}; }

__device__ __forceinline__ int sigma_inv(int L) { return 128 * ((L >> 5) & 1) + 32 * (L >> 6) + 16 * ((L >> 2) & 1) + 4 * ((L >> 3) & 3) + (L & 3); }

__device__ __forceinline__ void phase_mods(const Params& p, LAS unsigned char* lds, const Tix T_) {
    LAS float* sc = (LAS float*)lds;
    LAS float* red = (LAS float*)(lds + 36864);
    float* mods = (float*)(p.ws + OFF_MODS);
    const int tid = T_.tid;
    for (int i = tid; i < 9 * 1024; i += NTHREADS) { const int b = i >> 10, k = i & 1023; const float v = b < 8 ? p.c[b * 1024 + k] : p.c_ctx[k]; sc[i] = silu_f(v); }
    __syncthreads();
    const int c4 = (tid & 15) * 4, kk = tid >> 4;
    for (int item = T_.bid; item < 384; item += T_.gsz) {
        const int l = item / 96, n0 = (item % 96) * 64;
        const float* W = p.ada_w + (size_t)l * 1024 * 6144 + n0 + c4;
        f32x4 acc[9];
#pragma unroll
        for (int b = 0; b < 9; ++b) acc[b] = (f32x4){0.f, 0.f, 0.f, 0.f};
#pragma unroll 4
        for (int i = 0; i < 32; ++i) { const int k = kk + 32 * i; const f32x4 w = *(const f32x4*)(W + (size_t)k * 6144);
#pragma unroll
            for (int b = 0; b < 9; ++b) acc[b] += sc[b * 1024 + k] * w; }
#pragma unroll
        for (int b = 0; b < 9; ++b) *(LAS f32x4*)(red + (kk * 9 + b) * 64 + c4) = acc[b];
        __syncthreads();
        for (int o = tid; o < 576; o += NTHREADS) { const int b = o >> 6, cc = o & 63; float s = 0.f;
            for (int j = 0; j < 32; ++j) s += red[(j * 9 + b) * 64 + cc];
            mods[(size_t)(l * 9 + b) * 6144 + n0 + cc] = s + p.ada_b[l * 6144 + n0 + cc]; }
        __syncthreads();
    }
}

struct MatDesc { const float* src; bf16_t* dst; int K, N; };
__device__ __forceinline__ MatDesc get_mat(const Params& p, int mi) {
    MatDesc m;
    if (mi < 4) { m.src = p.mlp_w1 + (size_t)mi * 1024 * 4096; m.dst = (bf16_t*)(p.ws + OFF_W1T) + (size_t)mi * 4096 * 1024; m.K = 1024; m.N = 4096; }
    else if (mi < 8) { const int l = mi - 4; m.src = p.mlp_w2 + (size_t)l * 4096 * 1024; m.dst = (bf16_t*)(p.ws + OFF_W2T) + (size_t)l * 1024 * 4096; m.K = 4096; m.N = 1024; }
    else if (mi < 10) { const int a = mi - 8; m.src = p.na_w_qkv + (size_t)a * 1024 * 3072; m.dst = (bf16_t*)(p.ws + OFF_QKVT) + (size_t)a * 3072 * 1024; m.K = 1024; m.N = 3072; }
    else if (mi < 12) { const int a = mi - 10; m.src = p.na_w_o + (size_t)a * 1024 * 1024; m.dst = (bf16_t*)(p.ws + OFF_WOT) + (size_t)a * 1024 * 1024; m.K = 1024; m.N = 1024; }
    else if (mi < 14) { const int s = mi - 12; m.src = p.sg_w_in + (size_t)s * 1024 * 6144; m.dst = (bf16_t*)(p.ws + OFF_WINT) + (size_t)s * 6144 * 1024; m.K = 1024; m.N = 6144; }
    else { const int s = mi - 14; m.src = p.sg_w_o + (size_t)s * 3072 * 1024; m.dst = (bf16_t*)(p.ws + OFF_SGOT) + (size_t)s * 1024 * 3072; m.K = 3072; m.N = 1024; }
    return m;
}
__device__ __forceinline__ void transpose_item(const float* W, int K, int N, bf16_t* WT, LAS float* scr, int item, int lane) {
    const int nblk = N / 32, kb = item / nblk, nb = item % nblk, k0 = 64 * kb, n0 = 32 * nb;
#pragma unroll 8
    for (int i = 0; i < 32; ++i) { const int kk = 2 * i + (lane >> 5); scr[kk * 33 + (lane & 31)] = W[(size_t)(k0 + kk) * N + n0 + (lane & 31)]; }
    LDS_WAIT();
    const int c = lane & 7;
#pragma unroll
    for (int j = 0; j < 4; ++j) { const int n = (lane >> 3) + 8 * j; const LAS float* s = scr + (8 * c) * 33 + n;
        u32x4 o; o.x = pk2(s[0 * 33], s[1 * 33]); o.y = pk2(s[2 * 33], s[3 * 33]); o.z = pk2(s[4 * 33], s[5 * 33]); o.w = pk2(s[6 * 33], s[7 * 33]);
        const int nl = n0 + n, drow = (nl & ~255) + sigma_inv(nl & 255);
        *(u32x4*)(WT + (size_t)drow * K + k0 + 8 * c) = o; }
    LDS_WAIT();
}
__device__ __forceinline__ void phase_convert(const Params& p, LAS unsigned char* lds, const Tix T_) {
    const int lane = T_.tid & 63, wave = T_.tid >> 6, gw = T_.bid * 8 + wave, NGW = T_.gsz * 8;
    LAS float* scr = (LAS float*)(lds + wave * 8704);
    for (int mi = 0; mi < 16; ++mi) {
        const MatDesc m = get_mat(p, mi);
        const int nitems = (m.K / 64) * (m.N / 32);
        for (int it = gw; it < nitems; it += NGW) transpose_item(m.src, m.K, m.N, m.dst, scr, it, lane);
    }
}


__device__ __forceinline__ void phase_zero(const Params& p, const Tix T_) {
    float* z0 = (float*)(p.ws + OFF_SSQ) + MTOT; const int n0 = 7 * MTOT + 2 * MTOT * 2;
    for (int i = T_.bid * NTHREADS + T_.tid; i < n0; i += T_.gsz * NTHREADS) z0[i] = 0.f;
}
__device__ __forceinline__ void phase_0b(const Params& p, LAS unsigned char* lds, const Tix T_) {
    const float* mods = (const float*)(p.ws + OFF_MODS);
    const int tid = T_.tid, lane = tid & 63, wave = tid >> 6, gw = T_.bid * 8 + wave, NGW = T_.gsz * 8;
    { float* gs = (float*)(p.ws + OFF_GS);
      for (int i = T_.bid * NTHREADS + tid; i < 8 * 9 * 1024; i += T_.gsz * NTHREADS) { const int n = i / 9216, rem = i % 9216, b = rem >> 10, c = rem & 1023, L = n >> 1;
          const float g = (n & 1) ? p.norm2_g[L * 1024 + c] : p.norm1_g[L * 1024 + c];
          gs[i] = g * (1.0f + mods[(size_t)(L * 9 + b) * 6144 + ((n & 1) ? 4096 : 1024) + c]); } }
    { bf16_t* hb = (bf16_t*)(p.ws + OFF_HB); float* ssq0 = (float*)(p.ws + OFF_SSQ);
      for (int row = gw; row < MTOT; row += NGW) {
          const float* xr = row < NLAT ? p.x + (size_t)row * 1024 : p.ctx + (size_t)(row - NLAT) * 1024;
          const int b = row < NLAT ? (row >> 12) : 8;
          f32x4 v[4]; float ss = 0.f;
#pragma unroll
          for (int j = 0; j < 4; ++j) { v[j] = *(const f32x4*)(xr + 4 * lane + 256 * j); ss += (v[j].x * v[j].x + v[j].y * v[j].y) + (v[j].z * v[j].z + v[j].w * v[j].w); }
          ss = wave_sum(ss);
          if (lane == 0) ssq0[row] = ss;
#pragma unroll
          for (int j = 0; j < 4; ++j) { const int col = 4 * lane + 256 * j;
              const f32x4 gv = *(const f32x4*)(p.norm1_g + col), scv = *(const f32x4*)(mods + (size_t)b * 6144 + 1024 + col);
              const f32x4 o = v[j] * gv * (1.0f + scv);
              u32x2 w; w.x = pk2(o.x, o.y); w.y = pk2(o.z, o.w);
              *(u32x2*)(hb + (size_t)row * 1024 + col) = w; } } }
    LAS float* sh = (LAS float*)lds;
    for (int cmb = 0; cmb < 8; ++cmb) {
        int L, shoff, N; const bf16_t* Bt; float* dst; const float* addb = nullptr;
        if (cmb < 2) { L = 2 * cmb; shoff = 0; N = 3072; Bt = (const bf16_t*)(p.ws + OFF_QKVT) + (size_t)cmb * 3072 * 1024; dst = (float*)(p.ws + OFF_BQKV) + (size_t)cmb * 9 * 3072; }
        else if (cmb < 6) { L = cmb - 2; shoff = 3072; N = 4096; Bt = (const bf16_t*)(p.ws + OFF_W1T) + (size_t)L * 4096 * 1024; dst = (float*)(p.ws + OFF_BMLP) + (size_t)L * 9 * 4096; }
        else { const int sl = cmb - 6; L = 2 * sl + 1; shoff = 0; N = 6144; Bt = (const bf16_t*)(p.ws + OFF_WINT) + (size_t)sl * 6144 * 1024; dst = (float*)(p.ws + OFF_BWIN) + (size_t)sl * 9 * 6144; addb = p.sg_b_in + sl * 6144; }
        __syncthreads();
        for (int i = tid; i < 9 * 1024; i += NTHREADS) sh[i] = mods[(size_t)(L * 9 + (i >> 10)) * 6144 + shoff + (i & 1023)];
        __syncthreads();
        for (int n = gw; n < N; n += NGW) {
            const bf16_t* wr_ = Bt + (size_t)((n & ~255) + sigma_inv(n & 255)) * 1024 + lane * 8;
            const u32x4 w0 = *(const u32x4*)wr_, w1 = *(const u32x4*)(wr_ + 512);
            float wv[16];
#pragma unroll
            for (int e = 0; e < 4; ++e) { wv[2 * e] = bf2f(w0[e] & 0xffffu); wv[2 * e + 1] = bf2f(w0[e] >> 16); wv[8 + 2 * e] = bf2f(w1[e] & 0xffffu); wv[8 + 2 * e + 1] = bf2f(w1[e] >> 16); }
            const float ab = addb ? addb[n] : 0.f;
#pragma unroll
            for (int b = 0; b < 9; ++b) {
                const f32x4 s0 = *(const LAS f32x4*)(sh + b * 1024 + lane * 8), s1 = *(const LAS f32x4*)(sh + b * 1024 + lane * 8 + 4);
                const f32x4 s2 = *(const LAS f32x4*)(sh + b * 1024 + 512 + lane * 8), s3 = *(const LAS f32x4*)(sh + b * 1024 + 512 + lane * 8 + 4);
                float a = (wv[0] * s0.x + wv[1] * s0.y) + (wv[2] * s0.z + wv[3] * s0.w) + (wv[4] * s1.x + wv[5] * s1.y) + (wv[6] * s1.z + wv[7] * s1.w)
                        + (wv[8] * s2.x + wv[9] * s2.y) + (wv[10] * s2.z + wv[11] * s2.w) + (wv[12] * s3.x + wv[13] * s3.y) + (wv[14] * s3.z + wv[15] * s3.w);
                a = wave_sum(a);
                if (lane == 0) dst[(size_t)b * N + n] = a + ab; }
        }
    }
}

typedef short s16x4 __attribute__((ext_vector_type(4)));
typedef short s16x8 __attribute__((ext_vector_type(8)));
typedef float f32x16 __attribute__((ext_vector_type(16)));
typedef __bf16 bf16x2_t __attribute__((ext_vector_type(2)));
__device__ __forceinline__ unsigned pkb(float a, float b) { const f32x2 v = {a, b}; const bf16x2_t r = __builtin_convertvector(v, bf16x2_t); return __builtin_bit_cast(unsigned, r); }
__device__ __forceinline__ s16x8 pack8(float a0, float a1, float a2, float a3, float a4, float a5, float a6, float a7) {
    u32x4 w; w.x = pkb(a0, a1); w.y = pkb(a2, a3); w.z = pkb(a4, a5); w.w = pkb(a6, a7); return __builtin_bit_cast(s16x8, w); }
__device__ __forceinline__ s16x8 tr_pair(const LAS unsigned char* a0, int second_off) {
    const s16x4 a = __builtin_amdgcn_ds_read_tr16_b64_v4i16((LAS s16x4*)a0);
    const s16x4 b = __builtin_amdgcn_ds_read_tr16_b64_v4i16((LAS s16x4*)(a0 + second_off));
    s16x8 r; r[0] = a[0]; r[1] = a[1]; r[2] = a[2]; r[3] = a[3]; r[4] = b[0]; r[5] = b[1]; r[6] = b[2]; r[7] = b[3]; return r; }
#define MFMA32(a, b, c) __builtin_amdgcn_mfma_f32_32x32x16_bf16((a), (b), (c), 0, 0, 0)

constexpr int AV_STR = 144;
__device__ __forceinline__ f32x16 attn_qk(const s16x8 (&Kf)[4], const s16x8 (&Qf)[4]) {
    f32x16 S;
#pragma unroll
    for (int i = 0; i < 16; ++i) S[i] = 0.f;
#pragma unroll
    for (int ks = 0; ks < 4; ++ks) S = MFMA32(Kf[ks], Qf[ks], S);
    return S;
}
__device__ __forceinline__ float tabv(const LAS unsigned char* tabrow, int off) { return *(const LAS float*)(tabrow + off); }
__device__ __forceinline__ void attn_one_tile(const s16x8 (&Kf)[4], const s16x8 (&Qf)[4], const LAS unsigned char* vb, const LAS unsigned char* tabrow, const unsigned (&offo)[4], const unsigned offx,
                                              f32x16& O0, f32x16& O1, float& lsum, int mode, float mbl) {
    const f32x16 S = attn_qk(Kf, Qf);
    float pv[16];
    if (mode == 0) {
#pragma unroll
        for (int i = 0; i < 16; ++i) pv[i] = __builtin_amdgcn_exp2f(S[i] - mbl);
    } else if (mode == 1) {
#pragma unroll
        for (int i = 0; i < 16; ++i) pv[i] = __builtin_amdgcn_exp2f(S[i] + tabv(tabrow, (int)((offo[i >> 2] >> (8 * (i & 3))) & 0xffu)));
    } else {
#pragma unroll
        for (int i = 0; i < 16; ++i) pv[i] = 0.f;
        if (mode == 2) {
#pragma unroll
            for (int i = 0; i < 4; ++i) pv[i] = __builtin_amdgcn_exp2f(S[i] + tabv(tabrow, (int)((offx >> (8 * i)) & 0xffu)));
        } else {
#pragma unroll
            for (int i = 0; i < 4; ++i) pv[12 + i] = __builtin_amdgcn_exp2f(S[12 + i] + tabv(tabrow, (int)((offx >> (8 * i)) & 0xffu)));
        }
    }
#pragma unroll
    for (int i = 0; i < 16; ++i) lsum += pv[i];
    const s16x8 P0 = pack8(pv[0], pv[1], pv[2], pv[3], pv[4], pv[5], pv[6], pv[7]), P1 = pack8(pv[8], pv[9], pv[10], pv[11], pv[12], pv[13], pv[14], pv[15]);
    { const s16x8 V00 = tr_pair(vb, 8 * AV_STR), V01 = tr_pair(vb + 64, 8 * AV_STR);
      O0 = MFMA32(V00, P0, O0); O1 = MFMA32(V01, P0, O1); }
    { const s16x8 V10 = tr_pair(vb + 16 * AV_STR, 8 * AV_STR), V11 = tr_pair(vb + 16 * AV_STR + 64, 8 * AV_STR);
      O0 = MFMA32(V10, P1, O0); O1 = MFMA32(V11, P1, O1); }
}
__device__ __forceinline__ void attn_load_k(s16x8 (&Kf)[4], const bf16_t* kbase, int klat0, int kctx0, int kt, int ntl, int rs) {
    const size_t grow = kt < ntl ? (size_t)(klat0 + (rs + (kt >> 1)) * 64 + 32 * (kt & 1)) : (size_t)(kctx0 + 32 * (kt - ntl));
#pragma unroll
    for (int ks = 0; ks < 4; ++ks) Kf[ks] = *(const s16x8*)(kbase + grow * 3072 + 16 * ks);
}
struct AUnit { int b, h, qrow0, r, rs, ntl, ntiles; };
__device__ __forceinline__ AUnit attn_decode(int u, int nlatu) {
    AUnit a;
    if (u < nlatu) { a.h = u & 15; const int br = u >> 4; a.r = br & 63; a.b = br >> 6; a.qrow0 = a.b * 4096 + a.r * 64; a.rs = min(max(a.r - 4, 0), 56); a.ntl = 16; a.ntiles = 24; }
    else { const int v = u - nlatu; a.h = v & 15; const int bq = v >> 4; a.b = bq >> 2; a.qrow0 = NLAT + a.b * 256 + (bq & 3) * 64; a.r = 0; a.rs = 0; a.ntl = 0; a.ntiles = 8; }
    return a;
}
__device__ __forceinline__ u32x4 attn_load_v1(const bf16_t* vbase, const AUnit& a, int idx) {
    const int key = idx >> 3, ch = idx & 7, kt = key >> 5, kk = key & 31;
    const int grow = kt < a.ntl ? (a.b * 4096 + (a.rs + (kt >> 1)) * 64 + 32 * (kt & 1) + kk) : (NLAT + a.b * 256 + 32 * (kt - a.ntl) + kk);
    return *(const u32x4*)(vbase + (size_t)grow * 3072 + ch * 8);
}
__device__ __forceinline__ void attn_load_v(u32x4 (&vpre)[12], const bf16_t* qkv, const AUnit& a, int tid) {
    const bf16_t* vbase = qkv + 2048 + a.h * 64;
#pragma unroll
    for (int i = 0; i < 4; ++i) vpre[i] = attn_load_v1(vbase, a, tid + NTHREADS * i);
    if (a.ntiles == 24) {
#pragma unroll
        for (int i = 4; i < 12; ++i) vpre[i] = attn_load_v1(vbase, a, tid + NTHREADS * i);
    }
}

__device__ __forceinline__ void phase_attn_mfma(const Params& p, int a_, bool ctx_q, LAS unsigned char* lds, const Tix T_) {
    const bf16_t* qkv = (const bf16_t*)(p.ws + OFF_BIG); bf16_t* ao = (bf16_t*)(p.ws + OFF_BIG) + (size_t)MTOT * 3072;
    const float* rpb = p.na_rpb + (size_t)a_ * 16 * 15 * 31;
    const int tid = T_.tid, lane = tid & 63, wave = __builtin_amdgcn_readfirstlane(tid >> 6), qt = wave & 1, kq = wave >> 1, l31 = lane & 31, hi = lane >> 5;
    LAS unsigned char* Vl = lds;
    LAS float* Ored = (LAS float*)lds;
    LAS float* lred = (LAS float*)(lds + 69632);
    LAS float* tab = (LAS float*)(lds + 110592);
    LAS float* misc = (LAS float*)(lds + 110592 + 2048);
    constexpr float LOG2E = 1.4426950408889634f;
    float mb;
    { float m = 0.f; for (int i = tid; i < 7440; i += NTHREADS) m = fmaxf(m, rpb[i]);
      float qg = 0.f, kg = 0.f; if (tid < 64) { qg = fabsf(p.na_q_norm[a_ * 64 + tid]); kg = fabsf(p.na_k_norm[a_ * 64 + tid]); }
      m = wave_max(m); qg = wave_max(qg); kg = wave_max(kg);
      if (lane == 0) { misc[wave] = m; if (wave == 0) { misc[8] = qg; misc[9] = kg; } }
      __syncthreads();
      float rm = misc[0];
#pragma unroll
      for (int w = 1; w < 8; ++w) rm = fmaxf(rm, misc[w]);
      mb = 8.0f * misc[8] * misc[9] + rm; }
    const float mbl = mb * LOG2E;
    const int nlatu = 8 * 64 * 16, total = nlatu + (ctx_q ? 8 * 4 * 16 : 0);
    const int tr_q = (lane & 15) >> 2, tr_p = lane & 3, dgrp = (lane >> 4) & 1;
    const int qcol = 32 * qt + l31, wst = min(max(qcol - 8, 0), 48);
    unsigned offo[4], offx = 0u;
#pragma unroll
    for (int j = 0; j < 4; ++j) { offo[j] = 0u;
#pragma unroll
        for (int i = 0; i < 4; ++i) { const int kcol = 32 * qt + 8 * j + 4 * hi + i; offo[j] |= (unsigned)(((unsigned)(kcol - wst) < 16u ? kcol - qcol + 15 : 31) * 4) << (8 * i); } }
#pragma unroll
    for (int i = 0; i < 4; ++i) { const int kcol = (qt == 0 ? 32 : 24) + 4 * hi + i; offx |= (unsigned)(((unsigned)(kcol - wst) < 16u ? kcol - qcol + 15 : 31) * 4) << (8 * i); }
    int u = T_.bid;
    AUnit cur = attn_decode(min(u, total - 1), nlatu);
    u32x4 vpre[12];
    s16x8 Qf[4], KA[4], KB[4];
    if (u < total) {
        attn_load_v(vpre, qkv, cur, tid);
        const bf16_t* qp = qkv + (size_t)(cur.qrow0 + 32 * qt + l31) * 3072 + cur.h * 64 + 8 * hi;
#pragma unroll
        for (int ks = 0; ks < 4; ++ks) Qf[ks] = *(const s16x8*)(qp + 16 * ks);
        const int t0 = kq * (cur.ntiles >> 2);
        attn_load_k(KA, qkv + 1024 + cur.h * 64 + 8 * hi, cur.b * 4096 + l31, NLAT + cur.b * 256 + l31, t0, cur.ntl, cur.rs);
        attn_load_k(KB, qkv + 1024 + cur.h * 64 + 8 * hi, cur.b * 4096 + l31, NLAT + cur.b * 256 + l31, t0 + 1, cur.ntl, cur.rs);
    }
    while (u < total) {
        const int b = cur.b, h = cur.h, qrow0 = cur.qrow0, r = cur.r, rs = cur.rs, ntl = cur.ntl, ntiles = cur.ntiles;
        int tidl = tid; asm volatile("" : "+v"(tidl));
#pragma unroll
        for (int i = 0; i < 4; ++i) { const int idx = tidl + NTHREADS * i; *(LAS u32x4*)(Vl + (idx >> 3) * AV_STR + (idx & 7) * 16) = vpre[i]; }
        if (ntiles == 24) {
#pragma unroll
            for (int i = 4; i < 12; ++i) { const int idx = tidl + NTHREADS * i; *(LAS u32x4*)(Vl + (idx >> 3) * AV_STR + (idx & 7) * 16) = vpre[i]; } }
        if (tid < 480) { const int rr = tid >> 5, dd = tid & 31; tab[tid] = dd < 31 ? (rpb[h * 465 + rr * 31 + dd] - mb) * LOG2E : -1e30f; }
        const bf16_t* kbase = qkv + 1024 + h * 64 + 8 * hi;
        const int klat0 = b * 4096 + l31, kctx0 = NLAT + b * 256 + l31;
        const int ntw = ntiles >> 2, t0 = kq * ntw;
        __syncthreads();
        f32x16 O0, O1;
#pragma unroll
        for (int i = 0; i < 16; ++i) { O0[i] = 0.f; O1[i] = 0.f; }
        float lsum = 0.f;
#pragma unroll 1
        for (int t = 0; t < ntw; t += 2) {
            { const int kt = t0 + t; const int mode = kt >= ntl ? 0 : ((kt & 1) == qt ? 1 : 2 + qt);
              attn_one_tile(KA, Qf, Vl + (kt * 32 + 4 * hi + tr_q) * AV_STR + (16 * dgrp + 4 * tr_p) * 2, (const LAS unsigned char*)tab + (rs + (kt >> 1) - r + 7) * 128, offo, offx, O0, O1, lsum, mode, mbl); }
            __builtin_amdgcn_sched_barrier(0);
            attn_load_k(KA, kbase, klat0, kctx0, t0 + min(t + 2, ntw - 2), ntl, rs);
            { const int kt = t0 + t + 1; const int mode = kt >= ntl ? 0 : ((kt & 1) == qt ? 1 : 2 + qt);
              attn_one_tile(KB, Qf, Vl + (kt * 32 + 4 * hi + tr_q) * AV_STR + (16 * dgrp + 4 * tr_p) * 2, (const LAS unsigned char*)tab + (rs + (kt >> 1) - r + 7) * 128, offo, offx, O0, O1, lsum, mode, mbl); }
            __builtin_amdgcn_sched_barrier(0);
            attn_load_k(KB, kbase, klat0, kctx0, t0 + min(t + 2, ntw - 2) + 1, ntl, rs);
        }
        const int un = u + T_.gsz;
        const AUnit nxt = attn_decode(min(un, total - 1), nlatu);
        int tidm = tid; asm volatile("" : "+v"(tidm));
        if (un < total) attn_load_v(vpre, qkv, nxt, tidm);
        __syncthreads();
#pragma unroll
        for (int j = 0; j < 4; ++j) {
            *(LAS f32x4*)(Ored + (size_t)((kq * 64 + 32 * qt + l31) * 68 + 8 * j + 4 * hi)) = (f32x4){O0[4 * j], O0[4 * j + 1], O0[4 * j + 2], O0[4 * j + 3]};
            *(LAS f32x4*)(Ored + (size_t)((kq * 64 + 32 * qt + l31) * 68 + 32 + 8 * j + 4 * hi)) = (f32x4){O1[4 * j], O1[4 * j + 1], O1[4 * j + 2], O1[4 * j + 3]}; }
        lred[(kq * 2 + hi) * 64 + 32 * qt + l31] = lsum;
        if (un < total) {
            const bf16_t* qp = qkv + (size_t)(nxt.qrow0 + 32 * qt + l31) * 3072 + nxt.h * 64 + 8 * hi;
#pragma unroll
            for (int ks = 0; ks < 4; ++ks) Qf[ks] = *(const s16x8*)(qp + 16 * ks);
            const int t0n = kq * (nxt.ntiles >> 2);
            attn_load_k(KA, qkv + 1024 + nxt.h * 64 + 8 * hi, nxt.b * 4096 + l31, NLAT + nxt.b * 256 + l31, t0n, nxt.ntl, nxt.rs);
            attn_load_k(KB, qkv + 1024 + nxt.h * 64 + 8 * hi, nxt.b * 4096 + l31, NLAT + nxt.b * 256 + l31, t0n + 1, nxt.ntl, nxt.rs);
        }
        __syncthreads();
        { const int q = tid >> 3, d8 = (tid & 7) * 8;
          f32x4 s0 = (f32x4){0.f, 0.f, 0.f, 0.f}, s1 = s0; float l = 0.f;
#pragma unroll
          for (int k = 0; k < 4; ++k) { s0 += *(const LAS f32x4*)(Ored + (k * 64 + q) * 68 + d8); s1 += *(const LAS f32x4*)(Ored + (k * 64 + q) * 68 + d8 + 4); l += lred[(k * 2) * 64 + q] + lred[(k * 2 + 1) * 64 + q]; }
          const float inv = 1.0f / l;
          u32x4 o; o.x = pkb(s0.x * inv, s0.y * inv); o.y = pkb(s0.z * inv, s0.w * inv); o.z = pkb(s1.x * inv, s1.y * inv); o.w = pkb(s1.z * inv, s1.w * inv);
          *(u32x4*)(ao + (size_t)(qrow0 + q) * 1024 + h * 64 + d8) = o; }
        __syncthreads();
        u = un; cur = nxt;
    }
}

constexpr int SP_RS = 320;
__device__ __forceinline__ void phase_spatial_mfma(const Params& p, int sl, int M, LAS unsigned char* lds, const Tix T_) {
    bf16_t* vb = (bf16_t*)(p.ws + OFF_BIG); const float* lnacc = (const float*)(p.ws + OFF_LNACC) + (size_t)sl * MTOT * 2;
    const float* lng = p.sg_ln_g + sl * 3072; const float* lnb = p.sg_ln_b + sl * 3072;
    const int tid = T_.tid, lane = tid & 63, wave = __builtin_amdgcn_readfirstlane(tid >> 6), pt = wave & 3, cth = wave >> 2, l31 = lane & 31, hi = lane >> 5;
    const int tr_q = (lane & 15) >> 2, tr_p = lane & 3, dgrp = (lane >> 4) & 1;
    const int nunits = (M / 128) * 24;
    for (int u = T_.bid; u < nunits; u += T_.gsz) {
        const int nc = u / 24, g = u % 24, r0 = nc * 128;
#pragma unroll
        for (int i = 0; i < 4; ++i) { const int idx = tid + NTHREADS * i, q = idx >> 4, c8 = (idx & 15) * 8;
            const u32x4 w = *(const u32x4*)(vb + (size_t)(r0 + q) * 3072 + g * 128 + c8);
            const float mean = lnacc[2 * (r0 + q)] * (1.0f / 3072.0f), rstd = 1.0f / sqrtf(fmaxf(lnacc[2 * (r0 + q) + 1] * (1.0f / 3072.0f) - mean * mean, 0.f) + 1e-6f);
            const f32x4 g0 = *(const f32x4*)(lng + g * 128 + c8), g1 = *(const f32x4*)(lng + g * 128 + c8 + 4), b0 = *(const f32x4*)(lnb + g * 128 + c8), b1 = *(const f32x4*)(lnb + g * 128 + c8 + 4);
            u32x4 o;
            o.x = pkb((bf2f(w.x & 0xffffu) - mean) * rstd * g0.x + b0.x, (bf2f(w.x >> 16) - mean) * rstd * g0.y + b0.y);
            o.y = pkb((bf2f(w.y & 0xffffu) - mean) * rstd * g0.z + b0.z, (bf2f(w.y >> 16) - mean) * rstd * g0.w + b0.w);
            o.z = pkb((bf2f(w.z & 0xffffu) - mean) * rstd * g1.x + b1.x, (bf2f(w.z >> 16) - mean) * rstd * g1.y + b1.y);
            o.w = pkb((bf2f(w.w & 0xffffu) - mean) * rstd * g1.z + b1.z, (bf2f(w.w >> 16) - mean) * rstd * g1.w + b1.w);
            *(LAS u32x4*)(lds + q * SP_RS + c8 * 2) = o; }
        const float* wp = p.sg_w_s + ((size_t)sl * 24 + g) * 16384 + (32 * pt + l31) * 128 + 8 * hi;
        s16x8 Wf[8];
#pragma unroll
        for (int ks = 0; ks < 8; ++ks) { const f32x4 x = *(const f32x4*)(wp + 16 * ks), y = *(const f32x4*)(wp + 16 * ks + 4); Wf[ks] = pack8(x.x, x.y, x.z, x.w, y.x, y.y, y.z, y.w); }
        const float bs = p.sg_b_s[((size_t)sl * 24 + g) * 128 + 32 * pt + l31];
        __syncthreads();
#pragma unroll
        for (int cc = 0; cc < 2; ++cc) { const int ct = 2 * cth + cc;
            f32x16 acc;
#pragma unroll
            for (int i = 0; i < 16; ++i) acc[i] = 0.f;
            const LAS unsigned char* ab = lds + (8 * hi + tr_q) * SP_RS + (32 * ct + 16 * dgrp + 4 * tr_p) * 2;
#pragma unroll
            for (int ks = 0; ks < 8; ++ks) { const s16x8 Af = tr_pair(ab + 16 * ks * SP_RS, 4 * SP_RS); acc = MFMA32(Af, Wf[ks], acc); }
            bf16_t* orow = vb + (size_t)(r0 + 32 * pt + l31) * 3072 + g * 128 + 32 * ct + 4 * hi;
#pragma unroll
            for (int j = 0; j < 4; ++j) { u32x2 o; o.x = pkb(acc[4 * j] + bs, acc[4 * j + 1] + bs); o.y = pkb(acc[4 * j + 2] + bs, acc[4 * j + 3] + bs); *(u32x2*)(orow + 8 * j) = o; }
        }
        __syncthreads();
    }
}

template <class F> struct EpiG {
    static constexpr bool PERM = false, AFTER_DRAIN = false;
    F f;
    __device__ __forceinline__ void operator()(const f32x4 (&acc)[2][2][4][2], const Unit& u, int wr, int wc, int fr, int fq) const {
        F g = f; const int colb = u.pn * 256 + 64 * wc + 8 * fq;
        g.begin(u, colb, fq);
#pragma unroll
        for (int ai = 0; ai < 2; ++ai)
#pragma unroll
            for (int m = 0; m < 4; ++m) { const int row = u.pm * 256 + ai * 128 + wr * 64 + m * 16 + fr;
                g.row(row, colb, acc[ai][0][m][0], acc[ai][0][m][1], acc[ai][1][m][0], acc[ai][1][m][1]);
                asm volatile("" ::: "memory"); }
    }
};
__device__ __forceinline__ void store8_bf16(bf16_t* o, const f32x4 a, const f32x4 b) { u32x4 w; w.x = pk2(a.x, a.y); w.y = pk2(a.z, a.w); w.z = pk2(b.x, b.y); w.w = pk2(b.z, b.w); *(u32x4*)o = w; }
__device__ __forceinline__ float sumsq4(const f32x4 x) { return (x.x * x.x + x.y * x.y) + (x.z * x.z + x.w * x.w); }
__device__ __forceinline__ float sum4(const f32x4 x) { return (x.x + x.y) + (x.z + x.w); }
__device__ __forceinline__ float rstd_of(const float* ssq, int row) { return 1.0f / sqrtf(ssq[row] * (1.0f / 1024.0f) + 1e-6f); }
__device__ __forceinline__ void atomic_addf(float* p, float v) { __hip_atomic_fetch_add(p, v, __ATOMIC_RELAXED, __HIP_MEMORY_SCOPE_AGENT); }

struct FQKV { bf16_t* O; const float* qg; const float* kg; const float* ssq; const float* bias;
    f32x4 gn[4], bz[4]; int sect;
    __device__ __forceinline__ void begin(const Unit& u, int colb, int fq) {
        sect = u.pn >> 2; const int b = min(u.pm >> 4, 8); const float* bp = bias + (size_t)b * 3072 + colb;
        bz[0] = *(const f32x4*)bp; bz[1] = *(const f32x4*)(bp + 4); bz[2] = *(const f32x4*)(bp + 32); bz[3] = *(const f32x4*)(bp + 36);
        if (sect < 2) { const float* gp = (sect == 0 ? qg : kg) + 8 * fq; const float mul = sect == 0 ? 0.125f * 1.4426950408889634f : 1.0f;
            gn[0] = *(const f32x4*)gp * mul; gn[1] = *(const f32x4*)(gp + 4) * mul; gn[2] = *(const f32x4*)(gp + 32) * mul; gn[3] = *(const f32x4*)(gp + 36) * mul; } }
    __device__ __forceinline__ void row(int row, int colb, f32x4 a0, f32x4 b0, f32x4 a1, f32x4 b1) {
        const float rs = rstd_of(ssq, row);
        a0 = a0 * rs + bz[0]; b0 = b0 * rs + bz[1]; a1 = a1 * rs + bz[2]; b1 = b1 * rs + bz[3];
        if (sect < 2) { float ss = (sumsq4(a0) + sumsq4(b0)) + (sumsq4(a1) + sumsq4(b1));
            ss += __shfl_xor(ss, 16); ss += __shfl_xor(ss, 32);
            const float r2 = 1.0f / sqrtf(ss * (1.0f / 64.0f) + 1e-6f);
            a0 = a0 * r2 * gn[0]; b0 = b0 * r2 * gn[1]; a1 = a1 * r2 * gn[2]; b1 = b1 * r2 * gn[3]; }
        bf16_t* op = O + (size_t)row * 3072 + colb; store8_bf16(op, a0, b0); store8_bf16(op + 32, a1, b1); } };
struct FSqrelu { bf16_t* O; const float* ssq; const float* bias;
    f32x4 bz[4];
    __device__ __forceinline__ void begin(const Unit& u, int colb, int fq) { const int b = min(u.pm >> 4, 8); const float* bp = bias + (size_t)b * 4096 + colb;
        bz[0] = *(const f32x4*)bp; bz[1] = *(const f32x4*)(bp + 4); bz[2] = *(const f32x4*)(bp + 32); bz[3] = *(const f32x4*)(bp + 36); }
    __device__ __forceinline__ void row(int row, int colb, f32x4 a0, f32x4 b0, f32x4 a1, f32x4 b1) {
        const float rs = rstd_of(ssq, row); const f32x4 z = (f32x4){0.f, 0.f, 0.f, 0.f};
        a0 = __builtin_elementwise_max(a0 * rs + bz[0], z); b0 = __builtin_elementwise_max(b0 * rs + bz[1], z); a1 = __builtin_elementwise_max(a1 * rs + bz[2], z); b1 = __builtin_elementwise_max(b1 * rs + bz[3], z);
        bf16_t* op = O + (size_t)row * 4096 + colb; store8_bf16(op, a0 * a0, b0 * b0); store8_bf16(op + 32, a1 * a1, b1 * b1); } };
struct FGeluV { bf16_t* O; const float* ssq; const float* bias; float* lnacc;
    f32x4 bz[4]; int fq_;
    __device__ __forceinline__ void begin(const Unit& u, int colb, int fq) { const int b = min(u.pm >> 4, 8); const float* bp = bias + (size_t)b * 6144 + colb; fq_ = fq;
        bz[0] = *(const f32x4*)bp; bz[1] = *(const f32x4*)(bp + 4); bz[2] = *(const f32x4*)(bp + 32); bz[3] = *(const f32x4*)(bp + 36); }
    __device__ __forceinline__ void row(int row, int colb, f32x4 a0, f32x4 b0, f32x4 a1, f32x4 b1) {
        const float rs = rstd_of(ssq, row);
        a0 = gelu4(a0 * rs + bz[0]); b0 = gelu4(b0 * rs + bz[1]); a1 = gelu4(a1 * rs + bz[2]); b1 = gelu4(b1 * rs + bz[3]);
        bf16_t* op = O + (size_t)row * 3072 + colb; store8_bf16(op, a0, b0); store8_bf16(op + 32, a1, b1);
        float s1 = (sum4(a0) + sum4(b0)) + (sum4(a1) + sum4(b1)), s2 = (sumsq4(a0) + sumsq4(b0)) + (sumsq4(a1) + sumsq4(b1));
        s1 += __shfl_xor(s1, 16); s1 += __shfl_xor(s1, 32); s2 += __shfl_xor(s2, 16); s2 += __shfl_xor(s2, 32);
        if (fq_ == 0) { atomic_addf(lnacc + 2 * (size_t)row, s1); atomic_addf(lnacc + 2 * (size_t)row + 1, s2); } } };
struct FGeluU { bf16_t* O; const float* ssq; const float* bias;
    f32x4 bz[4];
    __device__ __forceinline__ void begin(const Unit& u, int colb, int fq) { const int b = min(u.pm >> 4, 8); const float* bp = bias + (size_t)b * 6144 + colb;
        bz[0] = *(const f32x4*)bp; bz[1] = *(const f32x4*)(bp + 4); bz[2] = *(const f32x4*)(bp + 32); bz[3] = *(const f32x4*)(bp + 36); }
    __device__ __forceinline__ static f32x4 lo4(const u32x4 s) { return (f32x4){bf2f(s.x & 0xffffu), bf2f(s.x >> 16), bf2f(s.y & 0xffffu), bf2f(s.y >> 16)}; }
    __device__ __forceinline__ static f32x4 hi4(const u32x4 s) { return (f32x4){bf2f(s.z & 0xffffu), bf2f(s.z >> 16), bf2f(s.w & 0xffffu), bf2f(s.w >> 16)}; }
    __device__ __forceinline__ void row(int row, int colb, f32x4 a0, f32x4 b0, f32x4 a1, f32x4 b1) {
        const float rs = rstd_of(ssq, row);
        bf16_t* op = O + (size_t)row * 3072 + colb; const u32x4 sv0 = *(const u32x4*)op, sv1 = *(const u32x4*)(op + 32);
        a0 = gelu4(a0 * rs + bz[0]) * lo4(sv0); b0 = gelu4(b0 * rs + bz[1]) * hi4(sv0); a1 = gelu4(a1 * rs + bz[2]) * lo4(sv1); b1 = gelu4(b1 * rs + bz[3]) * hi4(sv1);
        store8_bf16(op, a0, b0); store8_bf16(op + 32, a1, b1); } };
struct FResid { const float* inl; const float* inc; float* outl; float* outc; const float* gate;
    const float* gsn; bf16_t* xb; float* ssqn;
    f32x4 gz[4], gsz[4]; int fq_;
    __device__ __forceinline__ void begin(const Unit& u, int colb, int fq) { const int b = min(u.pm >> 4, 8); fq_ = fq; const float* gp = gate + (size_t)b * 6144 + colb;
        gz[0] = *(const f32x4*)gp; gz[1] = *(const f32x4*)(gp + 4); gz[2] = *(const f32x4*)(gp + 32); gz[3] = *(const f32x4*)(gp + 36);
        if (gsn) { const float* sp = gsn + (size_t)b * 1024 + colb; gsz[0] = *(const f32x4*)sp; gsz[1] = *(const f32x4*)(sp + 4); gsz[2] = *(const f32x4*)(sp + 32); gsz[3] = *(const f32x4*)(sp + 36); } }
    __device__ __forceinline__ void row(int row, int colb, f32x4 a0, f32x4 b0, f32x4 a1, f32x4 b1) {
        const bool lat = row < NLAT;
        const float* ip = lat ? inl + (size_t)row * 1024 + colb : inc + (size_t)(row - NLAT) * 1024 + colb;
        float* op = lat ? outl + (size_t)row * 1024 + colb : outc + (size_t)(row - NLAT) * 1024 + colb;
        a0 = *(const f32x4*)ip + gz[0] * a0; b0 = *(const f32x4*)(ip + 4) + gz[1] * b0; a1 = *(const f32x4*)(ip + 32) + gz[2] * a1; b1 = *(const f32x4*)(ip + 36) + gz[3] * b1;
        *(f32x4*)op = a0; *(f32x4*)(op + 4) = b0; *(f32x4*)(op + 32) = a1; *(f32x4*)(op + 36) = b1;
        if (gsn) { float ss = (sumsq4(a0) + sumsq4(b0)) + (sumsq4(a1) + sumsq4(b1));
            ss += __shfl_xor(ss, 16); ss += __shfl_xor(ss, 32);
            if (fq_ == 0) atomic_addf(ssqn + row, ss);
            bf16_t* xp = xb + (size_t)row * 1024 + colb; store8_bf16(xp, a0 * gsz[0], b0 * gsz[1]); store8_bf16(xp + 32, a1 * gsz[2], b1 * gsz[3]); } } };

template <class F> __device__ __forceinline__ void run_gemm(LAS unsigned char* lds, const bf16_t* A, const bf16_t* Bt, int M, int N, int K, const F& f, const Tix T_) {
    pg8::StaticOrder S; S.init(M, N, T_.gsz, T_.bid);
    pg8::Gemm g; g.A = A; g.Bt = Bt; g.M = M; g.N = N; g.K = K;
    EpiG<F> E; E.f = f;
    pg8::gemm_phase<EpiG<F>, pg8::StaticOrder, true, true>(lds, g, S, E, T_.tid);
}

enum { OP_QKV, OP_ATTN, OP_MIXOUT, OP_MLP1, OP_MLP2, OP_VGEMM, OP_SPATIAL, OP_UGEMM, OP_PROLOGUE, OP_PHASE0B };

__device__ __forceinline__ void decode_phase(int ph, int& L, int& op) {
    L = 0; op = ph == 0 ? OP_PROLOGUE : OP_PHASE0B;
    if (ph > 1) {
        int q = ph - 2;
        if (q < 5) { L = 0; } else if (q < 11) { L = 1; q -= 5; } else if (q < 16) { L = 2; q -= 11; } else { L = 3; q -= 16; }
        if ((L & 1) == 0) op = q == 0 ? OP_QKV : q == 1 ? OP_ATTN : q == 2 ? OP_MIXOUT : q == 3 ? OP_MLP1 : OP_MLP2;
        else op = q == 0 ? OP_VGEMM : q == 1 ? OP_SPATIAL : q == 2 ? OP_UGEMM : q == 3 ? OP_MIXOUT : q == 4 ? OP_MLP1 : OP_MLP2;
    }
}

__device__ __forceinline__ void run_phase(const Params& p, int ph, LAS unsigned char* lds, const Tix T_) {
    int L, op; decode_phase(ph, L, op);
#ifdef ONLY_OP
    op = ONLY_OP;
#endif
    const int mi = L >> 1;
    const bool attnL = (L & 1) == 0;
    const int Mfull = L < 2 ? MTOT : NLAT;
    const float* modsl = (const float*)(p.ws + OFF_MODS) + (size_t)L * 9 * 6144;
    float* ctxr = (float*)(p.ws + OFF_CTXR);
    bf16_t* hb = (bf16_t*)(p.ws + OFF_HB); bf16_t* big = (bf16_t*)(p.ws + OFF_BIG);
    float* ssq = (float*)(p.ws + OFF_SSQ); const float* gs = (const float*)(p.ws + OFF_GS);
    const bool first = (L == 0);
    switch (op) {
    case OP_PROLOGUE: phase_zero(p, T_); phase_mods(p, lds, T_); __syncthreads(); phase_convert(p, lds, T_); break;
    case OP_PHASE0B: phase_0b(p, lds, T_); break;
    case OP_QKV: { FQKV f; f.O = big; f.qg = p.na_q_norm + mi * 64; f.kg = p.na_k_norm + mi * 64; f.ssq = ssq + (size_t)(2 * L) * MTOT; f.bias = (const float*)(p.ws + OFF_BQKV) + (size_t)mi * 9 * 3072;
        run_gemm(lds, hb, (const bf16_t*)(p.ws + OFF_QKVT) + (size_t)mi * 3072 * 1024, MTOT, 3072, 1024, f, T_); } break;
    case OP_ATTN: phase_attn_mfma(p, mi, L == 0, lds, T_); break;
    case OP_MIXOUT: case OP_MLP2: {
        FResid f; const bool mo = (op == OP_MIXOUT);
        f.inl = (first && mo) ? p.x : p.out; f.inc = (first && mo) ? p.ctx : ctxr; f.outl = p.out; f.outc = ctxr; f.gate = modsl + (mo ? 2048 : 5120);
        const int nn = mo ? 2 * L + 1 : 2 * L + 2;
        const bool has_next = nn < 8 && !(nn == 6 + 0 && false);
        f.gsn = has_next ? gs + (size_t)nn * 9 * 1024 : nullptr; f.xb = hb; f.ssqn = ssq + (size_t)(has_next ? nn : 0) * MTOT;
        const bf16_t* A; const bf16_t* Bt; int K;
        if (!mo) { A = big; Bt = (const bf16_t*)(p.ws + OFF_W2T) + (size_t)L * 1024 * 4096; K = 4096; }
        else if (attnL) { A = big + (size_t)MTOT * 3072; Bt = (const bf16_t*)(p.ws + OFF_WOT) + (size_t)mi * 1024 * 1024; K = 1024; }
        else { A = big; Bt = (const bf16_t*)(p.ws + OFF_SGOT) + (size_t)mi * 1024 * 3072; K = 3072; }
        run_gemm(lds, A, Bt, Mfull, 1024, K, f, T_); } break;
    case OP_MLP1: { FSqrelu f; f.O = big; f.ssq = ssq + (size_t)(2 * L + 1) * MTOT; f.bias = (const float*)(p.ws + OFF_BMLP) + (size_t)L * 9 * 4096;
        run_gemm(lds, hb, (const bf16_t*)(p.ws + OFF_W1T) + (size_t)L * 4096 * 1024, Mfull, 4096, 1024, f, T_); } break;
    case OP_VGEMM: { FGeluV f; f.O = big; f.ssq = ssq + (size_t)(2 * L) * MTOT; f.bias = (const float*)(p.ws + OFF_BWIN) + (size_t)mi * 9 * 6144 + 3072; f.lnacc = (float*)(p.ws + OFF_LNACC) + (size_t)mi * MTOT * 2;
        run_gemm(lds, hb, (const bf16_t*)(p.ws + OFF_WINT) + (size_t)mi * 6144 * 1024 + (size_t)3072 * 1024, Mfull, 3072, 1024, f, T_); } break;
    case OP_SPATIAL: phase_spatial_mfma(p, mi, Mfull, lds, T_); break;
    case OP_UGEMM: { FGeluU f; f.O = big; f.ssq = ssq + (size_t)(2 * L) * MTOT; f.bias = (const float*)(p.ws + OFF_BWIN) + (size_t)mi * 9 * 6144;
        run_gemm(lds, hb, (const bf16_t*)(p.ws + OFF_WINT) + (size_t)mi * 6144 * 1024, Mfull, 3072, 1024, f, T_); } break;
    default: break;
    }
}

#ifndef ONE_LAUNCH
#define ONE_LAUNCH 1
#endif
__global__ void __launch_bounds__(NTHREADS) mk(Params p0) {
    extern __shared__ __attribute__((aligned(16))) unsigned char lds_raw[];
    LAS unsigned char* lds = (LAS unsigned char*)lds_raw;
#if ONE_LAUNCH
    cg::grid_group grid = cg::this_grid();
    if (p0.ph_lo < 0) grid.sync();
    volatile LAS unsigned* st = (volatile LAS unsigned*)(lds + 131072);
    if (threadIdx.x == 0) { st[0] = 0u; st[1] = 0u; }
    __syncthreads();
    const XcdBarrier xbar = xcd_barrier_post((unsigned*)(p0.ws + OFF_BAR), st);
    bool first_it = true, repeated = false;
    for (int ph = p0.ph_lo; ph < p0.ph_hi; ) {
        if (!first_it) xcd_barrier(xbar);
        first_it = false;
        Tix T_; T_.tid = threadIdx.x; T_.bid = blockIdx.x; T_.gsz = gridDim.x;
        size_t z = 0;
        asm volatile("" : "+v"(T_.tid)); asm volatile("" : "+s"(T_.bid), "+s"(T_.gsz), "+s"(z));
        Params p = p0;
        { const float** pp = (const float**)&p;
#pragma unroll
          for (int i = 0; i < 22; ++i) pp[i] += z; }
        p.out += z; p.ws += z;
        run_phase(p, ph, lds, T_);
        __syncthreads();
        if (REP_MASK != 0) { int L_, op_; decode_phase(ph, L_, op_); if (((REP_MASK >> op_) & 1) && !repeated) { repeated = true; continue; } }
        repeated = false; ++ph;
    }
#else
    Tix T_; T_.tid = threadIdx.x; T_.bid = blockIdx.x; T_.gsz = gridDim.x;
    run_phase(p0, p0.ph_lo, lds, T_);
#endif
}

extern "C" void kernel_launch(void* const* d_in, const int* in_sizes, int n_in, void* d_out, int out_size, void* d_ws, size_t ws_size, hipStream_t stream) {
    static int grid = 0;
    if (grid == 0) {
        if (n_in != 22 || ws_size < WS_END) { fprintf(stderr, "kernel_launch: unexpected n_in %d or ws_size %zu (< %zu)\n", n_in, ws_size, (size_t)WS_END); grid = -1; return; }
        int dev = 0, cus = 0, per_cu = 0;
        hipGetDevice(&dev); hipDeviceGetAttribute(&cus, hipDeviceAttributeMultiprocessorCount, dev);
        if (hipFuncSetAttribute((const void*)mk, hipFuncAttributeMaxDynamicSharedMemorySize, LDS_BYTES) != hipSuccess) { fprintf(stderr, "kernel_launch: hipFuncSetAttribute failed\n"); grid = -1; return; }
        if (hipOccupancyMaxActiveBlocksPerMultiprocessor(&per_cu, (const void*)mk, NTHREADS, LDS_BYTES) != hipSuccess || per_cu < 1) { fprintf(stderr, "kernel_launch: occupancy query says %d\n", per_cu); per_cu = 1; }
        (void)hipGetLastError();
        grid = cus;
    }
    if (grid < 0) return;
    if (hipMemsetAsync((unsigned char*)d_ws + OFF_BAR, 0, 16384, stream) != hipSuccess) { fprintf(stderr, "kernel_launch: memset of the barrier words failed\n"); return; }
    Params p{};
    const float** pp = (const float**)&p;
    for (int i = 0; i < 22; ++i) pp[i] = (const float*)d_in[i];
    p.out = (float*)d_out; p.ws = (unsigned char*)d_ws;
#if ONE_LAUNCH
    p.ph_lo = 0; p.ph_hi = NPH;
    void* args[] = {&p};
    hipError_t e = hipLaunchCooperativeKernel((void*)mk, dim3(grid), dim3(NTHREADS), args, LDS_BYTES, stream);
    if (e != hipSuccess) fprintf(stderr, "cooperative launch failed: %s (grid %d)\n", hipGetErrorString(e), grid);
#else
    for (int ph = 0; ph < NPH; ++ph) { p.ph_lo = ph; p.ph_hi = ph + 1; hipLaunchKernelGGL(mk, dim3(grid), dim3(NTHREADS), LDS_BYTES, stream, p); }
#endif
}
```

```cpp
#include <hip/hip_runtime.h>
#include <hip/hip_cooperative_groups.h>
#include <cstdio>
#include <cstdint>
namespace cg = cooperative_groups;
namespace pg8 {
#define PG8_LAS __attribute__((address_space(3)))
typedef unsigned short bf16_t;
typedef short bf16x8 __attribute__((ext_vector_type(8)));
typedef float f32x4 __attribute__((ext_vector_type(4)));
typedef unsigned u32x4 __attribute__((ext_vector_type(4)));
constexpr int BM = 256, BK = 64, HALF = 128, HTB = HALF * BK * 2  , STAGE_BYTES = 8 * HTB, NXCD = 8, WGM = 8;

__host__ __device__ __forceinline__ int lds_byte(int r, int c) { const int st = (r >> 4) * 2 + (c >> 5), rr = r & 15, cc = c & 31, ob = rr * 64 + cc * 2; return st * 1024 + (ob ^ (((ob >> 9) & 1) << 5)); }
__host__ __device__ __forceinline__ void stage_rc(int b, int& R, int& C) { const int st = b / 1024, sb = b % 1024, swz = sb ^ (((sb >> 9) & 1) << 5); R = (st >> 1) * 16 + swz / 64; C = (st & 1) * 32 + (swz % 64) / 2; }
__host__ __device__ __forceinline__ int perm32(int rho) { const int n = rho >> 4, i = rho & 15; return 8 * (i >> 2) + 4 * n + (i & 3); }

struct Unit { int pm, pn; };
struct Gemm { const bf16_t* A; const bf16_t* Bt; int M, N, K; };

struct StaticOrder {
    int nM, nN, nwg, G, c;
    __host__ __device__ void init(int M, int N, int G_, int c_) { nM = M / BM; nN = N / BM; nwg = nM * nN; G = G_; c = c_; }
    __host__ __device__ bool next(int i, Unit& u) const {
        const long L = (long)i * G + c; if (L >= nwg) return false;
        int wgid = (int)L; { const int q = nwg / NXCD, r = nwg % NXCD, xcd = wgid % NXCD, off = wgid / NXCD; wgid = (xcd < r ? xcd * (q + 1) : r * (q + 1) + (xcd - r) * q) + off; }
        const int nig = WGM * nN, gid = wgid / nig, fm = gid * WGM, gsz = (nM - fm) < WGM ? (nM - fm) : WGM;
        u.pm = fm + ((wgid % nig) % gsz); u.pn = (wgid % nig) / gsz; return true;
    }
    __device__ __forceinline__ void a_ready(const Unit&) const {}
    __device__ __forceinline__ void done(const Unit&) const {}
};

__device__ __forceinline__ unsigned cvt_pk_bf16(float lo, float hi) { unsigned r; asm volatile("v_cvt_pk_bf16_f32 %0, %1, %2" : "=v"(r) : "v"(lo), "v"(hi)); return r; }
template <class Epi, class Sched, bool ALIGN_EPI = false, bool SP2 = false>
__device__ __forceinline__ void gemm_phase(PG8_LAS unsigned char* lds, const Gemm g, const Sched& S, const Epi& E, const int tid_in) {
    const int tid = tid_in, wid = __builtin_amdgcn_readfirstlane(tid >> 6), lane = tid & 63, wr = wid >> 2, wc = wid & 3, fr = lane & 15, fq = lane >> 4;
    const int K = g.K, nt = K / BK;
    unsigned voffA[2], voffB[2];
#pragma unroll
    for (int i = 0; i < 2; ++i) { int R, C; stage_rc(tid * 16 + i * 8192, R, C); const int Rb = Epi::PERM ? ((R & ~31) + perm32(R & 31)) : R;
        voffA[i] = (unsigned)(R * K + C) * 2u; voffB[i] = (unsigned)(Rb * K + C) * 2u; }
    const size_t kstep = (size_t)(BK * 2);
    const size_t hstep = (size_t)HALF * K * 2;
    const size_t tstep = 2 * hstep;
    const unsigned ldsw = (unsigned)wid * 1024u;
    const int aoff = lds_byte(wr * 64 + fr, fq * 8), boff = lds_byte(wc * 32 + fr, fq * 8);
#define PG8_SA(b, h) (((b) * 2 + (h)) * HTB)
#define PG8_SB(b, h) ((4 + (b) * 2 + (h)) * HTB)
#define PG8_STAGE(bufoff, gbase, voff) do { _Pragma("unroll") for (int _i = 0; _i < 2; ++_i) \
        __builtin_amdgcn_global_load_lds((const unsigned*)((const char*)(gbase) + (voff)[_i]), (PG8_LAS unsigned*)(lds + (bufoff) + ldsw + _i * 8192), 16, 0, 0); } while (0)
#define PG8_LDA(dst, b, h) do { _Pragma("unroll") for (int m = 0; m < 4; ++m) _Pragma("unroll") for (int k = 0; k < 2; ++k) dst[m][k] = *(const PG8_LAS bf16x8*)(lds + PG8_SA(b, h) + aoff + m * 2048 + k * 1024); } while (0)
#define PG8_LDB(dst, b, h) do { _Pragma("unroll") for (int n = 0; n < 2; ++n) _Pragma("unroll") for (int k = 0; k < 2; ++k) dst[n][k] = *(const PG8_LAS bf16x8*)(lds + PG8_SB(b, h) + boff + n * 2048 + k * 1024); } while (0)
#define PG8_MMA(ai, bj, At, Bt) do { __builtin_amdgcn_s_setprio(1); _Pragma("unroll") for (int m = 0; m < 4; ++m) _Pragma("unroll") for (int n = 0; n < 2; ++n) _Pragma("unroll") for (int k = 0; k < 2; ++k) \
        acc[ai][bj][m][n] = __builtin_amdgcn_mfma_f32_16x16x32_bf16(Bt[n][k], At[m][k], acc[ai][bj][m][n], 0, 0, 0); __builtin_amdgcn_s_setprio(0); } while (0)
#define PG8_WAIT_V(n) asm volatile("s_waitcnt vmcnt(" #n ")" ::: "memory")
#define PG8_WAIT_L(n) asm volatile("s_waitcnt lgkmcnt(" #n ")" ::: "memory")
#define PG8_BAR __builtin_amdgcn_s_barrier()
#define PG8_SCHED __builtin_amdgcn_sched_barrier(0)
    Unit cur, nxt; int ui = 0;
    if (!S.next(0, cur)) return;
    f32x4 acc[2][2][4][2];
#pragma unroll
    for (int a = 0; a < 2; ++a)
#pragma unroll
        for (int b = 0; b < 2; ++b)
#pragma unroll
            for (int m = 0; m < 4; ++m)
#pragma unroll
                for (int n = 0; n < 2; ++n) acc[a][b][m][n] = (f32x4){0.f, 0.f, 0.f, 0.f};
    bf16x8 At[4][2], B0[2][2], B1[2][2];
    const char* cA = (const char*)g.A + (size_t)cur.pm * tstep; const char* cB = (const char*)g.Bt + (size_t)cur.pn * tstep;
    S.a_ready(cur);
    if constexpr (SP2) {
        PG8_STAGE(PG8_SB(0, 0), cB, voffB); PG8_STAGE(PG8_SB(0, 1), cB + hstep, voffB); PG8_STAGE(PG8_SA(0, 0), cA, voffA); PG8_STAGE(PG8_SA(0, 1), cA + hstep, voffA);
        if (wr == 1) PG8_BAR;
        PG8_WAIT_V(2); PG8_BAR;
        PG8_STAGE(PG8_SB(1, 0), cB + kstep, voffB); PG8_STAGE(PG8_SA(1, 0), cA + kstep, voffA); PG8_STAGE(PG8_SB(1, 1), cB + hstep + kstep, voffB);
        PG8_WAIT_V(6); PG8_BAR;
    } else {
        PG8_STAGE(PG8_SB(0, 0), cB, voffB); PG8_STAGE(PG8_SA(0, 0), cA, voffA); PG8_STAGE(PG8_SB(0, 1), cB + hstep, voffB); PG8_STAGE(PG8_SA(0, 1), cA + hstep, voffA);
        if (wr == 1) PG8_BAR;
        PG8_WAIT_V(4); PG8_BAR;
        PG8_STAGE(PG8_SB(1, 0), cB + kstep, voffB); PG8_STAGE(PG8_SA(1, 0), cA + kstep, voffA); PG8_STAGE(PG8_SB(1, 1), cB + hstep + kstep, voffB);
        PG8_WAIT_V(6); PG8_BAR;
    }
    for (;;) {
        const bool has_next = S.next(ui + 1, nxt);
        const char* nA = has_next ? (const char*)g.A + (size_t)nxt.pm * tstep : cA; const char* nB = has_next ? (const char*)g.Bt + (size_t)nxt.pn * tstep : cB;
        for (int t = 0; t < nt; t += 2) {
            const bool last = (t == nt - 2);
            const char* a1 = cA + (size_t)(t + 1) * kstep;
            const char* a2 = last ? nA : cA + (size_t)(t + 2) * kstep; const char* b2 = last ? nB : cB + (size_t)(t + 2) * kstep;
            const char* a3 = a2 + kstep; const char* b3 = b2 + kstep;
            if (last && has_next) S.a_ready(nxt);
            if constexpr (SP2) {
            PG8_LDB(B0, 0, 0); PG8_LDB(B1, 0, 1); PG8_SCHED; PG8_LDA(At, 0, 0); PG8_STAGE(PG8_SA(1, 1), a1 + hstep, voffA);
            PG8_WAIT_V(8); PG8_WAIT_L(0); PG8_BAR; PG8_MMA(0, 0, At, B0); PG8_MMA(0, 1, At, B1); PG8_BAR; PG8_SCHED;
            PG8_LDA(At, 0, 1); PG8_STAGE(PG8_SB(0, 0), b2, voffB); PG8_STAGE(PG8_SB(0, 1), b2 + hstep, voffB); PG8_STAGE(PG8_SA(0, 0), a2, voffA);
            PG8_WAIT_V(8); PG8_WAIT_L(0); PG8_BAR; PG8_MMA(1, 0, At, B0); PG8_MMA(1, 1, At, B1); PG8_BAR; PG8_SCHED;
            PG8_LDB(B0, 1, 0); PG8_LDB(B1, 1, 1); PG8_SCHED; PG8_LDA(At, 1, 0); PG8_STAGE(PG8_SA(0, 1), a2 + hstep, voffA);
            PG8_WAIT_V(8); PG8_WAIT_L(0); PG8_BAR; PG8_MMA(0, 0, At, B0); PG8_MMA(0, 1, At, B1); PG8_BAR; PG8_SCHED;
            PG8_LDA(At, 1, 1); PG8_STAGE(PG8_SB(1, 0), b3, voffB); PG8_STAGE(PG8_SB(1, 1), b3 + hstep, voffB); PG8_STAGE(PG8_SA(1, 0), a3, voffA);
            PG8_WAIT_V(8); PG8_WAIT_L(0); PG8_BAR; PG8_MMA(1, 0, At, B0); PG8_MMA(1, 1, At, B1); PG8_BAR; PG8_SCHED;
            } else {
            PG8_LDB(B0, 0, 0); PG8_SCHED; PG8_LDA(At, 0, 0); PG8_STAGE(PG8_SA(1, 1), a1 + hstep, voffA);
            PG8_WAIT_L(8); PG8_BAR; PG8_WAIT_L(0); PG8_MMA(0, 0, At, B0); PG8_BAR; PG8_SCHED;
            PG8_LDB(B1, 0, 1); PG8_STAGE(PG8_SB(0, 0), b2, voffB);
            PG8_BAR; PG8_WAIT_L(0); PG8_MMA(0, 1, At, B1); PG8_BAR;
            PG8_LDA(At, 0, 1); PG8_STAGE(PG8_SA(0, 0), a2, voffA);
            PG8_BAR; PG8_WAIT_L(0); PG8_MMA(1, 0, At, B0); PG8_BAR; PG8_SCHED;
            PG8_STAGE(PG8_SB(0, 1), b2 + hstep, voffB);
            PG8_WAIT_V(6); PG8_BAR; PG8_MMA(1, 1, At, B1); PG8_BAR;
            PG8_LDB(B0, 1, 0); PG8_SCHED; PG8_LDA(At, 1, 0); PG8_STAGE(PG8_SA(0, 1), a2 + hstep, voffA);
            PG8_WAIT_L(8); PG8_BAR; PG8_WAIT_L(0); PG8_MMA(0, 0, At, B0); PG8_BAR; PG8_SCHED;
            PG8_LDB(B1, 1, 1); PG8_STAGE(PG8_SB(1, 0), b3, voffB);
            PG8_BAR; PG8_WAIT_L(0); PG8_MMA(0, 1, At, B1); PG8_BAR;
            PG8_LDA(At, 1, 1); PG8_STAGE(PG8_SA(1, 0), a3, voffA);
            PG8_BAR; PG8_WAIT_L(0); PG8_MMA(1, 0, At, B0); PG8_BAR; PG8_SCHED;
            PG8_STAGE(PG8_SB(1, 1), b3 + hstep, voffB);
            PG8_WAIT_V(6); PG8_BAR; PG8_MMA(1, 1, At, B1); PG8_BAR;
            }
        }
        if constexpr (ALIGN_EPI) { if (wr == 0) PG8_BAR; }
        if constexpr (!Epi::AFTER_DRAIN) { E(acc, cur, wr, wc, fr, fq); S.done(cur); }
        if (!has_next) break;
#pragma unroll
        for (int a = 0; a < 2; ++a)
#pragma unroll
            for (int b = 0; b < 2; ++b)
#pragma unroll
                for (int m = 0; m < 4; ++m)
#pragma unroll
                    for (int n = 0; n < 2; ++n) acc[a][b][m][n] = (f32x4){0.f, 0.f, 0.f, 0.f};
        cur = nxt; cA = nA; cB = nB; ++ui;
        if constexpr (ALIGN_EPI) { if (wr == 1) PG8_BAR; }
    }
    PG8_WAIT_V(0);
    if constexpr (!ALIGN_EPI) { if (wr == 0) PG8_BAR; }
    PG8_BAR;
    if constexpr (Epi::AFTER_DRAIN) { E.fused(acc, cur, wr, wc, fr, fq, lds, wid, lane); S.done(cur); }
#undef PG8_SA
#undef PG8_SB
#undef PG8_STAGE
#undef PG8_LDA
#undef PG8_LDB
#undef PG8_MMA
#undef PG8_WAIT_V
#undef PG8_WAIT_L
#undef PG8_BAR
#undef PG8_SCHED
}
}
#define LAS __attribute__((address_space(3)))

#define XB_TMO      128
#define XB_XCNT(j)  (256  + 64 * (j))
#define XB_XSUB(j)  (1280 + 64 * (j))
#define XB_XGEN(j)  (2304 + 64 * (j))
#define XB_TOP      3328
#define XB_TOPGEN   3392
#define XCD_BAR_WORDS 3456
#define XB_SPIN_CAP (1u << 18)

__device__ __forceinline__ unsigned xb_ld(unsigned* p)              { return __hip_atomic_load(p, __ATOMIC_RELAXED, __HIP_MEMORY_SCOPE_AGENT); }
__device__ __forceinline__ unsigned xb_add(unsigned* p, unsigned v) { return __hip_atomic_fetch_add(p, v, __ATOMIC_RELAXED, __HIP_MEMORY_SCOPE_AGENT); }
__device__ __forceinline__ unsigned xb_xcc_id() { return (unsigned)__builtin_amdgcn_s_getreg((3 << 11) | 20) & 0xFu; }
#define XB_SPIN(cond, bar) do { unsigned _sp = 0; while (cond) { __builtin_amdgcn_s_sleep(1); \
    if ((++_sp & 255u) == 0u) { if (xb_ld(&(bar)[XB_TMO])) break; if (_sp > XB_SPIN_CAP) { atomicAdd(&(bar)[XB_TMO], 1u); break; } } } } while (0)

struct XcdBarrier {
    unsigned* bar; unsigned x;
    volatile LAS unsigned* st;
};

__device__ __forceinline__ XcdBarrier xcd_barrier_post(unsigned* bar, volatile LAS unsigned* st) {
    XcdBarrier b; b.bar = bar; b.x = xb_xcc_id(); b.st = st;
    if (threadIdx.x == 0) (void)xb_add(&bar[XB_XCNT(b.x)], 1u);
    return b;
}
__device__ __forceinline__ void xcd_barrier_complete(unsigned* bar, unsigned x, unsigned& nloc, unsigned& nx) {
    const unsigned G = gridDim.x * gridDim.y * gridDim.z;
    unsigned sum, cnt, mine, sp = 0u;
    for (;;) {
        sum = 0u; cnt = 0u; mine = 0u;
#pragma unroll
        for (unsigned j = 0; j < 16; ++j) { const unsigned c = xb_ld(&bar[XB_XCNT(j)]); sum += c; cnt += (c > 0u) ? 1u : 0u; mine = (j == x) ? c : mine; }
        if (sum == G) break;
        __builtin_amdgcn_s_sleep(1);
        if ((++sp & 255u) == 0u) { if (xb_ld(&bar[XB_TMO])) break; if (sp > XB_SPIN_CAP) { atomicAdd(&bar[XB_TMO], 1u); break; } }
    }
    nloc = mine > 0u ? mine : 1u; nx = cnt > 0u ? cnt : 1u;
}

__device__ __forceinline__ void xcd_barrier(const XcdBarrier& b) {
    asm volatile("s_waitcnt vmcnt(0)" ::: "memory");
    __syncthreads();
    if (threadIdx.x == 0) {
        unsigned* bar = b.bar;
        __builtin_amdgcn_s_waitcnt(0);
        unsigned nloc = b.st[0], nx = b.st[1];
        if (nloc == 0u) { xcd_barrier_complete(bar, b.x, nloc, nx); b.st[0] = nloc; b.st[1] = nx; }
        const unsigned old = xb_add(&bar[XB_XSUB(b.x)], 1u);
        const unsigned gen = old / nloc;
        if (old + 1u == (gen + 1u) * nloc) {
            __builtin_amdgcn_fence(__ATOMIC_RELEASE, "agent");
            asm volatile("s_waitcnt vmcnt(0)" ::: "memory");
            const unsigned og = xb_add(&bar[XB_TOP], 1u);
            const unsigned tg = og / nx;
            if (og + 1u == (tg + 1u) * nx) xb_add(&bar[XB_TOPGEN], 1u);
            else XB_SPIN(xb_ld(&bar[XB_TOPGEN]) == tg, bar);
            __builtin_amdgcn_fence(__ATOMIC_ACQUIRE, "agent");
            xb_add(&bar[XB_XGEN(b.x)], 1u);
            asm volatile("s_waitcnt vmcnt(0)" ::: "memory");
        } else {
            XB_SPIN(xb_ld(&bar[XB_XGEN(b.x)]) == gen, bar);
            __builtin_amdgcn_fence(__ATOMIC_ACQUIRE, "agent");
            asm volatile("s_waitcnt vmcnt(0)" ::: "memory");
        }
    }
    __syncthreads();
}


#ifndef REP_MASK
#define REP_MASK 0
#endif
#ifndef NAIVE_ATTN
#define NAIVE_ATTN 0
#endif
#ifndef NAIVE_SPATIAL
#define NAIVE_SPATIAL 0
#endif

using pg8::bf16_t; using pg8::f32x4; using pg8::Unit; using pg8::u32x4;
typedef unsigned u32x2 __attribute__((ext_vector_type(2)));

constexpr int NLAT = 32768, NCTX = 2048, MTOT = 34816;
constexpr int NTHREADS = 512;
constexpr int LDS_BYTES = 131072 + 16;
constexpr int NPH = 24;

constexpr size_t OFF_W1T = 0;
constexpr size_t OFF_W2T = OFF_W1T + 4ull * 4096 * 1024 * 2;
constexpr size_t OFF_QKVT = OFF_W2T + 4ull * 4096 * 1024 * 2;
constexpr size_t OFF_WOT = OFF_QKVT + 2ull * 3072 * 1024 * 2;
constexpr size_t OFF_WINT = OFF_WOT + 2ull * 1024 * 1024 * 2;
constexpr size_t OFF_SGOT = OFF_WINT + 2ull * 6144 * 1024 * 2;
constexpr size_t OFF_MODS = OFF_SGOT + 2ull * 1024 * 3072 * 2;
constexpr size_t OFF_CTXR = OFF_MODS + 4ull * 9 * 6144 * 4;
constexpr size_t OFF_HB = OFF_CTXR + 2048ull * 1024 * 4;
constexpr size_t OFF_BIG = OFF_HB + 34816ull * 1024 * 2;
constexpr size_t OFF_SSQ = OFF_BIG + 34816ull * 4096 * 2;
constexpr size_t OFF_LNACC = OFF_SSQ + 8ull * 34816 * 4;
constexpr size_t OFF_GS = OFF_LNACC + 2ull * 34816 * 2 * 4;
constexpr size_t OFF_BQKV = OFF_GS + 8ull * 9 * 1024 * 4;
constexpr size_t OFF_BMLP = OFF_BQKV + 2ull * 9 * 3072 * 4;
constexpr size_t OFF_BWIN = OFF_BMLP + 4ull * 9 * 4096 * 4;
constexpr size_t OFF_BAR = OFF_BWIN + 2ull * 9 * 6144 * 4;
constexpr size_t WS_END = OFF_BAR + 16384;

struct Params {
    const float *x, *c, *ctx, *c_ctx, *ada_w, *ada_b, *norm1_g, *norm2_g, *mlp_w1, *mlp_w2, *na_w_qkv, *na_q_norm, *na_k_norm, *na_rpb, *na_w_o,
        *sg_w_in, *sg_b_in, *sg_ln_g, *sg_ln_b, *sg_w_s, *sg_b_s, *sg_w_o;
    float* out; unsigned char* ws; int ph_lo, ph_hi;
};

struct Tix { int tid, bid, gsz; };
__device__ __forceinline__ float bf2f(unsigned h) { return __uint_as_float(h << 16); }
__device__ __forceinline__ unsigned f2bf(float f) { unsigned u = __float_as_uint(f); u += 0x7FFFu + ((u >> 16) & 1u); return u >> 16; }
__device__ __forceinline__ unsigned pk2(float lo, float hi) { return pg8::cvt_pk_bf16(lo, hi); }
__device__ __forceinline__ float wave_sum(float v) {
#pragma unroll
    for (int o = 1; o < 64; o <<= 1) v += __shfl_xor(v, o);
    return v;
}
__device__ __forceinline__ float wave_max(float v) {
#pragma unroll
    for (int o = 1; o < 64; o <<= 1) v = fmaxf(v, __shfl_xor(v, o));
    return v;
}
#define LDS_WAIT() asm volatile("s_waitcnt lgkmcnt(0)" ::: "memory")
__device__ __forceinline__ float silu_f(float v) { return v / (1.f + expf(-v)); }
__device__ __forceinline__ float gelu_f(float v) { return 0.5f * v * (1.f + erff(v * 0.70710678118654752f)); }

typedef float f32x2 __attribute__((ext_vector_type(2)));
__device__ __forceinline__ f32x2 gelu_pk(f32x2 v) {
    const f32x2 av = __builtin_elementwise_abs(v), d = av * 0.2316418882f + 1.0f;
    f32x2 t; t.x = __builtin_amdgcn_rcpf(d.x); t.y = __builtin_amdgcn_rcpf(d.y);
    f32x2 q = t * 0.5307027145f + (-0.7265760135f); q = q * t + 0.7107068705f; q = q * t + (-0.142248368f); q = q * t + 0.127414796f; q = q * t;
    const f32x2 s = (v * v) * (-0.72134752044f);
    f32x2 e; e.x = __builtin_amdgcn_exp2f(s.x); e.y = __builtin_amdgcn_exp2f(s.y);
    const f32x2 m = v * (q * e), r = v - m;
    f32x2 o; o.x = v.x < 0.f ? m.x : r.x; o.y = v.y < 0.f ? m.y : r.y; return o;
}
__device__ __forceinline__ f32x4 gelu4(f32x4 v) { const f32x2 a = gelu_pk((f32x2){v.x, v.y}), b = gelu_pk((f32x2){v.z, v.w}); return (f32x4){a.x, a.y, b.x, b.y}; }

__device__ __forceinline__ int sigma_inv(int L) { return 128 * ((L >> 5) & 1) + 32 * (L >> 6) + 16 * ((L >> 2) & 1) + 4 * ((L >> 3) & 3) + (L & 3); }

__device__ __forceinline__ void phase_mods(const Params& p, LAS unsigned char* lds, const Tix T_) {
    LAS float* sc = (LAS float*)lds;
    LAS float* red = (LAS float*)(lds + 36864);
    float* mods = (float*)(p.ws + OFF_MODS);
    const int tid = T_.tid;
    for (int i = tid; i < 9 * 1024; i += NTHREADS) { const int b = i >> 10, k = i & 1023; const float v = b < 8 ? p.c[b * 1024 + k] : p.c_ctx[k]; sc[i] = silu_f(v); }
    __syncthreads();
    const int c4 = (tid & 15) * 4, kk = tid >> 4;
    for (int item = T_.bid; item < 384; item += T_.gsz) {
        const int l = item / 96, n0 = (item % 96) * 64;
        const float* W = p.ada_w + (size_t)l * 1024 * 6144 + n0 + c4;
        f32x4 acc[9];
#pragma unroll
        for (int b = 0; b < 9; ++b) acc[b] = (f32x4){0.f, 0.f, 0.f, 0.f};
#pragma unroll 4
        for (int i = 0; i < 32; ++i) { const int k = kk + 32 * i; const f32x4 w = *(const f32x4*)(W + (size_t)k * 6144);
#pragma unroll
            for (int b = 0; b < 9; ++b) acc[b] += sc[b * 1024 + k] * w; }
#pragma unroll
        for (int b = 0; b < 9; ++b) *(LAS f32x4*)(red + (kk * 9 + b) * 64 + c4) = acc[b];
        __syncthreads();
        for (int o = tid; o < 576; o += NTHREADS) { const int b = o >> 6, cc = o & 63; float s = 0.f;
            for (int j = 0; j < 32; ++j) s += red[(j * 9 + b) * 64 + cc];
            mods[(size_t)(l * 9 + b) * 6144 + n0 + cc] = s + p.ada_b[l * 6144 + n0 + cc]; }
        __syncthreads();
    }
}

struct MatDesc { const float* src; bf16_t* dst; int K, N; };
__device__ __forceinline__ MatDesc get_mat(const Params& p, int mi) {
    MatDesc m;
    if (mi < 4) { m.src = p.mlp_w1 + (size_t)mi * 1024 * 4096; m.dst = (bf16_t*)(p.ws + OFF_W1T) + (size_t)mi * 4096 * 1024; m.K = 1024; m.N = 4096; }
    else if (mi < 8) { const int l = mi - 4; m.src = p.mlp_w2 + (size_t)l * 4096 * 1024; m.dst = (bf16_t*)(p.ws + OFF_W2T) + (size_t)l * 1024 * 4096; m.K = 4096; m.N = 1024; }
    else if (mi < 10) { const int a = mi - 8; m.src = p.na_w_qkv + (size_t)a * 1024 * 3072; m.dst = (bf16_t*)(p.ws + OFF_QKVT) + (size_t)a * 3072 * 1024; m.K = 1024; m.N = 3072; }
    else if (mi < 12) { const int a = mi - 10; m.src = p.na_w_o + (size_t)a * 1024 * 1024; m.dst = (bf16_t*)(p.ws + OFF_WOT) + (size_t)a * 1024 * 1024; m.K = 1024; m.N = 1024; }
    else if (mi < 14) { const int s = mi - 12; m.src = p.sg_w_in + (size_t)s * 1024 * 6144; m.dst = (bf16_t*)(p.ws + OFF_WINT) + (size_t)s * 6144 * 1024; m.K = 1024; m.N = 6144; }
    else { const int s = mi - 14; m.src = p.sg_w_o + (size_t)s * 3072 * 1024; m.dst = (bf16_t*)(p.ws + OFF_SGOT) + (size_t)s * 1024 * 3072; m.K = 3072; m.N = 1024; }
    return m;
}
__device__ __forceinline__ void transpose_item(const float* W, int K, int N, bf16_t* WT, LAS float* scr, int item, int lane) {
    const int nblk = N / 32, kb = item / nblk, nb = item % nblk, k0 = 64 * kb, n0 = 32 * nb;
#pragma unroll 8
    for (int i = 0; i < 32; ++i) { const int kk = 2 * i + (lane >> 5); scr[kk * 33 + (lane & 31)] = W[(size_t)(k0 + kk) * N + n0 + (lane & 31)]; }
    LDS_WAIT();
    const int c = lane & 7;
#pragma unroll
    for (int j = 0; j < 4; ++j) { const int n = (lane >> 3) + 8 * j; const LAS float* s = scr + (8 * c) * 33 + n;
        u32x4 o; o.x = pk2(s[0 * 33], s[1 * 33]); o.y = pk2(s[2 * 33], s[3 * 33]); o.z = pk2(s[4 * 33], s[5 * 33]); o.w = pk2(s[6 * 33], s[7 * 33]);
        const int nl = n0 + n, drow = (nl & ~255) + sigma_inv(nl & 255);
        *(u32x4*)(WT + (size_t)drow * K + k0 + 8 * c) = o; }
    LDS_WAIT();
}
__device__ __forceinline__ void phase_convert(const Params& p, LAS unsigned char* lds, const Tix T_) {
    const int lane = T_.tid & 63, wave = T_.tid >> 6, gw = T_.bid * 8 + wave, NGW = T_.gsz * 8;
    LAS float* scr = (LAS float*)(lds + wave * 8704);
    for (int mi = 0; mi < 16; ++mi) {
        const MatDesc m = get_mat(p, mi);
        const int nitems = (m.K / 64) * (m.N / 32);
        for (int it = gw; it < nitems; it += NGW) transpose_item(m.src, m.K, m.N, m.dst, scr, it, lane);
    }
}


__device__ __forceinline__ void phase_zero(const Params& p, const Tix T_) {
    float* z0 = (float*)(p.ws + OFF_SSQ) + MTOT; const int n0 = 7 * MTOT + 2 * MTOT * 2;
    for (int i = T_.bid * NTHREADS + T_.tid; i < n0; i += T_.gsz * NTHREADS) z0[i] = 0.f;
}
__device__ __forceinline__ void phase_0b(const Params& p, LAS unsigned char* lds, const Tix T_) {
    const float* mods = (const float*)(p.ws + OFF_MODS);
    const int tid = T_.tid, lane = tid & 63, wave = tid >> 6, gw = T_.bid * 8 + wave, NGW = T_.gsz * 8;
    { float* gs = (float*)(p.ws + OFF_GS);
      for (int i = T_.bid * NTHREADS + tid; i < 8 * 9 * 1024; i += T_.gsz * NTHREADS) { const int n = i / 9216, rem = i % 9216, b = rem >> 10, c = rem & 1023, L = n >> 1;
          const float g = (n & 1) ? p.norm2_g[L * 1024 + c] : p.norm1_g[L * 1024 + c];
          gs[i] = g * (1.0f + mods[(size_t)(L * 9 + b) * 6144 + ((n & 1) ? 4096 : 1024) + c]); } }
    { bf16_t* hb = (bf16_t*)(p.ws + OFF_HB); float* ssq0 = (float*)(p.ws + OFF_SSQ);
      for (int row = gw; row < MTOT; row += NGW) {
          const float* xr = row < NLAT ? p.x + (size_t)row * 1024 : p.ctx + (size_t)(row - NLAT) * 1024;
          const int b = row < NLAT ? (row >> 12) : 8;
          f32x4 v[4]; float ss = 0.f;
#pragma unroll
          for (int j = 0; j < 4; ++j) { v[j] = *(const f32x4*)(xr + 4 * lane + 256 * j); ss += (v[j].x * v[j].x + v[j].y * v[j].y) + (v[j].z * v[j].z + v[j].w * v[j].w); }
          ss = wave_sum(ss);
          if (lane == 0) ssq0[row] = ss;
#pragma unroll
          for (int j = 0; j < 4; ++j) { const int col = 4 * lane + 256 * j;
              const f32x4 gv = *(const f32x4*)(p.norm1_g + col), scv = *(const f32x4*)(mods + (size_t)b * 6144 + 1024 + col);
              const f32x4 o = v[j] * gv * (1.0f + scv);
              u32x2 w; w.x = pk2(o.x, o.y); w.y = pk2(o.z, o.w);
              *(u32x2*)(hb + (size_t)row * 1024 + col) = w; } } }
    LAS float* sh = (LAS float*)lds;
    for (int cmb = 0; cmb < 8; ++cmb) {
        int L, shoff, N; const bf16_t* Bt; float* dst; const float* addb = nullptr;
        if (cmb < 2) { L = 2 * cmb; shoff = 0; N = 3072; Bt = (const bf16_t*)(p.ws + OFF_QKVT) + (size_t)cmb * 3072 * 1024; dst = (float*)(p.ws + OFF_BQKV) + (size_t)cmb * 9 * 3072; }
        else if (cmb < 6) { L = cmb - 2; shoff = 3072; N = 4096; Bt = (const bf16_t*)(p.ws + OFF_W1T) + (size_t)L * 4096 * 1024; dst = (float*)(p.ws + OFF_BMLP) + (size_t)L * 9 * 4096; }
        else { const int sl = cmb - 6; L = 2 * sl + 1; shoff = 0; N = 6144; Bt = (const bf16_t*)(p.ws + OFF_WINT) + (size_t)sl * 6144 * 1024; dst = (float*)(p.ws + OFF_BWIN) + (size_t)sl * 9 * 6144; addb = p.sg_b_in + sl * 6144; }
        __syncthreads();
        for (int i = tid; i < 9 * 1024; i += NTHREADS) sh[i] = mods[(size_t)(L * 9 + (i >> 10)) * 6144 + shoff + (i & 1023)];
        __syncthreads();
        for (int n = gw; n < N; n += NGW) {
            const bf16_t* wr_ = Bt + (size_t)((n & ~255) + sigma_inv(n & 255)) * 1024 + lane * 8;
            const u32x4 w0 = *(const u32x4*)wr_, w1 = *(const u32x4*)(wr_ + 512);
            float wv[16];
#pragma unroll
            for (int e = 0; e < 4; ++e) { wv[2 * e] = bf2f(w0[e] & 0xffffu); wv[2 * e + 1] = bf2f(w0[e] >> 16); wv[8 + 2 * e] = bf2f(w1[e] & 0xffffu); wv[8 + 2 * e + 1] = bf2f(w1[e] >> 16); }
            const float ab = addb ? addb[n] : 0.f;
#pragma unroll
            for (int b = 0; b < 9; ++b) {
                const f32x4 s0 = *(const LAS f32x4*)(sh + b * 1024 + lane * 8), s1 = *(const LAS f32x4*)(sh + b * 1024 + lane * 8 + 4);
                const f32x4 s2 = *(const LAS f32x4*)(sh + b * 1024 + 512 + lane * 8), s3 = *(const LAS f32x4*)(sh + b * 1024 + 512 + lane * 8 + 4);
                float a = (wv[0] * s0.x + wv[1] * s0.y) + (wv[2] * s0.z + wv[3] * s0.w) + (wv[4] * s1.x + wv[5] * s1.y) + (wv[6] * s1.z + wv[7] * s1.w)
                        + (wv[8] * s2.x + wv[9] * s2.y) + (wv[10] * s2.z + wv[11] * s2.w) + (wv[12] * s3.x + wv[13] * s3.y) + (wv[14] * s3.z + wv[15] * s3.w);
                a = wave_sum(a);
                if (lane == 0) dst[(size_t)b * N + n] = a + ab; }
        }
    }
}

typedef short s16x4 __attribute__((ext_vector_type(4)));
typedef short s16x8 __attribute__((ext_vector_type(8)));
typedef float f32x16 __attribute__((ext_vector_type(16)));
typedef __bf16 bf16x2_t __attribute__((ext_vector_type(2)));
__device__ __forceinline__ unsigned pkb(float a, float b) { const f32x2 v = {a, b}; const bf16x2_t r = __builtin_convertvector(v, bf16x2_t); return __builtin_bit_cast(unsigned, r); }
__device__ __forceinline__ s16x8 pack8(float a0, float a1, float a2, float a3, float a4, float a5, float a6, float a7) {
    u32x4 w; w.x = pkb(a0, a1); w.y = pkb(a2, a3); w.z = pkb(a4, a5); w.w = pkb(a6, a7); return __builtin_bit_cast(s16x8, w); }
__device__ __forceinline__ s16x8 tr_pair(const LAS unsigned char* a0, int second_off) {
    const s16x4 a = __builtin_amdgcn_ds_read_tr16_b64_v4i16((LAS s16x4*)a0);
    const s16x4 b = __builtin_amdgcn_ds_read_tr16_b64_v4i16((LAS s16x4*)(a0 + second_off));
    s16x8 r; r[0] = a[0]; r[1] = a[1]; r[2] = a[2]; r[3] = a[3]; r[4] = b[0]; r[5] = b[1]; r[6] = b[2]; r[7] = b[3]; return r; }
#define MFMA32(a, b, c) __builtin_amdgcn_mfma_f32_32x32x16_bf16((a), (b), (c), 0, 0, 0)

constexpr int AV_STR = 144;
__device__ __forceinline__ f32x16 attn_qk(const s16x8 (&Kf)[4], const s16x8 (&Qf)[4]) {
    f32x16 S;
#pragma unroll
    for (int i = 0; i < 16; ++i) S[i] = 0.f;
#pragma unroll
    for (int ks = 0; ks < 4; ++ks) S = MFMA32(Kf[ks], Qf[ks], S);
    return S;
}
__device__ __forceinline__ float tabv(const LAS unsigned char* tabrow, int off) { return *(const LAS float*)(tabrow + off); }
__device__ __forceinline__ void attn_one_tile(const s16x8 (&Kf)[4], const s16x8 (&Qf)[4], const LAS unsigned char* vb, const LAS unsigned char* tabrow, const unsigned (&offo)[4], const unsigned offx,
                                              f32x16& O0, f32x16& O1, float& lsum, int mode, float mbl) {
    const f32x16 S = attn_qk(Kf, Qf);
    float pv[16];
    if (mode == 0) {
#pragma unroll
        for (int i = 0; i < 16; ++i) pv[i] = __builtin_amdgcn_exp2f(S[i] - mbl);
    } else if (mode == 1) {
#pragma unroll
        for (int i = 0; i < 16; ++i) pv[i] = __builtin_amdgcn_exp2f(S[i] + tabv(tabrow, (int)((offo[i >> 2] >> (8 * (i & 3))) & 0xffu)));
    } else {
#pragma unroll
        for (int i = 0; i < 16; ++i) pv[i] = 0.f;
        if (mode == 2) {
#pragma unroll
            for (int i = 0; i < 4; ++i) pv[i] = __builtin_amdgcn_exp2f(S[i] + tabv(tabrow, (int)((offx >> (8 * i)) & 0xffu)));
        } else {
#pragma unroll
            for (int i = 0; i < 4; ++i) pv[12 + i] = __builtin_amdgcn_exp2f(S[12 + i] + tabv(tabrow, (int)((offx >> (8 * i)) & 0xffu)));
        }
    }
#pragma unroll
    for (int i = 0; i < 16; ++i) lsum += pv[i];
    const s16x8 P0 = pack8(pv[0], pv[1], pv[2], pv[3], pv[4], pv[5], pv[6], pv[7]), P1 = pack8(pv[8], pv[9], pv[10], pv[11], pv[12], pv[13], pv[14], pv[15]);
    { const s16x8 V00 = tr_pair(vb, 8 * AV_STR), V01 = tr_pair(vb + 64, 8 * AV_STR);
      O0 = MFMA32(V00, P0, O0); O1 = MFMA32(V01, P0, O1); }
    { const s16x8 V10 = tr_pair(vb + 16 * AV_STR, 8 * AV_STR), V11 = tr_pair(vb + 16 * AV_STR + 64, 8 * AV_STR);
      O0 = MFMA32(V10, P1, O0); O1 = MFMA32(V11, P1, O1); }
}
__device__ __forceinline__ void attn_load_k(s16x8 (&Kf)[4], const bf16_t* kbase, int klat0, int kctx0, int kt, int ntl, int rs) {
    const size_t grow = kt < ntl ? (size_t)(klat0 + (rs + (kt >> 1)) * 64 + 32 * (kt & 1)) : (size_t)(kctx0 + 32 * (kt - ntl));
#pragma unroll
    for (int ks = 0; ks < 4; ++ks) Kf[ks] = *(const s16x8*)(kbase + grow * 3072 + 16 * ks);
}
struct AUnit { int b, h, qrow0, r, rs, ntl, ntiles; };
__device__ __forceinline__ AUnit attn_decode(int u, int nlatu) {
    AUnit a;
    if (u < nlatu) { a.h = u & 15; const int br = u >> 4; a.r = br & 63; a.b = br >> 6; a.qrow0 = a.b * 4096 + a.r * 64; a.rs = min(max(a.r - 4, 0), 56); a.ntl = 16; a.ntiles = 24; }
    else { const int v = u - nlatu; a.h = v & 15; const int bq = v >> 4; a.b = bq >> 2; a.qrow0 = NLAT + a.b * 256 + (bq & 3) * 64; a.r = 0; a.rs = 0; a.ntl = 0; a.ntiles = 8; }
    return a;
}
__device__ __forceinline__ u32x4 attn_load_v1(const bf16_t* vbase, const AUnit& a, int idx) {
    const int key = idx >> 3, ch = idx & 7, kt = key >> 5, kk = key & 31;
    const int grow = kt < a.ntl ? (a.b * 4096 + (a.rs + (kt >> 1)) * 64 + 32 * (kt & 1) + kk) : (NLAT + a.b * 256 + 32 * (kt - a.ntl) + kk);
    return *(const u32x4*)(vbase + (size_t)grow * 3072 + ch * 8);
}
__device__ __forceinline__ void attn_load_v(u32x4 (&vpre)[12], const bf16_t* qkv, const AUnit& a, int tid) {
    const bf16_t* vbase = qkv + 2048 + a.h * 64;
#pragma unroll
    for (int i = 0; i < 4; ++i) vpre[i] = attn_load_v1(vbase, a, tid + NTHREADS * i);
    if (a.ntiles == 24) {
#pragma unroll
        for (int i = 4; i < 12; ++i) vpre[i] = attn_load_v1(vbase, a, tid + NTHREADS * i);
    }
}

__device__ __forceinline__ void phase_attn_mfma(const Params& p, int a_, bool ctx_q, LAS unsigned char* lds, const Tix T_) {
    const bf16_t* qkv = (const bf16_t*)(p.ws + OFF_BIG); bf16_t* ao = (bf16_t*)(p.ws + OFF_BIG) + (size_t)MTOT * 3072;
    const float* rpb = p.na_rpb + (size_t)a_ * 16 * 15 * 31;
    const int tid = T_.tid, lane = tid & 63, wave = __builtin_amdgcn_readfirstlane(tid >> 6), qt = wave & 1, kq = wave >> 1, l31 = lane & 31, hi = lane >> 5;
    LAS unsigned char* Vl = lds;
    LAS float* Ored = (LAS float*)lds;
    LAS float* lred = (LAS float*)(lds + 69632);
    LAS float* tab = (LAS float*)(lds + 110592);
    LAS float* misc = (LAS float*)(lds + 110592 + 2048);
    constexpr float LOG2E = 1.4426950408889634f;
    float mb;
    { float m = 0.f; for (int i = tid; i < 7440; i += NTHREADS) m = fmaxf(m, rpb[i]);
      float qg = 0.f, kg = 0.f; if (tid < 64) { qg = fabsf(p.na_q_norm[a_ * 64 + tid]); kg = fabsf(p.na_k_norm[a_ * 64 + tid]); }
      m = wave_max(m); qg = wave_max(qg); kg = wave_max(kg);
      if (lane == 0) { misc[wave] = m; if (wave == 0) { misc[8] = qg; misc[9] = kg; } }
      __syncthreads();
      float rm = misc[0];
#pragma unroll
      for (int w = 1; w < 8; ++w) rm = fmaxf(rm, misc[w]);
      mb = 8.0f * misc[8] * misc[9] + rm; }
    const float mbl = mb * LOG2E;
    const int nlatu = 8 * 64 * 16, total = nlatu + (ctx_q ? 8 * 4 * 16 : 0);
    const int tr_q = (lane & 15) >> 2, tr_p = lane & 3, dgrp = (lane >> 4) & 1;
    const int qcol = 32 * qt + l31, wst = min(max(qcol - 8, 0), 48);
    unsigned offo[4], offx = 0u;
#pragma unroll
    for (int j = 0; j < 4; ++j) { offo[j] = 0u;
#pragma unroll
        for (int i = 0; i < 4; ++i) { const int kcol = 32 * qt + 8 * j + 4 * hi + i; offo[j] |= (unsigned)(((unsigned)(kcol - wst) < 16u ? kcol - qcol + 15 : 31) * 4) << (8 * i); } }
#pragma unroll
    for (int i = 0; i < 4; ++i) { const int kcol = (qt == 0 ? 32 : 24) + 4 * hi + i; offx |= (unsigned)(((unsigned)(kcol - wst) < 16u ? kcol - qcol + 15 : 31) * 4) << (8 * i); }
    int u = T_.bid;
    AUnit cur = attn_decode(min(u, total - 1), nlatu);
    u32x4 vpre[12];
    s16x8 Qf[4], KA[4], KB[4];
    if (u < total) {
        attn_load_v(vpre, qkv, cur, tid);
        const bf16_t* qp = qkv + (size_t)(cur.qrow0 + 32 * qt + l31) * 3072 + cur.h * 64 + 8 * hi;
#pragma unroll
        for (int ks = 0; ks < 4; ++ks) Qf[ks] = *(const s16x8*)(qp + 16 * ks);
        const int t0 = kq * (cur.ntiles >> 2);
        attn_load_k(KA, qkv + 1024 + cur.h * 64 + 8 * hi, cur.b * 4096 + l31, NLAT + cur.b * 256 + l31, t0, cur.ntl, cur.rs);
        attn_load_k(KB, qkv + 1024 + cur.h * 64 + 8 * hi, cur.b * 4096 + l31, NLAT + cur.b * 256 + l31, t0 + 1, cur.ntl, cur.rs);
    }
    while (u < total) {
        const int b = cur.b, h = cur.h, qrow0 = cur.qrow0, r = cur.r, rs = cur.rs, ntl = cur.ntl, ntiles = cur.ntiles;
        int tidl = tid; asm volatile("" : "+v"(tidl));
#pragma unroll
        for (int i = 0; i < 4; ++i) { const int idx = tidl + NTHREADS * i; *(LAS u32x4*)(Vl + (idx >> 3) * AV_STR + (idx & 7) * 16) = vpre[i]; }
        if (ntiles == 24) {
#pragma unroll
            for (int i = 4; i < 12; ++i) { const int idx = tidl + NTHREADS * i; *(LAS u32x4*)(Vl + (idx >> 3) * AV_STR + (idx & 7) * 16) = vpre[i]; } }
        if (tid < 480) { const int rr = tid >> 5, dd = tid & 31; tab[tid] = dd < 31 ? (rpb[h * 465 + rr * 31 + dd] - mb) * LOG2E : -1e30f; }
        const bf16_t* kbase = qkv + 1024 + h * 64 + 8 * hi;
        const int klat0 = b * 4096 + l31, kctx0 = NLAT + b * 256 + l31;
        const int ntw = ntiles >> 2, t0 = kq * ntw;
        __syncthreads();
        f32x16 O0, O1;
#pragma unroll
        for (int i = 0; i < 16; ++i) { O0[i] = 0.f; O1[i] = 0.f; }
        float lsum = 0.f;
#pragma unroll 1
        for (int t = 0; t < ntw; t += 2) {
            { const int kt = t0 + t; const int mode = kt >= ntl ? 0 : ((kt & 1) == qt ? 1 : 2 + qt);
              attn_one_tile(KA, Qf, Vl + (kt * 32 + 4 * hi + tr_q) * AV_STR + (16 * dgrp + 4 * tr_p) * 2, (const LAS unsigned char*)tab + (rs + (kt >> 1) - r + 7) * 128, offo, offx, O0, O1, lsum, mode, mbl); }
            __builtin_amdgcn_sched_barrier(0);
            attn_load_k(KA, kbase, klat0, kctx0, t0 + min(t + 2, ntw - 2), ntl, rs);
            { const int kt = t0 + t + 1; const int mode = kt >= ntl ? 0 : ((kt & 1) == qt ? 1 : 2 + qt);
              attn_one_tile(KB, Qf, Vl + (kt * 32 + 4 * hi + tr_q) * AV_STR + (16 * dgrp + 4 * tr_p) * 2, (const LAS unsigned char*)tab + (rs + (kt >> 1) - r + 7) * 128, offo, offx, O0, O1, lsum, mode, mbl); }
            __builtin_amdgcn_sched_barrier(0);
            attn_load_k(KB, kbase, klat0, kctx0, t0 + min(t + 2, ntw - 2) + 1, ntl, rs);
        }
        const int un = u + T_.gsz;
        const AUnit nxt = attn_decode(min(un, total - 1), nlatu);
        int tidm = tid; asm volatile("" : "+v"(tidm));
        if (un < total) attn_load_v(vpre, qkv, nxt, tidm);
        __syncthreads();
#pragma unroll
        for (int j = 0; j < 4; ++j) {
            *(LAS f32x4*)(Ored + (size_t)((kq * 64 + 32 * qt + l31) * 68 + 8 * j + 4 * hi)) = (f32x4){O0[4 * j], O0[4 * j + 1], O0[4 * j + 2], O0[4 * j + 3]};
            *(LAS f32x4*)(Ored + (size_t)((kq * 64 + 32 * qt + l31) * 68 + 32 + 8 * j + 4 * hi)) = (f32x4){O1[4 * j], O1[4 * j + 1], O1[4 * j + 2], O1[4 * j + 3]}; }
        lred[(kq * 2 + hi) * 64 + 32 * qt + l31] = lsum;
        if (un < total) {
            const bf16_t* qp = qkv + (size_t)(nxt.qrow0 + 32 * qt + l31) * 3072 + nxt.h * 64 + 8 * hi;
#pragma unroll
            for (int ks = 0; ks < 4; ++ks) Qf[ks] = *(const s16x8*)(qp + 16 * ks);
            const int t0n = kq * (nxt.ntiles >> 2);
            attn_load_k(KA, qkv + 1024 + nxt.h * 64 + 8 * hi, nxt.b * 4096 + l31, NLAT + nxt.b * 256 + l31, t0n, nxt.ntl, nxt.rs);
            attn_load_k(KB, qkv + 1024 + nxt.h * 64 + 8 * hi, nxt.b * 4096 + l31, NLAT + nxt.b * 256 + l31, t0n + 1, nxt.ntl, nxt.rs);
        }
        __syncthreads();
        { const int q = tid >> 3, d8 = (tid & 7) * 8;
          f32x4 s0 = (f32x4){0.f, 0.f, 0.f, 0.f}, s1 = s0; float l = 0.f;
#pragma unroll
          for (int k = 0; k < 4; ++k) { s0 += *(const LAS f32x4*)(Ored + (k * 64 + q) * 68 + d8); s1 += *(const LAS f32x4*)(Ored + (k * 64 + q) * 68 + d8 + 4); l += lred[(k * 2) * 64 + q] + lred[(k * 2 + 1) * 64 + q]; }
          const float inv = 1.0f / l;
          u32x4 o; o.x = pkb(s0.x * inv, s0.y * inv); o.y = pkb(s0.z * inv, s0.w * inv); o.z = pkb(s1.x * inv, s1.y * inv); o.w = pkb(s1.z * inv, s1.w * inv);
          *(u32x4*)(ao + (size_t)(qrow0 + q) * 1024 + h * 64 + d8) = o; }
        __syncthreads();
        u = un; cur = nxt;
    }
}

constexpr int SP_RS = 320;
__device__ __forceinline__ void phase_spatial_mfma(const Params& p, int sl, int M, LAS unsigned char* lds, const Tix T_) {
    bf16_t* vb = (bf16_t*)(p.ws + OFF_BIG); const float* lnacc = (const float*)(p.ws + OFF_LNACC) + (size_t)sl * MTOT * 2;
    const float* lng = p.sg_ln_g + sl * 3072; const float* lnb = p.sg_ln_b + sl * 3072;
    const int tid = T_.tid, lane = tid & 63, wave = __builtin_amdgcn_readfirstlane(tid >> 6), pt = wave & 3, cth = wave >> 2, l31 = lane & 31, hi = lane >> 5;
    const int tr_q = (lane & 15) >> 2, tr_p = lane & 3, dgrp = (lane >> 4) & 1;
    const int nunits = (M / 128) * 24;
    for (int u = T_.bid; u < nunits; u += T_.gsz) {
        const int nc = u / 24, g = u % 24, r0 = nc * 128;
        const float* wp = p.sg_w_s + ((size_t)sl * 24 + g) * 16384 + (32 * pt + l31) * 128 + 8 * hi;
        f32x4 wx[16];
#pragma unroll
        for (int ks = 0; ks < 8; ++ks) { wx[2 * ks] = *(const f32x4*)(wp + 16 * ks); wx[2 * ks + 1] = *(const f32x4*)(wp + 16 * ks + 4); }
        const int c8 = (tid & 15) * 8;
        u32x4 vw[4]; f32x2 st2[4];
#pragma unroll
        for (int i = 0; i < 4; ++i) { const int q = (tid + NTHREADS * i) >> 4;
            vw[i] = *(const u32x4*)(vb + (size_t)(r0 + q) * 3072 + g * 128 + c8); st2[i] = *(const f32x2*)(lnacc + 2 * (r0 + q)); }
        const f32x4 g0 = *(const f32x4*)(lng + g * 128 + c8), g1 = *(const f32x4*)(lng + g * 128 + c8 + 4), b0 = *(const f32x4*)(lnb + g * 128 + c8), b1 = *(const f32x4*)(lnb + g * 128 + c8 + 4);
        const float bs = p.sg_b_s[((size_t)sl * 24 + g) * 128 + 32 * pt + l31];
        __builtin_amdgcn_sched_barrier(0);
#pragma unroll
        for (int i = 0; i < 4; ++i) { const int q = (tid + NTHREADS * i) >> 4; const u32x4 w = vw[i];
            const float mean = st2[i].x * (1.0f / 3072.0f), rstd = 1.0f / sqrtf(fmaxf(st2[i].y * (1.0f / 3072.0f) - mean * mean, 0.f) + 1e-6f);
            u32x4 o;
            o.x = pkb((bf2f(w.x & 0xffffu) - mean) * rstd * g0.x + b0.x, (bf2f(w.x >> 16) - mean) * rstd * g0.y + b0.y);
            o.y = pkb((bf2f(w.y & 0xffffu) - mean) * rstd * g0.z + b0.z, (bf2f(w.y >> 16) - mean) * rstd * g0.w + b0.w);
            o.z = pkb((bf2f(w.z & 0xffffu) - mean) * rstd * g1.x + b1.x, (bf2f(w.z >> 16) - mean) * rstd * g1.y + b1.y);
            o.w = pkb((bf2f(w.w & 0xffffu) - mean) * rstd * g1.z + b1.z, (bf2f(w.w >> 16) - mean) * rstd * g1.w + b1.w);
            *(LAS u32x4*)(lds + q * SP_RS + c8 * 2) = o; }
        s16x8 Wf[8];
#pragma unroll
        for (int ks = 0; ks < 8; ++ks) { const f32x4 x = wx[2 * ks], y = wx[2 * ks + 1]; Wf[ks] = pack8(x.x, x.y, x.z, x.w, y.x, y.y, y.z, y.w); }
        __syncthreads();
#pragma unroll
        for (int cc = 0; cc < 2; ++cc) { const int ct = 2 * cth + cc;
            f32x16 acc;
#pragma unroll
            for (int i = 0; i < 16; ++i) acc[i] = 0.f;
            const LAS unsigned char* ab = lds + (8 * hi + tr_q) * SP_RS + (32 * ct + 16 * dgrp + 4 * tr_p) * 2;
#pragma unroll
            for (int ks = 0; ks < 8; ++ks) { const s16x8 Af = tr_pair(ab + 16 * ks * SP_RS, 4 * SP_RS); acc = MFMA32(Af, Wf[ks], acc); }
            bf16_t* orow = vb + (size_t)(r0 + 32 * pt + l31) * 3072 + g * 128 + 32 * ct + 4 * hi;
#pragma unroll
            for (int j = 0; j < 4; ++j) { u32x2 o; o.x = pkb(acc[4 * j] + bs, acc[4 * j + 1] + bs); o.y = pkb(acc[4 * j + 2] + bs, acc[4 * j + 3] + bs); *(u32x2*)(orow + 8 * j) = o; }
        }
        __syncthreads();
    }
}

template <class F> struct EpiG {
    static constexpr bool PERM = false, AFTER_DRAIN = false;
    F f;
    __device__ __forceinline__ void operator()(const f32x4 (&acc)[2][2][4][2], const Unit& u, int wr, int wc, int fr, int fq) const {
        F g = f; const int colb = u.pn * 256 + 64 * wc + 8 * fq, rowbase = u.pm * 256 + wr * 64 + fr;
        g.begin(u, colb, fq, rowbase);
#pragma unroll
        for (int ai = 0; ai < 2; ++ai)
#pragma unroll
            for (int m = 0; m < 4; ++m) {
                g.row(ai * 4 + m, rowbase + ai * 128 + m * 16, colb, acc[ai][0][m][0], acc[ai][0][m][1], acc[ai][1][m][0], acc[ai][1][m][1]);
                asm volatile("" ::: "memory"); }
    }
};
__device__ __forceinline__ int epi_row(int rowbase, int idx) { return rowbase + 128 * (idx >> 2) + 16 * (idx & 3); }
__device__ __forceinline__ void store8_bf16(bf16_t* o, const f32x4 a, const f32x4 b) { u32x4 w; w.x = pk2(a.x, a.y); w.y = pk2(a.z, a.w); w.z = pk2(b.x, b.y); w.w = pk2(b.z, b.w); *(u32x4*)o = w; }
__device__ __forceinline__ float sumsq4(const f32x4 x) { return (x.x * x.x + x.y * x.y) + (x.z * x.z + x.w * x.w); }
__device__ __forceinline__ float sum4(const f32x4 x) { return (x.x + x.y) + (x.z + x.w); }
__device__ __forceinline__ float rstd_from(float ssq) { return 1.0f / sqrtf(ssq * (1.0f / 1024.0f) + 1e-6f); }
__device__ __forceinline__ void atomic_addf(float* p, float v) { __hip_atomic_fetch_add(p, v, __ATOMIC_RELAXED, __HIP_MEMORY_SCOPE_AGENT); }
struct RowSsq { float v[8];
    __device__ __forceinline__ void load(const float* ssq, int rowbase) {
#pragma unroll
        for (int i = 0; i < 8; ++i) v[i] = ssq[epi_row(rowbase, i)]; } };

struct FQKV { bf16_t* O; const float* qg; const float* kg; const float* ssq; const float* bias;
    f32x4 gn[4], bz[4]; int sect; RowSsq rq;
    __device__ __forceinline__ void begin(const Unit& u, int colb, int fq, int rowbase) {
        rq.load(ssq, rowbase);
        sect = u.pn >> 2; const int b = min(u.pm >> 4, 8); const float* bp = bias + (size_t)b * 3072 + colb;
        bz[0] = *(const f32x4*)bp; bz[1] = *(const f32x4*)(bp + 4); bz[2] = *(const f32x4*)(bp + 32); bz[3] = *(const f32x4*)(bp + 36);
        if (sect < 2) { const float* gp = (sect == 0 ? qg : kg) + 8 * fq; const float mul = sect == 0 ? 0.125f * 1.4426950408889634f : 1.0f;
            gn[0] = *(const f32x4*)gp * mul; gn[1] = *(const f32x4*)(gp + 4) * mul; gn[2] = *(const f32x4*)(gp + 32) * mul; gn[3] = *(const f32x4*)(gp + 36) * mul; } }
    __device__ __forceinline__ void row(int idx, int row, int colb, f32x4 a0, f32x4 b0, f32x4 a1, f32x4 b1) {
        const float rs = rstd_from(rq.v[idx]);
        a0 = a0 * rs + bz[0]; b0 = b0 * rs + bz[1]; a1 = a1 * rs + bz[2]; b1 = b1 * rs + bz[3];
        if (sect < 2) { float ss = (sumsq4(a0) + sumsq4(b0)) + (sumsq4(a1) + sumsq4(b1));
            ss += __shfl_xor(ss, 16); ss += __shfl_xor(ss, 32);
            const float r2 = 1.0f / sqrtf(ss * (1.0f / 64.0f) + 1e-6f);
            a0 = a0 * r2 * gn[0]; b0 = b0 * r2 * gn[1]; a1 = a1 * r2 * gn[2]; b1 = b1 * r2 * gn[3]; }
        bf16_t* op = O + (size_t)row * 3072 + colb; store8_bf16(op, a0, b0); store8_bf16(op + 32, a1, b1); } };
struct FSqrelu { bf16_t* O; const float* ssq; const float* bias;
    f32x4 bz[4]; RowSsq rq;
    __device__ __forceinline__ void begin(const Unit& u, int colb, int fq, int rowbase) { rq.load(ssq, rowbase); const int b = min(u.pm >> 4, 8); const float* bp = bias + (size_t)b * 4096 + colb;
        bz[0] = *(const f32x4*)bp; bz[1] = *(const f32x4*)(bp + 4); bz[2] = *(const f32x4*)(bp + 32); bz[3] = *(const f32x4*)(bp + 36); }
    __device__ __forceinline__ void row(int idx, int row, int colb, f32x4 a0, f32x4 b0, f32x4 a1, f32x4 b1) {
        const float rs = rstd_from(rq.v[idx]); const f32x4 z = (f32x4){0.f, 0.f, 0.f, 0.f};
        a0 = __builtin_elementwise_max(a0 * rs + bz[0], z); b0 = __builtin_elementwise_max(b0 * rs + bz[1], z); a1 = __builtin_elementwise_max(a1 * rs + bz[2], z); b1 = __builtin_elementwise_max(b1 * rs + bz[3], z);
        bf16_t* op = O + (size_t)row * 4096 + colb; store8_bf16(op, a0 * a0, b0 * b0); store8_bf16(op + 32, a1 * a1, b1 * b1); } };
struct FGeluV { bf16_t* O; const float* ssq; const float* bias; float* lnacc;
    f32x4 bz[4]; int fq_; RowSsq rq;
    __device__ __forceinline__ void begin(const Unit& u, int colb, int fq, int rowbase) { rq.load(ssq, rowbase); const int b = min(u.pm >> 4, 8); const float* bp = bias + (size_t)b * 6144 + colb; fq_ = fq;
        bz[0] = *(const f32x4*)bp; bz[1] = *(const f32x4*)(bp + 4); bz[2] = *(const f32x4*)(bp + 32); bz[3] = *(const f32x4*)(bp + 36); }
    __device__ __forceinline__ void row(int idx, int row, int colb, f32x4 a0, f32x4 b0, f32x4 a1, f32x4 b1) {
        const float rs = rstd_from(rq.v[idx]);
        a0 = gelu4(a0 * rs + bz[0]); b0 = gelu4(b0 * rs + bz[1]); a1 = gelu4(a1 * rs + bz[2]); b1 = gelu4(b1 * rs + bz[3]);
        bf16_t* op = O + (size_t)row * 3072 + colb; store8_bf16(op, a0, b0); store8_bf16(op + 32, a1, b1);
        float s1 = (sum4(a0) + sum4(b0)) + (sum4(a1) + sum4(b1)), s2 = (sumsq4(a0) + sumsq4(b0)) + (sumsq4(a1) + sumsq4(b1));
        s1 += __shfl_xor(s1, 16); s1 += __shfl_xor(s1, 32); s2 += __shfl_xor(s2, 16); s2 += __shfl_xor(s2, 32);
        if (fq_ == 0) { atomic_addf(lnacc + 2 * (size_t)row, s1); atomic_addf(lnacc + 2 * (size_t)row + 1, s2); } } };
struct FGeluU { bf16_t* O; const float* ssq; const float* bias;
    f32x4 bz[4]; RowSsq rq; u32x4 sv[2][2]; int rowbase_;
    __device__ __forceinline__ void fetch(int idx, int colb) { const bf16_t* op = O + (size_t)epi_row(rowbase_, idx) * 3072 + colb; sv[idx & 1][0] = *(const u32x4*)op; sv[idx & 1][1] = *(const u32x4*)(op + 32); }
    __device__ __forceinline__ void begin(const Unit& u, int colb, int fq, int rowbase) { rq.load(ssq, rowbase); rowbase_ = rowbase; fetch(0, colb);
        const int b = min(u.pm >> 4, 8); const float* bp = bias + (size_t)b * 6144 + colb;
        bz[0] = *(const f32x4*)bp; bz[1] = *(const f32x4*)(bp + 4); bz[2] = *(const f32x4*)(bp + 32); bz[3] = *(const f32x4*)(bp + 36); }
    __device__ __forceinline__ static f32x4 lo4(const u32x4 s) { return (f32x4){bf2f(s.x & 0xffffu), bf2f(s.x >> 16), bf2f(s.y & 0xffffu), bf2f(s.y >> 16)}; }
    __device__ __forceinline__ static f32x4 hi4(const u32x4 s) { return (f32x4){bf2f(s.z & 0xffffu), bf2f(s.z >> 16), bf2f(s.w & 0xffffu), bf2f(s.w >> 16)}; }
    __device__ __forceinline__ void row(int idx, int row, int colb, f32x4 a0, f32x4 b0, f32x4 a1, f32x4 b1) {
        if (idx < 7) fetch(idx + 1, colb);
        const float rs = rstd_from(rq.v[idx]);
        bf16_t* op = O + (size_t)row * 3072 + colb; const u32x4 sv0 = sv[idx & 1][0], sv1 = sv[idx & 1][1];
        a0 = gelu4(a0 * rs + bz[0]) * lo4(sv0); b0 = gelu4(b0 * rs + bz[1]) * hi4(sv0); a1 = gelu4(a1 * rs + bz[2]) * lo4(sv1); b1 = gelu4(b1 * rs + bz[3]) * hi4(sv1);
        store8_bf16(op, a0, b0); store8_bf16(op + 32, a1, b1); } };
struct FResid { const float* inl; const float* inc; float* outl; float* outc; const float* gate;
    const float* gsn; bf16_t* xb; float* ssqn;
    f32x4 gz[4], gsz[4], xin[2][4]; int fq_, rowbase_;
    __device__ __forceinline__ void fetch(int idx, int colb) { const int row = epi_row(rowbase_, idx);
        const float* ip = row < NLAT ? inl + (size_t)row * 1024 + colb : inc + (size_t)(row - NLAT) * 1024 + colb;
        xin[idx & 1][0] = *(const f32x4*)ip; xin[idx & 1][1] = *(const f32x4*)(ip + 4); xin[idx & 1][2] = *(const f32x4*)(ip + 32); xin[idx & 1][3] = *(const f32x4*)(ip + 36); }
    __device__ __forceinline__ void begin(const Unit& u, int colb, int fq, int rowbase) { const int b = min(u.pm >> 4, 8); fq_ = fq; rowbase_ = rowbase; fetch(0, colb);
        const float* gp = gate + (size_t)b * 6144 + colb;
        gz[0] = *(const f32x4*)gp; gz[1] = *(const f32x4*)(gp + 4); gz[2] = *(const f32x4*)(gp + 32); gz[3] = *(const f32x4*)(gp + 36);
        if (gsn) { const float* sp = gsn + (size_t)b * 1024 + colb; gsz[0] = *(const f32x4*)sp; gsz[1] = *(const f32x4*)(sp + 4); gsz[2] = *(const f32x4*)(sp + 32); gsz[3] = *(const f32x4*)(sp + 36); } }
    __device__ __forceinline__ void row(int idx, int row, int colb, f32x4 a0, f32x4 b0, f32x4 a1, f32x4 b1) {
        if (idx < 7) fetch(idx + 1, colb);
        float* op = row < NLAT ? outl + (size_t)row * 1024 + colb : outc + (size_t)(row - NLAT) * 1024 + colb;
        a0 = xin[idx & 1][0] + gz[0] * a0; b0 = xin[idx & 1][1] + gz[1] * b0; a1 = xin[idx & 1][2] + gz[2] * a1; b1 = xin[idx & 1][3] + gz[3] * b1;
        *(f32x4*)op = a0; *(f32x4*)(op + 4) = b0; *(f32x4*)(op + 32) = a1; *(f32x4*)(op + 36) = b1;
        if (gsn) { float ss = (sumsq4(a0) + sumsq4(b0)) + (sumsq4(a1) + sumsq4(b1));
            ss += __shfl_xor(ss, 16); ss += __shfl_xor(ss, 32);
            if (fq_ == 0) atomic_addf(ssqn + row, ss);
            bf16_t* xp = xb + (size_t)row * 1024 + colb; store8_bf16(xp, a0 * gsz[0], b0 * gsz[1]); store8_bf16(xp + 32, a1 * gsz[2], b1 * gsz[3]); } } };

template <class F> __device__ __forceinline__ void run_gemm(LAS unsigned char* lds, const bf16_t* A, const bf16_t* Bt, int M, int N, int K, const F& f, const Tix T_) {
    pg8::StaticOrder S; S.init(M, N, T_.gsz, T_.bid);
    pg8::Gemm g; g.A = A; g.Bt = Bt; g.M = M; g.N = N; g.K = K;
    EpiG<F> E; E.f = f;
    pg8::gemm_phase<EpiG<F>, pg8::StaticOrder, true, true>(lds, g, S, E, T_.tid);
}

enum { OP_QKV, OP_ATTN, OP_MIXOUT, OP_MLP1, OP_MLP2, OP_VGEMM, OP_SPATIAL, OP_UGEMM, OP_PROLOGUE, OP_PHASE0B };

__device__ __forceinline__ void decode_phase(int ph, int& L, int& op) {
    L = 0; op = ph == 0 ? OP_PROLOGUE : OP_PHASE0B;
    if (ph > 1) {
        int q = ph - 2;
        if (q < 5) { L = 0; } else if (q < 11) { L = 1; q -= 5; } else if (q < 16) { L = 2; q -= 11; } else { L = 3; q -= 16; }
        if ((L & 1) == 0) op = q == 0 ? OP_QKV : q == 1 ? OP_ATTN : q == 2 ? OP_MIXOUT : q == 3 ? OP_MLP1 : OP_MLP2;
        else op = q == 0 ? OP_VGEMM : q == 1 ? OP_SPATIAL : q == 2 ? OP_UGEMM : q == 3 ? OP_MIXOUT : q == 4 ? OP_MLP1 : OP_MLP2;
    }
}

__device__ __forceinline__ void run_phase(const Params& p, int ph, LAS unsigned char* lds, const Tix T_) {
    int L, op; decode_phase(ph, L, op);
#ifdef ONLY_OP
    op = ONLY_OP;
#endif
    const int mi = L >> 1;
    const bool attnL = (L & 1) == 0;
    const int Mfull = L < 2 ? MTOT : NLAT;
    const float* modsl = (const float*)(p.ws + OFF_MODS) + (size_t)L * 9 * 6144;
    float* ctxr = (float*)(p.ws + OFF_CTXR);
    bf16_t* hb = (bf16_t*)(p.ws + OFF_HB); bf16_t* big = (bf16_t*)(p.ws + OFF_BIG);
    float* ssq = (float*)(p.ws + OFF_SSQ); const float* gs = (const float*)(p.ws + OFF_GS);
    const bool first = (L == 0);
    switch (op) {
    case OP_PROLOGUE: phase_zero(p, T_); phase_mods(p, lds, T_); __syncthreads(); phase_convert(p, lds, T_); break;
    case OP_PHASE0B: phase_0b(p, lds, T_); break;
    case OP_QKV: { FQKV f; f.O = big; f.qg = p.na_q_norm + mi * 64; f.kg = p.na_k_norm + mi * 64; f.ssq = ssq + (size_t)(2 * L) * MTOT; f.bias = (const float*)(p.ws + OFF_BQKV) + (size_t)mi * 9 * 3072;
        run_gemm(lds, hb, (const bf16_t*)(p.ws + OFF_QKVT) + (size_t)mi * 3072 * 1024, MTOT, 3072, 1024, f, T_); } break;
    case OP_ATTN: phase_attn_mfma(p, mi, L == 0, lds, T_); break;
    case OP_MIXOUT: case OP_MLP2: {
        FResid f; const bool mo = (op == OP_MIXOUT);
        f.inl = (first && mo) ? p.x : p.out; f.inc = (first && mo) ? p.ctx : ctxr; f.outl = p.out; f.outc = ctxr; f.gate = modsl + (mo ? 2048 : 5120);
        const int nn = mo ? 2 * L + 1 : 2 * L + 2;
        const bool has_next = nn < 8 && !(nn == 6 + 0 && false);
        f.gsn = has_next ? gs + (size_t)nn * 9 * 1024 : nullptr; f.xb = hb; f.ssqn = ssq + (size_t)(has_next ? nn : 0) * MTOT;
        const bf16_t* A; const bf16_t* Bt; int K;
        if (!mo) { A = big; Bt = (const bf16_t*)(p.ws + OFF_W2T) + (size_t)L * 1024 * 4096; K = 4096; }
        else if (attnL) { A = big + (size_t)MTOT * 3072; Bt = (const bf16_t*)(p.ws + OFF_WOT) + (size_t)mi * 1024 * 1024; K = 1024; }
        else { A = big; Bt = (const bf16_t*)(p.ws + OFF_SGOT) + (size_t)mi * 1024 * 3072; K = 3072; }
        run_gemm(lds, A, Bt, Mfull, 1024, K, f, T_); } break;
    case OP_MLP1: { FSqrelu f; f.O = big; f.ssq = ssq + (size_t)(2 * L + 1) * MTOT; f.bias = (const float*)(p.ws + OFF_BMLP) + (size_t)L * 9 * 4096;
        run_gemm(lds, hb, (const bf16_t*)(p.ws + OFF_W1T) + (size_t)L * 4096 * 1024, Mfull, 4096, 1024, f, T_); } break;
    case OP_VGEMM: { FGeluV f; f.O = big; f.ssq = ssq + (size_t)(2 * L) * MTOT; f.bias = (const float*)(p.ws + OFF_BWIN) + (size_t)mi * 9 * 6144 + 3072; f.lnacc = (float*)(p.ws + OFF_LNACC) + (size_t)mi * MTOT * 2;
        run_gemm(lds, hb, (const bf16_t*)(p.ws + OFF_WINT) + (size_t)mi * 6144 * 1024 + (size_t)3072 * 1024, Mfull, 3072, 1024, f, T_); } break;
    case OP_SPATIAL: phase_spatial_mfma(p, mi, Mfull, lds, T_); break;
    case OP_UGEMM: { FGeluU f; f.O = big; f.ssq = ssq + (size_t)(2 * L) * MTOT; f.bias = (const float*)(p.ws + OFF_BWIN) + (size_t)mi * 9 * 6144;
        run_gemm(lds, hb, (const bf16_t*)(p.ws + OFF_WINT) + (size_t)mi * 6144 * 1024, Mfull, 3072, 1024, f, T_); } break;
    default: break;
    }
}

#ifndef ONE_LAUNCH
#define ONE_LAUNCH 1
#endif
__global__ void __launch_bounds__(NTHREADS) mk(Params p0) {
    extern __shared__ __attribute__((aligned(16))) unsigned char lds_raw[];
    LAS unsigned char* lds = (LAS unsigned char*)lds_raw;
#if ONE_LAUNCH
    cg::grid_group grid = cg::this_grid();
    if (p0.ph_lo < 0) grid.sync();
    volatile LAS unsigned* st = (volatile LAS unsigned*)(lds + 131072);
    if (threadIdx.x == 0) { st[0] = 0u; st[1] = 0u; }
    __syncthreads();
    const XcdBarrier xbar = xcd_barrier_post((unsigned*)(p0.ws + OFF_BAR), st);
    bool first_it = true, repeated = false;
    for (int ph = p0.ph_lo; ph < p0.ph_hi; ) {
        if (!first_it) xcd_barrier(xbar);
        first_it = false;
        Tix T_; T_.tid = threadIdx.x; T_.bid = blockIdx.x; T_.gsz = gridDim.x;
        size_t z = 0;
        asm volatile("" : "+v"(T_.tid)); asm volatile("" : "+s"(T_.bid), "+s"(T_.gsz), "+s"(z));
        Params p = p0;
        { const float** pp = (const float**)&p;
#pragma unroll
          for (int i = 0; i < 22; ++i) pp[i] += z; }
        p.out += z; p.ws += z;
        run_phase(p, ph, lds, T_);
        __syncthreads();
        if (REP_MASK != 0) { int L_, op_; decode_phase(ph, L_, op_); if (((REP_MASK >> op_) & 1) && !repeated) { repeated = true; continue; } }
        repeated = false; ++ph;
    }
#else
    Tix T_; T_.tid = threadIdx.x; T_.bid = blockIdx.x; T_.gsz = gridDim.x;
    run_phase(p0, p0.ph_lo, lds, T_);
#endif
}

extern "C" void kernel_launch(void* const* d_in, const int* in_sizes, int n_in, void* d_out, int out_size, void* d_ws, size_t ws_size, hipStream_t stream) {
    static int grid = 0;
    if (grid == 0) {
        if (n_in != 22 || ws_size < WS_END) { fprintf(stderr, "kernel_launch: unexpected n_in %d or ws_size %zu (< %zu)\n", n_in, ws_size, (size_t)WS_END); grid = -1; return; }
        int dev = 0, cus = 0, per_cu = 0;
        hipGetDevice(&dev); hipDeviceGetAttribute(&cus, hipDeviceAttributeMultiprocessorCount, dev);
        if (hipFuncSetAttribute((const void*)mk, hipFuncAttributeMaxDynamicSharedMemorySize, LDS_BYTES) != hipSuccess) { fprintf(stderr, "kernel_launch: hipFuncSetAttribute failed\n"); grid = -1; return; }
        if (hipOccupancyMaxActiveBlocksPerMultiprocessor(&per_cu, (const void*)mk, NTHREADS, LDS_BYTES) != hipSuccess || per_cu < 1) { fprintf(stderr, "kernel_launch: occupancy query says %d\n", per_cu); per_cu = 1; }
        (void)hipGetLastError();
        grid = cus;
    }
    if (grid < 0) return;
    if (hipMemsetAsync((unsigned char*)d_ws + OFF_BAR, 0, 16384, stream) != hipSuccess) { fprintf(stderr, "kernel_launch: memset of the barrier words failed\n"); return; }
    Params p{};
    const float** pp = (const float**)&p;
    for (int i = 0; i < 22; ++i) pp[i] = (const float*)d_in[i];
    p.out = (float*)d_out; p.ws = (unsigned char*)d_ws;
#if ONE_LAUNCH
    p.ph_lo = 0; p.ph_hi = NPH;
    void* args[] = {&p};
    hipError_t e = hipLaunchCooperativeKernel((void*)mk, dim3(grid), dim3(NTHREADS), args, LDS_BYTES, stream);
    if (e != hipSuccess) fprintf(stderr, "cooperative launch failed: %s (grid %d)\n", hipGetErrorString(e), grid);
#else
    for (int ph = 0; ph < NPH; ++ph) { p.ph_lo = ph; p.ph_hi = ph + 1; hipLaunchKernelGGL(mk, dim3(grid), dim3(NTHREADS), LDS_BYTES, stream, p); }
#endif
}
```

```cpp
#include <hip/hip_runtime.h>
#include <hip/hip_cooperative_groups.h>
#include <cstdio>
#include <cstdint>
namespace cg = cooperative_groups;
namespace pg8 {
#define PG8_LAS __attribute__((address_space(3)))
typedef unsigned short bf16_t;
typedef short bf16x8 __attribute__((ext_vector_type(8)));
typedef float f32x4 __attribute__((ext_vector_type(4)));
typedef unsigned u32x4 __attribute__((ext_vector_type(4)));
constexpr int BM = 256, BK = 64, HALF = 128, HTB = HALF * BK * 2  , STAGE_BYTES = 8 * HTB, NXCD = 8, WGM = 8;

__host__ __device__ __forceinline__ int lds_byte(int r, int c) { const int st = (r >> 4) * 2 + (c >> 5), rr = r & 15, cc = c & 31, ob = rr * 64 + cc * 2; return st * 1024 + (ob ^ (((ob >> 9) & 1) << 5)); }
__host__ __device__ __forceinline__ void stage_rc(int b, int& R, int& C) { const int st = b / 1024, sb = b % 1024, swz = sb ^ (((sb >> 9) & 1) << 5); R = (st >> 1) * 16 + swz / 64; C = (st & 1) * 32 + (swz % 64) / 2; }
__host__ __device__ __forceinline__ int perm32(int rho) { const int n = rho >> 4, i = rho & 15; return 8 * (i >> 2) + 4 * n + (i & 3); }

struct Unit { int pm, pn; };
struct Gemm { const bf16_t* A; const bf16_t* Bt; int M, N, K; };

struct StaticOrder {
    int nM, nN, nwg, G, c;
    __host__ __device__ void init(int M, int N, int G_, int c_) { nM = M / BM; nN = N / BM; nwg = nM * nN; G = G_; c = c_; }
    __host__ __device__ bool next(int i, Unit& u) const {
        const long L = (long)i * G + c; if (L >= nwg) return false;
        int wgid = (int)L; { const int q = nwg / NXCD, r = nwg % NXCD, xcd = wgid % NXCD, off = wgid / NXCD; wgid = (xcd < r ? xcd * (q + 1) : r * (q + 1) + (xcd - r) * q) + off; }
        const int nig = WGM * nN, gid = wgid / nig, fm = gid * WGM, gsz = (nM - fm) < WGM ? (nM - fm) : WGM;
        u.pm = fm + ((wgid % nig) % gsz); u.pn = (wgid % nig) / gsz; return true;
    }
    __device__ __forceinline__ void a_ready(const Unit&) const {}
    __device__ __forceinline__ void done(const Unit&) const {}
};

__device__ __forceinline__ unsigned cvt_pk_bf16(float lo, float hi) { unsigned r; asm volatile("v_cvt_pk_bf16_f32 %0, %1, %2" : "=v"(r) : "v"(lo), "v"(hi)); return r; }
template <class Epi, class Sched, bool ALIGN_EPI = false, bool SP2 = false>
__device__ __forceinline__ void gemm_phase(PG8_LAS unsigned char* lds, const Gemm g, const Sched& S, const Epi& E, const int tid_in) {
    const int tid = tid_in, wid = __builtin_amdgcn_readfirstlane(tid >> 6), lane = tid & 63, wr = wid >> 2, wc = wid & 3, fr = lane & 15, fq = lane >> 4;
    const int K = g.K, nt = K / BK;
    unsigned voffA[2], voffB[2];
#pragma unroll
    for (int i = 0; i < 2; ++i) { int R, C; stage_rc(tid * 16 + i * 8192, R, C); const int Rb = Epi::PERM ? ((R & ~31) + perm32(R & 31)) : R;
        voffA[i] = (unsigned)(R * K + C) * 2u; voffB[i] = (unsigned)(Rb * K + C) * 2u; }
    const size_t kstep = (size_t)(BK * 2);
    const size_t hstep = (size_t)HALF * K * 2;
    const size_t tstep = 2 * hstep;
    const unsigned ldsw = (unsigned)wid * 1024u;
    const int aoff = lds_byte(wr * 64 + fr, fq * 8), boff = lds_byte(wc * 32 + fr, fq * 8);
#define PG8_SA(b, h) (((b) * 2 + (h)) * HTB)
#define PG8_SB(b, h) ((4 + (b) * 2 + (h)) * HTB)
#define PG8_STAGE(bufoff, gbase, voff) do { _Pragma("unroll") for (int _i = 0; _i < 2; ++_i) \
        __builtin_amdgcn_global_load_lds((const unsigned*)((const char*)(gbase) + (voff)[_i]), (PG8_LAS unsigned*)(lds + (bufoff) + ldsw + _i * 8192), 16, 0, 0); } while (0)
#define PG8_LDA(dst, b, h) do { _Pragma("unroll") for (int m = 0; m < 4; ++m) _Pragma("unroll") for (int k = 0; k < 2; ++k) dst[m][k] = *(const PG8_LAS bf16x8*)(lds + PG8_SA(b, h) + aoff + m * 2048 + k * 1024); } while (0)
#define PG8_LDB(dst, b, h) do { _Pragma("unroll") for (int n = 0; n < 2; ++n) _Pragma("unroll") for (int k = 0; k < 2; ++k) dst[n][k] = *(const PG8_LAS bf16x8*)(lds + PG8_SB(b, h) + boff + n * 2048 + k * 1024); } while (0)
#define PG8_MMA(ai, bj, At, Bt) do { __builtin_amdgcn_s_setprio(1); _Pragma("unroll") for (int m = 0; m < 4; ++m) _Pragma("unroll") for (int n = 0; n < 2; ++n) _Pragma("unroll") for (int k = 0; k < 2; ++k) \
        acc[ai][bj][m][n] = __builtin_amdgcn_mfma_f32_16x16x32_bf16(Bt[n][k], At[m][k], acc[ai][bj][m][n], 0, 0, 0); __builtin_amdgcn_s_setprio(0); } while (0)
#define PG8_WAIT_V(n) asm volatile("s_waitcnt vmcnt(" #n ")" ::: "memory")
#define PG8_WAIT_L(n) asm volatile("s_waitcnt lgkmcnt(" #n ")" ::: "memory")
#define PG8_BAR __builtin_amdgcn_s_barrier()
#define PG8_SCHED __builtin_amdgcn_sched_barrier(0)
    Unit cur, nxt; int ui = 0;
    if (!S.next(0, cur)) return;
    f32x4 acc[2][2][4][2];
#pragma unroll
    for (int a = 0; a < 2; ++a)
#pragma unroll
        for (int b = 0; b < 2; ++b)
#pragma unroll
            for (int m = 0; m < 4; ++m)
#pragma unroll
                for (int n = 0; n < 2; ++n) acc[a][b][m][n] = (f32x4){0.f, 0.f, 0.f, 0.f};
    bf16x8 At[4][2], B0[2][2], B1[2][2];
    const char* cA = (const char*)g.A + (size_t)cur.pm * tstep; const char* cB = (const char*)g.Bt + (size_t)cur.pn * tstep;
    S.a_ready(cur);
    if constexpr (SP2) {
        PG8_STAGE(PG8_SB(0, 0), cB, voffB); PG8_STAGE(PG8_SB(0, 1), cB + hstep, voffB); PG8_STAGE(PG8_SA(0, 0), cA, voffA); PG8_STAGE(PG8_SA(0, 1), cA + hstep, voffA);
        if (wr == 1) PG8_BAR;
        PG8_WAIT_V(2); PG8_BAR;
        PG8_STAGE(PG8_SB(1, 0), cB + kstep, voffB); PG8_STAGE(PG8_SA(1, 0), cA + kstep, voffA); PG8_STAGE(PG8_SB(1, 1), cB + hstep + kstep, voffB);
        PG8_WAIT_V(6); PG8_BAR;
    } else {
        PG8_STAGE(PG8_SB(0, 0), cB, voffB); PG8_STAGE(PG8_SA(0, 0), cA, voffA); PG8_STAGE(PG8_SB(0, 1), cB + hstep, voffB); PG8_STAGE(PG8_SA(0, 1), cA + hstep, voffA);
        if (wr == 1) PG8_BAR;
        PG8_WAIT_V(4); PG8_BAR;
        PG8_STAGE(PG8_SB(1, 0), cB + kstep, voffB); PG8_STAGE(PG8_SA(1, 0), cA + kstep, voffA); PG8_STAGE(PG8_SB(1, 1), cB + hstep + kstep, voffB);
        PG8_WAIT_V(6); PG8_BAR;
    }
    for (;;) {
        const bool has_next = S.next(ui + 1, nxt);
        const char* nA = has_next ? (const char*)g.A + (size_t)nxt.pm * tstep : cA; const char* nB = has_next ? (const char*)g.Bt + (size_t)nxt.pn * tstep : cB;
        for (int t = 0; t < nt; t += 2) {
            const bool last = (t == nt - 2);
            const char* a1 = cA + (size_t)(t + 1) * kstep;
            const char* a2 = last ? nA : cA + (size_t)(t + 2) * kstep; const char* b2 = last ? nB : cB + (size_t)(t + 2) * kstep;
            const char* a3 = a2 + kstep; const char* b3 = b2 + kstep;
            if (last && has_next) S.a_ready(nxt);
            if constexpr (SP2) {
            PG8_LDB(B0, 0, 0); PG8_LDB(B1, 0, 1); PG8_SCHED; PG8_LDA(At, 0, 0); PG8_STAGE(PG8_SA(1, 1), a1 + hstep, voffA);
            PG8_WAIT_V(8); PG8_WAIT_L(0); PG8_BAR; PG8_MMA(0, 0, At, B0); PG8_MMA(0, 1, At, B1); PG8_BAR; PG8_SCHED;
            PG8_LDA(At, 0, 1); PG8_STAGE(PG8_SB(0, 0), b2, voffB); PG8_STAGE(PG8_SB(0, 1), b2 + hstep, voffB); PG8_STAGE(PG8_SA(0, 0), a2, voffA);
            PG8_WAIT_V(8); PG8_WAIT_L(0); PG8_BAR; PG8_MMA(1, 0, At, B0); PG8_MMA(1, 1, At, B1); PG8_BAR; PG8_SCHED;
            PG8_LDB(B0, 1, 0); PG8_LDB(B1, 1, 1); PG8_SCHED; PG8_LDA(At, 1, 0); PG8_STAGE(PG8_SA(0, 1), a2 + hstep, voffA);
            PG8_WAIT_V(8); PG8_WAIT_L(0); PG8_BAR; PG8_MMA(0, 0, At, B0); PG8_MMA(0, 1, At, B1); PG8_BAR; PG8_SCHED;
            PG8_LDA(At, 1, 1); PG8_STAGE(PG8_SB(1, 0), b3, voffB); PG8_STAGE(PG8_SB(1, 1), b3 + hstep, voffB); PG8_STAGE(PG8_SA(1, 0), a3, voffA);
            PG8_WAIT_V(8); PG8_WAIT_L(0); PG8_BAR; PG8_MMA(1, 0, At, B0); PG8_MMA(1, 1, At, B1); PG8_BAR; PG8_SCHED;
            } else {
            PG8_LDB(B0, 0, 0); PG8_SCHED; PG8_LDA(At, 0, 0); PG8_STAGE(PG8_SA(1, 1), a1 + hstep, voffA);
            PG8_WAIT_L(8); PG8_BAR; PG8_WAIT_L(0); PG8_MMA(0, 0, At, B0); PG8_BAR; PG8_SCHED;
            PG8_LDB(B1, 0, 1); PG8_STAGE(PG8_SB(0, 0), b2, voffB);
            PG8_BAR; PG8_WAIT_L(0); PG8_MMA(0, 1, At, B1); PG8_BAR;
            PG8_LDA(At, 0, 1); PG8_STAGE(PG8_SA(0, 0), a2, voffA);
            PG8_BAR; PG8_WAIT_L(0); PG8_MMA(1, 0, At, B0); PG8_BAR; PG8_SCHED;
            PG8_STAGE(PG8_SB(0, 1), b2 + hstep, voffB);
            PG8_WAIT_V(6); PG8_BAR; PG8_MMA(1, 1, At, B1); PG8_BAR;
            PG8_LDB(B0, 1, 0); PG8_SCHED; PG8_LDA(At, 1, 0); PG8_STAGE(PG8_SA(0, 1), a2 + hstep, voffA);
            PG8_WAIT_L(8); PG8_BAR; PG8_WAIT_L(0); PG8_MMA(0, 0, At, B0); PG8_BAR; PG8_SCHED;
            PG8_LDB(B1, 1, 1); PG8_STAGE(PG8_SB(1, 0), b3, voffB);
            PG8_BAR; PG8_WAIT_L(0); PG8_MMA(0, 1, At, B1); PG8_BAR;
            PG8_LDA(At, 1, 1); PG8_STAGE(PG8_SA(1, 0), a3, voffA);
            PG8_BAR; PG8_WAIT_L(0); PG8_MMA(1, 0, At, B0); PG8_BAR; PG8_SCHED;
            PG8_STAGE(PG8_SB(1, 1), b3 + hstep, voffB);
            PG8_WAIT_V(6); PG8_BAR; PG8_MMA(1, 1, At, B1); PG8_BAR;
            }
        }
        if constexpr (ALIGN_EPI) { if (wr == 0) PG8_BAR; }
        if constexpr (!Epi::AFTER_DRAIN) { E(acc, cur, wr, wc, fr, fq); S.done(cur); }
        if (!has_next) break;
#pragma unroll
        for (int a = 0; a < 2; ++a)
#pragma unroll
            for (int b = 0; b < 2; ++b)
#pragma unroll
                for (int m = 0; m < 4; ++m)
#pragma unroll
                    for (int n = 0; n < 2; ++n) acc[a][b][m][n] = (f32x4){0.f, 0.f, 0.f, 0.f};
        cur = nxt; cA = nA; cB = nB; ++ui;
        if constexpr (ALIGN_EPI) { if (wr == 1) PG8_BAR; }
    }
    PG8_WAIT_V(0);
    if constexpr (!ALIGN_EPI) { if (wr == 0) PG8_BAR; }
    PG8_BAR;
    if constexpr (Epi::AFTER_DRAIN) { E.fused(acc, cur, wr, wc, fr, fq, lds, wid, lane); S.done(cur); }
#undef PG8_SA
#undef PG8_SB
#undef PG8_STAGE
#undef PG8_LDA
#undef PG8_LDB
#undef PG8_MMA
#undef PG8_WAIT_V
#undef PG8_WAIT_L
#undef PG8_BAR
#undef PG8_SCHED
}
}
#define LAS __attribute__((address_space(3)))

#define XB_TMO      128
#define XB_XCNT(j)  (256  + 64 * (j))
#define XB_XSUB(j)  (1280 + 64 * (j))
#define XB_XGEN(j)  (2304 + 64 * (j))
#define XB_TOP      3328
#define XB_TOPGEN   3392
#define XCD_BAR_WORDS 3456
#define XB_SPIN_CAP (1u << 18)

__device__ __forceinline__ unsigned xb_ld(unsigned* p)              { return __hip_atomic_load(p, __ATOMIC_RELAXED, __HIP_MEMORY_SCOPE_AGENT); }
__device__ __forceinline__ unsigned xb_add(unsigned* p, unsigned v) { return __hip_atomic_fetch_add(p, v, __ATOMIC_RELAXED, __HIP_MEMORY_SCOPE_AGENT); }
__device__ __forceinline__ unsigned xb_xcc_id() { return (unsigned)__builtin_amdgcn_s_getreg((3 << 11) | 20) & 0xFu; }
#define XB_SPIN(cond, bar) do { unsigned _sp = 0; while (cond) { __builtin_amdgcn_s_sleep(1); \
    if ((++_sp & 255u) == 0u) { if (xb_ld(&(bar)[XB_TMO])) break; if (_sp > XB_SPIN_CAP) { atomicAdd(&(bar)[XB_TMO], 1u); break; } } } } while (0)

struct XcdBarrier {
    unsigned* bar; unsigned x;
    volatile LAS unsigned* st;
};

__device__ __forceinline__ XcdBarrier xcd_barrier_post(unsigned* bar, volatile LAS unsigned* st) {
    XcdBarrier b; b.bar = bar; b.x = xb_xcc_id(); b.st = st;
    if (threadIdx.x == 0) (void)xb_add(&bar[XB_XCNT(b.x)], 1u);
    return b;
}
__device__ __forceinline__ void xcd_barrier_complete(unsigned* bar, unsigned x, unsigned& nloc, unsigned& nx) {
    const unsigned G = gridDim.x * gridDim.y * gridDim.z;
    unsigned sum, cnt, mine, sp = 0u;
    for (;;) {
        sum = 0u; cnt = 0u; mine = 0u;
#pragma unroll
        for (unsigned j = 0; j < 16; ++j) { const unsigned c = xb_ld(&bar[XB_XCNT(j)]); sum += c; cnt += (c > 0u) ? 1u : 0u; mine = (j == x) ? c : mine; }
        if (sum == G) break;
        __builtin_amdgcn_s_sleep(1);
        if ((++sp & 255u) == 0u) { if (xb_ld(&bar[XB_TMO])) break; if (sp > XB_SPIN_CAP) { atomicAdd(&bar[XB_TMO], 1u); break; } }
    }
    nloc = mine > 0u ? mine : 1u; nx = cnt > 0u ? cnt : 1u;
}

__device__ __forceinline__ void xcd_barrier(const XcdBarrier& b) {
    asm volatile("s_waitcnt vmcnt(0)" ::: "memory");
    __syncthreads();
    if (threadIdx.x == 0) {
        unsigned* bar = b.bar;
        __builtin_amdgcn_s_waitcnt(0);
        unsigned nloc = b.st[0], nx = b.st[1];
        if (nloc == 0u) { xcd_barrier_complete(bar, b.x, nloc, nx); b.st[0] = nloc; b.st[1] = nx; }
        const unsigned old = xb_add(&bar[XB_XSUB(b.x)], 1u);
        const unsigned gen = old / nloc;
        if (old + 1u == (gen + 1u) * nloc) {
            __builtin_amdgcn_fence(__ATOMIC_RELEASE, "agent");
            asm volatile("s_waitcnt vmcnt(0)" ::: "memory");
            const unsigned og = xb_add(&bar[XB_TOP], 1u);
            const unsigned tg = og / nx;
            if (og + 1u == (tg + 1u) * nx) xb_add(&bar[XB_TOPGEN], 1u);
            else XB_SPIN(xb_ld(&bar[XB_TOPGEN]) == tg, bar);
            __builtin_amdgcn_fence(__ATOMIC_ACQUIRE, "agent");
            xb_add(&bar[XB_XGEN(b.x)], 1u);
            asm volatile("s_waitcnt vmcnt(0)" ::: "memory");
        } else {
            XB_SPIN(xb_ld(&bar[XB_XGEN(b.x)]) == gen, bar);
            __builtin_amdgcn_fence(__ATOMIC_ACQUIRE, "agent");
            asm volatile("s_waitcnt vmcnt(0)" ::: "memory");
        }
    }
    __syncthreads();
}


#ifndef REP_MASK
#define REP_MASK 0
#endif
#ifndef NAIVE_ATTN
#define NAIVE_ATTN 0
#endif
#ifndef NAIVE_SPATIAL
#define NAIVE_SPATIAL 0
#endif

using pg8::bf16_t; using pg8::f32x4; using pg8::Unit; using pg8::u32x4;
typedef unsigned u32x2 __attribute__((ext_vector_type(2)));

constexpr int NLAT = 32768, NCTX = 2048, MTOT = 34816;
constexpr int NTHREADS = 512;
constexpr int LDS_BYTES = 131072 + 16;
constexpr int NPH = 24;

constexpr size_t OFF_W1T = 0;
constexpr size_t OFF_W2T = OFF_W1T + 4ull * 4096 * 1024 * 2;
constexpr size_t OFF_QKVT = OFF_W2T + 4ull * 4096 * 1024 * 2;
constexpr size_t OFF_WOT = OFF_QKVT + 2ull * 3072 * 1024 * 2;
constexpr size_t OFF_WINT = OFF_WOT + 2ull * 1024 * 1024 * 2;
constexpr size_t OFF_SGOT = OFF_WINT + 2ull * 6144 * 1024 * 2;
constexpr size_t OFF_MODS = OFF_SGOT + 2ull * 1024 * 3072 * 2;
constexpr size_t OFF_CTXR = OFF_MODS + 4ull * 9 * 6144 * 4;
constexpr size_t OFF_HB = OFF_CTXR + 2048ull * 1024 * 4;
constexpr size_t OFF_BIG = OFF_HB + 34816ull * 1024 * 2;
constexpr size_t OFF_SSQ = OFF_BIG + 34816ull * 4096 * 2;
constexpr size_t OFF_LNACC = OFF_SSQ + 8ull * 34816 * 4;
constexpr size_t OFF_GS = OFF_LNACC + 2ull * 34816 * 2 * 4;
constexpr size_t OFF_BQKV = OFF_GS + 8ull * 9 * 1024 * 4;
constexpr size_t OFF_BMLP = OFF_BQKV + 2ull * 9 * 3072 * 4;
constexpr size_t OFF_BWIN = OFF_BMLP + 4ull * 9 * 4096 * 4;
constexpr size_t OFF_WSF = OFF_BWIN + 2ull * 9 * 6144 * 4;
constexpr size_t OFF_BAR = OFF_WSF + 2ull * 24 * 16384 * 2;
constexpr size_t WS_END = OFF_BAR + 16384;

struct Params {
    const float *x, *c, *ctx, *c_ctx, *ada_w, *ada_b, *norm1_g, *norm2_g, *mlp_w1, *mlp_w2, *na_w_qkv, *na_q_norm, *na_k_norm, *na_rpb, *na_w_o,
        *sg_w_in, *sg_b_in, *sg_ln_g, *sg_ln_b, *sg_w_s, *sg_b_s, *sg_w_o;
    float* out; unsigned char* ws; int ph_lo, ph_hi;
};

struct Tix { int tid, bid, gsz; };
__device__ __forceinline__ float bf2f(unsigned h) { return __uint_as_float(h << 16); }
__device__ __forceinline__ unsigned f2bf(float f) { unsigned u = __float_as_uint(f); u += 0x7FFFu + ((u >> 16) & 1u); return u >> 16; }
__device__ __forceinline__ unsigned pk2(float lo, float hi) { return pg8::cvt_pk_bf16(lo, hi); }
__device__ __forceinline__ float wave_sum(float v) {
#pragma unroll
    for (int o = 1; o < 64; o <<= 1) v += __shfl_xor(v, o);
    return v;
}
__device__ __forceinline__ float wave_max(float v) {
#pragma unroll
    for (int o = 1; o < 64; o <<= 1) v = fmaxf(v, __shfl_xor(v, o));
    return v;
}
#define LDS_WAIT() asm volatile("s_waitcnt lgkmcnt(0)" ::: "memory")
__device__ __forceinline__ float silu_f(float v) { return v / (1.f + expf(-v)); }
__device__ __forceinline__ float gelu_f(float v) { return 0.5f * v * (1.f + erff(v * 0.70710678118654752f)); }

typedef float f32x2 __attribute__((ext_vector_type(2)));
__device__ __forceinline__ f32x2 gelu_pk(f32x2 v) {
    const f32x2 av = __builtin_elementwise_abs(v), d = av * 0.2316418882f + 1.0f;
    f32x2 t; t.x = __builtin_amdgcn_rcpf(d.x); t.y = __builtin_amdgcn_rcpf(d.y);
    f32x2 q = t * 0.5307027145f + (-0.7265760135f); q = q * t + 0.7107068705f; q = q * t + (-0.142248368f); q = q * t + 0.127414796f; q = q * t;
    const f32x2 s = (v * v) * (-0.72134752044f);
    f32x2 e; e.x = __builtin_amdgcn_exp2f(s.x); e.y = __builtin_amdgcn_exp2f(s.y);
    const f32x2 m = v * (q * e), r = v - m;
    f32x2 o; o.x = v.x < 0.f ? m.x : r.x; o.y = v.y < 0.f ? m.y : r.y; return o;
}
__device__ __forceinline__ f32x4 gelu4(f32x4 v) { const f32x2 a = gelu_pk((f32x2){v.x, v.y}), b = gelu_pk((f32x2){v.z, v.w}); return (f32x4){a.x, a.y, b.x, b.y}; }

__device__ __forceinline__ int sigma_inv(int L) { return 128 * ((L >> 5) & 1) + 32 * (L >> 6) + 16 * ((L >> 2) & 1) + 4 * ((L >> 3) & 3) + (L & 3); }

__device__ __forceinline__ void phase_mods(const Params& p, LAS unsigned char* lds, const Tix T_) {
    LAS float* sc = (LAS float*)lds;
    LAS float* red = (LAS float*)(lds + 36864);
    float* mods = (float*)(p.ws + OFF_MODS);
    const int tid = T_.tid;
    for (int i = tid; i < 9 * 1024; i += NTHREADS) { const int b = i >> 10, k = i & 1023; const float v = b < 8 ? p.c[b * 1024 + k] : p.c_ctx[k]; sc[i] = silu_f(v); }
    __syncthreads();
    const int c4 = (tid & 15) * 4, kk = tid >> 4;
    for (int item = T_.bid; item < 384; item += T_.gsz) {
        const int l = item / 96, n0 = (item % 96) * 64;
        const float* W = p.ada_w + (size_t)l * 1024 * 6144 + n0 + c4;
        f32x4 acc[9];
#pragma unroll
        for (int b = 0; b < 9; ++b) acc[b] = (f32x4){0.f, 0.f, 0.f, 0.f};
#pragma unroll 4
        for (int i = 0; i < 32; ++i) { const int k = kk + 32 * i; const f32x4 w = *(const f32x4*)(W + (size_t)k * 6144);
#pragma unroll
            for (int b = 0; b < 9; ++b) acc[b] += sc[b * 1024 + k] * w; }
#pragma unroll
        for (int b = 0; b < 9; ++b) *(LAS f32x4*)(red + (kk * 9 + b) * 64 + c4) = acc[b];
        __syncthreads();
        for (int o = tid; o < 576; o += NTHREADS) { const int b = o >> 6, cc = o & 63; float s = 0.f;
            for (int j = 0; j < 32; ++j) s += red[(j * 9 + b) * 64 + cc];
            mods[(size_t)(l * 9 + b) * 6144 + n0 + cc] = s + p.ada_b[l * 6144 + n0 + cc]; }
        __syncthreads();
    }
}

struct MatDesc { const float* src; bf16_t* dst; int K, N; };
__device__ __forceinline__ MatDesc get_mat(const Params& p, int mi) {
    MatDesc m;
    if (mi < 4) { m.src = p.mlp_w1 + (size_t)mi * 1024 * 4096; m.dst = (bf16_t*)(p.ws + OFF_W1T) + (size_t)mi * 4096 * 1024; m.K = 1024; m.N = 4096; }
    else if (mi < 8) { const int l = mi - 4; m.src = p.mlp_w2 + (size_t)l * 4096 * 1024; m.dst = (bf16_t*)(p.ws + OFF_W2T) + (size_t)l * 1024 * 4096; m.K = 4096; m.N = 1024; }
    else if (mi < 10) { const int a = mi - 8; m.src = p.na_w_qkv + (size_t)a * 1024 * 3072; m.dst = (bf16_t*)(p.ws + OFF_QKVT) + (size_t)a * 3072 * 1024; m.K = 1024; m.N = 3072; }
    else if (mi < 12) { const int a = mi - 10; m.src = p.na_w_o + (size_t)a * 1024 * 1024; m.dst = (bf16_t*)(p.ws + OFF_WOT) + (size_t)a * 1024 * 1024; m.K = 1024; m.N = 1024; }
    else if (mi < 14) { const int s = mi - 12; m.src = p.sg_w_in + (size_t)s * 1024 * 6144; m.dst = (bf16_t*)(p.ws + OFF_WINT) + (size_t)s * 6144 * 1024; m.K = 1024; m.N = 6144; }
    else { const int s = mi - 14; m.src = p.sg_w_o + (size_t)s * 3072 * 1024; m.dst = (bf16_t*)(p.ws + OFF_SGOT) + (size_t)s * 1024 * 3072; m.K = 3072; m.N = 1024; }
    return m;
}
__device__ __forceinline__ void transpose_item(const float* W, int K, int N, bf16_t* WT, LAS float* scr, int item, int lane) {
    const int nblk = N / 32, kb = item / nblk, nb = item % nblk, k0 = 64 * kb, n0 = 32 * nb;
#pragma unroll 8
    for (int i = 0; i < 32; ++i) { const int kk = 2 * i + (lane >> 5); scr[kk * 33 + (lane & 31)] = W[(size_t)(k0 + kk) * N + n0 + (lane & 31)]; }
    LDS_WAIT();
    const int c = lane & 7;
#pragma unroll
    for (int j = 0; j < 4; ++j) { const int n = (lane >> 3) + 8 * j; const LAS float* s = scr + (8 * c) * 33 + n;
        u32x4 o; o.x = pk2(s[0 * 33], s[1 * 33]); o.y = pk2(s[2 * 33], s[3 * 33]); o.z = pk2(s[4 * 33], s[5 * 33]); o.w = pk2(s[6 * 33], s[7 * 33]);
        const int nl = n0 + n, drow = (nl & ~255) + sigma_inv(nl & 255);
        *(u32x4*)(WT + (size_t)drow * K + k0 + 8 * c) = o; }
    LDS_WAIT();
}
__device__ __forceinline__ void phase_convert(const Params& p, LAS unsigned char* lds, const Tix T_) {
    const int lane = T_.tid & 63, wave = T_.tid >> 6, gw = T_.bid * 8 + wave, NGW = T_.gsz * 8;
    LAS float* scr = (LAS float*)(lds + wave * 8704);
    for (int mi = 0; mi < 16; ++mi) {
        const MatDesc m = get_mat(p, mi);
        const int nitems = (m.K / 64) * (m.N / 32);
        for (int it = gw; it < nitems; it += NGW) transpose_item(m.src, m.K, m.N, m.dst, scr, it, lane);
    }
    { bf16_t* wsf = (bf16_t*)(p.ws + OFF_WSF);
      for (int it = gw; it < 2 * 24 * 4 * 8; it += NGW) { const int ks = it & 7, pt = (it >> 3) & 3, slg = it >> 5;
          const float* wp = p.sg_w_s + (size_t)slg * 16384 + (32 * pt + (lane & 31)) * 128 + 16 * ks + 8 * (lane >> 5);
          const f32x4 x = *(const f32x4*)wp, y = *(const f32x4*)(wp + 4);
          u32x4 o; o.x = pk2(x.x, x.y); o.y = pk2(x.z, x.w); o.z = pk2(y.x, y.y); o.w = pk2(y.z, y.w);
          *(u32x4*)(wsf + (size_t)it * 512 + lane * 8) = o; } }
}


__device__ __forceinline__ void phase_zero(const Params& p, const Tix T_) {
    float* z0 = (float*)(p.ws + OFF_SSQ) + MTOT; const int n0 = 7 * MTOT + 2 * MTOT * 2;
    for (int i = T_.bid * NTHREADS + T_.tid; i < n0; i += T_.gsz * NTHREADS) z0[i] = 0.f;
}
__device__ __forceinline__ void phase_0b(const Params& p, LAS unsigned char* lds, const Tix T_) {
    const float* mods = (const float*)(p.ws + OFF_MODS);
    const int tid = T_.tid, lane = tid & 63, wave = tid >> 6, gw = T_.bid * 8 + wave, NGW = T_.gsz * 8;
    { float* gs = (float*)(p.ws + OFF_GS);
      for (int i = T_.bid * NTHREADS + tid; i < 8 * 9 * 1024; i += T_.gsz * NTHREADS) { const int n = i / 9216, rem = i % 9216, b = rem >> 10, c = rem & 1023, L = n >> 1;
          const float g = (n & 1) ? p.norm2_g[L * 1024 + c] : p.norm1_g[L * 1024 + c];
          gs[i] = g * (1.0f + mods[(size_t)(L * 9 + b) * 6144 + ((n & 1) ? 4096 : 1024) + c]); } }
    { bf16_t* hb = (bf16_t*)(p.ws + OFF_HB); float* ssq0 = (float*)(p.ws + OFF_SSQ);
      for (int row = gw; row < MTOT; row += NGW) {
          const float* xr = row < NLAT ? p.x + (size_t)row * 1024 : p.ctx + (size_t)(row - NLAT) * 1024;
          const int b = row < NLAT ? (row >> 12) : 8;
          f32x4 v[4]; float ss = 0.f;
#pragma unroll
          for (int j = 0; j < 4; ++j) { v[j] = *(const f32x4*)(xr + 4 * lane + 256 * j); ss += (v[j].x * v[j].x + v[j].y * v[j].y) + (v[j].z * v[j].z + v[j].w * v[j].w); }
          ss = wave_sum(ss);
          if (lane == 0) ssq0[row] = ss;
#pragma unroll
          for (int j = 0; j < 4; ++j) { const int col = 4 * lane + 256 * j;
              const f32x4 gv = *(const f32x4*)(p.norm1_g + col), scv = *(const f32x4*)(mods + (size_t)b * 6144 + 1024 + col);
              const f32x4 o = v[j] * gv * (1.0f + scv);
              u32x2 w; w.x = pk2(o.x, o.y); w.y = pk2(o.z, o.w);
              *(u32x2*)(hb + (size_t)row * 1024 + col) = w; } } }
    LAS float* sh = (LAS float*)lds;
    for (int cmb = 0; cmb < 8; ++cmb) {
        int L, shoff, N; const bf16_t* Bt; float* dst; const float* addb = nullptr;
        if (cmb < 2) { L = 2 * cmb; shoff = 0; N = 3072; Bt = (const bf16_t*)(p.ws + OFF_QKVT) + (size_t)cmb * 3072 * 1024; dst = (float*)(p.ws + OFF_BQKV) + (size_t)cmb * 9 * 3072; }
        else if (cmb < 6) { L = cmb - 2; shoff = 3072; N = 4096; Bt = (const bf16_t*)(p.ws + OFF_W1T) + (size_t)L * 4096 * 1024; dst = (float*)(p.ws + OFF_BMLP) + (size_t)L * 9 * 4096; }
        else { const int sl = cmb - 6; L = 2 * sl + 1; shoff = 0; N = 6144; Bt = (const bf16_t*)(p.ws + OFF_WINT) + (size_t)sl * 6144 * 1024; dst = (float*)(p.ws + OFF_BWIN) + (size_t)sl * 9 * 6144; addb = p.sg_b_in + sl * 6144; }
        __syncthreads();
        for (int i = tid; i < 9 * 1024; i += NTHREADS) sh[i] = mods[(size_t)(L * 9 + (i >> 10)) * 6144 + shoff + (i & 1023)];
        __syncthreads();
        for (int n = gw; n < N; n += NGW) {
            const bf16_t* wr_ = Bt + (size_t)((n & ~255) + sigma_inv(n & 255)) * 1024 + lane * 8;
            const u32x4 w0 = *(const u32x4*)wr_, w1 = *(const u32x4*)(wr_ + 512);
            float wv[16];
#pragma unroll
            for (int e = 0; e < 4; ++e) { wv[2 * e] = bf2f(w0[e] & 0xffffu); wv[2 * e + 1] = bf2f(w0[e] >> 16); wv[8 + 2 * e] = bf2f(w1[e] & 0xffffu); wv[8 + 2 * e + 1] = bf2f(w1[e] >> 16); }
            const float ab = addb ? addb[n] : 0.f;
#pragma unroll
            for (int b = 0; b < 9; ++b) {
                const f32x4 s0 = *(const LAS f32x4*)(sh + b * 1024 + lane * 8), s1 = *(const LAS f32x4*)(sh + b * 1024 + lane * 8 + 4);
                const f32x4 s2 = *(const LAS f32x4*)(sh + b * 1024 + 512 + lane * 8), s3 = *(const LAS f32x4*)(sh + b * 1024 + 512 + lane * 8 + 4);
                float a = (wv[0] * s0.x + wv[1] * s0.y) + (wv[2] * s0.z + wv[3] * s0.w) + (wv[4] * s1.x + wv[5] * s1.y) + (wv[6] * s1.z + wv[7] * s1.w)
                        + (wv[8] * s2.x + wv[9] * s2.y) + (wv[10] * s2.z + wv[11] * s2.w) + (wv[12] * s3.x + wv[13] * s3.y) + (wv[14] * s3.z + wv[15] * s3.w);
                a = wave_sum(a);
                if (lane == 0) dst[(size_t)b * N + n] = a + ab; }
        }
    }
}

typedef short s16x4 __attribute__((ext_vector_type(4)));
typedef short s16x8 __attribute__((ext_vector_type(8)));
typedef float f32x16 __attribute__((ext_vector_type(16)));
typedef __bf16 bf16x2_t __attribute__((ext_vector_type(2)));
__device__ __forceinline__ unsigned pkb(float a, float b) { const f32x2 v = {a, b}; const bf16x2_t r = __builtin_convertvector(v, bf16x2_t); return __builtin_bit_cast(unsigned, r); }
__device__ __forceinline__ s16x8 pack8(float a0, float a1, float a2, float a3, float a4, float a5, float a6, float a7) {
    u32x4 w; w.x = pkb(a0, a1); w.y = pkb(a2, a3); w.z = pkb(a4, a5); w.w = pkb(a6, a7); return __builtin_bit_cast(s16x8, w); }
__device__ __forceinline__ s16x8 tr_pair(const LAS unsigned char* a0, int second_off) {
    const s16x4 a = __builtin_amdgcn_ds_read_tr16_b64_v4i16((LAS s16x4*)a0);
    const s16x4 b = __builtin_amdgcn_ds_read_tr16_b64_v4i16((LAS s16x4*)(a0 + second_off));
    s16x8 r; r[0] = a[0]; r[1] = a[1]; r[2] = a[2]; r[3] = a[3]; r[4] = b[0]; r[5] = b[1]; r[6] = b[2]; r[7] = b[3]; return r; }
#define MFMA32(a, b, c) __builtin_amdgcn_mfma_f32_32x32x16_bf16((a), (b), (c), 0, 0, 0)

constexpr int AV_STR = 144;
__device__ __forceinline__ f32x16 attn_qk(const s16x8 (&Kf)[4], const s16x8 (&Qf)[4]) {
    f32x16 S;
#pragma unroll
    for (int i = 0; i < 16; ++i) S[i] = 0.f;
#pragma unroll
    for (int ks = 0; ks < 4; ++ks) S = MFMA32(Kf[ks], Qf[ks], S);
    return S;
}
__device__ __forceinline__ float tabv(const LAS unsigned char* tabrow, int off) { return *(const LAS float*)(tabrow + off); }
__device__ __forceinline__ void attn_one_tile(const s16x8 (&Kf)[4], const s16x8 (&Qf)[4], const LAS unsigned char* vb, const LAS unsigned char* tabrow, const unsigned (&offo)[4], const unsigned offx,
                                              f32x16& O0, f32x16& O1, float& lsum, int mode, float mbl) {
    const f32x16 S = attn_qk(Kf, Qf);
    float pv[16];
    if (mode == 0) {
#pragma unroll
        for (int i = 0; i < 16; ++i) pv[i] = __builtin_amdgcn_exp2f(S[i] - mbl);
    } else if (mode == 1) {
#pragma unroll
        for (int i = 0; i < 16; ++i) pv[i] = __builtin_amdgcn_exp2f(S[i] + tabv(tabrow, (int)((offo[i >> 2] >> (8 * (i & 3))) & 0xffu)));
    } else {
#pragma unroll
        for (int i = 0; i < 16; ++i) pv[i] = 0.f;
        if (mode == 2) {
#pragma unroll
            for (int i = 0; i < 4; ++i) pv[i] = __builtin_amdgcn_exp2f(S[i] + tabv(tabrow, (int)((offx >> (8 * i)) & 0xffu)));
        } else {
#pragma unroll
            for (int i = 0; i < 4; ++i) pv[12 + i] = __builtin_amdgcn_exp2f(S[12 + i] + tabv(tabrow, (int)((offx >> (8 * i)) & 0xffu)));
        }
    }
#pragma unroll
    for (int i = 0; i < 16; ++i) lsum += pv[i];
    const s16x8 P0 = pack8(pv[0], pv[1], pv[2], pv[3], pv[4], pv[5], pv[6], pv[7]), P1 = pack8(pv[8], pv[9], pv[10], pv[11], pv[12], pv[13], pv[14], pv[15]);
    { const s16x8 V00 = tr_pair(vb, 8 * AV_STR), V01 = tr_pair(vb + 64, 8 * AV_STR);
      O0 = MFMA32(V00, P0, O0); O1 = MFMA32(V01, P0, O1); }
    { const s16x8 V10 = tr_pair(vb + 16 * AV_STR, 8 * AV_STR), V11 = tr_pair(vb + 16 * AV_STR + 64, 8 * AV_STR);
      O0 = MFMA32(V10, P1, O0); O1 = MFMA32(V11, P1, O1); }
}
__device__ __forceinline__ void attn_load_k(s16x8 (&Kf)[4], const bf16_t* kbase, int klat0, int kctx0, int kt, int ntl, int rs) {
    const size_t grow = kt < ntl ? (size_t)(klat0 + (rs + (kt >> 1)) * 64 + 32 * (kt & 1)) : (size_t)(kctx0 + 32 * (kt - ntl));
#pragma unroll
    for (int ks = 0; ks < 4; ++ks) Kf[ks] = *(const s16x8*)(kbase + grow * 3072 + 16 * ks);
}
struct AUnit { int b, h, qrow0, r, rs, ntl, ntiles; };
__device__ __forceinline__ AUnit attn_decode(int u, int nlatu) {
    AUnit a;
    if (u < nlatu) { a.h = u & 15; const int br = u >> 4; a.r = br & 63; a.b = br >> 6; a.qrow0 = a.b * 4096 + a.r * 64; a.rs = min(max(a.r - 4, 0), 56); a.ntl = 16; a.ntiles = 24; }
    else { const int v = u - nlatu; a.h = v & 15; const int bq = v >> 4; a.b = bq >> 2; a.qrow0 = NLAT + a.b * 256 + (bq & 3) * 64; a.r = 0; a.rs = 0; a.ntl = 0; a.ntiles = 8; }
    return a;
}
__device__ __forceinline__ u32x4 attn_load_v1(const bf16_t* vbase, const AUnit& a, int idx) {
    const int key = idx >> 3, ch = idx & 7, kt = key >> 5, kk = key & 31;
    const int grow = kt < a.ntl ? (a.b * 4096 + (a.rs + (kt >> 1)) * 64 + 32 * (kt & 1) + kk) : (NLAT + a.b * 256 + 32 * (kt - a.ntl) + kk);
    return *(const u32x4*)(vbase + (size_t)grow * 3072 + ch * 8);
}
__device__ __forceinline__ void attn_load_v(u32x4 (&vpre)[12], const bf16_t* qkv, const AUnit& a, int tid) {
    const bf16_t* vbase = qkv + 2048 + a.h * 64;
#pragma unroll
    for (int i = 0; i < 4; ++i) vpre[i] = attn_load_v1(vbase, a, tid + NTHREADS * i);
    if (a.ntiles == 24) {
#pragma unroll
        for (int i = 4; i < 12; ++i) vpre[i] = attn_load_v1(vbase, a, tid + NTHREADS * i);
    }
}

__device__ __forceinline__ void phase_attn_mfma(const Params& p, int a_, bool ctx_q, LAS unsigned char* lds, const Tix T_) {
    const bf16_t* qkv = (const bf16_t*)(p.ws + OFF_BIG); bf16_t* ao = (bf16_t*)(p.ws + OFF_BIG) + (size_t)MTOT * 3072;
    const float* rpb = p.na_rpb + (size_t)a_ * 16 * 15 * 31;
    const int tid = T_.tid, lane = tid & 63, wave = __builtin_amdgcn_readfirstlane(tid >> 6), qt = wave & 1, kq = wave >> 1, l31 = lane & 31, hi = lane >> 5;
    LAS unsigned char* Vl = lds;
    LAS float* Ored = (LAS float*)lds;
    LAS float* lred = (LAS float*)(lds + 69632);
    LAS float* tab = (LAS float*)(lds + 110592);
    LAS float* misc = (LAS float*)(lds + 110592 + 2048);
    constexpr float LOG2E = 1.4426950408889634f;
    float mb;
    { float m = 0.f; for (int i = tid; i < 7440; i += NTHREADS) m = fmaxf(m, rpb[i]);
      float qg = 0.f, kg = 0.f; if (tid < 64) { qg = fabsf(p.na_q_norm[a_ * 64 + tid]); kg = fabsf(p.na_k_norm[a_ * 64 + tid]); }
      m = wave_max(m); qg = wave_max(qg); kg = wave_max(kg);
      if (lane == 0) { misc[wave] = m; if (wave == 0) { misc[8] = qg; misc[9] = kg; } }
      __syncthreads();
      float rm = misc[0];
#pragma unroll
      for (int w = 1; w < 8; ++w) rm = fmaxf(rm, misc[w]);
      mb = 8.0f * misc[8] * misc[9] + rm; }
    const float mbl = mb * LOG2E;
    const int nlatu = 8 * 64 * 16, total = nlatu + (ctx_q ? 8 * 4 * 16 : 0);
    const int tr_q = (lane & 15) >> 2, tr_p = lane & 3, dgrp = (lane >> 4) & 1;
    const int qcol = 32 * qt + l31, wst = min(max(qcol - 8, 0), 48);
    unsigned offo[4], offx = 0u;
#pragma unroll
    for (int j = 0; j < 4; ++j) { offo[j] = 0u;
#pragma unroll
        for (int i = 0; i < 4; ++i) { const int kcol = 32 * qt + 8 * j + 4 * hi + i; offo[j] |= (unsigned)(((unsigned)(kcol - wst) < 16u ? kcol - qcol + 15 : 31) * 4) << (8 * i); } }
#pragma unroll
    for (int i = 0; i < 4; ++i) { const int kcol = (qt == 0 ? 32 : 24) + 4 * hi + i; offx |= (unsigned)(((unsigned)(kcol - wst) < 16u ? kcol - qcol + 15 : 31) * 4) << (8 * i); }
    int u = T_.bid;
    AUnit cur = attn_decode(min(u, total - 1), nlatu);
    u32x4 vpre[12];
    s16x8 Qf[4], KA[4], KB[4];
    if (u < total) {
        attn_load_v(vpre, qkv, cur, tid);
        const bf16_t* qp = qkv + (size_t)(cur.qrow0 + 32 * qt + l31) * 3072 + cur.h * 64 + 8 * hi;
#pragma unroll
        for (int ks = 0; ks < 4; ++ks) Qf[ks] = *(const s16x8*)(qp + 16 * ks);
        const int t0 = kq * (cur.ntiles >> 2);
        attn_load_k(KA, qkv + 1024 + cur.h * 64 + 8 * hi, cur.b * 4096 + l31, NLAT + cur.b * 256 + l31, t0, cur.ntl, cur.rs);
        attn_load_k(KB, qkv + 1024 + cur.h * 64 + 8 * hi, cur.b * 4096 + l31, NLAT + cur.b * 256 + l31, t0 + 1, cur.ntl, cur.rs);
    }
    while (u < total) {
        const int b = cur.b, h = cur.h, qrow0 = cur.qrow0, r = cur.r, rs = cur.rs, ntl = cur.ntl, ntiles = cur.ntiles;
        int tidl = tid; asm volatile("" : "+v"(tidl));
#pragma unroll
        for (int i = 0; i < 4; ++i) { const int idx = tidl + NTHREADS * i; *(LAS u32x4*)(Vl + (idx >> 3) * AV_STR + (idx & 7) * 16) = vpre[i]; }
        if (ntiles == 24) {
#pragma unroll
            for (int i = 4; i < 12; ++i) { const int idx = tidl + NTHREADS * i; *(LAS u32x4*)(Vl + (idx >> 3) * AV_STR + (idx & 7) * 16) = vpre[i]; } }
        if (tid < 480) { const int rr = tid >> 5, dd = tid & 31; tab[tid] = dd < 31 ? (rpb[h * 465 + rr * 31 + dd] - mb) * LOG2E : -1e30f; }
        const bf16_t* kbase = qkv + 1024 + h * 64 + 8 * hi;
        const int klat0 = b * 4096 + l31, kctx0 = NLAT + b * 256 + l31;
        const int ntw = ntiles >> 2, t0 = kq * ntw;
        __syncthreads();
        f32x16 O0, O1;
#pragma unroll
        for (int i = 0; i < 16; ++i) { O0[i] = 0.f; O1[i] = 0.f; }
        float lsum = 0.f;
#pragma unroll 1
        for (int t = 0; t < ntw; t += 2) {
            { const int kt = t0 + t; const int mode = kt >= ntl ? 0 : ((kt & 1) == qt ? 1 : 2 + qt);
              attn_one_tile(KA, Qf, Vl + (kt * 32 + 4 * hi + tr_q) * AV_STR + (16 * dgrp + 4 * tr_p) * 2, (const LAS unsigned char*)tab + (rs + (kt >> 1) - r + 7) * 128, offo, offx, O0, O1, lsum, mode, mbl); }
            __builtin_amdgcn_sched_barrier(0);
            attn_load_k(KA, kbase, klat0, kctx0, t0 + min(t + 2, ntw - 2), ntl, rs);
            { const int kt = t0 + t + 1; const int mode = kt >= ntl ? 0 : ((kt & 1) == qt ? 1 : 2 + qt);
              attn_one_tile(KB, Qf, Vl + (kt * 32 + 4 * hi + tr_q) * AV_STR + (16 * dgrp + 4 * tr_p) * 2, (const LAS unsigned char*)tab + (rs + (kt >> 1) - r + 7) * 128, offo, offx, O0, O1, lsum, mode, mbl); }
            __builtin_amdgcn_sched_barrier(0);
            attn_load_k(KB, kbase, klat0, kctx0, t0 + min(t + 2, ntw - 2) + 1, ntl, rs);
        }
        const int un = u + T_.gsz;
        const AUnit nxt = attn_decode(min(un, total - 1), nlatu);
        int tidm = tid; asm volatile("" : "+v"(tidm));
        if (un < total) attn_load_v(vpre, qkv, nxt, tidm);
        __syncthreads();
#pragma unroll
        for (int j = 0; j < 4; ++j) {
            *(LAS f32x4*)(Ored + (size_t)((kq * 64 + 32 * qt + l31) * 68 + 8 * j + 4 * hi)) = (f32x4){O0[4 * j], O0[4 * j + 1], O0[4 * j + 2], O0[4 * j + 3]};
            *(LAS f32x4*)(Ored + (size_t)((kq * 64 + 32 * qt + l31) * 68 + 32 + 8 * j + 4 * hi)) = (f32x4){O1[4 * j], O1[4 * j + 1], O1[4 * j + 2], O1[4 * j + 3]}; }
        lred[(kq * 2 + hi) * 64 + 32 * qt + l31] = lsum;
        if (un < total) {
            const bf16_t* qp = qkv + (size_t)(nxt.qrow0 + 32 * qt + l31) * 3072 + nxt.h * 64 + 8 * hi;
#pragma unroll
            for (int ks = 0; ks < 4; ++ks) Qf[ks] = *(const s16x8*)(qp + 16 * ks);
            const int t0n = kq * (nxt.ntiles >> 2);
            attn_load_k(KA, qkv + 1024 + nxt.h * 64 + 8 * hi, nxt.b * 4096 + l31, NLAT + nxt.b * 256 + l31, t0n, nxt.ntl, nxt.rs);
            attn_load_k(KB, qkv + 1024 + nxt.h * 64 + 8 * hi, nxt.b * 4096 + l31, NLAT + nxt.b * 256 + l31, t0n + 1, nxt.ntl, nxt.rs);
        }
        __syncthreads();
        { const int q = tid >> 3, d8 = (tid & 7) * 8;
          f32x4 s0 = (f32x4){0.f, 0.f, 0.f, 0.f}, s1 = s0; float l = 0.f;
#pragma unroll
          for (int k = 0; k < 4; ++k) { s0 += *(const LAS f32x4*)(Ored + (k * 64 + q) * 68 + d8); s1 += *(const LAS f32x4*)(Ored + (k * 64 + q) * 68 + d8 + 4); l += lred[(k * 2) * 64 + q] + lred[(k * 2 + 1) * 64 + q]; }
          const float inv = 1.0f / l;
          u32x4 o; o.x = pkb(s0.x * inv, s0.y * inv); o.y = pkb(s0.z * inv, s0.w * inv); o.z = pkb(s1.x * inv, s1.y * inv); o.w = pkb(s1.z * inv, s1.w * inv);
          *(u32x4*)(ao + (size_t)(qrow0 + q) * 1024 + h * 64 + d8) = o; }
        __syncthreads();
        u = un; cur = nxt;
    }
}

constexpr int SP_RS = 320;
__device__ __forceinline__ void phase_spatial_mfma(const Params& p, int sl, int M, LAS unsigned char* lds, const Tix T_, const bool dummy = false) {
    bf16_t* vb = (bf16_t*)(p.ws + OFF_BIG); const float* lnacc = (const float*)(p.ws + OFF_LNACC) + (size_t)sl * MTOT * 2;
    const float* lng = p.sg_ln_g + sl * 3072; const float* lnb = p.sg_ln_b + sl * 3072;
    const int tid = T_.tid, lane = tid & 63, wave = __builtin_amdgcn_readfirstlane(tid >> 6), pt = wave & 3, cth = wave >> 2, l31 = lane & 31, hi = lane >> 5;
    const int tr_q = (lane & 15) >> 2, tr_p = lane & 3, dgrp = (lane >> 4) & 1;
    const int nunits = (M / 128) * 24;
    const int c8 = (tid & 15) * 8;
    s16x8 wx[8]; u32x4 vw[4]; f32x2 st2[4]; f32x4 g0, g1, b0, b1; float bs;
    const bf16_t* wsf = (const bf16_t*)(p.ws + OFF_WSF);
#define SP_LOAD(uu) do { const int nc_ = (uu) / 24, g_ = (uu) % 24, r0_ = nc_ * 128; \
        const bf16_t* wp_ = wsf + ((size_t)((sl * 24 + g_) * 4 + pt) * 8) * 512 + lane * 8; \
        _Pragma("unroll") for (int ks = 0; ks < 8; ++ks) wx[ks] = *(const s16x8*)(wp_ + ks * 512); \
        _Pragma("unroll") for (int i = 0; i < 4; ++i) { const int q_ = (tid + NTHREADS * i) >> 4; \
            vw[i] = *(const u32x4*)(vb + (size_t)(r0_ + q_) * 3072 + g_ * 128 + c8); st2[i] = *(const f32x2*)(lnacc + 2 * (r0_ + q_)); } \
        g0 = *(const f32x4*)(lng + g_ * 128 + c8); g1 = *(const f32x4*)(lng + g_ * 128 + c8 + 4); b0 = *(const f32x4*)(lnb + g_ * 128 + c8); b1 = *(const f32x4*)(lnb + g_ * 128 + c8 + 4); \
        bs = p.sg_b_s[((size_t)sl * 24 + g_) * 128 + 32 * pt + l31]; } while (0)
    int u = T_.bid, buf = 0;
    if (u < nunits) SP_LOAD(u);
    while (u < nunits) {
        const int nc = u / 24, g = u % 24, r0 = nc * 128;
        LAS unsigned char* tile = lds + buf * (128 * SP_RS);
#pragma unroll
        for (int i = 0; i < 4; ++i) { const int q = (tid + NTHREADS * i) >> 4; const u32x4 w = vw[i];
            const float mean = st2[i].x * (1.0f / 3072.0f), rstd = 1.0f / sqrtf(fmaxf(st2[i].y * (1.0f / 3072.0f) - mean * mean, 0.f) + 1e-6f);
            u32x4 o;
            o.x = pkb((bf2f(w.x & 0xffffu) - mean) * rstd * g0.x + b0.x, (bf2f(w.x >> 16) - mean) * rstd * g0.y + b0.y);
            o.y = pkb((bf2f(w.y & 0xffffu) - mean) * rstd * g0.z + b0.z, (bf2f(w.y >> 16) - mean) * rstd * g0.w + b0.w);
            o.z = pkb((bf2f(w.z & 0xffffu) - mean) * rstd * g1.x + b1.x, (bf2f(w.z >> 16) - mean) * rstd * g1.y + b1.y);
            o.w = pkb((bf2f(w.w & 0xffffu) - mean) * rstd * g1.z + b1.z, (bf2f(w.w >> 16) - mean) * rstd * g1.w + b1.w);
            *(LAS u32x4*)(tile + q * SP_RS + c8 * 2) = o; }
        s16x8 Wf[8];
#pragma unroll
        for (int ks = 0; ks < 8; ++ks) Wf[ks] = wx[ks];
        const float bsc = bs;
        __syncthreads();
        const int un = u + T_.gsz;
        if (un < nunits) SP_LOAD(un);
        __builtin_amdgcn_sched_barrier(0);
#pragma unroll
        for (int cc = 0; cc < 2; ++cc) { const int ct = 2 * cth + cc;
            f32x16 acc;
#pragma unroll
            for (int i = 0; i < 16; ++i) acc[i] = 0.f;
            const LAS unsigned char* ab = tile + (8 * hi + tr_q) * SP_RS + (32 * ct + 16 * dgrp + 4 * tr_p) * 2;
#pragma unroll
            for (int ks = 0; ks < 8; ++ks) { const s16x8 Af = tr_pair(ab + 16 * ks * SP_RS, 4 * SP_RS); acc = MFMA32(Af, Wf[ks], acc); }
            bf16_t* orow = (dummy ? vb + (size_t)MTOT * 3072 + (size_t)((r0 + 32 * pt + l31) & 8191) * 3072 : vb + (size_t)(r0 + 32 * pt + l31) * 3072) + g * 128 + 32 * ct + 4 * hi;
#pragma unroll
            for (int j = 0; j < 4; ++j) { u32x2 o; o.x = pkb(acc[4 * j] + bsc, acc[4 * j + 1] + bsc); o.y = pkb(acc[4 * j + 2] + bsc, acc[4 * j + 3] + bsc); *(u32x2*)(orow + 8 * j) = o; }
        }
        u = un; buf ^= 1;
    }
#undef SP_LOAD
    __syncthreads();
}

template <class F> struct EpiG {
    static constexpr bool PERM = false, AFTER_DRAIN = false;
    F f;
    __device__ __forceinline__ void operator()(const f32x4 (&acc)[2][2][4][2], const Unit& u, int wr, int wc, int fr, int fq) const {
        F g = f; const int colb = u.pn * 256 + 64 * wc + 8 * fq, rowbase = u.pm * 256 + wr * 64 + fr;
        g.begin(u, colb, fq, rowbase);
#ifdef EPI_TWICE
        if (F::IDEMP) {
#pragma unroll
        for (int ai = 0; ai < 2; ++ai)
#pragma unroll
            for (int m = 0; m < 4; ++m) {
                g.row(ai * 4 + m, rowbase + ai * 128 + m * 16, colb, acc[ai][0][m][0], acc[ai][0][m][1], acc[ai][1][m][0], acc[ai][1][m][1]);
                asm volatile("" ::: "memory"); }
        }
#endif
#pragma unroll
        for (int ai = 0; ai < 2; ++ai)
#pragma unroll
            for (int m = 0; m < 4; ++m) {
                g.row(ai * 4 + m, rowbase + ai * 128 + m * 16, colb, acc[ai][0][m][0], acc[ai][0][m][1], acc[ai][1][m][0], acc[ai][1][m][1]);
                asm volatile("" ::: "memory"); }
    }
};
__device__ __forceinline__ int epi_row(int rowbase, int idx) { return rowbase + 128 * (idx >> 2) + 16 * (idx & 3); }
__device__ __forceinline__ void store8_bf16(bf16_t* o, const f32x4 a, const f32x4 b) { u32x4 w; w.x = pk2(a.x, a.y); w.y = pk2(a.z, a.w); w.z = pk2(b.x, b.y); w.w = pk2(b.z, b.w); *(u32x4*)o = w; }
__device__ __forceinline__ float sumsq4(const f32x4 x) { return (x.x * x.x + x.y * x.y) + (x.z * x.z + x.w * x.w); }
__device__ __forceinline__ float sum4(const f32x4 x) { return (x.x + x.y) + (x.z + x.w); }
__device__ __forceinline__ float rstd_from(float ssq) { return 1.0f / sqrtf(ssq * (1.0f / 1024.0f) + 1e-6f); }
__device__ __forceinline__ void atomic_addf(float* p, float v) { __hip_atomic_fetch_add(p, v, __ATOMIC_RELAXED, __HIP_MEMORY_SCOPE_AGENT); }
struct RowSsq { float v[8];
    __device__ __forceinline__ void load(const float* ssq, int rowbase) {
#pragma unroll
        for (int i = 0; i < 8; ++i) v[i] = ssq[epi_row(rowbase, i)]; } };

struct FQKV { static constexpr bool IDEMP = true; bf16_t* O; const float* qg; const float* kg; const float* ssq; const float* bias;
    f32x4 gn[4], bz[4]; int sect; RowSsq rq;
    __device__ __forceinline__ void begin(const Unit& u, int colb, int fq, int rowbase) {
        rq.load(ssq, rowbase);
        sect = u.pn >> 2; const int b = min(u.pm >> 4, 8); const float* bp = bias + (size_t)b * 3072 + colb;
        bz[0] = *(const f32x4*)bp; bz[1] = *(const f32x4*)(bp + 4); bz[2] = *(const f32x4*)(bp + 32); bz[3] = *(const f32x4*)(bp + 36);
        if (sect < 2) { const float* gp = (sect == 0 ? qg : kg) + 8 * fq; const float mul = sect == 0 ? 0.125f * 1.4426950408889634f : 1.0f;
            gn[0] = *(const f32x4*)gp * mul; gn[1] = *(const f32x4*)(gp + 4) * mul; gn[2] = *(const f32x4*)(gp + 32) * mul; gn[3] = *(const f32x4*)(gp + 36) * mul; } }
    __device__ __forceinline__ void row(int idx, int row, int colb, f32x4 a0, f32x4 b0, f32x4 a1, f32x4 b1) {
        const float rs = rstd_from(rq.v[idx]);
        a0 = a0 * rs + bz[0]; b0 = b0 * rs + bz[1]; a1 = a1 * rs + bz[2]; b1 = b1 * rs + bz[3];
        if (sect < 2) { float ss = (sumsq4(a0) + sumsq4(b0)) + (sumsq4(a1) + sumsq4(b1));
            ss += __shfl_xor(ss, 16); ss += __shfl_xor(ss, 32);
            const float r2 = 1.0f / sqrtf(ss * (1.0f / 64.0f) + 1e-6f);
            a0 = a0 * r2 * gn[0]; b0 = b0 * r2 * gn[1]; a1 = a1 * r2 * gn[2]; b1 = b1 * r2 * gn[3]; }
        bf16_t* op = O + (size_t)row * 3072 + colb; store8_bf16(op, a0, b0); store8_bf16(op + 32, a1, b1); } };
struct FSqrelu { static constexpr bool IDEMP = true; bf16_t* O; const float* ssq; const float* bias;
    f32x4 bz[4]; RowSsq rq;
    __device__ __forceinline__ void begin(const Unit& u, int colb, int fq, int rowbase) { rq.load(ssq, rowbase); const int b = min(u.pm >> 4, 8); const float* bp = bias + (size_t)b * 4096 + colb;
        bz[0] = *(const f32x4*)bp; bz[1] = *(const f32x4*)(bp + 4); bz[2] = *(const f32x4*)(bp + 32); bz[3] = *(const f32x4*)(bp + 36); }
    __device__ __forceinline__ void row(int idx, int row, int colb, f32x4 a0, f32x4 b0, f32x4 a1, f32x4 b1) {
        const float rs = rstd_from(rq.v[idx]); const f32x4 z = (f32x4){0.f, 0.f, 0.f, 0.f};
        a0 = __builtin_elementwise_max(a0 * rs + bz[0], z); b0 = __builtin_elementwise_max(b0 * rs + bz[1], z); a1 = __builtin_elementwise_max(a1 * rs + bz[2], z); b1 = __builtin_elementwise_max(b1 * rs + bz[3], z);
        bf16_t* op = O + (size_t)row * 4096 + colb; store8_bf16(op, a0 * a0, b0 * b0); store8_bf16(op + 32, a1 * a1, b1 * b1); } };
struct FGeluV { static constexpr bool IDEMP = false; bf16_t* O; const float* ssq; const float* bias; float* lnacc;
    f32x4 bz[4]; int fq_; RowSsq rq;
    __device__ __forceinline__ void begin(const Unit& u, int colb, int fq, int rowbase) { rq.load(ssq, rowbase); const int b = min(u.pm >> 4, 8); const float* bp = bias + (size_t)b * 6144 + colb; fq_ = fq;
        bz[0] = *(const f32x4*)bp; bz[1] = *(const f32x4*)(bp + 4); bz[2] = *(const f32x4*)(bp + 32); bz[3] = *(const f32x4*)(bp + 36); }
    __device__ __forceinline__ void row(int idx, int row, int colb, f32x4 a0, f32x4 b0, f32x4 a1, f32x4 b1) {
        const float rs = rstd_from(rq.v[idx]);
        a0 = gelu4(a0 * rs + bz[0]); b0 = gelu4(b0 * rs + bz[1]); a1 = gelu4(a1 * rs + bz[2]); b1 = gelu4(b1 * rs + bz[3]);
        bf16_t* op = O + (size_t)row * 3072 + colb; store8_bf16(op, a0, b0); store8_bf16(op + 32, a1, b1);
        float s1 = (sum4(a0) + sum4(b0)) + (sum4(a1) + sum4(b1)), s2 = (sumsq4(a0) + sumsq4(b0)) + (sumsq4(a1) + sumsq4(b1));
        s1 += __shfl_xor(s1, 16); s1 += __shfl_xor(s1, 32); s2 += __shfl_xor(s2, 16); s2 += __shfl_xor(s2, 32);
        if (fq_ == 0) { atomic_addf(lnacc + 2 * (size_t)row, s1); atomic_addf(lnacc + 2 * (size_t)row + 1, s2); } } };
struct FGeluU { static constexpr bool IDEMP = false; bf16_t* O; const float* ssq; const float* bias;
    f32x4 bz[4]; RowSsq rq; u32x4 sv[2][2]; int rowbase_;
    __device__ __forceinline__ void fetch(int idx, int colb) { const bf16_t* op = O + (size_t)epi_row(rowbase_, idx) * 3072 + colb; sv[idx & 1][0] = *(const u32x4*)op; sv[idx & 1][1] = *(const u32x4*)(op + 32); }
    __device__ __forceinline__ void begin(const Unit& u, int colb, int fq, int rowbase) { rq.load(ssq, rowbase); rowbase_ = rowbase; fetch(0, colb);
        const int b = min(u.pm >> 4, 8); const float* bp = bias + (size_t)b * 6144 + colb;
        bz[0] = *(const f32x4*)bp; bz[1] = *(const f32x4*)(bp + 4); bz[2] = *(const f32x4*)(bp + 32); bz[3] = *(const f32x4*)(bp + 36); }
    __device__ __forceinline__ static f32x4 lo4(const u32x4 s) { return (f32x4){bf2f(s.x & 0xffffu), bf2f(s.x >> 16), bf2f(s.y & 0xffffu), bf2f(s.y >> 16)}; }
    __device__ __forceinline__ static f32x4 hi4(const u32x4 s) { return (f32x4){bf2f(s.z & 0xffffu), bf2f(s.z >> 16), bf2f(s.w & 0xffffu), bf2f(s.w >> 16)}; }
    __device__ __forceinline__ void row(int idx, int row, int colb, f32x4 a0, f32x4 b0, f32x4 a1, f32x4 b1) {
        if (idx < 7) fetch(idx + 1, colb);
        const float rs = rstd_from(rq.v[idx]);
        bf16_t* op = O + (size_t)row * 3072 + colb; const u32x4 sv0 = sv[idx & 1][0], sv1 = sv[idx & 1][1];
        a0 = gelu4(a0 * rs + bz[0]) * lo4(sv0); b0 = gelu4(b0 * rs + bz[1]) * hi4(sv0); a1 = gelu4(a1 * rs + bz[2]) * lo4(sv1); b1 = gelu4(b1 * rs + bz[3]) * hi4(sv1);
        store8_bf16(op, a0, b0); store8_bf16(op + 32, a1, b1); } };
struct FResid { static constexpr bool IDEMP = false; const float* inl; const float* inc; float* outl; float* outc; const float* gate;
    const float* gsn; bf16_t* xb; float* ssqn;
    f32x4 gz[4], gsz[4], xin[2][4]; int fq_, rowbase_;
    __device__ __forceinline__ void fetch(int idx, int colb) { const int row = epi_row(rowbase_, idx);
        const float* ip = row < NLAT ? inl + (size_t)row * 1024 + colb : inc + (size_t)(row - NLAT) * 1024 + colb;
        xin[idx & 1][0] = *(const f32x4*)ip; xin[idx & 1][1] = *(const f32x4*)(ip + 4); xin[idx & 1][2] = *(const f32x4*)(ip + 32); xin[idx & 1][3] = *(const f32x4*)(ip + 36); }
    __device__ __forceinline__ void begin(const Unit& u, int colb, int fq, int rowbase) { const int b = min(u.pm >> 4, 8); fq_ = fq; rowbase_ = rowbase; fetch(0, colb);
        const float* gp = gate + (size_t)b * 6144 + colb;
        gz[0] = *(const f32x4*)gp; gz[1] = *(const f32x4*)(gp + 4); gz[2] = *(const f32x4*)(gp + 32); gz[3] = *(const f32x4*)(gp + 36);
        if (gsn) { const float* sp = gsn + (size_t)b * 1024 + colb; gsz[0] = *(const f32x4*)sp; gsz[1] = *(const f32x4*)(sp + 4); gsz[2] = *(const f32x4*)(sp + 32); gsz[3] = *(const f32x4*)(sp + 36); } }
    __device__ __forceinline__ void row(int idx, int row, int colb, f32x4 a0, f32x4 b0, f32x4 a1, f32x4 b1) {
        if (idx < 7) fetch(idx + 1, colb);
        float* op = row < NLAT ? outl + (size_t)row * 1024 + colb : outc + (size_t)(row - NLAT) * 1024 + colb;
        a0 = xin[idx & 1][0] + gz[0] * a0; b0 = xin[idx & 1][1] + gz[1] * b0; a1 = xin[idx & 1][2] + gz[2] * a1; b1 = xin[idx & 1][3] + gz[3] * b1;
        *(f32x4*)op = a0; *(f32x4*)(op + 4) = b0; *(f32x4*)(op + 32) = a1; *(f32x4*)(op + 36) = b1;
        if (gsn) { float ss = (sumsq4(a0) + sumsq4(b0)) + (sumsq4(a1) + sumsq4(b1));
            ss += __shfl_xor(ss, 16); ss += __shfl_xor(ss, 32);
            if (fq_ == 0) atomic_addf(ssqn + row, ss);
            bf16_t* xp = xb + (size_t)row * 1024 + colb; store8_bf16(xp, a0 * gsz[0], b0 * gsz[1]); store8_bf16(xp + 32, a1 * gsz[2], b1 * gsz[3]); } } };

template <class F> __device__ __forceinline__ void run_gemm(LAS unsigned char* lds, const bf16_t* A, const bf16_t* Bt, int M, int N, int K, const F& f, const Tix T_) {
    pg8::StaticOrder S; S.init(M, N, T_.gsz, T_.bid);
    pg8::Gemm g; g.A = A; g.Bt = Bt; g.M = M; g.N = N; g.K = K;
    EpiG<F> E; E.f = f;
    pg8::gemm_phase<EpiG<F>, pg8::StaticOrder, true, true>(lds, g, S, E, T_.tid);
}

enum { OP_QKV, OP_ATTN, OP_MIXOUT, OP_MLP1, OP_MLP2, OP_VGEMM, OP_SPATIAL, OP_UGEMM, OP_PROLOGUE, OP_PHASE0B };

__device__ __forceinline__ void decode_phase(int ph, int& L, int& op) {
    L = 0; op = ph == 0 ? OP_PROLOGUE : OP_PHASE0B;
    if (ph > 1) {
        int q = ph - 2;
        if (q < 5) { L = 0; } else if (q < 11) { L = 1; q -= 5; } else if (q < 16) { L = 2; q -= 11; } else { L = 3; q -= 16; }
        if ((L & 1) == 0) op = q == 0 ? OP_QKV : q == 1 ? OP_ATTN : q == 2 ? OP_MIXOUT : q == 3 ? OP_MLP1 : OP_MLP2;
        else op = q == 0 ? OP_VGEMM : q == 1 ? OP_SPATIAL : q == 2 ? OP_UGEMM : q == 3 ? OP_MIXOUT : q == 4 ? OP_MLP1 : OP_MLP2;
    }
}

__device__ __forceinline__ void run_phase(const Params& p, int ph, LAS unsigned char* lds, const Tix T_) {
    int L, op; decode_phase(ph, L, op);
#ifdef ONLY_OP
    op = ONLY_OP;
#endif
    const int mi = L >> 1;
    const bool attnL = (L & 1) == 0;
    const int Mfull = L < 2 ? MTOT : NLAT;
    const float* modsl = (const float*)(p.ws + OFF_MODS) + (size_t)L * 9 * 6144;
    float* ctxr = (float*)(p.ws + OFF_CTXR);
    bf16_t* hb = (bf16_t*)(p.ws + OFF_HB); bf16_t* big = (bf16_t*)(p.ws + OFF_BIG);
    float* ssq = (float*)(p.ws + OFF_SSQ); const float* gs = (const float*)(p.ws + OFF_GS);
    const bool first = (L == 0);
    switch (op) {
    case OP_PROLOGUE: phase_zero(p, T_); phase_mods(p, lds, T_); __syncthreads(); phase_convert(p, lds, T_); break;
    case OP_PHASE0B: phase_0b(p, lds, T_); break;
    case OP_QKV: { FQKV f; f.O = big; f.qg = p.na_q_norm + mi * 64; f.kg = p.na_k_norm + mi * 64; f.ssq = ssq + (size_t)(2 * L) * MTOT; f.bias = (const float*)(p.ws + OFF_BQKV) + (size_t)mi * 9 * 3072;
        run_gemm(lds, hb, (const bf16_t*)(p.ws + OFF_QKVT) + (size_t)mi * 3072 * 1024, MTOT, 3072, 1024, f, T_); } break;
    case OP_ATTN: phase_attn_mfma(p, mi, L == 0, lds, T_); break;
    case OP_MIXOUT: case OP_MLP2: {
        FResid f; const bool mo = (op == OP_MIXOUT);
        f.inl = (first && mo) ? p.x : p.out; f.inc = (first && mo) ? p.ctx : ctxr; f.outl = p.out; f.outc = ctxr; f.gate = modsl + (mo ? 2048 : 5120);
        const int nn = mo ? 2 * L + 1 : 2 * L + 2;
        const bool has_next = nn < 8 && !(nn == 6 + 0 && false);
        f.gsn = has_next ? gs + (size_t)nn * 9 * 1024 : nullptr; f.xb = hb; f.ssqn = ssq + (size_t)(has_next ? nn : 0) * MTOT;
        const bf16_t* A; const bf16_t* Bt; int K;
        if (!mo) { A = big; Bt = (const bf16_t*)(p.ws + OFF_W2T) + (size_t)L * 1024 * 4096; K = 4096; }
        else if (attnL) { A = big + (size_t)MTOT * 3072; Bt = (const bf16_t*)(p.ws + OFF_WOT) + (size_t)mi * 1024 * 1024; K = 1024; }
        else { A = big; Bt = (const bf16_t*)(p.ws + OFF_SGOT) + (size_t)mi * 1024 * 3072; K = 3072; }
        run_gemm(lds, A, Bt, Mfull, 1024, K, f, T_); } break;
    case OP_MLP1: { FSqrelu f; f.O = big; f.ssq = ssq + (size_t)(2 * L + 1) * MTOT; f.bias = (const float*)(p.ws + OFF_BMLP) + (size_t)L * 9 * 4096;
        run_gemm(lds, hb, (const bf16_t*)(p.ws + OFF_W1T) + (size_t)L * 4096 * 1024, Mfull, 4096, 1024, f, T_); } break;
    case OP_VGEMM: { FGeluV f; f.O = big; f.ssq = ssq + (size_t)(2 * L) * MTOT; f.bias = (const float*)(p.ws + OFF_BWIN) + (size_t)mi * 9 * 6144 + 3072; f.lnacc = (float*)(p.ws + OFF_LNACC) + (size_t)mi * MTOT * 2;
        run_gemm(lds, hb, (const bf16_t*)(p.ws + OFF_WINT) + (size_t)mi * 6144 * 1024 + (size_t)3072 * 1024, Mfull, 3072, 1024, f, T_); } break;
#ifdef REP_SPATIAL
    case OP_SPATIAL: phase_spatial_mfma(p, mi, Mfull, lds, T_, true); __syncthreads(); phase_spatial_mfma(p, mi, Mfull, lds, T_); break;
#else
    case OP_SPATIAL: phase_spatial_mfma(p, mi, Mfull, lds, T_); break;
#endif
    case OP_UGEMM: { FGeluU f; f.O = big; f.ssq = ssq + (size_t)(2 * L) * MTOT; f.bias = (const float*)(p.ws + OFF_BWIN) + (size_t)mi * 9 * 6144;
        run_gemm(lds, hb, (const bf16_t*)(p.ws + OFF_WINT) + (size_t)mi * 6144 * 1024, Mfull, 3072, 1024, f, T_); } break;
    default: break;
    }
}

#ifndef ONE_LAUNCH
#define ONE_LAUNCH 1
#endif
__global__ void __launch_bounds__(NTHREADS) mk(Params p0) {
    extern __shared__ __attribute__((aligned(16))) unsigned char lds_raw[];
    LAS unsigned char* lds = (LAS unsigned char*)lds_raw;
#if ONE_LAUNCH
    cg::grid_group grid = cg::this_grid();
    if (p0.ph_lo < 0) grid.sync();
    volatile LAS unsigned* st = (volatile LAS unsigned*)(lds + 131072);
    if (threadIdx.x == 0) { st[0] = 0u; st[1] = 0u; }
    __syncthreads();
    const XcdBarrier xbar = xcd_barrier_post((unsigned*)(p0.ws + OFF_BAR), st);
    bool first_it = true, repeated = false;
    for (int ph = p0.ph_lo; ph < p0.ph_hi; ) {
        if (!first_it) xcd_barrier(xbar);
        first_it = false;
        Tix T_; T_.tid = threadIdx.x; T_.bid = blockIdx.x; T_.gsz = gridDim.x;
        size_t z = 0;
        asm volatile("" : "+v"(T_.tid)); asm volatile("" : "+s"(T_.bid), "+s"(T_.gsz), "+s"(z));
        Params p = p0;
        { const float** pp = (const float**)&p;
#pragma unroll
          for (int i = 0; i < 22; ++i) pp[i] += z; }
        p.out += z; p.ws += z;
        run_phase(p, ph, lds, T_);
        __syncthreads();
        if (REP_MASK != 0) { int L_, op_; decode_phase(ph, L_, op_); if (((REP_MASK >> op_) & 1) && !repeated) { repeated = true; continue; } }
        repeated = false; ++ph;
    }
#else
    Tix T_; T_.tid = threadIdx.x; T_.bid = blockIdx.x; T_.gsz = gridDim.x;
    run_phase(p0, p0.ph_lo, lds, T_);
#endif
}

extern "C" void kernel_launch(void* const* d_in, const int* in_sizes, int n_in, void* d_out, int out_size, void* d_ws, size_t ws_size, hipStream_t stream) {
    static int grid = 0;
    if (grid == 0) {
        if (n_in != 22 || ws_size < WS_END) { fprintf(stderr, "kernel_launch: unexpected n_in %d or ws_size %zu (< %zu)\n", n_in, ws_size, (size_t)WS_END); grid = -1; return; }
        int dev = 0, cus = 0, per_cu = 0;
        hipGetDevice(&dev); hipDeviceGetAttribute(&cus, hipDeviceAttributeMultiprocessorCount, dev);
        if (hipFuncSetAttribute((const void*)mk, hipFuncAttributeMaxDynamicSharedMemorySize, LDS_BYTES) != hipSuccess) { fprintf(stderr, "kernel_launch: hipFuncSetAttribute failed\n"); grid = -1; return; }
        if (hipOccupancyMaxActiveBlocksPerMultiprocessor(&per_cu, (const void*)mk, NTHREADS, LDS_BYTES) != hipSuccess || per_cu < 1) { fprintf(stderr, "kernel_launch: occupancy query says %d\n", per_cu); per_cu = 1; }
        (void)hipGetLastError();
        grid = cus;
    }
    if (grid < 0) return;
    if (hipMemsetAsync((unsigned char*)d_ws + OFF_BAR, 0, 16384, stream) != hipSuccess) { fprintf(stderr, "kernel_launch: memset of the barrier words failed\n"); return; }
    Params p{};
    const float** pp = (const float**)&p;
    for (int i = 0; i < 22; ++i) pp[i] = (const float*)d_in[i];
    p.out = (float*)d_out; p.ws = (unsigned char*)d_ws;
#if ONE_LAUNCH
    p.ph_lo = 0; p.ph_hi = NPH;
    void* args[] = {&p};
    hipError_t e = hipLaunchCooperativeKernel((void*)mk, dim3(grid), dim3(NTHREADS), args, LDS_BYTES, stream);
    if (e != hipSuccess) fprintf(stderr, "cooperative launch failed: %s (grid %d)\n", hipGetErrorString(e), grid);
#else
    for (int ph = 0; ph < NPH; ++ph) { p.ph_lo = ph; p.ph_hi = ph + 1; hipLaunchKernelGGL(mk, dim3(grid), dim3(NTHREADS), LDS_BYTES, stream, p); }
#endif
}
```

```cpp
#include <hip/hip_runtime.h>
#include <hip/hip_cooperative_groups.h>
#include <cstdio>
#include <cstdint>
namespace cg = cooperative_groups;
namespace pg8 {
#define PG8_LAS __attribute__((address_space(3)))
typedef unsigned short bf16_t;
typedef short bf16x8 __attribute__((ext_vector_type(8)));
typedef float f32x4 __attribute__((ext_vector_type(4)));
typedef unsigned u32x4 __attribute__((ext_vector_type(4)));
constexpr int BM = 256, BK = 64, HALF = 128, HTB = HALF * BK * 2  , STAGE_BYTES = 8 * HTB, NXCD = 8, WGM = 8;

__host__ __device__ __forceinline__ int lds_byte(int r, int c) { const int st = (r >> 4) * 2 + (c >> 5), rr = r & 15, cc = c & 31, ob = rr * 64 + cc * 2; return st * 1024 + (ob ^ (((ob >> 9) & 1) << 5)); }
__host__ __device__ __forceinline__ void stage_rc(int b, int& R, int& C) { const int st = b / 1024, sb = b % 1024, swz = sb ^ (((sb >> 9) & 1) << 5); R = (st >> 1) * 16 + swz / 64; C = (st & 1) * 32 + (swz % 64) / 2; }
__host__ __device__ __forceinline__ int perm32(int rho) { const int n = rho >> 4, i = rho & 15; return 8 * (i >> 2) + 4 * n + (i & 3); }

struct Unit { int pm, pn; };
struct Gemm { const bf16_t* A; const bf16_t* Bt; int M, N, K; };

struct StaticOrder {
    int nM, nN, nwg, G, c;
    __host__ __device__ void init(int M, int N, int G_, int c_) { nM = M / BM; nN = N / BM; nwg = nM * nN; G = G_; c = c_; }
    __host__ __device__ bool next(int i, Unit& u) const {
        const long L = (long)i * G + c; if (L >= nwg) return false;
        int wgid = (int)L; { const int q = nwg / NXCD, r = nwg % NXCD, xcd = wgid % NXCD, off = wgid / NXCD; wgid = (xcd < r ? xcd * (q + 1) : r * (q + 1) + (xcd - r) * q) + off; }
        const int nig = WGM * nN, gid = wgid / nig, fm = gid * WGM, gsz = (nM - fm) < WGM ? (nM - fm) : WGM;
        u.pm = fm + ((wgid % nig) % gsz); u.pn = (wgid % nig) / gsz; return true;
    }
    __device__ __forceinline__ void a_ready(const Unit&) const {}
    __device__ __forceinline__ void done(const Unit&) const {}
};

__device__ __forceinline__ unsigned cvt_pk_bf16(float lo, float hi) { unsigned r; asm volatile("v_cvt_pk_bf16_f32 %0, %1, %2" : "=v"(r) : "v"(lo), "v"(hi)); return r; }
template <class Epi, class Sched, bool ALIGN_EPI = false, bool SP2 = false>
__device__ __forceinline__ void gemm_phase(PG8_LAS unsigned char* lds, const Gemm g, const Sched& S, const Epi& E, const int tid_in) {
    const int tid = tid_in, wid = __builtin_amdgcn_readfirstlane(tid >> 6), lane = tid & 63, wr = wid >> 2, wc = wid & 3, fr = lane & 15, fq = lane >> 4;
    const int K = g.K, nt = K / BK;
    unsigned voffA[2], voffB[2];
#pragma unroll
    for (int i = 0; i < 2; ++i) { int R, C; stage_rc(tid * 16 + i * 8192, R, C); const int Rb = Epi::PERM ? ((R & ~31) + perm32(R & 31)) : R;
        voffA[i] = (unsigned)(R * K + C) * 2u; voffB[i] = (unsigned)(Rb * K + C) * 2u; }
    const size_t kstep = (size_t)(BK * 2);
    const size_t hstep = (size_t)HALF * K * 2;
    const size_t tstep = 2 * hstep;
    const unsigned ldsw = (unsigned)wid * 1024u;
    const int aoff = lds_byte(wr * 64 + fr, fq * 8), boff = lds_byte(wc * 32 + fr, fq * 8);
#define PG8_SA(b, h) (((b) * 2 + (h)) * HTB)
#define PG8_SB(b, h) ((4 + (b) * 2 + (h)) * HTB)
#define PG8_STAGE(bufoff, gbase, voff) do { _Pragma("unroll") for (int _i = 0; _i < 2; ++_i) \
        __builtin_amdgcn_global_load_lds((const unsigned*)((const char*)(gbase) + (voff)[_i]), (PG8_LAS unsigned*)(lds + (bufoff) + ldsw + _i * 8192), 16, 0, 0); } while (0)
#define PG8_LDA(dst, b, h) do { _Pragma("unroll") for (int m = 0; m < 4; ++m) _Pragma("unroll") for (int k = 0; k < 2; ++k) dst[m][k] = *(const PG8_LAS bf16x8*)(lds + PG8_SA(b, h) + aoff + m * 2048 + k * 1024); } while (0)
#define PG8_LDB(dst, b, h) do { _Pragma("unroll") for (int n = 0; n < 2; ++n) _Pragma("unroll") for (int k = 0; k < 2; ++k) dst[n][k] = *(const PG8_LAS bf16x8*)(lds + PG8_SB(b, h) + boff + n * 2048 + k * 1024); } while (0)
#define PG8_MMA(ai, bj, At, Bt) do { __builtin_amdgcn_s_setprio(1); _Pragma("unroll") for (int m = 0; m < 4; ++m) _Pragma("unroll") for (int n = 0; n < 2; ++n) _Pragma("unroll") for (int k = 0; k < 2; ++k) \
        acc[ai][bj][m][n] = __builtin_amdgcn_mfma_f32_16x16x32_bf16(Bt[n][k], At[m][k], acc[ai][bj][m][n], 0, 0, 0); __builtin_amdgcn_s_setprio(0); } while (0)
#define PG8_WAIT_V(n) asm volatile("s_waitcnt vmcnt(" #n ")" ::: "memory")
#define PG8_WAIT_L(n) asm volatile("s_waitcnt lgkmcnt(" #n ")" ::: "memory")
#define PG8_BAR __builtin_amdgcn_s_barrier()
#define PG8_SCHED __builtin_amdgcn_sched_barrier(0)
    Unit cur, nxt; int ui = 0;
    if (!S.next(0, cur)) return;
    f32x4 acc[2][2][4][2];
#pragma unroll
    for (int a = 0; a < 2; ++a)
#pragma unroll
        for (int b = 0; b < 2; ++b)
#pragma unroll
            for (int m = 0; m < 4; ++m)
#pragma unroll
                for (int n = 0; n < 2; ++n) acc[a][b][m][n] = (f32x4){0.f, 0.f, 0.f, 0.f};
    bf16x8 At[4][2], B0[2][2], B1[2][2];
    const char* cA = (const char*)g.A + (size_t)cur.pm * tstep; const char* cB = (const char*)g.Bt + (size_t)cur.pn * tstep;
    S.a_ready(cur);
    if constexpr (SP2) {
        PG8_STAGE(PG8_SB(0, 0), cB, voffB); PG8_STAGE(PG8_SB(0, 1), cB + hstep, voffB); PG8_STAGE(PG8_SA(0, 0), cA, voffA); PG8_STAGE(PG8_SA(0, 1), cA + hstep, voffA);
        if (wr == 1) PG8_BAR;
        PG8_WAIT_V(2); PG8_BAR;
        PG8_STAGE(PG8_SB(1, 0), cB + kstep, voffB); PG8_STAGE(PG8_SA(1, 0), cA + kstep, voffA); PG8_STAGE(PG8_SB(1, 1), cB + hstep + kstep, voffB);
        PG8_WAIT_V(6); PG8_BAR;
    } else {
        PG8_STAGE(PG8_SB(0, 0), cB, voffB); PG8_STAGE(PG8_SA(0, 0), cA, voffA); PG8_STAGE(PG8_SB(0, 1), cB + hstep, voffB); PG8_STAGE(PG8_SA(0, 1), cA + hstep, voffA);
        if (wr == 1) PG8_BAR;
        PG8_WAIT_V(4); PG8_BAR;
        PG8_STAGE(PG8_SB(1, 0), cB + kstep, voffB); PG8_STAGE(PG8_SA(1, 0), cA + kstep, voffA); PG8_STAGE(PG8_SB(1, 1), cB + hstep + kstep, voffB);
        PG8_WAIT_V(6); PG8_BAR;
    }
    for (;;) {
        const bool has_next = S.next(ui + 1, nxt);
        const char* nA = has_next ? (const char*)g.A + (size_t)nxt.pm * tstep : cA; const char* nB = has_next ? (const char*)g.Bt + (size_t)nxt.pn * tstep : cB;
        for (int t = 0; t < nt; t += 2) {
            const bool last = (t == nt - 2);
            const char* a1 = cA + (size_t)(t + 1) * kstep;
            const char* a2 = last ? nA : cA + (size_t)(t + 2) * kstep; const char* b2 = last ? nB : cB + (size_t)(t + 2) * kstep;
            const char* a3 = a2 + kstep; const char* b3 = b2 + kstep;
            if (last && has_next) S.a_ready(nxt);
            if constexpr (SP2) {
            PG8_LDB(B0, 0, 0); PG8_LDB(B1, 0, 1); PG8_SCHED; PG8_LDA(At, 0, 0); PG8_STAGE(PG8_SA(1, 1), a1 + hstep, voffA);
            PG8_WAIT_V(8); PG8_WAIT_L(0); PG8_BAR; PG8_MMA(0, 0, At, B0); PG8_MMA(0, 1, At, B1); PG8_BAR; PG8_SCHED;
            PG8_LDA(At, 0, 1); PG8_STAGE(PG8_SB(0, 0), b2, voffB); PG8_STAGE(PG8_SB(0, 1), b2 + hstep, voffB); PG8_STAGE(PG8_SA(0, 0), a2, voffA);
            PG8_WAIT_V(8); PG8_WAIT_L(0); PG8_BAR; PG8_MMA(1, 0, At, B0); PG8_MMA(1, 1, At, B1); PG8_BAR; PG8_SCHED;
            PG8_LDB(B0, 1, 0); PG8_LDB(B1, 1, 1); PG8_SCHED; PG8_LDA(At, 1, 0); PG8_STAGE(PG8_SA(0, 1), a2 + hstep, voffA);
            PG8_WAIT_V(8); PG8_WAIT_L(0); PG8_BAR; PG8_MMA(0, 0, At, B0); PG8_MMA(0, 1, At, B1); PG8_BAR; PG8_SCHED;
            PG8_LDA(At, 1, 1); PG8_STAGE(PG8_SB(1, 0), b3, voffB); PG8_STAGE(PG8_SB(1, 1), b3 + hstep, voffB); PG8_STAGE(PG8_SA(1, 0), a3, voffA);
            PG8_WAIT_V(8); PG8_WAIT_L(0); PG8_BAR; PG8_MMA(1, 0, At, B0); PG8_MMA(1, 1, At, B1); PG8_BAR; PG8_SCHED;
            } else {
            PG8_LDB(B0, 0, 0); PG8_SCHED; PG8_LDA(At, 0, 0); PG8_STAGE(PG8_SA(1, 1), a1 + hstep, voffA);
            PG8_WAIT_L(8); PG8_BAR; PG8_WAIT_L(0); PG8_MMA(0, 0, At, B0); PG8_BAR; PG8_SCHED;
            PG8_LDB(B1, 0, 1); PG8_STAGE(PG8_SB(0, 0), b2, voffB);
            PG8_BAR; PG8_WAIT_L(0); PG8_MMA(0, 1, At, B1); PG8_BAR;
            PG8_LDA(At, 0, 1); PG8_STAGE(PG8_SA(0, 0), a2, voffA);
            PG8_BAR; PG8_WAIT_L(0); PG8_MMA(1, 0, At, B0); PG8_BAR; PG8_SCHED;
            PG8_STAGE(PG8_SB(0, 1), b2 + hstep, voffB);
            PG8_WAIT_V(6); PG8_BAR; PG8_MMA(1, 1, At, B1); PG8_BAR;
            PG8_LDB(B0, 1, 0); PG8_SCHED; PG8_LDA(At, 1, 0); PG8_STAGE(PG8_SA(0, 1), a2 + hstep, voffA);
            PG8_WAIT_L(8); PG8_BAR; PG8_WAIT_L(0); PG8_MMA(0, 0, At, B0); PG8_BAR; PG8_SCHED;
            PG8_LDB(B1, 1, 1); PG8_STAGE(PG8_SB(1, 0), b3, voffB);
            PG8_BAR; PG8_WAIT_L(0); PG8_MMA(0, 1, At, B1); PG8_BAR;
            PG8_LDA(At, 1, 1); PG8_STAGE(PG8_SA(1, 0), a3, voffA);
            PG8_BAR; PG8_WAIT_L(0); PG8_MMA(1, 0, At, B0); PG8_BAR; PG8_SCHED;
            PG8_STAGE(PG8_SB(1, 1), b3 + hstep, voffB);
            PG8_WAIT_V(6); PG8_BAR; PG8_MMA(1, 1, At, B1); PG8_BAR;
            }
        }
        if constexpr (ALIGN_EPI) { if (wr == 0) PG8_BAR; }
        if constexpr (!Epi::AFTER_DRAIN) { E(acc, cur, wr, wc, fr, fq); S.done(cur); }
        if (!has_next) break;
#pragma unroll
        for (int a = 0; a < 2; ++a)
#pragma unroll
            for (int b = 0; b < 2; ++b)
#pragma unroll
                for (int m = 0; m < 4; ++m)
#pragma unroll
                    for (int n = 0; n < 2; ++n) acc[a][b][m][n] = (f32x4){0.f, 0.f, 0.f, 0.f};
        cur = nxt; cA = nA; cB = nB; ++ui;
        if constexpr (ALIGN_EPI) { if (wr == 1) PG8_BAR; }
    }
    PG8_WAIT_V(0);
    if constexpr (!ALIGN_EPI) { if (wr == 0) PG8_BAR; }
    PG8_BAR;
    if constexpr (Epi::AFTER_DRAIN) { E.fused(acc, cur, wr, wc, fr, fq, lds, wid, lane); S.done(cur); }
#undef PG8_SA
#undef PG8_SB
#undef PG8_STAGE
#undef PG8_LDA
#undef PG8_LDB
#undef PG8_MMA
#undef PG8_WAIT_V
#undef PG8_WAIT_L
#undef PG8_BAR
#undef PG8_SCHED
}
}
#define LAS __attribute__((address_space(3)))

#define XB_TMO      128
#define XB_XCNT(j)  (256  + 64 * (j))
#define XB_XSUB(j)  (1280 + 64 * (j))
#define XB_XGEN(j)  (2304 + 64 * (j))
#define XB_TOP      3328
#define XB_TOPGEN   3392
#define XCD_BAR_WORDS 3456
#define XB_SPIN_CAP (1u << 18)

__device__ __forceinline__ unsigned xb_ld(unsigned* p)              { return __hip_atomic_load(p, __ATOMIC_RELAXED, __HIP_MEMORY_SCOPE_AGENT); }
__device__ __forceinline__ unsigned xb_add(unsigned* p, unsigned v) { return __hip_atomic_fetch_add(p, v, __ATOMIC_RELAXED, __HIP_MEMORY_SCOPE_AGENT); }
__device__ __forceinline__ unsigned xb_xcc_id() { return (unsigned)__builtin_amdgcn_s_getreg((3 << 11) | 20) & 0xFu; }
#define XB_SPIN(cond, bar) do { unsigned _sp = 0; while (cond) { __builtin_amdgcn_s_sleep(1); \
    if ((++_sp & 255u) == 0u) { if (xb_ld(&(bar)[XB_TMO])) break; if (_sp > XB_SPIN_CAP) { atomicAdd(&(bar)[XB_TMO], 1u); break; } } } } while (0)

struct XcdBarrier {
    unsigned* bar; unsigned x;
    volatile LAS unsigned* st;
};

__device__ __forceinline__ XcdBarrier xcd_barrier_post(unsigned* bar, volatile LAS unsigned* st) {
    XcdBarrier b; b.bar = bar; b.x = xb_xcc_id(); b.st = st;
    if (threadIdx.x == 0) (void)xb_add(&bar[XB_XCNT(b.x)], 1u);
    return b;
}
__device__ __forceinline__ void xcd_barrier_complete(unsigned* bar, unsigned x, unsigned& nloc, unsigned& nx) {
    const unsigned G = gridDim.x * gridDim.y * gridDim.z;
    unsigned sum, cnt, mine, sp = 0u;
    for (;;) {
        sum = 0u; cnt = 0u; mine = 0u;
#pragma unroll
        for (unsigned j = 0; j < 16; ++j) { const unsigned c = xb_ld(&bar[XB_XCNT(j)]); sum += c; cnt += (c > 0u) ? 1u : 0u; mine = (j == x) ? c : mine; }
        if (sum == G) break;
        __builtin_amdgcn_s_sleep(1);
        if ((++sp & 255u) == 0u) { if (xb_ld(&bar[XB_TMO])) break; if (sp > XB_SPIN_CAP) { atomicAdd(&bar[XB_TMO], 1u); break; } }
    }
    nloc = mine > 0u ? mine : 1u; nx = cnt > 0u ? cnt : 1u;
}

__device__ __forceinline__ void xcd_barrier(const XcdBarrier& b) {
    asm volatile("s_waitcnt vmcnt(0)" ::: "memory");
    __syncthreads();
    if (threadIdx.x == 0) {
        unsigned* bar = b.bar;
        __builtin_amdgcn_s_waitcnt(0);
        unsigned nloc = b.st[0], nx = b.st[1];
        if (nloc == 0u) { xcd_barrier_complete(bar, b.x, nloc, nx); b.st[0] = nloc; b.st[1] = nx; }
        const unsigned old = xb_add(&bar[XB_XSUB(b.x)], 1u);
        const unsigned gen = old / nloc;
        if (old + 1u == (gen + 1u) * nloc) {
            __builtin_amdgcn_fence(__ATOMIC_RELEASE, "agent");
            asm volatile("s_waitcnt vmcnt(0)" ::: "memory");
            const unsigned og = xb_add(&bar[XB_TOP], 1u);
            const unsigned tg = og / nx;
            if (og + 1u == (tg + 1u) * nx) xb_add(&bar[XB_TOPGEN], 1u);
            else XB_SPIN(xb_ld(&bar[XB_TOPGEN]) == tg, bar);
            __builtin_amdgcn_fence(__ATOMIC_ACQUIRE, "agent");
            xb_add(&bar[XB_XGEN(b.x)], 1u);
            asm volatile("s_waitcnt vmcnt(0)" ::: "memory");
        } else {
            XB_SPIN(xb_ld(&bar[XB_XGEN(b.x)]) == gen, bar);
            __builtin_amdgcn_fence(__ATOMIC_ACQUIRE, "agent");
            asm volatile("s_waitcnt vmcnt(0)" ::: "memory");
        }
    }
    __syncthreads();
}


#ifndef REP_MASK
#define REP_MASK 0
#endif
#ifndef NAIVE_ATTN
#define NAIVE_ATTN 0
#endif
#ifndef NAIVE_SPATIAL
#define NAIVE_SPATIAL 0
#endif

using pg8::bf16_t; using pg8::f32x4; using pg8::Unit; using pg8::u32x4;
typedef unsigned u32x2 __attribute__((ext_vector_type(2)));

constexpr int NLAT = 32768, NCTX = 2048, MTOT = 34816;
constexpr int NTHREADS = 512;
constexpr int LDS_BYTES = 131072 + 16;
constexpr int NPH = 24;

constexpr size_t OFF_W1T = 0;
constexpr size_t OFF_W2T = OFF_W1T + 4ull * 4096 * 1024 * 2;
constexpr size_t OFF_QKVT = OFF_W2T + 4ull * 4096 * 1024 * 2;
constexpr size_t OFF_WOT = OFF_QKVT + 2ull * 3072 * 1024 * 2;
constexpr size_t OFF_WINT = OFF_WOT + 2ull * 1024 * 1024 * 2;
constexpr size_t OFF_SGOT = OFF_WINT + 2ull * 6144 * 1024 * 2;
constexpr size_t OFF_MODS = OFF_SGOT + 2ull * 1024 * 3072 * 2;
constexpr size_t OFF_CTXR = OFF_MODS + 4ull * 9 * 6144 * 4;
constexpr size_t OFF_HB = OFF_CTXR + 2048ull * 1024 * 4;
constexpr size_t OFF_BIG = OFF_HB + 34816ull * 1024 * 2;
constexpr size_t OFF_SSQ = OFF_BIG + 34816ull * 4096 * 2;
constexpr size_t OFF_LNACC = OFF_SSQ + 8ull * 34816 * 4;
constexpr size_t OFF_GS = OFF_LNACC + 2ull * 34816 * 2 * 4;
constexpr size_t OFF_BQKV = OFF_GS + 8ull * 9 * 1024 * 4;
constexpr size_t OFF_BMLP = OFF_BQKV + 2ull * 9 * 3072 * 4;
constexpr size_t OFF_BWIN = OFF_BMLP + 4ull * 9 * 4096 * 4;
constexpr size_t OFF_WSF = OFF_BWIN + 2ull * 9 * 6144 * 4;
constexpr size_t OFF_BAR = OFF_WSF + 2ull * 24 * 16384 * 2;
constexpr size_t WS_END = OFF_BAR + 16384;

struct Params {
    const float *x, *c, *ctx, *c_ctx, *ada_w, *ada_b, *norm1_g, *norm2_g, *mlp_w1, *mlp_w2, *na_w_qkv, *na_q_norm, *na_k_norm, *na_rpb, *na_w_o,
        *sg_w_in, *sg_b_in, *sg_ln_g, *sg_ln_b, *sg_w_s, *sg_b_s, *sg_w_o;
    float* out; unsigned char* ws; int ph_lo, ph_hi;
};

struct Tix { int tid, bid, gsz; };
__device__ __forceinline__ float bf2f(unsigned h) { return __uint_as_float(h << 16); }
__device__ __forceinline__ unsigned f2bf(float f) { unsigned u = __float_as_uint(f); u += 0x7FFFu + ((u >> 16) & 1u); return u >> 16; }
__device__ __forceinline__ unsigned pk2(float lo, float hi) { return pg8::cvt_pk_bf16(lo, hi); }
__device__ __forceinline__ float wave_sum(float v) {
#pragma unroll
    for (int o = 1; o < 64; o <<= 1) v += __shfl_xor(v, o);
    return v;
}
__device__ __forceinline__ float wave_max(float v) {
#pragma unroll
    for (int o = 1; o < 64; o <<= 1) v = fmaxf(v, __shfl_xor(v, o));
    return v;
}
#define LDS_WAIT() asm volatile("s_waitcnt lgkmcnt(0)" ::: "memory")
__device__ __forceinline__ float silu_f(float v) { return v / (1.f + expf(-v)); }
__device__ __forceinline__ float gelu_f(float v) { return 0.5f * v * (1.f + erff(v * 0.70710678118654752f)); }

typedef float f32x2 __attribute__((ext_vector_type(2)));
__device__ __forceinline__ f32x2 gelu_pk(f32x2 v) {
    const f32x2 av = __builtin_elementwise_abs(v), d = av * 0.2316418882f + 1.0f;
    f32x2 t; t.x = __builtin_amdgcn_rcpf(d.x); t.y = __builtin_amdgcn_rcpf(d.y);
    f32x2 q = t * 0.5307027145f + (-0.7265760135f); q = q * t + 0.7107068705f; q = q * t + (-0.142248368f); q = q * t + 0.127414796f; q = q * t;
    const f32x2 s = (v * v) * (-0.72134752044f);
    f32x2 e; e.x = __builtin_amdgcn_exp2f(s.x); e.y = __builtin_amdgcn_exp2f(s.y);
    const f32x2 m = v * (q * e), r = v - m;
    f32x2 o; o.x = v.x < 0.f ? m.x : r.x; o.y = v.y < 0.f ? m.y : r.y; return o;
}
__device__ __forceinline__ f32x4 gelu4(f32x4 v) { const f32x2 a = gelu_pk((f32x2){v.x, v.y}), b = gelu_pk((f32x2){v.z, v.w}); return (f32x4){a.x, a.y, b.x, b.y}; }

__device__ __forceinline__ int sigma_inv(int L) { return 128 * ((L >> 5) & 1) + 32 * (L >> 6) + 16 * ((L >> 2) & 1) + 4 * ((L >> 3) & 3) + (L & 3); }

__device__ __forceinline__ void phase_mods(const Params& p, LAS unsigned char* lds, const Tix T_) {
    LAS float* sc = (LAS float*)lds;
    LAS float* red = (LAS float*)(lds + 36864);
    float* mods = (float*)(p.ws + OFF_MODS);
    const int tid = T_.tid;
    for (int i = tid; i < 9 * 1024; i += NTHREADS) { const int b = i >> 10, k = i & 1023; const float v = b < 8 ? p.c[b * 1024 + k] : p.c_ctx[k]; sc[i] = silu_f(v); }
    __syncthreads();
    const int c4 = (tid & 15) * 4, kk = tid >> 4;
    for (int item = T_.bid; item < 384; item += T_.gsz) {
        const int l = item / 96, n0 = (item % 96) * 64;
        const float* W = p.ada_w + (size_t)l * 1024 * 6144 + n0 + c4;
        f32x4 acc[9];
#pragma unroll
        for (int b = 0; b < 9; ++b) acc[b] = (f32x4){0.f, 0.f, 0.f, 0.f};
#pragma unroll 4
        for (int i = 0; i < 32; ++i) { const int k = kk + 32 * i; const f32x4 w = *(const f32x4*)(W + (size_t)k * 6144);
#pragma unroll
            for (int b = 0; b < 9; ++b) acc[b] += sc[b * 1024 + k] * w; }
#pragma unroll
        for (int b = 0; b < 9; ++b) *(LAS f32x4*)(red + (kk * 9 + b) * 64 + c4) = acc[b];
        __syncthreads();
        for (int o = tid; o < 576; o += NTHREADS) { const int b = o >> 6, cc = o & 63; float s = 0.f;
            for (int j = 0; j < 32; ++j) s += red[(j * 9 + b) * 64 + cc];
            mods[(size_t)(l * 9 + b) * 6144 + n0 + cc] = s + p.ada_b[l * 6144 + n0 + cc]; }
        __syncthreads();
    }
}

struct MatDesc { const float* src; bf16_t* dst; int K, N; };
__device__ __forceinline__ MatDesc get_mat(const Params& p, int mi) {
    MatDesc m;
    if (mi < 4) { m.src = p.mlp_w1 + (size_t)mi * 1024 * 4096; m.dst = (bf16_t*)(p.ws + OFF_W1T) + (size_t)mi * 4096 * 1024; m.K = 1024; m.N = 4096; }
    else if (mi < 8) { const int l = mi - 4; m.src = p.mlp_w2 + (size_t)l * 4096 * 1024; m.dst = (bf16_t*)(p.ws + OFF_W2T) + (size_t)l * 1024 * 4096; m.K = 4096; m.N = 1024; }
    else if (mi < 10) { const int a = mi - 8; m.src = p.na_w_qkv + (size_t)a * 1024 * 3072; m.dst = (bf16_t*)(p.ws + OFF_QKVT) + (size_t)a * 3072 * 1024; m.K = 1024; m.N = 3072; }
    else if (mi < 12) { const int a = mi - 10; m.src = p.na_w_o + (size_t)a * 1024 * 1024; m.dst = (bf16_t*)(p.ws + OFF_WOT) + (size_t)a * 1024 * 1024; m.K = 1024; m.N = 1024; }
    else if (mi < 14) { const int s = mi - 12; m.src = p.sg_w_in + (size_t)s * 1024 * 6144; m.dst = (bf16_t*)(p.ws + OFF_WINT) + (size_t)s * 6144 * 1024; m.K = 1024; m.N = 6144; }
    else { const int s = mi - 14; m.src = p.sg_w_o + (size_t)s * 3072 * 1024; m.dst = (bf16_t*)(p.ws + OFF_SGOT) + (size_t)s * 1024 * 3072; m.K = 3072; m.N = 1024; }
    return m;
}
__device__ __forceinline__ void transpose_item(const float* W, int K, int N, bf16_t* WT, LAS float* scr, int item, int lane) {
    const int nblk = N / 32, kb = item / nblk, nb = item % nblk, k0 = 64 * kb, n0 = 32 * nb;
#pragma unroll 8
    for (int i = 0; i < 32; ++i) { const int kk = 2 * i + (lane >> 5); scr[kk * 33 + (lane & 31)] = W[(size_t)(k0 + kk) * N + n0 + (lane & 31)]; }
    LDS_WAIT();
    const int c = lane & 7;
#pragma unroll
    for (int j = 0; j < 4; ++j) { const int n = (lane >> 3) + 8 * j; const LAS float* s = scr + (8 * c) * 33 + n;
        u32x4 o; o.x = pk2(s[0 * 33], s[1 * 33]); o.y = pk2(s[2 * 33], s[3 * 33]); o.z = pk2(s[4 * 33], s[5 * 33]); o.w = pk2(s[6 * 33], s[7 * 33]);
        const int nl = n0 + n, drow = (nl & ~255) + sigma_inv(nl & 255);
        *(u32x4*)(WT + (size_t)drow * K + k0 + 8 * c) = o; }
    LDS_WAIT();
}
__device__ __forceinline__ void phase_convert(const Params& p, LAS unsigned char* lds, const Tix T_) {
    const int lane = T_.tid & 63, wave = T_.tid >> 6, gw = T_.bid * 8 + wave, NGW = T_.gsz * 8;
    LAS float* scr = (LAS float*)(lds + wave * 8704);
    for (int mi = 0; mi < 16; ++mi) {
        const MatDesc m = get_mat(p, mi);
        const int nitems = (m.K / 64) * (m.N / 32);
        for (int it = gw; it < nitems; it += NGW) transpose_item(m.src, m.K, m.N, m.dst, scr, it, lane);
    }
    { bf16_t* wsf = (bf16_t*)(p.ws + OFF_WSF);
      for (int it = gw; it < 2 * 24 * 4 * 8; it += NGW) { const int ks = it & 7, pt = (it >> 3) & 3, slg = it >> 5;
          const float* wp = p.sg_w_s + (size_t)slg * 16384 + (32 * pt + (lane & 31)) * 128 + 16 * ks + 8 * (lane >> 5);
          const f32x4 x = *(const f32x4*)wp, y = *(const f32x4*)(wp + 4);
          u32x4 o; o.x = pk2(x.x, x.y); o.y = pk2(x.z, x.w); o.z = pk2(y.x, y.y); o.w = pk2(y.z, y.w);
          *(u32x4*)(wsf + (size_t)it * 512 + lane * 8) = o; } }
}


__device__ __forceinline__ void phase_zero(const Params& p, const Tix T_) {
    float* z0 = (float*)(p.ws + OFF_SSQ) + MTOT; const int n0 = 7 * MTOT + 2 * MTOT * 2;
    for (int i = T_.bid * NTHREADS + T_.tid; i < n0; i += T_.gsz * NTHREADS) z0[i] = 0.f;
}
__device__ __forceinline__ void phase_0b(const Params& p, LAS unsigned char* lds, const Tix T_) {
    const float* mods = (const float*)(p.ws + OFF_MODS);
    const int tid = T_.tid, lane = tid & 63, wave = tid >> 6, gw = T_.bid * 8 + wave, NGW = T_.gsz * 8;
    { float* gs = (float*)(p.ws + OFF_GS);
      for (int i = T_.bid * NTHREADS + tid; i < 8 * 9 * 1024; i += T_.gsz * NTHREADS) { const int n = i / 9216, rem = i % 9216, b = rem >> 10, c = rem & 1023, L = n >> 1;
          const float g = (n & 1) ? p.norm2_g[L * 1024 + c] : p.norm1_g[L * 1024 + c];
          gs[i] = g * (1.0f + mods[(size_t)(L * 9 + b) * 6144 + ((n & 1) ? 4096 : 1024) + c]); } }
    { bf16_t* hb = (bf16_t*)(p.ws + OFF_HB); float* ssq0 = (float*)(p.ws + OFF_SSQ);
      for (int row = gw; row < MTOT; row += NGW) {
          const float* xr = row < NLAT ? p.x + (size_t)row * 1024 : p.ctx + (size_t)(row - NLAT) * 1024;
          const int b = row < NLAT ? (row >> 12) : 8;
          f32x4 v[4]; float ss = 0.f;
#pragma unroll
          for (int j = 0; j < 4; ++j) { v[j] = *(const f32x4*)(xr + 4 * lane + 256 * j); ss += (v[j].x * v[j].x + v[j].y * v[j].y) + (v[j].z * v[j].z + v[j].w * v[j].w); }
          ss = wave_sum(ss);
          if (lane == 0) ssq0[row] = ss;
#pragma unroll
          for (int j = 0; j < 4; ++j) { const int col = 4 * lane + 256 * j;
              const f32x4 gv = *(const f32x4*)(p.norm1_g + col), scv = *(const f32x4*)(mods + (size_t)b * 6144 + 1024 + col);
              const f32x4 o = v[j] * gv * (1.0f + scv);
              u32x2 w; w.x = pk2(o.x, o.y); w.y = pk2(o.z, o.w);
              *(u32x2*)(hb + (size_t)row * 1024 + col) = w; } } }
    LAS float* sh = (LAS float*)lds;
    for (int cmb = 0; cmb < 8; ++cmb) {
        int L, shoff, N; const bf16_t* Bt; float* dst; const float* addb = nullptr;
        if (cmb < 2) { L = 2 * cmb; shoff = 0; N = 3072; Bt = (const bf16_t*)(p.ws + OFF_QKVT) + (size_t)cmb * 3072 * 1024; dst = (float*)(p.ws + OFF_BQKV) + (size_t)cmb * 9 * 3072; }
        else if (cmb < 6) { L = cmb - 2; shoff = 3072; N = 4096; Bt = (const bf16_t*)(p.ws + OFF_W1T) + (size_t)L * 4096 * 1024; dst = (float*)(p.ws + OFF_BMLP) + (size_t)L * 9 * 4096; }
        else { const int sl = cmb - 6; L = 2 * sl + 1; shoff = 0; N = 6144; Bt = (const bf16_t*)(p.ws + OFF_WINT) + (size_t)sl * 6144 * 1024; dst = (float*)(p.ws + OFF_BWIN) + (size_t)sl * 9 * 6144; addb = p.sg_b_in + sl * 6144; }
        __syncthreads();
        for (int i = tid; i < 9 * 1024; i += NTHREADS) sh[i] = mods[(size_t)(L * 9 + (i >> 10)) * 6144 + shoff + (i & 1023)];
        __syncthreads();
        for (int n = gw; n < N; n += NGW) {
            const bf16_t* wr_ = Bt + (size_t)((n & ~255) + sigma_inv(n & 255)) * 1024 + lane * 8;
            const u32x4 w0 = *(const u32x4*)wr_, w1 = *(const u32x4*)(wr_ + 512);
            float wv[16];
#pragma unroll
            for (int e = 0; e < 4; ++e) { wv[2 * e] = bf2f(w0[e] & 0xffffu); wv[2 * e + 1] = bf2f(w0[e] >> 16); wv[8 + 2 * e] = bf2f(w1[e] & 0xffffu); wv[8 + 2 * e + 1] = bf2f(w1[e] >> 16); }
            const float ab = addb ? addb[n] : 0.f;
#pragma unroll
            for (int b = 0; b < 9; ++b) {
                const f32x4 s0 = *(const LAS f32x4*)(sh + b * 1024 + lane * 8), s1 = *(const LAS f32x4*)(sh + b * 1024 + lane * 8 + 4);
                const f32x4 s2 = *(const LAS f32x4*)(sh + b * 1024 + 512 + lane * 8), s3 = *(const LAS f32x4*)(sh + b * 1024 + 512 + lane * 8 + 4);
                float a = (wv[0] * s0.x + wv[1] * s0.y) + (wv[2] * s0.z + wv[3] * s0.w) + (wv[4] * s1.x + wv[5] * s1.y) + (wv[6] * s1.z + wv[7] * s1.w)
                        + (wv[8] * s2.x + wv[9] * s2.y) + (wv[10] * s2.z + wv[11] * s2.w) + (wv[12] * s3.x + wv[13] * s3.y) + (wv[14] * s3.z + wv[15] * s3.w);
                a = wave_sum(a);
                if (lane == 0) dst[(size_t)b * N + n] = a + ab; }
        }
    }
}

typedef short s16x4 __attribute__((ext_vector_type(4)));
typedef short s16x8 __attribute__((ext_vector_type(8)));
typedef float f32x16 __attribute__((ext_vector_type(16)));
typedef __bf16 bf16x2_t __attribute__((ext_vector_type(2)));
__device__ __forceinline__ unsigned pkb(float a, float b) { const f32x2 v = {a, b}; const bf16x2_t r = __builtin_convertvector(v, bf16x2_t); return __builtin_bit_cast(unsigned, r); }
__device__ __forceinline__ s16x8 pack8(float a0, float a1, float a2, float a3, float a4, float a5, float a6, float a7) {
    u32x4 w; w.x = pkb(a0, a1); w.y = pkb(a2, a3); w.z = pkb(a4, a5); w.w = pkb(a6, a7); return __builtin_bit_cast(s16x8, w); }
__device__ __forceinline__ s16x8 tr_pair(const LAS unsigned char* a0, int second_off) {
    const s16x4 a = __builtin_amdgcn_ds_read_tr16_b64_v4i16((LAS s16x4*)a0);
    const s16x4 b = __builtin_amdgcn_ds_read_tr16_b64_v4i16((LAS s16x4*)(a0 + second_off));
    s16x8 r; r[0] = a[0]; r[1] = a[1]; r[2] = a[2]; r[3] = a[3]; r[4] = b[0]; r[5] = b[1]; r[6] = b[2]; r[7] = b[3]; return r; }
#define MFMA32(a, b, c) __builtin_amdgcn_mfma_f32_32x32x16_bf16((a), (b), (c), 0, 0, 0)

constexpr int AV_STR = 144;
__device__ __forceinline__ f32x16 attn_qk(const s16x8 (&Kf)[4], const s16x8 (&Qf)[4]) {
    f32x16 S;
#pragma unroll
    for (int i = 0; i < 16; ++i) S[i] = 0.f;
#pragma unroll
    for (int ks = 0; ks < 4; ++ks) S = MFMA32(Kf[ks], Qf[ks], S);
    return S;
}
__device__ __forceinline__ float tabv(const LAS unsigned char* tabrow, int off) { return *(const LAS float*)(tabrow + off); }
__device__ __forceinline__ void attn_one_tile(const s16x8 (&Kf)[4], const s16x8 (&Qf)[4], const LAS unsigned char* vb, const LAS unsigned char* tabrow, const unsigned (&offo)[4], const unsigned offx,
                                              f32x16& O0, f32x16& O1, float& lsum, int mode, float mbl) {
    const f32x16 S = attn_qk(Kf, Qf);
    float pv[16];
    if (mode == 0) {
#pragma unroll
        for (int i = 0; i < 16; ++i) pv[i] = __builtin_amdgcn_exp2f(S[i] - mbl);
    } else if (mode == 1) {
#pragma unroll
        for (int i = 0; i < 16; ++i) pv[i] = __builtin_amdgcn_exp2f(S[i] + tabv(tabrow, (int)((offo[i >> 2] >> (8 * (i & 3))) & 0xffu)));
    } else {
#pragma unroll
        for (int i = 0; i < 16; ++i) pv[i] = 0.f;
        if (mode == 2) {
#pragma unroll
            for (int i = 0; i < 4; ++i) pv[i] = __builtin_amdgcn_exp2f(S[i] + tabv(tabrow, (int)((offx >> (8 * i)) & 0xffu)));
        } else {
#pragma unroll
            for (int i = 0; i < 4; ++i) pv[12 + i] = __builtin_amdgcn_exp2f(S[12 + i] + tabv(tabrow, (int)((offx >> (8 * i)) & 0xffu)));
        }
    }
#pragma unroll
    for (int i = 0; i < 16; ++i) lsum += pv[i];
    const s16x8 P0 = pack8(pv[0], pv[1], pv[2], pv[3], pv[4], pv[5], pv[6], pv[7]), P1 = pack8(pv[8], pv[9], pv[10], pv[11], pv[12], pv[13], pv[14], pv[15]);
    { const s16x8 V00 = tr_pair(vb, 8 * AV_STR), V01 = tr_pair(vb + 64, 8 * AV_STR);
      O0 = MFMA32(V00, P0, O0); O1 = MFMA32(V01, P0, O1); }
    { const s16x8 V10 = tr_pair(vb + 16 * AV_STR, 8 * AV_STR), V11 = tr_pair(vb + 16 * AV_STR + 64, 8 * AV_STR);
      O0 = MFMA32(V10, P1, O0); O1 = MFMA32(V11, P1, O1); }
}
__device__ __forceinline__ void attn_load_k(s16x8 (&Kf)[4], const bf16_t* kfb, int klat0, int kctx0, int kt, int ntl, int rs) {
    const int tile = kt < ntl ? klat0 + (rs + (kt >> 1)) * 2 + (kt & 1) : kctx0 + (kt - ntl);
#pragma unroll
    for (int ks = 0; ks < 4; ++ks) Kf[ks] = *(const s16x8*)(kfb + (size_t)tile * 32768 + ks * 512);
}
struct AUnit { int b, h, qrow0, r, rs, ntl, ntiles; };
__device__ __forceinline__ AUnit attn_decode(int u, int nlatu) {
    AUnit a;
    if (u < nlatu) { a.h = u & 15; const int br = u >> 4; a.r = br & 63; a.b = br >> 6; a.qrow0 = a.b * 4096 + a.r * 64; a.rs = min(max(a.r - 4, 0), 56); a.ntl = 16; a.ntiles = 24; }
    else { const int v = u - nlatu; a.h = v & 15; const int bq = v >> 4; a.b = bq >> 2; a.qrow0 = NLAT + a.b * 256 + (bq & 3) * 64; a.r = 0; a.rs = 0; a.ntl = 0; a.ntiles = 8; }
    return a;
}
__device__ __forceinline__ u32x4 attn_load_v1(const bf16_t* vbase, const AUnit& a, int idx) {
    const int key = idx >> 3, ch = idx & 7, kt = key >> 5, kk = key & 31;
    const int grow = kt < a.ntl ? (a.b * 4096 + (a.rs + (kt >> 1)) * 64 + 32 * (kt & 1) + kk) : (NLAT + a.b * 256 + 32 * (kt - a.ntl) + kk);
    return *(const u32x4*)(vbase + (size_t)grow * 1024 + ch * 8);
}
__device__ __forceinline__ void attn_load_v(u32x4 (&vpre)[12], const bf16_t* qkv, const AUnit& a, int tid) {
    const bf16_t* vbase = qkv + (size_t)2 * MTOT * 1024 + a.h * 64;
#pragma unroll
    for (int i = 0; i < 4; ++i) vpre[i] = attn_load_v1(vbase, a, tid + NTHREADS * i);
    if (a.ntiles == 24) {
#pragma unroll
        for (int i = 4; i < 12; ++i) vpre[i] = attn_load_v1(vbase, a, tid + NTHREADS * i);
    }
}

__device__ __forceinline__ void phase_attn_mfma(const Params& p, int a_, bool ctx_q, LAS unsigned char* lds, const Tix T_) {
    const bf16_t* qkv = (const bf16_t*)(p.ws + OFF_BIG); bf16_t* ao = (bf16_t*)(p.ws + OFF_BIG) + (size_t)MTOT * 3072;
    const bf16_t* kf = qkv + (size_t)MTOT * 1024;
    const float* rpb = p.na_rpb + (size_t)a_ * 16 * 15 * 31;
    const int tid = T_.tid, lane = tid & 63, wave = __builtin_amdgcn_readfirstlane(tid >> 6), qt = wave & 1, kq = wave >> 1, l31 = lane & 31, hi = lane >> 5;
    LAS unsigned char* Vl = lds;
    LAS float* Ored = (LAS float*)lds;
    LAS float* lred = (LAS float*)(lds + 69632);
    LAS float* tab = (LAS float*)(lds + 110592);
    LAS float* misc = (LAS float*)(lds + 110592 + 2048);
    constexpr float LOG2E = 1.4426950408889634f;
    float mb;
    { float m = 0.f; for (int i = tid; i < 7440; i += NTHREADS) m = fmaxf(m, rpb[i]);
      float qg = 0.f, kg = 0.f; if (tid < 64) { qg = fabsf(p.na_q_norm[a_ * 64 + tid]); kg = fabsf(p.na_k_norm[a_ * 64 + tid]); }
      m = wave_max(m); qg = wave_max(qg); kg = wave_max(kg);
      if (lane == 0) { misc[wave] = m; if (wave == 0) { misc[8] = qg; misc[9] = kg; } }
      __syncthreads();
      float rm = misc[0];
#pragma unroll
      for (int w = 1; w < 8; ++w) rm = fmaxf(rm, misc[w]);
      mb = 8.0f * misc[8] * misc[9] + rm; }
    const float mbl = mb * LOG2E;
    const int nlatu = 8 * 64 * 16, total = nlatu + (ctx_q ? 8 * 4 * 16 : 0);
    const int tr_q = (lane & 15) >> 2, tr_p = lane & 3, dgrp = (lane >> 4) & 1;
    const int qcol = 32 * qt + l31, wst = min(max(qcol - 8, 0), 48);
    unsigned offo[4], offx = 0u;
#pragma unroll
    for (int j = 0; j < 4; ++j) { offo[j] = 0u;
#pragma unroll
        for (int i = 0; i < 4; ++i) { const int kcol = 32 * qt + 8 * j + 4 * hi + i; offo[j] |= (unsigned)(((unsigned)(kcol - wst) < 16u ? kcol - qcol + 15 : 31) * 4) << (8 * i); } }
#pragma unroll
    for (int i = 0; i < 4; ++i) { const int kcol = (qt == 0 ? 32 : 24) + 4 * hi + i; offx |= (unsigned)(((unsigned)(kcol - wst) < 16u ? kcol - qcol + 15 : 31) * 4) << (8 * i); }
    int u = T_.bid;
    AUnit cur = attn_decode(min(u, total - 1), nlatu);
    u32x4 vpre[12];
    s16x8 Qf[4], KA[4], KB[4];
    if (u < total) {
        attn_load_v(vpre, qkv, cur, tid);
        const bf16_t* qp = qkv + (size_t)(((cur.qrow0 >> 5) + qt) * 16 + cur.h) * 2048 + lane * 8;
#pragma unroll
        for (int ks = 0; ks < 4; ++ks) Qf[ks] = *(const s16x8*)(qp + 512 * ks);
        const int t0 = kq * (cur.ntiles >> 2);
        attn_load_k(KA, kf + cur.h * 2048 + lane * 8, cur.b * 128, 1024 + cur.b * 8, t0, cur.ntl, cur.rs);
        attn_load_k(KB, kf + cur.h * 2048 + lane * 8, cur.b * 128, 1024 + cur.b * 8, t0 + 1, cur.ntl, cur.rs);
    }
    while (u < total) {
        const int b = cur.b, h = cur.h, qrow0 = cur.qrow0, r = cur.r, rs = cur.rs, ntl = cur.ntl, ntiles = cur.ntiles;
        int tidl = tid; asm volatile("" : "+v"(tidl));
#pragma unroll
        for (int i = 0; i < 4; ++i) { const int idx = tidl + NTHREADS * i; *(LAS u32x4*)(Vl + (idx >> 3) * AV_STR + (idx & 7) * 16) = vpre[i]; }
        if (ntiles == 24) {
#pragma unroll
            for (int i = 4; i < 12; ++i) { const int idx = tidl + NTHREADS * i; *(LAS u32x4*)(Vl + (idx >> 3) * AV_STR + (idx & 7) * 16) = vpre[i]; } }
        if (tid < 480) { const int rr = tid >> 5, dd = tid & 31; tab[tid] = dd < 31 ? (rpb[h * 465 + rr * 31 + dd] - mb) * LOG2E : -1e30f; }
        const bf16_t* kbase = kf + h * 2048 + lane * 8;
        const int klat0 = b * 128, kctx0 = 1024 + b * 8;
        const int ntw = ntiles >> 2, t0 = kq * ntw;
        __syncthreads();
        f32x16 O0, O1;
#pragma unroll
        for (int i = 0; i < 16; ++i) { O0[i] = 0.f; O1[i] = 0.f; }
        float lsum = 0.f;
#pragma unroll 1
        for (int t = 0; t < ntw; t += 2) {
            { const int kt = t0 + t; const int mode = kt >= ntl ? 0 : ((kt & 1) == qt ? 1 : 2 + qt);
              attn_one_tile(KA, Qf, Vl + (kt * 32 + 4 * hi + tr_q) * AV_STR + (16 * dgrp + 4 * tr_p) * 2, (const LAS unsigned char*)tab + (rs + (kt >> 1) - r + 7) * 128, offo, offx, O0, O1, lsum, mode, mbl); }
            __builtin_amdgcn_sched_barrier(0);
            attn_load_k(KA, kbase, klat0, kctx0, t0 + min(t + 2, ntw - 2), ntl, rs);
            { const int kt = t0 + t + 1; const int mode = kt >= ntl ? 0 : ((kt & 1) == qt ? 1 : 2 + qt);
              attn_one_tile(KB, Qf, Vl + (kt * 32 + 4 * hi + tr_q) * AV_STR + (16 * dgrp + 4 * tr_p) * 2, (const LAS unsigned char*)tab + (rs + (kt >> 1) - r + 7) * 128, offo, offx, O0, O1, lsum, mode, mbl); }
            __builtin_amdgcn_sched_barrier(0);
            attn_load_k(KB, kbase, klat0, kctx0, t0 + min(t + 2, ntw - 2) + 1, ntl, rs);
        }
        const int un = u + T_.gsz;
        const AUnit nxt = attn_decode(min(un, total - 1), nlatu);
        int tidm = tid; asm volatile("" : "+v"(tidm));
        if (un < total) attn_load_v(vpre, qkv, nxt, tidm);
        __syncthreads();
#pragma unroll
        for (int j = 0; j < 4; ++j) {
            *(LAS f32x4*)(Ored + (size_t)((kq * 64 + 32 * qt + l31) * 68 + 8 * j + 4 * hi)) = (f32x4){O0[4 * j], O0[4 * j + 1], O0[4 * j + 2], O0[4 * j + 3]};
            *(LAS f32x4*)(Ored + (size_t)((kq * 64 + 32 * qt + l31) * 68 + 32 + 8 * j + 4 * hi)) = (f32x4){O1[4 * j], O1[4 * j + 1], O1[4 * j + 2], O1[4 * j + 3]}; }
        lred[(kq * 2 + hi) * 64 + 32 * qt + l31] = lsum;
        if (un < total) {
            const bf16_t* qp = qkv + (size_t)(((nxt.qrow0 >> 5) + qt) * 16 + nxt.h) * 2048 + lane * 8;
#pragma unroll
            for (int ks = 0; ks < 4; ++ks) Qf[ks] = *(const s16x8*)(qp + 512 * ks);
            const int t0n = kq * (nxt.ntiles >> 2);
            attn_load_k(KA, kf + nxt.h * 2048 + lane * 8, nxt.b * 128, 1024 + nxt.b * 8, t0n, nxt.ntl, nxt.rs);
            attn_load_k(KB, kf + nxt.h * 2048 + lane * 8, nxt.b * 128, 1024 + nxt.b * 8, t0n + 1, nxt.ntl, nxt.rs);
        }
        __syncthreads();
        { const int q = tid >> 3, d8 = (tid & 7) * 8;
          f32x4 s0 = (f32x4){0.f, 0.f, 0.f, 0.f}, s1 = s0; float l = 0.f;
#pragma unroll
          for (int k = 0; k < 4; ++k) { s0 += *(const LAS f32x4*)(Ored + (k * 64 + q) * 68 + d8); s1 += *(const LAS f32x4*)(Ored + (k * 64 + q) * 68 + d8 + 4); l += lred[(k * 2) * 64 + q] + lred[(k * 2 + 1) * 64 + q]; }
          const float inv = 1.0f / l;
          u32x4 o; o.x = pkb(s0.x * inv, s0.y * inv); o.y = pkb(s0.z * inv, s0.w * inv); o.z = pkb(s1.x * inv, s1.y * inv); o.w = pkb(s1.z * inv, s1.w * inv);
          *(u32x4*)(ao + (size_t)(qrow0 + q) * 1024 + h * 64 + d8) = o; }
        __syncthreads();
        u = un; cur = nxt;
    }
}

constexpr int SP_RS = 320;
__device__ __forceinline__ void phase_spatial_mfma(const Params& p, int sl, int M, LAS unsigned char* lds, const Tix T_, const bool dummy = false) {
    bf16_t* vb = (bf16_t*)(p.ws + OFF_BIG); const float* lnacc = (const float*)(p.ws + OFF_LNACC) + (size_t)sl * MTOT * 2;
    const float* lng = p.sg_ln_g + sl * 3072; const float* lnb = p.sg_ln_b + sl * 3072;
    const int tid = T_.tid, lane = tid & 63, wave = __builtin_amdgcn_readfirstlane(tid >> 6), pt = wave & 3, cth = wave >> 2, l31 = lane & 31, hi = lane >> 5;
    const int tr_q = (lane & 15) >> 2, tr_p = lane & 3, dgrp = (lane >> 4) & 1;
    const int nunits = (M / 128) * 24;
    const int c8 = (tid & 15) * 8;
    s16x8 wx[8]; u32x4 vw[4]; f32x2 st2[4]; f32x4 g0, g1, b0, b1; float bs;
    const bf16_t* wsf = (const bf16_t*)(p.ws + OFF_WSF);
#define SP_LOAD(uu) do { const int nc_ = (uu) / 24, g_ = (uu) % 24, r0_ = nc_ * 128; \
        const bf16_t* wp_ = wsf + ((size_t)((sl * 24 + g_) * 4 + pt) * 8) * 512 + lane * 8; \
        _Pragma("unroll") for (int ks = 0; ks < 8; ++ks) wx[ks] = *(const s16x8*)(wp_ + ks * 512); \
        _Pragma("unroll") for (int i = 0; i < 4; ++i) { const int q_ = (tid + NTHREADS * i) >> 4; \
            vw[i] = *(const u32x4*)(vb + (size_t)(r0_ + q_) * 3072 + g_ * 128 + c8); st2[i] = *(const f32x2*)(lnacc + 2 * (r0_ + q_)); } \
        g0 = *(const f32x4*)(lng + g_ * 128 + c8); g1 = *(const f32x4*)(lng + g_ * 128 + c8 + 4); b0 = *(const f32x4*)(lnb + g_ * 128 + c8); b1 = *(const f32x4*)(lnb + g_ * 128 + c8 + 4); \
        bs = p.sg_b_s[((size_t)sl * 24 + g_) * 128 + 32 * pt + l31]; } while (0)
    int u = T_.bid, buf = 0;
    if (u < nunits) SP_LOAD(u);
    while (u < nunits) {
        const int nc = u / 24, g = u % 24, r0 = nc * 128;
        LAS unsigned char* tile = lds + buf * (128 * SP_RS);
#pragma unroll
        for (int i = 0; i < 4; ++i) { const int q = (tid + NTHREADS * i) >> 4; const u32x4 w = vw[i];
            const float mean = st2[i].x * (1.0f / 3072.0f), rstd = 1.0f / sqrtf(fmaxf(st2[i].y * (1.0f / 3072.0f) - mean * mean, 0.f) + 1e-6f);
            u32x4 o;
            o.x = pkb((bf2f(w.x & 0xffffu) - mean) * rstd * g0.x + b0.x, (bf2f(w.x >> 16) - mean) * rstd * g0.y + b0.y);
            o.y = pkb((bf2f(w.y & 0xffffu) - mean) * rstd * g0.z + b0.z, (bf2f(w.y >> 16) - mean) * rstd * g0.w + b0.w);
            o.z = pkb((bf2f(w.z & 0xffffu) - mean) * rstd * g1.x + b1.x, (bf2f(w.z >> 16) - mean) * rstd * g1.y + b1.y);
            o.w = pkb((bf2f(w.w & 0xffffu) - mean) * rstd * g1.z + b1.z, (bf2f(w.w >> 16) - mean) * rstd * g1.w + b1.w);
            *(LAS u32x4*)(tile + q * SP_RS + c8 * 2) = o; }
        s16x8 Wf[8];
#pragma unroll
        for (int ks = 0; ks < 8; ++ks) Wf[ks] = wx[ks];
        const float bsc = bs;
        __syncthreads();
        const int un = u + T_.gsz;
        if (un < nunits) SP_LOAD(un);
        __builtin_amdgcn_sched_barrier(0);
#pragma unroll
        for (int cc = 0; cc < 2; ++cc) { const int ct = 2 * cth + cc;
            f32x16 acc;
#pragma unroll
            for (int i = 0; i < 16; ++i) acc[i] = 0.f;
            const LAS unsigned char* ab = tile + (8 * hi + tr_q) * SP_RS + (32 * ct + 16 * dgrp + 4 * tr_p) * 2;
#pragma unroll
            for (int ks = 0; ks < 8; ++ks) { const s16x8 Af = tr_pair(ab + 16 * ks * SP_RS, 4 * SP_RS); acc = MFMA32(Af, Wf[ks], acc); }
            bf16_t* orow = (dummy ? vb + (size_t)MTOT * 3072 + (size_t)((r0 + 32 * pt + l31) & 8191) * 3072 : vb + (size_t)(r0 + 32 * pt + l31) * 3072) + g * 128 + 32 * ct + 4 * hi;
#pragma unroll
            for (int j = 0; j < 4; ++j) { u32x2 o; o.x = pkb(acc[4 * j] + bsc, acc[4 * j + 1] + bsc); o.y = pkb(acc[4 * j + 2] + bsc, acc[4 * j + 3] + bsc); *(u32x2*)(orow + 8 * j) = o; }
        }
        u = un; buf ^= 1;
    }
#undef SP_LOAD
    __syncthreads();
}

template <class F> struct EpiG {
    static constexpr bool PERM = false, AFTER_DRAIN = false;
    F f;
    __device__ __forceinline__ void operator()(const f32x4 (&acc)[2][2][4][2], const Unit& u, int wr, int wc, int fr, int fq) const {
        F g = f; const int colb = u.pn * 256 + 64 * wc + 8 * fq, rowbase = u.pm * 256 + wr * 64 + fr;
        g.begin(u, colb, fq, rowbase);
#ifdef EPI_TWICE
        if (F::IDEMP) {
#pragma unroll
        for (int ai = 0; ai < 2; ++ai)
#pragma unroll
            for (int m = 0; m < 4; ++m) {
                g.row(ai * 4 + m, rowbase + ai * 128 + m * 16, colb, acc[ai][0][m][0], acc[ai][0][m][1], acc[ai][1][m][0], acc[ai][1][m][1]);
                asm volatile("" ::: "memory"); }
        }
#endif
#pragma unroll
        for (int ai = 0; ai < 2; ++ai)
#pragma unroll
            for (int m = 0; m < 4; ++m) {
                g.row(ai * 4 + m, rowbase + ai * 128 + m * 16, colb, acc[ai][0][m][0], acc[ai][0][m][1], acc[ai][1][m][0], acc[ai][1][m][1]);
                asm volatile("" ::: "memory"); }
    }
};
__device__ __forceinline__ int epi_row(int rowbase, int idx) { return rowbase + 128 * (idx >> 2) + 16 * (idx & 3); }
__device__ __forceinline__ void store8_bf16(bf16_t* o, const f32x4 a, const f32x4 b) { u32x4 w; w.x = pk2(a.x, a.y); w.y = pk2(a.z, a.w); w.z = pk2(b.x, b.y); w.w = pk2(b.z, b.w); *(u32x4*)o = w; }
__device__ __forceinline__ float sumsq4(const f32x4 x) { return (x.x * x.x + x.y * x.y) + (x.z * x.z + x.w * x.w); }
__device__ __forceinline__ float sum4(const f32x4 x) { return (x.x + x.y) + (x.z + x.w); }
__device__ __forceinline__ float rstd_from(float ssq) { return 1.0f / sqrtf(ssq * (1.0f / 1024.0f) + 1e-6f); }
__device__ __forceinline__ void atomic_addf(float* p, float v) { __hip_atomic_fetch_add(p, v, __ATOMIC_RELAXED, __HIP_MEMORY_SCOPE_AGENT); }
struct RowSsq { float v[8];
    __device__ __forceinline__ void load(const float* ssq, int rowbase) {
#pragma unroll
        for (int i = 0; i < 8; ++i) v[i] = ssq[epi_row(rowbase, i)]; } };

struct FQKV { static constexpr bool IDEMP = true; bf16_t* O; const float* qg; const float* kg; const float* ssq; const float* bias;
    f32x4 gn[4], bz[4]; int sect; RowSsq rq;
    __device__ __forceinline__ void begin(const Unit& u, int colb, int fq, int rowbase) {
        rq.load(ssq, rowbase);
        sect = u.pn >> 2; const int b = min(u.pm >> 4, 8); const float* bp = bias + (size_t)b * 3072 + colb;
        bz[0] = *(const f32x4*)bp; bz[1] = *(const f32x4*)(bp + 4); bz[2] = *(const f32x4*)(bp + 32); bz[3] = *(const f32x4*)(bp + 36);
        if (sect < 2) { const float* gp = (sect == 0 ? qg : kg) + 8 * fq; const float mul = sect == 0 ? 0.125f * 1.4426950408889634f : 1.0f;
            gn[0] = *(const f32x4*)gp * mul; gn[1] = *(const f32x4*)(gp + 4) * mul; gn[2] = *(const f32x4*)(gp + 32) * mul; gn[3] = *(const f32x4*)(gp + 36) * mul; } }
    __device__ __forceinline__ void row(int idx, int row, int colb, f32x4 a0, f32x4 b0, f32x4 a1, f32x4 b1) {
        const float rs = rstd_from(rq.v[idx]);
        a0 = a0 * rs + bz[0]; b0 = b0 * rs + bz[1]; a1 = a1 * rs + bz[2]; b1 = b1 * rs + bz[3];
        if (sect < 2) { float ss = (sumsq4(a0) + sumsq4(b0)) + (sumsq4(a1) + sumsq4(b1));
            ss += __shfl_xor(ss, 16); ss += __shfl_xor(ss, 32);
            const float r2 = 1.0f / sqrtf(ss * (1.0f / 64.0f) + 1e-6f);
            a0 = a0 * r2 * gn[0]; b0 = b0 * r2 * gn[1]; a1 = a1 * r2 * gn[2]; b1 = b1 * r2 * gn[3]; }
        if (sect < 2) {
            const int within = colb & 1023, h = within >> 6, fq = (within >> 3) & 7;
            bf16_t* op = O + (size_t)sect * MTOT * 1024 + ((size_t)((row >> 5) * 16 + h) * 4 + (fq >> 1)) * 512 + ((fq & 1) * 32 + (row & 31)) * 8;
            store8_bf16(op, a0, b0); store8_bf16(op + 2 * 512, a1, b1);
        } else { bf16_t* op = O + (size_t)2 * MTOT * 1024 + (size_t)row * 1024 + (colb - 2048); store8_bf16(op, a0, b0); store8_bf16(op + 32, a1, b1); } } };
struct FSqrelu { static constexpr bool IDEMP = true; bf16_t* O; const float* ssq; const float* bias;
    f32x4 bz[4]; RowSsq rq;
    __device__ __forceinline__ void begin(const Unit& u, int colb, int fq, int rowbase) { rq.load(ssq, rowbase); const int b = min(u.pm >> 4, 8); const float* bp = bias + (size_t)b * 4096 + colb;
        bz[0] = *(const f32x4*)bp; bz[1] = *(const f32x4*)(bp + 4); bz[2] = *(const f32x4*)(bp + 32); bz[3] = *(const f32x4*)(bp + 36); }
    __device__ __forceinline__ void row(int idx, int row, int colb, f32x4 a0, f32x4 b0, f32x4 a1, f32x4 b1) {
        const float rs = rstd_from(rq.v[idx]); const f32x4 z = (f32x4){0.f, 0.f, 0.f, 0.f};
        a0 = __builtin_elementwise_max(a0 * rs + bz[0], z); b0 = __builtin_elementwise_max(b0 * rs + bz[1], z); a1 = __builtin_elementwise_max(a1 * rs + bz[2], z); b1 = __builtin_elementwise_max(b1 * rs + bz[3], z);
        bf16_t* op = O + (size_t)row * 4096 + colb; store8_bf16(op, a0 * a0, b0 * b0); store8_bf16(op + 32, a1 * a1, b1 * b1); } };
struct FGeluV { static constexpr bool IDEMP = false; bf16_t* O; const float* ssq; const float* bias; float* lnacc;
    f32x4 bz[4]; int fq_; RowSsq rq;
    __device__ __forceinline__ void begin(const Unit& u, int colb, int fq, int rowbase) { rq.load(ssq, rowbase); const int b = min(u.pm >> 4, 8); const float* bp = bias + (size_t)b * 6144 + colb; fq_ = fq;
        bz[0] = *(const f32x4*)bp; bz[1] = *(const f32x4*)(bp + 4); bz[2] = *(const f32x4*)(bp + 32); bz[3] = *(const f32x4*)(bp + 36); }
    __device__ __forceinline__ void row(int idx, int row, int colb, f32x4 a0, f32x4 b0, f32x4 a1, f32x4 b1) {
        const float rs = rstd_from(rq.v[idx]);
        a0 = gelu4(a0 * rs + bz[0]); b0 = gelu4(b0 * rs + bz[1]); a1 = gelu4(a1 * rs + bz[2]); b1 = gelu4(b1 * rs + bz[3]);
        bf16_t* op = O + (size_t)row * 3072 + colb; store8_bf16(op, a0, b0); store8_bf16(op + 32, a1, b1);
        float s1 = (sum4(a0) + sum4(b0)) + (sum4(a1) + sum4(b1)), s2 = (sumsq4(a0) + sumsq4(b0)) + (sumsq4(a1) + sumsq4(b1));
        s1 += __shfl_xor(s1, 16); s1 += __shfl_xor(s1, 32); s2 += __shfl_xor(s2, 16); s2 += __shfl_xor(s2, 32);
        if (fq_ == 0) { atomic_addf(lnacc + 2 * (size_t)row, s1); atomic_addf(lnacc + 2 * (size_t)row + 1, s2); } } };
struct FGeluU { static constexpr bool IDEMP = false; bf16_t* O; const float* ssq; const float* bias;
    f32x4 bz[4]; RowSsq rq; u32x4 sv[2][2]; int rowbase_;
    __device__ __forceinline__ void fetch(int idx, int colb) { const bf16_t* op = O + (size_t)epi_row(rowbase_, idx) * 3072 + colb; sv[idx & 1][0] = *(const u32x4*)op; sv[idx & 1][1] = *(const u32x4*)(op + 32); }
    __device__ __forceinline__ void begin(const Unit& u, int colb, int fq, int rowbase) { rq.load(ssq, rowbase); rowbase_ = rowbase; fetch(0, colb);
        const int b = min(u.pm >> 4, 8); const float* bp = bias + (size_t)b * 6144 + colb;
        bz[0] = *(const f32x4*)bp; bz[1] = *(const f32x4*)(bp + 4); bz[2] = *(const f32x4*)(bp + 32); bz[3] = *(const f32x4*)(bp + 36); }
    __device__ __forceinline__ static f32x4 lo4(const u32x4 s) { return (f32x4){bf2f(s.x & 0xffffu), bf2f(s.x >> 16), bf2f(s.y & 0xffffu), bf2f(s.y >> 16)}; }
    __device__ __forceinline__ static f32x4 hi4(const u32x4 s) { return (f32x4){bf2f(s.z & 0xffffu), bf2f(s.z >> 16), bf2f(s.w & 0xffffu), bf2f(s.w >> 16)}; }
    __device__ __forceinline__ void row(int idx, int row, int colb, f32x4 a0, f32x4 b0, f32x4 a1, f32x4 b1) {
        if (idx < 7) fetch(idx + 1, colb);
        const float rs = rstd_from(rq.v[idx]);
        bf16_t* op = O + (size_t)row * 3072 + colb; const u32x4 sv0 = sv[idx & 1][0], sv1 = sv[idx & 1][1];
        a0 = gelu4(a0 * rs + bz[0]) * lo4(sv0); b0 = gelu4(b0 * rs + bz[1]) * hi4(sv0); a1 = gelu4(a1 * rs + bz[2]) * lo4(sv1); b1 = gelu4(b1 * rs + bz[3]) * hi4(sv1);
        store8_bf16(op, a0, b0); store8_bf16(op + 32, a1, b1); } };
struct FResid { static constexpr bool IDEMP = false; const float* inl; const float* inc; float* outl; float* outc; const float* gate;
    const float* gsn; bf16_t* xb; float* ssqn;
    f32x4 gz[4], gsz[4], xin[2][4]; int fq_, rowbase_;
    __device__ __forceinline__ void fetch(int idx, int colb) { const int row = epi_row(rowbase_, idx);
        const float* ip = row < NLAT ? inl + (size_t)row * 1024 + colb : inc + (size_t)(row - NLAT) * 1024 + colb;
        xin[idx & 1][0] = *(const f32x4*)ip; xin[idx & 1][1] = *(const f32x4*)(ip + 4); xin[idx & 1][2] = *(const f32x4*)(ip + 32); xin[idx & 1][3] = *(const f32x4*)(ip + 36); }
    __device__ __forceinline__ void begin(const Unit& u, int colb, int fq, int rowbase) { const int b = min(u.pm >> 4, 8); fq_ = fq; rowbase_ = rowbase; fetch(0, colb);
        const float* gp = gate + (size_t)b * 6144 + colb;
        gz[0] = *(const f32x4*)gp; gz[1] = *(const f32x4*)(gp + 4); gz[2] = *(const f32x4*)(gp + 32); gz[3] = *(const f32x4*)(gp + 36);
        if (gsn) { const float* sp = gsn + (size_t)b * 1024 + colb; gsz[0] = *(const f32x4*)sp; gsz[1] = *(const f32x4*)(sp + 4); gsz[2] = *(const f32x4*)(sp + 32); gsz[3] = *(const f32x4*)(sp + 36); } }
    __device__ __forceinline__ void row(int idx, int row, int colb, f32x4 a0, f32x4 b0, f32x4 a1, f32x4 b1) {
        if (idx < 7) fetch(idx + 1, colb);
        float* op = row < NLAT ? outl + (size_t)row * 1024 + colb : outc + (size_t)(row - NLAT) * 1024 + colb;
        a0 = xin[idx & 1][0] + gz[0] * a0; b0 = xin[idx & 1][1] + gz[1] * b0; a1 = xin[idx & 1][2] + gz[2] * a1; b1 = xin[idx & 1][3] + gz[3] * b1;
        *(f32x4*)op = a0; *(f32x4*)(op + 4) = b0; *(f32x4*)(op + 32) = a1; *(f32x4*)(op + 36) = b1;
        if (gsn) { float ss = (sumsq4(a0) + sumsq4(b0)) + (sumsq4(a1) + sumsq4(b1));
            ss += __shfl_xor(ss, 16); ss += __shfl_xor(ss, 32);
            if (fq_ == 0) atomic_addf(ssqn + row, ss);
            bf16_t* xp = xb + (size_t)row * 1024 + colb; store8_bf16(xp, a0 * gsz[0], b0 * gsz[1]); store8_bf16(xp + 32, a1 * gsz[2], b1 * gsz[3]); } } };

template <class F> __device__ __forceinline__ void run_gemm(LAS unsigned char* lds, const bf16_t* A, const bf16_t* Bt, int M, int N, int K, const F& f, const Tix T_) {
    pg8::StaticOrder S; S.init(M, N, T_.gsz, T_.bid);
    pg8::Gemm g; g.A = A; g.Bt = Bt; g.M = M; g.N = N; g.K = K;
    EpiG<F> E; E.f = f;
    pg8::gemm_phase<EpiG<F>, pg8::StaticOrder, true, true>(lds, g, S, E, T_.tid);
}

enum { OP_QKV, OP_ATTN, OP_MIXOUT, OP_MLP1, OP_MLP2, OP_VGEMM, OP_SPATIAL, OP_UGEMM, OP_PROLOGUE, OP_PHASE0B };

__device__ __forceinline__ void decode_phase(int ph, int& L, int& op) {
    L = 0; op = ph == 0 ? OP_PROLOGUE : OP_PHASE0B;
    if (ph > 1) {
        int q = ph - 2;
        if (q < 5) { L = 0; } else if (q < 11) { L = 1; q -= 5; } else if (q < 16) { L = 2; q -= 11; } else { L = 3; q -= 16; }
        if ((L & 1) == 0) op = q == 0 ? OP_QKV : q == 1 ? OP_ATTN : q == 2 ? OP_MIXOUT : q == 3 ? OP_MLP1 : OP_MLP2;
        else op = q == 0 ? OP_VGEMM : q == 1 ? OP_SPATIAL : q == 2 ? OP_UGEMM : q == 3 ? OP_MIXOUT : q == 4 ? OP_MLP1 : OP_MLP2;
    }
}

__device__ __forceinline__ void run_phase(const Params& p, int ph, LAS unsigned char* lds, const Tix T_) {
    int L, op; decode_phase(ph, L, op);
#ifdef ONLY_OP
    op = ONLY_OP;
#endif
    const int mi = L >> 1;
    const bool attnL = (L & 1) == 0;
    const int Mfull = L < 2 ? MTOT : NLAT;
    const float* modsl = (const float*)(p.ws + OFF_MODS) + (size_t)L * 9 * 6144;
    float* ctxr = (float*)(p.ws + OFF_CTXR);
    bf16_t* hb = (bf16_t*)(p.ws + OFF_HB); bf16_t* big = (bf16_t*)(p.ws + OFF_BIG);
    float* ssq = (float*)(p.ws + OFF_SSQ); const float* gs = (const float*)(p.ws + OFF_GS);
    const bool first = (L == 0);
    switch (op) {
    case OP_PROLOGUE: phase_zero(p, T_); phase_mods(p, lds, T_); __syncthreads(); phase_convert(p, lds, T_); break;
    case OP_PHASE0B: phase_0b(p, lds, T_); break;
    case OP_QKV: { FQKV f; f.O = big; f.qg = p.na_q_norm + mi * 64; f.kg = p.na_k_norm + mi * 64; f.ssq = ssq + (size_t)(2 * L) * MTOT; f.bias = (const float*)(p.ws + OFF_BQKV) + (size_t)mi * 9 * 3072;
        run_gemm(lds, hb, (const bf16_t*)(p.ws + OFF_QKVT) + (size_t)mi * 3072 * 1024, MTOT, 3072, 1024, f, T_); } break;
    case OP_ATTN: phase_attn_mfma(p, mi, L == 0, lds, T_); break;
    case OP_MIXOUT: case OP_MLP2: {
        FResid f; const bool mo = (op == OP_MIXOUT);
        f.inl = (first && mo) ? p.x : p.out; f.inc = (first && mo) ? p.ctx : ctxr; f.outl = p.out; f.outc = ctxr; f.gate = modsl + (mo ? 2048 : 5120);
        const int nn = mo ? 2 * L + 1 : 2 * L + 2;
        const bool has_next = nn < 8 && !(nn == 6 + 0 && false);
        f.gsn = has_next ? gs + (size_t)nn * 9 * 1024 : nullptr; f.xb = hb; f.ssqn = ssq + (size_t)(has_next ? nn : 0) * MTOT;
        const bf16_t* A; const bf16_t* Bt; int K;
        if (!mo) { A = big; Bt = (const bf16_t*)(p.ws + OFF_W2T) + (size_t)L * 1024 * 4096; K = 4096; }
        else if (attnL) { A = big + (size_t)MTOT * 3072; Bt = (const bf16_t*)(p.ws + OFF_WOT) + (size_t)mi * 1024 * 1024; K = 1024; }
        else { A = big; Bt = (const bf16_t*)(p.ws + OFF_SGOT) + (size_t)mi * 1024 * 3072; K = 3072; }
        run_gemm(lds, A, Bt, Mfull, 1024, K, f, T_); } break;
    case OP_MLP1: { FSqrelu f; f.O = big; f.ssq = ssq + (size_t)(2 * L + 1) * MTOT; f.bias = (const float*)(p.ws + OFF_BMLP) + (size_t)L * 9 * 4096;
        run_gemm(lds, hb, (const bf16_t*)(p.ws + OFF_W1T) + (size_t)L * 4096 * 1024, Mfull, 4096, 1024, f, T_); } break;
    case OP_VGEMM: { FGeluV f; f.O = big; f.ssq = ssq + (size_t)(2 * L) * MTOT; f.bias = (const float*)(p.ws + OFF_BWIN) + (size_t)mi * 9 * 6144 + 3072; f.lnacc = (float*)(p.ws + OFF_LNACC) + (size_t)mi * MTOT * 2;
        run_gemm(lds, hb, (const bf16_t*)(p.ws + OFF_WINT) + (size_t)mi * 6144 * 1024 + (size_t)3072 * 1024, Mfull, 3072, 1024, f, T_); } break;
#ifdef REP_SPATIAL
    case OP_SPATIAL: phase_spatial_mfma(p, mi, Mfull, lds, T_, true); __syncthreads(); phase_spatial_mfma(p, mi, Mfull, lds, T_); break;
#else
    case OP_SPATIAL: phase_spatial_mfma(p, mi, Mfull, lds, T_); break;
#endif
    case OP_UGEMM: { FGeluU f; f.O = big; f.ssq = ssq + (size_t)(2 * L) * MTOT; f.bias = (const float*)(p.ws + OFF_BWIN) + (size_t)mi * 9 * 6144;
        run_gemm(lds, hb, (const bf16_t*)(p.ws + OFF_WINT) + (size_t)mi * 6144 * 1024, Mfull, 3072, 1024, f, T_); } break;
    default: break;
    }
}

#ifndef ONE_LAUNCH
#define ONE_LAUNCH 1
#endif
__global__ void __launch_bounds__(NTHREADS) mk(Params p0) {
    extern __shared__ __attribute__((aligned(16))) unsigned char lds_raw[];
    LAS unsigned char* lds = (LAS unsigned char*)lds_raw;
#if ONE_LAUNCH
    cg::grid_group grid = cg::this_grid();
    if (p0.ph_lo < 0) grid.sync();
    volatile LAS unsigned* st = (volatile LAS unsigned*)(lds + 131072);
    if (threadIdx.x == 0) { st[0] = 0u; st[1] = 0u; }
    __syncthreads();
    const XcdBarrier xbar = xcd_barrier_post((unsigned*)(p0.ws + OFF_BAR), st);
    bool first_it = true, repeated = false;
    for (int ph = p0.ph_lo; ph < p0.ph_hi; ) {
        if (!first_it) xcd_barrier(xbar);
        first_it = false;
        Tix T_; T_.tid = threadIdx.x; T_.bid = blockIdx.x; T_.gsz = gridDim.x;
        size_t z = 0;
        asm volatile("" : "+v"(T_.tid)); asm volatile("" : "+s"(T_.bid), "+s"(T_.gsz), "+s"(z));
        Params p = p0;
        { const float** pp = (const float**)&p;
#pragma unroll
          for (int i = 0; i < 22; ++i) pp[i] += z; }
        p.out += z; p.ws += z;
        run_phase(p, ph, lds, T_);
        __syncthreads();
        if (REP_MASK != 0) { int L_, op_; decode_phase(ph, L_, op_); if (((REP_MASK >> op_) & 1) && !repeated) { repeated = true; continue; } }
        repeated = false; ++ph;
    }
#else
    Tix T_; T_.tid = threadIdx.x; T_.bid = blockIdx.x; T_.gsz = gridDim.x;
    run_phase(p0, p0.ph_lo, lds, T_);
#endif
}

extern "C" void kernel_launch(void* const* d_in, const int* in_sizes, int n_in, void* d_out, int out_size, void* d_ws, size_t ws_size, hipStream_t stream) {
    static int grid = 0;
    if (grid == 0) {
        if (n_in != 22 || ws_size < WS_END) { fprintf(stderr, "kernel_launch: unexpected n_in %d or ws_size %zu (< %zu)\n", n_in, ws_size, (size_t)WS_END); grid = -1; return; }
        int dev = 0, cus = 0, per_cu = 0;
        hipGetDevice(&dev); hipDeviceGetAttribute(&cus, hipDeviceAttributeMultiprocessorCount, dev);
        if (hipFuncSetAttribute((const void*)mk, hipFuncAttributeMaxDynamicSharedMemorySize, LDS_BYTES) != hipSuccess) { fprintf(stderr, "kernel_launch: hipFuncSetAttribute failed\n"); grid = -1; return; }
        if (hipOccupancyMaxActiveBlocksPerMultiprocessor(&per_cu, (const void*)mk, NTHREADS, LDS_BYTES) != hipSuccess || per_cu < 1) { fprintf(stderr, "kernel_launch: occupancy query says %d\n", per_cu); per_cu = 1; }
        (void)hipGetLastError();
        grid = cus;
    }
    if (grid < 0) return;
    if (hipMemsetAsync((unsigned char*)d_ws + OFF_BAR, 0, 16384, stream) != hipSuccess) { fprintf(stderr, "kernel_launch: memset of the barrier words failed\n"); return; }
    Params p{};
    const float** pp = (const float**)&p;
    for (int i = 0; i < 22; ++i) pp[i] = (const float*)d_in[i];
    p.out = (float*)d_out; p.ws = (unsigned char*)d_ws;
#if ONE_LAUNCH
    p.ph_lo = 0; p.ph_hi = NPH;
    void* args[] = {&p};
    hipError_t e = hipLaunchCooperativeKernel((void*)mk, dim3(grid), dim3(NTHREADS), args, LDS_BYTES, stream);
    if (e != hipSuccess) fprintf(stderr, "cooperative launch failed: %s (grid %d)\n", hipGetErrorString(e), grid);
#else
    for (int ph = 0; ph < NPH; ++ph) { p.ph_lo = ph; p.ph_hi = ph + 1; hipLaunchKernelGGL(mk, dim3(grid), dim3(NTHREADS), LDS_BYTES, stream, p); }
#endif
}
```

```cpp
#include <hip/hip_runtime.h>
#include <hip/hip_cooperative_groups.h>
#include <cstdio>
#include <cstdint>
namespace cg = cooperative_groups;
namespace pg8 {
#define PG8_LAS __attribute__((address_space(3)))
typedef unsigned short bf16_t;
typedef short bf16x8 __attribute__((ext_vector_type(8)));
typedef float f32x4 __attribute__((ext_vector_type(4)));
typedef unsigned u32x4 __attribute__((ext_vector_type(4)));
constexpr int BM = 256, BK = 64, HALF = 128, HTB = HALF * BK * 2  , STAGE_BYTES = 8 * HTB, NXCD = 8, WGM = 8;

__host__ __device__ __forceinline__ int lds_byte(int r, int c) { const int st = (r >> 4) * 2 + (c >> 5), rr = r & 15, cc = c & 31, ob = rr * 64 + cc * 2; return st * 1024 + (ob ^ (((ob >> 9) & 1) << 5)); }
__host__ __device__ __forceinline__ void stage_rc(int b, int& R, int& C) { const int st = b / 1024, sb = b % 1024, swz = sb ^ (((sb >> 9) & 1) << 5); R = (st >> 1) * 16 + swz / 64; C = (st & 1) * 32 + (swz % 64) / 2; }
__host__ __device__ __forceinline__ int perm32(int rho) { const int n = rho >> 4, i = rho & 15; return 8 * (i >> 2) + 4 * n + (i & 3); }

struct Unit { int pm, pn; };
struct Gemm { const bf16_t* A; const bf16_t* Bt; int M, N, K; };

struct StaticOrder {
    int nM, nN, nwg, G, c;
    __host__ __device__ void init(int M, int N, int G_, int c_) { nM = M / BM; nN = N / BM; nwg = nM * nN; G = G_; c = c_; }
    __host__ __device__ bool next(int i, Unit& u) const {
        const long L = (long)i * G + c; if (L >= nwg) return false;
        int wgid = (int)L; { const int q = nwg / NXCD, r = nwg % NXCD, xcd = wgid % NXCD, off = wgid / NXCD; wgid = (xcd < r ? xcd * (q + 1) : r * (q + 1) + (xcd - r) * q) + off; }
        const int nig = WGM * nN, gid = wgid / nig, fm = gid * WGM, gsz = (nM - fm) < WGM ? (nM - fm) : WGM;
        u.pm = fm + ((wgid % nig) % gsz); u.pn = (wgid % nig) / gsz; return true;
    }
    __device__ __forceinline__ void a_ready(const Unit&) const {}
    __device__ __forceinline__ void done(const Unit&) const {}
};

__device__ __forceinline__ unsigned cvt_pk_bf16(float lo, float hi) { unsigned r; asm volatile("v_cvt_pk_bf16_f32 %0, %1, %2" : "=v"(r) : "v"(lo), "v"(hi)); return r; }
template <class Epi, class Sched, bool ALIGN_EPI = false, bool SP2 = false>
__device__ __forceinline__ void gemm_phase(PG8_LAS unsigned char* lds, const Gemm g, const Sched& S, const Epi& E, const int tid_in) {
    const int tid = tid_in, wid = __builtin_amdgcn_readfirstlane(tid >> 6), lane = tid & 63, wr = wid >> 2, wc = wid & 3, fr = lane & 15, fq = lane >> 4;
    const int K = g.K, nt = K / BK;
    unsigned voffA[2], voffB[2];
#pragma unroll
    for (int i = 0; i < 2; ++i) { int R, C; stage_rc(tid * 16 + i * 8192, R, C); const int Rb = Epi::PERM ? ((R & ~31) + perm32(R & 31)) : R;
        voffA[i] = (unsigned)(R * K + C) * 2u; voffB[i] = (unsigned)(Rb * K + C) * 2u; }
    const size_t kstep = (size_t)(BK * 2);
    const size_t hstep = (size_t)HALF * K * 2;
    const size_t tstep = 2 * hstep;
    const unsigned ldsw = (unsigned)wid * 1024u;
    const int aoff = lds_byte(wr * 64 + fr, fq * 8), boff = lds_byte(wc * 32 + fr, fq * 8);
#define PG8_SA(b, h) (((b) * 2 + (h)) * HTB)
#define PG8_SB(b, h) ((4 + (b) * 2 + (h)) * HTB)
#define PG8_STAGE(bufoff, gbase, voff) do { _Pragma("unroll") for (int _i = 0; _i < 2; ++_i) \
        __builtin_amdgcn_global_load_lds((const unsigned*)((const char*)(gbase) + (voff)[_i]), (PG8_LAS unsigned*)(lds + (bufoff) + ldsw + _i * 8192), 16, 0, 0); } while (0)
#define PG8_LDA(dst, b, h) do { _Pragma("unroll") for (int m = 0; m < 4; ++m) _Pragma("unroll") for (int k = 0; k < 2; ++k) dst[m][k] = *(const PG8_LAS bf16x8*)(lds + PG8_SA(b, h) + aoff + m * 2048 + k * 1024); } while (0)
#define PG8_LDB(dst, b, h) do { _Pragma("unroll") for (int n = 0; n < 2; ++n) _Pragma("unroll") for (int k = 0; k < 2; ++k) dst[n][k] = *(const PG8_LAS bf16x8*)(lds + PG8_SB(b, h) + boff + n * 2048 + k * 1024); } while (0)
#define PG8_MMA(ai, bj, At, Bt) do { __builtin_amdgcn_s_setprio(1); _Pragma("unroll") for (int m = 0; m < 4; ++m) _Pragma("unroll") for (int n = 0; n < 2; ++n) _Pragma("unroll") for (int k = 0; k < 2; ++k) \
        acc[ai][bj][m][n] = __builtin_amdgcn_mfma_f32_16x16x32_bf16(Bt[n][k], At[m][k], acc[ai][bj][m][n], 0, 0, 0); __builtin_amdgcn_s_setprio(0); } while (0)
#define PG8_WAIT_V(n) asm volatile("s_waitcnt vmcnt(" #n ")" ::: "memory")
#define PG8_WAIT_L(n) asm volatile("s_waitcnt lgkmcnt(" #n ")" ::: "memory")
#define PG8_BAR __builtin_amdgcn_s_barrier()
#define PG8_SCHED __builtin_amdgcn_sched_barrier(0)
    Unit cur, nxt; int ui = 0;
    if (!S.next(0, cur)) return;
    f32x4 acc[2][2][4][2];
#pragma unroll
    for (int a = 0; a < 2; ++a)
#pragma unroll
        for (int b = 0; b < 2; ++b)
#pragma unroll
            for (int m = 0; m < 4; ++m)
#pragma unroll
                for (int n = 0; n < 2; ++n) acc[a][b][m][n] = (f32x4){0.f, 0.f, 0.f, 0.f};
    bf16x8 At[4][2], B0[2][2], B1[2][2];
    const char* cA = (const char*)g.A + (size_t)cur.pm * tstep; const char* cB = (const char*)g.Bt + (size_t)cur.pn * tstep;
    S.a_ready(cur);
    typename Epi::Pre pre; E.prefetch(pre, cur, wr, wc, fr, fq);
    if constexpr (SP2) {
        PG8_STAGE(PG8_SB(0, 0), cB, voffB); PG8_STAGE(PG8_SB(0, 1), cB + hstep, voffB); PG8_STAGE(PG8_SA(0, 0), cA, voffA); PG8_STAGE(PG8_SA(0, 1), cA + hstep, voffA);
        if (wr == 1) PG8_BAR;
        PG8_WAIT_V(2); PG8_BAR;
        PG8_STAGE(PG8_SB(1, 0), cB + kstep, voffB); PG8_STAGE(PG8_SA(1, 0), cA + kstep, voffA); PG8_STAGE(PG8_SB(1, 1), cB + hstep + kstep, voffB);
        PG8_WAIT_V(6); PG8_BAR;
    } else {
        PG8_STAGE(PG8_SB(0, 0), cB, voffB); PG8_STAGE(PG8_SA(0, 0), cA, voffA); PG8_STAGE(PG8_SB(0, 1), cB + hstep, voffB); PG8_STAGE(PG8_SA(0, 1), cA + hstep, voffA);
        if (wr == 1) PG8_BAR;
        PG8_WAIT_V(4); PG8_BAR;
        PG8_STAGE(PG8_SB(1, 0), cB + kstep, voffB); PG8_STAGE(PG8_SA(1, 0), cA + kstep, voffA); PG8_STAGE(PG8_SB(1, 1), cB + hstep + kstep, voffB);
        PG8_WAIT_V(6); PG8_BAR;
    }
    for (;;) {
        const bool has_next = S.next(ui + 1, nxt);
        const char* nA = has_next ? (const char*)g.A + (size_t)nxt.pm * tstep : cA; const char* nB = has_next ? (const char*)g.Bt + (size_t)nxt.pn * tstep : cB;
        for (int t = 0; t < nt; t += 2) {
            const bool last = (t == nt - 2);
            const char* a1 = cA + (size_t)(t + 1) * kstep;
            const char* a2 = last ? nA : cA + (size_t)(t + 2) * kstep; const char* b2 = last ? nB : cB + (size_t)(t + 2) * kstep;
            const char* a3 = a2 + kstep; const char* b3 = b2 + kstep;
            if (last && has_next) S.a_ready(nxt);
            if constexpr (SP2) {
            PG8_LDB(B0, 0, 0); PG8_LDB(B1, 0, 1); PG8_SCHED; PG8_LDA(At, 0, 0); PG8_STAGE(PG8_SA(1, 1), a1 + hstep, voffA);
            PG8_WAIT_V(8); PG8_WAIT_L(0); PG8_BAR; PG8_MMA(0, 0, At, B0); PG8_MMA(0, 1, At, B1); PG8_BAR; PG8_SCHED;
            PG8_LDA(At, 0, 1); PG8_STAGE(PG8_SB(0, 0), b2, voffB); PG8_STAGE(PG8_SB(0, 1), b2 + hstep, voffB); PG8_STAGE(PG8_SA(0, 0), a2, voffA);
            PG8_WAIT_V(8); PG8_WAIT_L(0); PG8_BAR; PG8_MMA(1, 0, At, B0); PG8_MMA(1, 1, At, B1); PG8_BAR; PG8_SCHED;
            PG8_LDB(B0, 1, 0); PG8_LDB(B1, 1, 1); PG8_SCHED; PG8_LDA(At, 1, 0); PG8_STAGE(PG8_SA(0, 1), a2 + hstep, voffA);
            PG8_WAIT_V(8); PG8_WAIT_L(0); PG8_BAR; PG8_MMA(0, 0, At, B0); PG8_MMA(0, 1, At, B1); PG8_BAR; PG8_SCHED;
            PG8_LDA(At, 1, 1); PG8_STAGE(PG8_SB(1, 0), b3, voffB); PG8_STAGE(PG8_SB(1, 1), b3 + hstep, voffB); PG8_STAGE(PG8_SA(1, 0), a3, voffA);
            PG8_WAIT_V(8); PG8_WAIT_L(0); PG8_BAR; PG8_MMA(1, 0, At, B0); PG8_MMA(1, 1, At, B1); PG8_BAR; PG8_SCHED;
            } else {
            PG8_LDB(B0, 0, 0); PG8_SCHED; PG8_LDA(At, 0, 0); PG8_STAGE(PG8_SA(1, 1), a1 + hstep, voffA);
            PG8_WAIT_L(8); PG8_BAR; PG8_WAIT_L(0); PG8_MMA(0, 0, At, B0); PG8_BAR; PG8_SCHED;
            PG8_LDB(B1, 0, 1); PG8_STAGE(PG8_SB(0, 0), b2, voffB);
            PG8_BAR; PG8_WAIT_L(0); PG8_MMA(0, 1, At, B1); PG8_BAR;
            PG8_LDA(At, 0, 1); PG8_STAGE(PG8_SA(0, 0), a2, voffA);
            PG8_BAR; PG8_WAIT_L(0); PG8_MMA(1, 0, At, B0); PG8_BAR; PG8_SCHED;
            PG8_STAGE(PG8_SB(0, 1), b2 + hstep, voffB);
            PG8_WAIT_V(6); PG8_BAR; PG8_MMA(1, 1, At, B1); PG8_BAR;
            PG8_LDB(B0, 1, 0); PG8_SCHED; PG8_LDA(At, 1, 0); PG8_STAGE(PG8_SA(0, 1), a2 + hstep, voffA);
            PG8_WAIT_L(8); PG8_BAR; PG8_WAIT_L(0); PG8_MMA(0, 0, At, B0); PG8_BAR; PG8_SCHED;
            PG8_LDB(B1, 1, 1); PG8_STAGE(PG8_SB(1, 0), b3, voffB);
            PG8_BAR; PG8_WAIT_L(0); PG8_MMA(0, 1, At, B1); PG8_BAR;
            PG8_LDA(At, 1, 1); PG8_STAGE(PG8_SA(1, 0), a3, voffA);
            PG8_BAR; PG8_WAIT_L(0); PG8_MMA(1, 0, At, B0); PG8_BAR; PG8_SCHED;
            PG8_STAGE(PG8_SB(1, 1), b3 + hstep, voffB);
            PG8_WAIT_V(6); PG8_BAR; PG8_MMA(1, 1, At, B1); PG8_BAR;
            }
        }
        if constexpr (ALIGN_EPI) { if (wr == 0) PG8_BAR; }
        if constexpr (!Epi::AFTER_DRAIN) { E(acc, cur, wr, wc, fr, fq, pre); S.done(cur); }
        if (!has_next) break;
#pragma unroll
        for (int a = 0; a < 2; ++a)
#pragma unroll
            for (int b = 0; b < 2; ++b)
#pragma unroll
                for (int m = 0; m < 4; ++m)
#pragma unroll
                    for (int n = 0; n < 2; ++n) acc[a][b][m][n] = (f32x4){0.f, 0.f, 0.f, 0.f};
        cur = nxt; cA = nA; cB = nB; ++ui;
        E.prefetch(pre, cur, wr, wc, fr, fq);
        if constexpr (ALIGN_EPI) { if (wr == 1) PG8_BAR; }
    }
    PG8_WAIT_V(0);
    if constexpr (!ALIGN_EPI) { if (wr == 0) PG8_BAR; }
    PG8_BAR;
    if constexpr (Epi::AFTER_DRAIN) { E.fused(acc, cur, wr, wc, fr, fq, lds, wid, lane); S.done(cur); }
#undef PG8_SA
#undef PG8_SB
#undef PG8_STAGE
#undef PG8_LDA
#undef PG8_LDB
#undef PG8_MMA
#undef PG8_WAIT_V
#undef PG8_WAIT_L
#undef PG8_BAR
#undef PG8_SCHED
}
}
#define LAS __attribute__((address_space(3)))

#define XB_TMO      128
#define XB_XCNT(j)  (256  + 64 * (j))
#define XB_XSUB(j)  (1280 + 64 * (j))
#define XB_XGEN(j)  (2304 + 64 * (j))
#define XB_TOP      3328
#define XB_TOPGEN   3392
#define XCD_BAR_WORDS 3456
#define XB_SPIN_CAP (1u << 18)

__device__ __forceinline__ unsigned xb_ld(unsigned* p)              { return __hip_atomic_load(p, __ATOMIC_RELAXED, __HIP_MEMORY_SCOPE_AGENT); }
__device__ __forceinline__ unsigned xb_add(unsigned* p, unsigned v) { return __hip_atomic_fetch_add(p, v, __ATOMIC_RELAXED, __HIP_MEMORY_SCOPE_AGENT); }
__device__ __forceinline__ unsigned xb_xcc_id() { return (unsigned)__builtin_amdgcn_s_getreg((3 << 11) | 20) & 0xFu; }
#define XB_SPIN(cond, bar) do { unsigned _sp = 0; while (cond) { __builtin_amdgcn_s_sleep(1); \
    if ((++_sp & 255u) == 0u) { if (xb_ld(&(bar)[XB_TMO])) break; if (_sp > XB_SPIN_CAP) { atomicAdd(&(bar)[XB_TMO], 1u); break; } } } } while (0)

struct XcdBarrier {
    unsigned* bar; unsigned x;
    volatile LAS unsigned* st;
};

__device__ __forceinline__ XcdBarrier xcd_barrier_post(unsigned* bar, volatile LAS unsigned* st) {
    XcdBarrier b; b.bar = bar; b.x = xb_xcc_id(); b.st = st;
    if (threadIdx.x == 0) (void)xb_add(&bar[XB_XCNT(b.x)], 1u);
    return b;
}
__device__ __forceinline__ void xcd_barrier_complete(unsigned* bar, unsigned x, unsigned& nloc, unsigned& nx) {
    const unsigned G = gridDim.x * gridDim.y * gridDim.z;
    unsigned sum, cnt, mine, sp = 0u;
    for (;;) {
        sum = 0u; cnt = 0u; mine = 0u;
#pragma unroll
        for (unsigned j = 0; j < 16; ++j) { const unsigned c = xb_ld(&bar[XB_XCNT(j)]); sum += c; cnt += (c > 0u) ? 1u : 0u; mine = (j == x) ? c : mine; }
        if (sum == G) break;
        __builtin_amdgcn_s_sleep(1);
        if ((++sp & 255u) == 0u) { if (xb_ld(&bar[XB_TMO])) break; if (sp > XB_SPIN_CAP) { atomicAdd(&bar[XB_TMO], 1u); break; } }
    }
    nloc = mine > 0u ? mine : 1u; nx = cnt > 0u ? cnt : 1u;
}

__device__ __forceinline__ void xcd_barrier(const XcdBarrier& b) {
    asm volatile("s_waitcnt vmcnt(0)" ::: "memory");
    __syncthreads();
    if (threadIdx.x == 0) {
        unsigned* bar = b.bar;
        __builtin_amdgcn_s_waitcnt(0);
        unsigned nloc = b.st[0], nx = b.st[1];
        if (nloc == 0u) { xcd_barrier_complete(bar, b.x, nloc, nx); b.st[0] = nloc; b.st[1] = nx; }
        const unsigned old = xb_add(&bar[XB_XSUB(b.x)], 1u);
        const unsigned gen = old / nloc;
        if (old + 1u == (gen + 1u) * nloc) {
            __builtin_amdgcn_fence(__ATOMIC_RELEASE, "agent");
            asm volatile("s_waitcnt vmcnt(0)" ::: "memory");
            const unsigned og = xb_add(&bar[XB_TOP], 1u);
            const unsigned tg = og / nx;
            if (og + 1u == (tg + 1u) * nx) xb_add(&bar[XB_TOPGEN], 1u);
            else XB_SPIN(xb_ld(&bar[XB_TOPGEN]) == tg, bar);
            __builtin_amdgcn_fence(__ATOMIC_ACQUIRE, "agent");
            xb_add(&bar[XB_XGEN(b.x)], 1u);
            asm volatile("s_waitcnt vmcnt(0)" ::: "memory");
        } else {
            XB_SPIN(xb_ld(&bar[XB_XGEN(b.x)]) == gen, bar);
            __builtin_amdgcn_fence(__ATOMIC_ACQUIRE, "agent");
            asm volatile("s_waitcnt vmcnt(0)" ::: "memory");
        }
    }
    __syncthreads();
}


#ifndef REP_MASK
#define REP_MASK 0
#endif
#ifndef NAIVE_ATTN
#define NAIVE_ATTN 0
#endif
#ifndef NAIVE_SPATIAL
#define NAIVE_SPATIAL 0
#endif

using pg8::bf16_t; using pg8::f32x4; using pg8::Unit; using pg8::u32x4;
typedef unsigned u32x2 __attribute__((ext_vector_type(2)));

constexpr int NLAT = 32768, NCTX = 2048, MTOT = 34816;
constexpr int NTHREADS = 512;
constexpr int LDS_BYTES = 131072 + 16;
constexpr int NPH = 24;

constexpr size_t OFF_W1T = 0;
constexpr size_t OFF_W2T = OFF_W1T + 4ull * 4096 * 1024 * 2;
constexpr size_t OFF_QKVT = OFF_W2T + 4ull * 4096 * 1024 * 2;
constexpr size_t OFF_WOT = OFF_QKVT + 2ull * 3072 * 1024 * 2;
constexpr size_t OFF_WINT = OFF_WOT + 2ull * 1024 * 1024 * 2;
constexpr size_t OFF_SGOT = OFF_WINT + 2ull * 6144 * 1024 * 2;
constexpr size_t OFF_MODS = OFF_SGOT + 2ull * 1024 * 3072 * 2;
constexpr size_t OFF_CTXR = OFF_MODS + 4ull * 9 * 6144 * 4;
constexpr size_t OFF_HB = OFF_CTXR + 2048ull * 1024 * 4;
constexpr size_t OFF_BIG = OFF_HB + 34816ull * 1024 * 2;
constexpr size_t OFF_SSQ = OFF_BIG + 34816ull * 4096 * 2;
constexpr size_t OFF_LNACC = OFF_SSQ + 8ull * 34816 * 4;
constexpr size_t OFF_GS = OFF_LNACC + 2ull * 34816 * 2 * 4;
constexpr size_t OFF_BQKV = OFF_GS + 8ull * 9 * 1024 * 4;
constexpr size_t OFF_BMLP = OFF_BQKV + 2ull * 9 * 3072 * 4;
constexpr size_t OFF_BWIN = OFF_BMLP + 4ull * 9 * 4096 * 4;
constexpr size_t OFF_WSF = OFF_BWIN + 2ull * 9 * 6144 * 4;
constexpr size_t OFF_BAR = OFF_WSF + 2ull * 24 * 16384 * 2;
constexpr size_t WS_END = OFF_BAR + 16384;

struct Params {
    const float *x, *c, *ctx, *c_ctx, *ada_w, *ada_b, *norm1_g, *norm2_g, *mlp_w1, *mlp_w2, *na_w_qkv, *na_q_norm, *na_k_norm, *na_rpb, *na_w_o,
        *sg_w_in, *sg_b_in, *sg_ln_g, *sg_ln_b, *sg_w_s, *sg_b_s, *sg_w_o;
    float* out; unsigned char* ws; int ph_lo, ph_hi;
};

struct Tix { int tid, bid, gsz; };
__device__ __forceinline__ float bf2f(unsigned h) { return __uint_as_float(h << 16); }
__device__ __forceinline__ unsigned f2bf(float f) { unsigned u = __float_as_uint(f); u += 0x7FFFu + ((u >> 16) & 1u); return u >> 16; }
__device__ __forceinline__ unsigned pk2(float lo, float hi) { return pg8::cvt_pk_bf16(lo, hi); }
__device__ __forceinline__ float wave_sum(float v) {
#pragma unroll
    for (int o = 1; o < 64; o <<= 1) v += __shfl_xor(v, o);
    return v;
}
__device__ __forceinline__ float wave_max(float v) {
#pragma unroll
    for (int o = 1; o < 64; o <<= 1) v = fmaxf(v, __shfl_xor(v, o));
    return v;
}
#define LDS_WAIT() asm volatile("s_waitcnt lgkmcnt(0)" ::: "memory")
__device__ __forceinline__ float silu_f(float v) { return v / (1.f + expf(-v)); }
__device__ __forceinline__ float gelu_f(float v) { return 0.5f * v * (1.f + erff(v * 0.70710678118654752f)); }

typedef float f32x2 __attribute__((ext_vector_type(2)));
__device__ __forceinline__ f32x2 gelu_pk(f32x2 v) {
    const f32x2 av = __builtin_elementwise_abs(v), d = av * 0.2316418882f + 1.0f;
    f32x2 t; t.x = __builtin_amdgcn_rcpf(d.x); t.y = __builtin_amdgcn_rcpf(d.y);
    f32x2 q = t * 0.5307027145f + (-0.7265760135f); q = q * t + 0.7107068705f; q = q * t + (-0.142248368f); q = q * t + 0.127414796f; q = q * t;
    const f32x2 s = (v * v) * (-0.72134752044f);
    f32x2 e; e.x = __builtin_amdgcn_exp2f(s.x); e.y = __builtin_amdgcn_exp2f(s.y);
    const f32x2 m = v * (q * e), r = v - m;
    f32x2 o; o.x = v.x < 0.f ? m.x : r.x; o.y = v.y < 0.f ? m.y : r.y; return o;
}
__device__ __forceinline__ f32x4 gelu4(f32x4 v) { const f32x2 a = gelu_pk((f32x2){v.x, v.y}), b = gelu_pk((f32x2){v.z, v.w}); return (f32x4){a.x, a.y, b.x, b.y}; }

__device__ __forceinline__ int sigma_inv(int L) { return 128 * ((L >> 5) & 1) + 32 * (L >> 6) + 16 * ((L >> 2) & 1) + 4 * ((L >> 3) & 3) + (L & 3); }

__device__ __forceinline__ void phase_mods(const Params& p, LAS unsigned char* lds, const Tix T_) {
    LAS float* sc = (LAS float*)lds;
    LAS float* red = (LAS float*)(lds + 36864);
    float* mods = (float*)(p.ws + OFF_MODS);
    const int tid = T_.tid;
    for (int i = tid; i < 9 * 1024; i += NTHREADS) { const int b = i >> 10, k = i & 1023; const float v = b < 8 ? p.c[b * 1024 + k] : p.c_ctx[k]; sc[i] = silu_f(v); }
    __syncthreads();
    const int c4 = (tid & 15) * 4, kk = tid >> 4;
    for (int item = T_.bid; item < 384; item += T_.gsz) {
        const int l = item / 96, n0 = (item % 96) * 64;
        const float* W = p.ada_w + (size_t)l * 1024 * 6144 + n0 + c4;
        f32x4 acc[9];
#pragma unroll
        for (int b = 0; b < 9; ++b) acc[b] = (f32x4){0.f, 0.f, 0.f, 0.f};
#pragma unroll 4
        for (int i = 0; i < 32; ++i) { const int k = kk + 32 * i; const f32x4 w = *(const f32x4*)(W + (size_t)k * 6144);
#pragma unroll
            for (int b = 0; b < 9; ++b) acc[b] += sc[b * 1024 + k] * w; }
#pragma unroll
        for (int b = 0; b < 9; ++b) *(LAS f32x4*)(red + (kk * 9 + b) * 64 + c4) = acc[b];
        __syncthreads();
        for (int o = tid; o < 576; o += NTHREADS) { const int b = o >> 6, cc = o & 63; float s = 0.f;
            for (int j = 0; j < 32; ++j) s += red[(j * 9 + b) * 64 + cc];
            mods[(size_t)(l * 9 + b) * 6144 + n0 + cc] = s + p.ada_b[l * 6144 + n0 + cc]; }
        __syncthreads();
    }
}

struct MatDesc { const float* src; bf16_t* dst; int K, N; };
__device__ __forceinline__ MatDesc get_mat(const Params& p, int mi) {
    MatDesc m;
    if (mi < 4) { m.src = p.mlp_w1 + (size_t)mi * 1024 * 4096; m.dst = (bf16_t*)(p.ws + OFF_W1T) + (size_t)mi * 4096 * 1024; m.K = 1024; m.N = 4096; }
    else if (mi < 8) { const int l = mi - 4; m.src = p.mlp_w2 + (size_t)l * 4096 * 1024; m.dst = (bf16_t*)(p.ws + OFF_W2T) + (size_t)l * 1024 * 4096; m.K = 4096; m.N = 1024; }
    else if (mi < 10) { const int a = mi - 8; m.src = p.na_w_qkv + (size_t)a * 1024 * 3072; m.dst = (bf16_t*)(p.ws + OFF_QKVT) + (size_t)a * 3072 * 1024; m.K = 1024; m.N = 3072; }
    else if (mi < 12) { const int a = mi - 10; m.src = p.na_w_o + (size_t)a * 1024 * 1024; m.dst = (bf16_t*)(p.ws + OFF_WOT) + (size_t)a * 1024 * 1024; m.K = 1024; m.N = 1024; }
    else if (mi < 14) { const int s = mi - 12; m.src = p.sg_w_in + (size_t)s * 1024 * 6144; m.dst = (bf16_t*)(p.ws + OFF_WINT) + (size_t)s * 6144 * 1024; m.K = 1024; m.N = 6144; }
    else { const int s = mi - 14; m.src = p.sg_w_o + (size_t)s * 3072 * 1024; m.dst = (bf16_t*)(p.ws + OFF_SGOT) + (size_t)s * 1024 * 3072; m.K = 3072; m.N = 1024; }
    return m;
}
__device__ __forceinline__ void transpose_item(const float* W, int K, int N, bf16_t* WT, LAS float* scr, int item, int lane) {
    const int nblk = N / 32, kb = item / nblk, nb = item % nblk, k0 = 64 * kb, n0 = 32 * nb;
#pragma unroll 8
    for (int i = 0; i < 32; ++i) { const int kk = 2 * i + (lane >> 5); scr[kk * 33 + (lane & 31)] = W[(size_t)(k0 + kk) * N + n0 + (lane & 31)]; }
    LDS_WAIT();
    const int c = lane & 7;
#pragma unroll
    for (int j = 0; j < 4; ++j) { const int n = (lane >> 3) + 8 * j; const LAS float* s = scr + (8 * c) * 33 + n;
        u32x4 o; o.x = pk2(s[0 * 33], s[1 * 33]); o.y = pk2(s[2 * 33], s[3 * 33]); o.z = pk2(s[4 * 33], s[5 * 33]); o.w = pk2(s[6 * 33], s[7 * 33]);
        const int nl = n0 + n, drow = (nl & ~255) + sigma_inv(nl & 255);
        *(u32x4*)(WT + (size_t)drow * K + k0 + 8 * c) = o; }
    LDS_WAIT();
}
__device__ __forceinline__ void phase_convert(const Params& p, LAS unsigned char* lds, const Tix T_) {
    const int lane = T_.tid & 63, wave = T_.tid >> 6, gw = T_.bid * 8 + wave, NGW = T_.gsz * 8;
    LAS float* scr = (LAS float*)(lds + wave * 8704);
    for (int mi = 0; mi < 16; ++mi) {
        const MatDesc m = get_mat(p, mi);
        const int nitems = (m.K / 64) * (m.N / 32);
        for (int it = gw; it < nitems; it += NGW) transpose_item(m.src, m.K, m.N, m.dst, scr, it, lane);
    }
    { bf16_t* wsf = (bf16_t*)(p.ws + OFF_WSF);
      for (int it = gw; it < 2 * 24 * 4 * 8; it += NGW) { const int ks = it & 7, pt = (it >> 3) & 3, slg = it >> 5;
          const float* wp = p.sg_w_s + (size_t)slg * 16384 + (32 * pt + (lane & 31)) * 128 + 16 * ks + 8 * (lane >> 5);
          const f32x4 x = *(const f32x4*)wp, y = *(const f32x4*)(wp + 4);
          u32x4 o; o.x = pk2(x.x, x.y); o.y = pk2(x.z, x.w); o.z = pk2(y.x, y.y); o.w = pk2(y.z, y.w);
          *(u32x4*)(wsf + (size_t)it * 512 + lane * 8) = o; } }
}


__device__ __forceinline__ void phase_zero(const Params& p, const Tix T_) {
    float* z0 = (float*)(p.ws + OFF_SSQ) + MTOT; const int n0 = 7 * MTOT + 2 * MTOT * 2;
    for (int i = T_.bid * NTHREADS + T_.tid; i < n0; i += T_.gsz * NTHREADS) z0[i] = 0.f;
}
__device__ __forceinline__ void phase_0b(const Params& p, LAS unsigned char* lds, const Tix T_) {
    const float* mods = (const float*)(p.ws + OFF_MODS);
    const int tid = T_.tid, lane = tid & 63, wave = tid >> 6, gw = T_.bid * 8 + wave, NGW = T_.gsz * 8;
    { float* gs = (float*)(p.ws + OFF_GS);
      for (int i = T_.bid * NTHREADS + tid; i < 8 * 9 * 1024; i += T_.gsz * NTHREADS) { const int n = i / 9216, rem = i % 9216, b = rem >> 10, c = rem & 1023, L = n >> 1;
          const float g = (n & 1) ? p.norm2_g[L * 1024 + c] : p.norm1_g[L * 1024 + c];
          gs[i] = g * (1.0f + mods[(size_t)(L * 9 + b) * 6144 + ((n & 1) ? 4096 : 1024) + c]); } }
    { bf16_t* hb = (bf16_t*)(p.ws + OFF_HB); float* ssq0 = (float*)(p.ws + OFF_SSQ);
      for (int row = gw; row < MTOT; row += NGW) {
          const float* xr = row < NLAT ? p.x + (size_t)row * 1024 : p.ctx + (size_t)(row - NLAT) * 1024;
          const int b = row < NLAT ? (row >> 12) : 8;
          f32x4 v[4]; float ss = 0.f;
#pragma unroll
          for (int j = 0; j < 4; ++j) { v[j] = *(const f32x4*)(xr + 4 * lane + 256 * j); ss += (v[j].x * v[j].x + v[j].y * v[j].y) + (v[j].z * v[j].z + v[j].w * v[j].w); }
          ss = wave_sum(ss);
          if (lane == 0) ssq0[row] = ss;
#pragma unroll
          for (int j = 0; j < 4; ++j) { const int col = 4 * lane + 256 * j;
              const f32x4 gv = *(const f32x4*)(p.norm1_g + col), scv = *(const f32x4*)(mods + (size_t)b * 6144 + 1024 + col);
              const f32x4 o = v[j] * gv * (1.0f + scv);
              u32x2 w; w.x = pk2(o.x, o.y); w.y = pk2(o.z, o.w);
              *(u32x2*)(hb + (size_t)row * 1024 + col) = w; } } }
    LAS float* sh = (LAS float*)lds;
    for (int cmb = 0; cmb < 8; ++cmb) {
        int L, shoff, N; const bf16_t* Bt; float* dst; const float* addb = nullptr;
        if (cmb < 2) { L = 2 * cmb; shoff = 0; N = 3072; Bt = (const bf16_t*)(p.ws + OFF_QKVT) + (size_t)cmb * 3072 * 1024; dst = (float*)(p.ws + OFF_BQKV) + (size_t)cmb * 9 * 3072; }
        else if (cmb < 6) { L = cmb - 2; shoff = 3072; N = 4096; Bt = (const bf16_t*)(p.ws + OFF_W1T) + (size_t)L * 4096 * 1024; dst = (float*)(p.ws + OFF_BMLP) + (size_t)L * 9 * 4096; }
        else { const int sl = cmb - 6; L = 2 * sl + 1; shoff = 0; N = 6144; Bt = (const bf16_t*)(p.ws + OFF_WINT) + (size_t)sl * 6144 * 1024; dst = (float*)(p.ws + OFF_BWIN) + (size_t)sl * 9 * 6144; addb = p.sg_b_in + sl * 6144; }
        __syncthreads();
        for (int i = tid; i < 9 * 1024; i += NTHREADS) sh[i] = mods[(size_t)(L * 9 + (i >> 10)) * 6144 + shoff + (i & 1023)];
        __syncthreads();
        for (int n = gw; n < N; n += NGW) {
            const bf16_t* wr_ = Bt + (size_t)((n & ~255) + sigma_inv(n & 255)) * 1024 + lane * 8;
            const u32x4 w0 = *(const u32x4*)wr_, w1 = *(const u32x4*)(wr_ + 512);
            float wv[16];
#pragma unroll
            for (int e = 0; e < 4; ++e) { wv[2 * e] = bf2f(w0[e] & 0xffffu); wv[2 * e + 1] = bf2f(w0[e] >> 16); wv[8 + 2 * e] = bf2f(w1[e] & 0xffffu); wv[8 + 2 * e + 1] = bf2f(w1[e] >> 16); }
            const float ab = addb ? addb[n] : 0.f;
#pragma unroll
            for (int b = 0; b < 9; ++b) {
                const f32x4 s0 = *(const LAS f32x4*)(sh + b * 1024 + lane * 8), s1 = *(const LAS f32x4*)(sh + b * 1024 + lane * 8 + 4);
                const f32x4 s2 = *(const LAS f32x4*)(sh + b * 1024 + 512 + lane * 8), s3 = *(const LAS f32x4*)(sh + b * 1024 + 512 + lane * 8 + 4);
                float a = (wv[0] * s0.x + wv[1] * s0.y) + (wv[2] * s0.z + wv[3] * s0.w) + (wv[4] * s1.x + wv[5] * s1.y) + (wv[6] * s1.z + wv[7] * s1.w)
                        + (wv[8] * s2.x + wv[9] * s2.y) + (wv[10] * s2.z + wv[11] * s2.w) + (wv[12] * s3.x + wv[13] * s3.y) + (wv[14] * s3.z + wv[15] * s3.w);
                a = wave_sum(a);
                if (lane == 0) dst[(size_t)b * N + n] = a + ab; }
        }
    }
}

typedef short s16x4 __attribute__((ext_vector_type(4)));
typedef short s16x8 __attribute__((ext_vector_type(8)));
typedef float f32x16 __attribute__((ext_vector_type(16)));
typedef __bf16 bf16x2_t __attribute__((ext_vector_type(2)));
__device__ __forceinline__ unsigned pkb(float a, float b) { const f32x2 v = {a, b}; const bf16x2_t r = __builtin_convertvector(v, bf16x2_t); return __builtin_bit_cast(unsigned, r); }
__device__ __forceinline__ s16x8 pack8(float a0, float a1, float a2, float a3, float a4, float a5, float a6, float a7) {
    u32x4 w; w.x = pkb(a0, a1); w.y = pkb(a2, a3); w.z = pkb(a4, a5); w.w = pkb(a6, a7); return __builtin_bit_cast(s16x8, w); }
__device__ __forceinline__ s16x8 tr_pair(const LAS unsigned char* a0, int second_off) {
    const s16x4 a = __builtin_amdgcn_ds_read_tr16_b64_v4i16((LAS s16x4*)a0);
    const s16x4 b = __builtin_amdgcn_ds_read_tr16_b64_v4i16((LAS s16x4*)(a0 + second_off));
    s16x8 r; r[0] = a[0]; r[1] = a[1]; r[2] = a[2]; r[3] = a[3]; r[4] = b[0]; r[5] = b[1]; r[6] = b[2]; r[7] = b[3]; return r; }
#define MFMA32(a, b, c) __builtin_amdgcn_mfma_f32_32x32x16_bf16((a), (b), (c), 0, 0, 0)

constexpr int AV_STR = 144;
__device__ __forceinline__ f32x16 attn_qk(const s16x8 (&Kf)[4], const s16x8 (&Qf)[4]) {
    f32x16 S;
#pragma unroll
    for (int i = 0; i < 16; ++i) S[i] = 0.f;
#pragma unroll
    for (int ks = 0; ks < 4; ++ks) S = MFMA32(Kf[ks], Qf[ks], S);
    return S;
}
__device__ __forceinline__ float tabv(const LAS unsigned char* tabrow, int off) { return *(const LAS float*)(tabrow + off); }
__device__ __forceinline__ void attn_one_tile(const s16x8 (&Kf)[4], const s16x8 (&Qf)[4], const LAS unsigned char* vb, const LAS unsigned char* tabrow, const unsigned (&offo)[4], const unsigned offx,
                                              f32x16& O0, f32x16& O1, float& lsum, int mode, float mbl) {
    const f32x16 S = attn_qk(Kf, Qf);
    float pv[16];
    if (mode == 0) {
#pragma unroll
        for (int i = 0; i < 16; ++i) pv[i] = __builtin_amdgcn_exp2f(S[i] - mbl);
    } else if (mode == 1) {
#pragma unroll
        for (int i = 0; i < 16; ++i) pv[i] = __builtin_amdgcn_exp2f(S[i] + tabv(tabrow, (int)((offo[i >> 2] >> (8 * (i & 3))) & 0xffu)));
    } else {
#pragma unroll
        for (int i = 0; i < 16; ++i) pv[i] = 0.f;
        if (mode == 2) {
#pragma unroll
            for (int i = 0; i < 4; ++i) pv[i] = __builtin_amdgcn_exp2f(S[i] + tabv(tabrow, (int)((offx >> (8 * i)) & 0xffu)));
        } else {
#pragma unroll
            for (int i = 0; i < 4; ++i) pv[12 + i] = __builtin_amdgcn_exp2f(S[12 + i] + tabv(tabrow, (int)((offx >> (8 * i)) & 0xffu)));
        }
    }
#pragma unroll
    for (int i = 0; i < 16; ++i) lsum += pv[i];
    const s16x8 P0 = pack8(pv[0], pv[1], pv[2], pv[3], pv[4], pv[5], pv[6], pv[7]), P1 = pack8(pv[8], pv[9], pv[10], pv[11], pv[12], pv[13], pv[14], pv[15]);
    { const s16x8 V00 = tr_pair(vb, 8 * AV_STR), V01 = tr_pair(vb + 64, 8 * AV_STR);
      O0 = MFMA32(V00, P0, O0); O1 = MFMA32(V01, P0, O1); }
    { const s16x8 V10 = tr_pair(vb + 16 * AV_STR, 8 * AV_STR), V11 = tr_pair(vb + 16 * AV_STR + 64, 8 * AV_STR);
      O0 = MFMA32(V10, P1, O0); O1 = MFMA32(V11, P1, O1); }
}
__device__ __forceinline__ void attn_load_k(s16x8 (&Kf)[4], const bf16_t* kfb, int klat0, int kctx0, int kt, int ntl, int rs) {
    const int tile = kt < ntl ? klat0 + (rs + (kt >> 1)) * 2 + (kt & 1) : kctx0 + (kt - ntl);
#pragma unroll
    for (int ks = 0; ks < 4; ++ks) Kf[ks] = *(const s16x8*)(kfb + (size_t)tile * 32768 + ks * 512);
}
struct AUnit { int b, h, qrow0, r, rs, ntl, ntiles; };
__device__ __forceinline__ AUnit attn_decode(int u, int nlatu) {
    AUnit a;
    if (u < nlatu) { a.h = u & 15; const int br = u >> 4; a.r = br & 63; a.b = br >> 6; a.qrow0 = a.b * 4096 + a.r * 64; a.rs = min(max(a.r - 4, 0), 56); a.ntl = 16; a.ntiles = 24; }
    else { const int v = u - nlatu; a.h = v & 15; const int bq = v >> 4; a.b = bq >> 2; a.qrow0 = NLAT + a.b * 256 + (bq & 3) * 64; a.r = 0; a.rs = 0; a.ntl = 0; a.ntiles = 8; }
    return a;
}
__device__ __forceinline__ u32x4 attn_load_v1(const bf16_t* vbase, const AUnit& a, int idx) {
    const int key = idx >> 3, ch = idx & 7, kt = key >> 5, kk = key & 31;
    const int grow = kt < a.ntl ? (a.b * 4096 + (a.rs + (kt >> 1)) * 64 + 32 * (kt & 1) + kk) : (NLAT + a.b * 256 + 32 * (kt - a.ntl) + kk);
    return *(const u32x4*)(vbase + (size_t)grow * 1024 + ch * 8);
}
__device__ __forceinline__ void attn_load_v(u32x4 (&vpre)[12], const bf16_t* qkv, const AUnit& a, int tid) {
    const bf16_t* vbase = qkv + (size_t)2 * MTOT * 1024 + a.h * 64;
#pragma unroll
    for (int i = 0; i < 4; ++i) vpre[i] = attn_load_v1(vbase, a, tid + NTHREADS * i);
    if (a.ntiles == 24) {
#pragma unroll
        for (int i = 4; i < 12; ++i) vpre[i] = attn_load_v1(vbase, a, tid + NTHREADS * i);
    }
}

__device__ __forceinline__ void phase_attn_mfma(const Params& p, int a_, bool ctx_q, LAS unsigned char* lds, const Tix T_) {
    const bf16_t* qkv = (const bf16_t*)(p.ws + OFF_BIG); bf16_t* ao = (bf16_t*)(p.ws + OFF_BIG) + (size_t)MTOT * 3072;
    const bf16_t* kf = qkv + (size_t)MTOT * 1024;
    const float* rpb = p.na_rpb + (size_t)a_ * 16 * 15 * 31;
    const int tid = T_.tid, lane = tid & 63, wave = __builtin_amdgcn_readfirstlane(tid >> 6), qt = wave & 1, kq = wave >> 1, l31 = lane & 31, hi = lane >> 5;
    LAS unsigned char* Vl = lds;
    LAS float* Ored = (LAS float*)lds;
    LAS float* lred = (LAS float*)(lds + 69632);
    LAS float* tab = (LAS float*)(lds + 110592);
    LAS float* misc = (LAS float*)(lds + 110592 + 2048);
    constexpr float LOG2E = 1.4426950408889634f;
    float mb;
    { float m = 0.f; for (int i = tid; i < 7440; i += NTHREADS) m = fmaxf(m, rpb[i]);
      float qg = 0.f, kg = 0.f; if (tid < 64) { qg = fabsf(p.na_q_norm[a_ * 64 + tid]); kg = fabsf(p.na_k_norm[a_ * 64 + tid]); }
      m = wave_max(m); qg = wave_max(qg); kg = wave_max(kg);
      if (lane == 0) { misc[wave] = m; if (wave == 0) { misc[8] = qg; misc[9] = kg; } }
      __syncthreads();
      float rm = misc[0];
#pragma unroll
      for (int w = 1; w < 8; ++w) rm = fmaxf(rm, misc[w]);
      mb = 8.0f * misc[8] * misc[9] + rm; }
    const float mbl = mb * LOG2E;
    const int nlatu = 8 * 64 * 16, total = nlatu + (ctx_q ? 8 * 4 * 16 : 0);
    const int tr_q = (lane & 15) >> 2, tr_p = lane & 3, dgrp = (lane >> 4) & 1;
    const int qcol = 32 * qt + l31, wst = min(max(qcol - 8, 0), 48);
    unsigned offo[4], offx = 0u;
#pragma unroll
    for (int j = 0; j < 4; ++j) { offo[j] = 0u;
#pragma unroll
        for (int i = 0; i < 4; ++i) { const int kcol = 32 * qt + 8 * j + 4 * hi + i; offo[j] |= (unsigned)(((unsigned)(kcol - wst) < 16u ? kcol - qcol + 15 : 31) * 4) << (8 * i); } }
#pragma unroll
    for (int i = 0; i < 4; ++i) { const int kcol = (qt == 0 ? 32 : 24) + 4 * hi + i; offx |= (unsigned)(((unsigned)(kcol - wst) < 16u ? kcol - qcol + 15 : 31) * 4) << (8 * i); }
    int u = T_.bid;
    AUnit cur = attn_decode(min(u, total - 1), nlatu);
    u32x4 vpre[12];
    s16x8 Qf[4], KA[4], KB[4];
    if (u < total) {
        attn_load_v(vpre, qkv, cur, tid);
        const bf16_t* qp = qkv + (size_t)(((cur.qrow0 >> 5) + qt) * 16 + cur.h) * 2048 + lane * 8;
#pragma unroll
        for (int ks = 0; ks < 4; ++ks) Qf[ks] = *(const s16x8*)(qp + 512 * ks);
        const int t0 = kq * (cur.ntiles >> 2);
        attn_load_k(KA, kf + cur.h * 2048 + lane * 8, cur.b * 128, 1024 + cur.b * 8, t0, cur.ntl, cur.rs);
        attn_load_k(KB, kf + cur.h * 2048 + lane * 8, cur.b * 128, 1024 + cur.b * 8, t0 + 1, cur.ntl, cur.rs);
    }
    while (u < total) {
        const int b = cur.b, h = cur.h, qrow0 = cur.qrow0, r = cur.r, rs = cur.rs, ntl = cur.ntl, ntiles = cur.ntiles;
        int tidl = tid; asm volatile("" : "+v"(tidl));
#pragma unroll
        for (int i = 0; i < 4; ++i) { const int idx = tidl + NTHREADS * i; *(LAS u32x4*)(Vl + (idx >> 3) * AV_STR + (idx & 7) * 16) = vpre[i]; }
        if (ntiles == 24) {
#pragma unroll
            for (int i = 4; i < 12; ++i) { const int idx = tidl + NTHREADS * i; *(LAS u32x4*)(Vl + (idx >> 3) * AV_STR + (idx & 7) * 16) = vpre[i]; } }
        if (tid < 480) { const int rr = tid >> 5, dd = tid & 31; tab[tid] = dd < 31 ? (rpb[h * 465 + rr * 31 + dd] - mb) * LOG2E : -1e30f; }
        const bf16_t* kbase = kf + h * 2048 + lane * 8;
        const int klat0 = b * 128, kctx0 = 1024 + b * 8;
        const int ntw = ntiles >> 2, t0 = kq * ntw;
        __syncthreads();
        f32x16 O0, O1;
#pragma unroll
        for (int i = 0; i < 16; ++i) { O0[i] = 0.f; O1[i] = 0.f; }
        float lsum = 0.f;
#pragma unroll 1
        for (int t = 0; t < ntw; t += 2) {
            { const int kt = t0 + t; const int mode = kt >= ntl ? 0 : ((kt & 1) == qt ? 1 : 2 + qt);
              attn_one_tile(KA, Qf, Vl + (kt * 32 + 4 * hi + tr_q) * AV_STR + (16 * dgrp + 4 * tr_p) * 2, (const LAS unsigned char*)tab + (rs + (kt >> 1) - r + 7) * 128, offo, offx, O0, O1, lsum, mode, mbl); }
            __builtin_amdgcn_sched_barrier(0);
            attn_load_k(KA, kbase, klat0, kctx0, t0 + min(t + 2, ntw - 2), ntl, rs);
            { const int kt = t0 + t + 1; const int mode = kt >= ntl ? 0 : ((kt & 1) == qt ? 1 : 2 + qt);
              attn_one_tile(KB, Qf, Vl + (kt * 32 + 4 * hi + tr_q) * AV_STR + (16 * dgrp + 4 * tr_p) * 2, (const LAS unsigned char*)tab + (rs + (kt >> 1) - r + 7) * 128, offo, offx, O0, O1, lsum, mode, mbl); }
            __builtin_amdgcn_sched_barrier(0);
            attn_load_k(KB, kbase, klat0, kctx0, t0 + min(t + 2, ntw - 2) + 1, ntl, rs);
        }
        const int un = u + T_.gsz;
        const AUnit nxt = attn_decode(min(un, total - 1), nlatu);
        int tidm = tid; asm volatile("" : "+v"(tidm));
        if (un < total) attn_load_v(vpre, qkv, nxt, tidm);
        __syncthreads();
#pragma unroll
        for (int j = 0; j < 4; ++j) {
            *(LAS f32x4*)(Ored + (size_t)((kq * 64 + 32 * qt + l31) * 68 + 8 * j + 4 * hi)) = (f32x4){O0[4 * j], O0[4 * j + 1], O0[4 * j + 2], O0[4 * j + 3]};
            *(LAS f32x4*)(Ored + (size_t)((kq * 64 + 32 * qt + l31) * 68 + 32 + 8 * j + 4 * hi)) = (f32x4){O1[4 * j], O1[4 * j + 1], O1[4 * j + 2], O1[4 * j + 3]}; }
        lred[(kq * 2 + hi) * 64 + 32 * qt + l31] = lsum;
        if (un < total) {
            const bf16_t* qp = qkv + (size_t)(((nxt.qrow0 >> 5) + qt) * 16 + nxt.h) * 2048 + lane * 8;
#pragma unroll
            for (int ks = 0; ks < 4; ++ks) Qf[ks] = *(const s16x8*)(qp + 512 * ks);
            const int t0n = kq * (nxt.ntiles >> 2);
            attn_load_k(KA, kf + nxt.h * 2048 + lane * 8, nxt.b * 128, 1024 + nxt.b * 8, t0n, nxt.ntl, nxt.rs);
            attn_load_k(KB, kf + nxt.h * 2048 + lane * 8, nxt.b * 128, 1024 + nxt.b * 8, t0n + 1, nxt.ntl, nxt.rs);
        }
        __syncthreads();
        { const int q = tid >> 3, d8 = (tid & 7) * 8;
          f32x4 s0 = (f32x4){0.f, 0.f, 0.f, 0.f}, s1 = s0; float l = 0.f;
#pragma unroll
          for (int k = 0; k < 4; ++k) { s0 += *(const LAS f32x4*)(Ored + (k * 64 + q) * 68 + d8); s1 += *(const LAS f32x4*)(Ored + (k * 64 + q) * 68 + d8 + 4); l += lred[(k * 2) * 64 + q] + lred[(k * 2 + 1) * 64 + q]; }
          const float inv = 1.0f / l;
          u32x4 o; o.x = pkb(s0.x * inv, s0.y * inv); o.y = pkb(s0.z * inv, s0.w * inv); o.z = pkb(s1.x * inv, s1.y * inv); o.w = pkb(s1.z * inv, s1.w * inv);
          *(u32x4*)(ao + (size_t)(qrow0 + q) * 1024 + h * 64 + d8) = o; }
        __syncthreads();
        u = un; cur = nxt;
    }
}

constexpr int SP_RS = 320;
__device__ __forceinline__ void phase_spatial_mfma(const Params& p, int sl, int M, LAS unsigned char* lds, const Tix T_, const bool dummy = false) {
    bf16_t* vb = (bf16_t*)(p.ws + OFF_BIG); const float* lnacc = (const float*)(p.ws + OFF_LNACC) + (size_t)sl * MTOT * 2;
    const float* lng = p.sg_ln_g + sl * 3072; const float* lnb = p.sg_ln_b + sl * 3072;
    const int tid = T_.tid, lane = tid & 63, wave = __builtin_amdgcn_readfirstlane(tid >> 6), pt = wave & 3, cth = wave >> 2, l31 = lane & 31, hi = lane >> 5;
    const int tr_q = (lane & 15) >> 2, tr_p = lane & 3, dgrp = (lane >> 4) & 1;
    const int nunits = (M / 128) * 24;
    const int c8 = (tid & 15) * 8;
    s16x8 wx[8]; u32x4 vw[4]; f32x2 st2[4]; f32x4 g0, g1, b0, b1; float bs;
    const bf16_t* wsf = (const bf16_t*)(p.ws + OFF_WSF);
#define SP_LOAD(uu) do { const int nc_ = (uu) / 24, g_ = (uu) % 24, r0_ = nc_ * 128; \
        const bf16_t* wp_ = wsf + ((size_t)((sl * 24 + g_) * 4 + pt) * 8) * 512 + lane * 8; \
        _Pragma("unroll") for (int ks = 0; ks < 8; ++ks) wx[ks] = *(const s16x8*)(wp_ + ks * 512); \
        _Pragma("unroll") for (int i = 0; i < 4; ++i) { const int q_ = (tid + NTHREADS * i) >> 4; \
            vw[i] = *(const u32x4*)(vb + (size_t)(r0_ + q_) * 3072 + g_ * 128 + c8); st2[i] = *(const f32x2*)(lnacc + 2 * (r0_ + q_)); } \
        g0 = *(const f32x4*)(lng + g_ * 128 + c8); g1 = *(const f32x4*)(lng + g_ * 128 + c8 + 4); b0 = *(const f32x4*)(lnb + g_ * 128 + c8); b1 = *(const f32x4*)(lnb + g_ * 128 + c8 + 4); \
        bs = p.sg_b_s[((size_t)sl * 24 + g_) * 128 + 32 * pt + l31]; } while (0)
    int u = T_.bid, buf = 0;
    if (u < nunits) SP_LOAD(u);
    while (u < nunits) {
        const int nc = u / 24, g = u % 24, r0 = nc * 128;
        LAS unsigned char* tile = lds + buf * (128 * SP_RS);
#pragma unroll
        for (int i = 0; i < 4; ++i) { const int q = (tid + NTHREADS * i) >> 4; const u32x4 w = vw[i];
            const float mean = st2[i].x * (1.0f / 3072.0f), rstd = __builtin_amdgcn_rsqf(fmaxf(st2[i].y * (1.0f / 3072.0f) - mean * mean, 0.f) + 1e-6f);
            u32x4 o;
            o.x = pkb((bf2f(w.x & 0xffffu) - mean) * rstd * g0.x + b0.x, (bf2f(w.x >> 16) - mean) * rstd * g0.y + b0.y);
            o.y = pkb((bf2f(w.y & 0xffffu) - mean) * rstd * g0.z + b0.z, (bf2f(w.y >> 16) - mean) * rstd * g0.w + b0.w);
            o.z = pkb((bf2f(w.z & 0xffffu) - mean) * rstd * g1.x + b1.x, (bf2f(w.z >> 16) - mean) * rstd * g1.y + b1.y);
            o.w = pkb((bf2f(w.w & 0xffffu) - mean) * rstd * g1.z + b1.z, (bf2f(w.w >> 16) - mean) * rstd * g1.w + b1.w);
            *(LAS u32x4*)(tile + q * SP_RS + c8 * 2) = o; }
        s16x8 Wf[8];
#pragma unroll
        for (int ks = 0; ks < 8; ++ks) Wf[ks] = wx[ks];
        const float bsc = bs;
        __syncthreads();
        const int un = u + T_.gsz;
        if (un < nunits) SP_LOAD(un);
        __builtin_amdgcn_sched_barrier(0);
#pragma unroll
        for (int cc = 0; cc < 2; ++cc) { const int ct = 2 * cth + cc;
            f32x16 acc;
#pragma unroll
            for (int i = 0; i < 16; ++i) acc[i] = 0.f;
            const LAS unsigned char* ab = tile + (8 * hi + tr_q) * SP_RS + (32 * ct + 16 * dgrp + 4 * tr_p) * 2;
#pragma unroll
            for (int ks = 0; ks < 8; ++ks) { const s16x8 Af = tr_pair(ab + 16 * ks * SP_RS, 4 * SP_RS); acc = MFMA32(Af, Wf[ks], acc); }
            bf16_t* orow = (dummy ? vb + (size_t)MTOT * 3072 + (size_t)((r0 + 32 * pt + l31) & 8191) * 3072 : vb + (size_t)(r0 + 32 * pt + l31) * 3072) + g * 128 + 32 * ct + 4 * hi;
#pragma unroll
            for (int j = 0; j < 4; ++j) { u32x2 o; o.x = pkb(acc[4 * j] + bsc, acc[4 * j + 1] + bsc); o.y = pkb(acc[4 * j + 2] + bsc, acc[4 * j + 3] + bsc); *(u32x2*)(orow + 8 * j) = o; }
        }
        u = un; buf ^= 1;
    }
#undef SP_LOAD
    __syncthreads();
}

__device__ __forceinline__ int epi_row(int rowbase, int idx) { return rowbase + 128 * (idx >> 2) + 16 * (idx & 3); }
template <class F> struct EpiG {
    static constexpr bool PERM = false, AFTER_DRAIN = false;
    typedef typename F::Pre Pre;
    F f;
    __device__ __forceinline__ void prefetch(Pre& pre, const Unit& u, int wr, int wc, int fr, int fq) const {
        f.prefetch(pre, u, u.pn * 256 + 64 * wc + 8 * fq, u.pm * 256 + wr * 64 + fr); }
    __device__ __forceinline__ void operator()(const f32x4 (&acc)[2][2][4][2], const Unit& u, int wr, int wc, int fr, int fq, const Pre& pre) const {
        F g = f; const int colb = u.pn * 256 + 64 * wc + 8 * fq, rowbase = u.pm * 256 + wr * 64 + fr;
        g.begin(u, colb, fq, rowbase, pre);
#pragma unroll
        for (int ai = 0; ai < 2; ++ai)
#pragma unroll
            for (int m = 0; m < 4; ++m) {
                g.row(ai * 4 + m, rowbase + ai * 128 + m * 16, colb, acc[ai][0][m][0], acc[ai][0][m][1], acc[ai][1][m][0], acc[ai][1][m][1]);
                asm volatile("" ::: "memory"); }
    }
};
struct PreSB { float v[8]; f32x4 bz[4];
    __device__ __forceinline__ void load(const float* ssq, int rowbase, const float* bp) {
#pragma unroll
        for (int i = 0; i < 8; ++i) v[i] = ssq[epi_row(rowbase, i)];
        bz[0] = *(const f32x4*)bp; bz[1] = *(const f32x4*)(bp + 4); bz[2] = *(const f32x4*)(bp + 32); bz[3] = *(const f32x4*)(bp + 36); } };
__device__ __forceinline__ void store8_bf16(bf16_t* o, const f32x4 a, const f32x4 b) { u32x4 w; w.x = pk2(a.x, a.y); w.y = pk2(a.z, a.w); w.z = pk2(b.x, b.y); w.w = pk2(b.z, b.w); *(u32x4*)o = w; }
__device__ __forceinline__ float sumsq4(const f32x4 x) { return (x.x * x.x + x.y * x.y) + (x.z * x.z + x.w * x.w); }
__device__ __forceinline__ float sum4(const f32x4 x) { return (x.x + x.y) + (x.z + x.w); }
__device__ __forceinline__ float rstd_from(float ssq) { return __builtin_amdgcn_rsqf(ssq * (1.0f / 1024.0f) + 1e-6f); }
__device__ __forceinline__ void atomic_addf(float* p, float v) { __hip_atomic_fetch_add(p, v, __ATOMIC_RELAXED, __HIP_MEMORY_SCOPE_AGENT); }
struct FQKV { static constexpr bool IDEMP = true; bf16_t* O; const float* qg; const float* kg; const float* ssq; const float* bias;
    typedef PreSB Pre;
    f32x4 gn[4], bz[4]; int sect; float rqv[8];
    __device__ __forceinline__ void prefetch(Pre& pre, const Unit& u, int colb, int rowbase) const { pre.load(ssq, rowbase, bias + (size_t)min(u.pm >> 4, 8) * 3072 + colb); }
    __device__ __forceinline__ void begin(const Unit& u, int colb, int fq, int rowbase, const Pre& pre) {
#pragma unroll
        for (int i = 0; i < 8; ++i) rqv[i] = pre.v[i];
#pragma unroll
        for (int i = 0; i < 4; ++i) bz[i] = pre.bz[i];
        sect = u.pn >> 2;
        if (sect < 2) { const float* gp = (sect == 0 ? qg : kg) + 8 * fq; const float mul = sect == 0 ? 0.125f * 1.4426950408889634f : 1.0f;
            gn[0] = *(const f32x4*)gp * mul; gn[1] = *(const f32x4*)(gp + 4) * mul; gn[2] = *(const f32x4*)(gp + 32) * mul; gn[3] = *(const f32x4*)(gp + 36) * mul; } }
    __device__ __forceinline__ void row(int idx, int row, int colb, f32x4 a0, f32x4 b0, f32x4 a1, f32x4 b1) {
        const float rs = rstd_from(rqv[idx]);
        a0 = a0 * rs + bz[0]; b0 = b0 * rs + bz[1]; a1 = a1 * rs + bz[2]; b1 = b1 * rs + bz[3];
        if (sect < 2) { float ss = (sumsq4(a0) + sumsq4(b0)) + (sumsq4(a1) + sumsq4(b1));
            ss += __shfl_xor(ss, 16); ss += __shfl_xor(ss, 32);
            const float r2 = __builtin_amdgcn_rsqf(ss * (1.0f / 64.0f) + 1e-6f);
            a0 = a0 * r2 * gn[0]; b0 = b0 * r2 * gn[1]; a1 = a1 * r2 * gn[2]; b1 = b1 * r2 * gn[3]; }
        if (sect < 2) {
            const int within = colb & 1023, h = within >> 6, fq = (within >> 3) & 7;
            bf16_t* op = O + (size_t)sect * MTOT * 1024 + ((size_t)((row >> 5) * 16 + h) * 4 + (fq >> 1)) * 512 + ((fq & 1) * 32 + (row & 31)) * 8;
            store8_bf16(op, a0, b0); store8_bf16(op + 2 * 512, a1, b1);
        } else { bf16_t* op = O + (size_t)2 * MTOT * 1024 + (size_t)row * 1024 + (colb - 2048); store8_bf16(op, a0, b0); store8_bf16(op + 32, a1, b1); } } };
struct FSqrelu { static constexpr bool IDEMP = true; bf16_t* O; const float* ssq; const float* bias;
    typedef PreSB Pre;
    f32x4 bz[4]; float rqv[8];
    __device__ __forceinline__ void prefetch(Pre& pre, const Unit& u, int colb, int rowbase) const { pre.load(ssq, rowbase, bias + (size_t)min(u.pm >> 4, 8) * 4096 + colb); }
    __device__ __forceinline__ void begin(const Unit& u, int colb, int fq, int rowbase, const Pre& pre) {
#pragma unroll
        for (int i = 0; i < 8; ++i) rqv[i] = pre.v[i];
#pragma unroll
        for (int i = 0; i < 4; ++i) bz[i] = pre.bz[i]; }
    __device__ __forceinline__ void row(int idx, int row, int colb, f32x4 a0, f32x4 b0, f32x4 a1, f32x4 b1) {
        const float rs = rstd_from(rqv[idx]); const f32x4 z = (f32x4){0.f, 0.f, 0.f, 0.f};
        a0 = __builtin_elementwise_max(a0 * rs + bz[0], z); b0 = __builtin_elementwise_max(b0 * rs + bz[1], z); a1 = __builtin_elementwise_max(a1 * rs + bz[2], z); b1 = __builtin_elementwise_max(b1 * rs + bz[3], z);
        bf16_t* op = O + (size_t)row * 4096 + colb; store8_bf16(op, a0 * a0, b0 * b0); store8_bf16(op + 32, a1 * a1, b1 * b1); } };
struct FGeluV { static constexpr bool IDEMP = false; bf16_t* O; const float* ssq; const float* bias; float* lnacc;
    typedef PreSB Pre;
    f32x4 bz[4]; int fq_; float rqv[8];
    __device__ __forceinline__ void prefetch(Pre& pre, const Unit& u, int colb, int rowbase) const { pre.load(ssq, rowbase, bias + (size_t)min(u.pm >> 4, 8) * 6144 + colb); }
    __device__ __forceinline__ void begin(const Unit& u, int colb, int fq, int rowbase, const Pre& pre) { fq_ = fq;
#pragma unroll
        for (int i = 0; i < 8; ++i) rqv[i] = pre.v[i];
#pragma unroll
        for (int i = 0; i < 4; ++i) bz[i] = pre.bz[i]; }
    __device__ __forceinline__ void row(int idx, int row, int colb, f32x4 a0, f32x4 b0, f32x4 a1, f32x4 b1) {
        const float rs = rstd_from(rqv[idx]);
        a0 = gelu4(a0 * rs + bz[0]); b0 = gelu4(b0 * rs + bz[1]); a1 = gelu4(a1 * rs + bz[2]); b1 = gelu4(b1 * rs + bz[3]);
        bf16_t* op = O + (size_t)row * 3072 + colb; store8_bf16(op, a0, b0); store8_bf16(op + 32, a1, b1);
        float s1 = (sum4(a0) + sum4(b0)) + (sum4(a1) + sum4(b1)), s2 = (sumsq4(a0) + sumsq4(b0)) + (sumsq4(a1) + sumsq4(b1));
        s1 += __shfl_xor(s1, 16); s1 += __shfl_xor(s1, 32); s2 += __shfl_xor(s2, 16); s2 += __shfl_xor(s2, 32);
        if (fq_ == 0) { atomic_addf(lnacc + 2 * (size_t)row, s1); atomic_addf(lnacc + 2 * (size_t)row + 1, s2); } } };
struct FGeluU { static constexpr bool IDEMP = false; bf16_t* O; const float* ssq; const float* bias;
    typedef PreSB Pre;
    f32x4 bz[4]; float rqv[8]; u32x4 sv[2][2]; int rowbase_;
    __device__ __forceinline__ void prefetch(Pre& pre, const Unit& u, int colb, int rowbase) const { pre.load(ssq, rowbase, bias + (size_t)min(u.pm >> 4, 8) * 6144 + colb); }
    __device__ __forceinline__ void fetch(int idx, int colb) { const bf16_t* op = O + (size_t)epi_row(rowbase_, idx) * 3072 + colb; sv[idx & 1][0] = *(const u32x4*)op; sv[idx & 1][1] = *(const u32x4*)(op + 32); }
    __device__ __forceinline__ void begin(const Unit& u, int colb, int fq, int rowbase, const Pre& pre) { rowbase_ = rowbase; fetch(0, colb);
#pragma unroll
        for (int i = 0; i < 8; ++i) rqv[i] = pre.v[i];
#pragma unroll
        for (int i = 0; i < 4; ++i) bz[i] = pre.bz[i]; }
    __device__ __forceinline__ static f32x4 lo4(const u32x4 s) { return (f32x4){bf2f(s.x & 0xffffu), bf2f(s.x >> 16), bf2f(s.y & 0xffffu), bf2f(s.y >> 16)}; }
    __device__ __forceinline__ static f32x4 hi4(const u32x4 s) { return (f32x4){bf2f(s.z & 0xffffu), bf2f(s.z >> 16), bf2f(s.w & 0xffffu), bf2f(s.w >> 16)}; }
    __device__ __forceinline__ void row(int idx, int row, int colb, f32x4 a0, f32x4 b0, f32x4 a1, f32x4 b1) {
        if (idx < 7) fetch(idx + 1, colb);
        const float rs = rstd_from(rqv[idx]);
        bf16_t* op = O + (size_t)row * 3072 + colb; const u32x4 sv0 = sv[idx & 1][0], sv1 = sv[idx & 1][1];
        a0 = gelu4(a0 * rs + bz[0]) * lo4(sv0); b0 = gelu4(b0 * rs + bz[1]) * hi4(sv0); a1 = gelu4(a1 * rs + bz[2]) * lo4(sv1); b1 = gelu4(b1 * rs + bz[3]) * hi4(sv1);
        store8_bf16(op, a0, b0); store8_bf16(op + 32, a1, b1); } };
struct FResid { static constexpr bool IDEMP = false; const float* inl; const float* inc; float* outl; float* outc; const float* gate;
    const float* gsn; bf16_t* xb; float* ssqn;
    struct Pre { f32x4 gz[4]; };
    f32x4 gz[4], gsz[4], xin[2][4]; int fq_, rowbase_;
    __device__ __forceinline__ void prefetch(Pre& pre, const Unit& u, int colb, int rowbase) const { const float* gp = gate + (size_t)min(u.pm >> 4, 8) * 6144 + colb;
        pre.gz[0] = *(const f32x4*)gp; pre.gz[1] = *(const f32x4*)(gp + 4); pre.gz[2] = *(const f32x4*)(gp + 32); pre.gz[3] = *(const f32x4*)(gp + 36); }
    __device__ __forceinline__ void fetch(int idx, int colb) { const int row = epi_row(rowbase_, idx);
        const float* ip = row < NLAT ? inl + (size_t)row * 1024 + colb : inc + (size_t)(row - NLAT) * 1024 + colb;
        xin[idx & 1][0] = *(const f32x4*)ip; xin[idx & 1][1] = *(const f32x4*)(ip + 4); xin[idx & 1][2] = *(const f32x4*)(ip + 32); xin[idx & 1][3] = *(const f32x4*)(ip + 36); }
    __device__ __forceinline__ void begin(const Unit& u, int colb, int fq, int rowbase, const Pre& pre) { const int b = min(u.pm >> 4, 8); fq_ = fq; rowbase_ = rowbase; fetch(0, colb);
#pragma unroll
        for (int i = 0; i < 4; ++i) gz[i] = pre.gz[i];
        if (gsn) { const float* sp = gsn + (size_t)b * 1024 + colb; gsz[0] = *(const f32x4*)sp; gsz[1] = *(const f32x4*)(sp + 4); gsz[2] = *(const f32x4*)(sp + 32); gsz[3] = *(const f32x4*)(sp + 36); } }
    __device__ __forceinline__ void row(int idx, int row, int colb, f32x4 a0, f32x4 b0, f32x4 a1, f32x4 b1) {
        if (idx < 7) fetch(idx + 1, colb);
        float* op = row < NLAT ? outl + (size_t)row * 1024 + colb : outc + (size_t)(row - NLAT) * 1024 + colb;
        a0 = xin[idx & 1][0] + gz[0] * a0; b0 = xin[idx & 1][1] + gz[1] * b0; a1 = xin[idx & 1][2] + gz[2] * a1; b1 = xin[idx & 1][3] + gz[3] * b1;
        *(f32x4*)op = a0; *(f32x4*)(op + 4) = b0; *(f32x4*)(op + 32) = a1; *(f32x4*)(op + 36) = b1;
        if (gsn) { float ss = (sumsq4(a0) + sumsq4(b0)) + (sumsq4(a1) + sumsq4(b1));
            ss += __shfl_xor(ss, 16); ss += __shfl_xor(ss, 32);
            if (fq_ == 0) atomic_addf(ssqn + row, ss);
            bf16_t* xp = xb + (size_t)row * 1024 + colb; store8_bf16(xp, a0 * gsz[0], b0 * gsz[1]); store8_bf16(xp + 32, a1 * gsz[2], b1 * gsz[3]); } } };

template <class F> __device__ __forceinline__ void run_gemm(LAS unsigned char* lds, const bf16_t* A, const bf16_t* Bt, int M, int N, int K, const F& f, const Tix T_) {
    pg8::StaticOrder S; S.init(M, N, T_.gsz, T_.bid);
    pg8::Gemm g; g.A = A; g.Bt = Bt; g.M = M; g.N = N; g.K = K;
    EpiG<F> E; E.f = f;
    pg8::gemm_phase<EpiG<F>, pg8::StaticOrder, true, true>(lds, g, S, E, T_.tid);
}

enum { OP_QKV, OP_ATTN, OP_MIXOUT, OP_MLP1, OP_MLP2, OP_VGEMM, OP_SPATIAL, OP_UGEMM, OP_PROLOGUE, OP_PHASE0B };

__device__ __forceinline__ void decode_phase(int ph, int& L, int& op) {
    L = 0; op = ph == 0 ? OP_PROLOGUE : OP_PHASE0B;
    if (ph > 1) {
        int q = ph - 2;
        if (q < 5) { L = 0; } else if (q < 11) { L = 1; q -= 5; } else if (q < 16) { L = 2; q -= 11; } else { L = 3; q -= 16; }
        if ((L & 1) == 0) op = q == 0 ? OP_QKV : q == 1 ? OP_ATTN : q == 2 ? OP_MIXOUT : q == 3 ? OP_MLP1 : OP_MLP2;
        else op = q == 0 ? OP_VGEMM : q == 1 ? OP_SPATIAL : q == 2 ? OP_UGEMM : q == 3 ? OP_MIXOUT : q == 4 ? OP_MLP1 : OP_MLP2;
    }
}

__device__ __forceinline__ void run_phase(const Params& p, int ph, LAS unsigned char* lds, const Tix T_) {
    int L, op; decode_phase(ph, L, op);
#ifdef ONLY_OP
    op = ONLY_OP;
#endif
    const int mi = L >> 1;
    const bool attnL = (L & 1) == 0;
    const int Mfull = L < 2 ? MTOT : NLAT;
    const float* modsl = (const float*)(p.ws + OFF_MODS) + (size_t)L * 9 * 6144;
    float* ctxr = (float*)(p.ws + OFF_CTXR);
    bf16_t* hb = (bf16_t*)(p.ws + OFF_HB); bf16_t* big = (bf16_t*)(p.ws + OFF_BIG);
    float* ssq = (float*)(p.ws + OFF_SSQ); const float* gs = (const float*)(p.ws + OFF_GS);
    const bool first = (L == 0);
    switch (op) {
    case OP_PROLOGUE: phase_zero(p, T_); phase_mods(p, lds, T_); __syncthreads(); phase_convert(p, lds, T_); break;
    case OP_PHASE0B: phase_0b(p, lds, T_); break;
    case OP_QKV: { FQKV f; f.O = big; f.qg = p.na_q_norm + mi * 64; f.kg = p.na_k_norm + mi * 64; f.ssq = ssq + (size_t)(2 * L) * MTOT; f.bias = (const float*)(p.ws + OFF_BQKV) + (size_t)mi * 9 * 3072;
        run_gemm(lds, hb, (const bf16_t*)(p.ws + OFF_QKVT) + (size_t)mi * 3072 * 1024, MTOT, 3072, 1024, f, T_); } break;
    case OP_ATTN: phase_attn_mfma(p, mi, L == 0, lds, T_); break;
    case OP_MIXOUT: case OP_MLP2: {
        FResid f; const bool mo = (op == OP_MIXOUT);
        f.inl = (first && mo) ? p.x : p.out; f.inc = (first && mo) ? p.ctx : ctxr; f.outl = p.out; f.outc = ctxr; f.gate = modsl + (mo ? 2048 : 5120);
        const int nn = mo ? 2 * L + 1 : 2 * L + 2;
        const bool has_next = nn < 8 && !(nn == 6 + 0 && false);
        f.gsn = has_next ? gs + (size_t)nn * 9 * 1024 : nullptr; f.xb = hb; f.ssqn = ssq + (size_t)(has_next ? nn : 0) * MTOT;
        const bf16_t* A; const bf16_t* Bt; int K;
        if (!mo) { A = big; Bt = (const bf16_t*)(p.ws + OFF_W2T) + (size_t)L * 1024 * 4096; K = 4096; }
        else if (attnL) { A = big + (size_t)MTOT * 3072; Bt = (const bf16_t*)(p.ws + OFF_WOT) + (size_t)mi * 1024 * 1024; K = 1024; }
        else { A = big; Bt = (const bf16_t*)(p.ws + OFF_SGOT) + (size_t)mi * 1024 * 3072; K = 3072; }
        run_gemm(lds, A, Bt, Mfull, 1024, K, f, T_); } break;
    case OP_MLP1: { FSqrelu f; f.O = big; f.ssq = ssq + (size_t)(2 * L + 1) * MTOT; f.bias = (const float*)(p.ws + OFF_BMLP) + (size_t)L * 9 * 4096;
        run_gemm(lds, hb, (const bf16_t*)(p.ws + OFF_W1T) + (size_t)L * 4096 * 1024, Mfull, 4096, 1024, f, T_); } break;
    case OP_VGEMM: { FGeluV f; f.O = big; f.ssq = ssq + (size_t)(2 * L) * MTOT; f.bias = (const float*)(p.ws + OFF_BWIN) + (size_t)mi * 9 * 6144 + 3072; f.lnacc = (float*)(p.ws + OFF_LNACC) + (size_t)mi * MTOT * 2;
        run_gemm(lds, hb, (const bf16_t*)(p.ws + OFF_WINT) + (size_t)mi * 6144 * 1024 + (size_t)3072 * 1024, Mfull, 3072, 1024, f, T_); } break;
#ifdef REP_SPATIAL
    case OP_SPATIAL: phase_spatial_mfma(p, mi, Mfull, lds, T_, true); __syncthreads(); phase_spatial_mfma(p, mi, Mfull, lds, T_); break;
#else
    case OP_SPATIAL: phase_spatial_mfma(p, mi, Mfull, lds, T_); break;
#endif
    case OP_UGEMM: { FGeluU f; f.O = big; f.ssq = ssq + (size_t)(2 * L) * MTOT; f.bias = (const float*)(p.ws + OFF_BWIN) + (size_t)mi * 9 * 6144;
        run_gemm(lds, hb, (const bf16_t*)(p.ws + OFF_WINT) + (size_t)mi * 6144 * 1024, Mfull, 3072, 1024, f, T_); } break;
    default: break;
    }
}

#ifndef ONE_LAUNCH
#define ONE_LAUNCH 1
#endif
__global__ void __launch_bounds__(NTHREADS) mk(Params p0) {
    extern __shared__ __attribute__((aligned(16))) unsigned char lds_raw[];
    LAS unsigned char* lds = (LAS unsigned char*)lds_raw;
#if ONE_LAUNCH
    cg::grid_group grid = cg::this_grid();
    if (p0.ph_lo < 0) grid.sync();
    volatile LAS unsigned* st = (volatile LAS unsigned*)(lds + 131072);
    if (threadIdx.x == 0) { st[0] = 0u; st[1] = 0u; }
    __syncthreads();
    const XcdBarrier xbar = xcd_barrier_post((unsigned*)(p0.ws + OFF_BAR), st);
    bool first_it = true, repeated = false;
    for (int ph = p0.ph_lo; ph < p0.ph_hi; ) {
        if (!first_it) xcd_barrier(xbar);
        first_it = false;
        Tix T_; T_.tid = threadIdx.x; T_.bid = blockIdx.x; T_.gsz = gridDim.x;
        size_t z = 0;
        asm volatile("" : "+v"(T_.tid)); asm volatile("" : "+s"(T_.bid), "+s"(T_.gsz), "+s"(z));
        Params p = p0;
        { const float** pp = (const float**)&p;
#pragma unroll
          for (int i = 0; i < 22; ++i) pp[i] += z; }
        p.out += z; p.ws += z;
        run_phase(p, ph, lds, T_);
        __syncthreads();
        if (REP_MASK != 0) { int L_, op_; decode_phase(ph, L_, op_); if (((REP_MASK >> op_) & 1) && !repeated) { repeated = true; continue; } }
        repeated = false; ++ph;
    }
#else
    Tix T_; T_.tid = threadIdx.x; T_.bid = blockIdx.x; T_.gsz = gridDim.x;
    run_phase(p0, p0.ph_lo, lds, T_);
#endif
}

extern "C" void kernel_launch(void* const* d_in, const int* in_sizes, int n_in, void* d_out, int out_size, void* d_ws, size_t ws_size, hipStream_t stream) {
    static int grid = 0;
    if (grid == 0) {
        if (n_in != 22 || ws_size < WS_END) { fprintf(stderr, "kernel_launch: unexpected n_in %d or ws_size %zu (< %zu)\n", n_in, ws_size, (size_t)WS_END); grid = -1; return; }
        int dev = 0, cus = 0, per_cu = 0;
        hipGetDevice(&dev); hipDeviceGetAttribute(&cus, hipDeviceAttributeMultiprocessorCount, dev);
        if (hipFuncSetAttribute((const void*)mk, hipFuncAttributeMaxDynamicSharedMemorySize, LDS_BYTES) != hipSuccess) { fprintf(stderr, "kernel_launch: hipFuncSetAttribute failed\n"); grid = -1; return; }
        if (hipOccupancyMaxActiveBlocksPerMultiprocessor(&per_cu, (const void*)mk, NTHREADS, LDS_BYTES) != hipSuccess || per_cu < 1) { fprintf(stderr, "kernel_launch: occupancy query says %d\n", per_cu); per_cu = 1; }
        (void)hipGetLastError();
        grid = cus;
    }
    if (grid < 0) return;
    if (hipMemsetAsync((unsigned char*)d_ws + OFF_BAR, 0, 16384, stream) != hipSuccess) { fprintf(stderr, "kernel_launch: memset of the barrier words failed\n"); return; }
    Params p{};
    const float** pp = (const float**)&p;
    for (int i = 0; i < 22; ++i) pp[i] = (const float*)d_in[i];
    p.out = (float*)d_out; p.ws = (unsigned char*)d_ws;
#if ONE_LAUNCH
    p.ph_lo = 0; p.ph_hi = NPH;
    void* args[] = {&p};
    hipError_t e = hipLaunchCooperativeKernel((void*)mk, dim3(grid), dim3(NTHREADS), args, LDS_BYTES, stream);
    if (e != hipSuccess) fprintf(stderr, "cooperative launch failed: %s (grid %d)\n", hipGetErrorString(e), grid);
#else
    for (int ph = 0; ph < NPH; ++ph) { p.ph_lo = ph; p.ph_hi = ph + 1; hipLaunchKernelGGL(mk, dim3(grid), dim3(NTHREADS), LDS_BYTES, stream, p); }
#endif
}
```

```cpp
#include <hip/hip_runtime.h>
#include <hip/hip_cooperative_groups.h>
#include <cstdio>
#include <cstdint>
namespace cg = cooperative_groups;
namespace pg8 {
#define PG8_LAS __attribute__((address_space(3)))
typedef unsigned short bf16_t;
typedef short bf16x8 __attribute__((ext_vector_type(8)));
typedef float f32x4 __attribute__((ext_vector_type(4)));
typedef unsigned u32x4 __attribute__((ext_vector_type(4)));
constexpr int BM = 256, BK = 64, HALF = 128, HTB = HALF * BK * 2  , STAGE_BYTES = 8 * HTB, NXCD = 8, WGM = 8;

__host__ __device__ __forceinline__ int lds_byte(int r, int c) { const int st = (r >> 4) * 2 + (c >> 5), rr = r & 15, cc = c & 31, ob = rr * 64 + cc * 2; return st * 1024 + (ob ^ (((ob >> 9) & 1) << 5)); }
__host__ __device__ __forceinline__ void stage_rc(int b, int& R, int& C) { const int st = b / 1024, sb = b % 1024, swz = sb ^ (((sb >> 9) & 1) << 5); R = (st >> 1) * 16 + swz / 64; C = (st & 1) * 32 + (swz % 64) / 2; }
__host__ __device__ __forceinline__ int perm32(int rho) { const int n = rho >> 4, i = rho & 15; return 8 * (i >> 2) + 4 * n + (i & 3); }

struct Unit { int pm, pn; };
struct Gemm { const bf16_t* A; const bf16_t* Bt; int M, N, K; };

struct StaticOrder {
    int nM, nN, nwg, G, c;
    __host__ __device__ void init(int M, int N, int G_, int c_) { nM = M / BM; nN = N / BM; nwg = nM * nN; G = G_; c = c_; }
    __host__ __device__ bool next(int i, Unit& u) const {
        const long L = (long)i * G + c; if (L >= nwg) return false;
        int wgid = (int)L; { const int q = nwg / NXCD, r = nwg % NXCD, xcd = wgid % NXCD, off = wgid / NXCD; wgid = (xcd < r ? xcd * (q + 1) : r * (q + 1) + (xcd - r) * q) + off; }
        const int nig = WGM * nN, gid = wgid / nig, fm = gid * WGM, gsz = (nM - fm) < WGM ? (nM - fm) : WGM;
        u.pm = fm + ((wgid % nig) % gsz); u.pn = (wgid % nig) / gsz; return true;
    }
    __device__ __forceinline__ void a_ready(const Unit&) const {}
    __device__ __forceinline__ void done(const Unit&) const {}
};

__device__ __forceinline__ unsigned cvt_pk_bf16(float lo, float hi) { unsigned r; asm volatile("v_cvt_pk_bf16_f32 %0, %1, %2" : "=v"(r) : "v"(lo), "v"(hi)); return r; }
template <class Epi, class Sched, bool ALIGN_EPI = false, bool SP2 = false>
__device__ __forceinline__ void gemm_phase(PG8_LAS unsigned char* lds, const Gemm g, const Sched& S, const Epi& E, const int tid_in) {
    const int tid = tid_in, wid = __builtin_amdgcn_readfirstlane(tid >> 6), lane = tid & 63, wr = wid >> 2, wc = wid & 3, fr = lane & 15, fq = lane >> 4;
    const int K = g.K, nt = K / BK;
    unsigned voffA[2], voffB[2];
#pragma unroll
    for (int i = 0; i < 2; ++i) { int R, C; stage_rc(tid * 16 + i * 8192, R, C); const int Rb = Epi::PERM ? ((R & ~31) + perm32(R & 31)) : R;
        voffA[i] = (unsigned)(R * K + C) * 2u; voffB[i] = (unsigned)(Rb * K + C) * 2u; }
    const size_t kstep = (size_t)(BK * 2);
    const size_t hstep = (size_t)HALF * K * 2;
    const size_t tstep = 2 * hstep;
    const unsigned ldsw = (unsigned)wid * 1024u;
    const int aoff = lds_byte(wr * 64 + fr, fq * 8), boff = lds_byte(wc * 32 + fr, fq * 8);
#define PG8_SA(b, h) (((b) * 2 + (h)) * HTB)
#define PG8_SB(b, h) ((4 + (b) * 2 + (h)) * HTB)
#define PG8_STAGE(bufoff, gbase, voff) do { _Pragma("unroll") for (int _i = 0; _i < 2; ++_i) \
        __builtin_amdgcn_global_load_lds((const unsigned*)((const char*)(gbase) + (voff)[_i]), (PG8_LAS unsigned*)(lds + (bufoff) + ldsw + _i * 8192), 16, 0, 0); } while (0)
#define PG8_LDA(dst, b, h) do { _Pragma("unroll") for (int m = 0; m < 4; ++m) _Pragma("unroll") for (int k = 0; k < 2; ++k) dst[m][k] = *(const PG8_LAS bf16x8*)(lds + PG8_SA(b, h) + aoff + m * 2048 + k * 1024); } while (0)
#define PG8_LDB(dst, b, h) do { _Pragma("unroll") for (int n = 0; n < 2; ++n) _Pragma("unroll") for (int k = 0; k < 2; ++k) dst[n][k] = *(const PG8_LAS bf16x8*)(lds + PG8_SB(b, h) + boff + n * 2048 + k * 1024); } while (0)
#define PG8_MMA(ai, bj, At, Bt) do { __builtin_amdgcn_s_setprio(1); _Pragma("unroll") for (int m = 0; m < 4; ++m) _Pragma("unroll") for (int n = 0; n < 2; ++n) _Pragma("unroll") for (int k = 0; k < 2; ++k) \
        acc[ai][bj][m][n] = __builtin_amdgcn_mfma_f32_16x16x32_bf16(Bt[n][k], At[m][k], acc[ai][bj][m][n], 0, 0, 0); __builtin_amdgcn_s_setprio(0); } while (0)
#define PG8_WAIT_V(n) asm volatile("s_waitcnt vmcnt(" #n ")" ::: "memory")
#define PG8_WAIT_L(n) asm volatile("s_waitcnt lgkmcnt(" #n ")" ::: "memory")
#define PG8_BAR __builtin_amdgcn_s_barrier()
#define PG8_SCHED __builtin_amdgcn_sched_barrier(0)
    Unit cur, nxt; int ui = 0;
    if (!S.next(0, cur)) return;
    f32x4 acc[2][2][4][2];
#pragma unroll
    for (int a = 0; a < 2; ++a)
#pragma unroll
        for (int b = 0; b < 2; ++b)
#pragma unroll
            for (int m = 0; m < 4; ++m)
#pragma unroll
                for (int n = 0; n < 2; ++n) acc[a][b][m][n] = (f32x4){0.f, 0.f, 0.f, 0.f};
    bf16x8 At[4][2], B0[2][2], B1[2][2];
    const char* cA = (const char*)g.A + (size_t)cur.pm * tstep; const char* cB = (const char*)g.Bt + (size_t)cur.pn * tstep;
    S.a_ready(cur);
    typename Epi::Pre pre; E.prefetch(pre, cur, wr, wc, fr, fq);
    if constexpr (SP2) {
        PG8_STAGE(PG8_SB(0, 0), cB, voffB); PG8_STAGE(PG8_SB(0, 1), cB + hstep, voffB); PG8_STAGE(PG8_SA(0, 0), cA, voffA); PG8_STAGE(PG8_SA(0, 1), cA + hstep, voffA);
        if (wr == 1) PG8_BAR;
        PG8_WAIT_V(2); PG8_BAR;
        PG8_STAGE(PG8_SB(1, 0), cB + kstep, voffB); PG8_STAGE(PG8_SA(1, 0), cA + kstep, voffA); PG8_STAGE(PG8_SB(1, 1), cB + hstep + kstep, voffB);
        PG8_WAIT_V(6); PG8_BAR;
    } else {
        PG8_STAGE(PG8_SB(0, 0), cB, voffB); PG8_STAGE(PG8_SA(0, 0), cA, voffA); PG8_STAGE(PG8_SB(0, 1), cB + hstep, voffB); PG8_STAGE(PG8_SA(0, 1), cA + hstep, voffA);
        if (wr == 1) PG8_BAR;
        PG8_WAIT_V(4); PG8_BAR;
        PG8_STAGE(PG8_SB(1, 0), cB + kstep, voffB); PG8_STAGE(PG8_SA(1, 0), cA + kstep, voffA); PG8_STAGE(PG8_SB(1, 1), cB + hstep + kstep, voffB);
        PG8_WAIT_V(6); PG8_BAR;
    }
    for (;;) {
        const bool has_next = S.next(ui + 1, nxt);
        const char* nA = has_next ? (const char*)g.A + (size_t)nxt.pm * tstep : cA; const char* nB = has_next ? (const char*)g.Bt + (size_t)nxt.pn * tstep : cB;
        for (int t = 0; t < nt; t += 2) {
            const bool last = (t == nt - 2);
            const char* a1 = cA + (size_t)(t + 1) * kstep;
            const char* a2 = last ? nA : cA + (size_t)(t + 2) * kstep; const char* b2 = last ? nB : cB + (size_t)(t + 2) * kstep;
            const char* a3 = a2 + kstep; const char* b3 = b2 + kstep;
            if (last && has_next) S.a_ready(nxt);
            if constexpr (SP2) {
            PG8_LDB(B0, 0, 0); PG8_LDB(B1, 0, 1); PG8_SCHED; PG8_LDA(At, 0, 0); PG8_STAGE(PG8_SA(1, 1), a1 + hstep, voffA);
            PG8_WAIT_V(8); PG8_WAIT_L(0); PG8_BAR; PG8_MMA(0, 0, At, B0); PG8_MMA(0, 1, At, B1); PG8_BAR; PG8_SCHED;
            PG8_LDA(At, 0, 1); PG8_STAGE(PG8_SB(0, 0), b2, voffB); PG8_STAGE(PG8_SB(0, 1), b2 + hstep, voffB); PG8_STAGE(PG8_SA(0, 0), a2, voffA);
            PG8_WAIT_V(8); PG8_WAIT_L(0); PG8_BAR; PG8_MMA(1, 0, At, B0); PG8_MMA(1, 1, At, B1); PG8_BAR; PG8_SCHED;
            PG8_LDB(B0, 1, 0); PG8_LDB(B1, 1, 1); PG8_SCHED; PG8_LDA(At, 1, 0); PG8_STAGE(PG8_SA(0, 1), a2 + hstep, voffA);
            PG8_WAIT_V(8); PG8_WAIT_L(0); PG8_BAR; PG8_MMA(0, 0, At, B0); PG8_MMA(0, 1, At, B1); PG8_BAR; PG8_SCHED;
            PG8_LDA(At, 1, 1); PG8_STAGE(PG8_SB(1, 0), b3, voffB); PG8_STAGE(PG8_SB(1, 1), b3 + hstep, voffB); PG8_STAGE(PG8_SA(1, 0), a3, voffA);
            PG8_WAIT_V(8); PG8_WAIT_L(0); PG8_BAR; PG8_MMA(1, 0, At, B0); PG8_MMA(1, 1, At, B1); PG8_BAR; PG8_SCHED;
            } else {
            PG8_LDB(B0, 0, 0); PG8_SCHED; PG8_LDA(At, 0, 0); PG8_STAGE(PG8_SA(1, 1), a1 + hstep, voffA);
            PG8_WAIT_L(8); PG8_BAR; PG8_WAIT_L(0); PG8_MMA(0, 0, At, B0); PG8_BAR; PG8_SCHED;
            PG8_LDB(B1, 0, 1); PG8_STAGE(PG8_SB(0, 0), b2, voffB);
            PG8_BAR; PG8_WAIT_L(0); PG8_MMA(0, 1, At, B1); PG8_BAR;
            PG8_LDA(At, 0, 1); PG8_STAGE(PG8_SA(0, 0), a2, voffA);
            PG8_BAR; PG8_WAIT_L(0); PG8_MMA(1, 0, At, B0); PG8_BAR; PG8_SCHED;
            PG8_STAGE(PG8_SB(0, 1), b2 + hstep, voffB);
            PG8_WAIT_V(6); PG8_BAR; PG8_MMA(1, 1, At, B1); PG8_BAR;
            PG8_LDB(B0, 1, 0); PG8_SCHED; PG8_LDA(At, 1, 0); PG8_STAGE(PG8_SA(0, 1), a2 + hstep, voffA);
            PG8_WAIT_L(8); PG8_BAR; PG8_WAIT_L(0); PG8_MMA(0, 0, At, B0); PG8_BAR; PG8_SCHED;
            PG8_LDB(B1, 1, 1); PG8_STAGE(PG8_SB(1, 0), b3, voffB);
            PG8_BAR; PG8_WAIT_L(0); PG8_MMA(0, 1, At, B1); PG8_BAR;
            PG8_LDA(At, 1, 1); PG8_STAGE(PG8_SA(1, 0), a3, voffA);
            PG8_BAR; PG8_WAIT_L(0); PG8_MMA(1, 0, At, B0); PG8_BAR; PG8_SCHED;
            PG8_STAGE(PG8_SB(1, 1), b3 + hstep, voffB);
            PG8_WAIT_V(6); PG8_BAR; PG8_MMA(1, 1, At, B1); PG8_BAR;
            }
        }
        if constexpr (ALIGN_EPI) { if (wr == 0) PG8_BAR; }
        if constexpr (!Epi::AFTER_DRAIN) { E(acc, cur, wr, wc, fr, fq, pre); S.done(cur); }
        if (!has_next) break;
#pragma unroll
        for (int a = 0; a < 2; ++a)
#pragma unroll
            for (int b = 0; b < 2; ++b)
#pragma unroll
                for (int m = 0; m < 4; ++m)
#pragma unroll
                    for (int n = 0; n < 2; ++n) acc[a][b][m][n] = (f32x4){0.f, 0.f, 0.f, 0.f};
        cur = nxt; cA = nA; cB = nB; ++ui;
        E.prefetch(pre, cur, wr, wc, fr, fq);
        if constexpr (ALIGN_EPI) { if (wr == 1) PG8_BAR; }
    }
    PG8_WAIT_V(0);
    if constexpr (!ALIGN_EPI) { if (wr == 0) PG8_BAR; }
    PG8_BAR;
    if constexpr (Epi::AFTER_DRAIN) { E.fused(acc, cur, wr, wc, fr, fq, lds, wid, lane); S.done(cur); }
#undef PG8_SA
#undef PG8_SB
#undef PG8_STAGE
#undef PG8_LDA
#undef PG8_LDB
#undef PG8_MMA
#undef PG8_WAIT_V
#undef PG8_WAIT_L
#undef PG8_BAR
#undef PG8_SCHED
}
}
#define LAS __attribute__((address_space(3)))

#define XB_TMO      128
#define XB_XCNT(j)  (256  + 64 * (j))
#define XB_XSUB(j)  (1280 + 64 * (j))
#define XB_XGEN(j)  (2304 + 64 * (j))
#define XB_TOP      3328
#define XB_TOPGEN   3392
#define XCD_BAR_WORDS 3456
#define XB_SPIN_CAP (1u << 18)

__device__ __forceinline__ unsigned xb_ld(unsigned* p)              { return __hip_atomic_load(p, __ATOMIC_RELAXED, __HIP_MEMORY_SCOPE_AGENT); }
__device__ __forceinline__ unsigned xb_add(unsigned* p, unsigned v) { return __hip_atomic_fetch_add(p, v, __ATOMIC_RELAXED, __HIP_MEMORY_SCOPE_AGENT); }
__device__ __forceinline__ unsigned xb_xcc_id() { return (unsigned)__builtin_amdgcn_s_getreg((3 << 11) | 20) & 0xFu; }
#define XB_SPIN(cond, bar) do { unsigned _sp = 0; while (cond) { __builtin_amdgcn_s_sleep(1); \
    if ((++_sp & 255u) == 0u) { if (xb_ld(&(bar)[XB_TMO])) break; if (_sp > XB_SPIN_CAP) { atomicAdd(&(bar)[XB_TMO], 1u); break; } } } } while (0)

struct XcdBarrier {
    unsigned* bar; unsigned x;
    volatile LAS unsigned* st;
};

__device__ __forceinline__ XcdBarrier xcd_barrier_post(unsigned* bar, volatile LAS unsigned* st) {
    XcdBarrier b; b.bar = bar; b.x = xb_xcc_id(); b.st = st;
    if (threadIdx.x == 0) (void)xb_add(&bar[XB_XCNT(b.x)], 1u);
    return b;
}
__device__ __forceinline__ void xcd_barrier_complete(unsigned* bar, unsigned x, unsigned& nloc, unsigned& nx) {
    const unsigned G = gridDim.x * gridDim.y * gridDim.z;
    unsigned sum, cnt, mine, sp = 0u;
    for (;;) {
        sum = 0u; cnt = 0u; mine = 0u;
#pragma unroll
        for (unsigned j = 0; j < 16; ++j) { const unsigned c = xb_ld(&bar[XB_XCNT(j)]); sum += c; cnt += (c > 0u) ? 1u : 0u; mine = (j == x) ? c : mine; }
        if (sum == G) break;
        __builtin_amdgcn_s_sleep(1);
        if ((++sp & 255u) == 0u) { if (xb_ld(&bar[XB_TMO])) break; if (sp > XB_SPIN_CAP) { atomicAdd(&bar[XB_TMO], 1u); break; } }
    }
    nloc = mine > 0u ? mine : 1u; nx = cnt > 0u ? cnt : 1u;
}

__device__ __forceinline__ void xcd_barrier(const XcdBarrier& b) {
    asm volatile("s_waitcnt vmcnt(0)" ::: "memory");
    __syncthreads();
    if (threadIdx.x == 0) {
        unsigned* bar = b.bar;
        __builtin_amdgcn_s_waitcnt(0);
        unsigned nloc = b.st[0], nx = b.st[1];
        if (nloc == 0u) { xcd_barrier_complete(bar, b.x, nloc, nx); b.st[0] = nloc; b.st[1] = nx; }
        const unsigned old = xb_add(&bar[XB_XSUB(b.x)], 1u);
        const unsigned gen = old / nloc;
        if (old + 1u == (gen + 1u) * nloc) {
            __builtin_amdgcn_fence(__ATOMIC_RELEASE, "agent");
            asm volatile("s_waitcnt vmcnt(0)" ::: "memory");
            const unsigned og = xb_add(&bar[XB_TOP], 1u);
            const unsigned tg = og / nx;
            if (og + 1u == (tg + 1u) * nx) xb_add(&bar[XB_TOPGEN], 1u);
            else XB_SPIN(xb_ld(&bar[XB_TOPGEN]) == tg, bar);
            __builtin_amdgcn_fence(__ATOMIC_ACQUIRE, "agent");
            xb_add(&bar[XB_XGEN(b.x)], 1u);
            asm volatile("s_waitcnt vmcnt(0)" ::: "memory");
        } else {
            XB_SPIN(xb_ld(&bar[XB_XGEN(b.x)]) == gen, bar);
            __builtin_amdgcn_fence(__ATOMIC_ACQUIRE, "agent");
            asm volatile("s_waitcnt vmcnt(0)" ::: "memory");
        }
    }
    __syncthreads();
}


#ifndef REP_MASK
#define REP_MASK 0
#endif
#ifndef NAIVE_ATTN
#define NAIVE_ATTN 0
#endif
#ifndef NAIVE_SPATIAL
#define NAIVE_SPATIAL 0
#endif

using pg8::bf16_t; using pg8::f32x4; using pg8::Unit; using pg8::u32x4;
typedef unsigned u32x2 __attribute__((ext_vector_type(2)));

constexpr int NLAT = 32768, NCTX = 2048, MTOT = 34816;
constexpr int NTHREADS = 512;
constexpr int LDS_BYTES = 141440;
constexpr int LDS_ST_OFF = 141424;
constexpr int NPH = 24;

constexpr size_t OFF_W1T = 0;
constexpr size_t OFF_W2T = OFF_W1T + 4ull * 4096 * 1024 * 2;
constexpr size_t OFF_QKVT = OFF_W2T + 4ull * 4096 * 1024 * 2;
constexpr size_t OFF_WOT = OFF_QKVT + 2ull * 3072 * 1024 * 2;
constexpr size_t OFF_WINT = OFF_WOT + 2ull * 1024 * 1024 * 2;
constexpr size_t OFF_SGOT = OFF_WINT + 2ull * 6144 * 1024 * 2;
constexpr size_t OFF_MODS = OFF_SGOT + 2ull * 1024 * 3072 * 2;
constexpr size_t OFF_CTXR = OFF_MODS + 4ull * 9 * 6144 * 4;
constexpr size_t OFF_HB = OFF_CTXR + 2048ull * 1024 * 4;
constexpr size_t OFF_BIG = OFF_HB + 34816ull * 1024 * 2;
constexpr size_t OFF_SSQ = OFF_BIG + 34816ull * 4096 * 2;
constexpr size_t OFF_LNACC = OFF_SSQ + 8ull * 34816 * 4;
constexpr size_t OFF_GS = OFF_LNACC + 2ull * 34816 * 2 * 4;
constexpr size_t OFF_BQKV = OFF_GS + 8ull * 9 * 1024 * 4;
constexpr size_t OFF_BMLP = OFF_BQKV + 2ull * 9 * 3072 * 4;
constexpr size_t OFF_BWIN = OFF_BMLP + 4ull * 9 * 4096 * 4;
constexpr size_t OFF_WSF = OFF_BWIN + 2ull * 9 * 6144 * 4;
constexpr size_t OFF_BAR = OFF_WSF + 2ull * 24 * 16384 * 2;
constexpr size_t WS_END = OFF_BAR + 16384;

struct Params {
    const float *x, *c, *ctx, *c_ctx, *ada_w, *ada_b, *norm1_g, *norm2_g, *mlp_w1, *mlp_w2, *na_w_qkv, *na_q_norm, *na_k_norm, *na_rpb, *na_w_o,
        *sg_w_in, *sg_b_in, *sg_ln_g, *sg_ln_b, *sg_w_s, *sg_b_s, *sg_w_o;
    float* out; unsigned char* ws; int ph_lo, ph_hi;
};

struct Tix { int tid, bid, gsz; };
__device__ __forceinline__ float bf2f(unsigned h) { return __uint_as_float(h << 16); }
__device__ __forceinline__ unsigned f2bf(float f) { unsigned u = __float_as_uint(f); u += 0x7FFFu + ((u >> 16) & 1u); return u >> 16; }
__device__ __forceinline__ unsigned pk2(float lo, float hi) { return pg8::cvt_pk_bf16(lo, hi); }
__device__ __forceinline__ float wave_sum(float v) {
#pragma unroll
    for (int o = 1; o < 64; o <<= 1) v += __shfl_xor(v, o);
    return v;
}
__device__ __forceinline__ float wave_max(float v) {
#pragma unroll
    for (int o = 1; o < 64; o <<= 1) v = fmaxf(v, __shfl_xor(v, o));
    return v;
}
#define LDS_WAIT() asm volatile("s_waitcnt lgkmcnt(0)" ::: "memory")
__device__ __forceinline__ float silu_f(float v) { return v / (1.f + expf(-v)); }
__device__ __forceinline__ float gelu_f(float v) { return 0.5f * v * (1.f + erff(v * 0.70710678118654752f)); }

typedef float f32x2 __attribute__((ext_vector_type(2)));
__device__ __forceinline__ f32x2 gelu_pk(f32x2 v) {
    const f32x2 av = __builtin_elementwise_abs(v), d = av * 0.2316418882f + 1.0f;
    f32x2 t; t.x = __builtin_amdgcn_rcpf(d.x); t.y = __builtin_amdgcn_rcpf(d.y);
    f32x2 q = t * 0.5307027145f + (-0.7265760135f); q = q * t + 0.7107068705f; q = q * t + (-0.142248368f); q = q * t + 0.127414796f; q = q * t;
    const f32x2 s = (v * v) * (-0.72134752044f);
    f32x2 e; e.x = __builtin_amdgcn_exp2f(s.x); e.y = __builtin_amdgcn_exp2f(s.y);
    const f32x2 m = v * (q * e), r = v - m;
    f32x2 o; o.x = v.x < 0.f ? m.x : r.x; o.y = v.y < 0.f ? m.y : r.y; return o;
}
__device__ __forceinline__ f32x4 gelu4(f32x4 v) { const f32x2 a = gelu_pk((f32x2){v.x, v.y}), b = gelu_pk((f32x2){v.z, v.w}); return (f32x4){a.x, a.y, b.x, b.y}; }

__device__ __forceinline__ int sigma_inv(int L) { return 128 * ((L >> 5) & 1) + 32 * (L >> 6) + 16 * ((L >> 2) & 1) + 4 * ((L >> 3) & 3) + (L & 3); }

__device__ __forceinline__ void phase_mods(const Params& p, LAS unsigned char* lds, const Tix T_) {
    LAS float* sc = (LAS float*)lds;
    LAS float* red = (LAS float*)(lds + 36864);
    float* mods = (float*)(p.ws + OFF_MODS);
    const int tid = T_.tid;
    for (int i = tid; i < 9 * 1024; i += NTHREADS) { const int b = i >> 10, k = i & 1023; const float v = b < 8 ? p.c[b * 1024 + k] : p.c_ctx[k]; sc[i] = silu_f(v); }
    __syncthreads();
    const int c4 = (tid & 15) * 4, kk = tid >> 4;
    for (int item = T_.bid; item < 384; item += T_.gsz) {
        const int l = item / 96, n0 = (item % 96) * 64;
        const float* W = p.ada_w + (size_t)l * 1024 * 6144 + n0 + c4;
        f32x4 acc[9];
#pragma unroll
        for (int b = 0; b < 9; ++b) acc[b] = (f32x4){0.f, 0.f, 0.f, 0.f};
#pragma unroll
        for (int hlf = 0; hlf < 2; ++hlf) {
            f32x4 wq[16];
#pragma unroll
            for (int i = 0; i < 16; ++i) wq[i] = *(const f32x4*)(W + (size_t)(kk + 32 * (16 * hlf + i)) * 6144);
            __builtin_amdgcn_sched_barrier(0);
#pragma unroll
            for (int i = 0; i < 16; ++i) { const int k = kk + 32 * (16 * hlf + i);
#pragma unroll
                for (int b = 0; b < 9; ++b) acc[b] += sc[b * 1024 + k] * wq[i]; } }
#pragma unroll
        for (int b = 0; b < 9; ++b) *(LAS f32x4*)(red + (kk * 9 + b) * 64 + c4) = acc[b];
        __syncthreads();
        for (int o = tid; o < 576; o += NTHREADS) { const int b = o >> 6, cc = o & 63; float s = 0.f;
            for (int j = 0; j < 32; ++j) s += red[(j * 9 + b) * 64 + cc];
            mods[(size_t)(l * 9 + b) * 6144 + n0 + cc] = s + p.ada_b[l * 6144 + n0 + cc]; }
        __syncthreads();
    }
}

struct MatDesc { const float* src; bf16_t* dst; int K, N; };
__device__ __forceinline__ MatDesc get_mat(const Params& p, int mi) {
    MatDesc m;
    if (mi < 4) { m.src = p.mlp_w1 + (size_t)mi * 1024 * 4096; m.dst = (bf16_t*)(p.ws + OFF_W1T) + (size_t)mi * 4096 * 1024; m.K = 1024; m.N = 4096; }
    else if (mi < 8) { const int l = mi - 4; m.src = p.mlp_w2 + (size_t)l * 4096 * 1024; m.dst = (bf16_t*)(p.ws + OFF_W2T) + (size_t)l * 1024 * 4096; m.K = 4096; m.N = 1024; }
    else if (mi < 10) { const int a = mi - 8; m.src = p.na_w_qkv + (size_t)a * 1024 * 3072; m.dst = (bf16_t*)(p.ws + OFF_QKVT) + (size_t)a * 3072 * 1024; m.K = 1024; m.N = 3072; }
    else if (mi < 12) { const int a = mi - 10; m.src = p.na_w_o + (size_t)a * 1024 * 1024; m.dst = (bf16_t*)(p.ws + OFF_WOT) + (size_t)a * 1024 * 1024; m.K = 1024; m.N = 1024; }
    else if (mi < 14) { const int s = mi - 12; m.src = p.sg_w_in + (size_t)s * 1024 * 6144; m.dst = (bf16_t*)(p.ws + OFF_WINT) + (size_t)s * 6144 * 1024; m.K = 1024; m.N = 6144; }
    else { const int s = mi - 14; m.src = p.sg_w_o + (size_t)s * 3072 * 1024; m.dst = (bf16_t*)(p.ws + OFF_SGOT) + (size_t)s * 1024 * 3072; m.K = 3072; m.N = 1024; }
    return m;
}
struct CvItem { const float* src; bf16_t* dst; int K, N, k0, n0; };
__device__ __forceinline__ CvItem cv_locate(const Params& p, int g) {
    int mi, it;
    if (g < 8192) { mi = g >> 11; it = g & 2047; }
    else if (g < 16384) { mi = 4 + ((g - 8192) >> 11); it = g & 2047; }
    else if (g < 19456) { const int t = g - 16384; mi = 8 + t / 1536; it = t % 1536; }
    else if (g < 20480) { const int t = g - 19456; mi = 10 + (t >> 9); it = t & 511; }
    else if (g < 26624) { const int t = g - 20480; mi = 12 + t / 3072; it = t % 3072; }
    else { const int t = g - 26624; mi = 14 + t / 1536; it = t % 1536; }
    const MatDesc m = get_mat(p, mi);
    CvItem c; c.src = m.src; c.dst = m.dst; c.K = m.K; c.N = m.N; const int nblk = m.N / 32; c.k0 = 64 * (it / nblk); c.n0 = 32 * (it % nblk);
    return c;
}
__device__ __forceinline__ void cv_load(float (&wv)[32], const CvItem& c, int lane) {
    const float* wsrc = c.src + (size_t)(c.k0 + (lane >> 5)) * c.N + c.n0 + (lane & 31);
#pragma unroll
    for (int i = 0; i < 32; ++i) wv[i] = wsrc[(size_t)(2 * i) * c.N];
}
__device__ __forceinline__ void phase_convert(const Params& p, LAS unsigned char* lds, const Tix T_) {
    const int lane = T_.tid & 63, wave = T_.tid >> 6, gw = T_.bid * 8 + wave, NGW = T_.gsz * 8;
    LAS float* scr = (LAS float*)(lds + wave * 8704);
    constexpr int NITEMS = 29696;
    float wv[32];
    int g = gw;
    CvItem cur = cv_locate(p, min(g, NITEMS - 1));
    if (g < NITEMS) cv_load(wv, cur, lane);
    while (g < NITEMS) {
#pragma unroll
        for (int i = 0; i < 32; ++i) scr[(2 * i + (lane >> 5)) * 33 + (lane & 31)] = wv[i];
        const int gn = g + NGW;
        const CvItem nxt = cv_locate(p, min(gn, NITEMS - 1));
        if (gn < NITEMS) cv_load(wv, nxt, lane);
        LDS_WAIT();
        const int c = lane & 7;
#pragma unroll
        for (int j = 0; j < 4; ++j) { const int n = (lane >> 3) + 8 * j; const LAS float* s = scr + (8 * c) * 33 + n;
            u32x4 o; o.x = pk2(s[0 * 33], s[1 * 33]); o.y = pk2(s[2 * 33], s[3 * 33]); o.z = pk2(s[4 * 33], s[5 * 33]); o.w = pk2(s[6 * 33], s[7 * 33]);
            const int nl = cur.n0 + n, drow = (nl & ~255) + sigma_inv(nl & 255);
            *(u32x4*)(cur.dst + (size_t)drow * cur.K + cur.k0 + 8 * c) = o; }
        LDS_WAIT();
        g = gn; cur = nxt;
    }
    { bf16_t* wsf = (bf16_t*)(p.ws + OFF_WSF);
      for (int it = gw; it < 2 * 24 * 4 * 8; it += NGW) { const int ks = it & 7, pt = (it >> 3) & 3, slg = it >> 5;
          const float* wp = p.sg_w_s + (size_t)slg * 16384 + (32 * pt + (lane & 31)) * 128 + 16 * ks + 8 * (lane >> 5);
          const f32x4 x = *(const f32x4*)wp, y = *(const f32x4*)(wp + 4);
          u32x4 o; o.x = pk2(x.x, x.y); o.y = pk2(x.z, x.w); o.z = pk2(y.x, y.y); o.w = pk2(y.z, y.w);
          *(u32x4*)(wsf + (size_t)it * 512 + lane * 8) = o; } }
}


__device__ __forceinline__ void phase_zero(const Params& p, const Tix T_) {
    float* z0 = (float*)(p.ws + OFF_SSQ) + MTOT; const int n0 = 7 * MTOT + 2 * MTOT * 2;
    for (int i = T_.bid * NTHREADS + T_.tid; i < n0; i += T_.gsz * NTHREADS) z0[i] = 0.f;
}
__device__ __forceinline__ void phase_0b(const Params& p, LAS unsigned char* lds, const Tix T_) {
    const float* mods = (const float*)(p.ws + OFF_MODS);
    const int tid = T_.tid, lane = tid & 63, wave = tid >> 6, gw = T_.bid * 8 + wave, NGW = T_.gsz * 8;
    { float* gs = (float*)(p.ws + OFF_GS);
      for (int i = T_.bid * NTHREADS + tid; i < 8 * 9 * 1024; i += T_.gsz * NTHREADS) { const int n = i / 9216, rem = i % 9216, b = rem >> 10, c = rem & 1023, L = n >> 1;
          const float g = (n & 1) ? p.norm2_g[L * 1024 + c] : p.norm1_g[L * 1024 + c];
          gs[i] = g * (1.0f + mods[(size_t)(L * 9 + b) * 6144 + ((n & 1) ? 4096 : 1024) + c]); } }
    { bf16_t* hb = (bf16_t*)(p.ws + OFF_HB); float* ssq0 = (float*)(p.ws + OFF_SSQ);
      for (int row0 = gw; row0 < MTOT; row0 += 2 * NGW) {
          const int row1 = row0 + NGW; const bool has1 = row1 < MTOT; const int r1 = has1 ? row1 : row0;
          const float* xr0 = row0 < NLAT ? p.x + (size_t)row0 * 1024 : p.ctx + (size_t)(row0 - NLAT) * 1024;
          const float* xr1 = r1 < NLAT ? p.x + (size_t)r1 * 1024 : p.ctx + (size_t)(r1 - NLAT) * 1024;
          f32x4 v0[4], v1[4];
#pragma unroll
          for (int j = 0; j < 4; ++j) { v0[j] = *(const f32x4*)(xr0 + 4 * lane + 256 * j); v1[j] = *(const f32x4*)(xr1 + 4 * lane + 256 * j); }
#pragma unroll
          for (int rr = 0; rr < 2; ++rr) { const int row = rr ? r1 : row0; if (rr && !has1) break;
              const int b = row < NLAT ? (row >> 12) : 8; float ss = 0.f;
#pragma unroll
              for (int j = 0; j < 4; ++j) { const f32x4 v = rr ? v1[j] : v0[j]; ss += (v.x * v.x + v.y * v.y) + (v.z * v.z + v.w * v.w); }
              ss = wave_sum(ss);
              if (lane == 0) ssq0[row] = ss;
#pragma unroll
              for (int j = 0; j < 4; ++j) { const int col = 4 * lane + 256 * j; const f32x4 v = rr ? v1[j] : v0[j];
                  const f32x4 gv = *(const f32x4*)(p.norm1_g + col), scv = *(const f32x4*)(mods + (size_t)b * 6144 + 1024 + col);
                  const f32x4 o = v * gv * (1.0f + scv);
                  u32x2 w; w.x = pk2(o.x, o.y); w.y = pk2(o.z, o.w);
                  *(u32x2*)(hb + (size_t)row * 1024 + col) = w; } } } }
    LAS float* sh = (LAS float*)lds;
    for (int cmb = 0; cmb < 8; ++cmb) {
        int L, shoff, N; const bf16_t* Bt; float* dst; const float* addb = nullptr;
        if (cmb < 2) { L = 2 * cmb; shoff = 0; N = 3072; Bt = (const bf16_t*)(p.ws + OFF_QKVT) + (size_t)cmb * 3072 * 1024; dst = (float*)(p.ws + OFF_BQKV) + (size_t)cmb * 9 * 3072; }
        else if (cmb < 6) { L = cmb - 2; shoff = 3072; N = 4096; Bt = (const bf16_t*)(p.ws + OFF_W1T) + (size_t)L * 4096 * 1024; dst = (float*)(p.ws + OFF_BMLP) + (size_t)L * 9 * 4096; }
        else { const int sl = cmb - 6; L = 2 * sl + 1; shoff = 0; N = 6144; Bt = (const bf16_t*)(p.ws + OFF_WINT) + (size_t)sl * 6144 * 1024; dst = (float*)(p.ws + OFF_BWIN) + (size_t)sl * 9 * 6144; addb = p.sg_b_in + sl * 6144; }
        __syncthreads();
        for (int i = tid; i < 9 * 1024; i += NTHREADS) sh[i] = mods[(size_t)(L * 9 + (i >> 10)) * 6144 + shoff + (i & 1023)];
        __syncthreads();
        for (int n = gw; n < N; n += NGW) {
            const bf16_t* wr_ = Bt + (size_t)((n & ~255) + sigma_inv(n & 255)) * 1024 + lane * 8;
            const u32x4 w0 = *(const u32x4*)wr_, w1 = *(const u32x4*)(wr_ + 512);
            float wv[16];
#pragma unroll
            for (int e = 0; e < 4; ++e) { wv[2 * e] = bf2f(w0[e] & 0xffffu); wv[2 * e + 1] = bf2f(w0[e] >> 16); wv[8 + 2 * e] = bf2f(w1[e] & 0xffffu); wv[8 + 2 * e + 1] = bf2f(w1[e] >> 16); }
            const float ab = addb ? addb[n] : 0.f;
#pragma unroll
            for (int b = 0; b < 9; ++b) {
                const f32x4 s0 = *(const LAS f32x4*)(sh + b * 1024 + lane * 8), s1 = *(const LAS f32x4*)(sh + b * 1024 + lane * 8 + 4);
                const f32x4 s2 = *(const LAS f32x4*)(sh + b * 1024 + 512 + lane * 8), s3 = *(const LAS f32x4*)(sh + b * 1024 + 512 + lane * 8 + 4);
                float a = (wv[0] * s0.x + wv[1] * s0.y) + (wv[2] * s0.z + wv[3] * s0.w) + (wv[4] * s1.x + wv[5] * s1.y) + (wv[6] * s1.z + wv[7] * s1.w)
                        + (wv[8] * s2.x + wv[9] * s2.y) + (wv[10] * s2.z + wv[11] * s2.w) + (wv[12] * s3.x + wv[13] * s3.y) + (wv[14] * s3.z + wv[15] * s3.w);
                a = wave_sum(a);
                if (lane == 0) dst[(size_t)b * N + n] = a + ab; }
        }
    }
}

typedef short s16x4 __attribute__((ext_vector_type(4)));
typedef short s16x8 __attribute__((ext_vector_type(8)));
typedef float f32x16 __attribute__((ext_vector_type(16)));
typedef __bf16 bf16x2_t __attribute__((ext_vector_type(2)));
__device__ __forceinline__ unsigned pkb(float a, float b) { const f32x2 v = {a, b}; const bf16x2_t r = __builtin_convertvector(v, bf16x2_t); return __builtin_bit_cast(unsigned, r); }
__device__ __forceinline__ s16x8 pack8(float a0, float a1, float a2, float a3, float a4, float a5, float a6, float a7) {
    u32x4 w; w.x = pkb(a0, a1); w.y = pkb(a2, a3); w.z = pkb(a4, a5); w.w = pkb(a6, a7); return __builtin_bit_cast(s16x8, w); }
__device__ __forceinline__ s16x8 tr_pair(const LAS unsigned char* a0, int second_off) {
    const s16x4 a = __builtin_amdgcn_ds_read_tr16_b64_v4i16((LAS s16x4*)a0);
    const s16x4 b = __builtin_amdgcn_ds_read_tr16_b64_v4i16((LAS s16x4*)(a0 + second_off));
    s16x8 r; r[0] = a[0]; r[1] = a[1]; r[2] = a[2]; r[3] = a[3]; r[4] = b[0]; r[5] = b[1]; r[6] = b[2]; r[7] = b[3]; return r; }
#define MFMA32(a, b, c) __builtin_amdgcn_mfma_f32_32x32x16_bf16((a), (b), (c), 0, 0, 0)

constexpr int AV_STR = 144;
__device__ __forceinline__ f32x16 attn_qk(const s16x8 (&Kf)[4], const s16x8 (&Qf)[4]) {
    f32x16 S;
#pragma unroll
    for (int i = 0; i < 16; ++i) S[i] = 0.f;
#pragma unroll
    for (int ks = 0; ks < 4; ++ks) S = MFMA32(Kf[ks], Qf[ks], S);
    return S;
}
__device__ __forceinline__ float tabv(const LAS unsigned char* tabrow, int off) { return *(const LAS float*)(tabrow + off); }
__device__ __forceinline__ void attn_one_tile(const s16x8 (&Kf)[4], const s16x8 (&Qf)[4], const LAS unsigned char* vb, const LAS unsigned char* tabrow, const unsigned (&offo)[4], const unsigned offx,
                                              f32x16& O0, f32x16& O1, float& lsum, int mode, float mbl) {
    const f32x16 S = attn_qk(Kf, Qf);
    float pv[16];
    if (mode == 0) {
#pragma unroll
        for (int i = 0; i < 16; ++i) pv[i] = __builtin_amdgcn_exp2f(S[i] - mbl);
    } else if (mode == 1) {
#pragma unroll
        for (int i = 0; i < 16; ++i) pv[i] = __builtin_amdgcn_exp2f(S[i] + tabv(tabrow, (int)((offo[i >> 2] >> (8 * (i & 3))) & 0xffu)));
    } else {
#pragma unroll
        for (int i = 0; i < 16; ++i) pv[i] = 0.f;
        if (mode == 2) {
#pragma unroll
            for (int i = 0; i < 4; ++i) pv[i] = __builtin_amdgcn_exp2f(S[i] + tabv(tabrow, (int)((offx >> (8 * i)) & 0xffu)));
        } else {
#pragma unroll
            for (int i = 0; i < 4; ++i) pv[12 + i] = __builtin_amdgcn_exp2f(S[12 + i] + tabv(tabrow, (int)((offx >> (8 * i)) & 0xffu)));
        }
    }
#pragma unroll
    for (int i = 0; i < 16; ++i) lsum += pv[i];
    const s16x8 P0 = pack8(pv[0], pv[1], pv[2], pv[3], pv[4], pv[5], pv[6], pv[7]), P1 = pack8(pv[8], pv[9], pv[10], pv[11], pv[12], pv[13], pv[14], pv[15]);
    { const s16x8 V00 = tr_pair(vb, 8 * AV_STR), V01 = tr_pair(vb + 64, 8 * AV_STR);
      O0 = MFMA32(V00, P0, O0); O1 = MFMA32(V01, P0, O1); }
    { const s16x8 V10 = tr_pair(vb + 16 * AV_STR, 8 * AV_STR), V11 = tr_pair(vb + 16 * AV_STR + 64, 8 * AV_STR);
      O0 = MFMA32(V10, P1, O0); O1 = MFMA32(V11, P1, O1); }
}
__device__ __forceinline__ void attn_load_k(s16x8 (&Kf)[4], const bf16_t* kfb, int klat0, int kctx0, int kt, int ntl, int rs) {
    const int tile = kt < ntl ? klat0 + (rs + (kt >> 1)) * 2 + (kt & 1) : kctx0 + (kt - ntl);
#pragma unroll
    for (int ks = 0; ks < 4; ++ks) Kf[ks] = *(const s16x8*)(kfb + (size_t)tile * 32768 + ks * 512);
}
struct AUnit { int b, h, qrow0, r, rs, ntl, ntiles; };
__device__ __forceinline__ AUnit attn_decode(int u, int nlatu) {
    AUnit a;
    if (u < nlatu) { a.h = u & 15; const int br = u >> 4; a.r = br & 63; a.b = br >> 6; a.qrow0 = a.b * 4096 + a.r * 64; a.rs = min(max(a.r - 4, 0), 56); a.ntl = 16; a.ntiles = 24; }
    else { const int v = u - nlatu; a.h = v & 15; const int bq = v >> 4; a.b = bq >> 2; a.qrow0 = NLAT + a.b * 256 + (bq & 3) * 64; a.r = 0; a.rs = 0; a.ntl = 0; a.ntiles = 8; }
    return a;
}
__device__ __forceinline__ u32x4 attn_load_v1(const bf16_t* vbase, const AUnit& a, int idx) {
    const int key = idx >> 3, ch = idx & 7, kt = key >> 5, kk = key & 31;
    const int grow = kt < a.ntl ? (a.b * 4096 + (a.rs + (kt >> 1)) * 64 + 32 * (kt & 1) + kk) : (NLAT + a.b * 256 + 32 * (kt - a.ntl) + kk);
    return *(const u32x4*)(vbase + (size_t)grow * 1024 + ch * 8);
}
__device__ __forceinline__ void attn_load_v(u32x4 (&vpre)[12], const bf16_t* qkv, const AUnit& a, int tid) {
    const bf16_t* vbase = qkv + (size_t)2 * MTOT * 1024 + a.h * 64;
#pragma unroll
    for (int i = 0; i < 4; ++i) vpre[i] = attn_load_v1(vbase, a, tid + NTHREADS * i);
    if (a.ntiles == 24) {
#pragma unroll
        for (int i = 4; i < 12; ++i) vpre[i] = attn_load_v1(vbase, a, tid + NTHREADS * i);
    }
}

__device__ __forceinline__ void phase_attn_mfma(const Params& p, int a_, bool ctx_q, LAS unsigned char* lds, const Tix T_, const int dummy = 0) {
    const bf16_t* qkv = (const bf16_t*)(p.ws + OFF_BIG); bf16_t* ao = (bf16_t*)(p.ws + OFF_BIG) + (size_t)MTOT * 3072;
    const bf16_t* kf = qkv + (size_t)MTOT * 1024;
    const float* rpb = p.na_rpb + (size_t)a_ * 16 * 15 * 31;
    const int tid = T_.tid, lane = tid & 63, wave = __builtin_amdgcn_readfirstlane(tid >> 6), qt = wave & 1, kq = wave >> 1, l31 = lane & 31, hi = lane >> 5;
    LAS unsigned char* Vl = lds;
    LAS float* Ored = (LAS float*)lds;
    LAS float* lred = (LAS float*)(lds + 69632);
    LAS float* tab_all = (LAS float*)(lds + 110592);
    LAS float* misc = (LAS float*)(lds + 110592 + 30720);
    constexpr float LOG2E = 1.4426950408889634f;
    float mb;
    { float m = 0.f; for (int i = tid; i < 7440; i += NTHREADS) m = fmaxf(m, rpb[i]);
      float qg = 0.f, kg = 0.f; if (tid < 64) { qg = fabsf(p.na_q_norm[a_ * 64 + tid]); kg = fabsf(p.na_k_norm[a_ * 64 + tid]); }
      m = wave_max(m); qg = wave_max(qg); kg = wave_max(kg);
      if (lane == 0) { misc[wave] = m; if (wave == 0) { misc[8] = qg; misc[9] = kg; } }
      __syncthreads();
      float rm = misc[0];
#pragma unroll
      for (int w = 1; w < 8; ++w) rm = fmaxf(rm, misc[w]);
      mb = 8.0f * misc[8] * misc[9] + rm; }
    const float mbl = mb * LOG2E;
    for (int i = tid; i < 16 * 480; i += NTHREADS) { const int hh = i / 480, rem = i % 480, rr = rem >> 5, dd = rem & 31; tab_all[i] = dd < 31 ? (rpb[hh * 465 + rr * 31 + dd] - mb) * LOG2E : -1e30f; }
    const int nlatu = 8 * 64 * 16, total = nlatu + (ctx_q ? 8 * 4 * 16 : 0);
    const int tr_q = (lane & 15) >> 2, tr_p = lane & 3, dgrp = (lane >> 4) & 1;
    const int qcol = 32 * qt + l31, wst = min(max(qcol - 8, 0), 48);
    unsigned offo[4], offx = 0u;
#pragma unroll
    for (int j = 0; j < 4; ++j) { offo[j] = 0u;
#pragma unroll
        for (int i = 0; i < 4; ++i) { const int kcol = 32 * qt + 8 * j + 4 * hi + i; offo[j] |= (unsigned)(((unsigned)(kcol - wst) < 16u ? kcol - qcol + 15 : 31) * 4) << (8 * i); } }
#pragma unroll
    for (int i = 0; i < 4; ++i) { const int kcol = (qt == 0 ? 32 : 24) + 4 * hi + i; offx |= (unsigned)(((unsigned)(kcol - wst) < 16u ? kcol - qcol + 15 : 31) * 4) << (8 * i); }
    int u = T_.bid;
    AUnit cur = attn_decode(min(u, total - 1), nlatu);
    u32x4 vpre[12];
    s16x8 Qf[4], KA[4], KB[4];
    if (u < total) {
        attn_load_v(vpre, qkv, cur, tid);
        const bf16_t* qp = qkv + (size_t)(((cur.qrow0 >> 5) + qt) * 16 + cur.h) * 2048 + lane * 8;
#pragma unroll
        for (int ks = 0; ks < 4; ++ks) Qf[ks] = *(const s16x8*)(qp + 512 * ks);
        const int t0 = kq * (cur.ntiles >> 2);
        attn_load_k(KA, kf + cur.h * 2048 + lane * 8, cur.b * 128, 1024 + cur.b * 8, t0, cur.ntl, cur.rs);
        attn_load_k(KB, kf + cur.h * 2048 + lane * 8, cur.b * 128, 1024 + cur.b * 8, t0 + 1, cur.ntl, cur.rs);
    }
    while (u < total) {
        const int b = cur.b, h = cur.h, qrow0 = cur.qrow0, r = cur.r, rs = cur.rs, ntl = cur.ntl, ntiles = cur.ntiles;
        int tidl = tid; asm volatile("" : "+v"(tidl));
#pragma unroll
        for (int i = 0; i < 4; ++i) { const int idx = tidl + NTHREADS * i; *(LAS u32x4*)(Vl + (idx >> 3) * AV_STR + (idx & 7) * 16) = vpre[i]; }
        if (ntiles == 24) {
#pragma unroll
            for (int i = 4; i < 12; ++i) { const int idx = tidl + NTHREADS * i; *(LAS u32x4*)(Vl + (idx >> 3) * AV_STR + (idx & 7) * 16) = vpre[i]; } }
        const LAS float* tab = tab_all + h * 480;
        const bf16_t* kbase = kf + h * 2048 + lane * 8;
        const int klat0 = b * 128, kctx0 = 1024 + b * 8;
        const int ntw = ntiles >> 2, t0 = kq * ntw;
        __syncthreads();
        f32x16 O0, O1;
#pragma unroll
        for (int i = 0; i < 16; ++i) { O0[i] = 0.f; O1[i] = 0.f; }
        float lsum = 0.f;
#pragma unroll 1
        for (int t = 0; t < (dummy ? 0 : ntw); t += 2) {
            { const int kt = t0 + t; const int mode = kt >= ntl ? 0 : ((kt & 1) == qt ? 1 : 2 + qt);
              attn_one_tile(KA, Qf, Vl + (kt * 32 + 4 * hi + tr_q) * AV_STR + (16 * dgrp + 4 * tr_p) * 2, (const LAS unsigned char*)tab + (rs + (kt >> 1) - r + 7) * 128, offo, offx, O0, O1, lsum, mode, mbl); }
            __builtin_amdgcn_sched_barrier(0);
            attn_load_k(KA, kbase, klat0, kctx0, t0 + min(t + 2, ntw - 2), ntl, rs);
            { const int kt = t0 + t + 1; const int mode = kt >= ntl ? 0 : ((kt & 1) == qt ? 1 : 2 + qt);
              attn_one_tile(KB, Qf, Vl + (kt * 32 + 4 * hi + tr_q) * AV_STR + (16 * dgrp + 4 * tr_p) * 2, (const LAS unsigned char*)tab + (rs + (kt >> 1) - r + 7) * 128, offo, offx, O0, O1, lsum, mode, mbl); }
            __builtin_amdgcn_sched_barrier(0);
            attn_load_k(KB, kbase, klat0, kctx0, t0 + min(t + 2, ntw - 2) + 1, ntl, rs);
        }
        const int un = u + T_.gsz;
        const AUnit nxt = attn_decode(min(un, total - 1), nlatu);
        int tidm = tid; asm volatile("" : "+v"(tidm));
        if (un < total) attn_load_v(vpre, qkv, nxt, tidm);
        __syncthreads();
#pragma unroll
        for (int j = 0; j < 4; ++j) {
            *(LAS f32x4*)(Ored + (size_t)((kq * 64 + 32 * qt + l31) * 68 + 8 * j + 4 * hi)) = (f32x4){O0[4 * j], O0[4 * j + 1], O0[4 * j + 2], O0[4 * j + 3]};
            *(LAS f32x4*)(Ored + (size_t)((kq * 64 + 32 * qt + l31) * 68 + 32 + 8 * j + 4 * hi)) = (f32x4){O1[4 * j], O1[4 * j + 1], O1[4 * j + 2], O1[4 * j + 3]}; }
        lred[(kq * 2 + hi) * 64 + 32 * qt + l31] = lsum;
        if (un < total) {
            const bf16_t* qp = qkv + (size_t)(((nxt.qrow0 >> 5) + qt) * 16 + nxt.h) * 2048 + lane * 8;
#pragma unroll
            for (int ks = 0; ks < 4; ++ks) Qf[ks] = *(const s16x8*)(qp + 512 * ks);
            const int t0n = kq * (nxt.ntiles >> 2);
            attn_load_k(KA, kf + nxt.h * 2048 + lane * 8, nxt.b * 128, 1024 + nxt.b * 8, t0n, nxt.ntl, nxt.rs);
            attn_load_k(KB, kf + nxt.h * 2048 + lane * 8, nxt.b * 128, 1024 + nxt.b * 8, t0n + 1, nxt.ntl, nxt.rs);
        }
        __syncthreads();
        { const int q = tid >> 3, d8 = (tid & 7) * 8;
          f32x4 s0 = (f32x4){0.f, 0.f, 0.f, 0.f}, s1 = s0; float l = 0.f;
#pragma unroll
          for (int k = 0; k < 4; ++k) { s0 += *(const LAS f32x4*)(Ored + (k * 64 + q) * 68 + d8); s1 += *(const LAS f32x4*)(Ored + (k * 64 + q) * 68 + d8 + 4); l += lred[(k * 2) * 64 + q] + lred[(k * 2 + 1) * 64 + q]; }
          const float inv = 1.0f / l;
          u32x4 o; o.x = pkb(s0.x * inv, s0.y * inv); o.y = pkb(s0.z * inv, s0.w * inv); o.z = pkb(s1.x * inv, s1.y * inv); o.w = pkb(s1.z * inv, s1.w * inv);
          *(u32x4*)(ao + (size_t)(qrow0 + q) * 1024 + h * 64 + d8) = o; }
        __syncthreads();
        u = un; cur = nxt;
    }
}

constexpr int SP_RS = 320;
__device__ __forceinline__ void phase_spatial_mfma(const Params& p, int sl, int M, LAS unsigned char* lds, const Tix T_, const bool dummy = false) {
    bf16_t* vb = (bf16_t*)(p.ws + OFF_BIG); const float* lnacc = (const float*)(p.ws + OFF_LNACC) + (size_t)sl * MTOT * 2;
    const float* lng = p.sg_ln_g + sl * 3072; const float* lnb = p.sg_ln_b + sl * 3072;
    const int tid = T_.tid, lane = tid & 63, wave = __builtin_amdgcn_readfirstlane(tid >> 6), pt = wave & 3, cth = wave >> 2, l31 = lane & 31, hi = lane >> 5;
    const int tr_q = (lane & 15) >> 2, tr_p = lane & 3, dgrp = (lane >> 4) & 1;
    const int nunits = (M / 128) * 24;
    const int c8 = (tid & 15) * 8;
    s16x8 wx[8]; u32x4 vw[4]; f32x2 st2[4]; f32x4 g0, g1, b0, b1; float bs;
    const bf16_t* wsf = (const bf16_t*)(p.ws + OFF_WSF);
#define SP_LOAD(uu) do { const int nc_ = (uu) / 24, g_ = (uu) % 24, r0_ = nc_ * 128; \
        const bf16_t* wp_ = wsf + ((size_t)((sl * 24 + g_) * 4 + pt) * 8) * 512 + lane * 8; \
        _Pragma("unroll") for (int ks = 0; ks < 8; ++ks) wx[ks] = *(const s16x8*)(wp_ + ks * 512); \
        _Pragma("unroll") for (int i = 0; i < 4; ++i) { const int q_ = (tid + NTHREADS * i) >> 4; \
            vw[i] = *(const u32x4*)(vb + (size_t)(r0_ + q_) * 3072 + g_ * 128 + c8); st2[i] = *(const f32x2*)(lnacc + 2 * (r0_ + q_)); } \
        g0 = *(const f32x4*)(lng + g_ * 128 + c8); g1 = *(const f32x4*)(lng + g_ * 128 + c8 + 4); b0 = *(const f32x4*)(lnb + g_ * 128 + c8); b1 = *(const f32x4*)(lnb + g_ * 128 + c8 + 4); \
        bs = p.sg_b_s[((size_t)sl * 24 + g_) * 128 + 32 * pt + l31]; } while (0)
    int u = T_.bid, buf = 0;
    if (u < nunits) SP_LOAD(u);
    while (u < nunits) {
        const int nc = u / 24, g = u % 24, r0 = nc * 128;
        LAS unsigned char* tile = lds + buf * (128 * SP_RS);
#pragma unroll
        for (int i = 0; i < 4; ++i) { const int q = (tid + NTHREADS * i) >> 4; const u32x4 w = vw[i];
            const float mean = st2[i].x * (1.0f / 3072.0f), rstd = __builtin_amdgcn_rsqf(fmaxf(st2[i].y * (1.0f / 3072.0f) - mean * mean, 0.f) + 1e-6f);
            u32x4 o;
            o.x = pkb((bf2f(w.x & 0xffffu) - mean) * rstd * g0.x + b0.x, (bf2f(w.x >> 16) - mean) * rstd * g0.y + b0.y);
            o.y = pkb((bf2f(w.y & 0xffffu) - mean) * rstd * g0.z + b0.z, (bf2f(w.y >> 16) - mean) * rstd * g0.w + b0.w);
            o.z = pkb((bf2f(w.z & 0xffffu) - mean) * rstd * g1.x + b1.x, (bf2f(w.z >> 16) - mean) * rstd * g1.y + b1.y);
            o.w = pkb((bf2f(w.w & 0xffffu) - mean) * rstd * g1.z + b1.z, (bf2f(w.w >> 16) - mean) * rstd * g1.w + b1.w);
            *(LAS u32x4*)(tile + q * SP_RS + c8 * 2) = o; }
        s16x8 Wf[8];
#pragma unroll
        for (int ks = 0; ks < 8; ++ks) Wf[ks] = wx[ks];
        const float bsc = bs;
        __syncthreads();
        const int un = u + T_.gsz;
        if (un < nunits) SP_LOAD(un);
        __builtin_amdgcn_sched_barrier(0);
#pragma unroll
        for (int cc = 0; cc < 2; ++cc) { const int ct = 2 * cth + cc;
            f32x16 acc;
#pragma unroll
            for (int i = 0; i < 16; ++i) acc[i] = 0.f;
            const LAS unsigned char* ab = tile + (8 * hi + tr_q) * SP_RS + (32 * ct + 16 * dgrp + 4 * tr_p) * 2;
#pragma unroll
            for (int ks = 0; ks < 8; ++ks) { const s16x8 Af = tr_pair(ab + 16 * ks * SP_RS, 4 * SP_RS); acc = MFMA32(Af, Wf[ks], acc); }
            bf16_t* orow = (dummy ? vb + (size_t)MTOT * 3072 + (size_t)((r0 + 32 * pt + l31) & 8191) * 3072 : vb + (size_t)(r0 + 32 * pt + l31) * 3072) + g * 128 + 32 * ct + 4 * hi;
#pragma unroll
            for (int j = 0; j < 4; ++j) { u32x2 o; o.x = pkb(acc[4 * j] + bsc, acc[4 * j + 1] + bsc); o.y = pkb(acc[4 * j + 2] + bsc, acc[4 * j + 3] + bsc); *(u32x2*)(orow + 8 * j) = o; }
        }
        u = un; buf ^= 1;
    }
#undef SP_LOAD
    __syncthreads();
}

__device__ __forceinline__ int epi_row(int rowbase, int idx) { return rowbase + 128 * (idx >> 2) + 16 * (idx & 3); }
template <class F> struct EpiG {
    static constexpr bool PERM = false, AFTER_DRAIN = false;
    typedef typename F::Pre Pre;
    F f;
    __device__ __forceinline__ void prefetch(Pre& pre, const Unit& u, int wr, int wc, int fr, int fq) const {
        f.prefetch(pre, u, u.pn * 256 + 64 * wc + 8 * fq, u.pm * 256 + wr * 64 + fr); }
    __device__ __forceinline__ void operator()(const f32x4 (&acc)[2][2][4][2], const Unit& u, int wr, int wc, int fr, int fq, const Pre& pre) const {
        F g = f; const int colb = u.pn * 256 + 64 * wc + 8 * fq, rowbase = u.pm * 256 + wr * 64 + fr;
        g.begin(u, colb, fq, rowbase, pre);
#pragma unroll
        for (int ai = 0; ai < 2; ++ai)
#pragma unroll
            for (int m = 0; m < 4; ++m) {
                g.row(ai * 4 + m, rowbase + ai * 128 + m * 16, colb, acc[ai][0][m][0], acc[ai][0][m][1], acc[ai][1][m][0], acc[ai][1][m][1]);
                asm volatile("" ::: "memory"); }
    }
};
struct PreSB { float v[8]; f32x4 bz[4];
    __device__ __forceinline__ void load(const float* ssq, int rowbase, const float* bp) {
#pragma unroll
        for (int i = 0; i < 8; ++i) v[i] = ssq[epi_row(rowbase, i)];
        bz[0] = *(const f32x4*)bp; bz[1] = *(const f32x4*)(bp + 4); bz[2] = *(const f32x4*)(bp + 32); bz[3] = *(const f32x4*)(bp + 36); } };
__device__ __forceinline__ void store8_bf16(bf16_t* o, const f32x4 a, const f32x4 b) { u32x4 w; w.x = pk2(a.x, a.y); w.y = pk2(a.z, a.w); w.z = pk2(b.x, b.y); w.w = pk2(b.z, b.w); *(u32x4*)o = w; }
__device__ __forceinline__ float sumsq4(const f32x4 x) { return (x.x * x.x + x.y * x.y) + (x.z * x.z + x.w * x.w); }
__device__ __forceinline__ float sum4(const f32x4 x) { return (x.x + x.y) + (x.z + x.w); }
__device__ __forceinline__ float rstd_from(float ssq) { return __builtin_amdgcn_rsqf(ssq * (1.0f / 1024.0f) + 1e-6f); }
__device__ __forceinline__ void atomic_addf(float* p, float v) { __hip_atomic_fetch_add(p, v, __ATOMIC_RELAXED, __HIP_MEMORY_SCOPE_AGENT); }
struct FQKV { static constexpr bool IDEMP = true; bf16_t* O; const float* qg; const float* kg; const float* ssq; const float* bias;
    typedef PreSB Pre;
    f32x4 gn[4], bz[4]; int sect; float rqv[8];
    __device__ __forceinline__ void prefetch(Pre& pre, const Unit& u, int colb, int rowbase) const { pre.load(ssq, rowbase, bias + (size_t)min(u.pm >> 4, 8) * 3072 + colb); }
    __device__ __forceinline__ void begin(const Unit& u, int colb, int fq, int rowbase, const Pre& pre) {
#pragma unroll
        for (int i = 0; i < 8; ++i) rqv[i] = pre.v[i];
#pragma unroll
        for (int i = 0; i < 4; ++i) bz[i] = pre.bz[i];
        sect = u.pn >> 2;
        if (sect < 2) { const float* gp = (sect == 0 ? qg : kg) + 8 * fq; const float mul = sect == 0 ? 0.125f * 1.4426950408889634f : 1.0f;
            gn[0] = *(const f32x4*)gp * mul; gn[1] = *(const f32x4*)(gp + 4) * mul; gn[2] = *(const f32x4*)(gp + 32) * mul; gn[3] = *(const f32x4*)(gp + 36) * mul; } }
    __device__ __forceinline__ void row(int idx, int row, int colb, f32x4 a0, f32x4 b0, f32x4 a1, f32x4 b1) {
        const float rs = rstd_from(rqv[idx]);
        a0 = a0 * rs + bz[0]; b0 = b0 * rs + bz[1]; a1 = a1 * rs + bz[2]; b1 = b1 * rs + bz[3];
        if (sect < 2) { float ss = (sumsq4(a0) + sumsq4(b0)) + (sumsq4(a1) + sumsq4(b1));
            ss += __shfl_xor(ss, 16); ss += __shfl_xor(ss, 32);
            const float r2 = __builtin_amdgcn_rsqf(ss * (1.0f / 64.0f) + 1e-6f);
            a0 = a0 * r2 * gn[0]; b0 = b0 * r2 * gn[1]; a1 = a1 * r2 * gn[2]; b1 = b1 * r2 * gn[3]; }
        if (sect < 2) {
            const int within = colb & 1023, h = within >> 6, fq = (within >> 3) & 7;
            bf16_t* op = O + (size_t)sect * MTOT * 1024 + ((size_t)((row >> 5) * 16 + h) * 4 + (fq >> 1)) * 512 + ((fq & 1) * 32 + (row & 31)) * 8;
            store8_bf16(op, a0, b0); store8_bf16(op + 2 * 512, a1, b1);
        } else { bf16_t* op = O + (size_t)2 * MTOT * 1024 + (size_t)row * 1024 + (colb - 2048); store8_bf16(op, a0, b0); store8_bf16(op + 32, a1, b1); } } };
struct FSqrelu { static constexpr bool IDEMP = true; bf16_t* O; const float* ssq; const float* bias;
    typedef PreSB Pre;
    f32x4 bz[4]; float rqv[8];
    __device__ __forceinline__ void prefetch(Pre& pre, const Unit& u, int colb, int rowbase) const { pre.load(ssq, rowbase, bias + (size_t)min(u.pm >> 4, 8) * 4096 + colb); }
    __device__ __forceinline__ void begin(const Unit& u, int colb, int fq, int rowbase, const Pre& pre) {
#pragma unroll
        for (int i = 0; i < 8; ++i) rqv[i] = pre.v[i];
#pragma unroll
        for (int i = 0; i < 4; ++i) bz[i] = pre.bz[i]; }
    __device__ __forceinline__ void row(int idx, int row, int colb, f32x4 a0, f32x4 b0, f32x4 a1, f32x4 b1) {
        const float rs = rstd_from(rqv[idx]); const f32x4 z = (f32x4){0.f, 0.f, 0.f, 0.f};
        a0 = __builtin_elementwise_max(a0 * rs + bz[0], z); b0 = __builtin_elementwise_max(b0 * rs + bz[1], z); a1 = __builtin_elementwise_max(a1 * rs + bz[2], z); b1 = __builtin_elementwise_max(b1 * rs + bz[3], z);
        bf16_t* op = O + (size_t)row * 4096 + colb; store8_bf16(op, a0 * a0, b0 * b0); store8_bf16(op + 32, a1 * a1, b1 * b1); } };
struct FGeluV { static constexpr bool IDEMP = false; bf16_t* O; const float* ssq; const float* bias; float* lnacc;
    typedef PreSB Pre;
    f32x4 bz[4]; int fq_; float rqv[8];
    __device__ __forceinline__ void prefetch(Pre& pre, const Unit& u, int colb, int rowbase) const { pre.load(ssq, rowbase, bias + (size_t)min(u.pm >> 4, 8) * 6144 + colb); }
    __device__ __forceinline__ void begin(const Unit& u, int colb, int fq, int rowbase, const Pre& pre) { fq_ = fq;
#pragma unroll
        for (int i = 0; i < 8; ++i) rqv[i] = pre.v[i];
#pragma unroll
        for (int i = 0; i < 4; ++i) bz[i] = pre.bz[i]; }
    __device__ __forceinline__ void row(int idx, int row, int colb, f32x4 a0, f32x4 b0, f32x4 a1, f32x4 b1) {
        const float rs = rstd_from(rqv[idx]);
        a0 = gelu4(a0 * rs + bz[0]); b0 = gelu4(b0 * rs + bz[1]); a1 = gelu4(a1 * rs + bz[2]); b1 = gelu4(b1 * rs + bz[3]);
        bf16_t* op = O + (size_t)row * 3072 + colb; store8_bf16(op, a0, b0); store8_bf16(op + 32, a1, b1);
        float s1 = (sum4(a0) + sum4(b0)) + (sum4(a1) + sum4(b1)), s2 = (sumsq4(a0) + sumsq4(b0)) + (sumsq4(a1) + sumsq4(b1));
        s1 += __shfl_xor(s1, 16); s1 += __shfl_xor(s1, 32); s2 += __shfl_xor(s2, 16); s2 += __shfl_xor(s2, 32);
        if (fq_ == 0) { atomic_addf(lnacc + 2 * (size_t)row, s1); atomic_addf(lnacc + 2 * (size_t)row + 1, s2); } } };
struct FGeluU { static constexpr bool IDEMP = false; bf16_t* O; const float* ssq; const float* bias;
    typedef PreSB Pre;
    f32x4 bz[4]; float rqv[8]; u32x4 sv[2][2]; int rowbase_;
    __device__ __forceinline__ void prefetch(Pre& pre, const Unit& u, int colb, int rowbase) const { pre.load(ssq, rowbase, bias + (size_t)min(u.pm >> 4, 8) * 6144 + colb); }
    __device__ __forceinline__ void fetch(int idx, int colb) { const bf16_t* op = O + (size_t)epi_row(rowbase_, idx) * 3072 + colb; sv[idx & 1][0] = *(const u32x4*)op; sv[idx & 1][1] = *(const u32x4*)(op + 32); }
    __device__ __forceinline__ void begin(const Unit& u, int colb, int fq, int rowbase, const Pre& pre) { rowbase_ = rowbase; fetch(0, colb);
#pragma unroll
        for (int i = 0; i < 8; ++i) rqv[i] = pre.v[i];
#pragma unroll
        for (int i = 0; i < 4; ++i) bz[i] = pre.bz[i]; }
    __device__ __forceinline__ static f32x4 lo4(const u32x4 s) { return (f32x4){bf2f(s.x & 0xffffu), bf2f(s.x >> 16), bf2f(s.y & 0xffffu), bf2f(s.y >> 16)}; }
    __device__ __forceinline__ static f32x4 hi4(const u32x4 s) { return (f32x4){bf2f(s.z & 0xffffu), bf2f(s.z >> 16), bf2f(s.w & 0xffffu), bf2f(s.w >> 16)}; }
    __device__ __forceinline__ void row(int idx, int row, int colb, f32x4 a0, f32x4 b0, f32x4 a1, f32x4 b1) {
        if (idx < 7) fetch(idx + 1, colb);
        const float rs = rstd_from(rqv[idx]);
        bf16_t* op = O + (size_t)row * 3072 + colb; const u32x4 sv0 = sv[idx & 1][0], sv1 = sv[idx & 1][1];
        a0 = gelu4(a0 * rs + bz[0]) * lo4(sv0); b0 = gelu4(b0 * rs + bz[1]) * hi4(sv0); a1 = gelu4(a1 * rs + bz[2]) * lo4(sv1); b1 = gelu4(b1 * rs + bz[3]) * hi4(sv1);
        store8_bf16(op, a0, b0); store8_bf16(op + 32, a1, b1); } };
struct FResid { static constexpr bool IDEMP = false; const float* inl; const float* inc; float* outl; float* outc; const float* gate;
    const float* gsn; bf16_t* xb; float* ssqn;
    struct Pre { f32x4 gz[4]; };
    f32x4 gz[4], gsz[4], xin[2][4]; int fq_, rowbase_;
    __device__ __forceinline__ void prefetch(Pre& pre, const Unit& u, int colb, int rowbase) const { const float* gp = gate + (size_t)min(u.pm >> 4, 8) * 6144 + colb;
        pre.gz[0] = *(const f32x4*)gp; pre.gz[1] = *(const f32x4*)(gp + 4); pre.gz[2] = *(const f32x4*)(gp + 32); pre.gz[3] = *(const f32x4*)(gp + 36); }
    __device__ __forceinline__ void fetch(int idx, int colb) { const int row = epi_row(rowbase_, idx);
        const float* ip = row < NLAT ? inl + (size_t)row * 1024 + colb : inc + (size_t)(row - NLAT) * 1024 + colb;
        xin[idx & 1][0] = *(const f32x4*)ip; xin[idx & 1][1] = *(const f32x4*)(ip + 4); xin[idx & 1][2] = *(const f32x4*)(ip + 32); xin[idx & 1][3] = *(const f32x4*)(ip + 36); }
    __device__ __forceinline__ void begin(const Unit& u, int colb, int fq, int rowbase, const Pre& pre) { const int b = min(u.pm >> 4, 8); fq_ = fq; rowbase_ = rowbase; fetch(0, colb);
#pragma unroll
        for (int i = 0; i < 4; ++i) gz[i] = pre.gz[i];
        if (gsn) { const float* sp = gsn + (size_t)b * 1024 + colb; gsz[0] = *(const f32x4*)sp; gsz[1] = *(const f32x4*)(sp + 4); gsz[2] = *(const f32x4*)(sp + 32); gsz[3] = *(const f32x4*)(sp + 36); } }
    __device__ __forceinline__ void row(int idx, int row, int colb, f32x4 a0, f32x4 b0, f32x4 a1, f32x4 b1) {
        if (idx < 7) fetch(idx + 1, colb);
        float* op = row < NLAT ? outl + (size_t)row * 1024 + colb : outc + (size_t)(row - NLAT) * 1024 + colb;
        a0 = xin[idx & 1][0] + gz[0] * a0; b0 = xin[idx & 1][1] + gz[1] * b0; a1 = xin[idx & 1][2] + gz[2] * a1; b1 = xin[idx & 1][3] + gz[3] * b1;
        *(f32x4*)op = a0; *(f32x4*)(op + 4) = b0; *(f32x4*)(op + 32) = a1; *(f32x4*)(op + 36) = b1;
        if (gsn) { float ss = (sumsq4(a0) + sumsq4(b0)) + (sumsq4(a1) + sumsq4(b1));
            ss += __shfl_xor(ss, 16); ss += __shfl_xor(ss, 32);
            if (fq_ == 0) atomic_addf(ssqn + row, ss);
            bf16_t* xp = xb + (size_t)row * 1024 + colb; store8_bf16(xp, a0 * gsz[0], b0 * gsz[1]); store8_bf16(xp + 32, a1 * gsz[2], b1 * gsz[3]); } } };

template <class F> __device__ __forceinline__ void run_gemm(LAS unsigned char* lds, const bf16_t* A, const bf16_t* Bt, int M, int N, int K, const F& f, const Tix T_) {
    pg8::StaticOrder S; S.init(M, N, T_.gsz, T_.bid);
    pg8::Gemm g; g.A = A; g.Bt = Bt; g.M = M; g.N = N; g.K = K;
    EpiG<F> E; E.f = f;
    pg8::gemm_phase<EpiG<F>, pg8::StaticOrder, true, true>(lds, g, S, E, T_.tid);
}

enum { OP_QKV, OP_ATTN, OP_MIXOUT, OP_MLP1, OP_MLP2, OP_VGEMM, OP_SPATIAL, OP_UGEMM, OP_PROLOGUE, OP_PHASE0B };

__device__ __forceinline__ void decode_phase(int ph, int& L, int& op) {
    L = 0; op = ph == 0 ? OP_PROLOGUE : OP_PHASE0B;
    if (ph > 1) {
        int q = ph - 2;
        if (q < 5) { L = 0; } else if (q < 11) { L = 1; q -= 5; } else if (q < 16) { L = 2; q -= 11; } else { L = 3; q -= 16; }
        if ((L & 1) == 0) op = q == 0 ? OP_QKV : q == 1 ? OP_ATTN : q == 2 ? OP_MIXOUT : q == 3 ? OP_MLP1 : OP_MLP2;
        else op = q == 0 ? OP_VGEMM : q == 1 ? OP_SPATIAL : q == 2 ? OP_UGEMM : q == 3 ? OP_MIXOUT : q == 4 ? OP_MLP1 : OP_MLP2;
    }
}

__device__ __forceinline__ void run_phase(const Params& p, int ph, LAS unsigned char* lds, const Tix T_) {
    int L, op; decode_phase(ph, L, op);
#ifdef ONLY_OP
    op = ONLY_OP;
#endif
    const int mi = L >> 1;
    const bool attnL = (L & 1) == 0;
    const int Mfull = L < 2 ? MTOT : NLAT;
    const float* modsl = (const float*)(p.ws + OFF_MODS) + (size_t)L * 9 * 6144;
    float* ctxr = (float*)(p.ws + OFF_CTXR);
    bf16_t* hb = (bf16_t*)(p.ws + OFF_HB); bf16_t* big = (bf16_t*)(p.ws + OFF_BIG);
    float* ssq = (float*)(p.ws + OFF_SSQ); const float* gs = (const float*)(p.ws + OFF_GS);
    const bool first = (L == 0);
    switch (op) {
    case OP_PROLOGUE: phase_zero(p, T_); phase_mods(p, lds, T_); __syncthreads(); phase_convert(p, lds, T_); break;
    case OP_PHASE0B: phase_0b(p, lds, T_); break;
    case OP_QKV: { FQKV f; f.O = big; f.qg = p.na_q_norm + mi * 64; f.kg = p.na_k_norm + mi * 64; f.ssq = ssq + (size_t)(2 * L) * MTOT; f.bias = (const float*)(p.ws + OFF_BQKV) + (size_t)mi * 9 * 3072;
        run_gemm(lds, hb, (const bf16_t*)(p.ws + OFF_QKVT) + (size_t)mi * 3072 * 1024, MTOT, 3072, 1024, f, T_); } break;
#ifdef REP_ATTN_DUMMY
    case OP_ATTN: phase_attn_mfma(p, mi, L == 0, lds, T_, 1); __syncthreads(); phase_attn_mfma(p, mi, L == 0, lds, T_); break;
#else
    case OP_ATTN: phase_attn_mfma(p, mi, L == 0, lds, T_); break;
#endif
    case OP_MIXOUT: case OP_MLP2: {
        FResid f; const bool mo = (op == OP_MIXOUT);
        f.inl = (first && mo) ? p.x : p.out; f.inc = (first && mo) ? p.ctx : ctxr; f.outl = p.out; f.outc = ctxr; f.gate = modsl + (mo ? 2048 : 5120);
        const int nn = mo ? 2 * L + 1 : 2 * L + 2;
        const bool has_next = nn < 8 && !(nn == 6 + 0 && false);
        f.gsn = has_next ? gs + (size_t)nn * 9 * 1024 : nullptr; f.xb = hb; f.ssqn = ssq + (size_t)(has_next ? nn : 0) * MTOT;
        const bf16_t* A; const bf16_t* Bt; int K;
        if (!mo) { A = big; Bt = (const bf16_t*)(p.ws + OFF_W2T) + (size_t)L * 1024 * 4096; K = 4096; }
        else if (attnL) { A = big + (size_t)MTOT * 3072; Bt = (const bf16_t*)(p.ws + OFF_WOT) + (size_t)mi * 1024 * 1024; K = 1024; }
        else { A = big; Bt = (const bf16_t*)(p.ws + OFF_SGOT) + (size_t)mi * 1024 * 3072; K = 3072; }
        run_gemm(lds, A, Bt, Mfull, 1024, K, f, T_); } break;
    case OP_MLP1: { FSqrelu f; f.O = big; f.ssq = ssq + (size_t)(2 * L + 1) * MTOT; f.bias = (const float*)(p.ws + OFF_BMLP) + (size_t)L * 9 * 4096;
        run_gemm(lds, hb, (const bf16_t*)(p.ws + OFF_W1T) + (size_t)L * 4096 * 1024, Mfull, 4096, 1024, f, T_); } break;
    case OP_VGEMM: { FGeluV f; f.O = big; f.ssq = ssq + (size_t)(2 * L) * MTOT; f.bias = (const float*)(p.ws + OFF_BWIN) + (size_t)mi * 9 * 6144 + 3072; f.lnacc = (float*)(p.ws + OFF_LNACC) + (size_t)mi * MTOT * 2;
        run_gemm(lds, hb, (const bf16_t*)(p.ws + OFF_WINT) + (size_t)mi * 6144 * 1024 + (size_t)3072 * 1024, Mfull, 3072, 1024, f, T_); } break;
#ifdef REP_SPATIAL
    case OP_SPATIAL: phase_spatial_mfma(p, mi, Mfull, lds, T_, true); __syncthreads(); phase_spatial_mfma(p, mi, Mfull, lds, T_); break;
#else
    case OP_SPATIAL: phase_spatial_mfma(p, mi, Mfull, lds, T_); break;
#endif
    case OP_UGEMM: { FGeluU f; f.O = big; f.ssq = ssq + (size_t)(2 * L) * MTOT; f.bias = (const float*)(p.ws + OFF_BWIN) + (size_t)mi * 9 * 6144;
        run_gemm(lds, hb, (const bf16_t*)(p.ws + OFF_WINT) + (size_t)mi * 6144 * 1024, Mfull, 3072, 1024, f, T_); } break;
    default: break;
    }
}

#ifndef ONE_LAUNCH
#define ONE_LAUNCH 1
#endif
__global__ void __launch_bounds__(NTHREADS) mk(Params p0) {
    extern __shared__ __attribute__((aligned(16))) unsigned char lds_raw[];
    LAS unsigned char* lds = (LAS unsigned char*)lds_raw;
#if ONE_LAUNCH
    cg::grid_group grid = cg::this_grid();
    if (p0.ph_lo < 0) grid.sync();
    volatile LAS unsigned* st = (volatile LAS unsigned*)(lds + LDS_ST_OFF);
    if (threadIdx.x == 0) { st[0] = 0u; st[1] = 0u; }
    __syncthreads();
    const XcdBarrier xbar = xcd_barrier_post((unsigned*)(p0.ws + OFF_BAR), st);
    bool first_it = true, repeated = false;
    for (int ph = p0.ph_lo; ph < p0.ph_hi; ) {
        if (!first_it) xcd_barrier(xbar);
        first_it = false;
        Tix T_; T_.tid = threadIdx.x; T_.bid = blockIdx.x; T_.gsz = gridDim.x;
        size_t z = 0;
        asm volatile("" : "+v"(T_.tid)); asm volatile("" : "+s"(T_.bid), "+s"(T_.gsz), "+s"(z));
        Params p = p0;
        { const float** pp = (const float**)&p;
#pragma unroll
          for (int i = 0; i < 22; ++i) pp[i] += z; }
        p.out += z; p.ws += z;
        run_phase(p, ph, lds, T_);
        __syncthreads();
        if (REP_MASK != 0) { int L_, op_; decode_phase(ph, L_, op_); if (((REP_MASK >> op_) & 1) && !repeated) { repeated = true; continue; } }
        repeated = false; ++ph;
    }
#else
    Tix T_; T_.tid = threadIdx.x; T_.bid = blockIdx.x; T_.gsz = gridDim.x;
    run_phase(p0, p0.ph_lo, lds, T_);
#endif
}

extern "C" void kernel_launch(void* const* d_in, const int* in_sizes, int n_in, void* d_out, int out_size, void* d_ws, size_t ws_size, hipStream_t stream) {
    static int grid = 0;
    if (grid == 0) {
        if (n_in != 22 || ws_size < WS_END) { fprintf(stderr, "kernel_launch: unexpected n_in %d or ws_size %zu (< %zu)\n", n_in, ws_size, (size_t)WS_END); grid = -1; return; }
        int dev = 0, cus = 0, per_cu = 0;
        hipGetDevice(&dev); hipDeviceGetAttribute(&cus, hipDeviceAttributeMultiprocessorCount, dev);
        if (hipFuncSetAttribute((const void*)mk, hipFuncAttributeMaxDynamicSharedMemorySize, LDS_BYTES) != hipSuccess) { fprintf(stderr, "kernel_launch: hipFuncSetAttribute failed\n"); grid = -1; return; }
        if (hipOccupancyMaxActiveBlocksPerMultiprocessor(&per_cu, (const void*)mk, NTHREADS, LDS_BYTES) != hipSuccess || per_cu < 1) { fprintf(stderr, "kernel_launch: occupancy query says %d\n", per_cu); per_cu = 1; }
        (void)hipGetLastError();
        grid = cus;
    }
    if (grid < 0) return;
    if (hipMemsetAsync((unsigned char*)d_ws + OFF_BAR, 0, 16384, stream) != hipSuccess) { fprintf(stderr, "kernel_launch: memset of the barrier words failed\n"); return; }
    Params p{};
    const float** pp = (const float**)&p;
    for (int i = 0; i < 22; ++i) pp[i] = (const float*)d_in[i];
    p.out = (float*)d_out; p.ws = (unsigned char*)d_ws;
#if ONE_LAUNCH
    p.ph_lo = 0; p.ph_hi = NPH;
    void* args[] = {&p};
    hipError_t e = hipLaunchCooperativeKernel((void*)mk, dim3(grid), dim3(NTHREADS), args, LDS_BYTES, stream);
    if (e != hipSuccess) fprintf(stderr, "cooperative launch failed: %s (grid %d)\n", hipGetErrorString(e), grid);
#else
    for (int ph = 0; ph < NPH; ++ph) { p.ph_lo = ph; p.ph_hi = ph + 1; hipLaunchKernelGGL(mk, dim3(grid), dim3(NTHREADS), LDS_BYTES, stream, p); }
#endif
}
```

```cpp
#include <hip/hip_runtime.h>
#include <hip/hip_cooperative_groups.h>
#include <cstdio>
#include <cstdint>
namespace cg = cooperative_groups;
namespace pg8 {
#define PG8_LAS __attribute__((address_space(3)))
typedef unsigned short bf16_t;
typedef short bf16x8 __attribute__((ext_vector_type(8)));
typedef float f32x4 __attribute__((ext_vector_type(4)));
typedef unsigned u32x4 __attribute__((ext_vector_type(4)));
constexpr int BM = 256, BK = 64, HALF = 128, HTB = HALF * BK * 2  , STAGE_BYTES = 8 * HTB, NXCD = 8, WGM = 8;

__host__ __device__ __forceinline__ int lds_byte(int r, int c) { const int st = (r >> 4) * 2 + (c >> 5), rr = r & 15, cc = c & 31, ob = rr * 64 + cc * 2; return st * 1024 + (ob ^ (((ob >> 9) & 1) << 5)); }
__host__ __device__ __forceinline__ void stage_rc(int b, int& R, int& C) { const int st = b / 1024, sb = b % 1024, swz = sb ^ (((sb >> 9) & 1) << 5); R = (st >> 1) * 16 + swz / 64; C = (st & 1) * 32 + (swz % 64) / 2; }
__host__ __device__ __forceinline__ int perm32(int rho) { const int n = rho >> 4, i = rho & 15; return 8 * (i >> 2) + 4 * n + (i & 3); }

struct Unit { int pm, pn, ko; };
struct Gemm { const bf16_t* A; const bf16_t* Bt; int M, N, K, ld; };

struct StaticOrder {
    int nM, nN, nwg, G, c;
    __host__ __device__ void init(int M, int N, int G_, int c_) { nM = M / BM; nN = N / BM; nwg = nM * nN; G = G_; c = c_; }
    __host__ __device__ bool next(int i, Unit& u) const {
        const long L = (long)i * G + c; if (L >= nwg) return false;
        int wgid = (int)L; { const int q = nwg / NXCD, r = nwg % NXCD, xcd = wgid % NXCD, off = wgid / NXCD; wgid = (xcd < r ? xcd * (q + 1) : r * (q + 1) + (xcd - r) * q) + off; }
        const int nig = WGM * nN, gid = wgid / nig, fm = gid * WGM, gsz = (nM - fm) < WGM ? (nM - fm) : WGM;
        u.pm = fm + ((wgid % nig) % gsz); u.pn = (wgid % nig) / gsz; u.ko = 0; return true;
    }
    __device__ __forceinline__ void a_ready(const Unit&) const {}
    __device__ __forceinline__ void done(const Unit&) const {}
};

struct SplitOrder {
    int nM, nN, ns, pm0, klen, nwg, G, c;
    __host__ __device__ void init(int nM_, int nN_, int ns_, int pm0_, int klen_, int G_, int c_) { nM = nM_; nN = nN_; ns = ns_; pm0 = pm0_; klen = klen_; nwg = nM * nN * ns; G = G_; c = c_; }
    __host__ __device__ bool next(int i, Unit& u) const {
        const long L = (long)i * G + c; if (L >= nwg) return false;
        const int w = (int)L, t = w % (nM * nN); u.ko = (w / (nM * nN)) * klen; u.pm = pm0 + t % nM; u.pn = t / nM; return true;
    }
    __device__ __forceinline__ void a_ready(const Unit&) const {}
    __device__ __forceinline__ void done(const Unit&) const {}
};

__device__ __forceinline__ unsigned cvt_pk_bf16(float lo, float hi) { unsigned r; asm volatile("v_cvt_pk_bf16_f32 %0, %1, %2" : "=v"(r) : "v"(lo), "v"(hi)); return r; }
template <class Epi, class Sched, bool ALIGN_EPI = false, bool SP2 = false>
__device__ __forceinline__ void gemm_phase(PG8_LAS unsigned char* lds, const Gemm g, const Sched& S, const Epi& E, const int tid_in) {
    const int tid = tid_in, wid = __builtin_amdgcn_readfirstlane(tid >> 6), lane = tid & 63, wr = wid >> 2, wc = wid & 3, fr = lane & 15, fq = lane >> 4;
    const int K = g.ld, nt = g.K / BK;
    unsigned voffA[2], voffB[2];
#pragma unroll
    for (int i = 0; i < 2; ++i) { int R, C; stage_rc(tid * 16 + i * 8192, R, C); const int Rb = Epi::PERM ? ((R & ~31) + perm32(R & 31)) : R;
        voffA[i] = (unsigned)(R * K + C) * 2u; voffB[i] = (unsigned)(Rb * K + C) * 2u; }
    const size_t kstep = (size_t)(BK * 2);
    const size_t hstep = (size_t)HALF * K * 2;
    const size_t tstep = 2 * hstep;
    const unsigned ldsw = (unsigned)wid * 1024u;
    const int aoff = lds_byte(wr * 64 + fr, fq * 8), boff = lds_byte(wc * 32 + fr, fq * 8);
#define PG8_SA(b, h) (((b) * 2 + (h)) * HTB)
#define PG8_SB(b, h) ((4 + (b) * 2 + (h)) * HTB)
#define PG8_STAGE(bufoff, gbase, voff) do { _Pragma("unroll") for (int _i = 0; _i < 2; ++_i) \
        __builtin_amdgcn_global_load_lds((const unsigned*)((const char*)(gbase) + (voff)[_i]), (PG8_LAS unsigned*)(lds + (bufoff) + ldsw + _i * 8192), 16, 0, 0); } while (0)
#define PG8_LDA(dst, b, h) do { _Pragma("unroll") for (int m = 0; m < 4; ++m) _Pragma("unroll") for (int k = 0; k < 2; ++k) dst[m][k] = *(const PG8_LAS bf16x8*)(lds + PG8_SA(b, h) + aoff + m * 2048 + k * 1024); } while (0)
#define PG8_LDB(dst, b, h) do { _Pragma("unroll") for (int n = 0; n < 2; ++n) _Pragma("unroll") for (int k = 0; k < 2; ++k) dst[n][k] = *(const PG8_LAS bf16x8*)(lds + PG8_SB(b, h) + boff + n * 2048 + k * 1024); } while (0)
#define PG8_MMA(ai, bj, At, Bt) do { __builtin_amdgcn_s_setprio(1); _Pragma("unroll") for (int m = 0; m < 4; ++m) _Pragma("unroll") for (int n = 0; n < 2; ++n) _Pragma("unroll") for (int k = 0; k < 2; ++k) \
        acc[ai][bj][m][n] = __builtin_amdgcn_mfma_f32_16x16x32_bf16(Bt[n][k], At[m][k], acc[ai][bj][m][n], 0, 0, 0); __builtin_amdgcn_s_setprio(0); } while (0)
#define PG8_WAIT_V(n) asm volatile("s_waitcnt vmcnt(" #n ")" ::: "memory")
#define PG8_WAIT_L(n) asm volatile("s_waitcnt lgkmcnt(" #n ")" ::: "memory")
#define PG8_BAR __builtin_amdgcn_s_barrier()
#define PG8_SCHED __builtin_amdgcn_sched_barrier(0)
    Unit cur, nxt; int ui = 0;
    if (!S.next(0, cur)) return;
    f32x4 acc[2][2][4][2];
#pragma unroll
    for (int a = 0; a < 2; ++a)
#pragma unroll
        for (int b = 0; b < 2; ++b)
#pragma unroll
            for (int m = 0; m < 4; ++m)
#pragma unroll
                for (int n = 0; n < 2; ++n) acc[a][b][m][n] = (f32x4){0.f, 0.f, 0.f, 0.f};
    bf16x8 At[4][2], B0[2][2], B1[2][2];
    const char* cA = (const char*)g.A + (size_t)cur.pm * tstep + (size_t)cur.ko * 2; const char* cB = (const char*)g.Bt + (size_t)cur.pn * tstep + (size_t)cur.ko * 2;
    S.a_ready(cur);
    typename Epi::Pre pre; E.prefetch(pre, cur, wr, wc, fr, fq);
    if constexpr (SP2) {
        PG8_STAGE(PG8_SB(0, 0), cB, voffB); PG8_STAGE(PG8_SB(0, 1), cB + hstep, voffB); PG8_STAGE(PG8_SA(0, 0), cA, voffA); PG8_STAGE(PG8_SA(0, 1), cA + hstep, voffA);
        if (wr == 1) PG8_BAR;
        PG8_WAIT_V(2); PG8_BAR;
        PG8_STAGE(PG8_SB(1, 0), cB + kstep, voffB); PG8_STAGE(PG8_SA(1, 0), cA + kstep, voffA); PG8_STAGE(PG8_SB(1, 1), cB + hstep + kstep, voffB);
        PG8_WAIT_V(6); PG8_BAR;
    } else {
        PG8_STAGE(PG8_SB(0, 0), cB, voffB); PG8_STAGE(PG8_SA(0, 0), cA, voffA); PG8_STAGE(PG8_SB(0, 1), cB + hstep, voffB); PG8_STAGE(PG8_SA(0, 1), cA + hstep, voffA);
        if (wr == 1) PG8_BAR;
        PG8_WAIT_V(4); PG8_BAR;
        PG8_STAGE(PG8_SB(1, 0), cB + kstep, voffB); PG8_STAGE(PG8_SA(1, 0), cA + kstep, voffA); PG8_STAGE(PG8_SB(1, 1), cB + hstep + kstep, voffB);
        PG8_WAIT_V(6); PG8_BAR;
    }
    for (;;) {
        const bool has_next = S.next(ui + 1, nxt);
        const char* nA = has_next ? (const char*)g.A + (size_t)nxt.pm * tstep + (size_t)nxt.ko * 2 : cA; const char* nB = has_next ? (const char*)g.Bt + (size_t)nxt.pn * tstep + (size_t)nxt.ko * 2 : cB;
        for (int t = 0; t < nt; t += 2) {
            const bool last = (t == nt - 2);
            const char* a1 = cA + (size_t)(t + 1) * kstep;
            const char* a2 = last ? nA : cA + (size_t)(t + 2) * kstep; const char* b2 = last ? nB : cB + (size_t)(t + 2) * kstep;
            const char* a3 = a2 + kstep; const char* b3 = b2 + kstep;
            if (last && has_next) S.a_ready(nxt);
            if constexpr (SP2) {
            PG8_LDB(B0, 0, 0); PG8_LDB(B1, 0, 1); PG8_SCHED; PG8_LDA(At, 0, 0); PG8_STAGE(PG8_SA(1, 1), a1 + hstep, voffA);
            PG8_WAIT_V(8); PG8_WAIT_L(0); PG8_BAR; PG8_MMA(0, 0, At, B0); PG8_MMA(0, 1, At, B1); PG8_BAR; PG8_SCHED;
            PG8_LDA(At, 0, 1); PG8_STAGE(PG8_SB(0, 0), b2, voffB); PG8_STAGE(PG8_SB(0, 1), b2 + hstep, voffB); PG8_STAGE(PG8_SA(0, 0), a2, voffA);
            PG8_WAIT_V(8); PG8_WAIT_L(0); PG8_BAR; PG8_MMA(1, 0, At, B0); PG8_MMA(1, 1, At, B1); PG8_BAR; PG8_SCHED;
            PG8_LDB(B0, 1, 0); PG8_LDB(B1, 1, 1); PG8_SCHED; PG8_LDA(At, 1, 0); PG8_STAGE(PG8_SA(0, 1), a2 + hstep, voffA);
            PG8_WAIT_V(8); PG8_WAIT_L(0); PG8_BAR; PG8_MMA(0, 0, At, B0); PG8_MMA(0, 1, At, B1); PG8_BAR; PG8_SCHED;
            PG8_LDA(At, 1, 1); PG8_STAGE(PG8_SB(1, 0), b3, voffB); PG8_STAGE(PG8_SB(1, 1), b3 + hstep, voffB); PG8_STAGE(PG8_SA(1, 0), a3, voffA);
            PG8_WAIT_V(8); PG8_WAIT_L(0); PG8_BAR; PG8_MMA(1, 0, At, B0); PG8_MMA(1, 1, At, B1); PG8_BAR; PG8_SCHED;
            } else {
            PG8_LDB(B0, 0, 0); PG8_SCHED; PG8_LDA(At, 0, 0); PG8_STAGE(PG8_SA(1, 1), a1 + hstep, voffA);
            PG8_WAIT_L(8); PG8_BAR; PG8_WAIT_L(0); PG8_MMA(0, 0, At, B0); PG8_BAR; PG8_SCHED;
            PG8_LDB(B1, 0, 1); PG8_STAGE(PG8_SB(0, 0), b2, voffB);
            PG8_BAR; PG8_WAIT_L(0); PG8_MMA(0, 1, At, B1); PG8_BAR;
            PG8_LDA(At, 0, 1); PG8_STAGE(PG8_SA(0, 0), a2, voffA);
            PG8_BAR; PG8_WAIT_L(0); PG8_MMA(1, 0, At, B0); PG8_BAR; PG8_SCHED;
            PG8_STAGE(PG8_SB(0, 1), b2 + hstep, voffB);
            PG8_WAIT_V(6); PG8_BAR; PG8_MMA(1, 1, At, B1); PG8_BAR;
            PG8_LDB(B0, 1, 0); PG8_SCHED; PG8_LDA(At, 1, 0); PG8_STAGE(PG8_SA(0, 1), a2 + hstep, voffA);
            PG8_WAIT_L(8); PG8_BAR; PG8_WAIT_L(0); PG8_MMA(0, 0, At, B0); PG8_BAR; PG8_SCHED;
            PG8_LDB(B1, 1, 1); PG8_STAGE(PG8_SB(1, 0), b3, voffB);
            PG8_BAR; PG8_WAIT_L(0); PG8_MMA(0, 1, At, B1); PG8_BAR;
            PG8_LDA(At, 1, 1); PG8_STAGE(PG8_SA(1, 0), a3, voffA);
            PG8_BAR; PG8_WAIT_L(0); PG8_MMA(1, 0, At, B0); PG8_BAR; PG8_SCHED;
            PG8_STAGE(PG8_SB(1, 1), b3 + hstep, voffB);
            PG8_WAIT_V(6); PG8_BAR; PG8_MMA(1, 1, At, B1); PG8_BAR;
            }
        }
        if constexpr (ALIGN_EPI) { if (wr == 0) PG8_BAR; }
        if constexpr (!Epi::AFTER_DRAIN) { E(acc, cur, wr, wc, fr, fq, pre); S.done(cur); }
        if (!has_next) break;
#pragma unroll
        for (int a = 0; a < 2; ++a)
#pragma unroll
            for (int b = 0; b < 2; ++b)
#pragma unroll
                for (int m = 0; m < 4; ++m)
#pragma unroll
                    for (int n = 0; n < 2; ++n) acc[a][b][m][n] = (f32x4){0.f, 0.f, 0.f, 0.f};
        cur = nxt; cA = nA; cB = nB; ++ui;
        E.prefetch(pre, cur, wr, wc, fr, fq);
        if constexpr (ALIGN_EPI) { if (wr == 1) PG8_BAR; }
    }
    PG8_WAIT_V(0);
    if constexpr (!ALIGN_EPI) { if (wr == 0) PG8_BAR; }
    PG8_BAR;
    if constexpr (Epi::AFTER_DRAIN) { E.fused(acc, cur, wr, wc, fr, fq, lds, wid, lane); S.done(cur); }
#undef PG8_SA
#undef PG8_SB
#undef PG8_STAGE
#undef PG8_LDA
#undef PG8_LDB
#undef PG8_MMA
#undef PG8_WAIT_V
#undef PG8_WAIT_L
#undef PG8_BAR
#undef PG8_SCHED
}
}
#define LAS __attribute__((address_space(3)))

#define XB_TMO      128
#define XB_XCNT(j)  (256  + 64 * (j))
#define XB_XSUB(j)  (1280 + 64 * (j))
#define XB_XGEN(j)  (2304 + 64 * (j))
#define XB_TOP      3328
#define XB_TOPGEN   3392
#define XCD_BAR_WORDS 3456
#define XB_SPIN_CAP (1u << 18)

__device__ __forceinline__ unsigned xb_ld(unsigned* p)              { return __hip_atomic_load(p, __ATOMIC_RELAXED, __HIP_MEMORY_SCOPE_AGENT); }
__device__ __forceinline__ unsigned xb_add(unsigned* p, unsigned v) { return __hip_atomic_fetch_add(p, v, __ATOMIC_RELAXED, __HIP_MEMORY_SCOPE_AGENT); }
__device__ __forceinline__ unsigned xb_xcc_id() { return (unsigned)__builtin_amdgcn_s_getreg((3 << 11) | 20) & 0xFu; }
#define XB_SPIN(cond, bar) do { unsigned _sp = 0; while (cond) { __builtin_amdgcn_s_sleep(1); \
    if ((++_sp & 255u) == 0u) { if (xb_ld(&(bar)[XB_TMO])) break; if (_sp > XB_SPIN_CAP) { atomicAdd(&(bar)[XB_TMO], 1u); break; } } } } while (0)

struct XcdBarrier {
    unsigned* bar; unsigned x;
    volatile LAS unsigned* st;
};

__device__ __forceinline__ XcdBarrier xcd_barrier_post(unsigned* bar, volatile LAS unsigned* st) {
    XcdBarrier b; b.bar = bar; b.x = xb_xcc_id(); b.st = st;
    if (threadIdx.x == 0) (void)xb_add(&bar[XB_XCNT(b.x)], 1u);
    return b;
}
__device__ __forceinline__ void xcd_barrier_complete(unsigned* bar, unsigned x, unsigned& nloc, unsigned& nx) {
    const unsigned G = gridDim.x * gridDim.y * gridDim.z;
    unsigned sum, cnt, mine, sp = 0u;
    for (;;) {
        sum = 0u; cnt = 0u; mine = 0u;
#pragma unroll
        for (unsigned j = 0; j < 16; ++j) { const unsigned c = xb_ld(&bar[XB_XCNT(j)]); sum += c; cnt += (c > 0u) ? 1u : 0u; mine = (j == x) ? c : mine; }
        if (sum == G) break;
        __builtin_amdgcn_s_sleep(1);
        if ((++sp & 255u) == 0u) { if (xb_ld(&bar[XB_TMO])) break; if (sp > XB_SPIN_CAP) { atomicAdd(&bar[XB_TMO], 1u); break; } }
    }
    nloc = mine > 0u ? mine : 1u; nx = cnt > 0u ? cnt : 1u;
}

__device__ __forceinline__ void xcd_barrier(const XcdBarrier& b) {
    asm volatile("s_waitcnt vmcnt(0)" ::: "memory");
    __syncthreads();
    if (threadIdx.x == 0) {
        unsigned* bar = b.bar;
        __builtin_amdgcn_s_waitcnt(0);
        unsigned nloc = b.st[0], nx = b.st[1];
        if (nloc == 0u) { xcd_barrier_complete(bar, b.x, nloc, nx); b.st[0] = nloc; b.st[1] = nx; }
        const unsigned old = xb_add(&bar[XB_XSUB(b.x)], 1u);
        const unsigned gen = old / nloc;
        if (old + 1u == (gen + 1u) * nloc) {
            __builtin_amdgcn_fence(__ATOMIC_RELEASE, "agent");
            asm volatile("s_waitcnt vmcnt(0)" ::: "memory");
            const unsigned og = xb_add(&bar[XB_TOP], 1u);
            const unsigned tg = og / nx;
            if (og + 1u == (tg + 1u) * nx) xb_add(&bar[XB_TOPGEN], 1u);
            else XB_SPIN(xb_ld(&bar[XB_TOPGEN]) == tg, bar);
            __builtin_amdgcn_fence(__ATOMIC_ACQUIRE, "agent");
            xb_add(&bar[XB_XGEN(b.x)], 1u);
            asm volatile("s_waitcnt vmcnt(0)" ::: "memory");
        } else {
            XB_SPIN(xb_ld(&bar[XB_XGEN(b.x)]) == gen, bar);
            __builtin_amdgcn_fence(__ATOMIC_ACQUIRE, "agent");
            asm volatile("s_waitcnt vmcnt(0)" ::: "memory");
        }
    }
    __syncthreads();
}


#ifndef REP_MASK
#define REP_MASK 0
#endif
#ifndef NAIVE_ATTN
#define NAIVE_ATTN 0
#endif
#ifndef NAIVE_SPATIAL
#define NAIVE_SPATIAL 0
#endif

using pg8::bf16_t; using pg8::f32x4; using pg8::Unit; using pg8::u32x4;
typedef unsigned u32x2 __attribute__((ext_vector_type(2)));

constexpr int NLAT = 32768, NCTX = 2048, MTOT = 34816;
constexpr int NTHREADS = 512;
constexpr int LDS_BYTES = 141440;
constexpr int LDS_ST_OFF = 141424;
constexpr int NPH = 27;

constexpr size_t OFF_W1T = 0;
constexpr size_t OFF_W2T = OFF_W1T + 4ull * 4096 * 1024 * 2;
constexpr size_t OFF_QKVT = OFF_W2T + 4ull * 4096 * 1024 * 2;
constexpr size_t OFF_WOT = OFF_QKVT + 2ull * 3072 * 1024 * 2;
constexpr size_t OFF_WINT = OFF_WOT + 2ull * 1024 * 1024 * 2;
constexpr size_t OFF_SGOT = OFF_WINT + 2ull * 6144 * 1024 * 2;
constexpr size_t OFF_MODS = OFF_SGOT + 2ull * 1024 * 3072 * 2;
constexpr size_t OFF_CTXR = OFF_MODS + 4ull * 9 * 6144 * 4;
constexpr size_t OFF_HB = OFF_CTXR + 2048ull * 1024 * 4;
constexpr size_t OFF_BIG = OFF_HB + 34816ull * 1024 * 2;
constexpr size_t OFF_SSQ = OFF_BIG + 34816ull * 4096 * 2;
constexpr size_t OFF_LNACC = OFF_SSQ + 8ull * 34816 * 4;
constexpr size_t OFF_GS = OFF_LNACC + 2ull * 34816 * 2 * 4;
constexpr size_t OFF_BQKV = OFF_GS + 8ull * 9 * 1024 * 4;
constexpr size_t OFF_BMLP = OFF_BQKV + 2ull * 9 * 3072 * 4;
constexpr size_t OFF_BWIN = OFF_BMLP + 4ull * 9 * 4096 * 4;
constexpr size_t OFF_WSF = OFF_BWIN + 2ull * 9 * 6144 * 4;
constexpr size_t OFF_PART = OFF_WSF + 2ull * 24 * 16384 * 2;
constexpr size_t OFF_BAR = OFF_PART + 4ull * 2048 * 1024 * 4;
constexpr size_t WS_END = OFF_BAR + 16384;

struct Params {
    const float *x, *c, *ctx, *c_ctx, *ada_w, *ada_b, *norm1_g, *norm2_g, *mlp_w1, *mlp_w2, *na_w_qkv, *na_q_norm, *na_k_norm, *na_rpb, *na_w_o,
        *sg_w_in, *sg_b_in, *sg_ln_g, *sg_ln_b, *sg_w_s, *sg_b_s, *sg_w_o;
    float* out; unsigned char* ws; int ph_lo, ph_hi;
};

struct Tix { int tid, bid, gsz; };
__device__ __forceinline__ float bf2f(unsigned h) { return __uint_as_float(h << 16); }
__device__ __forceinline__ unsigned f2bf(float f) { unsigned u = __float_as_uint(f); u += 0x7FFFu + ((u >> 16) & 1u); return u >> 16; }
__device__ __forceinline__ unsigned pk2(float lo, float hi) { return pg8::cvt_pk_bf16(lo, hi); }
__device__ __forceinline__ float wave_sum(float v) {
#pragma unroll
    for (int o = 1; o < 64; o <<= 1) v += __shfl_xor(v, o);
    return v;
}
__device__ __forceinline__ float wave_max(float v) {
#pragma unroll
    for (int o = 1; o < 64; o <<= 1) v = fmaxf(v, __shfl_xor(v, o));
    return v;
}
#define LDS_WAIT() asm volatile("s_waitcnt lgkmcnt(0)" ::: "memory")
__device__ __forceinline__ float sumsq4f(const pg8::f32x4 x) { return (x.x * x.x + x.y * x.y) + (x.z * x.z + x.w * x.w); }
__device__ __forceinline__ float silu_f(float v) { return v / (1.f + expf(-v)); }
__device__ __forceinline__ float gelu_f(float v) { return 0.5f * v * (1.f + erff(v * 0.70710678118654752f)); }

typedef float f32x2 __attribute__((ext_vector_type(2)));
__device__ __forceinline__ f32x2 gelu_pk(f32x2 v) {
    const f32x2 av = __builtin_elementwise_abs(v), d = av * 0.2316418882f + 1.0f;
    f32x2 t; t.x = __builtin_amdgcn_rcpf(d.x); t.y = __builtin_amdgcn_rcpf(d.y);
    f32x2 q = t * 0.5307027145f + (-0.7265760135f); q = q * t + 0.7107068705f; q = q * t + (-0.142248368f); q = q * t + 0.127414796f; q = q * t;
    const f32x2 s = (v * v) * (-0.72134752044f);
    f32x2 e; e.x = __builtin_amdgcn_exp2f(s.x); e.y = __builtin_amdgcn_exp2f(s.y);
    const f32x2 m = v * (q * e), r = v - m;
    f32x2 o; o.x = v.x < 0.f ? m.x : r.x; o.y = v.y < 0.f ? m.y : r.y; return o;
}
__device__ __forceinline__ f32x4 gelu4(f32x4 v) { const f32x2 a = gelu_pk((f32x2){v.x, v.y}), b = gelu_pk((f32x2){v.z, v.w}); return (f32x4){a.x, a.y, b.x, b.y}; }

__device__ __forceinline__ int sigma_inv(int L) { return 128 * ((L >> 5) & 1) + 32 * (L >> 6) + 16 * ((L >> 2) & 1) + 4 * ((L >> 3) & 3) + (L & 3); }

__device__ __forceinline__ void phase_mods(const Params& p, LAS unsigned char* lds, const Tix T_) {
    LAS float* sc = (LAS float*)lds;
    LAS float* red = (LAS float*)(lds + 36864);
    float* mods = (float*)(p.ws + OFF_MODS);
    const int tid = T_.tid;
    for (int i = tid; i < 9 * 1024; i += NTHREADS) { const int b = i >> 10, k = i & 1023; const float v = b < 8 ? p.c[b * 1024 + k] : p.c_ctx[k]; sc[i] = silu_f(v); }
    __syncthreads();
    const int c4 = (tid & 7) * 4, kk = tid >> 3;
    for (int item = T_.bid; item < 768; item += T_.gsz) {
        const int l = item / 192, n0 = (item % 192) * 32;
        const float* W = p.ada_w + (size_t)l * 1024 * 6144 + n0 + c4;
        f32x4 acc[9];
#pragma unroll
        for (int b = 0; b < 9; ++b) acc[b] = (f32x4){0.f, 0.f, 0.f, 0.f};
        f32x4 wq[16];
#pragma unroll
        for (int i = 0; i < 16; ++i) wq[i] = *(const f32x4*)(W + (size_t)(kk + 64 * i) * 6144);
        __builtin_amdgcn_sched_barrier(0);
#pragma unroll
        for (int i = 0; i < 16; ++i) { const int k = kk + 64 * i;
#pragma unroll
            for (int b = 0; b < 9; ++b) acc[b] += sc[b * 1024 + k] * wq[i]; }
#pragma unroll
        for (int b = 0; b < 9; ++b) *(LAS f32x4*)(red + (kk * 9 + b) * 32 + c4) = acc[b];
        __syncthreads();
        for (int o = tid; o < 288; o += NTHREADS) { const int b = o >> 5, cc = o & 31; float s0 = 0.f, s1 = 0.f;
            for (int j = 0; j < 64; j += 2) { s0 += red[(j * 9 + b) * 32 + cc]; s1 += red[((j + 1) * 9 + b) * 32 + cc]; }
            mods[(size_t)(l * 9 + b) * 6144 + n0 + cc] = (s0 + s1) + p.ada_b[l * 6144 + n0 + cc]; }
        __syncthreads();
    }
}

struct MatDesc { const float* src; bf16_t* dst; int K, N; };
__device__ __forceinline__ MatDesc get_mat(const Params& p, int mi) {
    MatDesc m;
    if (mi < 4) { m.src = p.mlp_w1 + (size_t)mi * 1024 * 4096; m.dst = (bf16_t*)(p.ws + OFF_W1T) + (size_t)mi * 4096 * 1024; m.K = 1024; m.N = 4096; }
    else if (mi < 8) { const int l = mi - 4; m.src = p.mlp_w2 + (size_t)l * 4096 * 1024; m.dst = (bf16_t*)(p.ws + OFF_W2T) + (size_t)l * 1024 * 4096; m.K = 4096; m.N = 1024; }
    else if (mi < 10) { const int a = mi - 8; m.src = p.na_w_qkv + (size_t)a * 1024 * 3072; m.dst = (bf16_t*)(p.ws + OFF_QKVT) + (size_t)a * 3072 * 1024; m.K = 1024; m.N = 3072; }
    else if (mi < 12) { const int a = mi - 10; m.src = p.na_w_o + (size_t)a * 1024 * 1024; m.dst = (bf16_t*)(p.ws + OFF_WOT) + (size_t)a * 1024 * 1024; m.K = 1024; m.N = 1024; }
    else if (mi < 14) { const int s = mi - 12; m.src = p.sg_w_in + (size_t)s * 1024 * 6144; m.dst = (bf16_t*)(p.ws + OFF_WINT) + (size_t)s * 6144 * 1024; m.K = 1024; m.N = 6144; }
    else { const int s = mi - 14; m.src = p.sg_w_o + (size_t)s * 3072 * 1024; m.dst = (bf16_t*)(p.ws + OFF_SGOT) + (size_t)s * 1024 * 3072; m.K = 3072; m.N = 1024; }
    return m;
}
struct CvItem { const float* src; bf16_t* dst; int K, N, k0, n0; };
__device__ __forceinline__ CvItem cv_locate(const Params& p, int g) {
    int mi, it;
    if (g < 8192) { mi = g >> 11; it = g & 2047; }
    else if (g < 16384) { mi = 4 + ((g - 8192) >> 11); it = g & 2047; }
    else if (g < 19456) { const int t = g - 16384; mi = 8 + t / 1536; it = t % 1536; }
    else if (g < 20480) { const int t = g - 19456; mi = 10 + (t >> 9); it = t & 511; }
    else if (g < 26624) { const int t = g - 20480; mi = 12 + t / 3072; it = t % 3072; }
    else { const int t = g - 26624; mi = 14 + t / 1536; it = t % 1536; }
    const MatDesc m = get_mat(p, mi);
    CvItem c; c.src = m.src; c.dst = m.dst; c.K = m.K; c.N = m.N; const int nblk = m.N / 32; c.k0 = 64 * (it / nblk); c.n0 = 32 * (it % nblk);
    return c;
}
__device__ __forceinline__ void cv_load(float (&wv)[32], const CvItem& c, int lane) {
    const float* wsrc = c.src + (size_t)(c.k0 + (lane >> 5)) * c.N + c.n0 + (lane & 31);
#pragma unroll
    for (int i = 0; i < 32; ++i) wv[i] = wsrc[(size_t)(2 * i) * c.N];
}
__device__ __forceinline__ void phase_convert(const Params& p, LAS unsigned char* lds, const Tix T_) {
    const int lane = T_.tid & 63, wave = T_.tid >> 6, gw = T_.bid * 8 + wave, NGW = T_.gsz * 8;
    LAS float* scr = (LAS float*)(lds + wave * 8704);
    constexpr int NITEMS = 29696;
    float wv[32];
    int g = gw;
    CvItem cur = cv_locate(p, min(g, NITEMS - 1));
    if (g < NITEMS) cv_load(wv, cur, lane);
    while (g < NITEMS) {
#pragma unroll
        for (int i = 0; i < 32; ++i) scr[(2 * i + (lane >> 5)) * 33 + (lane & 31)] = wv[i];
        const int gn = g + NGW;
        const CvItem nxt = cv_locate(p, min(gn, NITEMS - 1));
        if (gn < NITEMS) cv_load(wv, nxt, lane);
        LDS_WAIT();
        const int c = lane & 7;
#pragma unroll
        for (int j = 0; j < 4; ++j) { const int n = (lane >> 3) + 8 * j; const LAS float* s = scr + (8 * c) * 33 + n;
            u32x4 o; o.x = pk2(s[0 * 33], s[1 * 33]); o.y = pk2(s[2 * 33], s[3 * 33]); o.z = pk2(s[4 * 33], s[5 * 33]); o.w = pk2(s[6 * 33], s[7 * 33]);
            const int nl = cur.n0 + n, drow = (nl & ~255) + sigma_inv(nl & 255);
            *(u32x4*)(cur.dst + (size_t)drow * cur.K + cur.k0 + 8 * c) = o; }
        LDS_WAIT();
        g = gn; cur = nxt;
    }
    { bf16_t* wsf = (bf16_t*)(p.ws + OFF_WSF);
      for (int it = gw; it < 2 * 24 * 4 * 8; it += NGW) { const int ks = it & 7, pt = (it >> 3) & 3, slg = it >> 5;
          const float* wp = p.sg_w_s + (size_t)slg * 16384 + (32 * pt + (lane & 31)) * 128 + 16 * ks + 8 * (lane >> 5);
          const f32x4 x = *(const f32x4*)wp, y = *(const f32x4*)(wp + 4);
          u32x4 o; o.x = pk2(x.x, x.y); o.y = pk2(x.z, x.w); o.z = pk2(y.x, y.y); o.w = pk2(y.z, y.w);
          *(u32x4*)(wsf + (size_t)it * 512 + lane * 8) = o; } }
}


__device__ __forceinline__ void phase_zero(const Params& p, const Tix T_) {
    float* z0 = (float*)(p.ws + OFF_SSQ) + MTOT; const int n0 = 7 * MTOT + 2 * MTOT * 2;
    for (int i = T_.bid * NTHREADS + T_.tid; i < n0; i += T_.gsz * NTHREADS) z0[i] = 0.f;
}
__device__ __forceinline__ void phase_0b(const Params& p, LAS unsigned char* lds, const Tix T_) {
    const float* mods = (const float*)(p.ws + OFF_MODS);
    const int tid = T_.tid, lane = tid & 63, wave = tid >> 6, gw = T_.bid * 8 + wave, NGW = T_.gsz * 8;
    { float* gs = (float*)(p.ws + OFF_GS);
      for (int i = T_.bid * NTHREADS + tid; i < 8 * 9 * 1024; i += T_.gsz * NTHREADS) { const int n = i / 9216, rem = i % 9216, b = rem >> 10, c = rem & 1023, L = n >> 1;
          const float g = (n & 1) ? p.norm2_g[L * 1024 + c] : p.norm1_g[L * 1024 + c];
          gs[i] = g * (1.0f + mods[(size_t)(L * 9 + b) * 6144 + ((n & 1) ? 4096 : 1024) + c]); } }
    { bf16_t* hb = (bf16_t*)(p.ws + OFF_HB); float* ssq0 = (float*)(p.ws + OFF_SSQ);
      f32x4 gvv[4];
#pragma unroll
      for (int j = 0; j < 4; ++j) gvv[j] = *(const f32x4*)(p.norm1_g + 4 * lane + 256 * j);
      for (int row0 = gw; row0 < MTOT; row0 += 2 * NGW) {
          const int row1 = row0 + NGW; const bool has1 = row1 < MTOT; const int r1 = has1 ? row1 : row0;
          const float* xr0 = row0 < NLAT ? p.x + (size_t)row0 * 1024 : p.ctx + (size_t)(row0 - NLAT) * 1024;
          const float* xr1 = r1 < NLAT ? p.x + (size_t)r1 * 1024 : p.ctx + (size_t)(r1 - NLAT) * 1024;
          const int b0 = row0 < NLAT ? (row0 >> 12) : 8, b1 = r1 < NLAT ? (r1 >> 12) : 8;
          f32x4 v0[4], v1[4], s0[4], s1[4];
#pragma unroll
          for (int j = 0; j < 4; ++j) { v0[j] = *(const f32x4*)(xr0 + 4 * lane + 256 * j); v1[j] = *(const f32x4*)(xr1 + 4 * lane + 256 * j);
              s0[j] = *(const f32x4*)(mods + (size_t)b0 * 6144 + 1024 + 4 * lane + 256 * j); s1[j] = *(const f32x4*)(mods + (size_t)b1 * 6144 + 1024 + 4 * lane + 256 * j); }
          __builtin_amdgcn_sched_barrier(0);
          float ss0 = 0.f, ss1 = 0.f;
#pragma unroll
          for (int j = 0; j < 4; ++j) { ss0 += sumsq4f(v0[j]); ss1 += sumsq4f(v1[j]); }
#pragma unroll
          for (int o = 1; o < 64; o <<= 1) { const float t0 = __shfl_xor(ss0, o), t1 = __shfl_xor(ss1, o); ss0 += t0; ss1 += t1; }
          if (lane == 0) { ssq0[row0] = ss0; if (has1) ssq0[row1] = ss1; }
#pragma unroll
          for (int j = 0; j < 4; ++j) { const int col = 4 * lane + 256 * j;
              const f32x4 o0 = v0[j] * gvv[j] * (1.0f + s0[j]);
              u32x2 w; w.x = pk2(o0.x, o0.y); w.y = pk2(o0.z, o0.w);
              *(u32x2*)(hb + (size_t)row0 * 1024 + col) = w;
              if (has1) { const f32x4 o1 = v1[j] * gvv[j] * (1.0f + s1[j]);
                  u32x2 w1; w1.x = pk2(o1.x, o1.y); w1.y = pk2(o1.z, o1.w);
                  *(u32x2*)(hb + (size_t)row1 * 1024 + col) = w1; } } } }
    LAS float* sh = (LAS float*)lds;
    for (int cmb = 0; cmb < 8; ++cmb) {
        int L, shoff, N; const bf16_t* Bt; float* dst; const float* addb = nullptr;
        if (cmb < 2) { L = 2 * cmb; shoff = 0; N = 3072; Bt = (const bf16_t*)(p.ws + OFF_QKVT) + (size_t)cmb * 3072 * 1024; dst = (float*)(p.ws + OFF_BQKV) + (size_t)cmb * 9 * 3072; }
        else if (cmb < 6) { L = cmb - 2; shoff = 3072; N = 4096; Bt = (const bf16_t*)(p.ws + OFF_W1T) + (size_t)L * 4096 * 1024; dst = (float*)(p.ws + OFF_BMLP) + (size_t)L * 9 * 4096; }
        else { const int sl = cmb - 6; L = 2 * sl + 1; shoff = 0; N = 6144; Bt = (const bf16_t*)(p.ws + OFF_WINT) + (size_t)sl * 6144 * 1024; dst = (float*)(p.ws + OFF_BWIN) + (size_t)sl * 9 * 6144; addb = p.sg_b_in + sl * 6144; }
        __syncthreads();
        for (int i = tid; i < 9 * 1024; i += NTHREADS) sh[i] = mods[(size_t)(L * 9 + (i >> 10)) * 6144 + shoff + (i & 1023)];
        __syncthreads();
        for (int n = gw; n < N; n += NGW) {
            const bf16_t* wr_ = Bt + (size_t)((n & ~255) + sigma_inv(n & 255)) * 1024 + lane * 8;
            const u32x4 w0 = *(const u32x4*)wr_, w1 = *(const u32x4*)(wr_ + 512);
            float wv[16];
#pragma unroll
            for (int e = 0; e < 4; ++e) { wv[2 * e] = bf2f(w0[e] & 0xffffu); wv[2 * e + 1] = bf2f(w0[e] >> 16); wv[8 + 2 * e] = bf2f(w1[e] & 0xffffu); wv[8 + 2 * e + 1] = bf2f(w1[e] >> 16); }
            const float ab = addb ? addb[n] : 0.f;
            float a9[9];
#pragma unroll
            for (int b = 0; b < 9; ++b) {
                const f32x4 s0 = *(const LAS f32x4*)(sh + b * 1024 + lane * 8), s1 = *(const LAS f32x4*)(sh + b * 1024 + lane * 8 + 4);
                const f32x4 s2 = *(const LAS f32x4*)(sh + b * 1024 + 512 + lane * 8), s3 = *(const LAS f32x4*)(sh + b * 1024 + 512 + lane * 8 + 4);
                a9[b] = (wv[0] * s0.x + wv[1] * s0.y) + (wv[2] * s0.z + wv[3] * s0.w) + (wv[4] * s1.x + wv[5] * s1.y) + (wv[6] * s1.z + wv[7] * s1.w)
                      + (wv[8] * s2.x + wv[9] * s2.y) + (wv[10] * s2.z + wv[11] * s2.w) + (wv[12] * s3.x + wv[13] * s3.y) + (wv[14] * s3.z + wv[15] * s3.w); }
#pragma unroll
            for (int o = 1; o < 64; o <<= 1) {
                float t9[9];
#pragma unroll
                for (int b = 0; b < 9; ++b) t9[b] = __shfl_xor(a9[b], o);
#pragma unroll
                for (int b = 0; b < 9; ++b) a9[b] += t9[b]; }
            if (lane == 0) {
#pragma unroll
                for (int b = 0; b < 9; ++b) dst[(size_t)b * N + n] = a9[b] + ab; }
        }
    }
}

typedef short s16x4 __attribute__((ext_vector_type(4)));
typedef short s16x8 __attribute__((ext_vector_type(8)));
typedef float f32x16 __attribute__((ext_vector_type(16)));
typedef __bf16 bf16x2_t __attribute__((ext_vector_type(2)));
__device__ __forceinline__ unsigned pkb(float a, float b) { const f32x2 v = {a, b}; const bf16x2_t r = __builtin_convertvector(v, bf16x2_t); return __builtin_bit_cast(unsigned, r); }
__device__ __forceinline__ s16x8 pack8(float a0, float a1, float a2, float a3, float a4, float a5, float a6, float a7) {
    u32x4 w; w.x = pkb(a0, a1); w.y = pkb(a2, a3); w.z = pkb(a4, a5); w.w = pkb(a6, a7); return __builtin_bit_cast(s16x8, w); }
__device__ __forceinline__ s16x8 tr_pair(const LAS unsigned char* a0, int second_off) {
    const s16x4 a = __builtin_amdgcn_ds_read_tr16_b64_v4i16((LAS s16x4*)a0);
    const s16x4 b = __builtin_amdgcn_ds_read_tr16_b64_v4i16((LAS s16x4*)(a0 + second_off));
    s16x8 r; r[0] = a[0]; r[1] = a[1]; r[2] = a[2]; r[3] = a[3]; r[4] = b[0]; r[5] = b[1]; r[6] = b[2]; r[7] = b[3]; return r; }
#define MFMA32(a, b, c) __builtin_amdgcn_mfma_f32_32x32x16_bf16((a), (b), (c), 0, 0, 0)

constexpr int AV_STR = 144;
__device__ __forceinline__ f32x16 attn_qk(const s16x8 (&Kf)[4], const s16x8 (&Qf)[4]) {
    f32x16 S;
#pragma unroll
    for (int i = 0; i < 16; ++i) S[i] = 0.f;
#pragma unroll
    for (int ks = 0; ks < 4; ++ks) S = MFMA32(Kf[ks], Qf[ks], S);
    return S;
}
__device__ __forceinline__ float tabv(const LAS unsigned char* tabrow, int off) { return *(const LAS float*)(tabrow + off); }
__device__ __forceinline__ void attn_one_tile(const s16x8 (&Kf)[4], const s16x8 (&Qf)[4], const LAS unsigned char* vb, const LAS unsigned char* tabrow, const unsigned (&offo)[4], const unsigned offx,
                                              f32x16& O0, f32x16& O1, float& lsum, int mode, float mbl) {
    if (mode == 4) return;
    const f32x16 S = attn_qk(Kf, Qf);
    float pv[16];
    if (mode == 0) {
#pragma unroll
        for (int i = 0; i < 16; ++i) pv[i] = __builtin_amdgcn_exp2f(S[i] - mbl);
    } else if (mode == 1) {
        float tb[16];
#pragma unroll
        for (int i = 0; i < 16; ++i) tb[i] = tabv(tabrow, (int)((offo[i >> 2] >> (8 * (i & 3))) & 0xffu));
        __builtin_amdgcn_sched_barrier(0);
#pragma unroll
        for (int i = 0; i < 16; ++i) pv[i] = __builtin_amdgcn_exp2f(S[i] + tb[i]);
    } else {
        float tb[4];
#pragma unroll
        for (int i = 0; i < 4; ++i) tb[i] = tabv(tabrow, (int)((offx >> (8 * i)) & 0xffu));
        __builtin_amdgcn_sched_barrier(0);
#pragma unroll
        for (int i = 0; i < 16; ++i) pv[i] = 0.f;
        if (mode == 2) {
#pragma unroll
            for (int i = 0; i < 4; ++i) pv[i] = __builtin_amdgcn_exp2f(S[i] + tb[i]);
        } else {
#pragma unroll
            for (int i = 0; i < 4; ++i) pv[12 + i] = __builtin_amdgcn_exp2f(S[12 + i] + tb[i]);
        }
    }
#pragma unroll
    for (int i = 0; i < 16; ++i) lsum += pv[i];
    const s16x8 P0 = pack8(pv[0], pv[1], pv[2], pv[3], pv[4], pv[5], pv[6], pv[7]), P1 = pack8(pv[8], pv[9], pv[10], pv[11], pv[12], pv[13], pv[14], pv[15]);
    if (mode != 3) { const s16x8 V00 = tr_pair(vb, 8 * AV_STR), V01 = tr_pair(vb + 64, 8 * AV_STR);
      O0 = MFMA32(V00, P0, O0); O1 = MFMA32(V01, P0, O1); }
    if (mode != 2) { const s16x8 V10 = tr_pair(vb + 16 * AV_STR, 8 * AV_STR), V11 = tr_pair(vb + 16 * AV_STR + 64, 8 * AV_STR);
      O0 = MFMA32(V10, P1, O0); O1 = MFMA32(V11, P1, O1); }
}
__device__ __forceinline__ void attn_load_k(s16x8 (&Kf)[4], const bf16_t* kfb, int klat0, int kctx0, int kt, int ntl, int rs) {
    const int tile = kt < ntl ? klat0 + (rs + (kt >> 1)) * 2 + (kt & 1) : kctx0 + (kt - ntl);
#pragma unroll
    for (int ks = 0; ks < 4; ++ks) Kf[ks] = *(const s16x8*)(kfb + (size_t)tile * 32768 + ks * 512);
}
struct AUnit { int b, h, qrow0, r, rs, ntl, ntiles; };
__device__ __forceinline__ AUnit attn_decode(int u, int nlatu) {
    AUnit a;
    if (u < nlatu) { a.h = u & 15; const int br = u >> 4; a.r = br & 63; a.b = br >> 6; a.qrow0 = a.b * 4096 + a.r * 64; a.rs = min(max(a.r - 4, 0), 56); a.ntl = 16; a.ntiles = 24; }
    else { const int v = u - nlatu; a.h = v & 15; const int bq = v >> 4; a.b = bq >> 2; a.qrow0 = NLAT + a.b * 256 + (bq & 3) * 64; a.r = 0; a.rs = 0; a.ntl = 0; a.ntiles = 8; }
    return a;
}
__device__ __forceinline__ u32x4 attn_load_v1(const bf16_t* vbase, const AUnit& a, int idx) {
    const int key = idx >> 3, ch = idx & 7, kt = key >> 5, kk = key & 31;
    const int grow = kt < a.ntl ? (a.b * 4096 + (a.rs + (kt >> 1)) * 64 + 32 * (kt & 1) + kk) : (NLAT + a.b * 256 + 32 * (kt - a.ntl) + kk);
    return *(const u32x4*)(vbase + (size_t)grow * 1024 + ch * 8);
}
__device__ __forceinline__ void attn_load_v(u32x4 (&vpre)[12], const bf16_t* qkv, const AUnit& a, int tid) {
    const bf16_t* vbase = qkv + (size_t)2 * MTOT * 1024 + a.h * 64;
#pragma unroll
    for (int i = 0; i < 4; ++i) vpre[i] = attn_load_v1(vbase, a, tid + NTHREADS * i);
    if (a.ntiles == 24) {
#pragma unroll
        for (int i = 4; i < 12; ++i) vpre[i] = attn_load_v1(vbase, a, tid + NTHREADS * i);
    }
}

__device__ __forceinline__ void phase_attn_mfma(const Params& p, int a_, bool ctx_q, LAS unsigned char* lds, const Tix T_, const int dummy = 0) {
    const bf16_t* qkv = (const bf16_t*)(p.ws + OFF_BIG); bf16_t* ao = (bf16_t*)(p.ws + OFF_BIG) + (size_t)MTOT * 3072;
    const bf16_t* kf = qkv + (size_t)MTOT * 1024;
    const float* rpb = p.na_rpb + (size_t)a_ * 16 * 15 * 31;
    const int tid = T_.tid, lane = tid & 63, wave = __builtin_amdgcn_readfirstlane(tid >> 6), qt = wave & 1, kq = wave >> 1, l31 = lane & 31, hi = lane >> 5;
    LAS unsigned char* Vl = lds;
    LAS float* Ored = (LAS float*)lds;
    LAS float* lred = (LAS float*)(lds + 69632);
    LAS float* tab_all = (LAS float*)(lds + 110592);
    LAS float* misc = (LAS float*)(lds + 110592 + 30720);
    constexpr float LOG2E = 1.4426950408889634f;
    float mb;
    { float m = 0.f; for (int i = tid; i < 7440; i += NTHREADS) m = fmaxf(m, rpb[i]);
      float qg = 0.f, kg = 0.f; if (tid < 64) { qg = fabsf(p.na_q_norm[a_ * 64 + tid]); kg = fabsf(p.na_k_norm[a_ * 64 + tid]); }
      m = wave_max(m); qg = wave_max(qg); kg = wave_max(kg);
      if (lane == 0) { misc[wave] = m; if (wave == 0) { misc[8] = qg; misc[9] = kg; } }
      __syncthreads();
      float rm = misc[0];
#pragma unroll
      for (int w = 1; w < 8; ++w) rm = fmaxf(rm, misc[w]);
      mb = 8.0f * misc[8] * misc[9] + rm; }
    const float mbl = mb * LOG2E;
    for (int i = tid; i < 16 * 480; i += NTHREADS) { const int hh = i / 480, rem = i % 480, rr = rem >> 5, dd = rem & 31; tab_all[i] = dd < 31 ? (rpb[hh * 465 + rr * 31 + dd] - mb) * LOG2E : -1e30f; }
    const int nlatu = 8 * 64 * 16, total = nlatu + (ctx_q ? 8 * 4 * 16 : 0);
    const int tr_q = (lane & 15) >> 2, tr_p = lane & 3, dgrp = (lane >> 4) & 1;
    const int qcol = 32 * qt + l31, wst = min(max(qcol - 8, 0), 48);
    unsigned offo[4], offx = 0u;
#pragma unroll
    for (int j = 0; j < 4; ++j) { offo[j] = 0u;
#pragma unroll
        for (int i = 0; i < 4; ++i) { const int kcol = 32 * qt + 8 * j + 4 * hi + i; offo[j] |= (unsigned)(((unsigned)(kcol - wst) < 16u ? kcol - qcol + 15 : 31) * 4) << (8 * i); } }
#pragma unroll
    for (int i = 0; i < 4; ++i) { const int kcol = (qt == 0 ? 32 : 24) + 4 * hi + i; offx |= (unsigned)(((unsigned)(kcol - wst) < 16u ? kcol - qcol + 15 : 31) * 4) << (8 * i); }
    int u = T_.bid;
    AUnit cur = attn_decode(min(u, total - 1), nlatu);
    u32x4 vpre[12];
    s16x8 Qf[4], KA[4], KB[4];
    if (u < total) {
        attn_load_v(vpre, qkv, cur, tid);
        const bf16_t* qp = qkv + (size_t)(((cur.qrow0 >> 5) + qt) * 16 + cur.h) * 2048 + lane * 8;
#pragma unroll
        for (int ks = 0; ks < 4; ++ks) Qf[ks] = *(const s16x8*)(qp + 512 * ks);
        const int t0 = kq * (cur.ntiles >> 2);
        attn_load_k(KA, kf + cur.h * 2048 + lane * 8, cur.b * 128, 1024 + cur.b * 8, t0, cur.ntl, cur.rs);
        attn_load_k(KB, kf + cur.h * 2048 + lane * 8, cur.b * 128, 1024 + cur.b * 8, t0 + 1, cur.ntl, cur.rs);
    }
    while (u < total) {
        const int b = cur.b, h = cur.h, qrow0 = cur.qrow0, r = cur.r, rs = cur.rs, ntl = cur.ntl, ntiles = cur.ntiles;
        int tidl = tid; asm volatile("" : "+v"(tidl));
#pragma unroll
        for (int i = 0; i < 4; ++i) { const int idx = tidl + NTHREADS * i; *(LAS u32x4*)(Vl + (idx >> 3) * AV_STR + (idx & 7) * 16) = vpre[i]; }
        if (ntiles == 24) {
#pragma unroll
            for (int i = 4; i < 12; ++i) { const int idx = tidl + NTHREADS * i; *(LAS u32x4*)(Vl + (idx >> 3) * AV_STR + (idx & 7) * 16) = vpre[i]; } }
        const LAS float* tab = tab_all + h * 480;
        const bf16_t* kbase = kf + h * 2048 + lane * 8;
        const int klat0 = b * 128, kctx0 = 1024 + b * 8;
        const int ntw = ntiles >> 2, t0 = kq * ntw;
        __syncthreads();
        f32x16 O0, O1;
#pragma unroll
        for (int i = 0; i < 16; ++i) { O0[i] = 0.f; O1[i] = 0.f; }
        float lsum = 0.f;
#pragma unroll 1
        for (int t = 0; t < (dummy ? 0 : ntw); t += 2) {
            { const int kt = t0 + t; const int mode = kt >= ntl ? 0 : ((kt & 1) == qt ? 1 : 2 + qt);
              attn_one_tile(KA, Qf, Vl + (kt * 32 + 4 * hi + tr_q) * AV_STR + (16 * dgrp + 4 * tr_p) * 2, (const LAS unsigned char*)tab + (rs + (kt >> 1) - r + 7) * 128, offo, offx, O0, O1, lsum, mode, mbl); }
            __builtin_amdgcn_sched_barrier(0);
            attn_load_k(KA, kbase, klat0, kctx0, t0 + min(t + 2, ntw - 2), ntl, rs);
            { const int kt = t0 + t + 1; const int mode = kt >= ntl ? 0 : ((kt & 1) == qt ? 1 : 2 + qt);
              attn_one_tile(KB, Qf, Vl + (kt * 32 + 4 * hi + tr_q) * AV_STR + (16 * dgrp + 4 * tr_p) * 2, (const LAS unsigned char*)tab + (rs + (kt >> 1) - r + 7) * 128, offo, offx, O0, O1, lsum, mode, mbl); }
            __builtin_amdgcn_sched_barrier(0);
            attn_load_k(KB, kbase, klat0, kctx0, t0 + min(t + 2, ntw - 2) + 1, ntl, rs);
        }
        const int un = u + T_.gsz;
        const AUnit nxt = attn_decode(min(un, total - 1), nlatu);
        int tidm = tid; asm volatile("" : "+v"(tidm));
        if (un < total) attn_load_v(vpre, qkv, nxt, tidm);
        __syncthreads();
#pragma unroll
        for (int j = 0; j < 4; ++j) {
            *(LAS f32x4*)(Ored + (size_t)((kq * 64 + 32 * qt + l31) * 68 + 8 * j + 4 * hi)) = (f32x4){O0[4 * j], O0[4 * j + 1], O0[4 * j + 2], O0[4 * j + 3]};
            *(LAS f32x4*)(Ored + (size_t)((kq * 64 + 32 * qt + l31) * 68 + 32 + 8 * j + 4 * hi)) = (f32x4){O1[4 * j], O1[4 * j + 1], O1[4 * j + 2], O1[4 * j + 3]}; }
        lred[(kq * 2 + hi) * 64 + 32 * qt + l31] = lsum;
        if (un < total) {
            const bf16_t* qp = qkv + (size_t)(((nxt.qrow0 >> 5) + qt) * 16 + nxt.h) * 2048 + lane * 8;
#pragma unroll
            for (int ks = 0; ks < 4; ++ks) Qf[ks] = *(const s16x8*)(qp + 512 * ks);
            const int t0n = kq * (nxt.ntiles >> 2);
            attn_load_k(KA, kf + nxt.h * 2048 + lane * 8, nxt.b * 128, 1024 + nxt.b * 8, t0n, nxt.ntl, nxt.rs);
            attn_load_k(KB, kf + nxt.h * 2048 + lane * 8, nxt.b * 128, 1024 + nxt.b * 8, t0n + 1, nxt.ntl, nxt.rs);
        }
        __syncthreads();
        { const int q = tid >> 3, d8 = (tid & 7) * 8;
          f32x4 s0 = (f32x4){0.f, 0.f, 0.f, 0.f}, s1 = s0; float l = 0.f;
#pragma unroll
          for (int k = 0; k < 4; ++k) { s0 += *(const LAS f32x4*)(Ored + (k * 64 + q) * 68 + d8); s1 += *(const LAS f32x4*)(Ored + (k * 64 + q) * 68 + d8 + 4); l += lred[(k * 2) * 64 + q] + lred[(k * 2 + 1) * 64 + q]; }
          const float inv = 1.0f / l;
          u32x4 o; o.x = pkb(s0.x * inv, s0.y * inv); o.y = pkb(s0.z * inv, s0.w * inv); o.z = pkb(s1.x * inv, s1.y * inv); o.w = pkb(s1.z * inv, s1.w * inv);
          *(u32x4*)(ao + (size_t)(qrow0 + q) * 1024 + h * 64 + d8) = o; }
        __syncthreads();
        u = un; cur = nxt;
    }
}


struct AUnit2 { int b, h, qrow0, r0, rsu, ntl, ntiles; };
__device__ __forceinline__ AUnit2 attn2_decode(int u, int nlatu) {
    AUnit2 a;
    if (u < nlatu) { a.h = u & 15; const int brp = u >> 4; a.r0 = 2 * (brp & 31); a.b = brp >> 5; a.qrow0 = a.b * 4096 + a.r0 * 64; a.rsu = min(max(a.r0 - 4, 0), 56); a.ntl = 18; a.ntiles = 26; }
    else { const int v = u - nlatu; a.h = v & 15; const int bq = v >> 4; a.b = bq >> 1; a.qrow0 = NLAT + a.b * 256 + (bq & 1) * 128; a.r0 = 0; a.rsu = 0; a.ntl = 0; a.ntiles = 8; }
    return a;
}
__device__ __forceinline__ u32x4 attn2_load_v1(const bf16_t* vbase, const AUnit2& a, int idx) {
    const int key = idx >> 3, ch = idx & 7, kt = key >> 5, kk = key & 31;
    const int grow = kt < a.ntl ? (a.b * 4096 + min(a.rsu + (kt >> 1), 63) * 64 + 32 * (kt & 1) + kk) : (NLAT + a.b * 256 + 32 * (kt - a.ntl) + kk);
    return *(const u32x4*)(vbase + (size_t)grow * 1024 + ch * 8);
}
__device__ __forceinline__ void attn2_load_v(u32x4 (&vpre)[13], const bf16_t* qkv, const AUnit2& a, int tid) {
    const bf16_t* vbase = qkv + (size_t)2 * MTOT * 1024 + a.h * 64;
#pragma unroll
    for (int i = 0; i < 4; ++i) vpre[i] = attn2_load_v1(vbase, a, tid + NTHREADS * i);
    if (a.ntiles == 26) {
#pragma unroll
        for (int i = 4; i < 13; ++i) vpre[i] = attn2_load_v1(vbase, a, tid + NTHREADS * i);
    }
}
__device__ __forceinline__ void attn2_load_k(s16x8 (&Kf)[4], const bf16_t* kfb, int klat0, int kctx0, int kt, int ntl, int rsu) {
    const int tile = kt < ntl ? klat0 + min(rsu + (kt >> 1), 63) * 2 + (kt & 1) : kctx0 + (kt - ntl);
#pragma unroll
    for (int ks = 0; ks < 4; ++ks) Kf[ks] = *(const s16x8*)(kfb + (size_t)tile * 32768 + ks * 512);
}
__device__ __forceinline__ void phase_attn2(const Params& p, int a_, bool ctx_q, LAS unsigned char* lds, const Tix T_) {
    const bf16_t* qkv = (const bf16_t*)(p.ws + OFF_BIG); bf16_t* ao = (bf16_t*)(p.ws + OFF_BIG) + (size_t)MTOT * 3072;
    const bf16_t* kf = qkv + (size_t)MTOT * 1024;
    const float* rpb = p.na_rpb + (size_t)a_ * 16 * 15 * 31;
    const int tid = T_.tid, lane = tid & 63, wave = __builtin_amdgcn_readfirstlane(tid >> 6), qtile = wave & 3, qt = qtile & 1, qrow = qtile >> 1, kh = wave >> 2, l31 = lane & 31, hi = lane >> 5;
    LAS unsigned char* Vl = lds;
    LAS float* Ored = (LAS float*)lds;
    LAS float* lred = (LAS float*)(lds + 69632);
    LAS float* tab_all = (LAS float*)(lds + 119808);
    LAS float* misc = (LAS float*)(lds + 119808 + 30720);
    constexpr float LOG2E = 1.4426950408889634f;
    float mb;
    { float m = 0.f; for (int i = tid; i < 7440; i += NTHREADS) m = fmaxf(m, rpb[i]);
      float qg = 0.f, kg = 0.f; if (tid < 64) { qg = fabsf(p.na_q_norm[a_ * 64 + tid]); kg = fabsf(p.na_k_norm[a_ * 64 + tid]); }
      m = wave_max(m); qg = wave_max(qg); kg = wave_max(kg);
      if (lane == 0) { misc[wave] = m; if (wave == 0) { misc[8] = qg; misc[9] = kg; } }
      __syncthreads();
      float rm = misc[0];
#pragma unroll
      for (int w = 1; w < 8; ++w) rm = fmaxf(rm, misc[w]);
      mb = 8.0f * misc[8] * misc[9] + rm; }
    const float mbl = mb * LOG2E;
    for (int i = tid; i < 16 * 480; i += NTHREADS) { const int hh = i / 480, rem = i % 480, rr = rem >> 5, dd = rem & 31; tab_all[i] = dd < 31 ? (rpb[hh * 465 + rr * 31 + dd] - mb) * LOG2E : -1e30f; }
    const int nlatu = 8 * 32 * 16, total = nlatu + (ctx_q ? 8 * 2 * 16 : 0);
    const int tr_q = (lane & 15) >> 2, tr_p = lane & 3, dgrp = (lane >> 4) & 1;
    const int qcol = 32 * qt + l31, wst = min(max(qcol - 8, 0), 48);
    unsigned offo[4], offx = 0u;
#pragma unroll
    for (int j = 0; j < 4; ++j) { offo[j] = 0u;
#pragma unroll
        for (int i = 0; i < 4; ++i) { const int kcol = 32 * qt + 8 * j + 4 * hi + i; offo[j] |= (unsigned)(((unsigned)(kcol - wst) < 16u ? kcol - qcol + 15 : 31) * 4) << (8 * i); } }
#pragma unroll
    for (int i = 0; i < 4; ++i) { const int kcol = (qt == 0 ? 32 : 24) + 4 * hi + i; offx |= (unsigned)(((unsigned)(kcol - wst) < 16u ? kcol - qcol + 15 : 31) * 4) << (8 * i); }
    int u = T_.bid;
    AUnit2 cur = attn2_decode(min(u, total - 1), nlatu);
    u32x4 vpre[13];
    s16x8 Qf[4], KA[4], KB[4];
    if (u < total) {
        attn2_load_v(vpre, qkv, cur, tid);
        const bf16_t* qp = qkv + (size_t)(((cur.qrow0 >> 5) + qtile) * 16 + cur.h) * 2048 + lane * 8;
#pragma unroll
        for (int ks = 0; ks < 4; ++ks) Qf[ks] = *(const s16x8*)(qp + 512 * ks);
        const int t0 = kh * (cur.ntiles >> 1);
        attn2_load_k(KA, kf + cur.h * 2048 + lane * 8, cur.b * 128, 1024 + cur.b * 8, t0, cur.ntl, cur.rsu);
        attn2_load_k(KB, kf + cur.h * 2048 + lane * 8, cur.b * 128, 1024 + cur.b * 8, t0 + 1, cur.ntl, cur.rsu);
    }
    while (u < total) {
        const int b = cur.b, h = cur.h, qrow0 = cur.qrow0, rsu = cur.rsu, ntl = cur.ntl, ntiles = cur.ntiles;
        const int rr = cur.r0 + qrow, rsq = min(max(rr - 4, 0), 56);
        int tidl = tid; asm volatile("" : "+v"(tidl));
#pragma unroll
        for (int i = 0; i < 4; ++i) { const int idx = tidl + NTHREADS * i; *(LAS u32x4*)(Vl + (idx >> 3) * AV_STR + (idx & 7) * 16) = vpre[i]; }
        if (ntiles == 26) {
#pragma unroll
            for (int i = 4; i < 13; ++i) { const int idx = tidl + NTHREADS * i; *(LAS u32x4*)(Vl + (idx >> 3) * AV_STR + (idx & 7) * 16) = vpre[i]; } }
        const LAS float* tab = tab_all + h * 480;
        const bf16_t* kbase = kf + h * 2048 + lane * 8;
        const int klat0 = b * 128, kctx0 = 1024 + b * 8;
        const int ntw = ntiles >> 1, t0 = kh * ntw;
        __syncthreads();
        f32x16 O0, O1;
#pragma unroll
        for (int i = 0; i < 16; ++i) { O0[i] = 0.f; O1[i] = 0.f; }
        float lsum = 0.f;
#pragma unroll 1
        for (int t = 0; t < ntw; t += 2) {
            { const int kt = t0 + t; const int krow = rsu + (kt >> 1);
              const int mode = kt >= ntl ? 0 : ((unsigned)(krow - rsq) >= 8u ? 4 : ((kt & 1) == qt ? 1 : 2 + qt));
              attn_one_tile(KA, Qf, Vl + (kt * 32 + 4 * hi + tr_q) * AV_STR + (16 * dgrp + 4 * tr_p) * 2, (const LAS unsigned char*)tab + (krow - rr + 7) * 128, offo, offx, O0, O1, lsum, mode, mbl); }
            __builtin_amdgcn_sched_barrier(0);
            attn2_load_k(KA, kbase, klat0, kctx0, min(t0 + t + 2, ntiles - 1), ntl, rsu);
            { const int kt = t0 + t + 1; const int krow = rsu + (kt >> 1);
              const int mode = (t + 1 >= ntw) ? 4 : (kt >= ntl ? 0 : ((unsigned)(krow - rsq) >= 8u ? 4 : ((kt & 1) == qt ? 1 : 2 + qt)));
              attn_one_tile(KB, Qf, Vl + (min(kt, ntiles - 1) * 32 + 4 * hi + tr_q) * AV_STR + (16 * dgrp + 4 * tr_p) * 2, (const LAS unsigned char*)tab + (min(max(krow - rr + 7, 0), 14)) * 128, offo, offx, O0, O1, lsum, mode, mbl); }
            __builtin_amdgcn_sched_barrier(0);
            attn2_load_k(KB, kbase, klat0, kctx0, min(t0 + t + 3, ntiles - 1), ntl, rsu);
        }
        const int un = u + T_.gsz;
        const AUnit2 nxt = attn2_decode(min(un, total - 1), nlatu);
        int tidm = tid; asm volatile("" : "+v"(tidm));
        if (un < total) attn2_load_v(vpre, qkv, nxt, tidm);
        __syncthreads();
#pragma unroll
        for (int j = 0; j < 4; ++j) {
            *(LAS f32x4*)(Ored + (size_t)((kh * 128 + 32 * qtile + l31) * 68 + 8 * j + 4 * hi)) = (f32x4){O0[4 * j], O0[4 * j + 1], O0[4 * j + 2], O0[4 * j + 3]};
            *(LAS f32x4*)(Ored + (size_t)((kh * 128 + 32 * qtile + l31) * 68 + 32 + 8 * j + 4 * hi)) = (f32x4){O1[4 * j], O1[4 * j + 1], O1[4 * j + 2], O1[4 * j + 3]}; }
        lred[(kh * 2 + hi) * 128 + 32 * qtile + l31] = lsum;
        if (un < total) {
            const bf16_t* qp = qkv + (size_t)(((nxt.qrow0 >> 5) + qtile) * 16 + nxt.h) * 2048 + lane * 8;
#pragma unroll
            for (int ks = 0; ks < 4; ++ks) Qf[ks] = *(const s16x8*)(qp + 512 * ks);
            const int t0n = kh * (nxt.ntiles >> 1);
            attn2_load_k(KA, kf + nxt.h * 2048 + lane * 8, nxt.b * 128, 1024 + nxt.b * 8, t0n, nxt.ntl, nxt.rsu);
            attn2_load_k(KB, kf + nxt.h * 2048 + lane * 8, nxt.b * 128, 1024 + nxt.b * 8, t0n + 1, nxt.ntl, nxt.rsu);
        }
        __syncthreads();
        { const int q = tid >> 2, d16 = (tid & 3) * 16;
          f32x4 s[4]; float l = 0.f;
#pragma unroll
          for (int i = 0; i < 4; ++i) s[i] = *(const LAS f32x4*)(Ored + q * 68 + d16 + 4 * i) + *(const LAS f32x4*)(Ored + (128 + q) * 68 + d16 + 4 * i);
          l = (lred[q] + lred[128 + q]) + (lred[256 + q] + lred[384 + q]);
          const float inv = 1.0f / l;
          u32x4 o0, o1; o0.x = pkb(s[0].x * inv, s[0].y * inv); o0.y = pkb(s[0].z * inv, s[0].w * inv); o0.z = pkb(s[1].x * inv, s[1].y * inv); o0.w = pkb(s[1].z * inv, s[1].w * inv);
          o1.x = pkb(s[2].x * inv, s[2].y * inv); o1.y = pkb(s[2].z * inv, s[2].w * inv); o1.z = pkb(s[3].x * inv, s[3].y * inv); o1.w = pkb(s[3].z * inv, s[3].w * inv);
          bf16_t* op = ao + (size_t)(qrow0 + q) * 1024 + h * 64 + d16; *(u32x4*)op = o0; *(u32x4*)(op + 8) = o1; }
        __syncthreads();
        u = un; cur = nxt;
    }
}


struct AUnit4 { int b, h, qrow0, r0, rsu, ntl; };
__device__ __forceinline__ AUnit4 attn4_decode(int u, int nlatu) {
    AUnit4 a;
    if (u < nlatu) { a.h = u & 15; const int brq = u >> 4; a.r0 = 4 * (brq & 15); a.b = brq >> 4; a.qrow0 = a.b * 4096 + a.r0 * 64; a.rsu = min(max(a.r0 - 4, 0), 56); a.ntl = 22; }
    else { const int v = u - nlatu; a.h = v & 15; a.b = v >> 4; a.qrow0 = NLAT + a.b * 256; a.r0 = 0; a.rsu = 0; a.ntl = 0; }
    return a;
}
__device__ __forceinline__ u32x4 attn4_load_v1(const bf16_t* vbase, const AUnit4& a, int idx) {
    const int key = idx >> 3, ch = idx & 7, kt = key >> 5, kk = key & 31;
    const int grow = kt < a.ntl ? (a.b * 4096 + min(a.rsu + (kt >> 1), 63) * 64 + 32 * (kt & 1) + kk) : (NLAT + a.b * 256 + 32 * (kt - a.ntl) + kk);
    return *(const u32x4*)(vbase + (size_t)grow * 1024 + ch * 8);
}
__device__ __forceinline__ void attn4_load_v(u32x4 (&vpre)[15], const bf16_t* qkv, const AUnit4& a, int tid) {
    const bf16_t* vbase = qkv + (size_t)2 * MTOT * 1024 + a.h * 64;
#pragma unroll
    for (int i = 0; i < 4; ++i) vpre[i] = attn4_load_v1(vbase, a, tid + NTHREADS * i);
    if (a.ntl) {
#pragma unroll
        for (int i = 4; i < 15; ++i) vpre[i] = attn4_load_v1(vbase, a, tid + NTHREADS * i);
    }
}
__device__ __forceinline__ int attn4_kt(int s, int nls, int koff, int c0) { return s < nls ? koff + s : c0 + (s - nls); }
__device__ __forceinline__ void attn4_load_k(s16x8 (&Kf)[4], const bf16_t* kfb, int klat0, int kctx0, int kt, int ntl, int rsu) {
    const int tile = kt < ntl ? klat0 + min(rsu + (kt >> 1), 63) * 2 + (kt & 1) : kctx0 + (kt - ntl);
#pragma unroll
    for (int ks = 0; ks < 4; ++ks) Kf[ks] = *(const s16x8*)(kfb + (size_t)tile * 32768 + ks * 512);
}
__device__ __forceinline__ void phase_attn4(const Params& p, int a_, bool ctx_q, LAS unsigned char* lds, const Tix T_) {
    const bf16_t* qkv = (const bf16_t*)(p.ws + OFF_BIG); bf16_t* ao = (bf16_t*)(p.ws + OFF_BIG) + (size_t)MTOT * 3072;
    const bf16_t* kf = qkv + (size_t)MTOT * 1024;
    const float* rpb = p.na_rpb + (size_t)a_ * 16 * 15 * 31;
    const int tid = T_.tid, lane = tid & 63, wave = __builtin_amdgcn_readfirstlane(tid >> 6), qtile = wave, qt = qtile & 1, qrow = qtile >> 1, l31 = lane & 31, hi = lane >> 5;
    LAS unsigned char* Vl = lds;
    LAS float* tab = (LAS float*)(lds + 138240);
    LAS float* misc = (LAS float*)(lds + 138240 + 2048);
    constexpr float LOG2E = 1.4426950408889634f;
    float mb;
    { float m = 0.f; for (int i = tid; i < 7440; i += NTHREADS) m = fmaxf(m, rpb[i]);
      float qg = 0.f, kg = 0.f; if (tid < 64) { qg = fabsf(p.na_q_norm[a_ * 64 + tid]); kg = fabsf(p.na_k_norm[a_ * 64 + tid]); }
      m = wave_max(m); qg = wave_max(qg); kg = wave_max(kg);
      if (lane == 0) { misc[wave] = m; if (wave == 0) { misc[8] = qg; misc[9] = kg; } }
      __syncthreads();
      float rm = misc[0];
#pragma unroll
      for (int w = 1; w < 8; ++w) rm = fmaxf(rm, misc[w]);
      mb = 8.0f * misc[8] * misc[9] + rm; }
    const float mbl = mb * LOG2E;
    const int nlatu = 8 * 16 * 16, total = nlatu + (ctx_q ? 8 * 16 : 0);
    const int tr_q = (lane & 15) >> 2, tr_p = lane & 3, dgrp = (lane >> 4) & 1;
    const int qcol = 32 * qt + l31, wst = min(max(qcol - 8, 0), 48);
    unsigned offo[4], offx = 0u;
#pragma unroll
    for (int j = 0; j < 4; ++j) { offo[j] = 0u;
#pragma unroll
        for (int i = 0; i < 4; ++i) { const int kcol = 32 * qt + 8 * j + 4 * hi + i; offo[j] |= (unsigned)(((unsigned)(kcol - wst) < 16u ? kcol - qcol + 15 : 31) * 4) << (8 * i); } }
#pragma unroll
    for (int i = 0; i < 4; ++i) { const int kcol = (qt == 0 ? 32 : 24) + 4 * hi + i; offx |= (unsigned)(((unsigned)(kcol - wst) < 16u ? kcol - qcol + 15 : 31) * 4) << (8 * i); }
    const int trr = tid >> 5, tdd = tid & 31;
    int u = T_.bid;
    AUnit4 cur = attn4_decode(min(u, total - 1), nlatu);
    u32x4 vpre[15]; float tabpre = 0.f;
    if (u < total) { attn4_load_v(vpre, qkv, cur, tid); if (tid < 480 && tdd < 31) tabpre = rpb[cur.h * 465 + trr * 31 + tdd]; }
    while (u < total) {
        const int b = cur.b, h = cur.h, qrow0 = cur.qrow0, rsu = cur.rsu, ntl = cur.ntl;
        const int rr = cur.r0 + qrow, rsq = min(max(rr - 4, 0), 56);
        const int nls = ntl ? 16 : 0, nseq = nls + 8, koff = 2 * (rsq - rsu), c0 = ntl;
        const bf16_t* kbase = kf + h * 2048 + lane * 8;
        const int klat0 = b * 128, kctx0 = 1024 + b * 8;
        s16x8 Qf[4], KA[4], KB[4];
        { const bf16_t* qp = qkv + (size_t)(((qrow0 >> 5) + qtile) * 16 + h) * 2048 + lane * 8;
#pragma unroll
          for (int ks = 0; ks < 4; ++ks) Qf[ks] = *(const s16x8*)(qp + 512 * ks); }
        attn4_load_k(KA, kbase, klat0, kctx0, attn4_kt(0, nls, koff, c0), ntl, rsu);
        attn4_load_k(KB, kbase, klat0, kctx0, attn4_kt(1, nls, koff, c0), ntl, rsu);
        int tidl = tid; asm volatile("" : "+v"(tidl));
#pragma unroll
        for (int i = 0; i < 4; ++i) { const int idx = tidl + NTHREADS * i; *(LAS u32x4*)(Vl + (idx >> 3) * AV_STR + (idx & 7) * 16) = vpre[i]; }
        if (ntl) {
#pragma unroll
            for (int i = 4; i < 15; ++i) { const int idx = tidl + NTHREADS * i; *(LAS u32x4*)(Vl + (idx >> 3) * AV_STR + (idx & 7) * 16) = vpre[i]; } }
        if (tid < 480) tab[tid] = tdd < 31 ? (tabpre - mb) * LOG2E : -1e30f;
        __syncthreads();
        f32x16 O0, O1;
#pragma unroll
        for (int i = 0; i < 16; ++i) { O0[i] = 0.f; O1[i] = 0.f; }
        float lsum = 0.f;
#pragma unroll 1
        for (int t = 0; t < nseq; t += 2) {
            { const int kt = attn4_kt(t, nls, koff, c0); const int krow = rsu + (kt >> 1);
              const int mode = t >= nls ? 0 : ((kt & 1) == qt ? 1 : 2 + qt);
              attn_one_tile(KA, Qf, Vl + (kt * 32 + 4 * hi + tr_q) * AV_STR + (16 * dgrp + 4 * tr_p) * 2, (const LAS unsigned char*)tab + (min(max(krow - rr + 7, 0), 14)) * 128, offo, offx, O0, O1, lsum, mode, mbl); }
            __builtin_amdgcn_sched_barrier(0);
            attn4_load_k(KA, kbase, klat0, kctx0, attn4_kt(min(t + 2, nseq - 2), nls, koff, c0), ntl, rsu);
            { const int kt = attn4_kt(t + 1, nls, koff, c0); const int krow = rsu + (kt >> 1);
              const int mode = t + 1 >= nls ? 0 : ((kt & 1) == qt ? 1 : 2 + qt);
              attn_one_tile(KB, Qf, Vl + (kt * 32 + 4 * hi + tr_q) * AV_STR + (16 * dgrp + 4 * tr_p) * 2, (const LAS unsigned char*)tab + (min(max(krow - rr + 7, 0), 14)) * 128, offo, offx, O0, O1, lsum, mode, mbl); }
            __builtin_amdgcn_sched_barrier(0);
            attn4_load_k(KB, kbase, klat0, kctx0, attn4_kt(min(t + 2, nseq - 2) + 1, nls, koff, c0), ntl, rsu);
        }
        const int un = u + T_.gsz;
        const AUnit4 nxt = attn4_decode(min(un, total - 1), nlatu);
        int tidm = tid; asm volatile("" : "+v"(tidm));
        if (un < total) { attn4_load_v(vpre, qkv, nxt, tidm); if (tid < 480 && tdd < 31) tabpre = rpb[nxt.h * 465 + trr * 31 + tdd]; }
        lsum += __shfl_xor(lsum, 32);
        { const float inv = 1.0f / lsum;
          bf16_t* op = ao + (size_t)(qrow0 + 32 * qtile + l31) * 1024 + h * 64 + 4 * hi;
#pragma unroll
          for (int j = 0; j < 4; ++j) { u32x2 w0, w1; w0.x = pkb(O0[4 * j] * inv, O0[4 * j + 1] * inv); w0.y = pkb(O0[4 * j + 2] * inv, O0[4 * j + 3] * inv);
              w1.x = pkb(O1[4 * j] * inv, O1[4 * j + 1] * inv); w1.y = pkb(O1[4 * j + 2] * inv, O1[4 * j + 3] * inv);
              *(u32x2*)(op + 8 * j) = w0; *(u32x2*)(op + 32 + 8 * j) = w1; } }
        __syncthreads();
        u = un; cur = nxt;
    }
}

constexpr int SP_RS = 320;
__device__ __forceinline__ void phase_spatial_mfma(const Params& p, int sl, int M, LAS unsigned char* lds, const Tix T_, const bool dummy = false) {
    bf16_t* vb = (bf16_t*)(p.ws + OFF_BIG); const float* lnacc = (const float*)(p.ws + OFF_LNACC) + (size_t)sl * MTOT * 2;
    const float* lng = p.sg_ln_g + sl * 3072; const float* lnb = p.sg_ln_b + sl * 3072;
    const int tid = T_.tid, lane = tid & 63, wave = __builtin_amdgcn_readfirstlane(tid >> 6), pt = wave & 3, cth = wave >> 2, l31 = lane & 31, hi = lane >> 5;
    const int tr_q = (lane & 15) >> 2, tr_p = lane & 3, dgrp = (lane >> 4) & 1;
    const int nunits = (M / 128) * 24;
    const int c8 = (tid & 15) * 8;
    s16x8 wx[8]; u32x4 vw[4]; f32x2 st2[4]; f32x4 g0, g1, b0, b1; float bs;
    const bf16_t* wsf = (const bf16_t*)(p.ws + OFF_WSF);
    const int NC = M / 128; int gload = -1;
#define SP_LOAD(uu) do { const int g_ = (uu) / NC, nc_ = (uu) % NC, r0_ = nc_ * 128; \
        if (g_ != gload) { gload = g_; \
            const bf16_t* wp_ = wsf + ((size_t)((sl * 24 + g_) * 4 + pt) * 8) * 512 + lane * 8; \
            _Pragma("unroll") for (int ks = 0; ks < 8; ++ks) wx[ks] = *(const s16x8*)(wp_ + ks * 512); \
            g0 = *(const f32x4*)(lng + g_ * 128 + c8); g1 = *(const f32x4*)(lng + g_ * 128 + c8 + 4); b0 = *(const f32x4*)(lnb + g_ * 128 + c8); b1 = *(const f32x4*)(lnb + g_ * 128 + c8 + 4); \
            bs = p.sg_b_s[((size_t)sl * 24 + g_) * 128 + 32 * pt + l31]; } \
        _Pragma("unroll") for (int i = 0; i < 4; ++i) { const int q_ = (tid + NTHREADS * i) >> 4; \
            vw[i] = *(const u32x4*)(vb + (size_t)(r0_ + q_) * 3072 + g_ * 128 + c8); st2[i] = *(const f32x2*)(lnacc + 2 * (r0_ + q_)); } } while (0)
    int u = (int)(((long)T_.bid * nunits) / T_.gsz), buf = 0; const int uend = (int)(((long)(T_.bid + 1) * nunits) / T_.gsz);
    if (u < uend) SP_LOAD(u);
    while (u < uend) {
        const int g = u / NC, nc = u % NC, r0 = nc * 128;
        LAS unsigned char* tile = lds + buf * (128 * SP_RS);
#pragma unroll
        for (int i = 0; i < 4; ++i) { const int q = (tid + NTHREADS * i) >> 4; const u32x4 w = vw[i];
            const float mean = st2[i].x * (1.0f / 3072.0f), rstd = __builtin_amdgcn_rsqf(fmaxf(st2[i].y * (1.0f / 3072.0f) - mean * mean, 0.f) + 1e-6f);
            u32x4 o;
            o.x = pkb((bf2f(w.x & 0xffffu) - mean) * rstd * g0.x + b0.x, (bf2f(w.x >> 16) - mean) * rstd * g0.y + b0.y);
            o.y = pkb((bf2f(w.y & 0xffffu) - mean) * rstd * g0.z + b0.z, (bf2f(w.y >> 16) - mean) * rstd * g0.w + b0.w);
            o.z = pkb((bf2f(w.z & 0xffffu) - mean) * rstd * g1.x + b1.x, (bf2f(w.z >> 16) - mean) * rstd * g1.y + b1.y);
            o.w = pkb((bf2f(w.w & 0xffffu) - mean) * rstd * g1.z + b1.z, (bf2f(w.w >> 16) - mean) * rstd * g1.w + b1.w);
            *(LAS u32x4*)(tile + q * SP_RS + c8 * 2) = o; }
        s16x8 Wf[8];
#pragma unroll
        for (int ks = 0; ks < 8; ++ks) Wf[ks] = wx[ks];
        const float bsc = bs;
        __syncthreads();
        const int un = u + 1;
        if (un < uend) SP_LOAD(un);
        __builtin_amdgcn_sched_barrier(0);
#pragma unroll
        for (int cc = 0; cc < 2; ++cc) { const int ct = 2 * cth + cc;
            f32x16 acc;
#pragma unroll
            for (int i = 0; i < 16; ++i) acc[i] = 0.f;
            const LAS unsigned char* ab = tile + (8 * hi + tr_q) * SP_RS + (32 * ct + 16 * dgrp + 4 * tr_p) * 2;
            s16x8 Af[8];
#pragma unroll
            for (int ks = 0; ks < 8; ++ks) Af[ks] = tr_pair(ab + 16 * ks * SP_RS, 4 * SP_RS);
            __builtin_amdgcn_sched_barrier(0);
#pragma unroll
            for (int ks = 0; ks < 8; ++ks) acc = MFMA32(Af[ks], Wf[ks], acc);
            bf16_t* orow = (dummy ? vb + (size_t)MTOT * 3072 + (size_t)((r0 + 32 * pt + l31) & 8191) * 3072 : vb + (size_t)(r0 + 32 * pt + l31) * 3072) + g * 128 + 32 * ct + 4 * hi;
#pragma unroll
            for (int j = 0; j < 4; ++j) { u32x2 o; o.x = pkb(acc[4 * j] + bsc, acc[4 * j + 1] + bsc); o.y = pkb(acc[4 * j + 2] + bsc, acc[4 * j + 3] + bsc); *(u32x2*)(orow + 8 * j) = o; }
        }
        u = un; buf ^= 1;
    }
#undef SP_LOAD
    __syncthreads();
}

__device__ __forceinline__ int epi_row(int rowbase, int idx) { return rowbase + 128 * (idx >> 2) + 16 * (idx & 3); }
template <class F> struct EpiG {
    static constexpr bool PERM = false, AFTER_DRAIN = false;
    typedef typename F::Pre Pre;
    F f;
    __device__ __forceinline__ void prefetch(Pre& pre, const Unit& u, int wr, int wc, int fr, int fq) const {
        f.prefetch(pre, u, u.pn * 256 + 64 * wc + 8 * fq, u.pm * 256 + wr * 64 + fr); }
    __device__ __forceinline__ void operator()(const f32x4 (&acc)[2][2][4][2], const Unit& u, int wr, int wc, int fr, int fq, const Pre& pre) const {
        F g = f; const int colb = u.pn * 256 + 64 * wc + 8 * fq, rowbase = u.pm * 256 + wr * 64 + fr;
        g.begin(u, colb, fq, rowbase, pre);
#pragma unroll
        for (int ai = 0; ai < 2; ++ai)
#pragma unroll
            for (int m = 0; m < 4; ++m) {
                g.row(ai * 4 + m, rowbase + ai * 128 + m * 16, colb, acc[ai][0][m][0], acc[ai][0][m][1], acc[ai][1][m][0], acc[ai][1][m][1]);
                asm volatile("" ::: "memory"); }
    }
};
struct PreSB { float v[8]; f32x4 bz[4];
    __device__ __forceinline__ void load(const float* ssq, int rowbase, const float* bp) {
#pragma unroll
        for (int i = 0; i < 8; ++i) v[i] = ssq[epi_row(rowbase, i)];
        bz[0] = *(const f32x4*)bp; bz[1] = *(const f32x4*)(bp + 4); bz[2] = *(const f32x4*)(bp + 32); bz[3] = *(const f32x4*)(bp + 36); } };
#ifdef NT_STORE
__device__ __forceinline__ void store8_bf16(bf16_t* o, const f32x4 a, const f32x4 b) { u32x4 w; w.x = pk2(a.x, a.y); w.y = pk2(a.z, a.w); w.z = pk2(b.x, b.y); w.w = pk2(b.z, b.w); __builtin_nontemporal_store(w, (u32x4*)o); }
#else
__device__ __forceinline__ void store8_bf16(bf16_t* o, const f32x4 a, const f32x4 b) { u32x4 w; w.x = pk2(a.x, a.y); w.y = pk2(a.z, a.w); w.z = pk2(b.x, b.y); w.w = pk2(b.z, b.w); *(u32x4*)o = w; }
#endif
__device__ __forceinline__ float sumsq4(const f32x4 x) { return (x.x * x.x + x.y * x.y) + (x.z * x.z + x.w * x.w); }
__device__ __forceinline__ float sum4(const f32x4 x) { return (x.x + x.y) + (x.z + x.w); }
__device__ __forceinline__ float rstd_from(float ssq) { return __builtin_amdgcn_rsqf(ssq * (1.0f / 1024.0f) + 1e-6f); }
__device__ __forceinline__ void atomic_addf(float* p, float v) { __hip_atomic_fetch_add(p, v, __ATOMIC_RELAXED, __HIP_MEMORY_SCOPE_AGENT); }
struct FQKV { static constexpr bool IDEMP = true; bf16_t* O; const float* qg; const float* kg; const float* ssq; const float* bias;
    typedef PreSB Pre;
    f32x4 gn[4], bz[4]; int sect; float rqv[8];
    __device__ __forceinline__ void prefetch(Pre& pre, const Unit& u, int colb, int rowbase) const { pre.load(ssq, rowbase, bias + (size_t)min(u.pm >> 4, 8) * 3072 + colb); }
    __device__ __forceinline__ void begin(const Unit& u, int colb, int fq, int rowbase, const Pre& pre) {
#pragma unroll
        for (int i = 0; i < 8; ++i) rqv[i] = pre.v[i];
#pragma unroll
        for (int i = 0; i < 4; ++i) bz[i] = pre.bz[i];
        sect = u.pn >> 2;
        if (sect < 2) { const float* gp = (sect == 0 ? qg : kg) + 8 * fq; const float mul = sect == 0 ? 0.125f * 1.4426950408889634f : 1.0f;
            gn[0] = *(const f32x4*)gp * mul; gn[1] = *(const f32x4*)(gp + 4) * mul; gn[2] = *(const f32x4*)(gp + 32) * mul; gn[3] = *(const f32x4*)(gp + 36) * mul; } }
    __device__ __forceinline__ void row(int idx, int row, int colb, f32x4 a0, f32x4 b0, f32x4 a1, f32x4 b1) {
        const float rs = rstd_from(rqv[idx]);
        a0 = a0 * rs + bz[0]; b0 = b0 * rs + bz[1]; a1 = a1 * rs + bz[2]; b1 = b1 * rs + bz[3];
        if (sect < 2) { float ss = (sumsq4(a0) + sumsq4(b0)) + (sumsq4(a1) + sumsq4(b1));
            ss += __shfl_xor(ss, 16); ss += __shfl_xor(ss, 32);
            const float r2 = __builtin_amdgcn_rsqf(ss * (1.0f / 64.0f) + 1e-6f);
            a0 = a0 * r2 * gn[0]; b0 = b0 * r2 * gn[1]; a1 = a1 * r2 * gn[2]; b1 = b1 * r2 * gn[3]; }
        if (sect < 2) {
            const int within = colb & 1023, h = within >> 6, fq = (within >> 3) & 7;
            bf16_t* op = O + (size_t)sect * MTOT * 1024 + ((size_t)((row >> 5) * 16 + h) * 4 + (fq >> 1)) * 512 + ((fq & 1) * 32 + (row & 31)) * 8;
            store8_bf16(op, a0, b0); store8_bf16(op + 2 * 512, a1, b1);
        } else { bf16_t* op = O + (size_t)2 * MTOT * 1024 + (size_t)row * 1024 + (colb - 2048); store8_bf16(op, a0, b0); store8_bf16(op + 32, a1, b1); } } };
struct FSqrelu { static constexpr bool IDEMP = true; bf16_t* O; const float* ssq; const float* bias;
    typedef PreSB Pre;
    f32x4 bz[4]; float rqv[8];
    __device__ __forceinline__ void prefetch(Pre& pre, const Unit& u, int colb, int rowbase) const { pre.load(ssq, rowbase, bias + (size_t)min(u.pm >> 4, 8) * 4096 + colb); }
    __device__ __forceinline__ void begin(const Unit& u, int colb, int fq, int rowbase, const Pre& pre) {
#pragma unroll
        for (int i = 0; i < 8; ++i) rqv[i] = pre.v[i];
#pragma unroll
        for (int i = 0; i < 4; ++i) bz[i] = pre.bz[i]; }
    __device__ __forceinline__ void row(int idx, int row, int colb, f32x4 a0, f32x4 b0, f32x4 a1, f32x4 b1) {
        const float rs = rstd_from(rqv[idx]); const f32x4 z = (f32x4){0.f, 0.f, 0.f, 0.f};
        a0 = __builtin_elementwise_max(a0 * rs + bz[0], z); b0 = __builtin_elementwise_max(b0 * rs + bz[1], z); a1 = __builtin_elementwise_max(a1 * rs + bz[2], z); b1 = __builtin_elementwise_max(b1 * rs + bz[3], z);
        bf16_t* op = O + (size_t)row * 4096 + colb; store8_bf16(op, a0 * a0, b0 * b0); store8_bf16(op + 32, a1 * a1, b1 * b1); } };
struct FGeluV { static constexpr bool IDEMP = false; bf16_t* O; const float* ssq; const float* bias; float* lnacc;
    typedef PreSB Pre;
    f32x4 bz[4]; int fq_; float rqv[8];
    __device__ __forceinline__ void prefetch(Pre& pre, const Unit& u, int colb, int rowbase) const { pre.load(ssq, rowbase, bias + (size_t)min(u.pm >> 4, 8) * 6144 + colb); }
    __device__ __forceinline__ void begin(const Unit& u, int colb, int fq, int rowbase, const Pre& pre) { fq_ = fq;
#pragma unroll
        for (int i = 0; i < 8; ++i) rqv[i] = pre.v[i];
#pragma unroll
        for (int i = 0; i < 4; ++i) bz[i] = pre.bz[i]; }
    __device__ __forceinline__ void row(int idx, int row, int colb, f32x4 a0, f32x4 b0, f32x4 a1, f32x4 b1) {
        const float rs = rstd_from(rqv[idx]);
        a0 = gelu4(a0 * rs + bz[0]); b0 = gelu4(b0 * rs + bz[1]); a1 = gelu4(a1 * rs + bz[2]); b1 = gelu4(b1 * rs + bz[3]);
        bf16_t* op = O + (size_t)row * 3072 + colb; store8_bf16(op, a0, b0); store8_bf16(op + 32, a1, b1);
        float s1 = (sum4(a0) + sum4(b0)) + (sum4(a1) + sum4(b1)), s2 = (sumsq4(a0) + sumsq4(b0)) + (sumsq4(a1) + sumsq4(b1));
        s1 += __shfl_xor(s1, 16); s1 += __shfl_xor(s1, 32); s2 += __shfl_xor(s2, 16); s2 += __shfl_xor(s2, 32);
        if (fq_ == 0) { atomic_addf(lnacc + 2 * (size_t)row, s1); atomic_addf(lnacc + 2 * (size_t)row + 1, s2); } } };
struct FGeluU { static constexpr bool IDEMP = false; bf16_t* O; const float* ssq; const float* bias;
    typedef PreSB Pre;
    f32x4 bz[4]; float rqv[8]; u32x4 sv[2][2]; int rowbase_;
    __device__ __forceinline__ void prefetch(Pre& pre, const Unit& u, int colb, int rowbase) const { pre.load(ssq, rowbase, bias + (size_t)min(u.pm >> 4, 8) * 6144 + colb); }
    __device__ __forceinline__ void fetch(int idx, int colb) { const bf16_t* op = O + (size_t)epi_row(rowbase_, idx) * 3072 + colb; sv[idx & 1][0] = *(const u32x4*)op; sv[idx & 1][1] = *(const u32x4*)(op + 32); }
    __device__ __forceinline__ void begin(const Unit& u, int colb, int fq, int rowbase, const Pre& pre) { rowbase_ = rowbase; fetch(0, colb);
#pragma unroll
        for (int i = 0; i < 8; ++i) rqv[i] = pre.v[i];
#pragma unroll
        for (int i = 0; i < 4; ++i) bz[i] = pre.bz[i]; }
    __device__ __forceinline__ static f32x4 lo4(const u32x4 s) { return (f32x4){bf2f(s.x & 0xffffu), bf2f(s.x >> 16), bf2f(s.y & 0xffffu), bf2f(s.y >> 16)}; }
    __device__ __forceinline__ static f32x4 hi4(const u32x4 s) { return (f32x4){bf2f(s.z & 0xffffu), bf2f(s.z >> 16), bf2f(s.w & 0xffffu), bf2f(s.w >> 16)}; }
    __device__ __forceinline__ void row(int idx, int row, int colb, f32x4 a0, f32x4 b0, f32x4 a1, f32x4 b1) {
        if (idx < 7) fetch(idx + 1, colb);
        const float rs = rstd_from(rqv[idx]);
        bf16_t* op = O + (size_t)row * 3072 + colb; const u32x4 sv0 = sv[idx & 1][0], sv1 = sv[idx & 1][1];
        a0 = gelu4(a0 * rs + bz[0]) * lo4(sv0); b0 = gelu4(b0 * rs + bz[1]) * hi4(sv0); a1 = gelu4(a1 * rs + bz[2]) * lo4(sv1); b1 = gelu4(b1 * rs + bz[3]) * hi4(sv1);
        store8_bf16(op, a0, b0); store8_bf16(op + 32, a1, b1); } };
struct FResid { static constexpr bool IDEMP = false; const float* inl; const float* inc; float* outl; float* outc; const float* gate;
    const float* gsn; bf16_t* xb; float* ssqn;
    struct Pre { f32x4 gz[4]; };
    f32x4 gz[4], gsz[4], xin[2][4]; int fq_, rowbase_;
    __device__ __forceinline__ void prefetch(Pre& pre, const Unit& u, int colb, int rowbase) const { const float* gp = gate + (size_t)min(u.pm >> 4, 8) * 6144 + colb;
        pre.gz[0] = *(const f32x4*)gp; pre.gz[1] = *(const f32x4*)(gp + 4); pre.gz[2] = *(const f32x4*)(gp + 32); pre.gz[3] = *(const f32x4*)(gp + 36); }
    __device__ __forceinline__ void fetch(int idx, int colb) { const int row = epi_row(rowbase_, idx);
        const float* ip = row < NLAT ? inl + (size_t)row * 1024 + colb : inc + (size_t)(row - NLAT) * 1024 + colb;
        xin[idx & 1][0] = *(const f32x4*)ip; xin[idx & 1][1] = *(const f32x4*)(ip + 4); xin[idx & 1][2] = *(const f32x4*)(ip + 32); xin[idx & 1][3] = *(const f32x4*)(ip + 36); }
    __device__ __forceinline__ void begin(const Unit& u, int colb, int fq, int rowbase, const Pre& pre) { const int b = min(u.pm >> 4, 8); fq_ = fq; rowbase_ = rowbase; fetch(0, colb);
#pragma unroll
        for (int i = 0; i < 4; ++i) gz[i] = pre.gz[i];
        if (gsn) { const float* sp = gsn + (size_t)b * 1024 + colb; gsz[0] = *(const f32x4*)sp; gsz[1] = *(const f32x4*)(sp + 4); gsz[2] = *(const f32x4*)(sp + 32); gsz[3] = *(const f32x4*)(sp + 36); } }
    __device__ __forceinline__ void row(int idx, int row, int colb, f32x4 a0, f32x4 b0, f32x4 a1, f32x4 b1) {
        if (idx < 7) fetch(idx + 1, colb);
        float* op = row < NLAT ? outl + (size_t)row * 1024 + colb : outc + (size_t)(row - NLAT) * 1024 + colb;
        a0 = xin[idx & 1][0] + gz[0] * a0; b0 = xin[idx & 1][1] + gz[1] * b0; a1 = xin[idx & 1][2] + gz[2] * a1; b1 = xin[idx & 1][3] + gz[3] * b1;
        *(f32x4*)op = a0; *(f32x4*)(op + 4) = b0; *(f32x4*)(op + 32) = a1; *(f32x4*)(op + 36) = b1;
        if (gsn) { float ss = (sumsq4(a0) + sumsq4(b0)) + (sumsq4(a1) + sumsq4(b1));
            ss += __shfl_xor(ss, 16); ss += __shfl_xor(ss, 32);
            if (fq_ == 0) atomic_addf(ssqn + row, ss);
            bf16_t* xp = xb + (size_t)row * 1024 + colb; store8_bf16(xp, a0 * gsz[0], b0 * gsz[1]); store8_bf16(xp + 32, a1 * gsz[2], b1 * gsz[3]); } } };

template <class F> __device__ __forceinline__ void run_gemm(LAS unsigned char* lds, const bf16_t* A, const bf16_t* Bt, int M, int N, int K, const F& f, const Tix T_) {
    pg8::StaticOrder S; S.init(M, N, T_.gsz, T_.bid);
    pg8::Gemm g; g.A = A; g.Bt = Bt; g.M = M; g.N = N; g.K = K; g.ld = K;
#ifdef STAGGER_US
    if ((T_.bid >> 3) & 1) { const unsigned long long t0 = __builtin_amdgcn_s_memrealtime(); while (__builtin_amdgcn_s_memrealtime() - t0 < (unsigned long long)(STAGGER_US * 100)) __builtin_amdgcn_s_sleep(8); }
#endif
    EpiG<F> E; E.f = f;
    pg8::gemm_phase<EpiG<F>, pg8::StaticOrder, true, true>(lds, g, S, E, T_.tid);
}


struct FPartial { static constexpr bool IDEMP = true; float* part; int klen;
    struct Pre { int dummy; };
    float* base_;
    __device__ __forceinline__ void prefetch(Pre& pre, const Unit& u, int colb, int rowbase) const { pre.dummy = 0; }
    __device__ __forceinline__ void begin(const Unit& u, int colb, int fq, int rowbase, const Pre& pre) { base_ = part + (size_t)(u.ko / klen) * 2048 * 1024; }
    __device__ __forceinline__ void row(int idx, int row, int colb, f32x4 a0, f32x4 b0, f32x4 a1, f32x4 b1) {
        float* op = base_ + (size_t)(row - NLAT) * 1024 + colb;
        *(f32x4*)op = a0; *(f32x4*)(op + 4) = b0; *(f32x4*)(op + 32) = a1; *(f32x4*)(op + 36) = b1; } };
__device__ __forceinline__ void run_gemm_ctx_split(LAS unsigned char* lds, const bf16_t* A, const bf16_t* Bt, float* part, int ns, const Tix T_) {
    pg8::SplitOrder S; S.init(8, 4, ns, NLAT / 256, 1024, T_.gsz, T_.bid);
    pg8::Gemm g; g.A = A; g.Bt = Bt; g.M = MTOT; g.N = 1024; g.K = 1024; g.ld = 1024 * ns;
    FPartial f; f.part = part; f.klen = 1024;
    EpiG<FPartial> E; E.f = f;
    pg8::gemm_phase<EpiG<FPartial>, pg8::SplitOrder, true, true>(lds, g, S, E, T_.tid);
}
__device__ __forceinline__ void phase_ctxfin(const Params& p, int L, bool after_mlp, const Tix T_) {
    const float* part = (const float*)(p.ws + OFF_PART); float* ctxr = (float*)(p.ws + OFF_CTXR);
    const float* gate = (const float*)(p.ws + OFF_MODS) + (size_t)(L * 9 + 8) * 6144 + (after_mlp ? 5120 : 2048);
    const int nn = after_mlp ? 2 * L + 2 : 2 * L + 1;
    const float* gsn = (const float*)(p.ws + OFF_GS) + (size_t)(nn * 9 + 8) * 1024;
    bf16_t* xb = (bf16_t*)(p.ws + OFF_HB); float* ssqn = (float*)(p.ws + OFF_SSQ) + (size_t)nn * MTOT;
    const int lane = T_.tid & 63, gw = T_.bid * 8 + (T_.tid >> 6), NGW = T_.gsz * 8;
    for (int row = gw; row < 2048; row += NGW) {
        f32x4 pa[4][4], xv[4], gv[4], sv[4];
#pragma unroll
        for (int j = 0; j < 4; ++j) { const int col = 4 * lane + 256 * j; const size_t o = (size_t)row * 1024 + col;
#pragma unroll
            for (int k = 0; k < 3; ++k) pa[j][k] = *(const f32x4*)(part + (size_t)k * 2048 * 1024 + o);
            pa[j][3] = after_mlp ? *(const f32x4*)(part + (size_t)3 * 2048 * 1024 + o) : (f32x4){0.f, 0.f, 0.f, 0.f};
            xv[j] = *(const f32x4*)(ctxr + o); gv[j] = *(const f32x4*)(gate + col); sv[j] = *(const f32x4*)(gsn + col); }
        __builtin_amdgcn_sched_barrier(0);
        float ss = 0.f;
#pragma unroll
        for (int j = 0; j < 4; ++j) { const int col = 4 * lane + 256 * j; const size_t o = (size_t)row * 1024 + col;
            const f32x4 a = (pa[j][0] + pa[j][1]) + (pa[j][2] + pa[j][3]);
            const f32x4 x = xv[j] + gv[j] * a;
            *(f32x4*)(ctxr + o) = x; ss += sumsq4(x);
            const f32x4 xs = x * sv[j];
            u32x2 w; w.x = pk2(xs.x, xs.y); w.y = pk2(xs.z, xs.w);
            *(u32x2*)(xb + (size_t)(NLAT + row) * 1024 + col) = w; }
        ss = wave_sum(ss);
        if (lane == 0) ssqn[NLAT + row] = ss;
    }
}

enum { OP_QKV, OP_ATTN, OP_MIXOUT, OP_MLP1, OP_MLP2, OP_VGEMM, OP_SPATIAL, OP_UGEMM, OP_PROLOGUE, OP_PHASE0B, OP_CTXFIN, OP_CTXFIN_MIX };

__device__ __forceinline__ void decode_phase(int ph, int& L, int& op) {
    L = 0; op = ph == 0 ? OP_PROLOGUE : OP_PHASE0B;
    if (ph > 1) {
        int q = ph - 2;
        if (q < 6) { L = 0; } else if (q < 14) { L = 1; q -= 6; } else if (q < 19) { L = 2; q -= 14; } else { L = 3; q -= 19; }
        if ((L & 1) == 0) op = q == 0 ? OP_QKV : q == 1 ? OP_ATTN : q == 2 ? OP_MIXOUT : q == 3 ? OP_MLP1 : q == 4 ? OP_MLP2 : OP_CTXFIN;
        else if (L == 1) op = q == 0 ? OP_VGEMM : q == 1 ? OP_SPATIAL : q == 2 ? OP_UGEMM : q == 3 ? OP_MIXOUT : q == 4 ? OP_CTXFIN_MIX : q == 5 ? OP_MLP1 : q == 6 ? OP_MLP2 : OP_CTXFIN;
        else op = q == 0 ? OP_VGEMM : q == 1 ? OP_SPATIAL : q == 2 ? OP_UGEMM : q == 3 ? OP_MIXOUT : q == 4 ? OP_MLP1 : OP_MLP2;
    }
}

__device__ __forceinline__ void run_phase(const Params& p, int ph, LAS unsigned char* lds, const Tix T_) {
    int L, op; decode_phase(ph, L, op);
#ifdef ONLY_OP
    op = ONLY_OP;
#endif
    const int mi = L >> 1;
    const bool attnL = (L & 1) == 0;
    const int Mfull = L < 2 ? MTOT : NLAT;
    const float* modsl = (const float*)(p.ws + OFF_MODS) + (size_t)L * 9 * 6144;
    float* ctxr = (float*)(p.ws + OFF_CTXR);
    bf16_t* hb = (bf16_t*)(p.ws + OFF_HB); bf16_t* big = (bf16_t*)(p.ws + OFF_BIG);
    float* ssq = (float*)(p.ws + OFF_SSQ); const float* gs = (const float*)(p.ws + OFF_GS);
    const bool first = (L == 0);
    switch (op) {
    case OP_PROLOGUE: phase_zero(p, T_); phase_mods(p, lds, T_); __syncthreads(); phase_convert(p, lds, T_); break;
    case OP_PHASE0B: phase_0b(p, lds, T_); break;
    case OP_QKV: { FQKV f; f.O = big; f.qg = p.na_q_norm + mi * 64; f.kg = p.na_k_norm + mi * 64; f.ssq = ssq + (size_t)(2 * L) * MTOT; f.bias = (const float*)(p.ws + OFF_BQKV) + (size_t)mi * 9 * 3072;
        run_gemm(lds, hb, (const bf16_t*)(p.ws + OFF_QKVT) + (size_t)mi * 3072 * 1024, MTOT, 3072, 1024, f, T_); } break;
#ifdef REP_ATTN_DUMMY
    case OP_ATTN: phase_attn_mfma(p, mi, L == 0, lds, T_, 1); __syncthreads(); phase_attn_mfma(p, mi, L == 0, lds, T_); break;
#else
    case OP_ATTN: phase_attn4(p, mi, L == 0, lds, T_); break;
#endif
    case OP_MIXOUT: case OP_MLP2: {
        FResid f; const bool mo = (op == OP_MIXOUT);
        f.inl = (first && mo) ? p.x : p.out; f.inc = (first && mo) ? p.ctx : ctxr; f.outl = p.out; f.outc = ctxr; f.gate = modsl + (mo ? 2048 : 5120);
        const int nn = mo ? 2 * L + 1 : 2 * L + 2;
        const bool has_next = nn < 8 && !(nn == 6 + 0 && false);
        f.gsn = has_next ? gs + (size_t)nn * 9 * 1024 : nullptr; f.xb = hb; f.ssqn = ssq + (size_t)(has_next ? nn : 0) * MTOT;
        const bf16_t* A; const bf16_t* Bt; int K;
        if (!mo) { A = big; Bt = (const bf16_t*)(p.ws + OFF_W2T) + (size_t)L * 1024 * 4096; K = 4096; }
        else if (attnL) { A = big + (size_t)MTOT * 3072; Bt = (const bf16_t*)(p.ws + OFF_WOT) + (size_t)mi * 1024 * 1024; K = 1024; }
        else { A = big; Bt = (const bf16_t*)(p.ws + OFF_SGOT) + (size_t)mi * 1024 * 3072; K = 3072; }
        if ((!mo && L < 2) || (mo && L == 1)) { run_gemm(lds, A, Bt, NLAT, 1024, K, f, T_); __syncthreads(); run_gemm_ctx_split(lds, A, Bt, (float*)(p.ws + OFF_PART), K >> 10, T_); }
        else run_gemm(lds, A, Bt, Mfull, 1024, K, f, T_); } break;
    case OP_CTXFIN: phase_ctxfin(p, L, true, T_); break;
    case OP_CTXFIN_MIX: phase_ctxfin(p, L, false, T_); break;
    case OP_MLP1: { FSqrelu f; f.O = big; f.ssq = ssq + (size_t)(2 * L + 1) * MTOT; f.bias = (const float*)(p.ws + OFF_BMLP) + (size_t)L * 9 * 4096;
        run_gemm(lds, hb, (const bf16_t*)(p.ws + OFF_W1T) + (size_t)L * 4096 * 1024, Mfull, 4096, 1024, f, T_); } break;
    case OP_VGEMM: { FGeluV f; f.O = big; f.ssq = ssq + (size_t)(2 * L) * MTOT; f.bias = (const float*)(p.ws + OFF_BWIN) + (size_t)mi * 9 * 6144 + 3072; f.lnacc = (float*)(p.ws + OFF_LNACC) + (size_t)mi * MTOT * 2;
        run_gemm(lds, hb, (const bf16_t*)(p.ws + OFF_WINT) + (size_t)mi * 6144 * 1024 + (size_t)3072 * 1024, Mfull, 3072, 1024, f, T_); } break;
#ifdef REP_SPATIAL
    case OP_SPATIAL: phase_spatial_mfma(p, mi, Mfull, lds, T_, true); __syncthreads(); phase_spatial_mfma(p, mi, Mfull, lds, T_); break;
#else
    case OP_SPATIAL: phase_spatial_mfma(p, mi, Mfull, lds, T_); break;
#endif
    case OP_UGEMM: { FGeluU f; f.O = big; f.ssq = ssq + (size_t)(2 * L) * MTOT; f.bias = (const float*)(p.ws + OFF_BWIN) + (size_t)mi * 9 * 6144;
        run_gemm(lds, hb, (const bf16_t*)(p.ws + OFF_WINT) + (size_t)mi * 6144 * 1024, Mfull, 3072, 1024, f, T_); } break;
    default: break;
    }
}

#ifndef ONE_LAUNCH
#define ONE_LAUNCH 1
#endif
__global__ void __launch_bounds__(NTHREADS) mk(Params p0) {
    extern __shared__ __attribute__((aligned(16))) unsigned char lds_raw[];
    LAS unsigned char* lds = (LAS unsigned char*)lds_raw;
#if ONE_LAUNCH
    cg::grid_group grid = cg::this_grid();
    if (p0.ph_lo < 0) grid.sync();
    volatile LAS unsigned* st = (volatile LAS unsigned*)(lds + LDS_ST_OFF);
    if (threadIdx.x == 0) { st[0] = 0u; st[1] = 0u; }
    __syncthreads();
    const XcdBarrier xbar = xcd_barrier_post((unsigned*)(p0.ws + OFF_BAR), st);
    bool first_it = true, repeated = false;
    for (int ph = p0.ph_lo; ph < p0.ph_hi; ) {
        if (!first_it) xcd_barrier(xbar);
#ifdef EXTRA_SYNC
        if (ph == 3) { for (int e = 0; e < EXTRA_SYNC; ++e) xcd_barrier(xbar); }
#endif
        first_it = false;
        Tix T_; T_.tid = threadIdx.x; T_.bid = blockIdx.x; T_.gsz = gridDim.x;
        size_t z = 0;
        asm volatile("" : "+v"(T_.tid)); asm volatile("" : "+s"(T_.bid), "+s"(T_.gsz), "+s"(z));
        Params p = p0;
        { const float** pp = (const float**)&p;
#pragma unroll
          for (int i = 0; i < 22; ++i) pp[i] += z; }
        p.out += z; p.ws += z;
        run_phase(p, ph, lds, T_);
        __syncthreads();
        if (REP_MASK != 0) { int L_, op_; decode_phase(ph, L_, op_); if (((REP_MASK >> op_) & 1) && !repeated) { repeated = true; continue; } }
        repeated = false; ++ph;
    }
#else
    Tix T_; T_.tid = threadIdx.x; T_.bid = blockIdx.x; T_.gsz = gridDim.x;
    run_phase(p0, p0.ph_lo, lds, T_);
#endif
}

extern "C" void kernel_launch(void* const* d_in, const int* in_sizes, int n_in, void* d_out, int out_size, void* d_ws, size_t ws_size, hipStream_t stream) {
    static int grid = 0;
    if (grid == 0) {
        if (n_in != 22 || ws_size < WS_END) { fprintf(stderr, "kernel_launch: unexpected n_in %d or ws_size %zu (< %zu)\n", n_in, ws_size, (size_t)WS_END); grid = -1; return; }
        int dev = 0, cus = 0, per_cu = 0;
        hipGetDevice(&dev); hipDeviceGetAttribute(&cus, hipDeviceAttributeMultiprocessorCount, dev);
        if (hipFuncSetAttribute((const void*)mk, hipFuncAttributeMaxDynamicSharedMemorySize, LDS_BYTES) != hipSuccess) { fprintf(stderr, "kernel_launch: hipFuncSetAttribute failed\n"); grid = -1; return; }
        if (hipOccupancyMaxActiveBlocksPerMultiprocessor(&per_cu, (const void*)mk, NTHREADS, LDS_BYTES) != hipSuccess || per_cu < 1) { fprintf(stderr, "kernel_launch: occupancy query says %d\n", per_cu); per_cu = 1; }
        (void)hipGetLastError();
        grid = cus;
    }
    if (grid < 0) return;
    if (hipMemsetAsync((unsigned char*)d_ws + OFF_BAR, 0, 16384, stream) != hipSuccess) { fprintf(stderr, "kernel_launch: memset of the barrier words failed\n"); return; }
    Params p{};
    const float** pp = (const float**)&p;
    for (int i = 0; i < 22; ++i) pp[i] = (const float*)d_in[i];
    p.out = (float*)d_out; p.ws = (unsigned char*)d_ws;
#if ONE_LAUNCH
    p.ph_lo = 0; p.ph_hi = NPH;
    void* args[] = {&p};
    hipError_t e = hipLaunchCooperativeKernel((void*)mk, dim3(grid), dim3(NTHREADS), args, LDS_BYTES, stream);
    if (e != hipSuccess) fprintf(stderr, "cooperative launch failed: %s (grid %d)\n", hipGetErrorString(e), grid);
#else
    for (int ph = 0; ph < NPH; ++ph) { p.ph_lo = ph; p.ph_hi = ph + 1; hipLaunchKernelGGL(mk, dim3(grid), dim3(NTHREADS), LDS_BYTES, stream, p); }
#endif
}
```

```cpp
#include <hip/hip_runtime.h>
#include <hip/hip_cooperative_groups.h>
#include <cstdio>
#include <cstdint>
namespace cg = cooperative_groups;
namespace pg8 {
#define PG8_LAS __attribute__((address_space(3)))
typedef unsigned short bf16_t;
typedef short bf16x8 __attribute__((ext_vector_type(8)));
typedef float f32x4 __attribute__((ext_vector_type(4)));
typedef unsigned u32x4 __attribute__((ext_vector_type(4)));
constexpr int BM = 256, BK = 64, HALF = 128, HTB = HALF * BK * 2  , STAGE_BYTES = 8 * HTB, NXCD = 8, WGM = 8;

__host__ __device__ __forceinline__ int lds_byte(int r, int c) { const int st = (r >> 4) * 2 + (c >> 5), rr = r & 15, cc = c & 31, ob = rr * 64 + cc * 2; return st * 1024 + (ob ^ (((ob >> 9) & 1) << 5)); }
__host__ __device__ __forceinline__ void stage_rc(int b, int& R, int& C) { const int st = b / 1024, sb = b % 1024, swz = sb ^ (((sb >> 9) & 1) << 5); R = (st >> 1) * 16 + swz / 64; C = (st & 1) * 32 + (swz % 64) / 2; }
__host__ __device__ __forceinline__ int perm32(int rho) { const int n = rho >> 4, i = rho & 15; return 8 * (i >> 2) + 4 * n + (i & 3); }

struct Unit { int pm, pn, ko; };
struct Gemm { const bf16_t* A; const bf16_t* Bt; int M, N, K, ld; };

struct StaticOrder {
    int nM, nN, nwg, G, c;
    __host__ __device__ void init(int M, int N, int G_, int c_) { nM = M / BM; nN = N / BM; nwg = nM * nN; G = G_; c = c_; }
    __host__ __device__ bool next(int i, Unit& u) const {
        const long L = (long)i * G + c; if (L >= nwg) return false;
        int wgid = (int)L; { const int q = nwg / NXCD, r = nwg % NXCD, xcd = wgid % NXCD, off = wgid / NXCD; wgid = (xcd < r ? xcd * (q + 1) : r * (q + 1) + (xcd - r) * q) + off; }
        const int nig = WGM * nN, gid = wgid / nig, fm = gid * WGM, gsz = (nM - fm) < WGM ? (nM - fm) : WGM;
        u.pm = fm + ((wgid % nig) % gsz); u.pn = (wgid % nig) / gsz; u.ko = 0; return true;
    }
    __device__ __forceinline__ void a_ready(const Unit&) const {}
    __device__ __forceinline__ void done(const Unit&) const {}
};

struct SplitOrder {
    int nM, nN, ns, pm0, klen, nwg, G, c;
    __host__ __device__ void init(int nM_, int nN_, int ns_, int pm0_, int klen_, int G_, int c_) { nM = nM_; nN = nN_; ns = ns_; pm0 = pm0_; klen = klen_; nwg = nM * nN * ns; G = G_; c = c_; }
    __host__ __device__ bool next(int i, Unit& u) const {
        const long L = (long)i * G + c; if (L >= nwg) return false;
        const int w = (int)L, t = w % (nM * nN); u.ko = (w / (nM * nN)) * klen; u.pm = pm0 + t % nM; u.pn = t / nM; return true;
    }
    __device__ __forceinline__ void a_ready(const Unit&) const {}
    __device__ __forceinline__ void done(const Unit&) const {}
};

__device__ __forceinline__ unsigned cvt_pk_bf16(float lo, float hi) { unsigned r; asm volatile("v_cvt_pk_bf16_f32 %0, %1, %2" : "=v"(r) : "v"(lo), "v"(hi)); return r; }
template <class Epi, class Sched, bool ALIGN_EPI = false, bool SP2 = false>
__device__ __forceinline__ void gemm_phase(PG8_LAS unsigned char* lds, const Gemm g, const Sched& S, const Epi& E, const int tid_in) {
    const int tid = tid_in, wid = __builtin_amdgcn_readfirstlane(tid >> 6), lane = tid & 63, wr = wid >> 2, wc = wid & 3, fr = lane & 15, fq = lane >> 4;
    const int K = g.ld, nt = g.K / BK;
    unsigned voffA[2], voffB[2];
#pragma unroll
    for (int i = 0; i < 2; ++i) { int R, C; stage_rc(tid * 16 + i * 8192, R, C); const int Rb = Epi::PERM ? ((R & ~31) + perm32(R & 31)) : R;
        voffA[i] = (unsigned)(R * K + C) * 2u; voffB[i] = (unsigned)(Rb * K + C) * 2u; }
    const size_t kstep = (size_t)(BK * 2);
    const size_t hstep = (size_t)HALF * K * 2;
    const size_t tstep = 2 * hstep;
    const unsigned ldsw = (unsigned)wid * 1024u;
    const int aoff = lds_byte(wr * 64 + fr, fq * 8), boff = lds_byte(wc * 32 + fr, fq * 8);
#define PG8_SA(b, h) (((b) * 2 + (h)) * HTB)
#define PG8_SB(b, h) ((4 + (b) * 2 + (h)) * HTB)
#define PG8_STAGE(bufoff, gbase, voff) do { _Pragma("unroll") for (int _i = 0; _i < 2; ++_i) \
        __builtin_amdgcn_global_load_lds((const unsigned*)((const char*)(gbase) + (voff)[_i]), (PG8_LAS unsigned*)(lds + (bufoff) + ldsw + _i * 8192), 16, 0, 0); } while (0)
#define PG8_LDA(dst, b, h) do { _Pragma("unroll") for (int m = 0; m < 4; ++m) _Pragma("unroll") for (int k = 0; k < 2; ++k) dst[m][k] = *(const PG8_LAS bf16x8*)(lds + PG8_SA(b, h) + aoff + m * 2048 + k * 1024); } while (0)
#define PG8_LDB(dst, b, h) do { _Pragma("unroll") for (int n = 0; n < 2; ++n) _Pragma("unroll") for (int k = 0; k < 2; ++k) dst[n][k] = *(const PG8_LAS bf16x8*)(lds + PG8_SB(b, h) + boff + n * 2048 + k * 1024); } while (0)
#define PG8_MMA(ai, bj, At, Bt) do { __builtin_amdgcn_s_setprio(1); _Pragma("unroll") for (int m = 0; m < 4; ++m) _Pragma("unroll") for (int n = 0; n < 2; ++n) _Pragma("unroll") for (int k = 0; k < 2; ++k) \
        acc[ai][bj][m][n] = __builtin_amdgcn_mfma_f32_16x16x32_bf16(Bt[n][k], At[m][k], acc[ai][bj][m][n], 0, 0, 0); __builtin_amdgcn_s_setprio(0); } while (0)
#define PG8_WAIT_V(n) asm volatile("s_waitcnt vmcnt(" #n ")" ::: "memory")
#define PG8_WAIT_L(n) asm volatile("s_waitcnt lgkmcnt(" #n ")" ::: "memory")
#define PG8_BAR __builtin_amdgcn_s_barrier()
#define PG8_SCHED __builtin_amdgcn_sched_barrier(0)
    Unit cur, nxt; int ui = 0;
    if (!S.next(0, cur)) return;
    f32x4 acc[2][2][4][2];
#pragma unroll
    for (int a = 0; a < 2; ++a)
#pragma unroll
        for (int b = 0; b < 2; ++b)
#pragma unroll
            for (int m = 0; m < 4; ++m)
#pragma unroll
                for (int n = 0; n < 2; ++n) acc[a][b][m][n] = (f32x4){0.f, 0.f, 0.f, 0.f};
    bf16x8 At[4][2], B0[2][2], B1[2][2];
    const char* cA = (const char*)g.A + (size_t)cur.pm * tstep + (size_t)cur.ko * 2; const char* cB = (const char*)g.Bt + (size_t)cur.pn * tstep + (size_t)cur.ko * 2;
    S.a_ready(cur);
    typename Epi::Pre pre; E.prefetch(pre, cur, wr, wc, fr, fq);
    if constexpr (SP2) {
        PG8_STAGE(PG8_SB(0, 0), cB, voffB); PG8_STAGE(PG8_SB(0, 1), cB + hstep, voffB); PG8_STAGE(PG8_SA(0, 0), cA, voffA); PG8_STAGE(PG8_SA(0, 1), cA + hstep, voffA);
        if (wr == 1) PG8_BAR;
        PG8_WAIT_V(2); PG8_BAR;
        PG8_STAGE(PG8_SB(1, 0), cB + kstep, voffB); PG8_STAGE(PG8_SA(1, 0), cA + kstep, voffA); PG8_STAGE(PG8_SB(1, 1), cB + hstep + kstep, voffB);
        PG8_WAIT_V(6); PG8_BAR;
    } else {
        PG8_STAGE(PG8_SB(0, 0), cB, voffB); PG8_STAGE(PG8_SA(0, 0), cA, voffA); PG8_STAGE(PG8_SB(0, 1), cB + hstep, voffB); PG8_STAGE(PG8_SA(0, 1), cA + hstep, voffA);
        if (wr == 1) PG8_BAR;
        PG8_WAIT_V(4); PG8_BAR;
        PG8_STAGE(PG8_SB(1, 0), cB + kstep, voffB); PG8_STAGE(PG8_SA(1, 0), cA + kstep, voffA); PG8_STAGE(PG8_SB(1, 1), cB + hstep + kstep, voffB);
        PG8_WAIT_V(6); PG8_BAR;
    }
    for (;;) {
        const bool has_next = S.next(ui + 1, nxt);
        const char* nA = has_next ? (const char*)g.A + (size_t)nxt.pm * tstep + (size_t)nxt.ko * 2 : cA; const char* nB = has_next ? (const char*)g.Bt + (size_t)nxt.pn * tstep + (size_t)nxt.ko * 2 : cB;
        for (int t = 0; t < nt; t += 2) {
            const bool last = (t == nt - 2);
            const char* a1 = cA + (size_t)(t + 1) * kstep;
            const char* a2 = last ? nA : cA + (size_t)(t + 2) * kstep; const char* b2 = last ? nB : cB + (size_t)(t + 2) * kstep;
            const char* a3 = a2 + kstep; const char* b3 = b2 + kstep;
            if (last && has_next) S.a_ready(nxt);
            if constexpr (SP2) {
            PG8_LDB(B0, 0, 0); PG8_LDB(B1, 0, 1); PG8_SCHED; PG8_LDA(At, 0, 0); PG8_STAGE(PG8_SA(1, 1), a1 + hstep, voffA);
            PG8_WAIT_V(8); PG8_WAIT_L(0); PG8_BAR; PG8_MMA(0, 0, At, B0); PG8_MMA(0, 1, At, B1); PG8_BAR; PG8_SCHED;
            PG8_LDA(At, 0, 1); PG8_STAGE(PG8_SB(0, 0), b2, voffB); PG8_STAGE(PG8_SB(0, 1), b2 + hstep, voffB); PG8_STAGE(PG8_SA(0, 0), a2, voffA);
            PG8_WAIT_V(8); PG8_WAIT_L(0); PG8_BAR; PG8_MMA(1, 0, At, B0); PG8_MMA(1, 1, At, B1); PG8_BAR; PG8_SCHED;
            PG8_LDB(B0, 1, 0); PG8_LDB(B1, 1, 1); PG8_SCHED; PG8_LDA(At, 1, 0); PG8_STAGE(PG8_SA(0, 1), a2 + hstep, voffA);
            PG8_WAIT_V(8); PG8_WAIT_L(0); PG8_BAR; PG8_MMA(0, 0, At, B0); PG8_MMA(0, 1, At, B1); PG8_BAR; PG8_SCHED;
            PG8_LDA(At, 1, 1); PG8_STAGE(PG8_SB(1, 0), b3, voffB); PG8_STAGE(PG8_SB(1, 1), b3 + hstep, voffB); PG8_STAGE(PG8_SA(1, 0), a3, voffA);
            PG8_WAIT_V(8); PG8_WAIT_L(0); PG8_BAR; PG8_MMA(1, 0, At, B0); PG8_MMA(1, 1, At, B1); PG8_BAR; PG8_SCHED;
            } else {
            PG8_LDB(B0, 0, 0); PG8_SCHED; PG8_LDA(At, 0, 0); PG8_STAGE(PG8_SA(1, 1), a1 + hstep, voffA);
            PG8_WAIT_L(8); PG8_BAR; PG8_WAIT_L(0); PG8_MMA(0, 0, At, B0); PG8_BAR; PG8_SCHED;
            PG8_LDB(B1, 0, 1); PG8_STAGE(PG8_SB(0, 0), b2, voffB);
            PG8_BAR; PG8_WAIT_L(0); PG8_MMA(0, 1, At, B1); PG8_BAR;
            PG8_LDA(At, 0, 1); PG8_STAGE(PG8_SA(0, 0), a2, voffA);
            PG8_BAR; PG8_WAIT_L(0); PG8_MMA(1, 0, At, B0); PG8_BAR; PG8_SCHED;
            PG8_STAGE(PG8_SB(0, 1), b2 + hstep, voffB);
            PG8_WAIT_V(6); PG8_BAR; PG8_MMA(1, 1, At, B1); PG8_BAR;
            PG8_LDB(B0, 1, 0); PG8_SCHED; PG8_LDA(At, 1, 0); PG8_STAGE(PG8_SA(0, 1), a2 + hstep, voffA);
            PG8_WAIT_L(8); PG8_BAR; PG8_WAIT_L(0); PG8_MMA(0, 0, At, B0); PG8_BAR; PG8_SCHED;
            PG8_LDB(B1, 1, 1); PG8_STAGE(PG8_SB(1, 0), b3, voffB);
            PG8_BAR; PG8_WAIT_L(0); PG8_MMA(0, 1, At, B1); PG8_BAR;
            PG8_LDA(At, 1, 1); PG8_STAGE(PG8_SA(1, 0), a3, voffA);
            PG8_BAR; PG8_WAIT_L(0); PG8_MMA(1, 0, At, B0); PG8_BAR; PG8_SCHED;
            PG8_STAGE(PG8_SB(1, 1), b3 + hstep, voffB);
            PG8_WAIT_V(6); PG8_BAR; PG8_MMA(1, 1, At, B1); PG8_BAR;
            }
        }
        if constexpr (ALIGN_EPI) { if (wr == 0) PG8_BAR; }
        if constexpr (!Epi::AFTER_DRAIN) { E(acc, cur, wr, wc, fr, fq, pre); S.done(cur); }
        if (!has_next) break;
#pragma unroll
        for (int a = 0; a < 2; ++a)
#pragma unroll
            for (int b = 0; b < 2; ++b)
#pragma unroll
                for (int m = 0; m < 4; ++m)
#pragma unroll
                    for (int n = 0; n < 2; ++n) acc[a][b][m][n] = (f32x4){0.f, 0.f, 0.f, 0.f};
        cur = nxt; cA = nA; cB = nB; ++ui;
        E.prefetch(pre, cur, wr, wc, fr, fq);
        if constexpr (ALIGN_EPI) { if (wr == 1) PG8_BAR; }
    }
    PG8_WAIT_V(0);
    if constexpr (!ALIGN_EPI) { if (wr == 0) PG8_BAR; }
    PG8_BAR;
    if constexpr (Epi::AFTER_DRAIN) { E.fused(acc, cur, wr, wc, fr, fq, lds, wid, lane); S.done(cur); }
#undef PG8_SA
#undef PG8_SB
#undef PG8_STAGE
#undef PG8_LDA
#undef PG8_LDB
#undef PG8_MMA
#undef PG8_WAIT_V
#undef PG8_WAIT_L
#undef PG8_BAR
#undef PG8_SCHED
}
}
#define LAS __attribute__((address_space(3)))

#define XB_TMO      128
#define XB_XCNT(j)  (256  + 64 * (j))
#define XB_XSUB(j)  (1280 + 64 * (j))
#define XB_XGEN(j)  (2304 + 64 * (j))
#define XB_TOP      3328
#define XB_TOPGEN   3392
#define XCD_BAR_WORDS 3456
#define XB_SPIN_CAP (1u << 18)

__device__ __forceinline__ unsigned xb_ld(unsigned* p)              { return __hip_atomic_load(p, __ATOMIC_RELAXED, __HIP_MEMORY_SCOPE_AGENT); }
__device__ __forceinline__ unsigned xb_add(unsigned* p, unsigned v) { return __hip_atomic_fetch_add(p, v, __ATOMIC_RELAXED, __HIP_MEMORY_SCOPE_AGENT); }
__device__ __forceinline__ unsigned xb_xcc_id() { return (unsigned)__builtin_amdgcn_s_getreg((3 << 11) | 20) & 0xFu; }
#define XB_SPIN(cond, bar) do { unsigned _sp = 0; while (cond) { __builtin_amdgcn_s_sleep(1); \
    if ((++_sp & 255u) == 0u) { if (xb_ld(&(bar)[XB_TMO])) break; if (_sp > XB_SPIN_CAP) { atomicAdd(&(bar)[XB_TMO], 1u); break; } } } } while (0)

struct XcdBarrier {
    unsigned* bar; unsigned x;
    volatile LAS unsigned* st;
};

__device__ __forceinline__ XcdBarrier xcd_barrier_post(unsigned* bar, volatile LAS unsigned* st) {
    XcdBarrier b; b.bar = bar; b.x = xb_xcc_id(); b.st = st;
    if (threadIdx.x == 0) (void)xb_add(&bar[XB_XCNT(b.x)], 1u);
    return b;
}
__device__ __forceinline__ void xcd_barrier_complete(unsigned* bar, unsigned x, unsigned& nloc, unsigned& nx) {
    const unsigned G = gridDim.x * gridDim.y * gridDim.z;
    unsigned sum, cnt, mine, sp = 0u;
    for (;;) {
        sum = 0u; cnt = 0u; mine = 0u;
#pragma unroll
        for (unsigned j = 0; j < 16; ++j) { const unsigned c = xb_ld(&bar[XB_XCNT(j)]); sum += c; cnt += (c > 0u) ? 1u : 0u; mine = (j == x) ? c : mine; }
        if (sum == G) break;
        __builtin_amdgcn_s_sleep(1);
        if ((++sp & 255u) == 0u) { if (xb_ld(&bar[XB_TMO])) break; if (sp > XB_SPIN_CAP) { atomicAdd(&bar[XB_TMO], 1u); break; } }
    }
    nloc = mine > 0u ? mine : 1u; nx = cnt > 0u ? cnt : 1u;
}

__device__ __forceinline__ void xcd_barrier(const XcdBarrier& b) {
    asm volatile("s_waitcnt vmcnt(0)" ::: "memory");
    __syncthreads();
    if (threadIdx.x == 0) {
        unsigned* bar = b.bar;
        __builtin_amdgcn_s_waitcnt(0);
        unsigned nloc = b.st[0], nx = b.st[1];
        if (nloc == 0u) { xcd_barrier_complete(bar, b.x, nloc, nx); b.st[0] = nloc; b.st[1] = nx; }
        const unsigned old = xb_add(&bar[XB_XSUB(b.x)], 1u);
        const unsigned gen = old / nloc;
        if (old + 1u == (gen + 1u) * nloc) {
            __builtin_amdgcn_fence(__ATOMIC_RELEASE, "agent");
            asm volatile("s_waitcnt vmcnt(0)" ::: "memory");
            const unsigned og = xb_add(&bar[XB_TOP], 1u);
            const unsigned tg = og / nx;
            if (og + 1u == (tg + 1u) * nx) xb_add(&bar[XB_TOPGEN], 1u);
            else XB_SPIN(xb_ld(&bar[XB_TOPGEN]) == tg, bar);
            __builtin_amdgcn_fence(__ATOMIC_ACQUIRE, "agent");
            xb_add(&bar[XB_XGEN(b.x)], 1u);
            asm volatile("s_waitcnt vmcnt(0)" ::: "memory");
        } else {
            XB_SPIN(xb_ld(&bar[XB_XGEN(b.x)]) == gen, bar);
            __builtin_amdgcn_fence(__ATOMIC_ACQUIRE, "agent");
            asm volatile("s_waitcnt vmcnt(0)" ::: "memory");
        }
    }
    __syncthreads();
}


#ifndef REP_MASK
#define REP_MASK 0
#endif
#ifndef NAIVE_ATTN
#define NAIVE_ATTN 0
#endif
#ifndef NAIVE_SPATIAL
#define NAIVE_SPATIAL 0
#endif

using pg8::bf16_t; using pg8::f32x4; using pg8::Unit; using pg8::u32x4;
typedef unsigned u32x2 __attribute__((ext_vector_type(2)));

constexpr int NLAT = 32768, NCTX = 2048, MTOT = 34816;
constexpr int NTHREADS = 512;
constexpr int LDS_BYTES = 141440;
constexpr int LDS_ST_OFF = 141424;
constexpr int NPH = 27;

constexpr size_t OFF_W1T = 0;
constexpr size_t OFF_W2T = OFF_W1T + 4ull * 4096 * 1024 * 2;
constexpr size_t OFF_QKVT = OFF_W2T + 4ull * 4096 * 1024 * 2;
constexpr size_t OFF_WOT = OFF_QKVT + 2ull * 3072 * 1024 * 2;
constexpr size_t OFF_WINT = OFF_WOT + 2ull * 1024 * 1024 * 2;
constexpr size_t OFF_SGOT = OFF_WINT + 2ull * 6144 * 1024 * 2;
constexpr size_t OFF_MODS = OFF_SGOT + 2ull * 1024 * 3072 * 2;
constexpr size_t OFF_CTXR = OFF_MODS + 4ull * 9 * 6144 * 4;
constexpr size_t OFF_HB = OFF_CTXR + 2048ull * 1024 * 4;
constexpr size_t OFF_BIG = OFF_HB + 34816ull * 1024 * 2;
constexpr size_t OFF_SSQ = OFF_BIG + 34816ull * 4096 * 2;
constexpr size_t OFF_LNACC = OFF_SSQ + 8ull * 34816 * 4;
constexpr size_t OFF_GS = OFF_LNACC + 2ull * 34816 * 2 * 4;
constexpr size_t OFF_BQKV = OFF_GS + 8ull * 9 * 1024 * 4;
constexpr size_t OFF_BMLP = OFF_BQKV + 2ull * 9 * 3072 * 4;
constexpr size_t OFF_BWIN = OFF_BMLP + 4ull * 9 * 4096 * 4;
constexpr size_t OFF_WSF = OFF_BWIN + 2ull * 9 * 6144 * 4;
constexpr size_t OFF_PART = OFF_WSF + 2ull * 24 * 16384 * 2;
constexpr size_t OFF_BAR = OFF_PART + 4ull * 2048 * 1024 * 4;
constexpr size_t WS_END = OFF_BAR + 16384;

struct Params {
    const float *x, *c, *ctx, *c_ctx, *ada_w, *ada_b, *norm1_g, *norm2_g, *mlp_w1, *mlp_w2, *na_w_qkv, *na_q_norm, *na_k_norm, *na_rpb, *na_w_o,
        *sg_w_in, *sg_b_in, *sg_ln_g, *sg_ln_b, *sg_w_s, *sg_b_s, *sg_w_o;
    float* out; unsigned char* ws; int ph_lo, ph_hi;
};

struct Tix { int tid, bid, gsz; };
__device__ __forceinline__ float bf2f(unsigned h) { return __uint_as_float(h << 16); }
__device__ __forceinline__ unsigned f2bf(float f) { unsigned u = __float_as_uint(f); u += 0x7FFFu + ((u >> 16) & 1u); return u >> 16; }
__device__ __forceinline__ unsigned pk2(float lo, float hi) { return pg8::cvt_pk_bf16(lo, hi); }
__device__ __forceinline__ float wave_sum(float v) {
#pragma unroll
    for (int o = 1; o < 64; o <<= 1) v += __shfl_xor(v, o);
    return v;
}
__device__ __forceinline__ float wave_max(float v) {
#pragma unroll
    for (int o = 1; o < 64; o <<= 1) v = fmaxf(v, __shfl_xor(v, o));
    return v;
}
#define LDS_WAIT() asm volatile("s_waitcnt lgkmcnt(0)" ::: "memory")
__device__ __forceinline__ float sumsq4f(const pg8::f32x4 x) { return (x.x * x.x + x.y * x.y) + (x.z * x.z + x.w * x.w); }
__device__ __forceinline__ float silu_f(float v) { return v / (1.f + expf(-v)); }
__device__ __forceinline__ float gelu_f(float v) { return 0.5f * v * (1.f + erff(v * 0.70710678118654752f)); }

typedef float f32x2 __attribute__((ext_vector_type(2)));
__device__ __forceinline__ f32x2 gelu_pk(f32x2 v) {
    const f32x2 av = __builtin_elementwise_abs(v), d = av * 0.2316418882f + 1.0f;
    f32x2 t; t.x = __builtin_amdgcn_rcpf(d.x); t.y = __builtin_amdgcn_rcpf(d.y);
    f32x2 q = t * 0.5307027145f + (-0.7265760135f); q = q * t + 0.7107068705f; q = q * t + (-0.142248368f); q = q * t + 0.127414796f; q = q * t;
    const f32x2 s = (v * v) * (-0.72134752044f);
    f32x2 e; e.x = __builtin_amdgcn_exp2f(s.x); e.y = __builtin_amdgcn_exp2f(s.y);
    const f32x2 m = v * (q * e), r = v - m;
    f32x2 o; o.x = v.x < 0.f ? m.x : r.x; o.y = v.y < 0.f ? m.y : r.y; return o;
}
__device__ __forceinline__ f32x4 gelu4(f32x4 v) { const f32x2 a = gelu_pk((f32x2){v.x, v.y}), b = gelu_pk((f32x2){v.z, v.w}); return (f32x4){a.x, a.y, b.x, b.y}; }

__device__ __forceinline__ int sigma_inv(int L) { return 128 * ((L >> 5) & 1) + 32 * (L >> 6) + 16 * ((L >> 2) & 1) + 4 * ((L >> 3) & 3) + (L & 3); }

__device__ __forceinline__ void phase_mods(const Params& p, LAS unsigned char* lds, const Tix T_) {
    LAS float* sc = (LAS float*)lds;
    LAS float* red = (LAS float*)(lds + 36864);
    float* mods = (float*)(p.ws + OFF_MODS);
    const int tid = T_.tid;
    for (int i = tid; i < 9 * 1024; i += NTHREADS) { const int b = i >> 10, k = i & 1023; const float v = b < 8 ? p.c[b * 1024 + k] : p.c_ctx[k]; sc[i] = silu_f(v); }
    __syncthreads();
    const int c4 = (tid & 15) * 4, kk = tid >> 4;
    for (int item = T_.bid; item < 384; item += T_.gsz) {
        const int l = item / 96, n0 = (item % 96) * 64;
        const float* W = p.ada_w + (size_t)l * 1024 * 6144 + n0 + c4;
        f32x4 acc[9];
#pragma unroll
        for (int b = 0; b < 9; ++b) acc[b] = (f32x4){0.f, 0.f, 0.f, 0.f};
#pragma unroll
        for (int hlf = 0; hlf < 2; ++hlf) {
            f32x4 wq[16];
#pragma unroll
            for (int i = 0; i < 16; ++i) wq[i] = *(const f32x4*)(W + (size_t)(kk + 32 * (16 * hlf + i)) * 6144);
            __builtin_amdgcn_sched_barrier(0);
#pragma unroll
            for (int i = 0; i < 16; ++i) { const int k = kk + 32 * (16 * hlf + i);
#pragma unroll
                for (int b = 0; b < 9; ++b) acc[b] += sc[b * 1024 + k] * wq[i]; } }
#pragma unroll
        for (int b = 0; b < 9; ++b) *(LAS f32x4*)(red + (kk * 9 + b) * 64 + c4) = acc[b];
        __syncthreads();
        for (int o = tid; o < 576; o += NTHREADS) { const int b = o >> 6, cc = o & 63; float s = 0.f;
            for (int j = 0; j < 32; ++j) s += red[(j * 9 + b) * 64 + cc];
            mods[(size_t)(l * 9 + b) * 6144 + n0 + cc] = s + p.ada_b[l * 6144 + n0 + cc]; }
        __syncthreads();
    }
}

struct MatDesc { const float* src; bf16_t* dst; int K, N; };
__device__ __forceinline__ MatDesc get_mat(const Params& p, int mi) {
    MatDesc m;
    if (mi < 4) { m.src = p.mlp_w1 + (size_t)mi * 1024 * 4096; m.dst = (bf16_t*)(p.ws + OFF_W1T) + (size_t)mi * 4096 * 1024; m.K = 1024; m.N = 4096; }
    else if (mi < 8) { const int l = mi - 4; m.src = p.mlp_w2 + (size_t)l * 4096 * 1024; m.dst = (bf16_t*)(p.ws + OFF_W2T) + (size_t)l * 1024 * 4096; m.K = 4096; m.N = 1024; }
    else if (mi < 10) { const int a = mi - 8; m.src = p.na_w_qkv + (size_t)a * 1024 * 3072; m.dst = (bf16_t*)(p.ws + OFF_QKVT) + (size_t)a * 3072 * 1024; m.K = 1024; m.N = 3072; }
    else if (mi < 12) { const int a = mi - 10; m.src = p.na_w_o + (size_t)a * 1024 * 1024; m.dst = (bf16_t*)(p.ws + OFF_WOT) + (size_t)a * 1024 * 1024; m.K = 1024; m.N = 1024; }
    else if (mi < 14) { const int s = mi - 12; m.src = p.sg_w_in + (size_t)s * 1024 * 6144; m.dst = (bf16_t*)(p.ws + OFF_WINT) + (size_t)s * 6144 * 1024; m.K = 1024; m.N = 6144; }
    else { const int s = mi - 14; m.src = p.sg_w_o + (size_t)s * 3072 * 1024; m.dst = (bf16_t*)(p.ws + OFF_SGOT) + (size_t)s * 1024 * 3072; m.K = 3072; m.N = 1024; }
    return m;
}
struct CvItem { const float* src; bf16_t* dst; int K, N, k0, n0; };
__device__ __forceinline__ CvItem cv_locate(const Params& p, int g) {
    int mi, it;
    if (g < 8192) { mi = g >> 11; it = g & 2047; }
    else if (g < 16384) { mi = 4 + ((g - 8192) >> 11); it = g & 2047; }
    else if (g < 19456) { const int t = g - 16384; mi = 8 + t / 1536; it = t % 1536; }
    else if (g < 20480) { const int t = g - 19456; mi = 10 + (t >> 9); it = t & 511; }
    else if (g < 26624) { const int t = g - 20480; mi = 12 + t / 3072; it = t % 3072; }
    else { const int t = g - 26624; mi = 14 + t / 1536; it = t % 1536; }
    const MatDesc m = get_mat(p, mi);
    CvItem c; c.src = m.src; c.dst = m.dst; c.K = m.K; c.N = m.N; const int nblk = m.N / 32; c.k0 = 64 * (it / nblk); c.n0 = 32 * (it % nblk);
    return c;
}
__device__ __forceinline__ void cv_load(float (&wv)[32], const CvItem& c, int lane) {
    const float* wsrc = c.src + (size_t)(c.k0 + (lane >> 5)) * c.N + c.n0 + (lane & 31);
#pragma unroll
    for (int i = 0; i < 32; ++i) wv[i] = wsrc[(size_t)(2 * i) * c.N];
}
__device__ __forceinline__ void phase_convert(const Params& p, LAS unsigned char* lds, const Tix T_) {
    const int lane = T_.tid & 63, wave = T_.tid >> 6, gw = T_.bid * 8 + wave, NGW = T_.gsz * 8;
    LAS float* scr = (LAS float*)(lds + wave * 8704);
    constexpr int NITEMS = 29696;
    float wv[32];
    int g = gw;
    CvItem cur = cv_locate(p, min(g, NITEMS - 1));
    if (g < NITEMS) cv_load(wv, cur, lane);
    while (g < NITEMS) {
#pragma unroll
        for (int i = 0; i < 32; ++i) scr[(2 * i + (lane >> 5)) * 33 + (lane & 31)] = wv[i];
        const int gn = g + NGW;
        const CvItem nxt = cv_locate(p, min(gn, NITEMS - 1));
        if (gn < NITEMS) cv_load(wv, nxt, lane);
        LDS_WAIT();
        const int c = lane & 7;
#pragma unroll
        for (int j = 0; j < 4; ++j) { const int n = (lane >> 3) + 8 * j; const LAS float* s = scr + (8 * c) * 33 + n;
            u32x4 o; o.x = pk2(s[0 * 33], s[1 * 33]); o.y = pk2(s[2 * 33], s[3 * 33]); o.z = pk2(s[4 * 33], s[5 * 33]); o.w = pk2(s[6 * 33], s[7 * 33]);
            const int nl = cur.n0 + n, drow = (nl & ~255) + sigma_inv(nl & 255);
            *(u32x4*)(cur.dst + (size_t)drow * cur.K + cur.k0 + 8 * c) = o; }
        LDS_WAIT();
        g = gn; cur = nxt;
    }
    { bf16_t* wsf = (bf16_t*)(p.ws + OFF_WSF);
      for (int it = gw; it < 2 * 24 * 4 * 8; it += NGW) { const int ks = it & 7, pt = (it >> 3) & 3, slg = it >> 5;
          const float* wp = p.sg_w_s + (size_t)slg * 16384 + (32 * pt + (lane & 31)) * 128 + 16 * ks + 8 * (lane >> 5);
          const f32x4 x = *(const f32x4*)wp, y = *(const f32x4*)(wp + 4);
          u32x4 o; o.x = pk2(x.x, x.y); o.y = pk2(x.z, x.w); o.z = pk2(y.x, y.y); o.w = pk2(y.z, y.w);
          *(u32x4*)(wsf + (size_t)it * 512 + lane * 8) = o; } }
}


__device__ __forceinline__ void phase_zero(const Params& p, const Tix T_) {
    float* z0 = (float*)(p.ws + OFF_SSQ) + MTOT; const int n0 = 7 * MTOT + 2 * MTOT * 2;
    for (int i = T_.bid * NTHREADS + T_.tid; i < n0; i += T_.gsz * NTHREADS) z0[i] = 0.f;
}
__device__ __forceinline__ void phase_0b(const Params& p, LAS unsigned char* lds, const Tix T_) {
    const float* mods = (const float*)(p.ws + OFF_MODS);
    const int tid = T_.tid, lane = tid & 63, wave = tid >> 6, gw = T_.bid * 8 + wave, NGW = T_.gsz * 8;
    { float* gs = (float*)(p.ws + OFF_GS);
      for (int i = T_.bid * NTHREADS + tid; i < 8 * 9 * 1024; i += T_.gsz * NTHREADS) { const int n = i / 9216, rem = i % 9216, b = rem >> 10, c = rem & 1023, L = n >> 1;
          const float g = (n & 1) ? p.norm2_g[L * 1024 + c] : p.norm1_g[L * 1024 + c];
          gs[i] = g * (1.0f + mods[(size_t)(L * 9 + b) * 6144 + ((n & 1) ? 4096 : 1024) + c]); } }
    { bf16_t* hb = (bf16_t*)(p.ws + OFF_HB); float* ssq0 = (float*)(p.ws + OFF_SSQ);
      f32x4 gvv[4];
#pragma unroll
      for (int j = 0; j < 4; ++j) gvv[j] = *(const f32x4*)(p.norm1_g + 4 * lane + 256 * j);
      for (int row0 = gw; row0 < MTOT; row0 += 2 * NGW) {
          const int row1 = row0 + NGW; const bool has1 = row1 < MTOT; const int r1 = has1 ? row1 : row0;
          const float* xr0 = row0 < NLAT ? p.x + (size_t)row0 * 1024 : p.ctx + (size_t)(row0 - NLAT) * 1024;
          const float* xr1 = r1 < NLAT ? p.x + (size_t)r1 * 1024 : p.ctx + (size_t)(r1 - NLAT) * 1024;
          const int b0 = row0 < NLAT ? (row0 >> 12) : 8, b1 = r1 < NLAT ? (r1 >> 12) : 8;
          f32x4 v0[4], v1[4], s0[4], s1[4];
#pragma unroll
          for (int j = 0; j < 4; ++j) { v0[j] = *(const f32x4*)(xr0 + 4 * lane + 256 * j); v1[j] = *(const f32x4*)(xr1 + 4 * lane + 256 * j);
              s0[j] = *(const f32x4*)(mods + (size_t)b0 * 6144 + 1024 + 4 * lane + 256 * j); s1[j] = *(const f32x4*)(mods + (size_t)b1 * 6144 + 1024 + 4 * lane + 256 * j); }
          __builtin_amdgcn_sched_barrier(0);
          float ss0 = 0.f, ss1 = 0.f;
#pragma unroll
          for (int j = 0; j < 4; ++j) { ss0 += sumsq4f(v0[j]); ss1 += sumsq4f(v1[j]); }
#pragma unroll
          for (int o = 1; o < 64; o <<= 1) { const float t0 = __shfl_xor(ss0, o), t1 = __shfl_xor(ss1, o); ss0 += t0; ss1 += t1; }
          if (lane == 0) { ssq0[row0] = ss0; if (has1) ssq0[row1] = ss1; }
#pragma unroll
          for (int j = 0; j < 4; ++j) { const int col = 4 * lane + 256 * j;
              const f32x4 o0 = v0[j] * gvv[j] * (1.0f + s0[j]);
              u32x2 w; w.x = pk2(o0.x, o0.y); w.y = pk2(o0.z, o0.w);
              *(u32x2*)(hb + (size_t)row0 * 1024 + col) = w;
              if (has1) { const f32x4 o1 = v1[j] * gvv[j] * (1.0f + s1[j]);
                  u32x2 w1; w1.x = pk2(o1.x, o1.y); w1.y = pk2(o1.z, o1.w);
                  *(u32x2*)(hb + (size_t)row1 * 1024 + col) = w1; } } } }
    LAS float* sh = (LAS float*)lds;
    for (int cmb = 0; cmb < 8; ++cmb) {
        int L, shoff, N; const bf16_t* Bt; float* dst; const float* addb = nullptr;
        if (cmb < 2) { L = 2 * cmb; shoff = 0; N = 3072; Bt = (const bf16_t*)(p.ws + OFF_QKVT) + (size_t)cmb * 3072 * 1024; dst = (float*)(p.ws + OFF_BQKV) + (size_t)cmb * 9 * 3072; }
        else if (cmb < 6) { L = cmb - 2; shoff = 3072; N = 4096; Bt = (const bf16_t*)(p.ws + OFF_W1T) + (size_t)L * 4096 * 1024; dst = (float*)(p.ws + OFF_BMLP) + (size_t)L * 9 * 4096; }
        else { const int sl = cmb - 6; L = 2 * sl + 1; shoff = 0; N = 6144; Bt = (const bf16_t*)(p.ws + OFF_WINT) + (size_t)sl * 6144 * 1024; dst = (float*)(p.ws + OFF_BWIN) + (size_t)sl * 9 * 6144; addb = p.sg_b_in + sl * 6144; }
        __syncthreads();
        for (int i = tid; i < 9 * 1024; i += NTHREADS) sh[i] = mods[(size_t)(L * 9 + (i >> 10)) * 6144 + shoff + (i & 1023)];
        __syncthreads();
        for (int n = gw; n < N; n += NGW) {
            const bf16_t* wr_ = Bt + (size_t)((n & ~255) + sigma_inv(n & 255)) * 1024 + lane * 8;
            const u32x4 w0 = *(const u32x4*)wr_, w1 = *(const u32x4*)(wr_ + 512);
            float wv[16];
#pragma unroll
            for (int e = 0; e < 4; ++e) { wv[2 * e] = bf2f(w0[e] & 0xffffu); wv[2 * e + 1] = bf2f(w0[e] >> 16); wv[8 + 2 * e] = bf2f(w1[e] & 0xffffu); wv[8 + 2 * e + 1] = bf2f(w1[e] >> 16); }
            const float ab = addb ? addb[n] : 0.f;
            float a9[9];
#pragma unroll
            for (int b = 0; b < 9; ++b) {
                const f32x4 s0 = *(const LAS f32x4*)(sh + b * 1024 + lane * 8), s1 = *(const LAS f32x4*)(sh + b * 1024 + lane * 8 + 4);
                const f32x4 s2 = *(const LAS f32x4*)(sh + b * 1024 + 512 + lane * 8), s3 = *(const LAS f32x4*)(sh + b * 1024 + 512 + lane * 8 + 4);
                a9[b] = (wv[0] * s0.x + wv[1] * s0.y) + (wv[2] * s0.z + wv[3] * s0.w) + (wv[4] * s1.x + wv[5] * s1.y) + (wv[6] * s1.z + wv[7] * s1.w)
                      + (wv[8] * s2.x + wv[9] * s2.y) + (wv[10] * s2.z + wv[11] * s2.w) + (wv[12] * s3.x + wv[13] * s3.y) + (wv[14] * s3.z + wv[15] * s3.w); }
#pragma unroll
            for (int o = 1; o < 64; o <<= 1) {
                float t9[9];
#pragma unroll
                for (int b = 0; b < 9; ++b) t9[b] = __shfl_xor(a9[b], o);
#pragma unroll
                for (int b = 0; b < 9; ++b) a9[b] += t9[b]; }
            if (lane == 0) {
#pragma unroll
                for (int b = 0; b < 9; ++b) dst[(size_t)b * N + n] = a9[b] + ab; }
        }
    }
}

typedef short s16x4 __attribute__((ext_vector_type(4)));
typedef short s16x8 __attribute__((ext_vector_type(8)));
typedef float f32x16 __attribute__((ext_vector_type(16)));
typedef __bf16 bf16x2_t __attribute__((ext_vector_type(2)));
__device__ __forceinline__ unsigned pkb(float a, float b) { const f32x2 v = {a, b}; const bf16x2_t r = __builtin_convertvector(v, bf16x2_t); return __builtin_bit_cast(unsigned, r); }
__device__ __forceinline__ s16x8 pack8(float a0, float a1, float a2, float a3, float a4, float a5, float a6, float a7) {
    u32x4 w; w.x = pkb(a0, a1); w.y = pkb(a2, a3); w.z = pkb(a4, a5); w.w = pkb(a6, a7); return __builtin_bit_cast(s16x8, w); }
__device__ __forceinline__ s16x8 tr_pair(const LAS unsigned char* a0, int second_off) {
    const s16x4 a = __builtin_amdgcn_ds_read_tr16_b64_v4i16((LAS s16x4*)a0);
    const s16x4 b = __builtin_amdgcn_ds_read_tr16_b64_v4i16((LAS s16x4*)(a0 + second_off));
    s16x8 r; r[0] = a[0]; r[1] = a[1]; r[2] = a[2]; r[3] = a[3]; r[4] = b[0]; r[5] = b[1]; r[6] = b[2]; r[7] = b[3]; return r; }
#define MFMA32(a, b, c) __builtin_amdgcn_mfma_f32_32x32x16_bf16((a), (b), (c), 0, 0, 0)

constexpr int AV_STR = 144;
__device__ __forceinline__ f32x16 attn_qk(const s16x8 (&Kf)[4], const s16x8 (&Qf)[4]) {
    f32x16 S;
#pragma unroll
    for (int i = 0; i < 16; ++i) S[i] = 0.f;
#pragma unroll
    for (int ks = 0; ks < 4; ++ks) S = MFMA32(Kf[ks], Qf[ks], S);
    return S;
}
__device__ __forceinline__ float tabv(const LAS unsigned char* tabrow, int off) { return *(const LAS float*)(tabrow + off); }
__device__ __forceinline__ void attn_one_tile(const s16x8 (&Kf)[4], const s16x8 (&Qf)[4], const LAS unsigned char* vb, const LAS unsigned char* tabrow, const unsigned (&offo)[4], const unsigned offx,
                                              f32x16& O0, f32x16& O1, float& lsum, int mode, float mbl) {
    if (mode == 4) return;
    const f32x16 S = attn_qk(Kf, Qf);
    s16x8 V00, V01, V10, V11;
    if (mode != 3) { V00 = tr_pair(vb, 8 * AV_STR); V01 = tr_pair(vb + 64, 8 * AV_STR); }
    if (mode != 2) { V10 = tr_pair(vb + 16 * AV_STR, 8 * AV_STR); V11 = tr_pair(vb + 16 * AV_STR + 64, 8 * AV_STR); }
    __builtin_amdgcn_sched_barrier(0);
    float pv[16];
    if (mode == 0) {
#pragma unroll
        for (int i = 0; i < 16; ++i) pv[i] = __builtin_amdgcn_exp2f(S[i] - mbl);
    } else if (mode == 1) {
        float tb[16];
#pragma unroll
        for (int i = 0; i < 16; ++i) tb[i] = tabv(tabrow, (int)((offo[i >> 2] >> (8 * (i & 3))) & 0xffu));
        __builtin_amdgcn_sched_barrier(0);
#pragma unroll
        for (int i = 0; i < 16; ++i) pv[i] = __builtin_amdgcn_exp2f(S[i] + tb[i]);
    } else {
        float tb[4];
#pragma unroll
        for (int i = 0; i < 4; ++i) tb[i] = tabv(tabrow, (int)((offx >> (8 * i)) & 0xffu));
        __builtin_amdgcn_sched_barrier(0);
#pragma unroll
        for (int i = 0; i < 16; ++i) pv[i] = 0.f;
        if (mode == 2) {
#pragma unroll
            for (int i = 0; i < 4; ++i) pv[i] = __builtin_amdgcn_exp2f(S[i] + tb[i]);
        } else {
#pragma unroll
            for (int i = 0; i < 4; ++i) pv[12 + i] = __builtin_amdgcn_exp2f(S[12 + i] + tb[i]);
        }
    }
#pragma unroll
    for (int i = 0; i < 16; ++i) lsum += pv[i];
    const s16x8 P0 = pack8(pv[0], pv[1], pv[2], pv[3], pv[4], pv[5], pv[6], pv[7]), P1 = pack8(pv[8], pv[9], pv[10], pv[11], pv[12], pv[13], pv[14], pv[15]);
    if (mode != 3) { O0 = MFMA32(V00, P0, O0); O1 = MFMA32(V01, P0, O1); }
    if (mode != 2) { O0 = MFMA32(V10, P1, O0); O1 = MFMA32(V11, P1, O1); }
}
__device__ __forceinline__ void attn_load_k(s16x8 (&Kf)[4], const bf16_t* kfb, int klat0, int kctx0, int kt, int ntl, int rs) {
    const int tile = kt < ntl ? klat0 + (rs + (kt >> 1)) * 2 + (kt & 1) : kctx0 + (kt - ntl);
#pragma unroll
    for (int ks = 0; ks < 4; ++ks) Kf[ks] = *(const s16x8*)(kfb + (size_t)tile * 32768 + ks * 512);
}
struct AUnit { int b, h, qrow0, r, rs, ntl, ntiles; };
__device__ __forceinline__ AUnit attn_decode(int u, int nlatu) {
    AUnit a;
    if (u < nlatu) { a.h = u & 15; const int br = u >> 4; a.r = br & 63; a.b = br >> 6; a.qrow0 = a.b * 4096 + a.r * 64; a.rs = min(max(a.r - 4, 0), 56); a.ntl = 16; a.ntiles = 24; }
    else { const int v = u - nlatu; a.h = v & 15; const int bq = v >> 4; a.b = bq >> 2; a.qrow0 = NLAT + a.b * 256 + (bq & 3) * 64; a.r = 0; a.rs = 0; a.ntl = 0; a.ntiles = 8; }
    return a;
}
__device__ __forceinline__ u32x4 attn_load_v1(const bf16_t* vbase, const AUnit& a, int idx) {
    const int key = idx >> 3, ch = idx & 7, kt = key >> 5, kk = key & 31;
    const int grow = kt < a.ntl ? (a.b * 4096 + (a.rs + (kt >> 1)) * 64 + 32 * (kt & 1) + kk) : (NLAT + a.b * 256 + 32 * (kt - a.ntl) + kk);
    return *(const u32x4*)(vbase + (size_t)grow * 1024 + ch * 8);
}
__device__ __forceinline__ void attn_load_v(u32x4 (&vpre)[12], const bf16_t* qkv, const AUnit& a, int tid) {
    const bf16_t* vbase = qkv + (size_t)2 * MTOT * 1024 + a.h * 64;
#pragma unroll
    for (int i = 0; i < 4; ++i) vpre[i] = attn_load_v1(vbase, a, tid + NTHREADS * i);
    if (a.ntiles == 24) {
#pragma unroll
        for (int i = 4; i < 12; ++i) vpre[i] = attn_load_v1(vbase, a, tid + NTHREADS * i);
    }
}

__device__ __forceinline__ void phase_attn_mfma(const Params& p, int a_, bool ctx_q, LAS unsigned char* lds, const Tix T_, const int dummy = 0) {
    const bf16_t* qkv = (const bf16_t*)(p.ws + OFF_BIG); bf16_t* ao = (bf16_t*)(p.ws + OFF_BIG) + (size_t)MTOT * 3072;
    const bf16_t* kf = qkv + (size_t)MTOT * 1024;
    const float* rpb = p.na_rpb + (size_t)a_ * 16 * 15 * 31;
    const int tid = T_.tid, lane = tid & 63, wave = __builtin_amdgcn_readfirstlane(tid >> 6), qt = wave & 1, kq = wave >> 1, l31 = lane & 31, hi = lane >> 5;
    LAS unsigned char* Vl = lds;
    LAS float* Ored = (LAS float*)lds;
    LAS float* lred = (LAS float*)(lds + 69632);
    LAS float* tab_all = (LAS float*)(lds + 110592);
    LAS float* misc = (LAS float*)(lds + 110592 + 30720);
    constexpr float LOG2E = 1.4426950408889634f;
    float mb;
    { float m = 0.f; for (int i = tid; i < 7440; i += NTHREADS) m = fmaxf(m, rpb[i]);
      float qg = 0.f, kg = 0.f; if (tid < 64) { qg = fabsf(p.na_q_norm[a_ * 64 + tid]); kg = fabsf(p.na_k_norm[a_ * 64 + tid]); }
      m = wave_max(m); qg = wave_max(qg); kg = wave_max(kg);
      if (lane == 0) { misc[wave] = m; if (wave == 0) { misc[8] = qg; misc[9] = kg; } }
      __syncthreads();
      float rm = misc[0];
#pragma unroll
      for (int w = 1; w < 8; ++w) rm = fmaxf(rm, misc[w]);
      mb = 8.0f * misc[8] * misc[9] + rm; }
    const float mbl = mb * LOG2E;
    for (int i = tid; i < 16 * 480; i += NTHREADS) { const int hh = i / 480, rem = i % 480, rr = rem >> 5, dd = rem & 31; tab_all[i] = dd < 31 ? (rpb[hh * 465 + rr * 31 + dd] - mb) * LOG2E : -1e30f; }
    const int nlatu = 8 * 64 * 16, total = nlatu + (ctx_q ? 8 * 4 * 16 : 0);
    const int tr_q = (lane & 15) >> 2, tr_p = lane & 3, dgrp = (lane >> 4) & 1;
    const int qcol = 32 * qt + l31, wst = min(max(qcol - 8, 0), 48);
    unsigned offo[4], offx = 0u;
#pragma unroll
    for (int j = 0; j < 4; ++j) { offo[j] = 0u;
#pragma unroll
        for (int i = 0; i < 4; ++i) { const int kcol = 32 * qt + 8 * j + 4 * hi + i; offo[j] |= (unsigned)(((unsigned)(kcol - wst) < 16u ? kcol - qcol + 15 : 31) * 4) << (8 * i); } }
#pragma unroll
    for (int i = 0; i < 4; ++i) { const int kcol = (qt == 0 ? 32 : 24) + 4 * hi + i; offx |= (unsigned)(((unsigned)(kcol - wst) < 16u ? kcol - qcol + 15 : 31) * 4) << (8 * i); }
    int u = T_.bid;
    AUnit cur = attn_decode(min(u, total - 1), nlatu);
    u32x4 vpre[12];
    s16x8 Qf[4], KA[4], KB[4];
    if (u < total) {
        attn_load_v(vpre, qkv, cur, tid);
        const bf16_t* qp = qkv + (size_t)(((cur.qrow0 >> 5) + qt) * 16 + cur.h) * 2048 + lane * 8;
#pragma unroll
        for (int ks = 0; ks < 4; ++ks) Qf[ks] = *(const s16x8*)(qp + 512 * ks);
        const int t0 = kq * (cur.ntiles >> 2);
        attn_load_k(KA, kf + cur.h * 2048 + lane * 8, cur.b * 128, 1024 + cur.b * 8, t0, cur.ntl, cur.rs);
        attn_load_k(KB, kf + cur.h * 2048 + lane * 8, cur.b * 128, 1024 + cur.b * 8, t0 + 1, cur.ntl, cur.rs);
    }
    while (u < total) {
        const int b = cur.b, h = cur.h, qrow0 = cur.qrow0, r = cur.r, rs = cur.rs, ntl = cur.ntl, ntiles = cur.ntiles;
        int tidl = tid; asm volatile("" : "+v"(tidl));
#pragma unroll
        for (int i = 0; i < 4; ++i) { const int idx = tidl + NTHREADS * i; *(LAS u32x4*)(Vl + (idx >> 3) * AV_STR + (idx & 7) * 16) = vpre[i]; }
        if (ntiles == 24) {
#pragma unroll
            for (int i = 4; i < 12; ++i) { const int idx = tidl + NTHREADS * i; *(LAS u32x4*)(Vl + (idx >> 3) * AV_STR + (idx & 7) * 16) = vpre[i]; } }
        const LAS float* tab = tab_all + h * 480;
        const bf16_t* kbase = kf + h * 2048 + lane * 8;
        const int klat0 = b * 128, kctx0 = 1024 + b * 8;
        const int ntw = ntiles >> 2, t0 = kq * ntw;
        __syncthreads();
        f32x16 O0, O1;
#pragma unroll
        for (int i = 0; i < 16; ++i) { O0[i] = 0.f; O1[i] = 0.f; }
        float lsum = 0.f;
#pragma unroll 1
        for (int t = 0; t < (dummy ? 0 : ntw); t += 2) {
            { const int kt = t0 + t; const int mode = kt >= ntl ? 0 : ((kt & 1) == qt ? 1 : 2 + qt);
              attn_one_tile(KA, Qf, Vl + (kt * 32 + 4 * hi + tr_q) * AV_STR + (16 * dgrp + 4 * tr_p) * 2, (const LAS unsigned char*)tab + (rs + (kt >> 1) - r + 7) * 128, offo, offx, O0, O1, lsum, mode, mbl); }
            __builtin_amdgcn_sched_barrier(0);
            attn_load_k(KA, kbase, klat0, kctx0, t0 + min(t + 2, ntw - 2), ntl, rs);
            { const int kt = t0 + t + 1; const int mode = kt >= ntl ? 0 : ((kt & 1) == qt ? 1 : 2 + qt);
              attn_one_tile(KB, Qf, Vl + (kt * 32 + 4 * hi + tr_q) * AV_STR + (16 * dgrp + 4 * tr_p) * 2, (const LAS unsigned char*)tab + (rs + (kt >> 1) - r + 7) * 128, offo, offx, O0, O1, lsum, mode, mbl); }
            __builtin_amdgcn_sched_barrier(0);
            attn_load_k(KB, kbase, klat0, kctx0, t0 + min(t + 2, ntw - 2) + 1, ntl, rs);
        }
        const int un = u + T_.gsz;
        const AUnit nxt = attn_decode(min(un, total - 1), nlatu);
        int tidm = tid; asm volatile("" : "+v"(tidm));
        if (un < total) attn_load_v(vpre, qkv, nxt, tidm);
        __syncthreads();
#pragma unroll
        for (int j = 0; j < 4; ++j) {
            *(LAS f32x4*)(Ored + (size_t)((kq * 64 + 32 * qt + l31) * 68 + 8 * j + 4 * hi)) = (f32x4){O0[4 * j], O0[4 * j + 1], O0[4 * j + 2], O0[4 * j + 3]};
            *(LAS f32x4*)(Ored + (size_t)((kq * 64 + 32 * qt + l31) * 68 + 32 + 8 * j + 4 * hi)) = (f32x4){O1[4 * j], O1[4 * j + 1], O1[4 * j + 2], O1[4 * j + 3]}; }
        lred[(kq * 2 + hi) * 64 + 32 * qt + l31] = lsum;
        if (un < total) {
            const bf16_t* qp = qkv + (size_t)(((nxt.qrow0 >> 5) + qt) * 16 + nxt.h) * 2048 + lane * 8;
#pragma unroll
            for (int ks = 0; ks < 4; ++ks) Qf[ks] = *(const s16x8*)(qp + 512 * ks);
            const int t0n = kq * (nxt.ntiles >> 2);
            attn_load_k(KA, kf + nxt.h * 2048 + lane * 8, nxt.b * 128, 1024 + nxt.b * 8, t0n, nxt.ntl, nxt.rs);
            attn_load_k(KB, kf + nxt.h * 2048 + lane * 8, nxt.b * 128, 1024 + nxt.b * 8, t0n + 1, nxt.ntl, nxt.rs);
        }
        __syncthreads();
        { const int q = tid >> 3, d8 = (tid & 7) * 8;
          f32x4 s0 = (f32x4){0.f, 0.f, 0.f, 0.f}, s1 = s0; float l = 0.f;
#pragma unroll
          for (int k = 0; k < 4; ++k) { s0 += *(const LAS f32x4*)(Ored + (k * 64 + q) * 68 + d8); s1 += *(const LAS f32x4*)(Ored + (k * 64 + q) * 68 + d8 + 4); l += lred[(k * 2) * 64 + q] + lred[(k * 2 + 1) * 64 + q]; }
          const float inv = 1.0f / l;
          u32x4 o; o.x = pkb(s0.x * inv, s0.y * inv); o.y = pkb(s0.z * inv, s0.w * inv); o.z = pkb(s1.x * inv, s1.y * inv); o.w = pkb(s1.z * inv, s1.w * inv);
          *(u32x4*)(ao + (size_t)(qrow0 + q) * 1024 + h * 64 + d8) = o; }
        __syncthreads();
        u = un; cur = nxt;
    }
}


struct AUnit2 { int b, h, qrow0, r0, rsu, ntl, ntiles; };
__device__ __forceinline__ AUnit2 attn2_decode(int u, int nlatu) {
    AUnit2 a;
    if (u < nlatu) { a.h = u & 15; const int brp = u >> 4; a.r0 = 2 * (brp & 31); a.b = brp >> 5; a.qrow0 = a.b * 4096 + a.r0 * 64; a.rsu = min(max(a.r0 - 4, 0), 56); a.ntl = 18; a.ntiles = 26; }
    else { const int v = u - nlatu; a.h = v & 15; const int bq = v >> 4; a.b = bq >> 1; a.qrow0 = NLAT + a.b * 256 + (bq & 1) * 128; a.r0 = 0; a.rsu = 0; a.ntl = 0; a.ntiles = 8; }
    return a;
}
__device__ __forceinline__ u32x4 attn2_load_v1(const bf16_t* vbase, const AUnit2& a, int idx) {
    const int key = idx >> 3, ch = idx & 7, kt = key >> 5, kk = key & 31;
    const int grow = kt < a.ntl ? (a.b * 4096 + min(a.rsu + (kt >> 1), 63) * 64 + 32 * (kt & 1) + kk) : (NLAT + a.b * 256 + 32 * (kt - a.ntl) + kk);
    return *(const u32x4*)(vbase + (size_t)grow * 1024 + ch * 8);
}
__device__ __forceinline__ void attn2_load_v(u32x4 (&vpre)[13], const bf16_t* qkv, const AUnit2& a, int tid) {
    const bf16_t* vbase = qkv + (size_t)2 * MTOT * 1024 + a.h * 64;
#pragma unroll
    for (int i = 0; i < 4; ++i) vpre[i] = attn2_load_v1(vbase, a, tid + NTHREADS * i);
    if (a.ntiles == 26) {
#pragma unroll
        for (int i = 4; i < 13; ++i) vpre[i] = attn2_load_v1(vbase, a, tid + NTHREADS * i);
    }
}
__device__ __forceinline__ void attn2_load_k(s16x8 (&Kf)[4], const bf16_t* kfb, int klat0, int kctx0, int kt, int ntl, int rsu) {
    const int tile = kt < ntl ? klat0 + min(rsu + (kt >> 1), 63) * 2 + (kt & 1) : kctx0 + (kt - ntl);
#pragma unroll
    for (int ks = 0; ks < 4; ++ks) Kf[ks] = *(const s16x8*)(kfb + (size_t)tile * 32768 + ks * 512);
}
__device__ __forceinline__ void phase_attn2(const Params& p, int a_, bool ctx_q, LAS unsigned char* lds, const Tix T_) {
    const bf16_t* qkv = (const bf16_t*)(p.ws + OFF_BIG); bf16_t* ao = (bf16_t*)(p.ws + OFF_BIG) + (size_t)MTOT * 3072;
    const bf16_t* kf = qkv + (size_t)MTOT * 1024;
    const float* rpb = p.na_rpb + (size_t)a_ * 16 * 15 * 31;
    const int tid = T_.tid, lane = tid & 63, wave = __builtin_amdgcn_readfirstlane(tid >> 6), qtile = wave & 3, qt = qtile & 1, qrow = qtile >> 1, kh = wave >> 2, l31 = lane & 31, hi = lane >> 5;
    LAS unsigned char* Vl = lds;
    LAS float* Ored = (LAS float*)lds;
    LAS float* lred = (LAS float*)(lds + 69632);
    LAS float* tab_all = (LAS float*)(lds + 119808);
    LAS float* misc = (LAS float*)(lds + 119808 + 30720);
    constexpr float LOG2E = 1.4426950408889634f;
    float mb;
    { float m = 0.f; for (int i = tid; i < 7440; i += NTHREADS) m = fmaxf(m, rpb[i]);
      float qg = 0.f, kg = 0.f; if (tid < 64) { qg = fabsf(p.na_q_norm[a_ * 64 + tid]); kg = fabsf(p.na_k_norm[a_ * 64 + tid]); }
      m = wave_max(m); qg = wave_max(qg); kg = wave_max(kg);
      if (lane == 0) { misc[wave] = m; if (wave == 0) { misc[8] = qg; misc[9] = kg; } }
      __syncthreads();
      float rm = misc[0];
#pragma unroll
      for (int w = 1; w < 8; ++w) rm = fmaxf(rm, misc[w]);
      mb = 8.0f * misc[8] * misc[9] + rm; }
    const float mbl = mb * LOG2E;
    for (int i = tid; i < 16 * 480; i += NTHREADS) { const int hh = i / 480, rem = i % 480, rr = rem >> 5, dd = rem & 31; tab_all[i] = dd < 31 ? (rpb[hh * 465 + rr * 31 + dd] - mb) * LOG2E : -1e30f; }
    const int nlatu = 8 * 32 * 16, total = nlatu + (ctx_q ? 8 * 2 * 16 : 0);
    const int tr_q = (lane & 15) >> 2, tr_p = lane & 3, dgrp = (lane >> 4) & 1;
    const int qcol = 32 * qt + l31, wst = min(max(qcol - 8, 0), 48);
    unsigned offo[4], offx = 0u;
#pragma unroll
    for (int j = 0; j < 4; ++j) { offo[j] = 0u;
#pragma unroll
        for (int i = 0; i < 4; ++i) { const int kcol = 32 * qt + 8 * j + 4 * hi + i; offo[j] |= (unsigned)(((unsigned)(kcol - wst) < 16u ? kcol - qcol + 15 : 31) * 4) << (8 * i); } }
#pragma unroll
    for (int i = 0; i < 4; ++i) { const int kcol = (qt == 0 ? 32 : 24) + 4 * hi + i; offx |= (unsigned)(((unsigned)(kcol - wst) < 16u ? kcol - qcol + 15 : 31) * 4) << (8 * i); }
    int u = T_.bid;
    AUnit2 cur = attn2_decode(min(u, total - 1), nlatu);
    u32x4 vpre[13];
    s16x8 Qf[4], KA[4], KB[4];
    if (u < total) {
        attn2_load_v(vpre, qkv, cur, tid);
        const bf16_t* qp = qkv + (size_t)(((cur.qrow0 >> 5) + qtile) * 16 + cur.h) * 2048 + lane * 8;
#pragma unroll
        for (int ks = 0; ks < 4; ++ks) Qf[ks] = *(const s16x8*)(qp + 512 * ks);
        const int t0 = kh * (cur.ntiles >> 1);
        attn2_load_k(KA, kf + cur.h * 2048 + lane * 8, cur.b * 128, 1024 + cur.b * 8, t0, cur.ntl, cur.rsu);
        attn2_load_k(KB, kf + cur.h * 2048 + lane * 8, cur.b * 128, 1024 + cur.b * 8, t0 + 1, cur.ntl, cur.rsu);
    }
    while (u < total) {
        const int b = cur.b, h = cur.h, qrow0 = cur.qrow0, rsu = cur.rsu, ntl = cur.ntl, ntiles = cur.ntiles;
        const int rr = cur.r0 + qrow, rsq = min(max(rr - 4, 0), 56);
        int tidl = tid; asm volatile("" : "+v"(tidl));
#pragma unroll
        for (int i = 0; i < 4; ++i) { const int idx = tidl + NTHREADS * i; *(LAS u32x4*)(Vl + (idx >> 3) * AV_STR + (idx & 7) * 16) = vpre[i]; }
        if (ntiles == 26) {
#pragma unroll
            for (int i = 4; i < 13; ++i) { const int idx = tidl + NTHREADS * i; *(LAS u32x4*)(Vl + (idx >> 3) * AV_STR + (idx & 7) * 16) = vpre[i]; } }
        const LAS float* tab = tab_all + h * 480;
        const bf16_t* kbase = kf + h * 2048 + lane * 8;
        const int klat0 = b * 128, kctx0 = 1024 + b * 8;
        const int ntw = ntiles >> 1, t0 = kh * ntw;
        __syncthreads();
        f32x16 O0, O1;
#pragma unroll
        for (int i = 0; i < 16; ++i) { O0[i] = 0.f; O1[i] = 0.f; }
        float lsum = 0.f;
#pragma unroll 1
        for (int t = 0; t < ntw; t += 2) {
            { const int kt = t0 + t; const int krow = rsu + (kt >> 1);
              const int mode = kt >= ntl ? 0 : ((unsigned)(krow - rsq) >= 8u ? 4 : ((kt & 1) == qt ? 1 : 2 + qt));
              attn_one_tile(KA, Qf, Vl + (kt * 32 + 4 * hi + tr_q) * AV_STR + (16 * dgrp + 4 * tr_p) * 2, (const LAS unsigned char*)tab + (krow - rr + 7) * 128, offo, offx, O0, O1, lsum, mode, mbl); }
            __builtin_amdgcn_sched_barrier(0);
            attn2_load_k(KA, kbase, klat0, kctx0, min(t0 + t + 2, ntiles - 1), ntl, rsu);
            { const int kt = t0 + t + 1; const int krow = rsu + (kt >> 1);
              const int mode = (t + 1 >= ntw) ? 4 : (kt >= ntl ? 0 : ((unsigned)(krow - rsq) >= 8u ? 4 : ((kt & 1) == qt ? 1 : 2 + qt)));
              attn_one_tile(KB, Qf, Vl + (min(kt, ntiles - 1) * 32 + 4 * hi + tr_q) * AV_STR + (16 * dgrp + 4 * tr_p) * 2, (const LAS unsigned char*)tab + (min(max(krow - rr + 7, 0), 14)) * 128, offo, offx, O0, O1, lsum, mode, mbl); }
            __builtin_amdgcn_sched_barrier(0);
            attn2_load_k(KB, kbase, klat0, kctx0, min(t0 + t + 3, ntiles - 1), ntl, rsu);
        }
        const int un = u + T_.gsz;
        const AUnit2 nxt = attn2_decode(min(un, total - 1), nlatu);
        int tidm = tid; asm volatile("" : "+v"(tidm));
        if (un < total) attn2_load_v(vpre, qkv, nxt, tidm);
        __syncthreads();
#pragma unroll
        for (int j = 0; j < 4; ++j) {
            *(LAS f32x4*)(Ored + (size_t)((kh * 128 + 32 * qtile + l31) * 68 + 8 * j + 4 * hi)) = (f32x4){O0[4 * j], O0[4 * j + 1], O0[4 * j + 2], O0[4 * j + 3]};
            *(LAS f32x4*)(Ored + (size_t)((kh * 128 + 32 * qtile + l31) * 68 + 32 + 8 * j + 4 * hi)) = (f32x4){O1[4 * j], O1[4 * j + 1], O1[4 * j + 2], O1[4 * j + 3]}; }
        lred[(kh * 2 + hi) * 128 + 32 * qtile + l31] = lsum;
        if (un < total) {
            const bf16_t* qp = qkv + (size_t)(((nxt.qrow0 >> 5) + qtile) * 16 + nxt.h) * 2048 + lane * 8;
#pragma unroll
            for (int ks = 0; ks < 4; ++ks) Qf[ks] = *(const s16x8*)(qp + 512 * ks);
            const int t0n = kh * (nxt.ntiles >> 1);
            attn2_load_k(KA, kf + nxt.h * 2048 + lane * 8, nxt.b * 128, 1024 + nxt.b * 8, t0n, nxt.ntl, nxt.rsu);
            attn2_load_k(KB, kf + nxt.h * 2048 + lane * 8, nxt.b * 128, 1024 + nxt.b * 8, t0n + 1, nxt.ntl, nxt.rsu);
        }
        __syncthreads();
        { const int q = tid >> 2, d16 = (tid & 3) * 16;
          f32x4 s[4]; float l = 0.f;
#pragma unroll
          for (int i = 0; i < 4; ++i) s[i] = *(const LAS f32x4*)(Ored + q * 68 + d16 + 4 * i) + *(const LAS f32x4*)(Ored + (128 + q) * 68 + d16 + 4 * i);
          l = (lred[q] + lred[128 + q]) + (lred[256 + q] + lred[384 + q]);
          const float inv = 1.0f / l;
          u32x4 o0, o1; o0.x = pkb(s[0].x * inv, s[0].y * inv); o0.y = pkb(s[0].z * inv, s[0].w * inv); o0.z = pkb(s[1].x * inv, s[1].y * inv); o0.w = pkb(s[1].z * inv, s[1].w * inv);
          o1.x = pkb(s[2].x * inv, s[2].y * inv); o1.y = pkb(s[2].z * inv, s[2].w * inv); o1.z = pkb(s[3].x * inv, s[3].y * inv); o1.w = pkb(s[3].z * inv, s[3].w * inv);
          bf16_t* op = ao + (size_t)(qrow0 + q) * 1024 + h * 64 + d16; *(u32x4*)op = o0; *(u32x4*)(op + 8) = o1; }
        __syncthreads();
        u = un; cur = nxt;
    }
}


struct AUnit4 { int b, h, qrow0, r0, rsu, ntl; };
__device__ __forceinline__ AUnit4 attn4_decode(int u, int nlatu) {
    AUnit4 a;
    if (u < nlatu) { a.h = u & 15; const int brq = u >> 4; a.r0 = 4 * (brq & 15); a.b = brq >> 4; a.qrow0 = a.b * 4096 + a.r0 * 64; a.rsu = min(max(a.r0 - 4, 0), 56); a.ntl = 22; }
    else { const int v = u - nlatu; a.h = v & 15; a.b = v >> 4; a.qrow0 = NLAT + a.b * 256; a.r0 = 0; a.rsu = 0; a.ntl = 0; }
    return a;
}
__device__ __forceinline__ u32x4 attn4_load_v1(const bf16_t* vbase, const AUnit4& a, int idx) {
    const int key = idx >> 3, ch = idx & 7, kt = key >> 5, kk = key & 31;
    const int grow = kt < a.ntl ? (a.b * 4096 + min(a.rsu + (kt >> 1), 63) * 64 + 32 * (kt & 1) + kk) : (NLAT + a.b * 256 + 32 * (kt - a.ntl) + kk);
    return *(const u32x4*)(vbase + (size_t)grow * 1024 + ch * 8);
}
__device__ __forceinline__ void attn4_load_v(u32x4 (&vpre)[15], const bf16_t* qkv, const AUnit4& a, int tid) {
    const bf16_t* vbase = qkv + (size_t)2 * MTOT * 1024 + a.h * 64;
#pragma unroll
    for (int i = 0; i < 4; ++i) vpre[i] = attn4_load_v1(vbase, a, tid + NTHREADS * i);
    if (a.ntl) {
#pragma unroll
        for (int i = 4; i < 15; ++i) vpre[i] = attn4_load_v1(vbase, a, tid + NTHREADS * i);
    }
}
__device__ __forceinline__ int attn4_kt(int s, int nls, int koff, int c0) { return s < nls ? koff + s : c0 + (s - nls); }
__device__ __forceinline__ void attn4_load_k(s16x8 (&Kf)[4], const bf16_t* kfb, int klat0, int kctx0, int kt, int ntl, int rsu) {
    const int tile = kt < ntl ? klat0 + min(rsu + (kt >> 1), 63) * 2 + (kt & 1) : kctx0 + (kt - ntl);
#pragma unroll
    for (int ks = 0; ks < 4; ++ks) Kf[ks] = *(const s16x8*)(kfb + (size_t)tile * 32768 + ks * 512);
}
__device__ __forceinline__ void phase_attn4(const Params& p, int a_, bool ctx_q, LAS unsigned char* lds, const Tix T_) {
    const bf16_t* qkv = (const bf16_t*)(p.ws + OFF_BIG); bf16_t* ao = (bf16_t*)(p.ws + OFF_BIG) + (size_t)MTOT * 3072;
    const bf16_t* kf = qkv + (size_t)MTOT * 1024;
    const float* rpb = p.na_rpb + (size_t)a_ * 16 * 15 * 31;
    const int tid = T_.tid, lane = tid & 63, wave = __builtin_amdgcn_readfirstlane(tid >> 6), qtile = wave, qt = qtile & 1, qrow = qtile >> 1, l31 = lane & 31, hi = lane >> 5;
    LAS unsigned char* Vl = lds;
    LAS float* tab = (LAS float*)(lds + 138240);
    LAS float* misc = (LAS float*)(lds + 138240 + 2048);
    constexpr float LOG2E = 1.4426950408889634f;
    float mb;
    { float m = 0.f; for (int i = tid; i < 7440; i += NTHREADS) m = fmaxf(m, rpb[i]);
      float qg = 0.f, kg = 0.f; if (tid < 64) { qg = fabsf(p.na_q_norm[a_ * 64 + tid]); kg = fabsf(p.na_k_norm[a_ * 64 + tid]); }
      m = wave_max(m); qg = wave_max(qg); kg = wave_max(kg);
      if (lane == 0) { misc[wave] = m; if (wave == 0) { misc[8] = qg; misc[9] = kg; } }
      __syncthreads();
      float rm = misc[0];
#pragma unroll
      for (int w = 1; w < 8; ++w) rm = fmaxf(rm, misc[w]);
      mb = 8.0f * misc[8] * misc[9] + rm; }
    const float mbl = mb * LOG2E;
    const int nlatu = 8 * 16 * 16, total = nlatu + (ctx_q ? 8 * 16 : 0);
    const int tr_q = (lane & 15) >> 2, tr_p = lane & 3, dgrp = (lane >> 4) & 1;
    const int qcol = 32 * qt + l31, wst = min(max(qcol - 8, 0), 48);
    unsigned offo[4], offx = 0u;
#pragma unroll
    for (int j = 0; j < 4; ++j) { offo[j] = 0u;
#pragma unroll
        for (int i = 0; i < 4; ++i) { const int kcol = 32 * qt + 8 * j + 4 * hi + i; offo[j] |= (unsigned)(((unsigned)(kcol - wst) < 16u ? kcol - qcol + 15 : 31) * 4) << (8 * i); } }
#pragma unroll
    for (int i = 0; i < 4; ++i) { const int kcol = (qt == 0 ? 32 : 24) + 4 * hi + i; offx |= (unsigned)(((unsigned)(kcol - wst) < 16u ? kcol - qcol + 15 : 31) * 4) << (8 * i); }
    const int trr = tid >> 5, tdd = tid & 31;
    int u = T_.bid;
    AUnit4 cur = attn4_decode(min(u, total - 1), nlatu);
    u32x4 vpre[15]; float tabpre = 0.f;
    if (u < total) { attn4_load_v(vpre, qkv, cur, tid); if (tid < 480 && tdd < 31) tabpre = rpb[cur.h * 465 + trr * 31 + tdd]; }
    while (u < total) {
        const int b = cur.b, h = cur.h, qrow0 = cur.qrow0, rsu = cur.rsu, ntl = cur.ntl;
        const int rr = cur.r0 + qrow, rsq = min(max(rr - 4, 0), 56);
        const int nls = ntl ? 16 : 0, nseq = nls + 8, koff = 2 * (rsq - rsu), c0 = ntl;
        const bf16_t* kbase = kf + h * 2048 + lane * 8;
        const int klat0 = b * 128, kctx0 = 1024 + b * 8;
        s16x8 Qf[4], KA[4], KB[4];
        { const bf16_t* qp = qkv + (size_t)(((qrow0 >> 5) + qtile) * 16 + h) * 2048 + lane * 8;
#pragma unroll
          for (int ks = 0; ks < 4; ++ks) Qf[ks] = *(const s16x8*)(qp + 512 * ks); }
        attn4_load_k(KA, kbase, klat0, kctx0, attn4_kt(0, nls, koff, c0), ntl, rsu);
        attn4_load_k(KB, kbase, klat0, kctx0, attn4_kt(1, nls, koff, c0), ntl, rsu);
        int tidl = tid; asm volatile("" : "+v"(tidl));
#pragma unroll
        for (int i = 0; i < 4; ++i) { const int idx = tidl + NTHREADS * i; *(LAS u32x4*)(Vl + (idx >> 3) * AV_STR + (idx & 7) * 16) = vpre[i]; }
        if (ntl) {
#pragma unroll
            for (int i = 4; i < 15; ++i) { const int idx = tidl + NTHREADS * i; *(LAS u32x4*)(Vl + (idx >> 3) * AV_STR + (idx & 7) * 16) = vpre[i]; } }
        if (tid < 480) tab[tid] = tdd < 31 ? (tabpre - mb) * LOG2E : -1e30f;
        __syncthreads();
        f32x16 O0, O1;
#pragma unroll
        for (int i = 0; i < 16; ++i) { O0[i] = 0.f; O1[i] = 0.f; }
        float lsum = 0.f;
#pragma unroll 1
        for (int t = 0; t < nseq; t += 2) {
            { const int kt = attn4_kt(t, nls, koff, c0); const int krow = rsu + (kt >> 1);
              const int mode = t >= nls ? 0 : ((kt & 1) == qt ? 1 : 2 + qt);
              attn_one_tile(KA, Qf, Vl + (kt * 32 + 4 * hi + tr_q) * AV_STR + (16 * dgrp + 4 * tr_p) * 2, (const LAS unsigned char*)tab + (min(max(krow - rr + 7, 0), 14)) * 128, offo, offx, O0, O1, lsum, mode, mbl); }
            __builtin_amdgcn_sched_barrier(0);
            attn4_load_k(KA, kbase, klat0, kctx0, attn4_kt(min(t + 2, nseq - 2), nls, koff, c0), ntl, rsu);
            { const int kt = attn4_kt(t + 1, nls, koff, c0); const int krow = rsu + (kt >> 1);
              const int mode = t + 1 >= nls ? 0 : ((kt & 1) == qt ? 1 : 2 + qt);
              attn_one_tile(KB, Qf, Vl + (kt * 32 + 4 * hi + tr_q) * AV_STR + (16 * dgrp + 4 * tr_p) * 2, (const LAS unsigned char*)tab + (min(max(krow - rr + 7, 0), 14)) * 128, offo, offx, O0, O1, lsum, mode, mbl); }
            __builtin_amdgcn_sched_barrier(0);
            attn4_load_k(KB, kbase, klat0, kctx0, attn4_kt(min(t + 2, nseq - 2) + 1, nls, koff, c0), ntl, rsu);
        }
        const int un = u + T_.gsz;
        const AUnit4 nxt = attn4_decode(min(un, total - 1), nlatu);
        int tidm = tid; asm volatile("" : "+v"(tidm));
        if (un < total) { attn4_load_v(vpre, qkv, nxt, tidm); if (tid < 480 && tdd < 31) tabpre = rpb[nxt.h * 465 + trr * 31 + tdd]; }
        lsum += __shfl_xor(lsum, 32);
        { const float inv = 1.0f / lsum;
          bf16_t* op = ao + (size_t)(qrow0 + 32 * qtile + l31) * 1024 + h * 64 + 8 * hi;
          typedef unsigned u2p __attribute__((ext_vector_type(2)));
#pragma unroll
          for (int dt = 0; dt < 2; ++dt)
#pragma unroll
              for (int m = 0; m < 2; ++m) { const int j0 = 2 * m, j1 = 2 * m + 1;
                  const float* Ov = nullptr; (void)Ov;
                  unsigned ax, ay, bx, by;
                  if (dt == 0) { ax = pkb(O0[4 * j0] * inv, O0[4 * j0 + 1] * inv); ay = pkb(O0[4 * j0 + 2] * inv, O0[4 * j0 + 3] * inv); bx = pkb(O0[4 * j1] * inv, O0[4 * j1 + 1] * inv); by = pkb(O0[4 * j1 + 2] * inv, O0[4 * j1 + 3] * inv); }
                  else { ax = pkb(O1[4 * j0] * inv, O1[4 * j0 + 1] * inv); ay = pkb(O1[4 * j0 + 2] * inv, O1[4 * j0 + 3] * inv); bx = pkb(O1[4 * j1] * inv, O1[4 * j1 + 1] * inv); by = pkb(O1[4 * j1 + 2] * inv, O1[4 * j1 + 3] * inv); }
                  const u2p rx = __builtin_amdgcn_permlane32_swap(ax, bx, false, false), ry = __builtin_amdgcn_permlane32_swap(ay, by, false, false);
                  u32x4 o; o.x = rx.x; o.y = ry.x; o.z = rx.y; o.w = ry.y;
                  *(u32x4*)(op + 32 * dt + 16 * m) = o; } }
        __syncthreads();
        u = un; cur = nxt;
    }
}

constexpr int SP_RS = 320;
__device__ __forceinline__ void phase_spatial_mfma(const Params& p, int sl, int M, LAS unsigned char* lds, const Tix T_, const bool dummy = false) {
    bf16_t* vb = (bf16_t*)(p.ws + OFF_BIG); const float* lnacc = (const float*)(p.ws + OFF_LNACC) + (size_t)sl * MTOT * 2;
    const float* lng = p.sg_ln_g + sl * 3072; const float* lnb = p.sg_ln_b + sl * 3072;
    const int tid = T_.tid, lane = tid & 63, wave = __builtin_amdgcn_readfirstlane(tid >> 6), pt = wave & 3, cth = wave >> 2, l31 = lane & 31, hi = lane >> 5;
    const int tr_q = (lane & 15) >> 2, tr_p = lane & 3, dgrp = (lane >> 4) & 1;
    const int nunits = (M / 128) * 24;
    const int c8 = (tid & 15) * 8;
    s16x8 wx[8]; u32x4 vw[4]; f32x2 st2[4]; f32x4 g0, g1, b0, b1; float bs;
    const bf16_t* wsf = (const bf16_t*)(p.ws + OFF_WSF);
    const int NC = M / 128; int gload = -1;
#define SP_LOAD(uu) do { const int g_ = (uu) / NC, nc_ = (uu) % NC, r0_ = nc_ * 128; \
        if (g_ != gload) { gload = g_; \
            const bf16_t* wp_ = wsf + ((size_t)((sl * 24 + g_) * 4 + pt) * 8) * 512 + lane * 8; \
            _Pragma("unroll") for (int ks = 0; ks < 8; ++ks) wx[ks] = *(const s16x8*)(wp_ + ks * 512); \
            g0 = *(const f32x4*)(lng + g_ * 128 + c8); g1 = *(const f32x4*)(lng + g_ * 128 + c8 + 4); b0 = *(const f32x4*)(lnb + g_ * 128 + c8); b1 = *(const f32x4*)(lnb + g_ * 128 + c8 + 4); \
            bs = p.sg_b_s[((size_t)sl * 24 + g_) * 128 + 32 * pt + l31]; } \
        _Pragma("unroll") for (int i = 0; i < 4; ++i) { const int q_ = (tid + NTHREADS * i) >> 4; \
            vw[i] = *(const u32x4*)(vb + (size_t)(r0_ + q_) * 3072 + g_ * 128 + c8); st2[i] = *(const f32x2*)(lnacc + 2 * (r0_ + q_)); } } while (0)
    int u = (int)(((long)T_.bid * nunits) / T_.gsz), buf = 0; const int uend = (int)(((long)(T_.bid + 1) * nunits) / T_.gsz);
    if (u < uend) SP_LOAD(u);
    while (u < uend) {
        const int g = u / NC, nc = u % NC, r0 = nc * 128;
        LAS unsigned char* tile = lds + buf * (128 * SP_RS);
#pragma unroll
        for (int i = 0; i < 4; ++i) { const int q = (tid + NTHREADS * i) >> 4; const u32x4 w = vw[i];
            const float mean = st2[i].x * (1.0f / 3072.0f), rstd = __builtin_amdgcn_rsqf(fmaxf(st2[i].y * (1.0f / 3072.0f) - mean * mean, 0.f) + 1e-6f);
            u32x4 o;
            o.x = pkb((bf2f(w.x & 0xffffu) - mean) * rstd * g0.x + b0.x, (bf2f(w.x >> 16) - mean) * rstd * g0.y + b0.y);
            o.y = pkb((bf2f(w.y & 0xffffu) - mean) * rstd * g0.z + b0.z, (bf2f(w.y >> 16) - mean) * rstd * g0.w + b0.w);
            o.z = pkb((bf2f(w.z & 0xffffu) - mean) * rstd * g1.x + b1.x, (bf2f(w.z >> 16) - mean) * rstd * g1.y + b1.y);
            o.w = pkb((bf2f(w.w & 0xffffu) - mean) * rstd * g1.z + b1.z, (bf2f(w.w >> 16) - mean) * rstd * g1.w + b1.w);
            *(LAS u32x4*)(tile + q * SP_RS + c8 * 2) = o; }
        s16x8 Wf[8];
#pragma unroll
        for (int ks = 0; ks < 8; ++ks) Wf[ks] = wx[ks];
        const float bsc = bs;
        __syncthreads();
        const int un = u + 1;
        if (un < uend) SP_LOAD(un);
        __builtin_amdgcn_sched_barrier(0);
#pragma unroll
        for (int cc = 0; cc < 2; ++cc) { const int ct = 2 * cth + cc;
            f32x16 acc;
#pragma unroll
            for (int i = 0; i < 16; ++i) acc[i] = 0.f;
            const LAS unsigned char* ab = tile + (8 * hi + tr_q) * SP_RS + (32 * ct + 16 * dgrp + 4 * tr_p) * 2;
            s16x8 Af[8];
#pragma unroll
            for (int ks = 0; ks < 8; ++ks) Af[ks] = tr_pair(ab + 16 * ks * SP_RS, 4 * SP_RS);
            __builtin_amdgcn_sched_barrier(0);
#pragma unroll
            for (int ks = 0; ks < 8; ++ks) acc = MFMA32(Af[ks], Wf[ks], acc);
            bf16_t* orow = (dummy ? vb + (size_t)MTOT * 3072 + (size_t)((r0 + 32 * pt + l31) & 8191) * 3072 : vb + (size_t)(r0 + 32 * pt + l31) * 3072) + g * 128 + 32 * ct + 4 * hi;
#pragma unroll
            for (int j = 0; j < 4; ++j) { u32x2 o; o.x = pkb(acc[4 * j] + bsc, acc[4 * j + 1] + bsc); o.y = pkb(acc[4 * j + 2] + bsc, acc[4 * j + 3] + bsc); *(u32x2*)(orow + 8 * j) = o; }
        }
        u = un; buf ^= 1;
    }
#undef SP_LOAD
    __syncthreads();
}

__device__ __forceinline__ int epi_row(int rowbase, int idx) { return rowbase + 128 * (idx >> 2) + 16 * (idx & 3); }
template <class F> struct EpiG {
    static constexpr bool PERM = false, AFTER_DRAIN = false;
    typedef typename F::Pre Pre;
    F f;
    __device__ __forceinline__ void prefetch(Pre& pre, const Unit& u, int wr, int wc, int fr, int fq) const {
        f.prefetch(pre, u, u.pn * 256 + 64 * wc + 8 * fq, u.pm * 256 + wr * 64 + fr); }
    __device__ __forceinline__ void operator()(const f32x4 (&acc)[2][2][4][2], const Unit& u, int wr, int wc, int fr, int fq, const Pre& pre) const {
        F g = f; const int colb = u.pn * 256 + 64 * wc + 8 * fq, rowbase = u.pm * 256 + wr * 64 + fr;
        g.begin(u, colb, fq, rowbase, pre);
#pragma unroll
        for (int ai = 0; ai < 2; ++ai)
#pragma unroll
            for (int m = 0; m < 4; ++m) {
                g.row(ai * 4 + m, rowbase + ai * 128 + m * 16, colb, acc[ai][0][m][0], acc[ai][0][m][1], acc[ai][1][m][0], acc[ai][1][m][1]);
                asm volatile("" ::: "memory"); }
    }
};
struct PreSB { float v[8]; f32x4 bz[4];
    __device__ __forceinline__ void load(const float* ssq, int rowbase, const float* bp) {
#pragma unroll
        for (int i = 0; i < 8; ++i) v[i] = ssq[epi_row(rowbase, i)];
        bz[0] = *(const f32x4*)bp; bz[1] = *(const f32x4*)(bp + 4); bz[2] = *(const f32x4*)(bp + 32); bz[3] = *(const f32x4*)(bp + 36); } };
#ifdef NT_STORE
__device__ __forceinline__ void store8_bf16(bf16_t* o, const f32x4 a, const f32x4 b) { u32x4 w; w.x = pk2(a.x, a.y); w.y = pk2(a.z, a.w); w.z = pk2(b.x, b.y); w.w = pk2(b.z, b.w); __builtin_nontemporal_store(w, (u32x4*)o); }
#else
__device__ __forceinline__ void store8_bf16(bf16_t* o, const f32x4 a, const f32x4 b) { u32x4 w; w.x = pk2(a.x, a.y); w.y = pk2(a.z, a.w); w.z = pk2(b.x, b.y); w.w = pk2(b.z, b.w); *(u32x4*)o = w; }
#endif
__device__ __forceinline__ float sumsq4(const f32x4 x) { return (x.x * x.x + x.y * x.y) + (x.z * x.z + x.w * x.w); }
__device__ __forceinline__ float sum4(const f32x4 x) { return (x.x + x.y) + (x.z + x.w); }
__device__ __forceinline__ float rstd_from(float ssq) { return __builtin_amdgcn_rsqf(ssq * (1.0f / 1024.0f) + 1e-6f); }
__device__ __forceinline__ void atomic_addf(float* p, float v) { __hip_atomic_fetch_add(p, v, __ATOMIC_RELAXED, __HIP_MEMORY_SCOPE_AGENT); }
struct FQKV { static constexpr bool IDEMP = true; bf16_t* O; const float* qg; const float* kg; const float* ssq; const float* bias;
    typedef PreSB Pre;
    f32x4 gn[4], bz[4]; int sect; float rqv[8];
    __device__ __forceinline__ void prefetch(Pre& pre, const Unit& u, int colb, int rowbase) const { pre.load(ssq, rowbase, bias + (size_t)min(u.pm >> 4, 8) * 3072 + colb); }
    __device__ __forceinline__ void begin(const Unit& u, int colb, int fq, int rowbase, const Pre& pre) {
#pragma unroll
        for (int i = 0; i < 8; ++i) rqv[i] = pre.v[i];
#pragma unroll
        for (int i = 0; i < 4; ++i) bz[i] = pre.bz[i];
        sect = u.pn >> 2;
        if (sect < 2) { const float* gp = (sect == 0 ? qg : kg) + 8 * fq; const float mul = sect == 0 ? 0.125f * 1.4426950408889634f : 1.0f;
            gn[0] = *(const f32x4*)gp * mul; gn[1] = *(const f32x4*)(gp + 4) * mul; gn[2] = *(const f32x4*)(gp + 32) * mul; gn[3] = *(const f32x4*)(gp + 36) * mul; } }
    __device__ __forceinline__ void row(int idx, int row, int colb, f32x4 a0, f32x4 b0, f32x4 a1, f32x4 b1) {
        const float rs = rstd_from(rqv[idx]);
        a0 = a0 * rs + bz[0]; b0 = b0 * rs + bz[1]; a1 = a1 * rs + bz[2]; b1 = b1 * rs + bz[3];
        if (sect < 2) { float ss = (sumsq4(a0) + sumsq4(b0)) + (sumsq4(a1) + sumsq4(b1));
            ss += __shfl_xor(ss, 16); ss += __shfl_xor(ss, 32);
            const float r2 = __builtin_amdgcn_rsqf(ss * (1.0f / 64.0f) + 1e-6f);
            a0 = a0 * r2 * gn[0]; b0 = b0 * r2 * gn[1]; a1 = a1 * r2 * gn[2]; b1 = b1 * r2 * gn[3]; }
        if (sect < 2) {
            const int within = colb & 1023, h = within >> 6, fq = (within >> 3) & 7;
            bf16_t* op = O + (size_t)sect * MTOT * 1024 + ((size_t)((row >> 5) * 16 + h) * 4 + (fq >> 1)) * 512 + ((fq & 1) * 32 + (row & 31)) * 8;
            store8_bf16(op, a0, b0); store8_bf16(op + 2 * 512, a1, b1);
        } else { bf16_t* op = O + (size_t)2 * MTOT * 1024 + (size_t)row * 1024 + (colb - 2048); store8_bf16(op, a0, b0); store8_bf16(op + 32, a1, b1); } } };
struct FSqrelu { static constexpr bool IDEMP = true; bf16_t* O; const float* ssq; const float* bias;
    typedef PreSB Pre;
    f32x4 bz[4]; float rqv[8];
    __device__ __forceinline__ void prefetch(Pre& pre, const Unit& u, int colb, int rowbase) const { pre.load(ssq, rowbase, bias + (size_t)min(u.pm >> 4, 8) * 4096 + colb); }
    __device__ __forceinline__ void begin(const Unit& u, int colb, int fq, int rowbase, const Pre& pre) {
#pragma unroll
        for (int i = 0; i < 8; ++i) rqv[i] = pre.v[i];
#pragma unroll
        for (int i = 0; i < 4; ++i) bz[i] = pre.bz[i]; }
    __device__ __forceinline__ void row(int idx, int row, int colb, f32x4 a0, f32x4 b0, f32x4 a1, f32x4 b1) {
        const float rs = rstd_from(rqv[idx]); const f32x4 z = (f32x4){0.f, 0.f, 0.f, 0.f};
        a0 = __builtin_elementwise_max(a0 * rs + bz[0], z); b0 = __builtin_elementwise_max(b0 * rs + bz[1], z); a1 = __builtin_elementwise_max(a1 * rs + bz[2], z); b1 = __builtin_elementwise_max(b1 * rs + bz[3], z);
        bf16_t* op = O + (size_t)row * 4096 + colb; store8_bf16(op, a0 * a0, b0 * b0); store8_bf16(op + 32, a1 * a1, b1 * b1); } };
struct FGeluV { static constexpr bool IDEMP = false; bf16_t* O; const float* ssq; const float* bias; float* lnacc;
    typedef PreSB Pre;
    f32x4 bz[4]; int fq_; float rqv[8];
    __device__ __forceinline__ void prefetch(Pre& pre, const Unit& u, int colb, int rowbase) const { pre.load(ssq, rowbase, bias + (size_t)min(u.pm >> 4, 8) * 6144 + colb); }
    __device__ __forceinline__ void begin(const Unit& u, int colb, int fq, int rowbase, const Pre& pre) { fq_ = fq;
#pragma unroll
        for (int i = 0; i < 8; ++i) rqv[i] = pre.v[i];
#pragma unroll
        for (int i = 0; i < 4; ++i) bz[i] = pre.bz[i]; }
    __device__ __forceinline__ void row(int idx, int row, int colb, f32x4 a0, f32x4 b0, f32x4 a1, f32x4 b1) {
        const float rs = rstd_from(rqv[idx]);
        a0 = gelu4(a0 * rs + bz[0]); b0 = gelu4(b0 * rs + bz[1]); a1 = gelu4(a1 * rs + bz[2]); b1 = gelu4(b1 * rs + bz[3]);
        bf16_t* op = O + (size_t)row * 3072 + colb; store8_bf16(op, a0, b0); store8_bf16(op + 32, a1, b1);
        float s1 = (sum4(a0) + sum4(b0)) + (sum4(a1) + sum4(b1)), s2 = (sumsq4(a0) + sumsq4(b0)) + (sumsq4(a1) + sumsq4(b1));
        s1 += __shfl_xor(s1, 16); s1 += __shfl_xor(s1, 32); s2 += __shfl_xor(s2, 16); s2 += __shfl_xor(s2, 32);
        if (fq_ == 0) { atomic_addf(lnacc + 2 * (size_t)row, s1); atomic_addf(lnacc + 2 * (size_t)row + 1, s2); } } };
struct FGeluU { static constexpr bool IDEMP = false; bf16_t* O; const float* ssq; const float* bias;
    typedef PreSB Pre;
    f32x4 bz[4]; float rqv[8]; u32x4 sv[2][2]; int rowbase_;
    __device__ __forceinline__ void prefetch(Pre& pre, const Unit& u, int colb, int rowbase) const { pre.load(ssq, rowbase, bias + (size_t)min(u.pm >> 4, 8) * 6144 + colb); }
    __device__ __forceinline__ void fetch(int idx, int colb) { const bf16_t* op = O + (size_t)epi_row(rowbase_, idx) * 3072 + colb; sv[idx & 1][0] = *(const u32x4*)op; sv[idx & 1][1] = *(const u32x4*)(op + 32); }
    __device__ __forceinline__ void begin(const Unit& u, int colb, int fq, int rowbase, const Pre& pre) { rowbase_ = rowbase; fetch(0, colb);
#pragma unroll
        for (int i = 0; i < 8; ++i) rqv[i] = pre.v[i];
#pragma unroll
        for (int i = 0; i < 4; ++i) bz[i] = pre.bz[i]; }
    __device__ __forceinline__ static f32x4 lo4(const u32x4 s) { return (f32x4){bf2f(s.x & 0xffffu), bf2f(s.x >> 16), bf2f(s.y & 0xffffu), bf2f(s.y >> 16)}; }
    __device__ __forceinline__ static f32x4 hi4(const u32x4 s) { return (f32x4){bf2f(s.z & 0xffffu), bf2f(s.z >> 16), bf2f(s.w & 0xffffu), bf2f(s.w >> 16)}; }
    __device__ __forceinline__ void row(int idx, int row, int colb, f32x4 a0, f32x4 b0, f32x4 a1, f32x4 b1) {
        if (idx < 7) fetch(idx + 1, colb);
        const float rs = rstd_from(rqv[idx]);
        bf16_t* op = O + (size_t)row * 3072 + colb; const u32x4 sv0 = sv[idx & 1][0], sv1 = sv[idx & 1][1];
        a0 = gelu4(a0 * rs + bz[0]) * lo4(sv0); b0 = gelu4(b0 * rs + bz[1]) * hi4(sv0); a1 = gelu4(a1 * rs + bz[2]) * lo4(sv1); b1 = gelu4(b1 * rs + bz[3]) * hi4(sv1);
        store8_bf16(op, a0, b0); store8_bf16(op + 32, a1, b1); } };
struct FResid { static constexpr bool IDEMP = false; const float* inl; const float* inc; float* outl; float* outc; const float* gate;
    const float* gsn; bf16_t* xb; float* ssqn;
    struct Pre { f32x4 gz[4]; };
    f32x4 gz[4], gsz[4], xin[2][4]; int fq_, rowbase_;
    __device__ __forceinline__ void prefetch(Pre& pre, const Unit& u, int colb, int rowbase) const { const float* gp = gate + (size_t)min(u.pm >> 4, 8) * 6144 + colb;
        pre.gz[0] = *(const f32x4*)gp; pre.gz[1] = *(const f32x4*)(gp + 4); pre.gz[2] = *(const f32x4*)(gp + 32); pre.gz[3] = *(const f32x4*)(gp + 36); }
    __device__ __forceinline__ void fetch(int idx, int colb) { const int row = epi_row(rowbase_, idx);
        const float* ip = row < NLAT ? inl + (size_t)row * 1024 + colb : inc + (size_t)(row - NLAT) * 1024 + colb;
        xin[idx & 1][0] = *(const f32x4*)ip; xin[idx & 1][1] = *(const f32x4*)(ip + 4); xin[idx & 1][2] = *(const f32x4*)(ip + 32); xin[idx & 1][3] = *(const f32x4*)(ip + 36); }
    __device__ __forceinline__ void begin(const Unit& u, int colb, int fq, int rowbase, const Pre& pre) { const int b = min(u.pm >> 4, 8); fq_ = fq; rowbase_ = rowbase; fetch(0, colb);
#pragma unroll
        for (int i = 0; i < 4; ++i) gz[i] = pre.gz[i];
        if (gsn) { const float* sp = gsn + (size_t)b * 1024 + colb; gsz[0] = *(const f32x4*)sp; gsz[1] = *(const f32x4*)(sp + 4); gsz[2] = *(const f32x4*)(sp + 32); gsz[3] = *(const f32x4*)(sp + 36); } }
    __device__ __forceinline__ void row(int idx, int row, int colb, f32x4 a0, f32x4 b0, f32x4 a1, f32x4 b1) {
        if (idx < 7) fetch(idx + 1, colb);
        float* op = row < NLAT ? outl + (size_t)row * 1024 + colb : outc + (size_t)(row - NLAT) * 1024 + colb;
        a0 = xin[idx & 1][0] + gz[0] * a0; b0 = xin[idx & 1][1] + gz[1] * b0; a1 = xin[idx & 1][2] + gz[2] * a1; b1 = xin[idx & 1][3] + gz[3] * b1;
        *(f32x4*)op = a0; *(f32x4*)(op + 4) = b0; *(f32x4*)(op + 32) = a1; *(f32x4*)(op + 36) = b1;
        if (gsn) { float ss = (sumsq4(a0) + sumsq4(b0)) + (sumsq4(a1) + sumsq4(b1));
            ss += __shfl_xor(ss, 16); ss += __shfl_xor(ss, 32);
            if (fq_ == 0) atomic_addf(ssqn + row, ss);
            bf16_t* xp = xb + (size_t)row * 1024 + colb; store8_bf16(xp, a0 * gsz[0], b0 * gsz[1]); store8_bf16(xp + 32, a1 * gsz[2], b1 * gsz[3]); } } };

template <class F> __device__ __forceinline__ void run_gemm(LAS unsigned char* lds, const bf16_t* A, const bf16_t* Bt, int M, int N, int K, const F& f, const Tix T_) {
    pg8::StaticOrder S; S.init(M, N, T_.gsz, T_.bid);
    pg8::Gemm g; g.A = A; g.Bt = Bt; g.M = M; g.N = N; g.K = K; g.ld = K;
#ifdef STAGGER_US
    if ((T_.bid >> 3) & 1) { const unsigned long long t0 = __builtin_amdgcn_s_memrealtime(); while (__builtin_amdgcn_s_memrealtime() - t0 < (unsigned long long)(STAGGER_US * 100)) __builtin_amdgcn_s_sleep(8); }
#endif
    EpiG<F> E; E.f = f;
    pg8::gemm_phase<EpiG<F>, pg8::StaticOrder, true, true>(lds, g, S, E, T_.tid);
}


struct FPartial { static constexpr bool IDEMP = true; bf16_t* part; int klen;
    struct Pre { int dummy; };
    bf16_t* base_;
    __device__ __forceinline__ void prefetch(Pre& pre, const Unit& u, int colb, int rowbase) const { pre.dummy = 0; }
    __device__ __forceinline__ void begin(const Unit& u, int colb, int fq, int rowbase, const Pre& pre) { base_ = part + (size_t)(u.ko / klen) * 2048 * 1024; }
    __device__ __forceinline__ void row(int idx, int row, int colb, f32x4 a0, f32x4 b0, f32x4 a1, f32x4 b1) {
        bf16_t* op = base_ + (size_t)(row - NLAT) * 1024 + colb; store8_bf16(op, a0, b0); store8_bf16(op + 32, a1, b1); } };
__device__ __forceinline__ void run_gemm_ctx_split(LAS unsigned char* lds, const bf16_t* A, const bf16_t* Bt, bf16_t* part, int K, const Tix T_) {
    pg8::SplitOrder S; S.init(8, 4, K >> 9, NLAT / 256, 512, T_.gsz, T_.bid);
    pg8::Gemm g; g.A = A; g.Bt = Bt; g.M = MTOT; g.N = 1024; g.K = 512; g.ld = K;
    FPartial f; f.part = part; f.klen = 512;
    EpiG<FPartial> E; E.f = f;
    pg8::gemm_phase<EpiG<FPartial>, pg8::SplitOrder, true, true>(lds, g, S, E, T_.tid);
}
__device__ __forceinline__ void phase_ctxfin(const Params& p, int L, bool after_mlp, const Tix T_) {
    const bf16_t* part = (const bf16_t*)(p.ws + OFF_PART); float* ctxr = (float*)(p.ws + OFF_CTXR);
    const float* gate = (const float*)(p.ws + OFF_MODS) + (size_t)(L * 9 + 8) * 6144 + (after_mlp ? 5120 : 2048);
    const int nn = after_mlp ? 2 * L + 2 : 2 * L + 1;
    const float* gsn = (const float*)(p.ws + OFF_GS) + (size_t)(nn * 9 + 8) * 1024;
    bf16_t* xb = (bf16_t*)(p.ws + OFF_HB); float* ssqn = (float*)(p.ws + OFF_SSQ) + (size_t)nn * MTOT;
    const int lane = T_.tid & 63, gw = T_.bid * 8 + (T_.tid >> 6), NGW = T_.gsz * 8;
    for (int row = gw; row < 2048; row += NGW) {
        u32x2 pa[4][8]; f32x4 xv[4], gv[4], sv[4];
#pragma unroll
        for (int j = 0; j < 4; ++j) { const int col = 4 * lane + 256 * j; const size_t o = (size_t)row * 1024 + col;
#pragma unroll
            for (int k = 0; k < 6; ++k) pa[j][k] = *(const u32x2*)(part + (size_t)k * 2048 * 1024 + o);
#pragma unroll
            for (int k = 6; k < 8; ++k) pa[j][k] = after_mlp ? *(const u32x2*)(part + (size_t)k * 2048 * 1024 + o) : (u32x2){0u, 0u};
            xv[j] = *(const f32x4*)(ctxr + o); gv[j] = *(const f32x4*)(gate + col); sv[j] = *(const f32x4*)(gsn + col); }
        __builtin_amdgcn_sched_barrier(0);
        float ss = 0.f;
#pragma unroll
        for (int j = 0; j < 4; ++j) { const int col = 4 * lane + 256 * j; const size_t o = (size_t)row * 1024 + col;
            f32x4 a = (f32x4){0.f, 0.f, 0.f, 0.f};
#pragma unroll
            for (int k = 0; k < 8; ++k) a += (f32x4){bf2f(pa[j][k].x & 0xffffu), bf2f(pa[j][k].x >> 16), bf2f(pa[j][k].y & 0xffffu), bf2f(pa[j][k].y >> 16)};
            const f32x4 x = xv[j] + gv[j] * a;
            *(f32x4*)(ctxr + o) = x; ss += sumsq4(x);
            const f32x4 xs = x * sv[j];
            u32x2 w; w.x = pk2(xs.x, xs.y); w.y = pk2(xs.z, xs.w);
            *(u32x2*)(xb + (size_t)(NLAT + row) * 1024 + col) = w; }
        ss = wave_sum(ss);
        if (lane == 0) ssqn[NLAT + row] = ss;
    }
}

enum { OP_QKV, OP_ATTN, OP_MIXOUT, OP_MLP1, OP_MLP2, OP_VGEMM, OP_SPATIAL, OP_UGEMM, OP_PROLOGUE, OP_PHASE0B, OP_CTXFIN, OP_CTXFIN_MIX };

__device__ __forceinline__ void decode_phase(int ph, int& L, int& op) {
    L = 0; op = ph == 0 ? OP_PROLOGUE : OP_PHASE0B;
    if (ph > 1) {
        int q = ph - 2;
        if (q < 6) { L = 0; } else if (q < 14) { L = 1; q -= 6; } else if (q < 19) { L = 2; q -= 14; } else { L = 3; q -= 19; }
        if ((L & 1) == 0) op = q == 0 ? OP_QKV : q == 1 ? OP_ATTN : q == 2 ? OP_MIXOUT : q == 3 ? OP_MLP1 : q == 4 ? OP_MLP2 : OP_CTXFIN;
        else if (L == 1) op = q == 0 ? OP_VGEMM : q == 1 ? OP_SPATIAL : q == 2 ? OP_UGEMM : q == 3 ? OP_MIXOUT : q == 4 ? OP_CTXFIN_MIX : q == 5 ? OP_MLP1 : q == 6 ? OP_MLP2 : OP_CTXFIN;
        else op = q == 0 ? OP_VGEMM : q == 1 ? OP_SPATIAL : q == 2 ? OP_UGEMM : q == 3 ? OP_MIXOUT : q == 4 ? OP_MLP1 : OP_MLP2;
    }
}

__device__ __forceinline__ void run_phase(const Params& p, int ph, LAS unsigned char* lds, const Tix T_) {
    int L, op; decode_phase(ph, L, op);
#ifdef ONLY_OP
    op = ONLY_OP;
#endif
    const int mi = L >> 1;
    const bool attnL = (L & 1) == 0;
    const int Mfull = L < 2 ? MTOT : NLAT;
    const float* modsl = (const float*)(p.ws + OFF_MODS) + (size_t)L * 9 * 6144;
    float* ctxr = (float*)(p.ws + OFF_CTXR);
    bf16_t* hb = (bf16_t*)(p.ws + OFF_HB); bf16_t* big = (bf16_t*)(p.ws + OFF_BIG);
    float* ssq = (float*)(p.ws + OFF_SSQ); const float* gs = (const float*)(p.ws + OFF_GS);
    const bool first = (L == 0);
    switch (op) {
    case OP_PROLOGUE: phase_zero(p, T_); phase_mods(p, lds, T_); __syncthreads(); phase_convert(p, lds, T_); break;
    case OP_PHASE0B: phase_0b(p, lds, T_); break;
    case OP_QKV: { FQKV f; f.O = big; f.qg = p.na_q_norm + mi * 64; f.kg = p.na_k_norm + mi * 64; f.ssq = ssq + (size_t)(2 * L) * MTOT; f.bias = (const float*)(p.ws + OFF_BQKV) + (size_t)mi * 9 * 3072;
        run_gemm(lds, hb, (const bf16_t*)(p.ws + OFF_QKVT) + (size_t)mi * 3072 * 1024, MTOT, 3072, 1024, f, T_); } break;
#ifdef REP_ATTN_DUMMY
    case OP_ATTN: phase_attn_mfma(p, mi, L == 0, lds, T_, 1); __syncthreads(); phase_attn_mfma(p, mi, L == 0, lds, T_); break;
#else
    case OP_ATTN: phase_attn4(p, mi, L == 0, lds, T_); break;
#endif
    case OP_MIXOUT: case OP_MLP2: {
        FResid f; const bool mo = (op == OP_MIXOUT);
        f.inl = (first && mo) ? p.x : p.out; f.inc = (first && mo) ? p.ctx : ctxr; f.outl = p.out; f.outc = ctxr; f.gate = modsl + (mo ? 2048 : 5120);
        const int nn = mo ? 2 * L + 1 : 2 * L + 2;
        const bool has_next = nn < 8 && !(nn == 6 + 0 && false);
        f.gsn = has_next ? gs + (size_t)nn * 9 * 1024 : nullptr; f.xb = hb; f.ssqn = ssq + (size_t)(has_next ? nn : 0) * MTOT;
        const bf16_t* A; const bf16_t* Bt; int K;
        if (!mo) { A = big; Bt = (const bf16_t*)(p.ws + OFF_W2T) + (size_t)L * 1024 * 4096; K = 4096; }
        else if (attnL) { A = big + (size_t)MTOT * 3072; Bt = (const bf16_t*)(p.ws + OFF_WOT) + (size_t)mi * 1024 * 1024; K = 1024; }
        else { A = big; Bt = (const bf16_t*)(p.ws + OFF_SGOT) + (size_t)mi * 1024 * 3072; K = 3072; }
        if ((!mo && L < 2) || (mo && L == 1)) { run_gemm(lds, A, Bt, NLAT, 1024, K, f, T_); __syncthreads(); run_gemm_ctx_split(lds, A, Bt, (bf16_t*)(p.ws + OFF_PART), K, T_); }
        else run_gemm(lds, A, Bt, Mfull, 1024, K, f, T_); } break;
    case OP_CTXFIN: phase_ctxfin(p, L, true, T_); break;
    case OP_CTXFIN_MIX: phase_ctxfin(p, L, false, T_); break;
    case OP_MLP1: { FSqrelu f; f.O = big; f.ssq = ssq + (size_t)(2 * L + 1) * MTOT; f.bias = (const float*)(p.ws + OFF_BMLP) + (size_t)L * 9 * 4096;
        run_gemm(lds, hb, (const bf16_t*)(p.ws + OFF_W1T) + (size_t)L * 4096 * 1024, Mfull, 4096, 1024, f, T_); } break;
    case OP_VGEMM: { FGeluV f; f.O = big; f.ssq = ssq + (size_t)(2 * L) * MTOT; f.bias = (const float*)(p.ws + OFF_BWIN) + (size_t)mi * 9 * 6144 + 3072; f.lnacc = (float*)(p.ws + OFF_LNACC) + (size_t)mi * MTOT * 2;
        run_gemm(lds, hb, (const bf16_t*)(p.ws + OFF_WINT) + (size_t)mi * 6144 * 1024 + (size_t)3072 * 1024, Mfull, 3072, 1024, f, T_); } break;
#ifdef REP_SPATIAL
    case OP_SPATIAL: phase_spatial_mfma(p, mi, Mfull, lds, T_, true); __syncthreads(); phase_spatial_mfma(p, mi, Mfull, lds, T_); break;
#else
    case OP_SPATIAL: phase_spatial_mfma(p, mi, Mfull, lds, T_); break;
#endif
    case OP_UGEMM: { FGeluU f; f.O = big; f.ssq = ssq + (size_t)(2 * L) * MTOT; f.bias = (const float*)(p.ws + OFF_BWIN) + (size_t)mi * 9 * 6144;
        run_gemm(lds, hb, (const bf16_t*)(p.ws + OFF_WINT) + (size_t)mi * 6144 * 1024, Mfull, 3072, 1024, f, T_); } break;
    default: break;
    }
}

#ifndef ONE_LAUNCH
#define ONE_LAUNCH 1
#endif
__global__ void __launch_bounds__(NTHREADS) mk(Params p0) {
    extern __shared__ __attribute__((aligned(16))) unsigned char lds_raw[];
    LAS unsigned char* lds = (LAS unsigned char*)lds_raw;
#if ONE_LAUNCH
    cg::grid_group grid = cg::this_grid();
    if (p0.ph_lo < 0) grid.sync();
    volatile LAS unsigned* st = (volatile LAS unsigned*)(lds + LDS_ST_OFF);
    if (threadIdx.x == 0) { st[0] = 0u; st[1] = 0u; }
    __syncthreads();
    const XcdBarrier xbar = xcd_barrier_post((unsigned*)(p0.ws + OFF_BAR), st);
    bool first_it = true, repeated = false;
    for (int ph = p0.ph_lo; ph < p0.ph_hi; ) {
        if (!first_it) xcd_barrier(xbar);
#ifdef EXTRA_SYNC
        if (ph == 3) { for (int e = 0; e < EXTRA_SYNC; ++e) xcd_barrier(xbar); }
#endif
        first_it = false;
        Tix T_; T_.tid = threadIdx.x; T_.bid = blockIdx.x; T_.gsz = gridDim.x;
        size_t z = 0;
        asm volatile("" : "+v"(T_.tid)); asm volatile("" : "+s"(T_.bid), "+s"(T_.gsz), "+s"(z));
        Params p = p0;
        { const float** pp = (const float**)&p;
#pragma unroll
          for (int i = 0; i < 22; ++i) pp[i] += z; }
        p.out += z; p.ws += z;
        run_phase(p, ph, lds, T_);
        __syncthreads();
        if (REP_MASK != 0) { int L_, op_; decode_phase(ph, L_, op_); if (((REP_MASK >> op_) & 1) && !repeated) { repeated = true; continue; } }
        repeated = false; ++ph;
    }
#else
    Tix T_; T_.tid = threadIdx.x; T_.bid = blockIdx.x; T_.gsz = gridDim.x;
    run_phase(p0, p0.ph_lo, lds, T_);
#endif
}

extern "C" void kernel_launch(void* const* d_in, const int* in_sizes, int n_in, void* d_out, int out_size, void* d_ws, size_t ws_size, hipStream_t stream) {
    static int grid = 0;
    if (grid == 0) {
        if (n_in != 22 || ws_size < WS_END) { fprintf(stderr, "kernel_launch: unexpected n_in %d or ws_size %zu (< %zu)\n", n_in, ws_size, (size_t)WS_END); grid = -1; return; }
        int dev = 0, cus = 0, per_cu = 0;
        hipGetDevice(&dev); hipDeviceGetAttribute(&cus, hipDeviceAttributeMultiprocessorCount, dev);
        if (hipFuncSetAttribute((const void*)mk, hipFuncAttributeMaxDynamicSharedMemorySize, LDS_BYTES) != hipSuccess) { fprintf(stderr, "kernel_launch: hipFuncSetAttribute failed\n"); grid = -1; return; }
        if (hipOccupancyMaxActiveBlocksPerMultiprocessor(&per_cu, (const void*)mk, NTHREADS, LDS_BYTES) != hipSuccess || per_cu < 1) { fprintf(stderr, "kernel_launch: occupancy query says %d\n", per_cu); per_cu = 1; }
        (void)hipGetLastError();
        grid = cus;
    }
    if (grid < 0) return;
    if (hipMemsetAsync((unsigned char*)d_ws + OFF_BAR, 0, 16384, stream) != hipSuccess) { fprintf(stderr, "kernel_launch: memset of the barrier words failed\n"); return; }
    Params p{};
    const float** pp = (const float**)&p;
    for (int i = 0; i < 22; ++i) pp[i] = (const float*)d_in[i];
    p.out = (float*)d_out; p.ws = (unsigned char*)d_ws;
#if ONE_LAUNCH
    p.ph_lo = 0; p.ph_hi = NPH;
    void* args[] = {&p};
    hipError_t e = hipLaunchCooperativeKernel((void*)mk, dim3(grid), dim3(NTHREADS), args, LDS_BYTES, stream);
    if (e != hipSuccess) fprintf(stderr, "cooperative launch failed: %s (grid %d)\n", hipGetErrorString(e), grid);
#else
    for (int ph = 0; ph < NPH; ++ph) { p.ph_lo = ph; p.ph_hi = ph + 1; hipLaunchKernelGGL(mk, dim3(grid), dim3(NTHREADS), LDS_BYTES, stream, p); }
#endif
}
```

```cpp
#include <hip/hip_runtime.h>
#include <hip/hip_cooperative_groups.h>
#include <cstdio>
#include <cstdint>
namespace cg = cooperative_groups;
namespace pg8 {
#define PG8_LAS __attribute__((address_space(3)))
typedef unsigned short bf16_t;
typedef short bf16x8 __attribute__((ext_vector_type(8)));
typedef float f32x4 __attribute__((ext_vector_type(4)));
typedef unsigned u32x4 __attribute__((ext_vector_type(4)));
constexpr int BM = 256, BK = 64, HALF = 128, HTB = HALF * BK * 2  , STAGE_BYTES = 8 * HTB, NXCD = 8, WGM = 8;

__host__ __device__ __forceinline__ int lds_byte(int r, int c) { const int st = (r >> 4) * 2 + (c >> 5), rr = r & 15, cc = c & 31, ob = rr * 64 + cc * 2; return st * 1024 + (ob ^ (((ob >> 9) & 1) << 5)); }
__host__ __device__ __forceinline__ void stage_rc(int b, int& R, int& C) { const int st = b / 1024, sb = b % 1024, swz = sb ^ (((sb >> 9) & 1) << 5); R = (st >> 1) * 16 + swz / 64; C = (st & 1) * 32 + (swz % 64) / 2; }
__host__ __device__ __forceinline__ int perm32(int rho) { const int n = rho >> 4, i = rho & 15; return 8 * (i >> 2) + 4 * n + (i & 3); }

struct Unit { int pm, pn, ko; };
struct Gemm { const bf16_t* A; const bf16_t* Bt; int M, N, K, ld; };

struct StaticOrder {
    int nM, nN, nwg, G, c;
    __host__ __device__ void init(int M, int N, int G_, int c_) { nM = M / BM; nN = N / BM; nwg = nM * nN; G = G_; c = c_; }
    __host__ __device__ bool next(int i, Unit& u) const {
        const long L = (long)i * G + c; if (L >= nwg) return false;
        int wgid = (int)L; { const int q = nwg / NXCD, r = nwg % NXCD, xcd = wgid % NXCD, off = wgid / NXCD; wgid = (xcd < r ? xcd * (q + 1) : r * (q + 1) + (xcd - r) * q) + off; }
        const int nig = WGM * nN, gid = wgid / nig, fm = gid * WGM, gsz = (nM - fm) < WGM ? (nM - fm) : WGM;
        u.pm = fm + ((wgid % nig) % gsz); u.pn = (wgid % nig) / gsz; u.ko = 0; return true;
    }
    __device__ __forceinline__ void a_ready(const Unit&) const {}
    __device__ __forceinline__ void done(const Unit&) const {}
};

struct SplitOrder {
    int nM, nN, ns, pm0, klen, nwg, G, c;
    __host__ __device__ void init(int nM_, int nN_, int ns_, int pm0_, int klen_, int G_, int c_) { nM = nM_; nN = nN_; ns = ns_; pm0 = pm0_; klen = klen_; nwg = nM * nN * ns; G = G_; c = c_; }
    __host__ __device__ bool next(int i, Unit& u) const {
        const long L = (long)i * G + c; if (L >= nwg) return false;
        const int w = (int)L, t = w % (nM * nN); u.ko = (w / (nM * nN)) * klen; u.pm = pm0 + t % nM; u.pn = t / nM; return true;
    }
    __device__ __forceinline__ void a_ready(const Unit&) const {}
    __device__ __forceinline__ void done(const Unit&) const {}
};

__device__ __forceinline__ unsigned cvt_pk_bf16(float lo, float hi) { unsigned r; asm volatile("v_cvt_pk_bf16_f32 %0, %1, %2" : "=v"(r) : "v"(lo), "v"(hi)); return r; }
template <class Epi, class Sched, bool ALIGN_EPI = false, bool SP2 = false>
__device__ __forceinline__ void gemm_phase(PG8_LAS unsigned char* lds, const Gemm g, const Sched& S, const Epi& E, const int tid_in) {
    const int tid = tid_in, wid = __builtin_amdgcn_readfirstlane(tid >> 6), lane = tid & 63, wr = wid >> 2, wc = wid & 3, fr = lane & 15, fq = lane >> 4;
    const int K = g.ld, nt = g.K / BK;
    unsigned voffA[2], voffB[2];
#pragma unroll
    for (int i = 0; i < 2; ++i) { int R, C; stage_rc(tid * 16 + i * 8192, R, C); const int Rb = Epi::PERM ? ((R & ~31) + perm32(R & 31)) : R;
        voffA[i] = (unsigned)(R * K + C) * 2u; voffB[i] = (unsigned)(Rb * K + C) * 2u; }
    const size_t kstep = (size_t)(BK * 2);
    const size_t hstep = (size_t)HALF * K * 2;
    const size_t tstep = 2 * hstep;
    const unsigned ldsw = (unsigned)wid * 1024u;
    const int aoff = lds_byte(wr * 64 + fr, fq * 8), boff = lds_byte(wc * 32 + fr, fq * 8);
#define PG8_SA(b, h) (((b) * 2 + (h)) * HTB)
#define PG8_SB(b, h) ((4 + (b) * 2 + (h)) * HTB)
#define PG8_STAGE(bufoff, gbase, voff) do { _Pragma("unroll") for (int _i = 0; _i < 2; ++_i) \
        __builtin_amdgcn_global_load_lds((const unsigned*)((const char*)(gbase) + (voff)[_i]), (PG8_LAS unsigned*)(lds + (bufoff) + ldsw + _i * 8192), 16, 0, 0); } while (0)
#define PG8_LDA(dst, b, h) do { _Pragma("unroll") for (int m = 0; m < 4; ++m) _Pragma("unroll") for (int k = 0; k < 2; ++k) dst[m][k] = *(const PG8_LAS bf16x8*)(lds + PG8_SA(b, h) + aoff + m * 2048 + k * 1024); } while (0)
#define PG8_LDB(dst, b, h) do { _Pragma("unroll") for (int n = 0; n < 2; ++n) _Pragma("unroll") for (int k = 0; k < 2; ++k) dst[n][k] = *(const PG8_LAS bf16x8*)(lds + PG8_SB(b, h) + boff + n * 2048 + k * 1024); } while (0)
#define PG8_MMA(ai, bj, At, Bt) do { __builtin_amdgcn_s_setprio(1); _Pragma("unroll") for (int m = 0; m < 4; ++m) _Pragma("unroll") for (int n = 0; n < 2; ++n) _Pragma("unroll") for (int k = 0; k < 2; ++k) \
        acc[ai][bj][m][n] = __builtin_amdgcn_mfma_f32_16x16x32_bf16(Bt[n][k], At[m][k], acc[ai][bj][m][n], 0, 0, 0); __builtin_amdgcn_s_setprio(0); } while (0)
#define PG8_WAIT_V(n) asm volatile("s_waitcnt vmcnt(" #n ")" ::: "memory")
#define PG8_WAIT_L(n) asm volatile("s_waitcnt lgkmcnt(" #n ")" ::: "memory")
#define PG8_BAR __builtin_amdgcn_s_barrier()
#define PG8_SCHED __builtin_amdgcn_sched_barrier(0)
    Unit cur, nxt; int ui = 0;
    if (!S.next(0, cur)) return;
    f32x4 acc[2][2][4][2];
#pragma unroll
    for (int a = 0; a < 2; ++a)
#pragma unroll
        for (int b = 0; b < 2; ++b)
#pragma unroll
            for (int m = 0; m < 4; ++m)
#pragma unroll
                for (int n = 0; n < 2; ++n) acc[a][b][m][n] = (f32x4){0.f, 0.f, 0.f, 0.f};
    bf16x8 At[4][2], B0[2][2], B1[2][2];
    const char* cA = (const char*)g.A + (size_t)cur.pm * tstep + (size_t)cur.ko * 2; const char* cB = (const char*)g.Bt + (size_t)cur.pn * tstep + (size_t)cur.ko * 2;
    S.a_ready(cur);
    typename Epi::Pre pre; E.prefetch(pre, cur, wr, wc, fr, fq);
    if constexpr (SP2) {
        PG8_STAGE(PG8_SB(0, 0), cB, voffB); PG8_STAGE(PG8_SB(0, 1), cB + hstep, voffB); PG8_STAGE(PG8_SA(0, 0), cA, voffA); PG8_STAGE(PG8_SA(0, 1), cA + hstep, voffA);
        if (wr == 1) PG8_BAR;
        PG8_WAIT_V(2); PG8_BAR;
        PG8_STAGE(PG8_SB(1, 0), cB + kstep, voffB); PG8_STAGE(PG8_SA(1, 0), cA + kstep, voffA); PG8_STAGE(PG8_SB(1, 1), cB + hstep + kstep, voffB);
        PG8_WAIT_V(6); PG8_BAR;
    } else {
        PG8_STAGE(PG8_SB(0, 0), cB, voffB); PG8_STAGE(PG8_SA(0, 0), cA, voffA); PG8_STAGE(PG8_SB(0, 1), cB + hstep, voffB); PG8_STAGE(PG8_SA(0, 1), cA + hstep, voffA);
        if (wr == 1) PG8_BAR;
        PG8_WAIT_V(4); PG8_BAR;
        PG8_STAGE(PG8_SB(1, 0), cB + kstep, voffB); PG8_STAGE(PG8_SA(1, 0), cA + kstep, voffA); PG8_STAGE(PG8_SB(1, 1), cB + hstep + kstep, voffB);
        PG8_WAIT_V(6); PG8_BAR;
    }
    for (;;) {
        const bool has_next = S.next(ui + 1, nxt);
        const char* nA = has_next ? (const char*)g.A + (size_t)nxt.pm * tstep + (size_t)nxt.ko * 2 : cA; const char* nB = has_next ? (const char*)g.Bt + (size_t)nxt.pn * tstep + (size_t)nxt.ko * 2 : cB;
        for (int t = 0; t < nt; t += 2) {
            const bool last = (t == nt - 2);
            const char* a1 = cA + (size_t)(t + 1) * kstep;
            const char* a2 = last ? nA : cA + (size_t)(t + 2) * kstep; const char* b2 = last ? nB : cB + (size_t)(t + 2) * kstep;
            const char* a3 = a2 + kstep; const char* b3 = b2 + kstep;
            if (last && has_next) S.a_ready(nxt);
            if constexpr (SP2) {
            PG8_LDB(B0, 0, 0); PG8_LDB(B1, 0, 1); PG8_SCHED; PG8_LDA(At, 0, 0); PG8_STAGE(PG8_SA(1, 1), a1 + hstep, voffA);
            PG8_WAIT_V(8); PG8_WAIT_L(0); PG8_BAR; PG8_MMA(0, 0, At, B0); PG8_MMA(0, 1, At, B1); PG8_BAR; PG8_SCHED;
            PG8_LDA(At, 0, 1); PG8_STAGE(PG8_SB(0, 0), b2, voffB); PG8_STAGE(PG8_SB(0, 1), b2 + hstep, voffB); PG8_STAGE(PG8_SA(0, 0), a2, voffA);
            PG8_WAIT_V(8); PG8_WAIT_L(0); PG8_BAR; PG8_MMA(1, 0, At, B0); PG8_MMA(1, 1, At, B1); PG8_BAR; PG8_SCHED;
            PG8_LDB(B0, 1, 0); PG8_LDB(B1, 1, 1); PG8_SCHED; PG8_LDA(At, 1, 0); PG8_STAGE(PG8_SA(0, 1), a2 + hstep, voffA);
            PG8_WAIT_V(8); PG8_WAIT_L(0); PG8_BAR; PG8_MMA(0, 0, At, B0); PG8_MMA(0, 1, At, B1); PG8_BAR; PG8_SCHED;
            PG8_LDA(At, 1, 1); PG8_STAGE(PG8_SB(1, 0), b3, voffB); PG8_STAGE(PG8_SB(1, 1), b3 + hstep, voffB); PG8_STAGE(PG8_SA(1, 0), a3, voffA);
            PG8_WAIT_V(8); PG8_WAIT_L(0); PG8_BAR; PG8_MMA(1, 0, At, B0); PG8_MMA(1, 1, At, B1); PG8_BAR; PG8_SCHED;
            } else {
            PG8_LDB(B0, 0, 0); PG8_SCHED; PG8_LDA(At, 0, 0); PG8_STAGE(PG8_SA(1, 1), a1 + hstep, voffA);
            PG8_WAIT_L(8); PG8_BAR; PG8_WAIT_L(0); PG8_MMA(0, 0, At, B0); PG8_BAR; PG8_SCHED;
            PG8_LDB(B1, 0, 1); PG8_STAGE(PG8_SB(0, 0), b2, voffB);
            PG8_BAR; PG8_WAIT_L(0); PG8_MMA(0, 1, At, B1); PG8_BAR;
            PG8_LDA(At, 0, 1); PG8_STAGE(PG8_SA(0, 0), a2, voffA);
            PG8_BAR; PG8_WAIT_L(0); PG8_MMA(1, 0, At, B0); PG8_BAR; PG8_SCHED;
            PG8_STAGE(PG8_SB(0, 1), b2 + hstep, voffB);
            PG8_WAIT_V(6); PG8_BAR; PG8_MMA(1, 1, At, B1); PG8_BAR;
            PG8_LDB(B0, 1, 0); PG8_SCHED; PG8_LDA(At, 1, 0); PG8_STAGE(PG8_SA(0, 1), a2 + hstep, voffA);
            PG8_WAIT_L(8); PG8_BAR; PG8_WAIT_L(0); PG8_MMA(0, 0, At, B0); PG8_BAR; PG8_SCHED;
            PG8_LDB(B1, 1, 1); PG8_STAGE(PG8_SB(1, 0), b3, voffB);
            PG8_BAR; PG8_WAIT_L(0); PG8_MMA(0, 1, At, B1); PG8_BAR;
            PG8_LDA(At, 1, 1); PG8_STAGE(PG8_SA(1, 0), a3, voffA);
            PG8_BAR; PG8_WAIT_L(0); PG8_MMA(1, 0, At, B0); PG8_BAR; PG8_SCHED;
            PG8_STAGE(PG8_SB(1, 1), b3 + hstep, voffB);
            PG8_WAIT_V(6); PG8_BAR; PG8_MMA(1, 1, At, B1); PG8_BAR;
            }
        }
        if constexpr (ALIGN_EPI) { if (wr == 0) PG8_BAR; }
        if constexpr (!Epi::AFTER_DRAIN) { E(acc, cur, wr, wc, fr, fq, pre); S.done(cur); }
        if (!has_next) break;
#pragma unroll
        for (int a = 0; a < 2; ++a)
#pragma unroll
            for (int b = 0; b < 2; ++b)
#pragma unroll
                for (int m = 0; m < 4; ++m)
#pragma unroll
                    for (int n = 0; n < 2; ++n) acc[a][b][m][n] = (f32x4){0.f, 0.f, 0.f, 0.f};
        cur = nxt; cA = nA; cB = nB; ++ui;
        E.prefetch(pre, cur, wr, wc, fr, fq);
        if constexpr (ALIGN_EPI) { if (wr == 1) PG8_BAR; }
    }
    PG8_WAIT_V(0);
    if constexpr (!ALIGN_EPI) { if (wr == 0) PG8_BAR; }
    PG8_BAR;
    if constexpr (Epi::AFTER_DRAIN) { E.fused(acc, cur, wr, wc, fr, fq, lds, wid, lane); S.done(cur); }
#undef PG8_SA
#undef PG8_SB
#undef PG8_STAGE
#undef PG8_LDA
#undef PG8_LDB
#undef PG8_MMA
#undef PG8_WAIT_V
#undef PG8_WAIT_L
#undef PG8_BAR
#undef PG8_SCHED
}
}
#define LAS __attribute__((address_space(3)))

#define XB_TMO      128
#define XB_XCNT(j)  (256  + 64 * (j))
#define XB_XSUB(j)  (1280 + 64 * (j))
#define XB_XGEN(j)  (2304 + 64 * (j))
#define XB_TOP      3328
#define XB_TOPGEN   3392
#define XCD_BAR_WORDS 3456
#define XB_SPIN_CAP (1u << 18)

__device__ __forceinline__ unsigned xb_ld(unsigned* p)              { return __hip_atomic_load(p, __ATOMIC_RELAXED, __HIP_MEMORY_SCOPE_AGENT); }
__device__ __forceinline__ unsigned xb_add(unsigned* p, unsigned v) { return __hip_atomic_fetch_add(p, v, __ATOMIC_RELAXED, __HIP_MEMORY_SCOPE_AGENT); }
__device__ __forceinline__ unsigned xb_xcc_id() { return (unsigned)__builtin_amdgcn_s_getreg((3 << 11) | 20) & 0xFu; }
#define XB_SPIN(cond, bar) do { unsigned _sp = 0; while (cond) { __builtin_amdgcn_s_sleep(1); \
    if ((++_sp & 255u) == 0u) { if (xb_ld(&(bar)[XB_TMO])) break; if (_sp > XB_SPIN_CAP) { atomicAdd(&(bar)[XB_TMO], 1u); break; } } } } while (0)

struct XcdBarrier {
    unsigned* bar; unsigned x;
    volatile LAS unsigned* st;
};

__device__ __forceinline__ XcdBarrier xcd_barrier_post(unsigned* bar, volatile LAS unsigned* st) {
    XcdBarrier b; b.bar = bar; b.x = xb_xcc_id(); b.st = st;
    if (threadIdx.x == 0) (void)xb_add(&bar[XB_XCNT(b.x)], 1u);
    return b;
}
__device__ __forceinline__ void xcd_barrier_complete(unsigned* bar, unsigned x, unsigned& nloc, unsigned& nx) {
    const unsigned G = gridDim.x * gridDim.y * gridDim.z;
    unsigned sum, cnt, mine, sp = 0u;
    for (;;) {
        sum = 0u; cnt = 0u; mine = 0u;
#pragma unroll
        for (unsigned j = 0; j < 16; ++j) { const unsigned c = xb_ld(&bar[XB_XCNT(j)]); sum += c; cnt += (c > 0u) ? 1u : 0u; mine = (j == x) ? c : mine; }
        if (sum == G) break;
        __builtin_amdgcn_s_sleep(1);
        if ((++sp & 255u) == 0u) { if (xb_ld(&bar[XB_TMO])) break; if (sp > XB_SPIN_CAP) { atomicAdd(&bar[XB_TMO], 1u); break; } }
    }
    nloc = mine > 0u ? mine : 1u; nx = cnt > 0u ? cnt : 1u;
}

__device__ __forceinline__ void xcd_barrier(const XcdBarrier& b) {
    asm volatile("s_waitcnt vmcnt(0)" ::: "memory");
    __syncthreads();
    if (threadIdx.x == 0) {
        unsigned* bar = b.bar;
        __builtin_amdgcn_s_waitcnt(0);
        unsigned nloc = b.st[0], nx = b.st[1];
        if (nloc == 0u) { xcd_barrier_complete(bar, b.x, nloc, nx); b.st[0] = nloc; b.st[1] = nx; }
        const unsigned old = xb_add(&bar[XB_XSUB(b.x)], 1u);
        const unsigned gen = old / nloc;
        if (old + 1u == (gen + 1u) * nloc) {
            __builtin_amdgcn_fence(__ATOMIC_RELEASE, "agent");
            asm volatile("s_waitcnt vmcnt(0)" ::: "memory");
            const unsigned og = xb_add(&bar[XB_TOP], 1u);
            const unsigned tg = og / nx;
            if (og + 1u == (tg + 1u) * nx) xb_add(&bar[XB_TOPGEN], 1u);
            else XB_SPIN(xb_ld(&bar[XB_TOPGEN]) == tg, bar);
            __builtin_amdgcn_fence(__ATOMIC_ACQUIRE, "agent");
            xb_add(&bar[XB_XGEN(b.x)], 1u);
            asm volatile("s_waitcnt vmcnt(0)" ::: "memory");
        } else {
            XB_SPIN(xb_ld(&bar[XB_XGEN(b.x)]) == gen, bar);
            __builtin_amdgcn_fence(__ATOMIC_ACQUIRE, "agent");
            asm volatile("s_waitcnt vmcnt(0)" ::: "memory");
        }
    }
    __syncthreads();
}


#ifndef REP_MASK
#define REP_MASK 0
#endif
#ifndef NAIVE_ATTN
#define NAIVE_ATTN 0
#endif
#ifndef NAIVE_SPATIAL
#define NAIVE_SPATIAL 0
#endif

using pg8::bf16_t; using pg8::f32x4; using pg8::Unit; using pg8::u32x4;
typedef unsigned u32x2 __attribute__((ext_vector_type(2)));

constexpr int NLAT = 32768, NCTX = 2048, MTOT = 34816;
constexpr int NTHREADS = 512;
constexpr int LDS_BYTES = 141440;
constexpr int LDS_ST_OFF = 141424;
constexpr int NPH = 27;

constexpr size_t OFF_W1T = 0;
constexpr size_t OFF_W2T = OFF_W1T + 4ull * 4096 * 1024 * 2;
constexpr size_t OFF_QKVT = OFF_W2T + 4ull * 4096 * 1024 * 2;
constexpr size_t OFF_WOT = OFF_QKVT + 2ull * 3072 * 1024 * 2;
constexpr size_t OFF_WINT = OFF_WOT + 2ull * 1024 * 1024 * 2;
constexpr size_t OFF_SGOT = OFF_WINT + 2ull * 6144 * 1024 * 2;
constexpr size_t OFF_MODS = OFF_SGOT + 2ull * 1024 * 3072 * 2;
constexpr size_t OFF_CTXR = OFF_MODS + 4ull * 9 * 6144 * 4;
constexpr size_t OFF_HB = OFF_CTXR + 2048ull * 1024 * 4;
constexpr size_t OFF_BIG = OFF_HB + 34816ull * 1024 * 2;
constexpr size_t OFF_SSQ = OFF_BIG + 34816ull * 4096 * 2;
constexpr size_t OFF_LNACC = OFF_SSQ + 8ull * 34816 * 4;
constexpr size_t OFF_GS = OFF_LNACC + 2ull * 34816 * 2 * 4;
constexpr size_t OFF_BQKV = OFF_GS + 8ull * 9 * 1024 * 4;
constexpr size_t OFF_BMLP = OFF_BQKV + 2ull * 9 * 3072 * 4;
constexpr size_t OFF_BWIN = OFF_BMLP + 4ull * 9 * 4096 * 4;
constexpr size_t OFF_WSF = OFF_BWIN + 2ull * 9 * 6144 * 4;
constexpr size_t OFF_PART = OFF_WSF + 2ull * 24 * 16384 * 2;
constexpr size_t OFF_BAR = OFF_PART + 4ull * 2048 * 1024 * 4;
constexpr size_t WS_END = OFF_BAR + 16384;

struct Params {
    const float *x, *c, *ctx, *c_ctx, *ada_w, *ada_b, *norm1_g, *norm2_g, *mlp_w1, *mlp_w2, *na_w_qkv, *na_q_norm, *na_k_norm, *na_rpb, *na_w_o,
        *sg_w_in, *sg_b_in, *sg_ln_g, *sg_ln_b, *sg_w_s, *sg_b_s, *sg_w_o;
    float* out; unsigned char* ws; int ph_lo, ph_hi;
};

struct Tix { int tid, bid, gsz; };
__device__ __forceinline__ float bf2f(unsigned h) { return __uint_as_float(h << 16); }
__device__ __forceinline__ unsigned f2bf(float f) { unsigned u = __float_as_uint(f); u += 0x7FFFu + ((u >> 16) & 1u); return u >> 16; }
__device__ __forceinline__ unsigned pk2(float lo, float hi) { return pg8::cvt_pk_bf16(lo, hi); }
__device__ __forceinline__ float wave_sum(float v) {
#pragma unroll
    for (int o = 1; o < 64; o <<= 1) v += __shfl_xor(v, o);
    return v;
}
__device__ __forceinline__ float wave_max(float v) {
#pragma unroll
    for (int o = 1; o < 64; o <<= 1) v = fmaxf(v, __shfl_xor(v, o));
    return v;
}
#define LDS_WAIT() asm volatile("s_waitcnt lgkmcnt(0)" ::: "memory")
__device__ __forceinline__ float sumsq4f(const pg8::f32x4 x) { return (x.x * x.x + x.y * x.y) + (x.z * x.z + x.w * x.w); }
__device__ __forceinline__ float silu_f(float v) { return v / (1.f + expf(-v)); }
__device__ __forceinline__ float gelu_f(float v) { return 0.5f * v * (1.f + erff(v * 0.70710678118654752f)); }

typedef float f32x2 __attribute__((ext_vector_type(2)));
__device__ __forceinline__ f32x2 gelu_pk(f32x2 v) {
    const f32x2 av = __builtin_elementwise_abs(v), d = av * 0.2316418882f + 1.0f;
    f32x2 t; t.x = __builtin_amdgcn_rcpf(d.x); t.y = __builtin_amdgcn_rcpf(d.y);
    f32x2 q = t * 0.5307027145f + (-0.7265760135f); q = q * t + 0.7107068705f; q = q * t + (-0.142248368f); q = q * t + 0.127414796f; q = q * t;
    const f32x2 s = (v * v) * (-0.72134752044f);
    f32x2 e; e.x = __builtin_amdgcn_exp2f(s.x); e.y = __builtin_amdgcn_exp2f(s.y);
    const f32x2 m = v * (q * e), r = v - m;
    f32x2 o; o.x = v.x < 0.f ? m.x : r.x; o.y = v.y < 0.f ? m.y : r.y; return o;
}
__device__ __forceinline__ f32x4 gelu4(f32x4 v) { const f32x2 a = gelu_pk((f32x2){v.x, v.y}), b = gelu_pk((f32x2){v.z, v.w}); return (f32x4){a.x, a.y, b.x, b.y}; }

__device__ __forceinline__ int sigma_inv(int L) { return 128 * ((L >> 5) & 1) + 32 * (L >> 6) + 16 * ((L >> 2) & 1) + 4 * ((L >> 3) & 3) + (L & 3); }

__device__ __forceinline__ void phase_mods(const Params& p, LAS unsigned char* lds, const Tix T_) {
    LAS float* sc = (LAS float*)lds;
    LAS float* red = (LAS float*)(lds + 36864);
    float* mods = (float*)(p.ws + OFF_MODS);
    const int tid = T_.tid;
    for (int i = tid; i < 9 * 1024; i += NTHREADS) { const int b = i >> 10, k = i & 1023; const float v = b < 8 ? p.c[b * 1024 + k] : p.c_ctx[k]; sc[i] = silu_f(v); }
    __syncthreads();
    const int c4 = (tid & 7) * 4, kk = tid >> 3;
    for (int item = T_.bid; item < 768; item += T_.gsz) {
        const int l = item / 192, n0 = (item % 192) * 32;
        const float* W = p.ada_w + (size_t)l * 1024 * 6144 + n0 + c4;
        f32x4 acc[9];
#pragma unroll
        for (int b = 0; b < 9; ++b) acc[b] = (f32x4){0.f, 0.f, 0.f, 0.f};
        f32x4 wq[16];
#pragma unroll
        for (int i = 0; i < 16; ++i) wq[i] = *(const f32x4*)(W + (size_t)(kk + 64 * i) * 6144);
        __builtin_amdgcn_sched_barrier(0);
#pragma unroll
        for (int i = 0; i < 16; ++i) { const int k = kk + 64 * i;
#pragma unroll
            for (int b = 0; b < 9; ++b) acc[b] += sc[b * 1024 + k] * wq[i]; }
#pragma unroll
        for (int b = 0; b < 9; ++b) *(LAS f32x4*)(red + (kk * 9 + b) * 32 + c4) = acc[b];
        __syncthreads();
        for (int o = tid; o < 288; o += NTHREADS) { const int b = o >> 5, cc = o & 31; float s0 = 0.f, s1 = 0.f;
            for (int j = 0; j < 64; j += 2) { s0 += red[(j * 9 + b) * 32 + cc]; s1 += red[((j + 1) * 9 + b) * 32 + cc]; }
            mods[(size_t)(l * 9 + b) * 6144 + n0 + cc] = (s0 + s1) + p.ada_b[l * 6144 + n0 + cc]; }
        __syncthreads();
    }
}

struct MatDesc { const float* src; bf16_t* dst; int K, N; };
__device__ __forceinline__ MatDesc get_mat(const Params& p, int mi) {
    MatDesc m;
    if (mi < 4) { m.src = p.mlp_w1 + (size_t)mi * 1024 * 4096; m.dst = (bf16_t*)(p.ws + OFF_W1T) + (size_t)mi * 4096 * 1024; m.K = 1024; m.N = 4096; }
    else if (mi < 8) { const int l = mi - 4; m.src = p.mlp_w2 + (size_t)l * 4096 * 1024; m.dst = (bf16_t*)(p.ws + OFF_W2T) + (size_t)l * 1024 * 4096; m.K = 4096; m.N = 1024; }
    else if (mi < 10) { const int a = mi - 8; m.src = p.na_w_qkv + (size_t)a * 1024 * 3072; m.dst = (bf16_t*)(p.ws + OFF_QKVT) + (size_t)a * 3072 * 1024; m.K = 1024; m.N = 3072; }
    else if (mi < 12) { const int a = mi - 10; m.src = p.na_w_o + (size_t)a * 1024 * 1024; m.dst = (bf16_t*)(p.ws + OFF_WOT) + (size_t)a * 1024 * 1024; m.K = 1024; m.N = 1024; }
    else if (mi < 14) { const int s = mi - 12; m.src = p.sg_w_in + (size_t)s * 1024 * 6144; m.dst = (bf16_t*)(p.ws + OFF_WINT) + (size_t)s * 6144 * 1024; m.K = 1024; m.N = 6144; }
    else { const int s = mi - 14; m.src = p.sg_w_o + (size_t)s * 3072 * 1024; m.dst = (bf16_t*)(p.ws + OFF_SGOT) + (size_t)s * 1024 * 3072; m.K = 3072; m.N = 1024; }
    return m;
}
struct CvItem { const float* src; bf16_t* dst; int K, N, k0, n0; };
__device__ __forceinline__ CvItem cv_locate(const Params& p, int g) {
    int mi, it;
    if (g < 8192) { mi = g >> 11; it = g & 2047; }
    else if (g < 16384) { mi = 4 + ((g - 8192) >> 11); it = g & 2047; }
    else if (g < 19456) { const int t = g - 16384; mi = 8 + t / 1536; it = t % 1536; }
    else if (g < 20480) { const int t = g - 19456; mi = 10 + (t >> 9); it = t & 511; }
    else if (g < 26624) { const int t = g - 20480; mi = 12 + t / 3072; it = t % 3072; }
    else { const int t = g - 26624; mi = 14 + t / 1536; it = t % 1536; }
    const MatDesc m = get_mat(p, mi);
    CvItem c; c.src = m.src; c.dst = m.dst; c.K = m.K; c.N = m.N; const int nblk = m.N / 32; c.k0 = 64 * (it / nblk); c.n0 = 32 * (it % nblk);
    return c;
}
__device__ __forceinline__ void cv_load(float (&wv)[32], const CvItem& c, int lane) {
    const float* wsrc = c.src + (size_t)(c.k0 + (lane >> 5)) * c.N + c.n0 + (lane & 31);
#pragma unroll
    for (int i = 0; i < 32; ++i) wv[i] = wsrc[(size_t)(2 * i) * c.N];
}
__device__ __forceinline__ void phase_convert(const Params& p, LAS unsigned char* lds, const Tix T_) {
    const int lane = T_.tid & 63, wave = T_.tid >> 6, gw = T_.bid * 8 + wave, NGW = T_.gsz * 8;
    LAS float* scr = (LAS float*)(lds + wave * 8704);
    constexpr int NITEMS = 29696;
    float wv[32];
    int g = gw;
    CvItem cur = cv_locate(p, min(g, NITEMS - 1));
    if (g < NITEMS) cv_load(wv, cur, lane);
    while (g < NITEMS) {
#pragma unroll
        for (int i = 0; i < 32; ++i) scr[(2 * i + (lane >> 5)) * 33 + (lane & 31)] = wv[i];
        const int gn = g + NGW;
        const CvItem nxt = cv_locate(p, min(gn, NITEMS - 1));
        if (gn < NITEMS) cv_load(wv, nxt, lane);
        LDS_WAIT();
        const int c = lane & 7;
#pragma unroll
        for (int j = 0; j < 4; ++j) { const int n = (lane >> 3) + 8 * j; const LAS float* s = scr + (8 * c) * 33 + n;
            u32x4 o; o.x = pk2(s[0 * 33], s[1 * 33]); o.y = pk2(s[2 * 33], s[3 * 33]); o.z = pk2(s[4 * 33], s[5 * 33]); o.w = pk2(s[6 * 33], s[7 * 33]);
            const int nl = cur.n0 + n, drow = (nl & ~255) + sigma_inv(nl & 255);
            *(u32x4*)(cur.dst + (size_t)drow * cur.K + cur.k0 + 8 * c) = o; }
        LDS_WAIT();
        g = gn; cur = nxt;
    }
    { bf16_t* wsf = (bf16_t*)(p.ws + OFF_WSF);
      for (int it = gw; it < 2 * 24 * 4 * 8; it += NGW) { const int ks = it & 7, pt = (it >> 3) & 3, slg = it >> 5;
          const float* wp = p.sg_w_s + (size_t)slg * 16384 + (32 * pt + (lane & 31)) * 128 + 16 * ks + 8 * (lane >> 5);
          const f32x4 x = *(const f32x4*)wp, y = *(const f32x4*)(wp + 4);
          u32x4 o; o.x = pk2(x.x, x.y); o.y = pk2(x.z, x.w); o.z = pk2(y.x, y.y); o.w = pk2(y.z, y.w);
          *(u32x4*)(wsf + (size_t)it * 512 + lane * 8) = o; } }
}


__device__ __forceinline__ void phase_zero(const Params& p, const Tix T_) {
    float* z0 = (float*)(p.ws + OFF_SSQ) + MTOT; const int n0 = 7 * MTOT + 2 * MTOT * 2;
    for (int i = T_.bid * NTHREADS + T_.tid; i < n0; i += T_.gsz * NTHREADS) z0[i] = 0.f;
}
__device__ __forceinline__ void phase_0b(const Params& p, LAS unsigned char* lds, const Tix T_) {
    const float* mods = (const float*)(p.ws + OFF_MODS);
    const int tid = T_.tid, lane = tid & 63, wave = tid >> 6, gw = T_.bid * 8 + wave, NGW = T_.gsz * 8;
    { float* gs = (float*)(p.ws + OFF_GS);
      for (int i = T_.bid * NTHREADS + tid; i < 8 * 9 * 1024; i += T_.gsz * NTHREADS) { const int n = i / 9216, rem = i % 9216, b = rem >> 10, c = rem & 1023, L = n >> 1;
          const float g = (n & 1) ? p.norm2_g[L * 1024 + c] : p.norm1_g[L * 1024 + c];
          gs[i] = g * (1.0f + mods[(size_t)(L * 9 + b) * 6144 + ((n & 1) ? 4096 : 1024) + c]); } }
    { bf16_t* hb = (bf16_t*)(p.ws + OFF_HB); float* ssq0 = (float*)(p.ws + OFF_SSQ);
      f32x4 gvv[4];
#pragma unroll
      for (int j = 0; j < 4; ++j) gvv[j] = *(const f32x4*)(p.norm1_g + 4 * lane + 256 * j);
      for (int row0 = gw; row0 < MTOT; row0 += 2 * NGW) {
          const int row1 = row0 + NGW; const bool has1 = row1 < MTOT; const int r1 = has1 ? row1 : row0;
          const float* xr0 = row0 < NLAT ? p.x + (size_t)row0 * 1024 : p.ctx + (size_t)(row0 - NLAT) * 1024;
          const float* xr1 = r1 < NLAT ? p.x + (size_t)r1 * 1024 : p.ctx + (size_t)(r1 - NLAT) * 1024;
          const int b0 = row0 < NLAT ? (row0 >> 12) : 8, b1 = r1 < NLAT ? (r1 >> 12) : 8;
          f32x4 v0[4], v1[4], s0[4], s1[4];
#pragma unroll
          for (int j = 0; j < 4; ++j) { v0[j] = *(const f32x4*)(xr0 + 4 * lane + 256 * j); v1[j] = *(const f32x4*)(xr1 + 4 * lane + 256 * j);
              s0[j] = *(const f32x4*)(mods + (size_t)b0 * 6144 + 1024 + 4 * lane + 256 * j); s1[j] = *(const f32x4*)(mods + (size_t)b1 * 6144 + 1024 + 4 * lane + 256 * j); }
          __builtin_amdgcn_sched_barrier(0);
          float ss0 = 0.f, ss1 = 0.f;
#pragma unroll
          for (int j = 0; j < 4; ++j) { ss0 += sumsq4f(v0[j]); ss1 += sumsq4f(v1[j]); }
#pragma unroll
          for (int o = 1; o < 64; o <<= 1) { const float t0 = __shfl_xor(ss0, o), t1 = __shfl_xor(ss1, o); ss0 += t0; ss1 += t1; }
          if (lane == 0) { ssq0[row0] = ss0; if (has1) ssq0[row1] = ss1; }
#pragma unroll
          for (int j = 0; j < 4; ++j) { const int col = 4 * lane + 256 * j;
              const f32x4 o0 = v0[j] * gvv[j] * (1.0f + s0[j]);
              u32x2 w; w.x = pk2(o0.x, o0.y); w.y = pk2(o0.z, o0.w);
              *(u32x2*)(hb + (size_t)row0 * 1024 + col) = w;
              if (has1) { const f32x4 o1 = v1[j] * gvv[j] * (1.0f + s1[j]);
                  u32x2 w1; w1.x = pk2(o1.x, o1.y); w1.y = pk2(o1.z, o1.w);
                  *(u32x2*)(hb + (size_t)row1 * 1024 + col) = w1; } } } }
    LAS float* sh = (LAS float*)lds;
    for (int cmb = 0; cmb < 8; ++cmb) {
        int L, shoff, N; const bf16_t* Bt; float* dst; const float* addb = nullptr;
        if (cmb < 2) { L = 2 * cmb; shoff = 0; N = 3072; Bt = (const bf16_t*)(p.ws + OFF_QKVT) + (size_t)cmb * 3072 * 1024; dst = (float*)(p.ws + OFF_BQKV) + (size_t)cmb * 9 * 3072; }
        else if (cmb < 6) { L = cmb - 2; shoff = 3072; N = 4096; Bt = (const bf16_t*)(p.ws + OFF_W1T) + (size_t)L * 4096 * 1024; dst = (float*)(p.ws + OFF_BMLP) + (size_t)L * 9 * 4096; }
        else { const int sl = cmb - 6; L = 2 * sl + 1; shoff = 0; N = 6144; Bt = (const bf16_t*)(p.ws + OFF_WINT) + (size_t)sl * 6144 * 1024; dst = (float*)(p.ws + OFF_BWIN) + (size_t)sl * 9 * 6144; addb = p.sg_b_in + sl * 6144; }
        __syncthreads();
        for (int i = tid; i < 9 * 1024; i += NTHREADS) sh[i] = mods[(size_t)(L * 9 + (i >> 10)) * 6144 + shoff + (i & 1023)];
        __syncthreads();
        for (int n = gw; n < N; n += NGW) {
            const bf16_t* wr_ = Bt + (size_t)((n & ~255) + sigma_inv(n & 255)) * 1024 + lane * 8;
            const u32x4 w0 = *(const u32x4*)wr_, w1 = *(const u32x4*)(wr_ + 512);
            float wv[16];
#pragma unroll
            for (int e = 0; e < 4; ++e) { wv[2 * e] = bf2f(w0[e] & 0xffffu); wv[2 * e + 1] = bf2f(w0[e] >> 16); wv[8 + 2 * e] = bf2f(w1[e] & 0xffffu); wv[8 + 2 * e + 1] = bf2f(w1[e] >> 16); }
            const float ab = addb ? addb[n] : 0.f;
            float a9[9];
#pragma unroll
            for (int b = 0; b < 9; ++b) {
                const f32x4 s0 = *(const LAS f32x4*)(sh + b * 1024 + lane * 8), s1 = *(const LAS f32x4*)(sh + b * 1024 + lane * 8 + 4);
                const f32x4 s2 = *(const LAS f32x4*)(sh + b * 1024 + 512 + lane * 8), s3 = *(const LAS f32x4*)(sh + b * 1024 + 512 + lane * 8 + 4);
                a9[b] = (wv[0] * s0.x + wv[1] * s0.y) + (wv[2] * s0.z + wv[3] * s0.w) + (wv[4] * s1.x + wv[5] * s1.y) + (wv[6] * s1.z + wv[7] * s1.w)
                      + (wv[8] * s2.x + wv[9] * s2.y) + (wv[10] * s2.z + wv[11] * s2.w) + (wv[12] * s3.x + wv[13] * s3.y) + (wv[14] * s3.z + wv[15] * s3.w); }
#pragma unroll
            for (int o = 1; o < 64; o <<= 1) {
                float t9[9];
#pragma unroll
                for (int b = 0; b < 9; ++b) t9[b] = __shfl_xor(a9[b], o);
#pragma unroll
                for (int b = 0; b < 9; ++b) a9[b] += t9[b]; }
            if (lane == 0) {
#pragma unroll
                for (int b = 0; b < 9; ++b) dst[(size_t)b * N + n] = a9[b] + ab; }
        }
    }
}

typedef short s16x4 __attribute__((ext_vector_type(4)));
typedef short s16x8 __attribute__((ext_vector_type(8)));
typedef float f32x16 __attribute__((ext_vector_type(16)));
typedef __bf16 bf16x2_t __attribute__((ext_vector_type(2)));
__device__ __forceinline__ unsigned pkb(float a, float b) { const f32x2 v = {a, b}; const bf16x2_t r = __builtin_convertvector(v, bf16x2_t); return __builtin_bit_cast(unsigned, r); }
__device__ __forceinline__ s16x8 pack8(float a0, float a1, float a2, float a3, float a4, float a5, float a6, float a7) {
    u32x4 w; w.x = pkb(a0, a1); w.y = pkb(a2, a3); w.z = pkb(a4, a5); w.w = pkb(a6, a7); return __builtin_bit_cast(s16x8, w); }
__device__ __forceinline__ s16x8 tr_pair(const LAS unsigned char* a0, int second_off) {
    const s16x4 a = __builtin_amdgcn_ds_read_tr16_b64_v4i16((LAS s16x4*)a0);
    const s16x4 b = __builtin_amdgcn_ds_read_tr16_b64_v4i16((LAS s16x4*)(a0 + second_off));
    s16x8 r; r[0] = a[0]; r[1] = a[1]; r[2] = a[2]; r[3] = a[3]; r[4] = b[0]; r[5] = b[1]; r[6] = b[2]; r[7] = b[3]; return r; }
#define MFMA32(a, b, c) __builtin_amdgcn_mfma_f32_32x32x16_bf16((a), (b), (c), 0, 0, 0)

constexpr int AV_STR = 144;
__device__ __forceinline__ f32x16 attn_qk(const s16x8 (&Kf)[4], const s16x8 (&Qf)[4]) {
    f32x16 S;
#pragma unroll
    for (int i = 0; i < 16; ++i) S[i] = 0.f;
#pragma unroll
    for (int ks = 0; ks < 4; ++ks) S = MFMA32(Kf[ks], Qf[ks], S);
    return S;
}
__device__ __forceinline__ float tabv(const LAS unsigned char* tabrow, int off) { return *(const LAS float*)(tabrow + off); }
__device__ __forceinline__ void attn_one_tile(const s16x8 (&Kf)[4], const s16x8 (&Qf)[4], const LAS unsigned char* vb, const LAS unsigned char* tabrow, const unsigned (&offo)[4], const unsigned offx,
                                              f32x16& O0, f32x16& O1, float& lsum, int mode, float mbl) {
    if (mode == 4) return;
    const f32x16 S = attn_qk(Kf, Qf);
    s16x8 V00, V01, V10, V11;
    if (mode != 3) { V00 = tr_pair(vb, 8 * AV_STR); V01 = tr_pair(vb + 64, 8 * AV_STR); }
    if (mode != 2) { V10 = tr_pair(vb + 16 * AV_STR, 8 * AV_STR); V11 = tr_pair(vb + 16 * AV_STR + 64, 8 * AV_STR); }
    __builtin_amdgcn_sched_barrier(0);
    float pv[16];
    if (mode == 0) {
#pragma unroll
        for (int i = 0; i < 16; ++i) pv[i] = __builtin_amdgcn_exp2f(S[i] - mbl);
    } else if (mode == 1) {
        float tb[16];
#pragma unroll
        for (int i = 0; i < 16; ++i) tb[i] = tabv(tabrow, (int)((offo[i >> 2] >> (8 * (i & 3))) & 0xffu));
        __builtin_amdgcn_sched_barrier(0);
#pragma unroll
        for (int i = 0; i < 16; ++i) pv[i] = __builtin_amdgcn_exp2f(S[i] + tb[i]);
    } else {
        float tb[4];
#pragma unroll
        for (int i = 0; i < 4; ++i) tb[i] = tabv(tabrow, (int)((offx >> (8 * i)) & 0xffu));
        __builtin_amdgcn_sched_barrier(0);
#pragma unroll
        for (int i = 0; i < 16; ++i) pv[i] = 0.f;
        if (mode == 2) {
#pragma unroll
            for (int i = 0; i < 4; ++i) pv[i] = __builtin_amdgcn_exp2f(S[i] + tb[i]);
        } else {
#pragma unroll
            for (int i = 0; i < 4; ++i) pv[12 + i] = __builtin_amdgcn_exp2f(S[12 + i] + tb[i]);
        }
    }
#pragma unroll
    for (int i = 0; i < 16; ++i) lsum += pv[i];
    const s16x8 P0 = pack8(pv[0], pv[1], pv[2], pv[3], pv[4], pv[5], pv[6], pv[7]), P1 = pack8(pv[8], pv[9], pv[10], pv[11], pv[12], pv[13], pv[14], pv[15]);
    if (mode != 3) { O0 = MFMA32(V00, P0, O0); O1 = MFMA32(V01, P0, O1); }
    if (mode != 2) { O0 = MFMA32(V10, P1, O0); O1 = MFMA32(V11, P1, O1); }
}
__device__ __forceinline__ void attn_load_k(s16x8 (&Kf)[4], const bf16_t* kfb, int klat0, int kctx0, int kt, int ntl, int rs) {
    const int tile = kt < ntl ? klat0 + (rs + (kt >> 1)) * 2 + (kt & 1) : kctx0 + (kt - ntl);
#pragma unroll
    for (int ks = 0; ks < 4; ++ks) Kf[ks] = *(const s16x8*)(kfb + (size_t)tile * 32768 + ks * 512);
}
struct AUnit { int b, h, qrow0, r, rs, ntl, ntiles; };
__device__ __forceinline__ AUnit attn_decode(int u, int nlatu) {
    AUnit a;
    if (u < nlatu) { a.h = u & 15; const int br = u >> 4; a.r = br & 63; a.b = br >> 6; a.qrow0 = a.b * 4096 + a.r * 64; a.rs = min(max(a.r - 4, 0), 56); a.ntl = 16; a.ntiles = 24; }
    else { const int v = u - nlatu; a.h = v & 15; const int bq = v >> 4; a.b = bq >> 2; a.qrow0 = NLAT + a.b * 256 + (bq & 3) * 64; a.r = 0; a.rs = 0; a.ntl = 0; a.ntiles = 8; }
    return a;
}
__device__ __forceinline__ u32x4 attn_load_v1(const bf16_t* vbase, const AUnit& a, int idx) {
    const int key = idx >> 3, ch = idx & 7, kt = key >> 5, kk = key & 31;
    const int grow = kt < a.ntl ? (a.b * 4096 + (a.rs + (kt >> 1)) * 64 + 32 * (kt & 1) + kk) : (NLAT + a.b * 256 + 32 * (kt - a.ntl) + kk);
    return *(const u32x4*)(vbase + (size_t)grow * 1024 + ch * 8);
}
__device__ __forceinline__ void attn_load_v(u32x4 (&vpre)[12], const bf16_t* qkv, const AUnit& a, int tid) {
    const bf16_t* vbase = qkv + (size_t)2 * MTOT * 1024 + a.h * 64;
#pragma unroll
    for (int i = 0; i < 4; ++i) vpre[i] = attn_load_v1(vbase, a, tid + NTHREADS * i);
    if (a.ntiles == 24) {
#pragma unroll
        for (int i = 4; i < 12; ++i) vpre[i] = attn_load_v1(vbase, a, tid + NTHREADS * i);
    }
}

__device__ __forceinline__ void phase_attn_mfma(const Params& p, int a_, bool ctx_q, LAS unsigned char* lds, const Tix T_, const int dummy = 0) {
    const bf16_t* qkv = (const bf16_t*)(p.ws + OFF_BIG); bf16_t* ao = (bf16_t*)(p.ws + OFF_BIG) + (size_t)MTOT * 3072;
    const bf16_t* kf = qkv + (size_t)MTOT * 1024;
    const float* rpb = p.na_rpb + (size_t)a_ * 16 * 15 * 31;
    const int tid = T_.tid, lane = tid & 63, wave = __builtin_amdgcn_readfirstlane(tid >> 6), qt = wave & 1, kq = wave >> 1, l31 = lane & 31, hi = lane >> 5;
    LAS unsigned char* Vl = lds;
    LAS float* Ored = (LAS float*)lds;
    LAS float* lred = (LAS float*)(lds + 69632);
    LAS float* tab_all = (LAS float*)(lds + 110592);
    LAS float* misc = (LAS float*)(lds + 110592 + 30720);
    constexpr float LOG2E = 1.4426950408889634f;
    float mb;
    { float m = 0.f; for (int i = tid; i < 7440; i += NTHREADS) m = fmaxf(m, rpb[i]);
      float qg = 0.f, kg = 0.f; if (tid < 64) { qg = fabsf(p.na_q_norm[a_ * 64 + tid]); kg = fabsf(p.na_k_norm[a_ * 64 + tid]); }
      m = wave_max(m); qg = wave_max(qg); kg = wave_max(kg);
      if (lane == 0) { misc[wave] = m; if (wave == 0) { misc[8] = qg; misc[9] = kg; } }
      __syncthreads();
      float rm = misc[0];
#pragma unroll
      for (int w = 1; w < 8; ++w) rm = fmaxf(rm, misc[w]);
      mb = 8.0f * misc[8] * misc[9] + rm; }
    const float mbl = mb * LOG2E;
    for (int i = tid; i < 16 * 480; i += NTHREADS) { const int hh = i / 480, rem = i % 480, rr = rem >> 5, dd = rem & 31; tab_all[i] = dd < 31 ? (rpb[hh * 465 + rr * 31 + dd] - mb) * LOG2E : -1e30f; }
    const int nlatu = 8 * 64 * 16, total = nlatu + (ctx_q ? 8 * 4 * 16 : 0);
    const int tr_q = (lane & 15) >> 2, tr_p = lane & 3, dgrp = (lane >> 4) & 1;
    const int qcol = 32 * qt + l31, wst = min(max(qcol - 8, 0), 48);
    unsigned offo[4], offx = 0u;
#pragma unroll
    for (int j = 0; j < 4; ++j) { offo[j] = 0u;
#pragma unroll
        for (int i = 0; i < 4; ++i) { const int kcol = 32 * qt + 8 * j + 4 * hi + i; offo[j] |= (unsigned)(((unsigned)(kcol - wst) < 16u ? kcol - qcol + 15 : 31) * 4) << (8 * i); } }
#pragma unroll
    for (int i = 0; i < 4; ++i) { const int kcol = (qt == 0 ? 32 : 24) + 4 * hi + i; offx |= (unsigned)(((unsigned)(kcol - wst) < 16u ? kcol - qcol + 15 : 31) * 4) << (8 * i); }
    int u = T_.bid;
    AUnit cur = attn_decode(min(u, total - 1), nlatu);
    u32x4 vpre[12];
    s16x8 Qf[4], KA[4], KB[4];
    if (u < total) {
        attn_load_v(vpre, qkv, cur, tid);
        const bf16_t* qp = qkv + (size_t)(((cur.qrow0 >> 5) + qt) * 16 + cur.h) * 2048 + lane * 8;
#pragma unroll
        for (int ks = 0; ks < 4; ++ks) Qf[ks] = *(const s16x8*)(qp + 512 * ks);
        const int t0 = kq * (cur.ntiles >> 2);
        attn_load_k(KA, kf + cur.h * 2048 + lane * 8, cur.b * 128, 1024 + cur.b * 8, t0, cur.ntl, cur.rs);
        attn_load_k(KB, kf + cur.h * 2048 + lane * 8, cur.b * 128, 1024 + cur.b * 8, t0 + 1, cur.ntl, cur.rs);
    }
    while (u < total) {
        const int b = cur.b, h = cur.h, qrow0 = cur.qrow0, r = cur.r, rs = cur.rs, ntl = cur.ntl, ntiles = cur.ntiles;
        int tidl = tid; asm volatile("" : "+v"(tidl));
#pragma unroll
        for (int i = 0; i < 4; ++i) { const int idx = tidl + NTHREADS * i; *(LAS u32x4*)(Vl + (idx >> 3) * AV_STR + (idx & 7) * 16) = vpre[i]; }
        if (ntiles == 24) {
#pragma unroll
            for (int i = 4; i < 12; ++i) { const int idx = tidl + NTHREADS * i; *(LAS u32x4*)(Vl + (idx >> 3) * AV_STR + (idx & 7) * 16) = vpre[i]; } }
        const LAS float* tab = tab_all + h * 480;
        const bf16_t* kbase = kf + h * 2048 + lane * 8;
        const int klat0 = b * 128, kctx0 = 1024 + b * 8;
        const int ntw = ntiles >> 2, t0 = kq * ntw;
        __syncthreads();
        f32x16 O0, O1;
#pragma unroll
        for (int i = 0; i < 16; ++i) { O0[i] = 0.f; O1[i] = 0.f; }
        float lsum = 0.f;
#pragma unroll 1
        for (int t = 0; t < (dummy ? 0 : ntw); t += 2) {
            { const int kt = t0 + t; const int mode = kt >= ntl ? 0 : ((kt & 1) == qt ? 1 : 2 + qt);
              attn_one_tile(KA, Qf, Vl + (kt * 32 + 4 * hi + tr_q) * AV_STR + (16 * dgrp + 4 * tr_p) * 2, (const LAS unsigned char*)tab + (rs + (kt >> 1) - r + 7) * 128, offo, offx, O0, O1, lsum, mode, mbl); }
            __builtin_amdgcn_sched_barrier(0);
            attn_load_k(KA, kbase, klat0, kctx0, t0 + min(t + 2, ntw - 2), ntl, rs);
            { const int kt = t0 + t + 1; const int mode = kt >= ntl ? 0 : ((kt & 1) == qt ? 1 : 2 + qt);
              attn_one_tile(KB, Qf, Vl + (kt * 32 + 4 * hi + tr_q) * AV_STR + (16 * dgrp + 4 * tr_p) * 2, (const LAS unsigned char*)tab + (rs + (kt >> 1) - r + 7) * 128, offo, offx, O0, O1, lsum, mode, mbl); }
            __builtin_amdgcn_sched_barrier(0);
            attn_load_k(KB, kbase, klat0, kctx0, t0 + min(t + 2, ntw - 2) + 1, ntl, rs);
        }
        const int un = u + T_.gsz;
        const AUnit nxt = attn_decode(min(un, total - 1), nlatu);
        int tidm = tid; asm volatile("" : "+v"(tidm));
        if (un < total) attn_load_v(vpre, qkv, nxt, tidm);
        __syncthreads();
#pragma unroll
        for (int j = 0; j < 4; ++j) {
            *(LAS f32x4*)(Ored + (size_t)((kq * 64 + 32 * qt + l31) * 68 + 8 * j + 4 * hi)) = (f32x4){O0[4 * j], O0[4 * j + 1], O0[4 * j + 2], O0[4 * j + 3]};
            *(LAS f32x4*)(Ored + (size_t)((kq * 64 + 32 * qt + l31) * 68 + 32 + 8 * j + 4 * hi)) = (f32x4){O1[4 * j], O1[4 * j + 1], O1[4 * j + 2], O1[4 * j + 3]}; }
        lred[(kq * 2 + hi) * 64 + 32 * qt + l31] = lsum;
        if (un < total) {
            const bf16_t* qp = qkv + (size_t)(((nxt.qrow0 >> 5) + qt) * 16 + nxt.h) * 2048 + lane * 8;
#pragma unroll
            for (int ks = 0; ks < 4; ++ks) Qf[ks] = *(const s16x8*)(qp + 512 * ks);
            const int t0n = kq * (nxt.ntiles >> 2);
            attn_load_k(KA, kf + nxt.h * 2048 + lane * 8, nxt.b * 128, 1024 + nxt.b * 8, t0n, nxt.ntl, nxt.rs);
            attn_load_k(KB, kf + nxt.h * 2048 + lane * 8, nxt.b * 128, 1024 + nxt.b * 8, t0n + 1, nxt.ntl, nxt.rs);
        }
        __syncthreads();
        { const int q = tid >> 3, d8 = (tid & 7) * 8;
          f32x4 s0 = (f32x4){0.f, 0.f, 0.f, 0.f}, s1 = s0; float l = 0.f;
#pragma unroll
          for (int k = 0; k < 4; ++k) { s0 += *(const LAS f32x4*)(Ored + (k * 64 + q) * 68 + d8); s1 += *(const LAS f32x4*)(Ored + (k * 64 + q) * 68 + d8 + 4); l += lred[(k * 2) * 64 + q] + lred[(k * 2 + 1) * 64 + q]; }
          const float inv = 1.0f / l;
          u32x4 o; o.x = pkb(s0.x * inv, s0.y * inv); o.y = pkb(s0.z * inv, s0.w * inv); o.z = pkb(s1.x * inv, s1.y * inv); o.w = pkb(s1.z * inv, s1.w * inv);
          *(u32x4*)(ao + (size_t)(qrow0 + q) * 1024 + h * 64 + d8) = o; }
        __syncthreads();
        u = un; cur = nxt;
    }
}


struct AUnit2 { int b, h, qrow0, r0, rsu, ntl, ntiles; };
__device__ __forceinline__ AUnit2 attn2_decode(int u, int nlatu) {
    AUnit2 a;
    if (u < nlatu) { a.h = u & 15; const int brp = u >> 4; a.r0 = 2 * (brp & 31); a.b = brp >> 5; a.qrow0 = a.b * 4096 + a.r0 * 64; a.rsu = min(max(a.r0 - 4, 0), 56); a.ntl = 18; a.ntiles = 26; }
    else { const int v = u - nlatu; a.h = v & 15; const int bq = v >> 4; a.b = bq >> 1; a.qrow0 = NLAT + a.b * 256 + (bq & 1) * 128; a.r0 = 0; a.rsu = 0; a.ntl = 0; a.ntiles = 8; }
    return a;
}
__device__ __forceinline__ u32x4 attn2_load_v1(const bf16_t* vbase, const AUnit2& a, int idx) {
    const int key = idx >> 3, ch = idx & 7, kt = key >> 5, kk = key & 31;
    const int grow = kt < a.ntl ? (a.b * 4096 + min(a.rsu + (kt >> 1), 63) * 64 + 32 * (kt & 1) + kk) : (NLAT + a.b * 256 + 32 * (kt - a.ntl) + kk);
    return *(const u32x4*)(vbase + (size_t)grow * 1024 + ch * 8);
}
__device__ __forceinline__ void attn2_load_v(u32x4 (&vpre)[13], const bf16_t* qkv, const AUnit2& a, int tid) {
    const bf16_t* vbase = qkv + (size_t)2 * MTOT * 1024 + a.h * 64;
#pragma unroll
    for (int i = 0; i < 4; ++i) vpre[i] = attn2_load_v1(vbase, a, tid + NTHREADS * i);
    if (a.ntiles == 26) {
#pragma unroll
        for (int i = 4; i < 13; ++i) vpre[i] = attn2_load_v1(vbase, a, tid + NTHREADS * i);
    }
}
__device__ __forceinline__ void attn2_load_k(s16x8 (&Kf)[4], const bf16_t* kfb, int klat0, int kctx0, int kt, int ntl, int rsu) {
    const int tile = kt < ntl ? klat0 + min(rsu + (kt >> 1), 63) * 2 + (kt & 1) : kctx0 + (kt - ntl);
#pragma unroll
    for (int ks = 0; ks < 4; ++ks) Kf[ks] = *(const s16x8*)(kfb + (size_t)tile * 32768 + ks * 512);
}
__device__ __forceinline__ void phase_attn2(const Params& p, int a_, bool ctx_q, LAS unsigned char* lds, const Tix T_) {
    const bf16_t* qkv = (const bf16_t*)(p.ws + OFF_BIG); bf16_t* ao = (bf16_t*)(p.ws + OFF_BIG) + (size_t)MTOT * 3072;
    const bf16_t* kf = qkv + (size_t)MTOT * 1024;
    const float* rpb = p.na_rpb + (size_t)a_ * 16 * 15 * 31;
    const int tid = T_.tid, lane = tid & 63, wave = __builtin_amdgcn_readfirstlane(tid >> 6), qtile = wave & 3, qt = qtile & 1, qrow = qtile >> 1, kh = wave >> 2, l31 = lane & 31, hi = lane >> 5;
    LAS unsigned char* Vl = lds;
    LAS float* Ored = (LAS float*)lds;
    LAS float* lred = (LAS float*)(lds + 69632);
    LAS float* tab_all = (LAS float*)(lds + 119808);
    LAS float* misc = (LAS float*)(lds + 119808 + 30720);
    constexpr float LOG2E = 1.4426950408889634f;
    float mb;
    { float m = 0.f; for (int i = tid; i < 7440; i += NTHREADS) m = fmaxf(m, rpb[i]);
      float qg = 0.f, kg = 0.f; if (tid < 64) { qg = fabsf(p.na_q_norm[a_ * 64 + tid]); kg = fabsf(p.na_k_norm[a_ * 64 + tid]); }
      m = wave_max(m); qg = wave_max(qg); kg = wave_max(kg);
      if (lane == 0) { misc[wave] = m; if (wave == 0) { misc[8] = qg; misc[9] = kg; } }
      __syncthreads();
      float rm = misc[0];
#pragma unroll
      for (int w = 1; w < 8; ++w) rm = fmaxf(rm, misc[w]);
      mb = 8.0f * misc[8] * misc[9] + rm; }
    const float mbl = mb * LOG2E;
    for (int i = tid; i < 16 * 480; i += NTHREADS) { const int hh = i / 480, rem = i % 480, rr = rem >> 5, dd = rem & 31; tab_all[i] = dd < 31 ? (rpb[hh * 465 + rr * 31 + dd] - mb) * LOG2E : -1e30f; }
    const int nlatu = 8 * 32 * 16, total = nlatu + (ctx_q ? 8 * 2 * 16 : 0);
    const int tr_q = (lane & 15) >> 2, tr_p = lane & 3, dgrp = (lane >> 4) & 1;
    const int qcol = 32 * qt + l31, wst = min(max(qcol - 8, 0), 48);
    unsigned offo[4], offx = 0u;
#pragma unroll
    for (int j = 0; j < 4; ++j) { offo[j] = 0u;
#pragma unroll
        for (int i = 0; i < 4; ++i) { const int kcol = 32 * qt + 8 * j + 4 * hi + i; offo[j] |= (unsigned)(((unsigned)(kcol - wst) < 16u ? kcol - qcol + 15 : 31) * 4) << (8 * i); } }
#pragma unroll
    for (int i = 0; i < 4; ++i) { const int kcol = (qt == 0 ? 32 : 24) + 4 * hi + i; offx |= (unsigned)(((unsigned)(kcol - wst) < 16u ? kcol - qcol + 15 : 31) * 4) << (8 * i); }
    int u = T_.bid;
    AUnit2 cur = attn2_decode(min(u, total - 1), nlatu);
    u32x4 vpre[13];
    s16x8 Qf[4], KA[4], KB[4];
    if (u < total) {
        attn2_load_v(vpre, qkv, cur, tid);
        const bf16_t* qp = qkv + (size_t)(((cur.qrow0 >> 5) + qtile) * 16 + cur.h) * 2048 + lane * 8;
#pragma unroll
        for (int ks = 0; ks < 4; ++ks) Qf[ks] = *(const s16x8*)(qp + 512 * ks);
        const int t0 = kh * (cur.ntiles >> 1);
        attn2_load_k(KA, kf + cur.h * 2048 + lane * 8, cur.b * 128, 1024 + cur.b * 8, t0, cur.ntl, cur.rsu);
        attn2_load_k(KB, kf + cur.h * 2048 + lane * 8, cur.b * 128, 1024 + cur.b * 8, t0 + 1, cur.ntl, cur.rsu);
    }
    while (u < total) {
        const int b = cur.b, h = cur.h, qrow0 = cur.qrow0, rsu = cur.rsu, ntl = cur.ntl, ntiles = cur.ntiles;
        const int rr = cur.r0 + qrow, rsq = min(max(rr - 4, 0), 56);
        int tidl = tid; asm volatile("" : "+v"(tidl));
#pragma unroll
        for (int i = 0; i < 4; ++i) { const int idx = tidl + NTHREADS * i; *(LAS u32x4*)(Vl + (idx >> 3) * AV_STR + (idx & 7) * 16) = vpre[i]; }
        if (ntiles == 26) {
#pragma unroll
            for (int i = 4; i < 13; ++i) { const int idx = tidl + NTHREADS * i; *(LAS u32x4*)(Vl + (idx >> 3) * AV_STR + (idx & 7) * 16) = vpre[i]; } }
        const LAS float* tab = tab_all + h * 480;
        const bf16_t* kbase = kf + h * 2048 + lane * 8;
        const int klat0 = b * 128, kctx0 = 1024 + b * 8;
        const int ntw = ntiles >> 1, t0 = kh * ntw;
        __syncthreads();
        f32x16 O0, O1;
#pragma unroll
        for (int i = 0; i < 16; ++i) { O0[i] = 0.f; O1[i] = 0.f; }
        float lsum = 0.f;
#pragma unroll 1
        for (int t = 0; t < ntw; t += 2) {
            { const int kt = t0 + t; const int krow = rsu + (kt >> 1);
              const int mode = kt >= ntl ? 0 : ((unsigned)(krow - rsq) >= 8u ? 4 : ((kt & 1) == qt ? 1 : 2 + qt));
              attn_one_tile(KA, Qf, Vl + (kt * 32 + 4 * hi + tr_q) * AV_STR + (16 * dgrp + 4 * tr_p) * 2, (const LAS unsigned char*)tab + (krow - rr + 7) * 128, offo, offx, O0, O1, lsum, mode, mbl); }
            __builtin_amdgcn_sched_barrier(0);
            attn2_load_k(KA, kbase, klat0, kctx0, min(t0 + t + 2, ntiles - 1), ntl, rsu);
            { const int kt = t0 + t + 1; const int krow = rsu + (kt >> 1);
              const int mode = (t + 1 >= ntw) ? 4 : (kt >= ntl ? 0 : ((unsigned)(krow - rsq) >= 8u ? 4 : ((kt & 1) == qt ? 1 : 2 + qt)));
              attn_one_tile(KB, Qf, Vl + (min(kt, ntiles - 1) * 32 + 4 * hi + tr_q) * AV_STR + (16 * dgrp + 4 * tr_p) * 2, (const LAS unsigned char*)tab + (min(max(krow - rr + 7, 0), 14)) * 128, offo, offx, O0, O1, lsum, mode, mbl); }
            __builtin_amdgcn_sched_barrier(0);
            attn2_load_k(KB, kbase, klat0, kctx0, min(t0 + t + 3, ntiles - 1), ntl, rsu);
        }
        const int un = u + T_.gsz;
        const AUnit2 nxt = attn2_decode(min(un, total - 1), nlatu);
        int tidm = tid; asm volatile("" : "+v"(tidm));
        if (un < total) attn2_load_v(vpre, qkv, nxt, tidm);
        __syncthreads();
#pragma unroll
        for (int j = 0; j < 4; ++j) {
            *(LAS f32x4*)(Ored + (size_t)((kh * 128 + 32 * qtile + l31) * 68 + 8 * j + 4 * hi)) = (f32x4){O0[4 * j], O0[4 * j + 1], O0[4 * j + 2], O0[4 * j + 3]};
            *(LAS f32x4*)(Ored + (size_t)((kh * 128 + 32 * qtile + l31) * 68 + 32 + 8 * j + 4 * hi)) = (f32x4){O1[4 * j], O1[4 * j + 1], O1[4 * j + 2], O1[4 * j + 3]}; }
        lred[(kh * 2 + hi) * 128 + 32 * qtile + l31] = lsum;
        if (un < total) {
            const bf16_t* qp = qkv + (size_t)(((nxt.qrow0 >> 5) + qtile) * 16 + nxt.h) * 2048 + lane * 8;
#pragma unroll
            for (int ks = 0; ks < 4; ++ks) Qf[ks] = *(const s16x8*)(qp + 512 * ks);
            const int t0n = kh * (nxt.ntiles >> 1);
            attn2_load_k(KA, kf + nxt.h * 2048 + lane * 8, nxt.b * 128, 1024 + nxt.b * 8, t0n, nxt.ntl, nxt.rsu);
            attn2_load_k(KB, kf + nxt.h * 2048 + lane * 8, nxt.b * 128, 1024 + nxt.b * 8, t0n + 1, nxt.ntl, nxt.rsu);
        }
        __syncthreads();
        { const int q = tid >> 2, d16 = (tid & 3) * 16;
          f32x4 s[4]; float l = 0.f;
#pragma unroll
          for (int i = 0; i < 4; ++i) s[i] = *(const LAS f32x4*)(Ored + q * 68 + d16 + 4 * i) + *(const LAS f32x4*)(Ored + (128 + q) * 68 + d16 + 4 * i);
          l = (lred[q] + lred[128 + q]) + (lred[256 + q] + lred[384 + q]);
          const float inv = 1.0f / l;
          u32x4 o0, o1; o0.x = pkb(s[0].x * inv, s[0].y * inv); o0.y = pkb(s[0].z * inv, s[0].w * inv); o0.z = pkb(s[1].x * inv, s[1].y * inv); o0.w = pkb(s[1].z * inv, s[1].w * inv);
          o1.x = pkb(s[2].x * inv, s[2].y * inv); o1.y = pkb(s[2].z * inv, s[2].w * inv); o1.z = pkb(s[3].x * inv, s[3].y * inv); o1.w = pkb(s[3].z * inv, s[3].w * inv);
          bf16_t* op = ao + (size_t)(qrow0 + q) * 1024 + h * 64 + d16; *(u32x4*)op = o0; *(u32x4*)(op + 8) = o1; }
        __syncthreads();
        u = un; cur = nxt;
    }
}


struct AUnit4 { int b, h, qrow0, r0, rsu, ntl; };
__device__ __forceinline__ AUnit4 attn4_decode(int u, int nlatu) {
    AUnit4 a;
    if (u < nlatu) { a.h = u & 15; const int brq = u >> 4; a.r0 = 4 * (brq & 15); a.b = brq >> 4; a.qrow0 = a.b * 4096 + a.r0 * 64; a.rsu = min(max(a.r0 - 4, 0), 56); a.ntl = 22; }
    else { const int v = u - nlatu; a.h = v & 15; a.b = v >> 4; a.qrow0 = NLAT + a.b * 256; a.r0 = 0; a.rsu = 0; a.ntl = 0; }
    return a;
}
__device__ __forceinline__ u32x4 attn4_load_v1(const bf16_t* vbase, const AUnit4& a, int idx) {
    const int key = idx >> 3, ch = idx & 7, kt = key >> 5, kk = key & 31;
    const int grow = kt < a.ntl ? (a.b * 4096 + min(a.rsu + (kt >> 1), 63) * 64 + 32 * (kt & 1) + kk) : (NLAT + a.b * 256 + 32 * (kt - a.ntl) + kk);
    return *(const u32x4*)(vbase + (size_t)grow * 1024 + ch * 8);
}
__device__ __forceinline__ void attn4_load_v(u32x4 (&vpre)[15], const bf16_t* qkv, const AUnit4& a, int tid) {
    const bf16_t* vbase = qkv + (size_t)2 * MTOT * 1024 + a.h * 64;
#pragma unroll
    for (int i = 0; i < 4; ++i) vpre[i] = attn4_load_v1(vbase, a, tid + NTHREADS * i);
    if (a.ntl) {
#pragma unroll
        for (int i = 4; i < 15; ++i) vpre[i] = attn4_load_v1(vbase, a, tid + NTHREADS * i);
    }
}
__device__ __forceinline__ int attn4_kt(int s, int nls, int koff, int c0) { return s < nls ? koff + s : c0 + (s - nls); }
__device__ __forceinline__ void attn4_load_k(s16x8 (&Kf)[4], const bf16_t* kfb, int klat0, int kctx0, int kt, int ntl, int rsu) {
    const int tile = kt < ntl ? klat0 + min(rsu + (kt >> 1), 63) * 2 + (kt & 1) : kctx0 + (kt - ntl);
#pragma unroll
    for (int ks = 0; ks < 4; ++ks) Kf[ks] = *(const s16x8*)(kfb + (size_t)tile * 32768 + ks * 512);
}
__device__ __forceinline__ void phase_attn4(const Params& p, int a_, bool ctx_q, LAS unsigned char* lds, const Tix T_) {
    const bf16_t* qkv = (const bf16_t*)(p.ws + OFF_BIG); bf16_t* ao = (bf16_t*)(p.ws + OFF_BIG) + (size_t)MTOT * 3072;
    const bf16_t* kf = qkv + (size_t)MTOT * 1024;
    const float* rpb = p.na_rpb + (size_t)a_ * 16 * 15 * 31;
    const int tid = T_.tid, lane = tid & 63, wave = __builtin_amdgcn_readfirstlane(tid >> 6), qtile = wave, qt = qtile & 1, qrow = qtile >> 1, l31 = lane & 31, hi = lane >> 5;
    LAS unsigned char* Vl = lds;
    LAS float* tab = (LAS float*)(lds + 138240);
    LAS float* misc = (LAS float*)(lds + 138240 + 2048);
    constexpr float LOG2E = 1.4426950408889634f;
    float mb;
    { float m = 0.f; for (int i = tid; i < 7440; i += NTHREADS) m = fmaxf(m, rpb[i]);
      float qg = 0.f, kg = 0.f; if (tid < 64) { qg = fabsf(p.na_q_norm[a_ * 64 + tid]); kg = fabsf(p.na_k_norm[a_ * 64 + tid]); }
      m = wave_max(m); qg = wave_max(qg); kg = wave_max(kg);
      if (lane == 0) { misc[wave] = m; if (wave == 0) { misc[8] = qg; misc[9] = kg; } }
      __syncthreads();
      float rm = misc[0];
#pragma unroll
      for (int w = 1; w < 8; ++w) rm = fmaxf(rm, misc[w]);
      mb = 8.0f * misc[8] * misc[9] + rm; }
    const float mbl = mb * LOG2E;
    const int nlatu = 8 * 16 * 16, total = nlatu + (ctx_q ? 8 * 16 : 0);
    const int tr_q = (lane & 15) >> 2, tr_p = lane & 3, dgrp = (lane >> 4) & 1;
    const int qcol = 32 * qt + l31, wst = min(max(qcol - 8, 0), 48);
    unsigned offo[4], offx = 0u;
#pragma unroll
    for (int j = 0; j < 4; ++j) { offo[j] = 0u;
#pragma unroll
        for (int i = 0; i < 4; ++i) { const int kcol = 32 * qt + 8 * j + 4 * hi + i; offo[j] |= (unsigned)(((unsigned)(kcol - wst) < 16u ? kcol - qcol + 15 : 31) * 4) << (8 * i); } }
#pragma unroll
    for (int i = 0; i < 4; ++i) { const int kcol = (qt == 0 ? 32 : 24) + 4 * hi + i; offx |= (unsigned)(((unsigned)(kcol - wst) < 16u ? kcol - qcol + 15 : 31) * 4) << (8 * i); }
    const int trr = tid >> 5, tdd = tid & 31;
    int u = T_.bid;
    AUnit4 cur = attn4_decode(min(u, total - 1), nlatu);
    u32x4 vpre[15]; float tabpre = 0.f;
    if (u < total) { attn4_load_v(vpre, qkv, cur, tid); if (tid < 480 && tdd < 31) tabpre = rpb[cur.h * 465 + trr * 31 + tdd]; }
    while (u < total) {
        const int b = cur.b, h = cur.h, qrow0 = cur.qrow0, rsu = cur.rsu, ntl = cur.ntl;
        const int rr = cur.r0 + qrow, rsq = min(max(rr - 4, 0), 56);
        const int nls = ntl ? 16 : 0, nseq = nls + 8, koff = 2 * (rsq - rsu), c0 = ntl;
        const bf16_t* kbase = kf + h * 2048 + lane * 8;
        const int klat0 = b * 128, kctx0 = 1024 + b * 8;
        s16x8 Qf[4], KA[4], KB[4];
        { const bf16_t* qp = qkv + (size_t)(((qrow0 >> 5) + qtile) * 16 + h) * 2048 + lane * 8;
#pragma unroll
          for (int ks = 0; ks < 4; ++ks) Qf[ks] = *(const s16x8*)(qp + 512 * ks); }
        attn4_load_k(KA, kbase, klat0, kctx0, attn4_kt(0, nls, koff, c0), ntl, rsu);
        attn4_load_k(KB, kbase, klat0, kctx0, attn4_kt(1, nls, koff, c0), ntl, rsu);
        int tidl = tid; asm volatile("" : "+v"(tidl));
#pragma unroll
        for (int i = 0; i < 4; ++i) { const int idx = tidl + NTHREADS * i; *(LAS u32x4*)(Vl + (idx >> 3) * AV_STR + (idx & 7) * 16) = vpre[i]; }
        if (ntl) {
#pragma unroll
            for (int i = 4; i < 15; ++i) { const int idx = tidl + NTHREADS * i; *(LAS u32x4*)(Vl + (idx >> 3) * AV_STR + (idx & 7) * 16) = vpre[i]; } }
        if (tid < 480) tab[tid] = tdd < 31 ? (tabpre - mb) * LOG2E : -1e30f;
        __syncthreads();
        f32x16 O0, O1;
#pragma unroll
        for (int i = 0; i < 16; ++i) { O0[i] = 0.f; O1[i] = 0.f; }
        float lsum = 0.f;
#pragma unroll 1
        for (int t = 0; t < nseq; t += 2) {
            { const int kt = attn4_kt(t, nls, koff, c0); const int krow = rsu + (kt >> 1);
              const int mode = t >= nls ? 0 : ((kt & 1) == qt ? 1 : 2 + qt);
              attn_one_tile(KA, Qf, Vl + (kt * 32 + 4 * hi + tr_q) * AV_STR + (16 * dgrp + 4 * tr_p) * 2, (const LAS unsigned char*)tab + (min(max(krow - rr + 7, 0), 14)) * 128, offo, offx, O0, O1, lsum, mode, mbl); }
            __builtin_amdgcn_sched_barrier(0);
            attn4_load_k(KA, kbase, klat0, kctx0, attn4_kt(min(t + 2, nseq - 2), nls, koff, c0), ntl, rsu);
            { const int kt = attn4_kt(t + 1, nls, koff, c0); const int krow = rsu + (kt >> 1);
              const int mode = t + 1 >= nls ? 0 : ((kt & 1) == qt ? 1 : 2 + qt);
              attn_one_tile(KB, Qf, Vl + (kt * 32 + 4 * hi + tr_q) * AV_STR + (16 * dgrp + 4 * tr_p) * 2, (const LAS unsigned char*)tab + (min(max(krow - rr + 7, 0), 14)) * 128, offo, offx, O0, O1, lsum, mode, mbl); }
            __builtin_amdgcn_sched_barrier(0);
            attn4_load_k(KB, kbase, klat0, kctx0, attn4_kt(min(t + 2, nseq - 2) + 1, nls, koff, c0), ntl, rsu);
        }
        const int un = u + T_.gsz;
        const AUnit4 nxt = attn4_decode(min(un, total - 1), nlatu);
        int tidm = tid; asm volatile("" : "+v"(tidm));
        if (un < total) { attn4_load_v(vpre, qkv, nxt, tidm); if (tid < 480 && tdd < 31) tabpre = rpb[nxt.h * 465 + trr * 31 + tdd]; }
        lsum += __shfl_xor(lsum, 32);
        { const float inv = 1.0f / lsum;
          bf16_t* op = ao + (size_t)(qrow0 + 32 * qtile + l31) * 1024 + h * 64 + 8 * hi;
          typedef unsigned u2p __attribute__((ext_vector_type(2)));
#pragma unroll
          for (int dt = 0; dt < 2; ++dt)
#pragma unroll
              for (int m = 0; m < 2; ++m) { const int j0 = 2 * m, j1 = 2 * m + 1;
                  const float* Ov = nullptr; (void)Ov;
                  unsigned ax, ay, bx, by;
                  if (dt == 0) { ax = pkb(O0[4 * j0] * inv, O0[4 * j0 + 1] * inv); ay = pkb(O0[4 * j0 + 2] * inv, O0[4 * j0 + 3] * inv); bx = pkb(O0[4 * j1] * inv, O0[4 * j1 + 1] * inv); by = pkb(O0[4 * j1 + 2] * inv, O0[4 * j1 + 3] * inv); }
                  else { ax = pkb(O1[4 * j0] * inv, O1[4 * j0 + 1] * inv); ay = pkb(O1[4 * j0 + 2] * inv, O1[4 * j0 + 3] * inv); bx = pkb(O1[4 * j1] * inv, O1[4 * j1 + 1] * inv); by = pkb(O1[4 * j1 + 2] * inv, O1[4 * j1 + 3] * inv); }
                  const u2p rx = __builtin_amdgcn_permlane32_swap(ax, bx, false, false), ry = __builtin_amdgcn_permlane32_swap(ay, by, false, false);
                  u32x4 o; o.x = rx.x; o.y = ry.x; o.z = rx.y; o.w = ry.y;
                  *(u32x4*)(op + 32 * dt + 16 * m) = o; } }
        __syncthreads();
        u = un; cur = nxt;
    }
}

constexpr int SP_RS = 320;
__device__ __forceinline__ void phase_spatial_mfma(const Params& p, int sl, int M, LAS unsigned char* lds, const Tix T_, const bool dummy = false) {
    bf16_t* vb = (bf16_t*)(p.ws + OFF_BIG); const float* lnacc = (const float*)(p.ws + OFF_LNACC) + (size_t)sl * MTOT * 2;
    const float* lng = p.sg_ln_g + sl * 3072; const float* lnb = p.sg_ln_b + sl * 3072;
    const int tid = T_.tid, lane = tid & 63, wave = __builtin_amdgcn_readfirstlane(tid >> 6), pt = wave & 3, cth = wave >> 2, l31 = lane & 31, hi = lane >> 5;
    const int tr_q = (lane & 15) >> 2, tr_p = lane & 3, dgrp = (lane >> 4) & 1;
    const int nunits = (M / 128) * 24;
    const int c8 = (tid & 15) * 8;
    s16x8 wx[8]; u32x4 vw[4]; f32x2 st2[4]; f32x4 g0, g1, b0, b1; float bs;
    const bf16_t* wsf = (const bf16_t*)(p.ws + OFF_WSF);
    const int NC = M / 128; int gload = -1;
#define SP_LOAD(uu) do { const int g_ = (uu) / NC, nc_ = (uu) % NC, r0_ = nc_ * 128; \
        if (g_ != gload) { gload = g_; \
            const bf16_t* wp_ = wsf + ((size_t)((sl * 24 + g_) * 4 + pt) * 8) * 512 + lane * 8; \
            _Pragma("unroll") for (int ks = 0; ks < 8; ++ks) wx[ks] = *(const s16x8*)(wp_ + ks * 512); \
            g0 = *(const f32x4*)(lng + g_ * 128 + c8); g1 = *(const f32x4*)(lng + g_ * 128 + c8 + 4); b0 = *(const f32x4*)(lnb + g_ * 128 + c8); b1 = *(const f32x4*)(lnb + g_ * 128 + c8 + 4); \
            bs = p.sg_b_s[((size_t)sl * 24 + g_) * 128 + 32 * pt + l31]; } \
        _Pragma("unroll") for (int i = 0; i < 4; ++i) { const int q_ = (tid + NTHREADS * i) >> 4; \
            vw[i] = *(const u32x4*)(vb + (size_t)(r0_ + q_) * 3072 + g_ * 128 + c8); st2[i] = *(const f32x2*)(lnacc + 2 * (r0_ + q_)); } } while (0)
    int u = (int)(((long)T_.bid * nunits) / T_.gsz), buf = 0; const int uend = (int)(((long)(T_.bid + 1) * nunits) / T_.gsz);
    if (u < uend) SP_LOAD(u);
    while (u < uend) {
        const int g = u / NC, nc = u % NC, r0 = nc * 128;
        LAS unsigned char* tile = lds + buf * (128 * SP_RS);
#pragma unroll
        for (int i = 0; i < 4; ++i) { const int q = (tid + NTHREADS * i) >> 4; const u32x4 w = vw[i];
            const float mean = st2[i].x * (1.0f / 3072.0f), rstd = __builtin_amdgcn_rsqf(fmaxf(st2[i].y * (1.0f / 3072.0f) - mean * mean, 0.f) + 1e-6f);
            u32x4 o;
            o.x = pkb((bf2f(w.x & 0xffffu) - mean) * rstd * g0.x + b0.x, (bf2f(w.x >> 16) - mean) * rstd * g0.y + b0.y);
            o.y = pkb((bf2f(w.y & 0xffffu) - mean) * rstd * g0.z + b0.z, (bf2f(w.y >> 16) - mean) * rstd * g0.w + b0.w);
            o.z = pkb((bf2f(w.z & 0xffffu) - mean) * rstd * g1.x + b1.x, (bf2f(w.z >> 16) - mean) * rstd * g1.y + b1.y);
            o.w = pkb((bf2f(w.w & 0xffffu) - mean) * rstd * g1.z + b1.z, (bf2f(w.w >> 16) - mean) * rstd * g1.w + b1.w);
            *(LAS u32x4*)(tile + q * SP_RS + c8 * 2) = o; }
        s16x8 Wf[8];
#pragma unroll
        for (int ks = 0; ks < 8; ++ks) Wf[ks] = wx[ks];
        const float bsc = bs;
        __syncthreads();
        const int un = u + 1;
        if (un < uend) SP_LOAD(un);
        __builtin_amdgcn_sched_barrier(0);
#pragma unroll
        for (int cc = 0; cc < 2; ++cc) { const int ct = 2 * cth + cc;
            f32x16 acc;
#pragma unroll
            for (int i = 0; i < 16; ++i) acc[i] = 0.f;
            const LAS unsigned char* ab = tile + (8 * hi + tr_q) * SP_RS + (32 * ct + 16 * dgrp + 4 * tr_p) * 2;
            s16x8 Af[8];
#pragma unroll
            for (int ks = 0; ks < 8; ++ks) Af[ks] = tr_pair(ab + 16 * ks * SP_RS, 4 * SP_RS);
            __builtin_amdgcn_sched_barrier(0);
#pragma unroll
            for (int ks = 0; ks < 8; ++ks) acc = MFMA32(Af[ks], Wf[ks], acc);
            bf16_t* orow = (dummy ? vb + (size_t)MTOT * 3072 + (size_t)((r0 + 32 * pt + l31) & 8191) * 3072 : vb + (size_t)(r0 + 32 * pt + l31) * 3072) + g * 128 + 32 * ct + 4 * hi;
#pragma unroll
            for (int j = 0; j < 4; ++j) { u32x2 o; o.x = pkb(acc[4 * j] + bsc, acc[4 * j + 1] + bsc); o.y = pkb(acc[4 * j + 2] + bsc, acc[4 * j + 3] + bsc); *(u32x2*)(orow + 8 * j) = o; }
        }
        u = un; buf ^= 1;
    }
#undef SP_LOAD
    __syncthreads();
}

__device__ __forceinline__ int epi_row(int rowbase, int idx) { return rowbase + 128 * (idx >> 2) + 16 * (idx & 3); }
template <class F> struct EpiG {
    static constexpr bool PERM = false, AFTER_DRAIN = false;
    typedef typename F::Pre Pre;
    F f;
    __device__ __forceinline__ void prefetch(Pre& pre, const Unit& u, int wr, int wc, int fr, int fq) const {
        f.prefetch(pre, u, u.pn * 256 + 64 * wc + 8 * fq, u.pm * 256 + wr * 64 + fr); }
    __device__ __forceinline__ void operator()(const f32x4 (&acc)[2][2][4][2], const Unit& u, int wr, int wc, int fr, int fq, const Pre& pre) const {
        F g = f; const int colb = u.pn * 256 + 64 * wc + 8 * fq, rowbase = u.pm * 256 + wr * 64 + fr;
        g.begin(u, colb, fq, rowbase, pre);
#pragma unroll
        for (int ai = 0; ai < 2; ++ai)
#pragma unroll
            for (int m = 0; m < 4; ++m) {
                g.row(ai * 4 + m, rowbase + ai * 128 + m * 16, colb, acc[ai][0][m][0], acc[ai][0][m][1], acc[ai][1][m][0], acc[ai][1][m][1]);
                asm volatile("" ::: "memory"); }
    }
};
struct PreSB { float v[8]; f32x4 bz[4];
    __device__ __forceinline__ void load(const float* ssq, int rowbase, const float* bp) {
#pragma unroll
        for (int i = 0; i < 8; ++i) v[i] = ssq[epi_row(rowbase, i)];
        bz[0] = *(const f32x4*)bp; bz[1] = *(const f32x4*)(bp + 4); bz[2] = *(const f32x4*)(bp + 32); bz[3] = *(const f32x4*)(bp + 36); } };
#ifdef NT_STORE
__device__ __forceinline__ void store8_bf16(bf16_t* o, const f32x4 a, const f32x4 b) { u32x4 w; w.x = pk2(a.x, a.y); w.y = pk2(a.z, a.w); w.z = pk2(b.x, b.y); w.w = pk2(b.z, b.w); __builtin_nontemporal_store(w, (u32x4*)o); }
#else
__device__ __forceinline__ void store8_bf16(bf16_t* o, const f32x4 a, const f32x4 b) { u32x4 w; w.x = pk2(a.x, a.y); w.y = pk2(a.z, a.w); w.z = pk2(b.x, b.y); w.w = pk2(b.z, b.w); *(u32x4*)o = w; }
#endif
__device__ __forceinline__ float sumsq4(const f32x4 x) { return (x.x * x.x + x.y * x.y) + (x.z * x.z + x.w * x.w); }
__device__ __forceinline__ float sum4(const f32x4 x) { return (x.x + x.y) + (x.z + x.w); }
__device__ __forceinline__ float rstd_from(float ssq) { return __builtin_amdgcn_rsqf(ssq * (1.0f / 1024.0f) + 1e-6f); }
typedef unsigned u32x2p __attribute__((ext_vector_type(2)));
__device__ __forceinline__ float xsum16(float v) { const unsigned u = __float_as_uint(v); const u32x2p r = __builtin_amdgcn_permlane16_swap(u, u, false, false); return __uint_as_float(r.x) + __uint_as_float(r.y); }
__device__ __forceinline__ float xsum32(float v) { const unsigned u = __float_as_uint(v); const u32x2p r = __builtin_amdgcn_permlane32_swap(u, u, false, false); return __uint_as_float(r.x) + __uint_as_float(r.y); }
__device__ __forceinline__ void atomic_addf(float* p, float v) { __hip_atomic_fetch_add(p, v, __ATOMIC_RELAXED, __HIP_MEMORY_SCOPE_AGENT); }
struct FQKV { static constexpr bool IDEMP = true; bf16_t* O; const float* qg; const float* kg; const float* ssq; const float* bias;
    typedef PreSB Pre;
    f32x4 gn[4], bz[4]; int sect; float rqv[8];
    __device__ __forceinline__ void prefetch(Pre& pre, const Unit& u, int colb, int rowbase) const { pre.load(ssq, rowbase, bias + (size_t)min(u.pm >> 4, 8) * 3072 + colb); }
    __device__ __forceinline__ void begin(const Unit& u, int colb, int fq, int rowbase, const Pre& pre) {
#pragma unroll
        for (int i = 0; i < 8; ++i) rqv[i] = pre.v[i];
#pragma unroll
        for (int i = 0; i < 4; ++i) bz[i] = pre.bz[i];
        sect = u.pn >> 2;
        if (sect < 2) { const float* gp = (sect == 0 ? qg : kg) + 8 * fq; const float mul = sect == 0 ? 0.125f * 1.4426950408889634f : 1.0f;
            gn[0] = *(const f32x4*)gp * mul; gn[1] = *(const f32x4*)(gp + 4) * mul; gn[2] = *(const f32x4*)(gp + 32) * mul; gn[3] = *(const f32x4*)(gp + 36) * mul; } }
    __device__ __forceinline__ void row(int idx, int row, int colb, f32x4 a0, f32x4 b0, f32x4 a1, f32x4 b1) {
        const float rs = rstd_from(rqv[idx]);
        a0 = a0 * rs + bz[0]; b0 = b0 * rs + bz[1]; a1 = a1 * rs + bz[2]; b1 = b1 * rs + bz[3];
        if (sect < 2) { float ss = (sumsq4(a0) + sumsq4(b0)) + (sumsq4(a1) + sumsq4(b1));
            ss = xsum32(xsum16(ss));
            const float r2 = __builtin_amdgcn_rsqf(ss * (1.0f / 64.0f) + 1e-6f);
            a0 = a0 * r2 * gn[0]; b0 = b0 * r2 * gn[1]; a1 = a1 * r2 * gn[2]; b1 = b1 * r2 * gn[3]; }
        if (sect < 2) {
            const int within = colb & 1023, h = within >> 6, fq = (within >> 3) & 7;
            bf16_t* op = O + (size_t)sect * MTOT * 1024 + ((size_t)((row >> 5) * 16 + h) * 4 + (fq >> 1)) * 512 + ((fq & 1) * 32 + (row & 31)) * 8;
            store8_bf16(op, a0, b0); store8_bf16(op + 2 * 512, a1, b1);
        } else { bf16_t* op = O + (size_t)2 * MTOT * 1024 + (size_t)row * 1024 + (colb - 2048); store8_bf16(op, a0, b0); store8_bf16(op + 32, a1, b1); } } };
struct FSqrelu { static constexpr bool IDEMP = true; bf16_t* O; const float* ssq; const float* bias;
    typedef PreSB Pre;
    f32x4 bz[4]; float rqv[8];
    __device__ __forceinline__ void prefetch(Pre& pre, const Unit& u, int colb, int rowbase) const { pre.load(ssq, rowbase, bias + (size_t)min(u.pm >> 4, 8) * 4096 + colb); }
    __device__ __forceinline__ void begin(const Unit& u, int colb, int fq, int rowbase, const Pre& pre) {
#pragma unroll
        for (int i = 0; i < 8; ++i) rqv[i] = pre.v[i];
#pragma unroll
        for (int i = 0; i < 4; ++i) bz[i] = pre.bz[i]; }
    __device__ __forceinline__ void row(int idx, int row, int colb, f32x4 a0, f32x4 b0, f32x4 a1, f32x4 b1) {
        const float rs = rstd_from(rqv[idx]); const f32x4 z = (f32x4){0.f, 0.f, 0.f, 0.f};
        a0 = __builtin_elementwise_max(a0 * rs + bz[0], z); b0 = __builtin_elementwise_max(b0 * rs + bz[1], z); a1 = __builtin_elementwise_max(a1 * rs + bz[2], z); b1 = __builtin_elementwise_max(b1 * rs + bz[3], z);
        bf16_t* op = O + (size_t)row * 4096 + colb; store8_bf16(op, a0 * a0, b0 * b0); store8_bf16(op + 32, a1 * a1, b1 * b1); } };
struct FGeluV { static constexpr bool IDEMP = false; bf16_t* O; const float* ssq; const float* bias; float* lnacc;
    typedef PreSB Pre;
    f32x4 bz[4]; int fq_; float rqv[8];
    __device__ __forceinline__ void prefetch(Pre& pre, const Unit& u, int colb, int rowbase) const { pre.load(ssq, rowbase, bias + (size_t)min(u.pm >> 4, 8) * 6144 + colb); }
    __device__ __forceinline__ void begin(const Unit& u, int colb, int fq, int rowbase, const Pre& pre) { fq_ = fq;
#pragma unroll
        for (int i = 0; i < 8; ++i) rqv[i] = pre.v[i];
#pragma unroll
        for (int i = 0; i < 4; ++i) bz[i] = pre.bz[i]; }
    __device__ __forceinline__ void row(int idx, int row, int colb, f32x4 a0, f32x4 b0, f32x4 a1, f32x4 b1) {
        const float rs = rstd_from(rqv[idx]);
        a0 = gelu4(a0 * rs + bz[0]); b0 = gelu4(b0 * rs + bz[1]); a1 = gelu4(a1 * rs + bz[2]); b1 = gelu4(b1 * rs + bz[3]);
        bf16_t* op = O + (size_t)row * 3072 + colb; store8_bf16(op, a0, b0); store8_bf16(op + 32, a1, b1);
        float s1 = (sum4(a0) + sum4(b0)) + (sum4(a1) + sum4(b1)), s2 = (sumsq4(a0) + sumsq4(b0)) + (sumsq4(a1) + sumsq4(b1));
        s1 = xsum32(xsum16(s1)); s2 = xsum32(xsum16(s2));
        if (fq_ == 0) { atomic_addf(lnacc + 2 * (size_t)row, s1); atomic_addf(lnacc + 2 * (size_t)row + 1, s2); } } };
struct FGeluU { static constexpr bool IDEMP = false; bf16_t* O; const float* ssq; const float* bias;
    typedef PreSB Pre;
    f32x4 bz[4]; float rqv[8]; u32x4 sv[2][2]; int rowbase_;
    __device__ __forceinline__ void prefetch(Pre& pre, const Unit& u, int colb, int rowbase) const { pre.load(ssq, rowbase, bias + (size_t)min(u.pm >> 4, 8) * 6144 + colb); }
    __device__ __forceinline__ void fetch(int idx, int colb) { const bf16_t* op = O + (size_t)epi_row(rowbase_, idx) * 3072 + colb; sv[idx & 1][0] = *(const u32x4*)op; sv[idx & 1][1] = *(const u32x4*)(op + 32); }
    __device__ __forceinline__ void begin(const Unit& u, int colb, int fq, int rowbase, const Pre& pre) { rowbase_ = rowbase; fetch(0, colb);
#pragma unroll
        for (int i = 0; i < 8; ++i) rqv[i] = pre.v[i];
#pragma unroll
        for (int i = 0; i < 4; ++i) bz[i] = pre.bz[i]; }
    __device__ __forceinline__ static f32x4 lo4(const u32x4 s) { return (f32x4){bf2f(s.x & 0xffffu), bf2f(s.x >> 16), bf2f(s.y & 0xffffu), bf2f(s.y >> 16)}; }
    __device__ __forceinline__ static f32x4 hi4(const u32x4 s) { return (f32x4){bf2f(s.z & 0xffffu), bf2f(s.z >> 16), bf2f(s.w & 0xffffu), bf2f(s.w >> 16)}; }
    __device__ __forceinline__ void row(int idx, int row, int colb, f32x4 a0, f32x4 b0, f32x4 a1, f32x4 b1) {
        if (idx < 7) fetch(idx + 1, colb);
        const float rs = rstd_from(rqv[idx]);
        bf16_t* op = O + (size_t)row * 3072 + colb; const u32x4 sv0 = sv[idx & 1][0], sv1 = sv[idx & 1][1];
        a0 = gelu4(a0 * rs + bz[0]) * lo4(sv0); b0 = gelu4(b0 * rs + bz[1]) * hi4(sv0); a1 = gelu4(a1 * rs + bz[2]) * lo4(sv1); b1 = gelu4(b1 * rs + bz[3]) * hi4(sv1);
        store8_bf16(op, a0, b0); store8_bf16(op + 32, a1, b1); } };
struct FResid { static constexpr bool IDEMP = false; const float* inl; const float* inc; float* outl; float* outc; const float* gate;
    const float* gsn; bf16_t* xb; float* ssqn;
    struct Pre { f32x4 gz[4]; };
    f32x4 gz[4], gsz[4], xin[2][4]; int fq_, rowbase_;
    __device__ __forceinline__ void prefetch(Pre& pre, const Unit& u, int colb, int rowbase) const { const float* gp = gate + (size_t)min(u.pm >> 4, 8) * 6144 + colb;
        pre.gz[0] = *(const f32x4*)gp; pre.gz[1] = *(const f32x4*)(gp + 4); pre.gz[2] = *(const f32x4*)(gp + 32); pre.gz[3] = *(const f32x4*)(gp + 36); }
    __device__ __forceinline__ void fetch(int idx, int colb) { const int row = epi_row(rowbase_, idx);
        const float* ip = row < NLAT ? inl + (size_t)row * 1024 + colb : inc + (size_t)(row - NLAT) * 1024 + colb;
        xin[idx & 1][0] = *(const f32x4*)ip; xin[idx & 1][1] = *(const f32x4*)(ip + 4); xin[idx & 1][2] = *(const f32x4*)(ip + 32); xin[idx & 1][3] = *(const f32x4*)(ip + 36); }
    __device__ __forceinline__ void begin(const Unit& u, int colb, int fq, int rowbase, const Pre& pre) { const int b = min(u.pm >> 4, 8); fq_ = fq; rowbase_ = rowbase; fetch(0, colb);
#pragma unroll
        for (int i = 0; i < 4; ++i) gz[i] = pre.gz[i];
        if (gsn) { const float* sp = gsn + (size_t)b * 1024 + colb; gsz[0] = *(const f32x4*)sp; gsz[1] = *(const f32x4*)(sp + 4); gsz[2] = *(const f32x4*)(sp + 32); gsz[3] = *(const f32x4*)(sp + 36); } }
    __device__ __forceinline__ void row(int idx, int row, int colb, f32x4 a0, f32x4 b0, f32x4 a1, f32x4 b1) {
        if (idx < 7) fetch(idx + 1, colb);
        float* op = row < NLAT ? outl + (size_t)row * 1024 + colb : outc + (size_t)(row - NLAT) * 1024 + colb;
        a0 = xin[idx & 1][0] + gz[0] * a0; b0 = xin[idx & 1][1] + gz[1] * b0; a1 = xin[idx & 1][2] + gz[2] * a1; b1 = xin[idx & 1][3] + gz[3] * b1;
        *(f32x4*)op = a0; *(f32x4*)(op + 4) = b0; *(f32x4*)(op + 32) = a1; *(f32x4*)(op + 36) = b1;
        if (gsn) { float ss = (sumsq4(a0) + sumsq4(b0)) + (sumsq4(a1) + sumsq4(b1));
            ss = xsum32(xsum16(ss));
            if (fq_ == 0) atomic_addf(ssqn + row, ss);
            bf16_t* xp = xb + (size_t)row * 1024 + colb; store8_bf16(xp, a0 * gsz[0], b0 * gsz[1]); store8_bf16(xp + 32, a1 * gsz[2], b1 * gsz[3]); } } };

template <class F> __device__ __forceinline__ void run_gemm(LAS unsigned char* lds, const bf16_t* A, const bf16_t* Bt, int M, int N, int K, const F& f, const Tix T_) {
    pg8::StaticOrder S; S.init(M, N, T_.gsz, T_.bid);
    pg8::Gemm g; g.A = A; g.Bt = Bt; g.M = M; g.N = N; g.K = K; g.ld = K;
#ifdef STAGGER_US
    if ((T_.bid >> 3) & 1) { const unsigned long long t0 = __builtin_amdgcn_s_memrealtime(); while (__builtin_amdgcn_s_memrealtime() - t0 < (unsigned long long)(STAGGER_US * 100)) __builtin_amdgcn_s_sleep(8); }
#endif
    EpiG<F> E; E.f = f;
    pg8::gemm_phase<EpiG<F>, pg8::StaticOrder, true, true>(lds, g, S, E, T_.tid);
}


struct FPartial { static constexpr bool IDEMP = true; bf16_t* part; int klen;
    struct Pre { int dummy; };
    bf16_t* base_;
    __device__ __forceinline__ void prefetch(Pre& pre, const Unit& u, int colb, int rowbase) const { pre.dummy = 0; }
    __device__ __forceinline__ void begin(const Unit& u, int colb, int fq, int rowbase, const Pre& pre) { base_ = part + (size_t)(u.ko / klen) * 2048 * 1024; }
    __device__ __forceinline__ void row(int idx, int row, int colb, f32x4 a0, f32x4 b0, f32x4 a1, f32x4 b1) {
        bf16_t* op = base_ + (size_t)(row - NLAT) * 1024 + colb; store8_bf16(op, a0, b0); store8_bf16(op + 32, a1, b1); } };
__device__ __forceinline__ void run_gemm_ctx_split(LAS unsigned char* lds, const bf16_t* A, const bf16_t* Bt, bf16_t* part, int K, const Tix T_) {
    pg8::SplitOrder S; S.init(8, 4, K >> 9, NLAT / 256, 512, T_.gsz, T_.bid);
    pg8::Gemm g; g.A = A; g.Bt = Bt; g.M = MTOT; g.N = 1024; g.K = 512; g.ld = K;
    FPartial f; f.part = part; f.klen = 512;
    EpiG<FPartial> E; E.f = f;
    pg8::gemm_phase<EpiG<FPartial>, pg8::SplitOrder, true, true>(lds, g, S, E, T_.tid);
}
__device__ __forceinline__ void phase_ctxfin(const Params& p, int L, bool after_mlp, const Tix T_) {
    const bf16_t* part = (const bf16_t*)(p.ws + OFF_PART); float* ctxr = (float*)(p.ws + OFF_CTXR);
    const float* gate = (const float*)(p.ws + OFF_MODS) + (size_t)(L * 9 + 8) * 6144 + (after_mlp ? 5120 : 2048);
    const int nn = after_mlp ? 2 * L + 2 : 2 * L + 1;
    const float* gsn = (const float*)(p.ws + OFF_GS) + (size_t)(nn * 9 + 8) * 1024;
    bf16_t* xb = (bf16_t*)(p.ws + OFF_HB); float* ssqn = (float*)(p.ws + OFF_SSQ) + (size_t)nn * MTOT;
    const int lane = T_.tid & 63, gw = T_.bid * 8 + (T_.tid >> 6), NGW = T_.gsz * 8;
    for (int row = gw; row < 2048; row += NGW) {
        u32x2 pa[4][8]; f32x4 xv[4], gv[4], sv[4];
#pragma unroll
        for (int j = 0; j < 4; ++j) { const int col = 4 * lane + 256 * j; const size_t o = (size_t)row * 1024 + col;
#pragma unroll
            for (int k = 0; k < 6; ++k) pa[j][k] = *(const u32x2*)(part + (size_t)k * 2048 * 1024 + o);
#pragma unroll
            for (int k = 6; k < 8; ++k) pa[j][k] = after_mlp ? *(const u32x2*)(part + (size_t)k * 2048 * 1024 + o) : (u32x2){0u, 0u};
            xv[j] = *(const f32x4*)(ctxr + o); gv[j] = *(const f32x4*)(gate + col); sv[j] = *(const f32x4*)(gsn + col); }
        __builtin_amdgcn_sched_barrier(0);
        float ss = 0.f;
#pragma unroll
        for (int j = 0; j < 4; ++j) { const int col = 4 * lane + 256 * j; const size_t o = (size_t)row * 1024 + col;
            f32x4 a = (f32x4){0.f, 0.f, 0.f, 0.f};
#pragma unroll
            for (int k = 0; k < 8; ++k) a += (f32x4){bf2f(pa[j][k].x & 0xffffu), bf2f(pa[j][k].x >> 16), bf2f(pa[j][k].y & 0xffffu), bf2f(pa[j][k].y >> 16)};
            const f32x4 x = xv[j] + gv[j] * a;
            *(f32x4*)(ctxr + o) = x; ss += sumsq4(x);
            const f32x4 xs = x * sv[j];
            u32x2 w; w.x = pk2(xs.x, xs.y); w.y = pk2(xs.z, xs.w);
            *(u32x2*)(xb + (size_t)(NLAT + row) * 1024 + col) = w; }
        ss = wave_sum(ss);
        if (lane == 0) ssqn[NLAT + row] = ss;
    }
}

enum { OP_QKV, OP_ATTN, OP_MIXOUT, OP_MLP1, OP_MLP2, OP_VGEMM, OP_SPATIAL, OP_UGEMM, OP_PROLOGUE, OP_PHASE0B, OP_CTXFIN, OP_CTXFIN_MIX };

__device__ __forceinline__ void decode_phase(int ph, int& L, int& op) {
    L = 0; op = ph == 0 ? OP_PROLOGUE : OP_PHASE0B;
    if (ph > 1) {
        int q = ph - 2;
        if (q < 6) { L = 0; } else if (q < 14) { L = 1; q -= 6; } else if (q < 19) { L = 2; q -= 14; } else { L = 3; q -= 19; }
        if ((L & 1) == 0) op = q == 0 ? OP_QKV : q == 1 ? OP_ATTN : q == 2 ? OP_MIXOUT : q == 3 ? OP_MLP1 : q == 4 ? OP_MLP2 : OP_CTXFIN;
        else if (L == 1) op = q == 0 ? OP_VGEMM : q == 1 ? OP_SPATIAL : q == 2 ? OP_UGEMM : q == 3 ? OP_MIXOUT : q == 4 ? OP_CTXFIN_MIX : q == 5 ? OP_MLP1 : q == 6 ? OP_MLP2 : OP_CTXFIN;
        else op = q == 0 ? OP_VGEMM : q == 1 ? OP_SPATIAL : q == 2 ? OP_UGEMM : q == 3 ? OP_MIXOUT : q == 4 ? OP_MLP1 : OP_MLP2;
    }
}

__device__ __forceinline__ void run_phase(const Params& p, int ph, LAS unsigned char* lds, const Tix T_) {
    int L, op; decode_phase(ph, L, op);
#ifdef ONLY_OP
    op = ONLY_OP;
#endif
    const int mi = L >> 1;
    const bool attnL = (L & 1) == 0;
    const int Mfull = L < 2 ? MTOT : NLAT;
    const float* modsl = (const float*)(p.ws + OFF_MODS) + (size_t)L * 9 * 6144;
    float* ctxr = (float*)(p.ws + OFF_CTXR);
    bf16_t* hb = (bf16_t*)(p.ws + OFF_HB); bf16_t* big = (bf16_t*)(p.ws + OFF_BIG);
    float* ssq = (float*)(p.ws + OFF_SSQ); const float* gs = (const float*)(p.ws + OFF_GS);
    const bool first = (L == 0);
    switch (op) {
    case OP_PROLOGUE: phase_zero(p, T_); phase_mods(p, lds, T_); __syncthreads(); phase_convert(p, lds, T_); break;
    case OP_PHASE0B: phase_0b(p, lds, T_); break;
    case OP_QKV: { FQKV f; f.O = big; f.qg = p.na_q_norm + mi * 64; f.kg = p.na_k_norm + mi * 64; f.ssq = ssq + (size_t)(2 * L) * MTOT; f.bias = (const float*)(p.ws + OFF_BQKV) + (size_t)mi * 9 * 3072;
        run_gemm(lds, hb, (const bf16_t*)(p.ws + OFF_QKVT) + (size_t)mi * 3072 * 1024, MTOT, 3072, 1024, f, T_); } break;
#ifdef REP_ATTN_DUMMY
    case OP_ATTN: phase_attn_mfma(p, mi, L == 0, lds, T_, 1); __syncthreads(); phase_attn_mfma(p, mi, L == 0, lds, T_); break;
#else
    case OP_ATTN: phase_attn4(p, mi, L == 0, lds, T_); break;
#endif
    case OP_MIXOUT: case OP_MLP2: {
        FResid f; const bool mo = (op == OP_MIXOUT);
        f.inl = (first && mo) ? p.x : p.out; f.inc = (first && mo) ? p.ctx : ctxr; f.outl = p.out; f.outc = ctxr; f.gate = modsl + (mo ? 2048 : 5120);
        const int nn = mo ? 2 * L + 1 : 2 * L + 2;
        const bool has_next = nn < 8 && !(nn == 6 + 0 && false);
        f.gsn = has_next ? gs + (size_t)nn * 9 * 1024 : nullptr; f.xb = hb; f.ssqn = ssq + (size_t)(has_next ? nn : 0) * MTOT;
        const bf16_t* A; const bf16_t* Bt; int K;
        if (!mo) { A = big; Bt = (const bf16_t*)(p.ws + OFF_W2T) + (size_t)L * 1024 * 4096; K = 4096; }
        else if (attnL) { A = big + (size_t)MTOT * 3072; Bt = (const bf16_t*)(p.ws + OFF_WOT) + (size_t)mi * 1024 * 1024; K = 1024; }
        else { A = big; Bt = (const bf16_t*)(p.ws + OFF_SGOT) + (size_t)mi * 1024 * 3072; K = 3072; }
        if ((!mo && L < 2) || (mo && L == 1)) { run_gemm(lds, A, Bt, NLAT, 1024, K, f, T_); __syncthreads(); run_gemm_ctx_split(lds, A, Bt, (bf16_t*)(p.ws + OFF_PART), K, T_); }
        else run_gemm(lds, A, Bt, Mfull, 1024, K, f, T_); } break;
    case OP_CTXFIN: phase_ctxfin(p, L, true, T_); break;
    case OP_CTXFIN_MIX: phase_ctxfin(p, L, false, T_); break;
    case OP_MLP1: { FSqrelu f; f.O = big; f.ssq = ssq + (size_t)(2 * L + 1) * MTOT; f.bias = (const float*)(p.ws + OFF_BMLP) + (size_t)L * 9 * 4096;
        run_gemm(lds, hb, (const bf16_t*)(p.ws + OFF_W1T) + (size_t)L * 4096 * 1024, Mfull, 4096, 1024, f, T_); } break;
    case OP_VGEMM: { FGeluV f; f.O = big; f.ssq = ssq + (size_t)(2 * L) * MTOT; f.bias = (const float*)(p.ws + OFF_BWIN) + (size_t)mi * 9 * 6144 + 3072; f.lnacc = (float*)(p.ws + OFF_LNACC) + (size_t)mi * MTOT * 2;
        run_gemm(lds, hb, (const bf16_t*)(p.ws + OFF_WINT) + (size_t)mi * 6144 * 1024 + (size_t)3072 * 1024, Mfull, 3072, 1024, f, T_); } break;
#ifdef REP_SPATIAL
    case OP_SPATIAL: phase_spatial_mfma(p, mi, Mfull, lds, T_, true); __syncthreads(); phase_spatial_mfma(p, mi, Mfull, lds, T_); break;
#else
    case OP_SPATIAL: phase_spatial_mfma(p, mi, Mfull, lds, T_); break;
#endif
    case OP_UGEMM: { FGeluU f; f.O = big; f.ssq = ssq + (size_t)(2 * L) * MTOT; f.bias = (const float*)(p.ws + OFF_BWIN) + (size_t)mi * 9 * 6144;
        run_gemm(lds, hb, (const bf16_t*)(p.ws + OFF_WINT) + (size_t)mi * 6144 * 1024, Mfull, 3072, 1024, f, T_); } break;
    default: break;
    }
}

#ifndef ONE_LAUNCH
#define ONE_LAUNCH 1
#endif
__global__ void __launch_bounds__(NTHREADS) mk(Params p0) {
    extern __shared__ __attribute__((aligned(16))) unsigned char lds_raw[];
    LAS unsigned char* lds = (LAS unsigned char*)lds_raw;
#if ONE_LAUNCH
    cg::grid_group grid = cg::this_grid();
    if (p0.ph_lo < 0) grid.sync();
    volatile LAS unsigned* st = (volatile LAS unsigned*)(lds + LDS_ST_OFF);
    if (threadIdx.x == 0) { st[0] = 0u; st[1] = 0u; }
    __syncthreads();
    const XcdBarrier xbar = xcd_barrier_post((unsigned*)(p0.ws + OFF_BAR), st);
    bool first_it = true, repeated = false;
    for (int ph = p0.ph_lo; ph < p0.ph_hi; ) {
        if (!first_it) xcd_barrier(xbar);
#ifdef EXTRA_SYNC
        if (ph == 3) { for (int e = 0; e < EXTRA_SYNC; ++e) xcd_barrier(xbar); }
#endif
        first_it = false;
        Tix T_; T_.tid = threadIdx.x; T_.bid = blockIdx.x; T_.gsz = gridDim.x;
        size_t z = 0;
        asm volatile("" : "+v"(T_.tid)); asm volatile("" : "+s"(T_.bid), "+s"(T_.gsz), "+s"(z));
        Params p = p0;
        { const float** pp = (const float**)&p;
#pragma unroll
          for (int i = 0; i < 22; ++i) pp[i] += z; }
        p.out += z; p.ws += z;
        run_phase(p, ph, lds, T_);
        __syncthreads();
        if (REP_MASK != 0) { int L_, op_; decode_phase(ph, L_, op_); if (((REP_MASK >> op_) & 1) && !repeated) { repeated = true; continue; } }
        repeated = false; ++ph;
    }
#else
    Tix T_; T_.tid = threadIdx.x; T_.bid = blockIdx.x; T_.gsz = gridDim.x;
    run_phase(p0, p0.ph_lo, lds, T_);
#endif
}

extern "C" void kernel_launch(void* const* d_in, const int* in_sizes, int n_in, void* d_out, int out_size, void* d_ws, size_t ws_size, hipStream_t stream) {
    static int grid = 0;
    if (grid == 0) {
        if (n_in != 22 || ws_size < WS_END) { fprintf(stderr, "kernel_launch: unexpected n_in %d or ws_size %zu (< %zu)\n", n_in, ws_size, (size_t)WS_END); grid = -1; return; }
        int dev = 0, cus = 0, per_cu = 0;
        hipGetDevice(&dev); hipDeviceGetAttribute(&cus, hipDeviceAttributeMultiprocessorCount, dev);
        if (hipFuncSetAttribute((const void*)mk, hipFuncAttributeMaxDynamicSharedMemorySize, LDS_BYTES) != hipSuccess) { fprintf(stderr, "kernel_launch: hipFuncSetAttribute failed\n"); grid = -1; return; }
        if (hipOccupancyMaxActiveBlocksPerMultiprocessor(&per_cu, (const void*)mk, NTHREADS, LDS_BYTES) != hipSuccess || per_cu < 1) { fprintf(stderr, "kernel_launch: occupancy query says %d\n", per_cu); per_cu = 1; }
        (void)hipGetLastError();
        grid = cus;
    }
    if (grid < 0) return;
    if (hipMemsetAsync((unsigned char*)d_ws + OFF_BAR, 0, 16384, stream) != hipSuccess) { fprintf(stderr, "kernel_launch: memset of the barrier words failed\n"); return; }
    Params p{};
    const float** pp = (const float**)&p;
    for (int i = 0; i < 22; ++i) pp[i] = (const float*)d_in[i];
    p.out = (float*)d_out; p.ws = (unsigned char*)d_ws;
#if ONE_LAUNCH
    p.ph_lo = 0; p.ph_hi = NPH;
    void* args[] = {&p};
    hipError_t e = hipLaunchCooperativeKernel((void*)mk, dim3(grid), dim3(NTHREADS), args, LDS_BYTES, stream);
    if (e != hipSuccess) fprintf(stderr, "cooperative launch failed: %s (grid %d)\n", hipGetErrorString(e), grid);
#else
    for (int ph = 0; ph < NPH; ++ph) { p.ph_lo = ph; p.ph_hi = ph + 1; hipLaunchKernelGGL(mk, dim3(grid), dim3(NTHREADS), LDS_BYTES, stream, p); }
#endif
}
```
